# Optimizing an MI355X kernel written in HIP

```python
import jax, jax.numpy as jnp
from jax import lax
import numpy as np

D_MODEL = 2048
BATCH = 2
SEQ = 16384
DEPTH = 1

PLE_DIM = 256
GDN_HEADS = 8
GDN_DK = 128
GDN_DV = 128
GDN_CONV = 4
GDN_CHUNK = 64
MOBA_HEADS = 8
MOBA_DH = 128
MOBA_BLOCK = 256
MOBA_TOPK = 3
MOBA_Q_BLOCK = 64
D_FF = -(-8 * D_MODEL // (3 * 256)) * 256
RMS_EPS = 1e-6
GDN_QK_W = GDN_HEADS * GDN_DK
GDN_V_W = GDN_HEADS * GDN_DV
MOBA_W = MOBA_HEADS * MOBA_DH
MIX_W = GDN_V_W + MOBA_W
IN_SPLITS = (GDN_QK_W, GDN_QK_W, GDN_V_W, GDN_V_W, GDN_HEADS, GDN_HEADS, MOBA_W, MOBA_W, MOBA_W)
IN_W = sum(IN_SPLITS)
CONV_W = 2 * GDN_QK_W + GDN_V_W

kernel_name = "hybrid_gdn_moba_parallel_heads"


def rms_norm(x, w, eps=RMS_EPS):
    x32 = x.astype(jnp.float32)
    y = x32 * lax.rsqrt(jnp.mean(x32 * x32, axis=-1, keepdims=True) + eps)
    return (y * w.astype(jnp.float32)).astype(x.dtype)


def l2_norm(x, eps=1e-6):
    return x * lax.rsqrt(jnp.sum(x * x, axis=-1, keepdims=True) + eps)


def causal_short_conv(x, w):
    K = w.shape[1]
    T = x.shape[1]
    xp = jnp.pad(x, ((0, 0), (K - 1, 0), (0, 0)))
    out = xp[:, 0:T] * w[:, 0]
    for j in range(1, K):
        out = out + xp[:, j:j + T] * w[:, j]
    return out


def chunk_gated_delta_rule(q, k, v, g, beta):
    B, T, H, Dk = q.shape
    Dv = v.shape[-1]
    C = GDN_CHUNK
    NC = T // C
    to_chunks = lambda t: t.reshape(B, NC, C, H, t.shape[-1]).transpose(0, 3, 1, 2, 4)
    q, k, v = to_chunks(q), to_chunks(k), to_chunks(v)
    g = g.reshape(B, NC, C, H).transpose(0, 3, 1, 2)
    beta = beta.reshape(B, NC, C, H).transpose(0, 3, 1, 2)
    gc = jnp.cumsum(g, axis=-1)
    tril = jnp.tril(jnp.ones((C, C), dtype=bool))
    strict = jnp.tril(jnp.ones((C, C), dtype=bool), -1)
    decay = jnp.exp(jnp.where(tril, gc[..., :, None] - gc[..., None, :], -jnp.inf))
    k_beta = k * beta[..., None]
    v_beta = v * beta[..., None]
    A = jnp.where(strict, jnp.einsum('bhncd,bhnsd->bhncs', k_beta, k) * decay, 0.0)
    eye = jnp.eye(C, dtype=A.dtype)
    Tm = lax.linalg.triangular_solve(eye + A, jnp.broadcast_to(eye, A.shape),
                                     left_side=True, lower=True)
    u = jnp.einsum('bhncs,bhnse->bhnce', Tm, v_beta)
    w = jnp.einsum('bhncs,bhnsd->bhncd', Tm, k_beta * jnp.exp(gc)[..., None])
    qk = jnp.where(tril, jnp.einsum('bhncd,bhnsd->bhncs', q, k) * decay, 0.0)
    g_last = gc[..., -1]
    k_dec = k * jnp.exp(g_last[..., None] - gc)[..., None]
    q_dec = q * jnp.exp(gc)[..., None]
    xs = tuple(jnp.moveaxis(t, 2, 0) for t in (q_dec, k_dec, u, w, qk, g_last))

    def step(S, inp):
        q_c, k_c, u_c, w_c, qk_c, gl = inp
        v_new = u_c - jnp.einsum('bhcd,bhde->bhce', w_c, S)
        o_c = jnp.einsum('bhcd,bhde->bhce', q_c, S) + jnp.einsum('bhcs,bhse->bhce', qk_c, v_new)
        S = S * jnp.exp(gl)[..., None, None] + jnp.einsum('bhcd,bhce->bhde', k_c, v_new)
        return S, o_c

    S0 = jnp.zeros((B, H, Dk, Dv), jnp.float32)
    _, o = lax.scan(step, S0, xs)
    return o.transpose(1, 0, 3, 2, 4).reshape(B, T, H, Dv)


def gated_deltanet(q, k, v, z, b, a, conv_w, A_log, dt_bias, norm_w):
    B, T, _ = q.shape
    dtype = q.dtype
    qkv = jax.nn.silu(causal_short_conv(jnp.concatenate([q, k, v], axis=-1), conv_w))
    q, k, v = jnp.split(qkv, [GDN_QK_W, 2 * GDN_QK_W], axis=-1)
    q = l2_norm(q.reshape(B, T, GDN_HEADS, GDN_DK).astype(jnp.float32)) * (GDN_DK ** -0.5)
    k = l2_norm(k.reshape(B, T, GDN_HEADS, GDN_DK).astype(jnp.float32))
    v = v.reshape(B, T, GDN_HEADS, GDN_DV).astype(jnp.float32)
    beta = jax.nn.sigmoid(b.astype(jnp.float32))
    g = -jnp.exp(A_log.astype(jnp.float32)) * jax.nn.softplus(a.astype(jnp.float32) + dt_bias.astype(jnp.float32))
    o = chunk_gated_delta_rule(q, k, v, g, beta)
    zh = z.reshape(B, T, GDN_HEADS, GDN_DV).astype(jnp.float32)
    o = rms_norm(o, norm_w) * jax.nn.silu(zh)
    return o.reshape(B, T, GDN_V_W).astype(dtype)


def moba_attention(q, k, v, q_gain, k_gain):
    B, T, _ = q.shape
    H, D, BLK, QB = MOBA_HEADS, MOBA_DH, MOBA_BLOCK, MOBA_Q_BLOCK
    heads = lambda t: t.reshape(B, T, H, D)
    q = rms_norm(heads(q), q_gain)
    k = rms_norm(heads(k), k_gain)
    v = heads(v)
    Tp = -(-T // BLK) * BLK
    pad = ((0, 0), (0, Tp - T), (0, 0), (0, 0))
    q, k, v = [jnp.pad(t, pad).transpose(0, 2, 1, 3) for t in (q, k, v)]
    NB = Tp // BLK
    kb = k.reshape(B, H, NB, BLK, D)
    vb = v.reshape(B, H, NB, BLK, D)
    k_mean = jnp.mean(kb.astype(jnp.float32), axis=3)
    q_blk = jnp.arange(Tp) // BLK
    gate = jnp.einsum('bhtd,bhnd->bhtn', q.astype(jnp.float32), k_mean)
    past = jnp.arange(NB)[None, :] < q_blk[:, None]
    gate = jnp.where(past, gate, -jnp.inf)
    n_sel = min(MOBA_TOPK, NB)
    _, sel = lax.top_k(gate, n_sel)
    valid = sel < q_blk[:, None]
    NQ = Tp // QB
    q_s = q.reshape(B, H, NQ, QB, D).transpose(2, 0, 1, 3, 4)
    sel_s = sel.reshape(B, H, NQ, QB, n_sel).transpose(2, 0, 1, 3, 4)
    valid_s = valid.reshape(B, H, NQ, QB, n_sel).transpose(2, 0, 1, 3, 4)
    b_ix = jnp.arange(B)[:, None, None, None]
    h_ix = jnp.arange(H)[None, :, None, None]
    scale = D ** -0.5

    def query_block(args):
        qi, q_c, sel_c, valid_c = args
        q0 = qi * QB
        own = q0 // BLK
        k_own = lax.dynamic_index_in_dim(kb, own, axis=2, keepdims=False)
        v_own = lax.dynamic_index_in_dim(vb, own, axis=2, keepdims=False)
        k_sel = kb[b_ix, h_ix, sel_c]
        v_sel = vb[b_ix, h_ix, sel_c]
        s_sel = jnp.einsum('bhqd,bhqnkd->bhqnk', q_c, k_sel, preferred_element_type=jnp.float32) * scale
        s_sel = jnp.where(valid_c[..., None], s_sel, -jnp.inf).reshape(B, H, QB, n_sel * BLK)
        s_own = jnp.einsum('bhqd,bhkd->bhqk', q_c, k_own, preferred_element_type=jnp.float32) * scale
        causal = (own * BLK + jnp.arange(BLK))[None, :] <= (q0 + jnp.arange(QB))[:, None]
        s_own = jnp.where(causal, s_own, -jnp.inf)
        probs = jax.nn.softmax(jnp.concatenate([s_sel, s_own], axis=-1), axis=-1).astype(v.dtype)
        p_sel = probs[..., :n_sel * BLK].reshape(B, H, QB, n_sel, BLK)
        p_own = probs[..., n_sel * BLK:]
        return (jnp.einsum('bhqnk,bhqnkd->bhqd', p_sel, v_sel)
                + jnp.einsum('bhqk,bhkd->bhqd', p_own, v_own))

    o = lax.map(query_block, (jnp.arange(NQ), q_s, sel_s, valid_s))
    o = o.transpose(1, 0, 3, 2, 4).reshape(B, Tp, H * D)
    return o[:, :T]


def setup_inputs(seed: int = 0) -> dict:
    key = jax.random.key(seed)
    ks = jax.random.split(key, 20)
    f32 = jnp.float32
    nrm = lambda k, shape, s: jax.random.normal(k, shape, f32) * s
    gain = lambda k, shape: 1.0 + 0.02 * jax.random.normal(k, shape, f32)
    dt = jnp.exp(jax.random.uniform(ks[6], (DEPTH, GDN_HEADS), f32, np.log(1e-3), np.log(1e-1)))
    return {
        "x": jax.random.normal(ks[0], (BATCH, SEQ, D_MODEL), f32),
        "p": jax.random.normal(ks[1], (DEPTH, BATCH, SEQ, PLE_DIM), f32),
        "attn_norm": gain(ks[2], (DEPTH, D_MODEL)),
        "w_in": nrm(ks[3], (DEPTH, D_MODEL, IN_W), D_MODEL ** -0.5),
        "conv_w": nrm(ks[4], (DEPTH, CONV_W, GDN_CONV), GDN_CONV ** -0.5),
        "A_log": jnp.log(jax.random.uniform(ks[5], (DEPTH, GDN_HEADS), f32, 1.0, 16.0)),
        "dt_bias": dt + jnp.log(-jnp.expm1(-dt)),
        "gdn_norm": gain(ks[7], (DEPTH, GDN_DV)),
        "q_norm": gain(ks[8], (DEPTH, MOBA_DH)),
        "k_norm": gain(ks[9], (DEPTH, MOBA_DH)),
        "w_o": nrm(ks[10], (DEPTH, MIX_W, D_MODEL), MIX_W ** -0.5),
        "ffn_norm": gain(ks[11], (DEPTH, D_MODEL)),
        "w_gate": nrm(ks[12], (DEPTH, D_MODEL, D_FF), D_MODEL ** -0.5),
        "w_up": nrm(ks[13], (DEPTH, D_MODEL, D_FF), D_MODEL ** -0.5),
        "w_down": nrm(ks[14], (DEPTH, D_FF, D_MODEL), D_FF ** -0.5),
        "ple_norm": gain(ks[15], (DEPTH, D_MODEL)),
        "w_ple_gate": nrm(ks[16], (DEPTH, D_MODEL, D_MODEL), D_MODEL ** -0.5),
        "w_ple_proj": nrm(ks[17], (DEPTH, PLE_DIM, D_MODEL), PLE_DIM ** -0.5),
    }


def reference(x, p, attn_norm, w_in, conv_w, A_log, dt_bias, gdn_norm, q_norm, k_norm,
              w_o, ffn_norm, w_gate, w_up, w_down, ple_norm, w_ple_gate, w_ple_proj):
    h = x
    split_at = list(np.cumsum(IN_SPLITS)[:-1])
    for i in range(DEPTH):
        xn = rms_norm(h, attn_norm[i])
        proj = xn @ w_in[i]
        gq, gk, gv, gz, gb, ga, mq, mk, mv = jnp.split(proj, split_at, axis=-1)
        o_gdn = gated_deltanet(gq, gk, gv, gz, gb, ga, conv_w[i], A_log[i], dt_bias[i], gdn_norm[i])
        o_moba = moba_attention(mq, mk, mv, q_norm[i], k_norm[i])
        h = h + jnp.concatenate([o_gdn, o_moba], axis=-1) @ w_o[i]
        hn = rms_norm(h, ffn_norm[i])
        h = h + (jax.nn.silu(hn @ w_gate[i]) * (hn @ w_up[i])) @ w_down[i]
        gate = jax.nn.sigmoid(rms_norm(h, ple_norm[i]) @ w_ple_gate[i])
        h = h + gate * (p[i] @ w_ple_proj[i])
    return h
```

```cpp
#include <hip/hip_runtime.h>
#include <hip/hip_cooperative_groups.h>
#include <cstdio>
namespace cg = cooperative_groups;

#define LAS __attribute__((address_space(3)))
#define DI __device__ __forceinline__
typedef unsigned short bf16_t;
typedef short bf16x8 __attribute__((ext_vector_type(8)));
typedef float f32x4 __attribute__((ext_vector_type(4)));
typedef float f32x2 __attribute__((ext_vector_type(2)));
typedef unsigned u32x4 __attribute__((ext_vector_type(4)));
typedef unsigned u32x2 __attribute__((ext_vector_type(2)));
typedef __bf16 bfv2 __attribute__((ext_vector_type(2)));

constexpr int DM = 2048, TT = 16384, MT = 32768, NPJ = 7168, FF = 5632, INW = 7184;
constexpr int OFF_GQ = 0, OFF_GK = 1024, OFF_GV = 2048, OFF_GZ = 3072, OFF_MQ = 4096, OFF_MK = 5120, OFF_MV = 6144;
constexpr int LISTN = 516096;
constexpr int NTHREADS = 512;
constexpr int LDS_BYTES = 163840;

constexpr size_t WS_CTL   = 0;
constexpr size_t WS_CNT   = 4096;
constexpr size_t WS_SS1   = 8192;
constexpr size_t WS_SS2   = WS_SS1 + 131072;
constexpr size_t WS_GL    = WS_SS2 + 131072;
constexpr size_t WS_KMEAN = WS_GL + 16384;
constexpr size_t WS_WBA   = WS_KMEAN + 524288;
constexpr size_t WS_BA    = WS_WBA + 65536;
constexpr size_t WS_WIN   = WS_BA + 2097152;
constexpr size_t WS_WO    = WS_WIN + (size_t)7168 * 2048 * 2;
constexpr size_t WS_WGU   = WS_WO + (size_t)2048 * 2048 * 2;
constexpr size_t WS_WDN   = WS_WGU + (size_t)11264 * 2048 * 2;
constexpr size_t WS_WPG   = WS_WDN + (size_t)2048 * 5632 * 2;
constexpr size_t WS_WPP   = WS_WPG + (size_t)2048 * 2048 * 2;
constexpr size_t WS_PB    = WS_WPP + (size_t)2048 * 256 * 2;
constexpr size_t WS_R0    = WS_PB + (size_t)32768 * 256 * 2;
constexpr size_t WS_R1    = WS_R0 + (size_t)32768 * 2048 * 2;
constexpr size_t WS_R2    = WS_R1 + (size_t)32768 * 7168 * 2;
constexpr size_t WS_W2    = WS_R2 + (size_t)32768 * 2048 * 2;
constexpr size_t WS_QKB   = WS_W2 + (size_t)32768 * 1024 * 2;
constexpr size_t WS_HALO  = WS_QKB + (size_t)4096 * 4096 * 2;
constexpr size_t WS_LIST  = WS_HALO + (size_t)513 * 3 * 3072 * 2 + 256 - ((size_t)513 * 3 * 3072 * 2) % 256;
constexpr size_t WS_ML    = WS_LIST + (size_t)16 * LISTN * 4;
constexpr size_t WS_SSQ   = WS_ML + (size_t)4 * 262144 * 8;
constexpr size_t WS_END   = WS_SSQ + (size_t)32768 * 64 * 4;

struct Params {
    const float* x; const float* p; const float* attn_norm; const float* w_in; const float* conv_w; const float* A_log; const float* dt_bias;
    const float* gdn_norm; const float* q_norm; const float* k_norm; const float* w_o; const float* ffn_norm; const float* w_gate; const float* w_up;
    const float* w_down; const float* ple_norm; const float* w_pg; const float* w_pp;
    float* out; unsigned char* ws;
};

DI unsigned pk2(float a, float b) { f32x2 v = {a, b}; bfv2 r = __builtin_convertvector(v, bfv2); return __builtin_bit_cast(unsigned, r); }
DI bf16_t f2bf(float a) { return (bf16_t)(pk2(a, 0.f) & 0xffffu); }
DI float bflo(unsigned w) { return __uint_as_float(w << 16); }
DI float bfhi(unsigned w) { return __uint_as_float(w & 0xffff0000u); }
DI float bf2f(bf16_t v) { return __uint_as_float(((unsigned)v) << 16); }
DI bf16x8 pack8(const f32x4& a, const f32x4& b) { u32x4 w; w.x = pk2(a[0], a[1]); w.y = pk2(a[2], a[3]); w.z = pk2(b[0], b[1]); w.w = pk2(b[2], b[3]); return __builtin_bit_cast(bf16x8, w); }
DI bf16x8 cat8(u32x2 lo, u32x2 hi) { u32x4 w; w.x = lo.x; w.y = lo.y; w.z = hi.x; w.w = hi.y; return __builtin_bit_cast(bf16x8, w); }
DI f32x4 mfma16(bf16x8 a, bf16x8 b, f32x4 c) { return __builtin_amdgcn_mfma_f32_16x16x32_bf16(a, b, c, 0, 0, 0); }
DI int perm4(int d4) { return d4 < 16 ? 2 * d4 : 2 * (d4 - 16) + 4; }
DI float dpp_f(float v, int ctrl_sel) { int x = __float_as_int(v); int r;
    if (ctrl_sel == 0) r = __builtin_amdgcn_mov_dpp(x, 0xB1, 0xf, 0xf, true); else if (ctrl_sel == 1) r = __builtin_amdgcn_mov_dpp(x, 0x4E, 0xf, 0xf, true);
    else if (ctrl_sel == 2) r = __builtin_amdgcn_mov_dpp(x, 0x141, 0xf, 0xf, true); else r = __builtin_amdgcn_mov_dpp(x, 0x140, 0xf, 0xf, true);
    return __int_as_float(r); }
DI float row16_sum(float v) { v += dpp_f(v, 0); v += dpp_f(v, 1); v += dpp_f(v, 2); v += dpp_f(v, 3); return v; }
DI float silu_f(float v) { return v / (1.f + __expf(-v)); }
DI float sigm_f(float v) { return 1.f / (1.f + __expf(-v)); }

DI int opq_tid() { int t = threadIdx.x; asm volatile("" : "+v"(t)); return t; }

namespace pg8 {
constexpr int BM = 256, BK = 64, HALF = 128, HTB = HALF * BK * 2, STAGE_BYTES = 8 * HTB, NXCD = 8, WGM = 8;
DI int lds_byte(int r, int c) { const int st = (r >> 4) * 2 + (c >> 5), rr = r & 15, cc = c & 31, ob = rr * 64 + cc * 2; return st * 1024 + (ob ^ (((ob >> 9) & 1) << 5)); }
DI void stage_rc(int b, int& R, int& C) { const int st = b / 1024, sb = b % 1024, swz = sb ^ (((sb >> 9) & 1) << 5); R = (st >> 1) * 16 + swz / 64; C = (st & 1) * 32 + (swz % 64) / 2; }
DI int perm32(int rho) { const int n = rho >> 4, i = rho & 15; return 8 * (i >> 2) + 4 * n + (i & 3); }
struct Unit { int pm, pn; };
struct Gemm { const bf16_t* A; const bf16_t* Bt; int M, N, K; };
struct StaticOrder {
    int nM, nN, nwg, G, c;
    DI void init(int M, int N, int G_, int c_) { nM = M / BM; nN = N / BM; nwg = nM * nN; G = G_; c = c_; }
    DI bool next(int i, Unit& u) const {
        const long L = (long)i * G + c; if (L >= nwg) return false;
        int wgid = (int)L; { const int q = nwg / NXCD, r = nwg % NXCD, xcd = wgid % NXCD, off = wgid / NXCD; wgid = (xcd < r ? xcd * (q + 1) : r * (q + 1) + (xcd - r) * q) + off; }
        const int nig = WGM * nN, gid = wgid / nig, fm = gid * WGM, gsz = (nM - fm) < WGM ? (nM - fm) : WGM;
        u.pm = fm + ((wgid % nig) % gsz); u.pn = (wgid % nig) / gsz; return true;
    }
};

template <class Epi>
DI void gemm_phase(LAS unsigned char* lds, const Gemm g, const StaticOrder& S, const Epi& E) {
    const int tid = opq_tid(), wid = __builtin_amdgcn_readfirstlane(tid >> 6), lane = tid & 63, wr = wid >> 2, wc = wid & 3, fr = lane & 15, fq = lane >> 4;
    const int K = g.K, nt = K / BK;
    unsigned voffA[2], voffB[2];
#pragma unroll
    for (int i = 0; i < 2; ++i) { int R, C; stage_rc(tid * 16 + i * 8192, R, C); const int Rb = Epi::PERM ? ((R & ~31) + perm32(R & 31)) : R;
        voffA[i] = (unsigned)(R * K + C) * 2u; voffB[i] = (unsigned)(Rb * K + C) * 2u; }
    const size_t kstep = (size_t)(BK * 2);
    const size_t hstep = (size_t)HALF * K * 2;
    const size_t tstep = 2 * hstep;
    const unsigned ldsw = (unsigned)wid * 1024u;
    const int aoff = lds_byte(wr * 64 + fr, fq * 8), boff = lds_byte(wc * 32 + fr, fq * 8);
#define PG8_SA(b, h) (((b) * 2 + (h)) * HTB)
#define PG8_SB(b, h) ((4 + (b) * 2 + (h)) * HTB)
#define PG8_STAGE(bufoff, gbase, voff) do { _Pragma("unroll") for (int _i = 0; _i < 2; ++_i) \
        __builtin_amdgcn_global_load_lds((const unsigned*)((const char*)(gbase) + (voff)[_i]), (LAS unsigned*)(lds + (bufoff) + ldsw + _i * 8192), 16, 0, 0); } while (0)
#define PG8_LDA(dst, b, h) do { _Pragma("unroll") for (int m = 0; m < 4; ++m) _Pragma("unroll") for (int k = 0; k < 2; ++k) dst[m][k] = *(const LAS bf16x8*)(lds + PG8_SA(b, h) + aoff + m * 2048 + k * 1024); } while (0)
#define PG8_LDB(dst, b, h) do { _Pragma("unroll") for (int n = 0; n < 2; ++n) _Pragma("unroll") for (int k = 0; k < 2; ++k) dst[n][k] = *(const LAS bf16x8*)(lds + PG8_SB(b, h) + boff + n * 2048 + k * 1024); } while (0)
#define PG8_MMA(ai, bj, At, Bt) do { __builtin_amdgcn_s_setprio(1); _Pragma("unroll") for (int m = 0; m < 4; ++m) _Pragma("unroll") for (int n = 0; n < 2; ++n) _Pragma("unroll") for (int k = 0; k < 2; ++k) \
        acc[ai][bj][m][n] = __builtin_amdgcn_mfma_f32_16x16x32_bf16(Bt[n][k], At[m][k], acc[ai][bj][m][n], 0, 0, 0); __builtin_amdgcn_s_setprio(0); } while (0)
#define PG8_WAIT_V(n) asm volatile("s_waitcnt vmcnt(" #n ")" ::: "memory")
#define PG8_WAIT_L(n) asm volatile("s_waitcnt lgkmcnt(" #n ")" ::: "memory")
#define PG8_BAR __builtin_amdgcn_s_barrier()
#define PG8_SCHED __builtin_amdgcn_sched_barrier(0)
    Unit cur, nxt; int ui = 0;
    if (!S.next(0, cur)) return;
    f32x4 acc[2][2][4][2];
#pragma unroll
    for (int a = 0; a < 2; ++a)
#pragma unroll
        for (int b = 0; b < 2; ++b)
#pragma unroll
            for (int m = 0; m < 4; ++m)
#pragma unroll
                for (int n = 0; n < 2; ++n) acc[a][b][m][n] = (f32x4){0.f, 0.f, 0.f, 0.f};
    bf16x8 At[4][2], B0[2][2], B1[2][2];
    const char* cA = (const char*)g.A + (size_t)cur.pm * tstep; const char* cB = (const char*)g.Bt + (size_t)cur.pn * tstep;
    PG8_STAGE(PG8_SB(0, 0), cB, voffB); PG8_STAGE(PG8_SA(0, 0), cA, voffA); PG8_STAGE(PG8_SB(0, 1), cB + hstep, voffB); PG8_STAGE(PG8_SA(0, 1), cA + hstep, voffA);
    if (wr == 1) PG8_BAR;
    PG8_WAIT_V(4); PG8_BAR;
    PG8_STAGE(PG8_SB(1, 0), cB + kstep, voffB); PG8_STAGE(PG8_SA(1, 0), cA + kstep, voffA); PG8_STAGE(PG8_SB(1, 1), cB + hstep + kstep, voffB);
    PG8_WAIT_V(6); PG8_BAR;
    for (;;) {
        const bool has_next = S.next(ui + 1, nxt);
        const char* nA = has_next ? (const char*)g.A + (size_t)nxt.pm * tstep : cA; const char* nB = has_next ? (const char*)g.Bt + (size_t)nxt.pn * tstep : cB;
        for (int t = 0; t < nt; t += 2) {
            const bool last = (t == nt - 2);
            const char* a1 = cA + (size_t)(t + 1) * kstep;
            const char* a2 = last ? nA : cA + (size_t)(t + 2) * kstep; const char* b2 = last ? nB : cB + (size_t)(t + 2) * kstep;
            const char* a3 = a2 + kstep; const char* b3 = b2 + kstep;
            PG8_LDB(B0, 0, 0); PG8_SCHED; PG8_LDA(At, 0, 0); PG8_STAGE(PG8_SA(1, 1), a1 + hstep, voffA);
            PG8_WAIT_L(8); PG8_BAR; PG8_WAIT_L(0); PG8_MMA(0, 0, At, B0); PG8_BAR; PG8_SCHED;
            PG8_LDB(B1, 0, 1); PG8_STAGE(PG8_SB(0, 0), b2, voffB);
            PG8_BAR; PG8_WAIT_L(0); PG8_MMA(0, 1, At, B1); PG8_BAR;
            PG8_LDA(At, 0, 1); PG8_STAGE(PG8_SA(0, 0), a2, voffA);
            PG8_BAR; PG8_WAIT_L(0); PG8_MMA(1, 0, At, B0); PG8_BAR; PG8_SCHED;
            PG8_STAGE(PG8_SB(0, 1), b2 + hstep, voffB);
            PG8_WAIT_V(6); PG8_BAR; PG8_MMA(1, 1, At, B1); PG8_BAR;
            PG8_LDB(B0, 1, 0); PG8_SCHED; PG8_LDA(At, 1, 0); PG8_STAGE(PG8_SA(0, 1), a2 + hstep, voffA);
            PG8_WAIT_L(8); PG8_BAR; PG8_WAIT_L(0); PG8_MMA(0, 0, At, B0); PG8_BAR; PG8_SCHED;
            PG8_LDB(B1, 1, 1); PG8_STAGE(PG8_SB(1, 0), b3, voffB);
            PG8_BAR; PG8_WAIT_L(0); PG8_MMA(0, 1, At, B1); PG8_BAR;
            PG8_LDA(At, 1, 1); PG8_STAGE(PG8_SA(1, 0), a3, voffA);
            PG8_BAR; PG8_WAIT_L(0); PG8_MMA(1, 0, At, B0); PG8_BAR; PG8_SCHED;
            PG8_STAGE(PG8_SB(1, 1), b3 + hstep, voffB);
            PG8_WAIT_V(6); PG8_BAR; PG8_MMA(1, 1, At, B1); PG8_BAR;
        }
        E(acc, cur, wr, wc, fr, fq);
        if (!has_next) break;
#pragma unroll
        for (int a = 0; a < 2; ++a)
#pragma unroll
            for (int b = 0; b < 2; ++b)
#pragma unroll
                for (int m = 0; m < 4; ++m)
#pragma unroll
                    for (int n = 0; n < 2; ++n) acc[a][b][m][n] = (f32x4){0.f, 0.f, 0.f, 0.f};
        cur = nxt; cA = nA; cB = nB; ++ui;
    }
    PG8_WAIT_V(0);
    if (wr == 0) PG8_BAR;
    PG8_BAR;
#undef PG8_SA
#undef PG8_SB
#undef PG8_STAGE
#undef PG8_LDA
#undef PG8_LDB
#undef PG8_MMA
#undef PG8_WAIT_V
#undef PG8_WAIT_L
#undef PG8_BAR
#undef PG8_SCHED
}
}
using pg8::Unit;

struct EpiProj {
    static constexpr bool PERM = true;
    bf16_t* O; bf16_t* halo;
    DI void operator()(const f32x4 (&acc)[2][2][4][2], const Unit& u, int wr, int wc, int fr, int fq) const {
        const int row0 = u.pm * 256 + wr * 64 + fr, col0 = u.pn * 256 + wc * 32 + 8 * fq;
#pragma unroll
        for (int ai = 0; ai < 2; ++ai)
#pragma unroll
            for (int m = 0; m < 4; ++m) { const int row = row0 + ai * 128 + m * 16; bf16_t* rowp = O + (size_t)row * NPJ + col0;
#pragma unroll
                for (int bj = 0; bj < 2; ++bj) { const f32x4 v0 = acc[ai][bj][m][0], v1 = acc[ai][bj][m][1];
                    u32x4 w; w.x = pk2(v0[0], v0[1]); w.y = pk2(v0[2], v0[3]); w.z = pk2(v1[0], v1[1]); w.w = pk2(v1[2], v1[3]);
                    *(u32x4*)(rowp + bj * 128) = w;
                    if (m == 3 && fr >= 13 && u.pn < 12) *(u32x4*)(halo + ((size_t)((row >> 6) + 1) * 3 + (fr - 13)) * 3072 + col0 + bj * 128) = w; } }
    }
};
struct EpiPlainBf16 {
    static constexpr bool PERM = true;
    bf16_t* O; int ldc;
    DI void operator()(const f32x4 (&acc)[2][2][4][2], const Unit& u, int wr, int wc, int fr, int fq) const {
        const int row0 = u.pm * 256 + wr * 64 + fr, col0 = u.pn * 256 + wc * 32 + 8 * fq;
#pragma unroll
        for (int ai = 0; ai < 2; ++ai)
#pragma unroll
            for (int m = 0; m < 4; ++m) { bf16_t* rowp = O + (size_t)(row0 + ai * 128 + m * 16) * ldc + col0;
#pragma unroll
                for (int bj = 0; bj < 2; ++bj) { const f32x4 v0 = acc[ai][bj][m][0], v1 = acc[ai][bj][m][1];
                    u32x4 w; w.x = pk2(v0[0], v0[1]); w.y = pk2(v0[2], v0[3]); w.z = pk2(v1[0], v1[1]); w.w = pk2(v1[2], v1[3]);
                    *(u32x4*)(rowp + bj * 128) = w; } }
    }
};
struct EpiResid {
    static constexpr bool PERM = false;
    const float* base; float* out; bf16_t* hb; float* ss;
    DI void operator()(const f32x4 (&acc)[2][2][4][2], const Unit& u, int wr, int wc, int fr, int fq) const {
        const int row0 = u.pm * 256 + wr * 64 + fr, col0 = u.pn * 256 + wc * 32 + 4 * fq;
#pragma unroll
        for (int ai = 0; ai < 2; ++ai) { f32x4 bs[4][4];
#pragma unroll
            for (int m = 0; m < 4; ++m)
#pragma unroll
                for (int q = 0; q < 4; ++q) bs[m][q] = *(const f32x4*)(base + (size_t)(row0 + ai * 128 + m * 16) * DM + col0 + (q >> 1) * 128 + (q & 1) * 16);
#pragma unroll
            for (int m = 0; m < 4; ++m) { const int row = row0 + ai * 128 + m * 16; const size_t off = (size_t)row * DM + col0; float s = 0.f;
#pragma unroll
                for (int q = 0; q < 4; ++q) { const f32x4 hv = bs[m][q] + acc[ai][q >> 1][m][q & 1];
                        *(f32x4*)(out + off + (q >> 1) * 128 + (q & 1) * 16) = hv; u32x2 w; w.x = pk2(hv[0], hv[1]); w.y = pk2(hv[2], hv[3]);
                        *(u32x2*)(hb + off + (q >> 1) * 128 + (q & 1) * 16) = w; s += (hv[0] * hv[0] + hv[1] * hv[1]) + (hv[2] * hv[2] + hv[3] * hv[3]); }
                s += __shfl_xor(s, 16); s += __shfl_xor(s, 32);
                if (fq == 0) atomicAdd(ss + row, s); }
            asm volatile("" ::: "memory"); }
    }
};
struct EpiAct {
    static constexpr bool PERM = true;
    bf16_t* O; const float* ss;
    DI void operator()(const f32x4 (&acc)[2][2][4][2], const Unit& u, int wr, int wc, int fr, int fq) const {
        const int row0 = u.pm * 256 + wr * 64 + fr, col0 = u.pn * 128 + wc * 32 + 8 * fq;
        float rs[8];
#pragma unroll
        for (int g = 0; g < 8; ++g) rs[g] = ss[row0 + (g >> 2) * 128 + (g & 3) * 16];
#pragma unroll
        for (int ai = 0; ai < 2; ++ai)
#pragma unroll
            for (int m = 0; m < 4; ++m) { const int row = row0 + ai * 128 + m * 16; const float r = rsqrtf(rs[ai * 4 + m] * (1.f / 2048.f) + 1e-6f);
                float a[8];
#pragma unroll
                for (int n = 0; n < 2; ++n)
#pragma unroll
                    for (int j = 0; j < 4; ++j) { const float gv = r * acc[ai][0][m][n][j], uv = r * acc[ai][1][m][n][j]; a[n * 4 + j] = silu_f(gv) * uv; }
                u32x4 w; w.x = pk2(a[0], a[1]); w.y = pk2(a[2], a[3]); w.z = pk2(a[4], a[5]); w.w = pk2(a[6], a[7]);
                *(u32x4*)(O + (size_t)row * FF + col0) = w; }
    }
};
struct EpiOut {
    static constexpr bool PERM = false;
    float* out; const bf16_t* pp; const float* ss;
    DI void operator()(const f32x4 (&acc)[2][2][4][2], const Unit& u, int wr, int wc, int fr, int fq) const {
        const int row0 = u.pm * 256 + wr * 64 + fr, col0 = u.pn * 256 + wc * 32 + 4 * fq;
        float rs[8];
#pragma unroll
        for (int g = 0; g < 8; ++g) rs[g] = ss[row0 + (g >> 2) * 128 + (g & 3) * 16];
#pragma unroll
        for (int ai = 0; ai < 2; ++ai) { f32x4 hv[4][4]; u32x2 pw[4][4];
#pragma unroll
            for (int m = 0; m < 4; ++m)
#pragma unroll
                for (int q = 0; q < 4; ++q) { const size_t o2 = (size_t)(row0 + ai * 128 + m * 16) * DM + col0 + (q >> 1) * 128 + (q & 1) * 16; hv[m][q] = *(const f32x4*)(out + o2); pw[m][q] = *(const u32x2*)(pp + o2); }
#pragma unroll
            for (int m = 0; m < 4; ++m) { const int row = row0 + ai * 128 + m * 16; const size_t off = (size_t)row * DM + col0; const float r = rsqrtf(rs[ai * 4 + m] * (1.f / 2048.f) + 1e-6f);
#pragma unroll
                for (int q = 0; q < 4; ++q) { const f32x4 a = acc[ai][q >> 1][m][q & 1]; f32x4 o;
                        o[0] = hv[m][q][0] + sigm_f(r * a[0]) * bflo(pw[m][q].x); o[1] = hv[m][q][1] + sigm_f(r * a[1]) * bfhi(pw[m][q].x);
                        o[2] = hv[m][q][2] + sigm_f(r * a[2]) * bflo(pw[m][q].y); o[3] = hv[m][q][3] + sigm_f(r * a[3]) * bfhi(pw[m][q].y);
                        *(f32x4*)(out + off + (q >> 1) * 128 + (q & 1) * 16) = o; } }
            asm volatile("" ::: "memory"); }
    }
};

DI void tconv_tile(const float* __restrict__ src, int ld, int c0, int k0, bf16_t* __restrict__ dst, int dK, int n0, const float* __restrict__ nw, LAS float* tl) {
    const int tid = opq_tid();
    f32x4 v[8];
#pragma unroll
    for (int i = 0; i < 8; ++i) v[i] = *(const f32x4*)(src + (size_t)(k0 + (tid >> 4) + 32 * i) * ld + c0 + (tid & 15) * 4);
#pragma unroll
    for (int i = 0; i < 8; ++i) { const int k = (tid >> 4) + 32 * i; const float sc = nw ? nw[k0 + k] : 1.f;
        LAS float* q = tl + k * 65 + (tid & 15) * 4; q[0] = v[i][0] * sc; q[1] = v[i][1] * sc; q[2] = v[i][2] * sc; q[3] = v[i][3] * sc; }
    __syncthreads();
    { const int n = tid >> 3, kq = (tid & 7) * 8;
#pragma unroll
      for (int j = 0; j < 4; ++j) { const int ks = kq + 64 * j; float f[8];
#pragma unroll
          for (int i = 0; i < 8; ++i) f[i] = tl[(ks + i) * 65 + n];
          u32x4 w; w.x = pk2(f[0], f[1]); w.y = pk2(f[2], f[3]); w.z = pk2(f[4], f[5]); w.w = pk2(f[6], f[7]);
          *(u32x4*)(dst + (size_t)(n0 + n) * dK + k0 + ks) = w; } }
    __syncthreads();
}

DI void phase_prep(const Params& P, LAS unsigned char* lds) {
    unsigned char* ws = P.ws; const int tid = opq_tid(), G = gridDim.x, bx = blockIdx.x;
    const int gtid = bx * NTHREADS + tid, gsz = G * NTHREADS;
    for (int i = gtid; i < (int)((WS_GL - WS_CTL) / 4); i += gsz) ((unsigned*)(ws + WS_CTL))[i] = 0u;
    { bf16_t* wba = (bf16_t*)(ws + WS_WBA); for (int i = gtid; i < 16 * 2048; i += gsz) { const int n = i >> 11, k = i & 2047; wba[i] = f2bf(P.w_in[(size_t)k * INW + 4096 + n]); } }
    { bf16_t* pb = (bf16_t*)(ws + WS_PB); for (int i = gtid; i < MT * 256 / 8; i += gsz) { const f32x4 a = *(const f32x4*)(P.p + (size_t)i * 8), b = *(const f32x4*)(P.p + (size_t)i * 8 + 4);
        u32x4 w; w.x = pk2(a[0], a[1]); w.y = pk2(a[2], a[3]); w.z = pk2(b[0], b[1]); w.w = pk2(b[2], b[3]); *(u32x4*)(pb + (size_t)i * 8) = w; } }
    { bf16_t* xn = (bf16_t*)(ws + WS_R0); const int lane = tid & 63, gw = bx * 8 + (tid >> 6);
      f32x4 wv[8];
#pragma unroll
      for (int i = 0; i < 8; ++i) wv[i] = *(const f32x4*)(P.attn_norm + lane * 4 + i * 256);
      for (int row = gw * 2; row < MT; row += G * 16) { const float* xr = P.x + (size_t)row * DM; f32x4 v[2][8]; float s0 = 0.f, s1 = 0.f;
#pragma unroll
          for (int r = 0; r < 2; ++r)
#pragma unroll
              for (int i = 0; i < 8; ++i) v[r][i] = *(const f32x4*)(xr + (size_t)r * DM + lane * 4 + i * 256);
#pragma unroll
          for (int i = 0; i < 8; ++i) { s0 += (v[0][i][0] * v[0][i][0] + v[0][i][1] * v[0][i][1]) + (v[0][i][2] * v[0][i][2] + v[0][i][3] * v[0][i][3]);
              s1 += (v[1][i][0] * v[1][i][0] + v[1][i][1] * v[1][i][1]) + (v[1][i][2] * v[1][i][2] + v[1][i][3] * v[1][i][3]); }
#pragma unroll
          for (int o = 1; o < 64; o <<= 1) { s0 += __shfl_xor(s0, o); s1 += __shfl_xor(s1, o); }
          const float r0 = rsqrtf(s0 * (1.f / 2048.f) + 1e-6f), r1 = rsqrtf(s1 * (1.f / 2048.f) + 1e-6f);
#pragma unroll
          for (int r = 0; r < 2; ++r)
#pragma unroll
              for (int i = 0; i < 8; ++i) { const float rr = r ? r1 : r0; u32x2 w; w.x = pk2(v[r][i][0] * rr * wv[i][0], v[r][i][1] * rr * wv[i][1]); w.y = pk2(v[r][i][2] * rr * wv[i][2], v[r][i][3] * rr * wv[i][3]);
                  *(u32x2*)(xn + (size_t)(row + r) * DM + lane * 4 + i * 256) = w; } } }
    LAS float* tl = (LAS float*)lds;
    for (int gi = bx; gi < 896; gi += G) { const int nt = gi >> 3, kg = gi & 7, n0 = nt * 64; tconv_tile(P.w_in, INW, n0 < 4096 ? n0 : n0 + 16, kg * 256, (bf16_t*)(ws + WS_WIN), 2048, n0, nullptr, tl); }
}
DI void phase_wconv_late(const Params& P, LAS unsigned char* lds, int wg0, int nwg) {
    unsigned char* ws = P.ws; LAS float* tl = (LAS float*)lds;
    for (int gi = 896 + wg0; gi < 3552; gi += nwg) {
        if (gi < 1152) { const int t2 = gi - 896, nt = t2 >> 3, kg = t2 & 7; tconv_tile(P.w_o, 2048, nt * 64, kg * 256, (bf16_t*)(ws + WS_WO), 2048, nt * 64, nullptr, tl); }
        else if (gi < 2560) { const int t2 = gi - 1152, nt = t2 >> 3, kg = t2 & 7, n0 = nt * 64, pn = n0 >> 8, r = n0 & 255;
            tconv_tile(r < 128 ? P.w_gate : P.w_up, FF, pn * 128 + (r & 127), kg * 256, (bf16_t*)(ws + WS_WGU), 2048, n0, P.ffn_norm, tl); }
        else if (gi < 3264) { const int t2 = gi - 2560, nt = t2 / 22, kg = t2 % 22; tconv_tile(P.w_down, 2048, nt * 64, kg * 256, (bf16_t*)(ws + WS_WDN), FF, nt * 64, nullptr, tl); }
        else if (gi < 3520) { const int t2 = gi - 3264, nt = t2 >> 3, kg = t2 & 7; tconv_tile(P.w_pg, 2048, nt * 64, kg * 256, (bf16_t*)(ws + WS_WPG), 2048, nt * 64, P.ple_norm, tl); }
        else { const int nt = gi - 3520; tconv_tile(P.w_pp, 2048, nt * 64, 0, (bf16_t*)(ws + WS_WPP), 256, nt * 64, nullptr, tl); }
    }
}

DI void phase_ba(const Params& P) {
    const int tid = opq_tid(), lane = tid & 63, fr = lane & 15, fq = lane >> 4, gw = blockIdx.x * 8 + (tid >> 6);
    const bf16_t* xn = (const bf16_t*)(P.ws + WS_R0); const bf16_t* wba = (const bf16_t*)(P.ws + WS_WBA); float* BA = (float*)(P.ws + WS_BA);
    for (int rt = gw; rt < MT / 16; rt += gridDim.x * 8) {
        f32x4 acc = {0.f, 0.f, 0.f, 0.f}; const bf16_t* ap = xn + (size_t)(rt * 16 + fr) * DM + 8 * fq; const bf16_t* bp = wba + fr * 2048 + 8 * fq;
#pragma unroll 8
        for (int ks = 0; ks < 64; ++ks) acc = mfma16(*(const bf16x8*)(ap + 32 * ks), *(const bf16x8*)(bp + 32 * ks), acc);
#pragma unroll
        for (int j = 0; j < 4; ++j) BA[(size_t)(rt * 16 + 4 * fq + j) * 16 + fr] = acc[j];
    }
}

constexpr int G1_QS = 0, G1_KS = 18432, G1_VT = 36864, G1_KT = 57344, G1_SM = 77824, G1_TEAM = 78848;
DI void phase_gdn_prep(const Params& P, LAS unsigned char* lds) {
    const int tid0 = opq_tid(), team = tid0 >> 8;
    LAS unsigned char* L = lds + team * G1_TEAM;
    LAS bf16_t* QS = (LAS bf16_t*)(L + G1_QS); LAS bf16_t* KS = (LAS bf16_t*)(L + G1_KS); LAS bf16_t* VT = (LAS bf16_t*)(L + G1_VT); LAS bf16_t* KT = (LAS bf16_t*)(L + G1_KT);
    LAS float* AF = (LAS float*)(L + G1_QS); LAS bf16_t* TB = (LAS bf16_t*)(L + G1_KS); LAS float* SM = (LAS float*)(L + G1_SM);
    bf16_t* proj = (bf16_t*)(P.ws + WS_R1); const bf16_t* halo = (const bf16_t*)(P.ws + WS_HALO); const float* BA = (const float*)(P.ws + WS_BA);
    bf16_t* W2 = (bf16_t*)(P.ws + WS_W2); bf16_t* QKB = (bf16_t*)(P.ws + WS_QKB); float* GL = (float*)(P.ws + WS_GL);
    for (int pi = blockIdx.x; pi < 2048; pi += gridDim.x) {
        int tid = tid0; asm volatile("" : "+v"(tid));
        const int tt = tid & 255, tw = __builtin_amdgcn_readfirstlane((tid >> 6) & 3), lane = tid & 63, fr = lane & 15, fq = lane >> 4;
        const int ci = pi * 2 + team, h = ci & 7, n = (ci >> 3) & 255, b = ci >> 11, t0 = b * TT + n * 64;
        if (tw == 0) {
            const float bv = BA[(size_t)(t0 + lane) * 16 + h], av = BA[(size_t)(t0 + lane) * 16 + 8 + h];
            const float beta = sigm_f(bv); const float xx = av + P.dt_bias[h]; const float sp = xx > 20.f ? xx : log1pf(__expf(xx));
            const float gg = -__expf(P.A_log[h]) * sp; float gc = gg;
#pragma unroll
            for (int o = 1; o < 64; o <<= 1) { const float v = __shfl_up(gc, o); if (lane >= o) gc += v; }
            const float glast = __shfl(gc, 63);
            SM[lane] = gc; SM[64 + lane] = beta; SM[128 + lane] = __expf(gc); SM[192 + lane] = __expf(glast - gc);
            if (lane == 63) GL[(b * 8 + h) * 256 + n] = __expf(gc);
        }
        __syncthreads();
        { const int r = tt >> 2, cg0 = (tt & 3) * 32; const float beta_r = SM[64 + r], egc_r = SM[128 + r];
#pragma unroll 1
          for (int x = 0; x < 3; ++x) {
              float val[32]; const int colbase = x * 1024 + h * 128 + cg0;
#pragma unroll
              for (int sg = 0; sg < 4; ++sg) { const int col = colbase + sg * 8; u32x4 raw[4];
#pragma unroll
                  for (int j = 0; j < 4; ++j) { const int rr = r - 3 + j; raw[j] = (u32x4){0u, 0u, 0u, 0u};
                      if (rr >= 0) raw[j] = *(const u32x4*)(proj + (size_t)(t0 + rr) * NPJ + col);
                      else if (n > 0) raw[j] = *(const u32x4*)(halo + ((size_t)(t0 >> 6) * 3 + (rr + 3)) * 3072 + col); }
#pragma unroll
                  for (int i = 0; i < 8; ++i) { const f32x4 w4 = *(const f32x4*)(P.conv_w + (size_t)(col + i) * 4); float a = 0.f;
#pragma unroll
                      for (int j = 0; j < 4; ++j) { const unsigned wd = raw[j][i >> 1]; const float xv = (i & 1) ? bfhi(wd) : bflo(wd); a += w4[j] * xv; }
                      val[sg * 8 + i] = silu_f(a); } }
              if (x < 2) { float ss = 0.f;
#pragma unroll
                  for (int i = 0; i < 32; ++i) ss += val[i] * val[i];
                  ss += __shfl_xor(ss, 1); ss += __shfl_xor(ss, 2);
                  const float sc = rsqrtf(ss + 1e-6f) * (x == 0 ? 0.08838834764831845f : 1.f);
#pragma unroll
                  for (int i = 0; i < 32; ++i) val[i] *= sc; }
              if (x < 2) { LAS bf16_t* dst = (x == 0 ? QS : KS) + r * 144 + cg0;
#pragma unroll
                  for (int i = 0; i < 4; ++i) { u32x4 w; w.x = pk2(val[8 * i], val[8 * i + 1]); w.y = pk2(val[8 * i + 2], val[8 * i + 3]); w.z = pk2(val[8 * i + 4], val[8 * i + 5]); w.w = pk2(val[8 * i + 6], val[8 * i + 7]);
                      *(LAS u32x4*)(dst + 8 * i) = w; } }
              if (x == 1) { const float f = beta_r * egc_r;
#pragma unroll
                  for (int i = 0; i < 32; ++i) KT[(cg0 + i) * 80 + r] = f2bf(val[i] * f); }
              if (x == 2) {
#pragma unroll
                  for (int i = 0; i < 32; ++i) VT[(cg0 + i) * 80 + r] = f2bf(val[i] * beta_r); }
          } }
        __syncthreads();
        f32x4 kk[4], qk[4];
#pragma unroll
        for (int nt = 0; nt < 4; ++nt) { kk[nt] = (f32x4){0.f, 0.f, 0.f, 0.f}; qk[nt] = (f32x4){0.f, 0.f, 0.f, 0.f}; }
#pragma unroll
        for (int ks = 0; ks < 4; ++ks) { const bf16x8 ak = *(const LAS bf16x8*)(KS + (16 * tw + fr) * 144 + 32 * ks + 8 * fq), aq = *(const LAS bf16x8*)(QS + (16 * tw + fr) * 144 + 32 * ks + 8 * fq);
#pragma unroll
            for (int nt = 0; nt < 4; ++nt) { const bf16x8 bk = *(const LAS bf16x8*)(KS + (16 * nt + fr) * 144 + 32 * ks + 8 * fq); kk[nt] = mfma16(ak, bk, kk[nt]); qk[nt] = mfma16(aq, bk, qk[nt]); } }
        { const int r = tt >> 2, cg0 = (tt & 3) * 32; const float e = SM[128 + r];
#pragma unroll
          for (int i = 0; i < 4; ++i) { const u32x4 s = *(const LAS u32x4*)(QS + r * 144 + cg0 + 8 * i); u32x4 w;
              w.x = pk2(bflo(s.x) * e, bfhi(s.x) * e); w.y = pk2(bflo(s.y) * e, bfhi(s.y) * e); w.z = pk2(bflo(s.z) * e, bfhi(s.z) * e); w.w = pk2(bflo(s.w) * e, bfhi(s.w) * e);
              *(u32x4*)(proj + (size_t)(t0 + r) * NPJ + OFF_GQ + h * 128 + cg0 + 8 * i) = w; } }
        { const int d = tt >> 1, cb = (tt & 1) * 32;
#pragma unroll
          for (int i4 = 0; i4 < 4; ++i4) { const int c0 = cb + 8 * i4; float f[8];
#pragma unroll
              for (int i = 0; i < 8; ++i) f[i] = bf2f(KS[(c0 + i) * 144 + d]) * SM[192 + c0 + i];
              u32x4 w; w.x = pk2(f[0], f[1]); w.y = pk2(f[2], f[3]); w.z = pk2(f[4], f[5]); w.w = pk2(f[6], f[7]);
              *(u32x4*)(proj + (size_t)(t0 + (d >> 1)) * NPJ + OFF_GK + h * 128 + (d & 1) * 64 + c0) = w; } }
        __syncthreads();
#pragma unroll
        for (int nt = 0; nt < 4; ++nt)
#pragma unroll
            for (int j = 0; j < 4; ++j) { const int c = 16 * tw + 4 * fq + j, s = 16 * nt + fr; const float dec = (s <= c) ? __expf(SM[c] - SM[s]) : 0.f;
                AF[c * 65 + s] = (s < c) ? SM[64 + c] * kk[nt][j] * dec : (s == c ? 1.f : 0.f);
                QKB[(size_t)ci * 4096 + c * 64 + s] = f2bf(qk[nt][j] * dec); }
        __syncthreads();
        { const int bb = tw * 16;
          if (lane < 16) {
              for (int i = 1; i < 16; ++i) { float a0 = 0.f, a1 = 0.f; int j = 0;
                  for (; j + 2 <= i; j += 2) { a0 += AF[(bb + i) * 65 + bb + j] * AF[(bb + j) * 65 + bb + lane]; a1 += AF[(bb + i) * 65 + bb + j + 1] * AF[(bb + j + 1) * 65 + bb + lane]; }
                  if (j < i) a0 += AF[(bb + i) * 65 + bb + j] * AF[(bb + j) * 65 + bb + lane];
                  AF[(bb + i) * 65 + bb + lane] = lane < i ? -(a0 + a1) : (lane == i ? 1.f : 0.f); } }
#pragma unroll
          for (int k = 0; k < 4; ++k) { const int row = bb + fq + 4 * k; TB[row * 80 + bb + fr] = f2bf(AF[row * 65 + bb + fr]);
              for (int jb = tw + 1; jb < 4; ++jb) TB[row * 80 + 16 * jb + fr] = (bf16_t)0; }
          __syncthreads();
          for (int i = 1; i < 4; ++i) {
              if (tw < i) { const int j = tw; f32x4 X = {0.f, 0.f, 0.f, 0.f};
                  for (int k = j; k < i; ++k) {
#pragma unroll
                      for (int kk = 0; kk < 4; ++kk) { const float av = AF[(16 * i + fr) * 65 + 16 * k + 4 * kk + fq];
                          const float bv = (k == j) ? AF[(16 * k + 4 * kk + fq) * 65 + 16 * j + fr] : bf2f(TB[(16 * k + 4 * kk + fq) * 80 + 16 * j + fr]);
                          X = __builtin_amdgcn_mfma_f32_16x16x4f32(av, bv, X, 0, 0, 0); } }
                  f32x4 O = {0.f, 0.f, 0.f, 0.f};
#pragma unroll
                  for (int kk = 0; kk < 4; ++kk) O = __builtin_amdgcn_mfma_f32_16x16x4f32(AF[(16 * i + fr) * 65 + 16 * i + 4 * fq + kk], X[kk], O, 0, 0, 0);
#pragma unroll
                  for (int jj = 0; jj < 4; ++jj) TB[(16 * i + 4 * fq + jj) * 80 + 16 * j + fr] = f2bf(-O[jj]); }
              __syncthreads(); }
        }
        { bf16x8 at[2];
#pragma unroll
          for (int ks = 0; ks < 2; ++ks) at[ks] = *(const LAS bf16x8*)(TB + (16 * tw + fr) * 80 + 32 * ks + 8 * fq);
#pragma unroll
          for (int nt = 0; nt < 8; ++nt) { f32x4 a = {0.f, 0.f, 0.f, 0.f};
#pragma unroll
              for (int ks = 0; ks < 2; ++ks) a = mfma16(at[ks], *(const LAS bf16x8*)(VT + (16 * nt + fr) * 80 + 32 * ks + 8 * fq), a);
              const int e = 16 * nt + fr; u32x2 w; w.x = pk2(a[0], a[1]); w.y = pk2(a[2], a[3]);
              *(u32x2*)(proj + (size_t)(t0 + (e >> 1)) * NPJ + OFF_GV + h * 128 + (e & 1) * 64 + 16 * tw + 4 * fq) = w; }
#pragma unroll
          for (int mt = 0; mt < 8; ++mt) { f32x4 a = {0.f, 0.f, 0.f, 0.f};
#pragma unroll
              for (int ks = 0; ks < 2; ++ks) a = mfma16(*(const LAS bf16x8*)(KT + (16 * mt + fr) * 80 + 32 * ks + 8 * fq), at[ks], a);
              u32x2 w; w.x = pk2(a[0], a[1]); w.y = pk2(a[2], a[3]);
              *(u32x2*)(W2 + (size_t)(t0 + 16 * tw + fr) * 1024 + h * 128 + 16 * mt + 4 * fq) = w; } }
        __syncthreads();
    }
}

DI void phase_moba_prep(const Params& P, LAS unsigned char* lds) {
    const int tid = opq_tid(), lane = tid & 63, wave = tid >> 6, l16 = lane & 15;
    bf16_t* proj = (bf16_t*)(P.ws + WS_R1); float* kmean = (float*)(P.ws + WS_KMEAN);
    LAS bf16_t* VS = (LAS bf16_t*)lds; LAS float* CS = (LAS float*)(lds + 69632);
    for (int task = blockIdx.x; task < 1024; task += gridDim.x) {
        const int h = task & 7, blk = (task >> 3) & 63, b = task >> 9; const size_t rbase = (size_t)(b * TT + blk * 256);
        f32x4 qg0 = *(const f32x4*)(P.q_norm + l16 * 8), qg1 = *(const f32x4*)(P.q_norm + l16 * 8 + 4), kg0 = *(const f32x4*)(P.k_norm + l16 * 8), kg1 = *(const f32x4*)(P.k_norm + l16 * 8 + 4);
        float cs[8];
#pragma unroll
        for (int i = 0; i < 8; ++i) cs[i] = 0.f;
        u32x4 rq[8], rk[8], rv[8];
#pragma unroll
        for (int ps = 0; ps < 8; ++ps) { const int r = ps * 32 + wave * 4 + (lane >> 4); const bf16_t* rp = proj + (rbase + r) * NPJ + h * 128 + l16 * 8;
            rq[ps] = *(const u32x4*)(rp + OFF_MQ); rk[ps] = *(const u32x4*)(rp + OFF_MK); rv[ps] = *(const u32x4*)(rp + OFF_MV); }
#pragma unroll
        for (int ps = 0; ps < 8; ++ps) { const int r = ps * 32 + wave * 4 + (lane >> 4); bf16_t* rp = proj + (rbase + r) * NPJ + h * 128 + l16 * 8;
#pragma unroll
            for (int x = 0; x < 2; ++x) { bf16_t* ptr = rp + (x == 0 ? OFF_MQ : OFF_MK); const u32x4 raw = x == 0 ? rq[ps] : rk[ps]; float v[8];
                v[0] = bflo(raw.x); v[1] = bfhi(raw.x); v[2] = bflo(raw.y); v[3] = bfhi(raw.y); v[4] = bflo(raw.z); v[5] = bfhi(raw.z); v[6] = bflo(raw.w); v[7] = bfhi(raw.w);
                float ss = 0.f;
#pragma unroll
                for (int i = 0; i < 8; ++i) ss += v[i] * v[i];
                ss = row16_sum(ss);
                const float rs = rsqrtf(ss * (1.f / 128.f) + 1e-6f); const f32x4 g0 = x == 0 ? qg0 : kg0, g1 = x == 0 ? qg1 : kg1;
#pragma unroll
                for (int i = 0; i < 4; ++i) { v[i] *= rs * g0[i]; v[4 + i] *= rs * g1[i]; }
                if (x == 1) {
#pragma unroll
                    for (int i = 0; i < 8; ++i) cs[i] += v[i]; }
                u32x4 w; w.x = pk2(v[0], v[1]); w.y = pk2(v[2], v[3]); w.z = pk2(v[4], v[5]); w.w = pk2(v[6], v[7]); *(u32x4*)ptr = w; }
            *(LAS u32x4*)(VS + r * 136 + l16 * 8) = rv[ps]; }
#pragma unroll
        for (int i = 0; i < 8; ++i) { cs[i] += __shfl_xor(cs[i], 16); cs[i] += __shfl_xor(cs[i], 32); }
        if (lane < 16) {
#pragma unroll
            for (int i = 0; i < 8; ++i) CS[wave * 128 + lane * 8 + i] = cs[i]; }
        __syncthreads();
        if (tid < 128) { float s = 0.f;
#pragma unroll
            for (int w = 0; w < 8; ++w) s += CS[w * 128 + tid];
            kmean[((size_t)(b * 8 + h) * 64 + blk) * 128 + tid] = s * (1.f / 256.f); }
#pragma unroll 2
        for (int i8 = 0; i8 < 8; ++i8) { const int pid = tid + i8 * 512, e = pid >> 5, ks = pid & 31; unsigned short f[8];
#pragma unroll
            for (int i = 0; i < 8; ++i) f[i] = VS[(ks * 8 + i) * 136 + e];
            u32x4 w; w.x = f[0] | ((unsigned)f[1] << 16); w.y = f[2] | ((unsigned)f[3] << 16); w.z = f[4] | ((unsigned)f[5] << 16); w.w = f[6] | ((unsigned)f[7] << 16);
            *(u32x4*)(proj + (rbase + 2 * e + (ks >> 4)) * NPJ + OFF_MV + h * 128 + (ks & 15) * 8) = w; }
        __syncthreads();
    }
}

DI void phase_moba_select(const Params& P, LAS unsigned char* lds) {
    const int tid = opq_tid(), qi = tid >> 1, half = tid & 1;
    const bf16_t* proj = (const bf16_t*)(P.ws + WS_R1); const float* kmean = (const float*)(P.ws + WS_KMEAN);
    int* cnt = (int*)(P.ws + WS_CNT); int* list = (int*)(P.ws + WS_LIST); f32x2* ML = (f32x2*)(P.ws + WS_ML);
    LAS float* KM = (LAS float*)lds; LAS int* hist = (LAS int*)(lds + 32768); LAS int* hbase = (LAS int*)(lds + 32768 + 256);
    for (int task = blockIdx.x; task < 1024; task += gridDim.x) {
        const int blk = task & 63, h = (task >> 6) & 7, b = task >> 9; const int bh = b * 8 + h; const int t = blk * 256 + qi; const size_t rid = (size_t)bh * TT + t;
        for (int i = tid; i < blk * 128; i += NTHREADS) KM[i] = kmean[(size_t)bh * 64 * 128 + i];
        if (tid < 64) hist[tid] = 0;
        float q[64];
        { const bf16_t* qp = proj + (size_t)(b * TT + t) * NPJ + OFF_MQ + h * 128 + half * 64;
#pragma unroll
          for (int i = 0; i < 8; ++i) { const u32x4 raw = *(const u32x4*)(qp + 8 * i); q[8 * i] = bflo(raw.x); q[8 * i + 1] = bfhi(raw.x); q[8 * i + 2] = bflo(raw.y); q[8 * i + 3] = bfhi(raw.y);
              q[8 * i + 4] = bflo(raw.z); q[8 * i + 5] = bfhi(raw.z); q[8 * i + 6] = bflo(raw.w); q[8 * i + 7] = bfhi(raw.w); } }
        __syncthreads();
        float v0 = -INFINITY, v1 = -INFINITY, v2 = -INFINITY; int i0 = -1, i1 = -1, i2 = -1;
        for (int n = 0; n < blk; ++n) { const LAS float* km = KM + n * 128 + half * 64; float d0 = 0.f, d1 = 0.f, d2 = 0.f, d3 = 0.f;
#pragma unroll
            for (int i = 0; i < 16; ++i) { const f32x4 kv = *(const LAS f32x4*)(km + 4 * i); d0 += q[4 * i] * kv[0]; d1 += q[4 * i + 1] * kv[1]; d2 += q[4 * i + 2] * kv[2]; d3 += q[4 * i + 3] * kv[3]; }
            float g = (d0 + d1) + (d2 + d3); g += __shfl_xor(g, 1);
            if (g > v0) { v2 = v1; i2 = i1; v1 = v0; i1 = i0; v0 = g; i0 = n; } else if (g > v1) { v2 = v1; i2 = i1; v1 = g; i1 = n; } else if (g > v2) { v2 = g; i2 = n; } }
        int rk0 = 0, rk1 = 0, rk2 = 0;
        if (half == 0) { if (i0 >= 0) rk0 = __hip_atomic_fetch_add(&hist[i0], 1, __ATOMIC_RELAXED, __HIP_MEMORY_SCOPE_WORKGROUP); if (i1 >= 0) rk1 = __hip_atomic_fetch_add(&hist[i1], 1, __ATOMIC_RELAXED, __HIP_MEMORY_SCOPE_WORKGROUP); if (i2 >= 0) rk2 = __hip_atomic_fetch_add(&hist[i2], 1, __ATOMIC_RELAXED, __HIP_MEMORY_SCOPE_WORKGROUP); }
        __syncthreads();
        if (tid < 64) { const int c = hist[tid]; hbase[tid] = c > 0 ? atomicAdd(&cnt[bh * 64 + tid], c) : 0; }
        __syncthreads();
        if (half == 0) {
            const f32x2 dead = {-INFINITY, 0.f};
            if (i0 >= 0) list[(size_t)bh * LISTN + i0 * 16384 - 128 * i0 * (i0 + 1) + hbase[i0] + rk0] = t; else ML[0 * 262144 + rid] = dead;
            if (i1 >= 0) list[(size_t)bh * LISTN + i1 * 16384 - 128 * i1 * (i1 + 1) + hbase[i1] + rk1] = t | (1 << 14); else ML[1 * 262144 + rid] = dead;
            if (i2 >= 0) list[(size_t)bh * LISTN + i2 * 16384 - 128 * i2 * (i2 + 1) + hbase[i2] + rk2] = t | (2 << 14); else ML[2 * 262144 + rid] = dead;
        }
        __syncthreads();
    }
}

constexpr int G2_W = 0, G2_Q = 18432, G2_QK = 36864, G2_KD = 47104, G2_BUF = 67584, G2_RED = 135168;
DI void phase_gdn_scan(const Params& P, LAS unsigned char* lds, int bh) {
    const int tid = opq_tid(), lane = tid & 63, w = tid >> 6, fr = lane & 15, fq = lane >> 4, b = bh >> 3, h = bh & 7;
    const bf16_t* proj = (const bf16_t*)(P.ws + WS_R1); const bf16_t* W2 = (const bf16_t*)(P.ws + WS_W2); const bf16_t* QKB = (const bf16_t*)(P.ws + WS_QKB);
    const float* GL = (const float*)(P.ws + WS_GL); bf16_t* mix = (bf16_t*)(P.ws + WS_R2);
    float* SSQ = (float*)(P.ws + WS_SSQ);
    const int e = 16 * w + fr; const float gnw = P.gdn_norm[e];
    f32x4 S[8];
#pragma unroll
    for (int i = 0; i < 8; ++i) S[i] = (f32x4){0.f, 0.f, 0.f, 0.f};
    const int wrow0 = tid >> 4, wseg = tid & 15;
    const int qrow = tid >> 3, qseg = tid & 7;
    struct Stage { u32x4 sw[2], sq[2], sqk, skd[2]; };
    u32x2 un[4];
    Stage stA, stB;
#define G2_LOAD(X, nn) do { const int t0_ = b * TT + (nn) * 64; const int ci_ = ((b * 256 + (nn)) << 3) + h; \
        _Pragma("unroll") for (int i_ = 0; i_ < 2; ++i_) { X.sw[i_] = *(const u32x4*)(W2 + (size_t)(t0_ + wrow0 + 32 * i_) * 1024 + h * 128 + wseg * 8); \
            X.sq[i_] = *(const u32x4*)(proj + (size_t)(t0_ + wrow0 + 32 * i_) * NPJ + OFF_GQ + h * 128 + wseg * 8); \
            const int d_ = qrow + 64 * i_; X.skd[i_] = *(const u32x4*)(proj + (size_t)(t0_ + (d_ >> 1)) * NPJ + OFF_GK + h * 128 + (d_ & 1) * 64 + qseg * 8); } \
        X.sqk = *(const u32x4*)(QKB + (size_t)ci_ * 4096 + qrow * 64 + qseg * 8); } while (0)
#define UN_LOAD(nn) do { const int t0_ = b * TT + (nn) * 64; _Pragma("unroll") for (int mt_ = 0; mt_ < 4; ++mt_) un[mt_] = *(const u32x2*)(proj + (size_t)(t0_ + (e >> 1)) * NPJ + OFF_GV + h * 128 + (e & 1) * 64 + 16 * mt_ + 4 * fq); } while (0)
#define G2_ST2(base_, rowoff_, sg_, v_) do { const int g_ = ((sg_) >> 2) * 64, d_ = ((sg_) & 3) * 8; \
        *(LAS u32x2*)(B_ + (base_) + (rowoff_) + g_ + perm4(d_) * 2) = (u32x2){(v_).x, (v_).y}; *(LAS u32x2*)(B_ + (base_) + (rowoff_) + g_ + perm4(d_ + 4) * 2) = (u32x2){(v_).z, (v_).w}; } while (0)
#define G2_STORE(X, bufi) do { LAS unsigned char* B_ = lds + (bufi) * G2_BUF; \
        _Pragma("unroll") for (int i_ = 0; i_ < 2; ++i_) { G2_ST2(G2_W, (wrow0 + 32 * i_) * 288, wseg, X.sw[i_]); G2_ST2(G2_Q, (wrow0 + 32 * i_) * 288, wseg, X.sq[i_]); \
            G2_ST2(G2_KD, (qrow + 64 * i_) * 160, qseg, X.skd[i_]); } \
        G2_ST2(G2_QK, qrow * 160, qseg, X.sqk); } while (0)
    G2_LOAD(stA, 0); G2_STORE(stA, 0); UN_LOAD(0);
    float egl_n = GL[bh * 256];
    u32x2 uc[4];
#pragma unroll
    for (int i = 0; i < 4; ++i) uc[i] = un[i];
    G2_LOAD(stA, 1);
    __syncthreads();
    for (int n2 = 0; n2 < 256; n2 += 2) {
#pragma unroll
      for (int hf2 = 0; hf2 < 2; ++hf2) {
        const int n = n2 + hf2; Stage& LDs = hf2 ? stA : stB; Stage& STs = hf2 ? stB : stA;
        const int cur = hf2, t0 = b * TT + n * 64; LAS unsigned char* Bf = lds + cur * G2_BUF;
        if (n + 2 < 256) G2_LOAD(LDs, n + 2);
        if (n + 1 < 256) UN_LOAD(n + 1);
        const float egl = egl_n; if (n + 1 < 256) egl_n = GL[bh * 256 + n + 1];
        f32x4 Pm[4], Om[4];
#pragma unroll
        for (int mt = 0; mt < 4; ++mt) { Pm[mt] = (f32x4){0.f, 0.f, 0.f, 0.f}; Om[mt] = (f32x4){0.f, 0.f, 0.f, 0.f}; }
#define SBAR __builtin_amdgcn_sched_barrier(0)
#define LD_X4(dst, base_, mp_, hf_) do { const int o0_ = (16 * (2 * (mp_)) + fr) * 288 + (64 * (hf_) + 8 * fq) * 2; \
        dst[0] = *(const LAS bf16x8*)(Bf + base_ + o0_); dst[1] = *(const LAS bf16x8*)(Bf + base_ + o0_ + 4608); \
        dst[2] = *(const LAS bf16x8*)(Bf + base_ + o0_ + 64); dst[3] = *(const LAS bf16x8*)(Bf + base_ + o0_ + 4608 + 64); } while (0)
#define MM_X4(src, A0_, A1_) do { A0_ = mfma16(src[0], sb0, A0_); A1_ = mfma16(src[1], sb0, A1_); A0_ = mfma16(src[2], sb1, A0_); A1_ = mfma16(src[3], sb1, A1_); } while (0)
#define LD_PAIR(dst, base_, p_) do { const int o0_ = (16 * (2 * (p_)) + fr) * 160 + (8 * fq) * 2; \
        dst[0] = *(const LAS bf16x8*)(Bf + base_ + o0_); dst[1] = *(const LAS bf16x8*)(Bf + base_ + o0_ + 2560); \
        dst[2] = *(const LAS bf16x8*)(Bf + base_ + o0_ + 64); dst[3] = *(const LAS bf16x8*)(Bf + base_ + o0_ + 2560 + 64); } while (0)
#define MM_PAIR(src, A0_, A1_) do { A0_ = mfma16(src[0], Vb[0], A0_); A1_ = mfma16(src[1], Vb[0], A1_); A0_ = mfma16(src[2], Vb[1], A0_); A1_ = mfma16(src[3], Vb[1], A1_); } while (0)
        bf16x8 fa[4], fb[4];
        LD_X4(fa, G2_W, 0, 0);
        { const bf16x8 sb0 = pack8(S[0], S[1]), sb1 = pack8(S[2], S[3]);
          LD_X4(fb, G2_W, 1, 0); SBAR; MM_X4(fa, Pm[0], Pm[1]); SBAR;
          LD_X4(fa, G2_W, 0, 1); SBAR; MM_X4(fb, Pm[2], Pm[3]); SBAR; }
        { const bf16x8 sb0 = pack8(S[4], S[5]), sb1 = pack8(S[6], S[7]);
          LD_X4(fb, G2_W, 1, 1); SBAR; MM_X4(fa, Pm[0], Pm[1]); SBAR;
          LD_X4(fa, G2_Q, 0, 0); SBAR; MM_X4(fb, Pm[2], Pm[3]); SBAR; }
        f32x4 vn[4];
#pragma unroll
        for (int mt = 0; mt < 4; ++mt) { vn[mt][0] = bflo(uc[mt].x) - Pm[mt][0]; vn[mt][1] = bfhi(uc[mt].x) - Pm[mt][1]; vn[mt][2] = bflo(uc[mt].y) - Pm[mt][2]; vn[mt][3] = bfhi(uc[mt].y) - Pm[mt][3]; }
        bf16x8 Vb[2];
#pragma unroll
        for (int k2 = 0; k2 < 2; ++k2) Vb[k2] = pack8(vn[2 * k2], vn[2 * k2 + 1]);
        { const bf16x8 sb0 = pack8(S[0], S[1]), sb1 = pack8(S[2], S[3]);
          LD_X4(fb, G2_Q, 1, 0); SBAR; MM_X4(fa, Om[0], Om[1]); SBAR;
          LD_X4(fa, G2_Q, 0, 1); SBAR; MM_X4(fb, Om[2], Om[3]); SBAR; }
        { const bf16x8 sb0 = pack8(S[4], S[5]), sb1 = pack8(S[6], S[7]);
          LD_X4(fb, G2_Q, 1, 1); SBAR; MM_X4(fa, Om[0], Om[1]); SBAR;
          LD_PAIR(fa, G2_QK, 0); SBAR; MM_X4(fb, Om[2], Om[3]); SBAR; }
#pragma unroll
        for (int dt = 0; dt < 8; ++dt) S[dt] = S[dt] * egl;
        SBAR;
        LD_PAIR(fb, G2_QK, 1); SBAR; MM_PAIR(fa, Om[0], Om[1]); SBAR;
        LD_PAIR(fa, G2_KD, 0); SBAR; MM_PAIR(fb, Om[2], Om[3]); SBAR;
        LD_PAIR(fb, G2_KD, 1); SBAR; MM_PAIR(fa, S[0], S[1]); SBAR;
        LD_PAIR(fa, G2_KD, 2); SBAR; MM_PAIR(fb, S[2], S[3]); SBAR;
        LD_PAIR(fb, G2_KD, 3); SBAR; MM_PAIR(fa, S[4], S[5]); SBAR;
        MM_PAIR(fb, S[6], S[7]); SBAR;
#undef LD_X4
#undef MM_X4
#undef LD_PAIR
#undef MM_PAIR
#undef SBAR
        { float mine = 0.f;
#pragma unroll
          for (int mt = 0; mt < 4; ++mt)
#pragma unroll
            for (int j = 0; j < 4; ++j) { const float s2 = row16_sum(Om[mt][j] * Om[mt][j]);
                mine = (fr == mt * 4 + j) ? s2 : mine; }
          SSQ[(size_t)(t0 + 16 * (fr >> 2) + 4 * fq + (fr & 3)) * 64 + h * 8 + w] = mine; }
#pragma unroll
        for (int mt = 0; mt < 4; ++mt)
#pragma unroll
            for (int j = 0; j < 4; ++j) mix[(size_t)(t0 + 16 * mt + 4 * fq + j) * DM + h * 128 + e] = f2bf(Om[mt][j] * gnw);
        if (n + 1 < 256) { G2_STORE(STs, cur ^ 1);
#pragma unroll
            for (int i = 0; i < 4; ++i) uc[i] = un[i]; }
        __syncthreads();
      }
    }
#undef G2_LOAD
#undef UN_LOAD
#undef G2_STORE
#undef G2_ST2
    __syncthreads();
}

constexpr int AT_KS = 0, AT_VT = 73728, AT_PF = 143360, AT_MISC = 147712;
DI void phase_moba_attn(const Params& P, LAS unsigned char* lds) {
    const int tid = opq_tid(), lane = tid & 63, w = tid >> 6, fr = lane & 15, fq = lane >> 4;
    const bf16_t* proj = (const bf16_t*)(P.ws + WS_R1); const int* cnt = (const int*)(P.ws + WS_CNT); const int* list = (const int*)(P.ws + WS_LIST);
    f32x2* ML = (f32x2*)(P.ws + WS_ML); bf16_t* opart = (bf16_t*)P.out; unsigned* workctr = (unsigned*)(P.ws + WS_CTL);
    LAS bf16_t* KS = (LAS bf16_t*)(lds + AT_KS); LAS bf16_t* VT = (LAS bf16_t*)(lds + AT_VT); LAS int* PF = (LAS int*)(lds + AT_PF); LAS int* MISC = (LAS int*)(lds + AT_MISC);
    { const int c0 = cnt[2 * tid], c1 = cnt[2 * tid + 1]; const int a = (c0 + 511) >> 9, bsum = a + ((c1 + 511) >> 9); int inc = bsum;
#pragma unroll
      for (int o = 1; o < 64; o <<= 1) { const int v = __shfl_up(inc, o); if (lane >= o) inc += v; }
      if (lane == 63) MISC[8 + w] = inc;
      __syncthreads();
      int wb = 0;
#pragma unroll
      for (int i = 0; i < 8; ++i) wb += (i < w) ? MISC[8 + i] : 0;
      const int ex = wb + inc - bsum; PF[2 * tid] = ex; PF[2 * tid + 1] = ex + a; if (tid == 511) PF[1024] = ex + bsum;
      __syncthreads(); }
    const int totalG = PF[1024];
    const float sc2 = 0.08838834764831845f * 1.4426950408889634f;
    const int tid_at = tid;
    for (;;) {
        int tid = tid_at; asm volatile("" : "+v"(tid)); const int lane = tid & 63, w = __builtin_amdgcn_readfirstlane(tid >> 6), fr = lane & 15, fq = lane >> 4;
        if (tid == 0) MISC[0] = (int)atomicAdd(workctr, 1u);
        __syncthreads();
        const int wid = MISC[0];
        __syncthreads();
        if (wid >= totalG + 1024) break;
        int bh, j, causal, qstart, qcount;
        if (wid < totalG) { int lo = 0, hi = 1024; while (hi - lo > 1) { const int mid = (lo + hi) >> 1; if (PF[mid] <= wid) lo = mid; else hi = mid; }
            bh = lo >> 6; j = lo & 63; causal = 0; qstart = (wid - PF[lo]) * 512; const int c = cnt[lo]; qcount = c - qstart; if (qcount > 512) qcount = 512; }
        else { const int o = wid - totalG; bh = o >> 6; j = o & 63; causal = 1; qstart = 0; qcount = 256; }
        const int b = bh >> 3, h = bh & 7; const size_t kbase = (size_t)(b * TT + j * 256);
        { u32x4 kr[8], vr[8];
#pragma unroll
          for (int i8 = 0; i8 < 8; ++i8) { const int pid = tid + i8 * 512; kr[i8] = *(const u32x4*)(proj + (kbase + (pid >> 4)) * NPJ + OFF_MK + h * 128 + (pid & 15) * 8);
              const int e = pid >> 5, ks = pid & 31; vr[i8] = *(const u32x4*)(proj + (kbase + 2 * e + (ks >> 4)) * NPJ + OFF_MV + h * 128 + (ks & 15) * 8); }
#pragma unroll
          for (int i8 = 0; i8 < 8; ++i8) { const int pid = tid + i8 * 512; *(LAS u32x4*)(KS + (pid >> 4) * 144 + (pid & 15) * 8) = kr[i8];
              const int e = pid >> 5, ks = pid & 31; const int g_ = (ks >> 2) * 32, d_ = (ks & 3) * 8;
              *(LAS u32x2*)(VT + e * 272 + g_ + perm4(d_)) = (u32x2){vr[i8].x, vr[i8].y}; *(LAS u32x2*)(VT + e * 272 + g_ + perm4(d_ + 4)) = (u32x2){vr[i8].z, vr[i8].w}; } }
        const int lbase = bh * LISTN + j * 16384 - 128 * j * (j + 1) + qstart;
        const int ntile = (qcount + 127) >> 7;
        int en0, en1, en2, en3;
        { const int q0 = 16 * w + fr, lim = qcount - 1;
          if (causal) { en0 = (j * 256 + q0) | (3 << 14); en1 = (j * 256 + q0 + 128) | (3 << 14); en2 = en1; en3 = en1; }
          else { en0 = list[lbase + (q0 < lim ? q0 : lim)]; en1 = list[lbase + (q0 + 128 < lim ? q0 + 128 : lim)]; en2 = list[lbase + (q0 + 256 < lim ? q0 + 256 : lim)]; en3 = list[lbase + (q0 + 384 < lim ? q0 + 384 : lim)]; } }
        bf16x8 Bq[4], Bn[4];
        { const bf16_t* qp = proj + (size_t)(b * TT + (en0 & 16383)) * NPJ + OFF_MQ + h * 128 + 8 * fq;
#pragma unroll
          for (int ks = 0; ks < 4; ++ks) Bq[ks] = *(const bf16x8*)(qp + 32 * ks); }
        __syncthreads();
        for (int tile = 0; tile < ntile; ++tile) {
            const int en = tile == 0 ? en0 : (tile == 1 ? en1 : (tile == 2 ? en2 : en3));
            { const int enx = tile == 0 ? en1 : (tile == 1 ? en2 : en3); const bf16_t* qp = proj + (size_t)(b * TT + (enx & 16383)) * NPJ + OFF_MQ + h * 128 + 8 * fq;
#pragma unroll
              for (int ks = 0; ks < 4; ++ks) Bn[ks] = *(const bf16x8*)(qp + 32 * ks); }
            const int qi = tile * 128 + 16 * w + fr; const bool valid = qi < qcount; const int t = en & 16383, slot = en >> 14;
            if (tile * 128 + 16 * w < qcount) {
            const int nkt = causal ? (8 * tile + w + 1) : 16;
            f32x4 st[16]; float mx = -INFINITY;
#pragma unroll
            for (int kp = 0; kp < 8; ++kp) { f32x4 a0 = {0.f, 0.f, 0.f, 0.f}, a1 = {0.f, 0.f, 0.f, 0.f};
                if (2 * kp < nkt) { bf16x8 kf[8];
#pragma unroll
                    for (int ks = 0; ks < 4; ++ks) { kf[ks] = *(const LAS bf16x8*)(KS + (32 * kp + fr) * 144 + 32 * ks + 8 * fq); kf[4 + ks] = *(const LAS bf16x8*)(KS + (32 * kp + 16 + fr) * 144 + 32 * ks + 8 * fq); }
#pragma unroll
                    for (int ks = 0; ks < 4; ++ks) { a0 = mfma16(kf[ks], Bq[ks], a0); a1 = mfma16(kf[4 + ks], Bq[ks], a1); }
#pragma unroll
                    for (int jj = 0; jj < 4; ++jj) { float s0 = a0[jj] * sc2, s1 = a1[jj] * sc2;
                        if (causal && (32 * kp + 4 * fq + jj) > qi) s0 = -INFINITY; if ((causal && (32 * kp + 16 + 4 * fq + jj) > qi) || 2 * kp + 1 >= nkt) s1 = -INFINITY;
                        a0[jj] = s0; a1[jj] = s1; mx = fmaxf(mx, fmaxf(s0, s1)); }
                } else { a0 = (f32x4){-INFINITY, -INFINITY, -INFINITY, -INFINITY}; a1 = a0; }
                st[2 * kp] = a0; st[2 * kp + 1] = a1; }
            mx = fmaxf(mx, __shfl_xor(mx, 16)); mx = fmaxf(mx, __shfl_xor(mx, 32));
            float ls = 0.f;
#pragma unroll
            for (int kt = 0; kt < 16; ++kt)
#pragma unroll
                for (int jj = 0; jj < 4; ++jj) { const float pv = exp2f(st[kt][jj] - mx); st[kt][jj] = pv; ls += pv; }
            ls += __shfl_xor(ls, 16); ls += __shfl_xor(ls, 32);
            f32x4 ot[8];
#pragma unroll
            for (int et = 0; et < 8; ++et) ot[et] = (f32x4){0.f, 0.f, 0.f, 0.f};
#pragma unroll
            for (int k2 = 0; k2 < 8; ++k2) { if (2 * k2 < nkt) { const bf16x8 pb = pack8(st[2 * k2], st[2 * k2 + 1]);
#pragma unroll
                    for (int eh = 0; eh < 2; ++eh) { bf16x8 vf[4];
#pragma unroll
                        for (int et = 0; et < 4; ++et) vf[et] = *(const LAS bf16x8*)(VT + (16 * (4 * eh + et) + fr) * 272 + 32 * k2 + 8 * fq);
#pragma unroll
                        for (int et = 0; et < 4; ++et) ot[4 * eh + et] = mfma16(vf[et], pb, ot[4 * eh + et]); } } }
            if (valid) { const float il = 1.f / ls; const size_t rid = (size_t)bh * TT + t; bf16_t* op = opart + ((size_t)slot * 262144 + rid) * 128 + 4 * fq;
#pragma unroll
                for (int et = 0; et < 8; ++et) { u32x2 wv; wv.x = pk2(ot[et][0] * il, ot[et][1] * il); wv.y = pk2(ot[et][2] * il, ot[et][3] * il); *(u32x2*)(op + 16 * et) = wv; }
                if (fq == 0) ML[(size_t)slot * 262144 + rid] = (f32x2){mx, ls}; }
            }
#pragma unroll
            for (int ks = 0; ks < 4; ++ks) Bq[ks] = Bn[ks];
        }
        __syncthreads();
    }
}

DI void phase_moba_combine(const Params& P) {
    const bf16_t* opart = (const bf16_t*)P.out; const f32x2* ML = (const f32x2*)(P.ws + WS_ML); bf16_t* mix = (bf16_t*)(P.ws + WS_R2);
    const int gtid = blockIdx.x * NTHREADS + opq_tid(), gsz = gridDim.x * NTHREADS;
    { const bf16_t* proj = (const bf16_t*)(P.ws + WS_R1); const float* SSQ = (const float*)(P.ws + WS_SSQ);
      for (int i = gtid; i < MT * 128; i += gsz) { const int row = i >> 7, sg = i & 127; bf16_t* mp = mix + (size_t)row * DM + sg * 8; const u32x4 mv = *(const u32x4*)mp, zv = *(const u32x4*)(proj + (size_t)row * NPJ + OFF_GZ + sg * 8);
          const f32x4 p0 = *(const f32x4*)(SSQ + (size_t)row * 64 + (sg >> 4) * 8), p1 = *(const f32x4*)(SSQ + (size_t)row * 64 + (sg >> 4) * 8 + 4);
          const float rs = rsqrtf((((p0[0] + p0[1]) + (p0[2] + p0[3])) + ((p1[0] + p1[1]) + (p1[2] + p1[3]))) * (1.f / 128.f) + 1e-6f);
          u32x4 wv; wv.x = pk2(bflo(mv.x) * rs * silu_f(bflo(zv.x)), bfhi(mv.x) * rs * silu_f(bfhi(zv.x))); wv.y = pk2(bflo(mv.y) * rs * silu_f(bflo(zv.y)), bfhi(mv.y) * rs * silu_f(bfhi(zv.y)));
          wv.z = pk2(bflo(mv.z) * rs * silu_f(bflo(zv.z)), bfhi(mv.z) * rs * silu_f(bfhi(zv.z))); wv.w = pk2(bflo(mv.w) * rs * silu_f(bflo(zv.w)), bfhi(mv.w) * rs * silu_f(bfhi(zv.w))); *(u32x4*)mp = wv; } }
    for (int i = gtid; i < 262144 * 16; i += gsz) { const int rid = i >> 4, sg = i & 15; const int bh = rid >> 14, t = rid & 16383, b = bh >> 3, h = bh & 7;
        f32x2 ml[4]; float M = -INFINITY;
#pragma unroll
        for (int s = 0; s < 4; ++s) { ml[s] = ML[(size_t)s * 262144 + rid]; M = fmaxf(M, ml[s].x); }
        float wgt[4], Lt = 0.f;
#pragma unroll
        for (int s = 0; s < 4; ++s) { wgt[s] = ml[s].y > 0.f ? ml[s].y * exp2f(ml[s].x - M) : 0.f; Lt += wgt[s]; }
        const float iL = 1.f / Lt; float o[8];
#pragma unroll
        for (int k = 0; k < 8; ++k) o[k] = 0.f;
#pragma unroll
        for (int s = 0; s < 4; ++s) { if (wgt[s] > 0.f) { const u32x4 raw = *(const u32x4*)(opart + ((size_t)s * 262144 + rid) * 128 + sg * 8); const float ww = wgt[s] * iL;
                o[0] += ww * bflo(raw.x); o[1] += ww * bfhi(raw.x); o[2] += ww * bflo(raw.y); o[3] += ww * bfhi(raw.y); o[4] += ww * bflo(raw.z); o[5] += ww * bfhi(raw.z); o[6] += ww * bflo(raw.w); o[7] += ww * bfhi(raw.w); } }
        u32x4 wv; wv.x = pk2(o[0], o[1]); wv.y = pk2(o[2], o[3]); wv.z = pk2(o[4], o[5]); wv.w = pk2(o[6], o[7]);
        *(u32x4*)(mix + (size_t)(b * TT + t) * DM + 1024 + h * 128 + sg * 8) = wv; }
}

__global__ void __launch_bounds__(NTHREADS) hybrid_fwd(Params P) {
    extern __shared__ __attribute__((aligned(16))) unsigned char smem[];
    LAS unsigned char* lds = (LAS unsigned char*)smem;
    cg::grid_group grid = cg::this_grid();
    unsigned char* ws = P.ws; const int G = gridDim.x, bx = blockIdx.x;
    bf16_t* R0 = (bf16_t*)(ws + WS_R0); bf16_t* R1 = (bf16_t*)(ws + WS_R1); bf16_t* R2 = (bf16_t*)(ws + WS_R2);
    float* ss1 = (float*)(ws + WS_SS1); float* ss2 = (float*)(ws + WS_SS2);

    phase_prep(P, lds);
    grid.sync();
    { pg8::Gemm g{R0, (const bf16_t*)(ws + WS_WIN), MT, NPJ, DM}; pg8::StaticOrder S; S.init(MT, NPJ, G, bx); EpiProj E{R1, (bf16_t*)(ws + WS_HALO)}; pg8::gemm_phase(lds, g, S, E); }
    phase_ba(P);
    grid.sync();
    phase_gdn_prep(P, lds);
    phase_moba_prep(P, lds);
    grid.sync();
    phase_moba_select(P, lds);
    grid.sync();
    if (bx < 16) phase_gdn_scan(P, lds, bx);
    phase_moba_attn(P, lds);
    if (bx >= 16) phase_wconv_late(P, lds, bx - 16, G - 16);
    grid.sync();
    phase_moba_combine(P);
    grid.sync();
    { pg8::Gemm g{R2, (const bf16_t*)(ws + WS_WO), MT, DM, DM}; pg8::StaticOrder S; S.init(MT, DM, G, bx); EpiResid E{P.x, P.out, R0, ss1}; pg8::gemm_phase(lds, g, S, E); }
    grid.sync();
    { pg8::Gemm g{R0, (const bf16_t*)(ws + WS_WGU), MT, 2 * FF, DM}; pg8::StaticOrder S; S.init(MT, 2 * FF, G, bx); EpiAct E{R1, ss1}; pg8::gemm_phase(lds, g, S, E); }
    grid.sync();
    { pg8::Gemm g{(const bf16_t*)(ws + WS_PB), (const bf16_t*)(ws + WS_WPP), MT, DM, 256}; pg8::StaticOrder S; S.init(MT, DM, G, bx); EpiPlainBf16 E{R0, DM}; pg8::gemm_phase(lds, g, S, E); }
    { pg8::Gemm g{R1, (const bf16_t*)(ws + WS_WDN), MT, DM, FF}; pg8::StaticOrder S; S.init(MT, DM, G, bx); EpiResid E{P.out, P.out, R2, ss2}; pg8::gemm_phase(lds, g, S, E); }
    grid.sync();
    { pg8::Gemm g{R2, (const bf16_t*)(ws + WS_WPG), MT, DM, DM}; pg8::StaticOrder S; S.init(MT, DM, G, bx); EpiOut E{P.out, R0, ss2}; pg8::gemm_phase(lds, g, S, E); }
}

extern "C" void kernel_launch(void* const* d_in, const int* in_sizes, int n_in, void* d_out, int out_size, void* d_ws, size_t ws_size, hipStream_t stream) {
    static int grid_blocks = 0;
    if (!grid_blocks) {
        int dev = 0, cus = 0, per_cu = 0;
        hipGetDevice(&dev);
        hipDeviceGetAttribute(&cus, hipDeviceAttributeMultiprocessorCount, dev);
        hipFuncSetAttribute((const void*)hybrid_fwd, hipFuncAttributeMaxDynamicSharedMemorySize, LDS_BYTES);
        hipOccupancyMaxActiveBlocksPerMultiprocessor(&per_cu, (const void*)hybrid_fwd, NTHREADS, LDS_BYTES);
        if (per_cu < 1) per_cu = 1;
        grid_blocks = cus * per_cu;
        if (ws_size < WS_END) fprintf(stderr, "kernel_launch: workspace too small: %zu < %zu\n", ws_size, (size_t)WS_END);
    }
    Params p{};
    p.x = (const float*)d_in[0]; p.p = (const float*)d_in[1]; p.attn_norm = (const float*)d_in[2]; p.w_in = (const float*)d_in[3]; p.conv_w = (const float*)d_in[4];
    p.A_log = (const float*)d_in[5]; p.dt_bias = (const float*)d_in[6]; p.gdn_norm = (const float*)d_in[7]; p.q_norm = (const float*)d_in[8]; p.k_norm = (const float*)d_in[9];
    p.w_o = (const float*)d_in[10]; p.ffn_norm = (const float*)d_in[11]; p.w_gate = (const float*)d_in[12]; p.w_up = (const float*)d_in[13]; p.w_down = (const float*)d_in[14];
    p.ple_norm = (const float*)d_in[15]; p.w_pg = (const float*)d_in[16]; p.w_pp = (const float*)d_in[17];
    p.out = (float*)d_out; p.ws = (unsigned char*)d_ws;
    void* args[] = {&p};
    hipError_t e = hipLaunchCooperativeKernel((const void*)hybrid_fwd, dim3(grid_blocks), dim3(NTHREADS), args, LDS_BYTES, stream);
    if (e != hipSuccess) fprintf(stderr, "cooperative launch failed: %s (grid %d)\n", hipGetErrorString(e), grid_blocks);
}
```

```cpp
#include <hip/hip_runtime.h>
#include <hip/hip_cooperative_groups.h>
#include <cstdio>
namespace cg = cooperative_groups;

#define LAS __attribute__((address_space(3)))
#define DI __device__ __forceinline__
typedef unsigned short bf16_t;
typedef short bf16x8 __attribute__((ext_vector_type(8)));
typedef float f32x4 __attribute__((ext_vector_type(4)));
typedef float f32x2 __attribute__((ext_vector_type(2)));
typedef unsigned u32x4 __attribute__((ext_vector_type(4)));
typedef unsigned u32x2 __attribute__((ext_vector_type(2)));
typedef __bf16 bfv2 __attribute__((ext_vector_type(2)));

constexpr int DM = 2048, TT = 16384, MT = 32768, NPJ = 7168, FF = 5632, INW = 7184;
constexpr int OFF_GQ = 0, OFF_GK = 1024, OFF_GV = 2048, OFF_GZ = 3072, OFF_MQ = 4096, OFF_MK = 5120, OFF_MV = 6144;
constexpr int LISTN = 516096;
constexpr int NTHREADS = 512;
constexpr int LDS_BYTES = 163840;

constexpr size_t WS_CTL   = 0;
constexpr size_t WS_CNT   = 4096;
constexpr size_t WS_SS1   = 8192;
constexpr size_t WS_SS2   = WS_SS1 + 131072;
constexpr size_t WS_GL    = WS_SS2 + 131072;
constexpr size_t WS_KMEAN = WS_GL + 16384;
constexpr size_t WS_WBA   = WS_KMEAN + 524288;
constexpr size_t WS_BA    = WS_WBA + 65536;
constexpr size_t WS_WIN   = WS_BA + 2097152;
constexpr size_t WS_WO    = WS_WIN + (size_t)7168 * 2048 * 2;
constexpr size_t WS_WGU   = WS_WO + (size_t)2048 * 2048 * 2;
constexpr size_t WS_WDN   = WS_WGU + (size_t)11264 * 2048 * 2;
constexpr size_t WS_WPG   = WS_WDN + (size_t)2048 * 5632 * 2;
constexpr size_t WS_WPP   = WS_WPG + (size_t)2048 * 2048 * 2;
constexpr size_t WS_PB    = WS_WPP + (size_t)2048 * 256 * 2;
constexpr size_t WS_R0    = WS_PB + (size_t)32768 * 256 * 2;
constexpr size_t WS_R1    = WS_R0 + (size_t)32768 * 2048 * 2;
constexpr size_t WS_R2    = WS_R1 + (size_t)32768 * 7168 * 2;
constexpr size_t WS_W2    = WS_R2 + (size_t)32768 * 2048 * 2;
constexpr size_t WS_QKB   = WS_W2 + (size_t)32768 * 1024 * 2;
constexpr size_t WS_HALO  = WS_QKB + (size_t)4096 * 4096 * 2;
constexpr size_t WS_LIST  = WS_HALO + (size_t)513 * 3 * 3072 * 2 + 256 - ((size_t)513 * 3 * 3072 * 2) % 256;
constexpr size_t WS_ML    = WS_LIST + (size_t)16 * LISTN * 4;
constexpr size_t WS_SSQ   = WS_ML + (size_t)4 * 262144 * 8;
constexpr size_t WS_END   = WS_SSQ + (size_t)32768 * 64 * 4;

struct Params {
    const float* x; const float* p; const float* attn_norm; const float* w_in; const float* conv_w; const float* A_log; const float* dt_bias;
    const float* gdn_norm; const float* q_norm; const float* k_norm; const float* w_o; const float* ffn_norm; const float* w_gate; const float* w_up;
    const float* w_down; const float* ple_norm; const float* w_pg; const float* w_pp;
    float* out; unsigned char* ws;
};

DI unsigned pk2(float a, float b) { f32x2 v = {a, b}; bfv2 r = __builtin_convertvector(v, bfv2); return __builtin_bit_cast(unsigned, r); }
DI bf16_t f2bf(float a) { return (bf16_t)(pk2(a, 0.f) & 0xffffu); }
DI float bflo(unsigned w) { return __uint_as_float(w << 16); }
DI float bfhi(unsigned w) { return __uint_as_float(w & 0xffff0000u); }
DI float bf2f(bf16_t v) { return __uint_as_float(((unsigned)v) << 16); }
DI bf16x8 pack8(const f32x4& a, const f32x4& b) { u32x4 w; w.x = pk2(a[0], a[1]); w.y = pk2(a[2], a[3]); w.z = pk2(b[0], b[1]); w.w = pk2(b[2], b[3]); return __builtin_bit_cast(bf16x8, w); }
DI bf16x8 cat8(u32x2 lo, u32x2 hi) { u32x4 w; w.x = lo.x; w.y = lo.y; w.z = hi.x; w.w = hi.y; return __builtin_bit_cast(bf16x8, w); }
DI f32x4 mfma16(bf16x8 a, bf16x8 b, f32x4 c) { return __builtin_amdgcn_mfma_f32_16x16x32_bf16(a, b, c, 0, 0, 0); }
DI int perm4(int d4) { return d4 < 16 ? 2 * d4 : 2 * (d4 - 16) + 4; }
DI float dpp_f(float v, int ctrl_sel) { int x = __float_as_int(v); int r;
    if (ctrl_sel == 0) r = __builtin_amdgcn_mov_dpp(x, 0xB1, 0xf, 0xf, true); else if (ctrl_sel == 1) r = __builtin_amdgcn_mov_dpp(x, 0x4E, 0xf, 0xf, true);
    else if (ctrl_sel == 2) r = __builtin_amdgcn_mov_dpp(x, 0x141, 0xf, 0xf, true); else r = __builtin_amdgcn_mov_dpp(x, 0x140, 0xf, 0xf, true);
    return __int_as_float(r); }
DI float row16_sum(float v) { v += dpp_f(v, 0); v += dpp_f(v, 1); v += dpp_f(v, 2); v += dpp_f(v, 3); return v; }
DI float silu_f(float v) { return v / (1.f + __expf(-v)); }
DI float sigm_f(float v) { return 1.f / (1.f + __expf(-v)); }

DI int opq_tid() { int t = threadIdx.x; asm volatile("" : "+v"(t)); return t; }

namespace pg8 {
constexpr int BM = 256, BK = 64, HALF = 128, HTB = HALF * BK * 2, STAGE_BYTES = 8 * HTB, NXCD = 8, WGM = 8;
DI int lds_byte(int r, int c) { const int st = (r >> 4) * 2 + (c >> 5), rr = r & 15, cc = c & 31, ob = rr * 64 + cc * 2; return st * 1024 + (ob ^ (((ob >> 9) & 1) << 5)); }
DI void stage_rc(int b, int& R, int& C) { const int st = b / 1024, sb = b % 1024, swz = sb ^ (((sb >> 9) & 1) << 5); R = (st >> 1) * 16 + swz / 64; C = (st & 1) * 32 + (swz % 64) / 2; }
DI int perm32(int rho) { const int n = rho >> 4, i = rho & 15; return 8 * (i >> 2) + 4 * n + (i & 3); }
struct Unit { int pm, pn; };
struct Gemm { const bf16_t* A; const bf16_t* Bt; int M, N, K; };
struct StaticOrder {
    int nM, nN, nwg, G, c;
    DI void init(int M, int N, int G_, int c_) { nM = M / BM; nN = N / BM; nwg = nM * nN; G = G_; c = c_; }
    DI bool next(int i, Unit& u) const {
        const long L = (long)i * G + c; if (L >= nwg) return false;
        int wgid = (int)L; { const int q = nwg / NXCD, r = nwg % NXCD, xcd = wgid % NXCD, off = wgid / NXCD; wgid = (xcd < r ? xcd * (q + 1) : r * (q + 1) + (xcd - r) * q) + off; }
        const int nig = WGM * nN, gid = wgid / nig, fm = gid * WGM, gsz = (nM - fm) < WGM ? (nM - fm) : WGM;
        u.pm = fm + ((wgid % nig) % gsz); u.pn = (wgid % nig) / gsz; return true;
    }
};

template <class Epi>
DI void gemm_phase(LAS unsigned char* lds, const Gemm g, const StaticOrder& S, const Epi& E) {
    const int tid = opq_tid(), wid = __builtin_amdgcn_readfirstlane(tid >> 6), lane = tid & 63, wr = wid >> 2, wc = wid & 3, fr = lane & 15, fq = lane >> 4;
    const int K = g.K, nt = K / BK;
    unsigned voffA[2], voffB[2];
#pragma unroll
    for (int i = 0; i < 2; ++i) { int R, C; stage_rc(tid * 16 + i * 8192, R, C); const int Rb = Epi::PERM ? ((R & ~31) + perm32(R & 31)) : R;
        voffA[i] = (unsigned)(R * K + C) * 2u; voffB[i] = (unsigned)(Rb * K + C) * 2u; }
    const size_t kstep = (size_t)(BK * 2);
    const size_t hstep = (size_t)HALF * K * 2;
    const size_t tstep = 2 * hstep;
    const unsigned ldsw = (unsigned)wid * 1024u;
    const int aoff = lds_byte(wr * 64 + fr, fq * 8), boff = lds_byte(wc * 32 + fr, fq * 8);
#define PG8_SA(b, h) (((b) * 2 + (h)) * HTB)
#define PG8_SB(b, h) ((4 + (b) * 2 + (h)) * HTB)
#define PG8_STAGE(bufoff, gbase, voff) do { _Pragma("unroll") for (int _i = 0; _i < 2; ++_i) \
        __builtin_amdgcn_global_load_lds((const unsigned*)((const char*)(gbase) + (voff)[_i]), (LAS unsigned*)(lds + (bufoff) + ldsw + _i * 8192), 16, 0, 0); } while (0)
#define PG8_LDA(dst, b, h) do { _Pragma("unroll") for (int m = 0; m < 4; ++m) _Pragma("unroll") for (int k = 0; k < 2; ++k) dst[m][k] = *(const LAS bf16x8*)(lds + PG8_SA(b, h) + aoff + m * 2048 + k * 1024); } while (0)
#define PG8_LDB(dst, b, h) do { _Pragma("unroll") for (int n = 0; n < 2; ++n) _Pragma("unroll") for (int k = 0; k < 2; ++k) dst[n][k] = *(const LAS bf16x8*)(lds + PG8_SB(b, h) + boff + n * 2048 + k * 1024); } while (0)
#define PG8_MMA(ai, bj, At, Bt) do { __builtin_amdgcn_s_setprio(1); _Pragma("unroll") for (int m = 0; m < 4; ++m) _Pragma("unroll") for (int n = 0; n < 2; ++n) _Pragma("unroll") for (int k = 0; k < 2; ++k) \
        acc[ai][bj][m][n] = __builtin_amdgcn_mfma_f32_16x16x32_bf16(Bt[n][k], At[m][k], acc[ai][bj][m][n], 0, 0, 0); __builtin_amdgcn_s_setprio(0); } while (0)
#define PG8_WAIT_V(n) asm volatile("s_waitcnt vmcnt(" #n ")" ::: "memory")
#define PG8_WAIT_L(n) asm volatile("s_waitcnt lgkmcnt(" #n ")" ::: "memory")
#define PG8_BAR __builtin_amdgcn_s_barrier()
#define PG8_SCHED __builtin_amdgcn_sched_barrier(0)
    Unit cur, nxt; int ui = 0;
    if (!S.next(0, cur)) return;
    f32x4 acc[2][2][4][2];
#pragma unroll
    for (int a = 0; a < 2; ++a)
#pragma unroll
        for (int b = 0; b < 2; ++b)
#pragma unroll
            for (int m = 0; m < 4; ++m)
#pragma unroll
                for (int n = 0; n < 2; ++n) acc[a][b][m][n] = (f32x4){0.f, 0.f, 0.f, 0.f};
    bf16x8 At[4][2], B0[2][2], B1[2][2];
    const char* cA = (const char*)g.A + (size_t)cur.pm * tstep; const char* cB = (const char*)g.Bt + (size_t)cur.pn * tstep;
    PG8_STAGE(PG8_SB(0, 0), cB, voffB); PG8_STAGE(PG8_SA(0, 0), cA, voffA); PG8_STAGE(PG8_SB(0, 1), cB + hstep, voffB); PG8_STAGE(PG8_SA(0, 1), cA + hstep, voffA);
    if (wr == 1) PG8_BAR;
    PG8_WAIT_V(4); PG8_BAR;
    PG8_STAGE(PG8_SB(1, 0), cB + kstep, voffB); PG8_STAGE(PG8_SA(1, 0), cA + kstep, voffA); PG8_STAGE(PG8_SB(1, 1), cB + hstep + kstep, voffB);
    PG8_WAIT_V(6); PG8_BAR;
    for (;;) {
        const bool has_next = S.next(ui + 1, nxt);
        const char* nA = has_next ? (const char*)g.A + (size_t)nxt.pm * tstep : cA; const char* nB = has_next ? (const char*)g.Bt + (size_t)nxt.pn * tstep : cB;
        for (int t = 0; t < nt; t += 2) {
            const bool last = (t == nt - 2);
            const char* a1 = cA + (size_t)(t + 1) * kstep;
            const char* a2 = last ? nA : cA + (size_t)(t + 2) * kstep; const char* b2 = last ? nB : cB + (size_t)(t + 2) * kstep;
            const char* a3 = a2 + kstep; const char* b3 = b2 + kstep;
            PG8_LDB(B0, 0, 0); PG8_SCHED; PG8_LDA(At, 0, 0); PG8_STAGE(PG8_SA(1, 1), a1 + hstep, voffA);
            PG8_WAIT_L(8); PG8_BAR; PG8_WAIT_L(0); PG8_MMA(0, 0, At, B0); PG8_BAR; PG8_SCHED;
            PG8_LDB(B1, 0, 1); PG8_STAGE(PG8_SB(0, 0), b2, voffB);
            PG8_BAR; PG8_WAIT_L(0); PG8_MMA(0, 1, At, B1); PG8_BAR;
            PG8_LDA(At, 0, 1); PG8_STAGE(PG8_SA(0, 0), a2, voffA);
            PG8_BAR; PG8_WAIT_L(0); PG8_MMA(1, 0, At, B0); PG8_BAR; PG8_SCHED;
            PG8_STAGE(PG8_SB(0, 1), b2 + hstep, voffB);
            PG8_WAIT_V(6); PG8_BAR; PG8_MMA(1, 1, At, B1); PG8_BAR;
            PG8_LDB(B0, 1, 0); PG8_SCHED; PG8_LDA(At, 1, 0); PG8_STAGE(PG8_SA(0, 1), a2 + hstep, voffA);
            PG8_WAIT_L(8); PG8_BAR; PG8_WAIT_L(0); PG8_MMA(0, 0, At, B0); PG8_BAR; PG8_SCHED;
            PG8_LDB(B1, 1, 1); PG8_STAGE(PG8_SB(1, 0), b3, voffB);
            PG8_BAR; PG8_WAIT_L(0); PG8_MMA(0, 1, At, B1); PG8_BAR;
            PG8_LDA(At, 1, 1); PG8_STAGE(PG8_SA(1, 0), a3, voffA);
            PG8_BAR; PG8_WAIT_L(0); PG8_MMA(1, 0, At, B0); PG8_BAR; PG8_SCHED;
            PG8_STAGE(PG8_SB(1, 1), b3 + hstep, voffB);
            PG8_WAIT_V(6); PG8_BAR; PG8_MMA(1, 1, At, B1); PG8_BAR;
        }
        E(acc, cur, wr, wc, fr, fq);
        if (!has_next) break;
#pragma unroll
        for (int a = 0; a < 2; ++a)
#pragma unroll
            for (int b = 0; b < 2; ++b)
#pragma unroll
                for (int m = 0; m < 4; ++m)
#pragma unroll
                    for (int n = 0; n < 2; ++n) acc[a][b][m][n] = (f32x4){0.f, 0.f, 0.f, 0.f};
        cur = nxt; cA = nA; cB = nB; ++ui;
    }
    PG8_WAIT_V(0);
    if (wr == 0) PG8_BAR;
    PG8_BAR;
#undef PG8_SA
#undef PG8_SB
#undef PG8_STAGE
#undef PG8_LDA
#undef PG8_LDB
#undef PG8_MMA
#undef PG8_WAIT_V
#undef PG8_WAIT_L
#undef PG8_BAR
#undef PG8_SCHED
}
}
using pg8::Unit;

struct EpiProj {
    static constexpr bool PERM = true;
    bf16_t* O; bf16_t* halo;
    DI void operator()(const f32x4 (&acc)[2][2][4][2], const Unit& u, int wr, int wc, int fr, int fq) const {
        const int row0 = u.pm * 256 + wr * 64 + fr, col0 = u.pn * 256 + wc * 32 + 8 * fq;
#pragma unroll
        for (int ai = 0; ai < 2; ++ai)
#pragma unroll
            for (int m = 0; m < 4; ++m) { const int row = row0 + ai * 128 + m * 16; bf16_t* rowp = O + (size_t)row * NPJ + col0;
#pragma unroll
                for (int bj = 0; bj < 2; ++bj) { const f32x4 v0 = acc[ai][bj][m][0], v1 = acc[ai][bj][m][1];
                    u32x4 w; w.x = pk2(v0[0], v0[1]); w.y = pk2(v0[2], v0[3]); w.z = pk2(v1[0], v1[1]); w.w = pk2(v1[2], v1[3]);
                    *(u32x4*)(rowp + bj * 128) = w;
                    if (m == 3 && fr >= 13 && u.pn < 12) *(u32x4*)(halo + ((size_t)((row >> 6) + 1) * 3 + (fr - 13)) * 3072 + col0 + bj * 128) = w; } }
    }
};
struct EpiPlainBf16 {
    static constexpr bool PERM = true;
    bf16_t* O; int ldc;
    DI void operator()(const f32x4 (&acc)[2][2][4][2], const Unit& u, int wr, int wc, int fr, int fq) const {
        const int row0 = u.pm * 256 + wr * 64 + fr, col0 = u.pn * 256 + wc * 32 + 8 * fq;
#pragma unroll
        for (int ai = 0; ai < 2; ++ai)
#pragma unroll
            for (int m = 0; m < 4; ++m) { bf16_t* rowp = O + (size_t)(row0 + ai * 128 + m * 16) * ldc + col0;
#pragma unroll
                for (int bj = 0; bj < 2; ++bj) { const f32x4 v0 = acc[ai][bj][m][0], v1 = acc[ai][bj][m][1];
                    u32x4 w; w.x = pk2(v0[0], v0[1]); w.y = pk2(v0[2], v0[3]); w.z = pk2(v1[0], v1[1]); w.w = pk2(v1[2], v1[3]);
                    *(u32x4*)(rowp + bj * 128) = w; } }
    }
};
struct EpiResid {
    static constexpr bool PERM = false;
    const float* base; float* out; bf16_t* hb; float* ss;
    DI void operator()(const f32x4 (&acc)[2][2][4][2], const Unit& u, int wr, int wc, int fr, int fq) const {
        const int row0 = u.pm * 256 + wr * 64 + fr, col0 = u.pn * 256 + wc * 32 + 4 * fq;
#pragma unroll
        for (int ai = 0; ai < 2; ++ai) { f32x4 bs[4][4];
#pragma unroll
            for (int m = 0; m < 4; ++m)
#pragma unroll
                for (int q = 0; q < 4; ++q) bs[m][q] = *(const f32x4*)(base + (size_t)(row0 + ai * 128 + m * 16) * DM + col0 + (q >> 1) * 128 + (q & 1) * 16);
#pragma unroll
            for (int m = 0; m < 4; ++m) { const int row = row0 + ai * 128 + m * 16; const size_t off = (size_t)row * DM + col0; float s = 0.f;
#pragma unroll
                for (int q = 0; q < 4; ++q) { const f32x4 hv = bs[m][q] + acc[ai][q >> 1][m][q & 1];
                        *(f32x4*)(out + off + (q >> 1) * 128 + (q & 1) * 16) = hv; u32x2 w; w.x = pk2(hv[0], hv[1]); w.y = pk2(hv[2], hv[3]);
                        *(u32x2*)(hb + off + (q >> 1) * 128 + (q & 1) * 16) = w; s += (hv[0] * hv[0] + hv[1] * hv[1]) + (hv[2] * hv[2] + hv[3] * hv[3]); }
                s += __shfl_xor(s, 16); s += __shfl_xor(s, 32);
                if (fq == 0) atomicAdd(ss + row, s); }
            asm volatile("" ::: "memory"); }
    }
};
struct EpiAct {
    static constexpr bool PERM = true;
    bf16_t* O; const float* ss;
    DI void operator()(const f32x4 (&acc)[2][2][4][2], const Unit& u, int wr, int wc, int fr, int fq) const {
        const int row0 = u.pm * 256 + wr * 64 + fr, col0 = u.pn * 128 + wc * 32 + 8 * fq;
        float rs[8];
#pragma unroll
        for (int g = 0; g < 8; ++g) rs[g] = ss[row0 + (g >> 2) * 128 + (g & 3) * 16];
#pragma unroll
        for (int ai = 0; ai < 2; ++ai)
#pragma unroll
            for (int m = 0; m < 4; ++m) { const int row = row0 + ai * 128 + m * 16; const float r = rsqrtf(rs[ai * 4 + m] * (1.f / 2048.f) + 1e-6f);
                float a[8];
#pragma unroll
                for (int n = 0; n < 2; ++n)
#pragma unroll
                    for (int j = 0; j < 4; ++j) { const float gv = r * acc[ai][0][m][n][j], uv = r * acc[ai][1][m][n][j]; a[n * 4 + j] = silu_f(gv) * uv; }
                u32x4 w; w.x = pk2(a[0], a[1]); w.y = pk2(a[2], a[3]); w.z = pk2(a[4], a[5]); w.w = pk2(a[6], a[7]);
                *(u32x4*)(O + (size_t)row * FF + col0) = w; }
    }
};
struct EpiOut {
    static constexpr bool PERM = false;
    float* out; const bf16_t* pp; const float* ss;
    DI void operator()(const f32x4 (&acc)[2][2][4][2], const Unit& u, int wr, int wc, int fr, int fq) const {
        const int row0 = u.pm * 256 + wr * 64 + fr, col0 = u.pn * 256 + wc * 32 + 4 * fq;
        float rs[8];
#pragma unroll
        for (int g = 0; g < 8; ++g) rs[g] = ss[row0 + (g >> 2) * 128 + (g & 3) * 16];
#pragma unroll
        for (int ai = 0; ai < 2; ++ai) { f32x4 hv[4][4]; u32x2 pw[4][4];
#pragma unroll
            for (int m = 0; m < 4; ++m)
#pragma unroll
                for (int q = 0; q < 4; ++q) { const size_t o2 = (size_t)(row0 + ai * 128 + m * 16) * DM + col0 + (q >> 1) * 128 + (q & 1) * 16; hv[m][q] = *(const f32x4*)(out + o2); pw[m][q] = *(const u32x2*)(pp + o2); }
#pragma unroll
            for (int m = 0; m < 4; ++m) { const int row = row0 + ai * 128 + m * 16; const size_t off = (size_t)row * DM + col0; const float r = rsqrtf(rs[ai * 4 + m] * (1.f / 2048.f) + 1e-6f);
#pragma unroll
                for (int q = 0; q < 4; ++q) { const f32x4 a = acc[ai][q >> 1][m][q & 1]; f32x4 o;
                        o[0] = hv[m][q][0] + sigm_f(r * a[0]) * bflo(pw[m][q].x); o[1] = hv[m][q][1] + sigm_f(r * a[1]) * bfhi(pw[m][q].x);
                        o[2] = hv[m][q][2] + sigm_f(r * a[2]) * bflo(pw[m][q].y); o[3] = hv[m][q][3] + sigm_f(r * a[3]) * bfhi(pw[m][q].y);
                        *(f32x4*)(out + off + (q >> 1) * 128 + (q & 1) * 16) = o; } }
            asm volatile("" ::: "memory"); }
    }
};

DI void tconv_tile(const float* __restrict__ src, int ld, int c0, int k0, bf16_t* __restrict__ dst, int dK, int n0, const float* __restrict__ nw, LAS float* tl) {
    const int tid = opq_tid();
    f32x4 v[8];
#pragma unroll
    for (int i = 0; i < 8; ++i) v[i] = *(const f32x4*)(src + (size_t)(k0 + (tid >> 4) + 32 * i) * ld + c0 + (tid & 15) * 4);
#pragma unroll
    for (int i = 0; i < 8; ++i) { const int k = (tid >> 4) + 32 * i; const float sc = nw ? nw[k0 + k] : 1.f;
        LAS float* q = tl + k * 65 + (tid & 15) * 4; q[0] = v[i][0] * sc; q[1] = v[i][1] * sc; q[2] = v[i][2] * sc; q[3] = v[i][3] * sc; }
    __syncthreads();
    { const int n = tid >> 3, kq = (tid & 7) * 8;
#pragma unroll
      for (int j = 0; j < 4; ++j) { const int ks = kq + 64 * j; float f[8];
#pragma unroll
          for (int i = 0; i < 8; ++i) f[i] = tl[(ks + i) * 65 + n];
          u32x4 w; w.x = pk2(f[0], f[1]); w.y = pk2(f[2], f[3]); w.z = pk2(f[4], f[5]); w.w = pk2(f[6], f[7]);
          *(u32x4*)(dst + (size_t)(n0 + n) * dK + k0 + ks) = w; } }
    __syncthreads();
}

DI void phase_prep(const Params& P, LAS unsigned char* lds) {
    unsigned char* ws = P.ws; const int tid = opq_tid(), G = gridDim.x, bx = blockIdx.x;
    const int gtid = bx * NTHREADS + tid, gsz = G * NTHREADS;
    for (int i = gtid; i < (int)((WS_GL - WS_CTL) / 4); i += gsz) ((unsigned*)(ws + WS_CTL))[i] = 0u;
    { bf16_t* wba = (bf16_t*)(ws + WS_WBA); for (int i = gtid; i < 16 * 2048; i += gsz) { const int n = i >> 11, k = i & 2047; wba[i] = f2bf(P.w_in[(size_t)k * INW + 4096 + n]); } }
    { bf16_t* pb = (bf16_t*)(ws + WS_PB); for (int i = gtid; i < MT * 256 / 8; i += gsz) { const f32x4 a = *(const f32x4*)(P.p + (size_t)i * 8), b = *(const f32x4*)(P.p + (size_t)i * 8 + 4);
        u32x4 w; w.x = pk2(a[0], a[1]); w.y = pk2(a[2], a[3]); w.z = pk2(b[0], b[1]); w.w = pk2(b[2], b[3]); *(u32x4*)(pb + (size_t)i * 8) = w; } }
    { bf16_t* xn = (bf16_t*)(ws + WS_R0); const int lane = tid & 63, gw = bx * 8 + (tid >> 6);
      f32x4 wv[8];
#pragma unroll
      for (int i = 0; i < 8; ++i) wv[i] = *(const f32x4*)(P.attn_norm + lane * 4 + i * 256);
      for (int row = gw * 2; row < MT; row += G * 16) { const float* xr = P.x + (size_t)row * DM; f32x4 v[2][8]; float s0 = 0.f, s1 = 0.f;
#pragma unroll
          for (int r = 0; r < 2; ++r)
#pragma unroll
              for (int i = 0; i < 8; ++i) v[r][i] = *(const f32x4*)(xr + (size_t)r * DM + lane * 4 + i * 256);
#pragma unroll
          for (int i = 0; i < 8; ++i) { s0 += (v[0][i][0] * v[0][i][0] + v[0][i][1] * v[0][i][1]) + (v[0][i][2] * v[0][i][2] + v[0][i][3] * v[0][i][3]);
              s1 += (v[1][i][0] * v[1][i][0] + v[1][i][1] * v[1][i][1]) + (v[1][i][2] * v[1][i][2] + v[1][i][3] * v[1][i][3]); }
#pragma unroll
          for (int o = 1; o < 64; o <<= 1) { s0 += __shfl_xor(s0, o); s1 += __shfl_xor(s1, o); }
          const float r0 = rsqrtf(s0 * (1.f / 2048.f) + 1e-6f), r1 = rsqrtf(s1 * (1.f / 2048.f) + 1e-6f);
#pragma unroll
          for (int r = 0; r < 2; ++r)
#pragma unroll
              for (int i = 0; i < 8; ++i) { const float rr = r ? r1 : r0; u32x2 w; w.x = pk2(v[r][i][0] * rr * wv[i][0], v[r][i][1] * rr * wv[i][1]); w.y = pk2(v[r][i][2] * rr * wv[i][2], v[r][i][3] * rr * wv[i][3]);
                  *(u32x2*)(xn + (size_t)(row + r) * DM + lane * 4 + i * 256) = w; } } }
    LAS float* tl = (LAS float*)lds;
    for (int gi = bx; gi < 896; gi += G) { const int nt = gi >> 3, kg = gi & 7, n0 = nt * 64; tconv_tile(P.w_in, INW, n0 < 4096 ? n0 : n0 + 16, kg * 256, (bf16_t*)(ws + WS_WIN), 2048, n0, nullptr, tl); }
}
DI void phase_wconv_late(const Params& P, LAS unsigned char* lds, int wg0, int nwg) {
    unsigned char* ws = P.ws; LAS float* tl = (LAS float*)lds;
    for (int gi = 896 + wg0; gi < 3552; gi += nwg) {
        if (gi < 1152) { const int t2 = gi - 896, nt = t2 >> 3, kg = t2 & 7; tconv_tile(P.w_o, 2048, nt * 64, kg * 256, (bf16_t*)(ws + WS_WO), 2048, nt * 64, nullptr, tl); }
        else if (gi < 2560) { const int t2 = gi - 1152, nt = t2 >> 3, kg = t2 & 7, n0 = nt * 64, pn = n0 >> 8, r = n0 & 255;
            tconv_tile(r < 128 ? P.w_gate : P.w_up, FF, pn * 128 + (r & 127), kg * 256, (bf16_t*)(ws + WS_WGU), 2048, n0, P.ffn_norm, tl); }
        else if (gi < 3264) { const int t2 = gi - 2560, nt = t2 / 22, kg = t2 % 22; tconv_tile(P.w_down, 2048, nt * 64, kg * 256, (bf16_t*)(ws + WS_WDN), FF, nt * 64, nullptr, tl); }
        else if (gi < 3520) { const int t2 = gi - 3264, nt = t2 >> 3, kg = t2 & 7; tconv_tile(P.w_pg, 2048, nt * 64, kg * 256, (bf16_t*)(ws + WS_WPG), 2048, nt * 64, P.ple_norm, tl); }
        else { const int nt = gi - 3520; tconv_tile(P.w_pp, 2048, nt * 64, 0, (bf16_t*)(ws + WS_WPP), 256, nt * 64, nullptr, tl); }
    }
}

DI void phase_ba(const Params& P) {
    const int tid = opq_tid(), lane = tid & 63, fr = lane & 15, fq = lane >> 4, gw = blockIdx.x * 8 + (tid >> 6);
    const bf16_t* xn = (const bf16_t*)(P.ws + WS_R0); const bf16_t* wba = (const bf16_t*)(P.ws + WS_WBA); float* BA = (float*)(P.ws + WS_BA);
    for (int rt = gw; rt < MT / 16; rt += gridDim.x * 8) {
        f32x4 acc = {0.f, 0.f, 0.f, 0.f}; const bf16_t* ap = xn + (size_t)(rt * 16 + fr) * DM + 8 * fq; const bf16_t* bp = wba + fr * 2048 + 8 * fq;
#pragma unroll 8
        for (int ks = 0; ks < 64; ++ks) acc = mfma16(*(const bf16x8*)(ap + 32 * ks), *(const bf16x8*)(bp + 32 * ks), acc);
#pragma unroll
        for (int j = 0; j < 4; ++j) BA[(size_t)(rt * 16 + 4 * fq + j) * 16 + fr] = acc[j];
    }
}

constexpr int G1_QS = 0, G1_KS = 18432, G1_VT = 36864, G1_KT = 57344, G1_SM = 77824, G1_TEAM = 78848;
DI void phase_gdn_prep(const Params& P, LAS unsigned char* lds) {
    const int tid0 = opq_tid(), team = tid0 >> 8;
    LAS unsigned char* L = lds + team * G1_TEAM;
    LAS bf16_t* QS = (LAS bf16_t*)(L + G1_QS); LAS bf16_t* KS = (LAS bf16_t*)(L + G1_KS); LAS bf16_t* VT = (LAS bf16_t*)(L + G1_VT); LAS bf16_t* KT = (LAS bf16_t*)(L + G1_KT);
    LAS float* AF = (LAS float*)(L + G1_QS); LAS bf16_t* TB = (LAS bf16_t*)(L + G1_KS); LAS float* SM = (LAS float*)(L + G1_SM);
    bf16_t* proj = (bf16_t*)(P.ws + WS_R1); const bf16_t* halo = (const bf16_t*)(P.ws + WS_HALO); const float* BA = (const float*)(P.ws + WS_BA);
    bf16_t* W2 = (bf16_t*)(P.ws + WS_W2); bf16_t* QKB = (bf16_t*)(P.ws + WS_QKB); float* GL = (float*)(P.ws + WS_GL);
    for (int pi = blockIdx.x; pi < 2048; pi += gridDim.x) {
        int tid = tid0; asm volatile("" : "+v"(tid));
        const int tt = tid & 255, tw = __builtin_amdgcn_readfirstlane((tid >> 6) & 3), lane = tid & 63, fr = lane & 15, fq = lane >> 4;
        const int ci = pi * 2 + team, h = ci & 7, n = (ci >> 3) & 255, b = ci >> 11, t0 = b * TT + n * 64;
        if (tw == 0) {
            const float bv = BA[(size_t)(t0 + lane) * 16 + h], av = BA[(size_t)(t0 + lane) * 16 + 8 + h];
            const float beta = sigm_f(bv); const float xx = av + P.dt_bias[h]; const float sp = xx > 20.f ? xx : log1pf(__expf(xx));
            const float gg = -__expf(P.A_log[h]) * sp; float gc = gg;
#pragma unroll
            for (int o = 1; o < 64; o <<= 1) { const float v = __shfl_up(gc, o); if (lane >= o) gc += v; }
            const float glast = __shfl(gc, 63);
            SM[lane] = gc; SM[64 + lane] = beta; SM[128 + lane] = __expf(gc); SM[192 + lane] = __expf(glast - gc);
            if (lane == 63) GL[(b * 8 + h) * 256 + n] = __expf(gc);
        }
        __syncthreads();
        { const int r = tt >> 2, cg0 = (tt & 3) * 32; const float beta_r = SM[64 + r], egc_r = SM[128 + r];
#pragma unroll 1
          for (int x = 0; x < 3; ++x) {
              float val[32]; const int colbase = x * 1024 + h * 128 + cg0;
#pragma unroll
              for (int sg = 0; sg < 4; ++sg) { const int col = colbase + sg * 8; u32x4 raw[4];
#pragma unroll
                  for (int j = 0; j < 4; ++j) { const int rr = r - 3 + j; raw[j] = (u32x4){0u, 0u, 0u, 0u};
                      if (rr >= 0) raw[j] = *(const u32x4*)(proj + (size_t)(t0 + rr) * NPJ + col);
                      else if (n > 0) raw[j] = *(const u32x4*)(halo + ((size_t)(t0 >> 6) * 3 + (rr + 3)) * 3072 + col); }
#pragma unroll
                  for (int i = 0; i < 8; ++i) { const f32x4 w4 = *(const f32x4*)(P.conv_w + (size_t)(col + i) * 4); float a = 0.f;
#pragma unroll
                      for (int j = 0; j < 4; ++j) { const unsigned wd = raw[j][i >> 1]; const float xv = (i & 1) ? bfhi(wd) : bflo(wd); a += w4[j] * xv; }
                      val[sg * 8 + i] = silu_f(a); } }
              if (x < 2) { float ss = 0.f;
#pragma unroll
                  for (int i = 0; i < 32; ++i) ss += val[i] * val[i];
                  ss += __shfl_xor(ss, 1); ss += __shfl_xor(ss, 2);
                  const float sc = rsqrtf(ss + 1e-6f) * (x == 0 ? 0.08838834764831845f : 1.f);
#pragma unroll
                  for (int i = 0; i < 32; ++i) val[i] *= sc; }
              if (x < 2) { LAS bf16_t* dst = (x == 0 ? QS : KS) + r * 144 + cg0;
#pragma unroll
                  for (int i = 0; i < 4; ++i) { u32x4 w; w.x = pk2(val[8 * i], val[8 * i + 1]); w.y = pk2(val[8 * i + 2], val[8 * i + 3]); w.z = pk2(val[8 * i + 4], val[8 * i + 5]); w.w = pk2(val[8 * i + 6], val[8 * i + 7]);
                      *(LAS u32x4*)(dst + 8 * i) = w; } }
              if (x == 1) { const float f = beta_r * egc_r;
#pragma unroll
                  for (int i = 0; i < 32; ++i) KT[(cg0 + i) * 80 + r] = f2bf(val[i] * f); }
              if (x == 2) {
#pragma unroll
                  for (int i = 0; i < 32; ++i) VT[(cg0 + i) * 80 + r] = f2bf(val[i] * beta_r); }
          } }
        __syncthreads();
        f32x4 kk[4], qk[4];
#pragma unroll
        for (int nt = 0; nt < 4; ++nt) { kk[nt] = (f32x4){0.f, 0.f, 0.f, 0.f}; qk[nt] = (f32x4){0.f, 0.f, 0.f, 0.f}; }
#pragma unroll
        for (int ks = 0; ks < 4; ++ks) { const bf16x8 ak = *(const LAS bf16x8*)(KS + (16 * tw + fr) * 144 + 32 * ks + 8 * fq), aq = *(const LAS bf16x8*)(QS + (16 * tw + fr) * 144 + 32 * ks + 8 * fq);
#pragma unroll
            for (int nt = 0; nt < 4; ++nt) { const bf16x8 bk = *(const LAS bf16x8*)(KS + (16 * nt + fr) * 144 + 32 * ks + 8 * fq); kk[nt] = mfma16(ak, bk, kk[nt]); qk[nt] = mfma16(aq, bk, qk[nt]); } }
        { const int r = tt >> 2, cg0 = (tt & 3) * 32; const float e = SM[128 + r];
#pragma unroll
          for (int i = 0; i < 4; ++i) { const u32x4 s = *(const LAS u32x4*)(QS + r * 144 + cg0 + 8 * i); u32x4 w;
              w.x = pk2(bflo(s.x) * e, bfhi(s.x) * e); w.y = pk2(bflo(s.y) * e, bfhi(s.y) * e); w.z = pk2(bflo(s.z) * e, bfhi(s.z) * e); w.w = pk2(bflo(s.w) * e, bfhi(s.w) * e);
              *(u32x4*)(proj + (size_t)(t0 + r) * NPJ + OFF_GQ + h * 128 + cg0 + 8 * i) = w; } }
        { const int d = tt >> 1, cb = (tt & 1) * 32;
#pragma unroll
          for (int i4 = 0; i4 < 4; ++i4) { const int c0 = cb + 8 * i4; float f[8];
#pragma unroll
              for (int i = 0; i < 8; ++i) f[i] = bf2f(KS[(c0 + i) * 144 + d]) * SM[192 + c0 + i];
              u32x4 w; w.x = pk2(f[0], f[1]); w.y = pk2(f[2], f[3]); w.z = pk2(f[4], f[5]); w.w = pk2(f[6], f[7]);
              *(u32x4*)(proj + (size_t)(t0 + (d >> 1)) * NPJ + OFF_GK + h * 128 + (d & 1) * 64 + c0) = w; } }
        __syncthreads();
#pragma unroll
        for (int nt = 0; nt < 4; ++nt)
#pragma unroll
            for (int j = 0; j < 4; ++j) { const int c = 16 * tw + 4 * fq + j, s = 16 * nt + fr; const float dec = (s <= c) ? __expf(SM[c] - SM[s]) : 0.f;
                AF[c * 65 + s] = (s < c) ? SM[64 + c] * kk[nt][j] * dec : (s == c ? 1.f : 0.f);
                QKB[(size_t)ci * 4096 + c * 64 + s] = f2bf(qk[nt][j] * dec); }
        __syncthreads();
        { const int bb = tw * 16;
          if (lane < 16) {
              for (int i = 1; i < 16; ++i) { float a0 = 0.f, a1 = 0.f; int j = 0;
                  for (; j + 2 <= i; j += 2) { a0 += AF[(bb + i) * 65 + bb + j] * AF[(bb + j) * 65 + bb + lane]; a1 += AF[(bb + i) * 65 + bb + j + 1] * AF[(bb + j + 1) * 65 + bb + lane]; }
                  if (j < i) a0 += AF[(bb + i) * 65 + bb + j] * AF[(bb + j) * 65 + bb + lane];
                  AF[(bb + i) * 65 + bb + lane] = lane < i ? -(a0 + a1) : (lane == i ? 1.f : 0.f); } }
#pragma unroll
          for (int k = 0; k < 4; ++k) { const int row = bb + fq + 4 * k; TB[row * 80 + bb + fr] = f2bf(AF[row * 65 + bb + fr]);
              for (int jb = tw + 1; jb < 4; ++jb) TB[row * 80 + 16 * jb + fr] = (bf16_t)0; }
          __syncthreads();
          for (int i = 1; i < 4; ++i) {
              if (tw < i) { const int j = tw; f32x4 X = {0.f, 0.f, 0.f, 0.f};
                  for (int k = j; k < i; ++k) {
#pragma unroll
                      for (int kk = 0; kk < 4; ++kk) { const float av = AF[(16 * i + fr) * 65 + 16 * k + 4 * kk + fq];
                          const float bv = (k == j) ? AF[(16 * k + 4 * kk + fq) * 65 + 16 * j + fr] : bf2f(TB[(16 * k + 4 * kk + fq) * 80 + 16 * j + fr]);
                          X = __builtin_amdgcn_mfma_f32_16x16x4f32(av, bv, X, 0, 0, 0); } }
                  f32x4 O = {0.f, 0.f, 0.f, 0.f};
#pragma unroll
                  for (int kk = 0; kk < 4; ++kk) O = __builtin_amdgcn_mfma_f32_16x16x4f32(AF[(16 * i + fr) * 65 + 16 * i + 4 * fq + kk], X[kk], O, 0, 0, 0);
#pragma unroll
                  for (int jj = 0; jj < 4; ++jj) TB[(16 * i + 4 * fq + jj) * 80 + 16 * j + fr] = f2bf(-O[jj]); }
              __syncthreads(); }
        }
        { bf16x8 at[2];
#pragma unroll
          for (int ks = 0; ks < 2; ++ks) at[ks] = *(const LAS bf16x8*)(TB + (16 * tw + fr) * 80 + 32 * ks + 8 * fq);
#pragma unroll
          for (int nt = 0; nt < 8; ++nt) { f32x4 a = {0.f, 0.f, 0.f, 0.f};
#pragma unroll
              for (int ks = 0; ks < 2; ++ks) a = mfma16(at[ks], *(const LAS bf16x8*)(VT + (16 * nt + fr) * 80 + 32 * ks + 8 * fq), a);
              const int e = 16 * nt + fr; u32x2 w; w.x = pk2(a[0], a[1]); w.y = pk2(a[2], a[3]);
              *(u32x2*)(proj + (size_t)(t0 + (e >> 1)) * NPJ + OFF_GV + h * 128 + (e & 1) * 64 + 16 * tw + 4 * fq) = w; }
#pragma unroll
          for (int mt = 0; mt < 8; ++mt) { f32x4 a = {0.f, 0.f, 0.f, 0.f};
#pragma unroll
              for (int ks = 0; ks < 2; ++ks) a = mfma16(*(const LAS bf16x8*)(KT + (16 * mt + fr) * 80 + 32 * ks + 8 * fq), at[ks], a);
              u32x2 w; w.x = pk2(a[0], a[1]); w.y = pk2(a[2], a[3]);
              *(u32x2*)(W2 + (size_t)(t0 + 16 * tw + fr) * 1024 + h * 128 + 16 * mt + 4 * fq) = w; } }
        __syncthreads();
    }
}

DI void phase_moba_prep(const Params& P, LAS unsigned char* lds) {
    const int tid = opq_tid(), lane = tid & 63, wave = tid >> 6, l16 = lane & 15;
    bf16_t* proj = (bf16_t*)(P.ws + WS_R1); float* kmean = (float*)(P.ws + WS_KMEAN);
    LAS bf16_t* VS = (LAS bf16_t*)lds; LAS float* CS = (LAS float*)(lds + 69632);
    for (int task = blockIdx.x; task < 1024; task += gridDim.x) {
        const int h = task & 7, blk = (task >> 3) & 63, b = task >> 9; const size_t rbase = (size_t)(b * TT + blk * 256);
        f32x4 qg0 = *(const f32x4*)(P.q_norm + l16 * 8), qg1 = *(const f32x4*)(P.q_norm + l16 * 8 + 4), kg0 = *(const f32x4*)(P.k_norm + l16 * 8), kg1 = *(const f32x4*)(P.k_norm + l16 * 8 + 4);
        float cs[8];
#pragma unroll
        for (int i = 0; i < 8; ++i) cs[i] = 0.f;
        u32x4 rq[8], rk[8], rv[8];
#pragma unroll
        for (int ps = 0; ps < 8; ++ps) { const int r = ps * 32 + wave * 4 + (lane >> 4); const bf16_t* rp = proj + (rbase + r) * NPJ + h * 128 + l16 * 8;
            rq[ps] = *(const u32x4*)(rp + OFF_MQ); rk[ps] = *(const u32x4*)(rp + OFF_MK); rv[ps] = *(const u32x4*)(rp + OFF_MV); }
#pragma unroll
        for (int ps = 0; ps < 8; ++ps) { const int r = ps * 32 + wave * 4 + (lane >> 4); bf16_t* rp = proj + (rbase + r) * NPJ + h * 128 + l16 * 8;
#pragma unroll
            for (int x = 0; x < 2; ++x) { bf16_t* ptr = rp + (x == 0 ? OFF_MQ : OFF_MK); const u32x4 raw = x == 0 ? rq[ps] : rk[ps]; float v[8];
                v[0] = bflo(raw.x); v[1] = bfhi(raw.x); v[2] = bflo(raw.y); v[3] = bfhi(raw.y); v[4] = bflo(raw.z); v[5] = bfhi(raw.z); v[6] = bflo(raw.w); v[7] = bfhi(raw.w);
                float ss = 0.f;
#pragma unroll
                for (int i = 0; i < 8; ++i) ss += v[i] * v[i];
                ss = row16_sum(ss);
                const float rs = rsqrtf(ss * (1.f / 128.f) + 1e-6f); const f32x4 g0 = x == 0 ? qg0 : kg0, g1 = x == 0 ? qg1 : kg1;
#pragma unroll
                for (int i = 0; i < 4; ++i) { v[i] *= rs * g0[i]; v[4 + i] *= rs * g1[i]; }
                if (x == 1) {
#pragma unroll
                    for (int i = 0; i < 8; ++i) cs[i] += v[i]; }
                u32x4 w; w.x = pk2(v[0], v[1]); w.y = pk2(v[2], v[3]); w.z = pk2(v[4], v[5]); w.w = pk2(v[6], v[7]); *(u32x4*)ptr = w; }
            *(LAS u32x4*)(VS + r * 136 + l16 * 8) = rv[ps]; }
#pragma unroll
        for (int i = 0; i < 8; ++i) { cs[i] += __shfl_xor(cs[i], 16); cs[i] += __shfl_xor(cs[i], 32); }
        if (lane < 16) {
#pragma unroll
            for (int i = 0; i < 8; ++i) CS[wave * 128 + lane * 8 + i] = cs[i]; }
        __syncthreads();
        if (tid < 128) { float s = 0.f;
#pragma unroll
            for (int w = 0; w < 8; ++w) s += CS[w * 128 + tid];
            kmean[((size_t)(b * 8 + h) * 64 + blk) * 128 + tid] = s * (1.f / 256.f); }
#pragma unroll 2
        for (int i8 = 0; i8 < 8; ++i8) { const int pid = tid + i8 * 512, e = pid >> 5, ks = pid & 31; unsigned short f[8];
#pragma unroll
            for (int i = 0; i < 8; ++i) f[i] = VS[(ks * 8 + i) * 136 + e];
            u32x4 w; w.x = f[0] | ((unsigned)f[1] << 16); w.y = f[2] | ((unsigned)f[3] << 16); w.z = f[4] | ((unsigned)f[5] << 16); w.w = f[6] | ((unsigned)f[7] << 16);
            *(u32x4*)(proj + (rbase + 2 * e + (ks >> 4)) * NPJ + OFF_MV + h * 128 + (ks & 15) * 8) = w; }
        __syncthreads();
    }
}

DI void phase_moba_select(const Params& P, LAS unsigned char* lds) {
    const int tid = opq_tid(), qi = tid >> 1, half = tid & 1;
    const bf16_t* proj = (const bf16_t*)(P.ws + WS_R1); const float* kmean = (const float*)(P.ws + WS_KMEAN);
    int* cnt = (int*)(P.ws + WS_CNT); int* list = (int*)(P.ws + WS_LIST); f32x2* ML = (f32x2*)(P.ws + WS_ML);
    LAS float* KM = (LAS float*)lds; LAS int* hist = (LAS int*)(lds + 32768); LAS int* hbase = (LAS int*)(lds + 32768 + 256);
    for (int task = blockIdx.x; task < 1024; task += gridDim.x) {
        const int blk = task & 63, h = (task >> 6) & 7, b = task >> 9; const int bh = b * 8 + h; const int t = blk * 256 + qi; const size_t rid = (size_t)bh * TT + t;
        for (int i = tid; i < blk * 128; i += NTHREADS) KM[i] = kmean[(size_t)bh * 64 * 128 + i];
        if (tid < 64) hist[tid] = 0;
        float q[64];
        { const bf16_t* qp = proj + (size_t)(b * TT + t) * NPJ + OFF_MQ + h * 128 + half * 64;
#pragma unroll
          for (int i = 0; i < 8; ++i) { const u32x4 raw = *(const u32x4*)(qp + 8 * i); q[8 * i] = bflo(raw.x); q[8 * i + 1] = bfhi(raw.x); q[8 * i + 2] = bflo(raw.y); q[8 * i + 3] = bfhi(raw.y);
              q[8 * i + 4] = bflo(raw.z); q[8 * i + 5] = bfhi(raw.z); q[8 * i + 6] = bflo(raw.w); q[8 * i + 7] = bfhi(raw.w); } }
        __syncthreads();
        float v0 = -INFINITY, v1 = -INFINITY, v2 = -INFINITY; int i0 = -1, i1 = -1, i2 = -1;
        for (int n = 0; n < blk; ++n) { const LAS float* km = KM + n * 128 + half * 64; float d0 = 0.f, d1 = 0.f, d2 = 0.f, d3 = 0.f;
#pragma unroll
            for (int i = 0; i < 16; ++i) { const f32x4 kv = *(const LAS f32x4*)(km + 4 * i); d0 += q[4 * i] * kv[0]; d1 += q[4 * i + 1] * kv[1]; d2 += q[4 * i + 2] * kv[2]; d3 += q[4 * i + 3] * kv[3]; }
            float g = (d0 + d1) + (d2 + d3); g += __shfl_xor(g, 1);
            if (g > v0) { v2 = v1; i2 = i1; v1 = v0; i1 = i0; v0 = g; i0 = n; } else if (g > v1) { v2 = v1; i2 = i1; v1 = g; i1 = n; } else if (g > v2) { v2 = g; i2 = n; } }
        int rk0 = 0, rk1 = 0, rk2 = 0;
        if (half == 0) { if (i0 >= 0) rk0 = __hip_atomic_fetch_add(&hist[i0], 1, __ATOMIC_RELAXED, __HIP_MEMORY_SCOPE_WORKGROUP); if (i1 >= 0) rk1 = __hip_atomic_fetch_add(&hist[i1], 1, __ATOMIC_RELAXED, __HIP_MEMORY_SCOPE_WORKGROUP); if (i2 >= 0) rk2 = __hip_atomic_fetch_add(&hist[i2], 1, __ATOMIC_RELAXED, __HIP_MEMORY_SCOPE_WORKGROUP); }
        __syncthreads();
        if (tid < 64) { const int c = hist[tid]; hbase[tid] = c > 0 ? atomicAdd(&cnt[bh * 64 + tid], c) : 0; }
        __syncthreads();
        if (half == 0) {
            const f32x2 dead = {-INFINITY, 0.f};
            if (i0 >= 0) list[(size_t)bh * LISTN + i0 * 16384 - 128 * i0 * (i0 + 1) + hbase[i0] + rk0] = t; else ML[0 * 262144 + rid] = dead;
            if (i1 >= 0) list[(size_t)bh * LISTN + i1 * 16384 - 128 * i1 * (i1 + 1) + hbase[i1] + rk1] = t | (1 << 14); else ML[1 * 262144 + rid] = dead;
            if (i2 >= 0) list[(size_t)bh * LISTN + i2 * 16384 - 128 * i2 * (i2 + 1) + hbase[i2] + rk2] = t | (2 << 14); else ML[2 * 262144 + rid] = dead;
        }
        __syncthreads();
    }
}

constexpr int G2_W = 0, G2_Q = 18432, G2_QK = 36864, G2_KD = 47104, G2_BUF = 67584, G2_RED = 135168;
DI void phase_gdn_scan(const Params& P, LAS unsigned char* lds, int bh) {
    const int tid = opq_tid(), lane = tid & 63, w = tid >> 6, fr = lane & 15, fq = lane >> 4, b = bh >> 3, h = bh & 7;
    const bf16_t* proj = (const bf16_t*)(P.ws + WS_R1); const bf16_t* W2 = (const bf16_t*)(P.ws + WS_W2); const bf16_t* QKB = (const bf16_t*)(P.ws + WS_QKB);
    const float* GL = (const float*)(P.ws + WS_GL); bf16_t* mix = (bf16_t*)(P.ws + WS_R2);
    float* SSQ = (float*)(P.ws + WS_SSQ);
    const int e = 16 * w + fr; const float gnw = P.gdn_norm[e];
    f32x4 S[8];
#pragma unroll
    for (int i = 0; i < 8; ++i) S[i] = (f32x4){0.f, 0.f, 0.f, 0.f};
    const int wrow0 = tid >> 4, wseg = tid & 15;
    const int qrow = tid >> 3, qseg = tid & 7;
    struct Stage { u32x4 sw[2], sq[2], sqk, skd[2]; };
    u32x2 un[4];
    Stage stA, stB;
#define G2_LOAD(X, nn) do { const int t0_ = b * TT + (nn) * 64; const int ci_ = ((b * 256 + (nn)) << 3) + h; \
        _Pragma("unroll") for (int i_ = 0; i_ < 2; ++i_) { X.sw[i_] = *(const u32x4*)(W2 + (size_t)(t0_ + wrow0 + 32 * i_) * 1024 + h * 128 + wseg * 8); \
            X.sq[i_] = *(const u32x4*)(proj + (size_t)(t0_ + wrow0 + 32 * i_) * NPJ + OFF_GQ + h * 128 + wseg * 8); \
            const int d_ = qrow + 64 * i_; X.skd[i_] = *(const u32x4*)(proj + (size_t)(t0_ + (d_ >> 1)) * NPJ + OFF_GK + h * 128 + (d_ & 1) * 64 + qseg * 8); } \
        X.sqk = *(const u32x4*)(QKB + (size_t)ci_ * 4096 + qrow * 64 + qseg * 8); } while (0)
#define UN_LOAD(nn) do { const int t0_ = b * TT + (nn) * 64; _Pragma("unroll") for (int mt_ = 0; mt_ < 4; ++mt_) un[mt_] = *(const u32x2*)(proj + (size_t)(t0_ + (e >> 1)) * NPJ + OFF_GV + h * 128 + (e & 1) * 64 + 16 * mt_ + 4 * fq); } while (0)
#define G2_ST2(base_, rowoff_, sg_, v_) do { const int g_ = ((sg_) >> 2) * 64, d_ = ((sg_) & 3) * 8; \
        *(LAS u32x2*)(B_ + (base_) + (rowoff_) + g_ + perm4(d_) * 2) = (u32x2){(v_).x, (v_).y}; *(LAS u32x2*)(B_ + (base_) + (rowoff_) + g_ + perm4(d_ + 4) * 2) = (u32x2){(v_).z, (v_).w}; } while (0)
#define G2_STORE(X, bufi) do { LAS unsigned char* B_ = lds + (bufi) * G2_BUF; \
        _Pragma("unroll") for (int i_ = 0; i_ < 2; ++i_) { G2_ST2(G2_W, (wrow0 + 32 * i_) * 288, wseg, X.sw[i_]); G2_ST2(G2_Q, (wrow0 + 32 * i_) * 288, wseg, X.sq[i_]); \
            G2_ST2(G2_KD, (qrow + 64 * i_) * 160, qseg, X.skd[i_]); } \
        G2_ST2(G2_QK, qrow * 160, qseg, X.sqk); } while (0)
    G2_LOAD(stA, 0); G2_STORE(stA, 0); UN_LOAD(0);
    float egl_n = GL[bh * 256];
    u32x2 uc[4];
#pragma unroll
    for (int i = 0; i < 4; ++i) uc[i] = un[i];
    G2_LOAD(stA, 1);
    __syncthreads();
    for (int n2 = 0; n2 < 256; n2 += 2) {
#pragma unroll
      for (int hf2 = 0; hf2 < 2; ++hf2) {
        const int n = n2 + hf2; Stage& LDs = hf2 ? stA : stB; Stage& STs = hf2 ? stB : stA;
        const int cur = hf2, t0 = b * TT + n * 64; LAS unsigned char* Bf = lds + cur * G2_BUF;
        { const int n2c = n + 2 < 256 ? n + 2 : 255, n1c = n + 1 < 256 ? n + 1 : 255; G2_LOAD(LDs, n2c); UN_LOAD(n1c); }
        const float egl = egl_n; egl_n = GL[bh * 256 + (n + 1 < 256 ? n + 1 : 255)];
        f32x4 Pm[4], Om[4];
#pragma unroll
        for (int mt = 0; mt < 4; ++mt) { Pm[mt] = (f32x4){0.f, 0.f, 0.f, 0.f}; Om[mt] = (f32x4){0.f, 0.f, 0.f, 0.f}; }
#define SBAR __builtin_amdgcn_sched_barrier(0)
#define LD_X4(dst, base_, mp_, hf_) do { const int o0_ = (16 * (2 * (mp_)) + fr) * 288 + (64 * (hf_) + 8 * fq) * 2; \
        dst[0] = *(const LAS bf16x8*)(Bf + base_ + o0_); dst[1] = *(const LAS bf16x8*)(Bf + base_ + o0_ + 4608); \
        dst[2] = *(const LAS bf16x8*)(Bf + base_ + o0_ + 64); dst[3] = *(const LAS bf16x8*)(Bf + base_ + o0_ + 4608 + 64); } while (0)
#define MM_X4(src, A0_, A1_) do { A0_ = mfma16(src[0], sb0, A0_); A1_ = mfma16(src[1], sb0, A1_); A0_ = mfma16(src[2], sb1, A0_); A1_ = mfma16(src[3], sb1, A1_); } while (0)
#define LD_PAIR(dst, base_, p_) do { const int o0_ = (16 * (2 * (p_)) + fr) * 160 + (8 * fq) * 2; \
        dst[0] = *(const LAS bf16x8*)(Bf + base_ + o0_); dst[1] = *(const LAS bf16x8*)(Bf + base_ + o0_ + 2560); \
        dst[2] = *(const LAS bf16x8*)(Bf + base_ + o0_ + 64); dst[3] = *(const LAS bf16x8*)(Bf + base_ + o0_ + 2560 + 64); } while (0)
#define MM_PAIR(src, A0_, A1_) do { A0_ = mfma16(src[0], Vb[0], A0_); A1_ = mfma16(src[1], Vb[0], A1_); A0_ = mfma16(src[2], Vb[1], A0_); A1_ = mfma16(src[3], Vb[1], A1_); } while (0)
        bf16x8 fa[4], fb[4];
        LD_X4(fa, G2_W, 0, 0);
        { const bf16x8 sb0 = pack8(S[0], S[1]), sb1 = pack8(S[2], S[3]);
          LD_X4(fb, G2_W, 1, 0); SBAR; MM_X4(fa, Pm[0], Pm[1]); SBAR;
          LD_X4(fa, G2_W, 0, 1); SBAR; MM_X4(fb, Pm[2], Pm[3]); SBAR; }
        { const bf16x8 sb0 = pack8(S[4], S[5]), sb1 = pack8(S[6], S[7]);
          LD_X4(fb, G2_W, 1, 1); SBAR; MM_X4(fa, Pm[0], Pm[1]); SBAR;
          LD_X4(fa, G2_Q, 0, 0); SBAR; MM_X4(fb, Pm[2], Pm[3]); SBAR; }
        f32x4 vn[4];
#pragma unroll
        for (int mt = 0; mt < 4; ++mt) { vn[mt][0] = bflo(uc[mt].x) - Pm[mt][0]; vn[mt][1] = bfhi(uc[mt].x) - Pm[mt][1]; vn[mt][2] = bflo(uc[mt].y) - Pm[mt][2]; vn[mt][3] = bfhi(uc[mt].y) - Pm[mt][3]; }
        bf16x8 Vb[2];
#pragma unroll
        for (int k2 = 0; k2 < 2; ++k2) Vb[k2] = pack8(vn[2 * k2], vn[2 * k2 + 1]);
        { const bf16x8 sb0 = pack8(S[0], S[1]), sb1 = pack8(S[2], S[3]);
          LD_X4(fb, G2_Q, 1, 0); SBAR; MM_X4(fa, Om[0], Om[1]); SBAR;
          LD_X4(fa, G2_Q, 0, 1); SBAR; MM_X4(fb, Om[2], Om[3]); SBAR; }
        { const bf16x8 sb0 = pack8(S[4], S[5]), sb1 = pack8(S[6], S[7]);
          LD_X4(fb, G2_Q, 1, 1); SBAR; MM_X4(fa, Om[0], Om[1]); SBAR;
          LD_PAIR(fa, G2_QK, 0); SBAR; MM_X4(fb, Om[2], Om[3]); SBAR; }
#pragma unroll
        for (int dt = 0; dt < 8; ++dt) S[dt] = S[dt] * egl;
        SBAR;
        LD_PAIR(fb, G2_QK, 1); SBAR; MM_PAIR(fa, Om[0], Om[1]); SBAR;
        LD_PAIR(fa, G2_KD, 0); SBAR; MM_PAIR(fb, Om[2], Om[3]); SBAR;
        LD_PAIR(fb, G2_KD, 1); SBAR; MM_PAIR(fa, S[0], S[1]); SBAR;
        LD_PAIR(fa, G2_KD, 2); SBAR; MM_PAIR(fb, S[2], S[3]); SBAR;
        LD_PAIR(fb, G2_KD, 3); SBAR; MM_PAIR(fa, S[4], S[5]); SBAR;
        MM_PAIR(fb, S[6], S[7]); SBAR;
#undef LD_X4
#undef MM_X4
#undef LD_PAIR
#undef MM_PAIR
#undef SBAR
        { G2_STORE(STs, cur ^ 1);
#pragma unroll
            for (int i = 0; i < 4; ++i) uc[i] = un[i]; }
        { float mine = 0.f;
#pragma unroll
          for (int mt = 0; mt < 4; ++mt)
#pragma unroll
            for (int j = 0; j < 4; ++j) { const float s2 = row16_sum(Om[mt][j] * Om[mt][j]);
                mine = (fr == mt * 4 + j) ? s2 : mine; }
          { float* sp_ = SSQ + (size_t)(t0 + 16 * (fr >> 2) + 4 * fq + (fr & 3)) * 64 + h * 8 + w; asm volatile("global_store_dword %0, %1, off" :: "v"(sp_), "v"(mine) : "memory"); } }
        { LAS bf16_t* OTW = (LAS bf16_t*)(lds + G2_RED + w * 2048);
#pragma unroll
          for (int mt = 0; mt < 4; ++mt)
#pragma unroll
            for (int j = 0; j < 4; ++j) OTW[(16 * mt + 4 * fq + j) * 16 + fr] = f2bf(Om[mt][j] * gnw);
#pragma unroll
          for (int i = 0; i < 2; ++i) { const int row = (lane >> 1) + 32 * i, hv = lane & 1;
              bf16_t* mp_ = mix + (size_t)(t0 + row) * DM + h * 128 + 16 * w + 8 * hv; const u32x4 ov_ = *(const LAS u32x4*)(OTW + row * 16 + hv * 8);
              asm volatile("global_store_dwordx4 %0, %1, off" :: "v"(mp_), "v"(ov_) : "memory"); } }
        __syncthreads();
      }
    }
#undef G2_LOAD
#undef UN_LOAD
#undef G2_STORE
#undef G2_ST2
    __syncthreads();
}

constexpr int AT_KS = 0, AT_VT = 73728, AT_PF = 143360, AT_MISC = 147712;
DI void phase_moba_attn(const Params& P, LAS unsigned char* lds) {
    const int tid = opq_tid(), lane = tid & 63, w = tid >> 6, fr = lane & 15, fq = lane >> 4;
    const bf16_t* proj = (const bf16_t*)(P.ws + WS_R1); const int* cnt = (const int*)(P.ws + WS_CNT); const int* list = (const int*)(P.ws + WS_LIST);
    f32x2* ML = (f32x2*)(P.ws + WS_ML); bf16_t* opart = (bf16_t*)P.out; unsigned* workctr = (unsigned*)(P.ws + WS_CTL);
    LAS bf16_t* KS = (LAS bf16_t*)(lds + AT_KS); LAS bf16_t* VT = (LAS bf16_t*)(lds + AT_VT); LAS int* PF = (LAS int*)(lds + AT_PF); LAS int* MISC = (LAS int*)(lds + AT_MISC);
    { const int c0 = cnt[2 * tid], c1 = cnt[2 * tid + 1]; const int a = (c0 + 511) >> 9, bsum = a + ((c1 + 511) >> 9); int inc = bsum;
#pragma unroll
      for (int o = 1; o < 64; o <<= 1) { const int v = __shfl_up(inc, o); if (lane >= o) inc += v; }
      if (lane == 63) MISC[8 + w] = inc;
      __syncthreads();
      int wb = 0;
#pragma unroll
      for (int i = 0; i < 8; ++i) wb += (i < w) ? MISC[8 + i] : 0;
      const int ex = wb + inc - bsum; PF[2 * tid] = ex; PF[2 * tid + 1] = ex + a; if (tid == 511) PF[1024] = ex + bsum;
      __syncthreads(); }
    const int totalG = PF[1024];
    const float sc2 = 0.08838834764831845f * 1.4426950408889634f;
    const int tid_at = tid;
    for (;;) {
        int tid = tid_at; asm volatile("" : "+v"(tid)); const int lane = tid & 63, w = __builtin_amdgcn_readfirstlane(tid >> 6), fr = lane & 15, fq = lane >> 4;
        if (tid == 0) MISC[0] = (int)atomicAdd(workctr, 1u);
        __syncthreads();
        const int wid = MISC[0];
        __syncthreads();
        if (wid >= totalG + 1024) break;
        int bh, j, causal, qstart, qcount;
        if (wid < totalG) { int lo = 0, hi = 1024; while (hi - lo > 1) { const int mid = (lo + hi) >> 1; if (PF[mid] <= wid) lo = mid; else hi = mid; }
            bh = lo >> 6; j = lo & 63; causal = 0; qstart = (wid - PF[lo]) * 512; const int c = cnt[lo]; qcount = c - qstart; if (qcount > 512) qcount = 512; }
        else { const int o = wid - totalG; bh = o >> 6; j = o & 63; causal = 1; qstart = 0; qcount = 256; }
        const int b = bh >> 3, h = bh & 7; const size_t kbase = (size_t)(b * TT + j * 256);
        { u32x4 kr[8], vr[8];
#pragma unroll
          for (int i8 = 0; i8 < 8; ++i8) { const int pid = tid + i8 * 512; kr[i8] = *(const u32x4*)(proj + (kbase + (pid >> 4)) * NPJ + OFF_MK + h * 128 + (pid & 15) * 8);
              const int e = pid >> 5, ks = pid & 31; vr[i8] = *(const u32x4*)(proj + (kbase + 2 * e + (ks >> 4)) * NPJ + OFF_MV + h * 128 + (ks & 15) * 8); }
#pragma unroll
          for (int i8 = 0; i8 < 8; ++i8) { const int pid = tid + i8 * 512; *(LAS u32x4*)(KS + (pid >> 4) * 144 + (pid & 15) * 8) = kr[i8];
              const int e = pid >> 5, ks = pid & 31; const int g_ = (ks >> 2) * 32, d_ = (ks & 3) * 8;
              *(LAS u32x2*)(VT + e * 272 + g_ + perm4(d_)) = (u32x2){vr[i8].x, vr[i8].y}; *(LAS u32x2*)(VT + e * 272 + g_ + perm4(d_ + 4)) = (u32x2){vr[i8].z, vr[i8].w}; } }
        const int lbase = bh * LISTN + j * 16384 - 128 * j * (j + 1) + qstart;
        const int ntile = (qcount + 127) >> 7;
        int en0, en1, en2, en3;
        { const int q0 = 16 * w + fr, lim = qcount - 1;
          if (causal) { en0 = (j * 256 + q0) | (3 << 14); en1 = (j * 256 + q0 + 128) | (3 << 14); en2 = en1; en3 = en1; }
          else { en0 = list[lbase + (q0 < lim ? q0 : lim)]; en1 = list[lbase + (q0 + 128 < lim ? q0 + 128 : lim)]; en2 = list[lbase + (q0 + 256 < lim ? q0 + 256 : lim)]; en3 = list[lbase + (q0 + 384 < lim ? q0 + 384 : lim)]; } }
        bf16x8 Bq[4], Bn[4];
        { const bf16_t* qp = proj + (size_t)(b * TT + (en0 & 16383)) * NPJ + OFF_MQ + h * 128 + 8 * fq;
#pragma unroll
          for (int ks = 0; ks < 4; ++ks) Bq[ks] = *(const bf16x8*)(qp + 32 * ks); }
        __syncthreads();
        for (int tile = 0; tile < ntile; ++tile) {
            const int en = tile == 0 ? en0 : (tile == 1 ? en1 : (tile == 2 ? en2 : en3));
            { const int enx = tile == 0 ? en1 : (tile == 1 ? en2 : en3); const bf16_t* qp = proj + (size_t)(b * TT + (enx & 16383)) * NPJ + OFF_MQ + h * 128 + 8 * fq;
#pragma unroll
              for (int ks = 0; ks < 4; ++ks) Bn[ks] = *(const bf16x8*)(qp + 32 * ks); }
            const int qi = tile * 128 + 16 * w + fr; const bool valid = qi < qcount; const int t = en & 16383, slot = en >> 14;
            if (tile * 128 + 16 * w < qcount) {
            const int nkt = causal ? (8 * tile + w + 1) : 16;
            f32x4 st[16]; float mx = -INFINITY;
#pragma unroll
            for (int kp = 0; kp < 8; ++kp) { f32x4 a0 = {0.f, 0.f, 0.f, 0.f}, a1 = {0.f, 0.f, 0.f, 0.f};
                if (2 * kp < nkt) { bf16x8 kf[8];
#pragma unroll
                    for (int ks = 0; ks < 4; ++ks) { kf[ks] = *(const LAS bf16x8*)(KS + (32 * kp + fr) * 144 + 32 * ks + 8 * fq); kf[4 + ks] = *(const LAS bf16x8*)(KS + (32 * kp + 16 + fr) * 144 + 32 * ks + 8 * fq); }
#pragma unroll
                    for (int ks = 0; ks < 4; ++ks) { a0 = mfma16(kf[ks], Bq[ks], a0); a1 = mfma16(kf[4 + ks], Bq[ks], a1); }
#pragma unroll
                    for (int jj = 0; jj < 4; ++jj) { float s0 = a0[jj] * sc2, s1 = a1[jj] * sc2;
                        if (causal && (32 * kp + 4 * fq + jj) > qi) s0 = -INFINITY; if ((causal && (32 * kp + 16 + 4 * fq + jj) > qi) || 2 * kp + 1 >= nkt) s1 = -INFINITY;
                        a0[jj] = s0; a1[jj] = s1; mx = fmaxf(mx, fmaxf(s0, s1)); }
                } else { a0 = (f32x4){-INFINITY, -INFINITY, -INFINITY, -INFINITY}; a1 = a0; }
                st[2 * kp] = a0; st[2 * kp + 1] = a1; }
            mx = fmaxf(mx, __shfl_xor(mx, 16)); mx = fmaxf(mx, __shfl_xor(mx, 32));
            float ls = 0.f;
#pragma unroll
            for (int kt = 0; kt < 16; ++kt)
#pragma unroll
                for (int jj = 0; jj < 4; ++jj) { const float pv = exp2f(st[kt][jj] - mx); st[kt][jj] = pv; ls += pv; }
            ls += __shfl_xor(ls, 16); ls += __shfl_xor(ls, 32);
            f32x4 ot[8];
#pragma unroll
            for (int et = 0; et < 8; ++et) ot[et] = (f32x4){0.f, 0.f, 0.f, 0.f};
#pragma unroll
            for (int k2 = 0; k2 < 8; ++k2) { if (2 * k2 < nkt) { const bf16x8 pb = pack8(st[2 * k2], st[2 * k2 + 1]);
#pragma unroll
                    for (int eh = 0; eh < 2; ++eh) { bf16x8 vf[4];
#pragma unroll
                        for (int et = 0; et < 4; ++et) vf[et] = *(const LAS bf16x8*)(VT + (16 * (4 * eh + et) + fr) * 272 + 32 * k2 + 8 * fq);
#pragma unroll
                        for (int et = 0; et < 4; ++et) ot[4 * eh + et] = mfma16(vf[et], pb, ot[4 * eh + et]); } } }
            if (valid) { const float il = 1.f / ls; const size_t rid = (size_t)bh * TT + t; bf16_t* op = opart + ((size_t)slot * 262144 + rid) * 128 + 4 * fq;
#pragma unroll
                for (int et = 0; et < 8; ++et) { u32x2 wv; wv.x = pk2(ot[et][0] * il, ot[et][1] * il); wv.y = pk2(ot[et][2] * il, ot[et][3] * il); *(u32x2*)(op + 16 * et) = wv; }
                if (fq == 0) ML[(size_t)slot * 262144 + rid] = (f32x2){mx, ls}; }
            }
#pragma unroll
            for (int ks = 0; ks < 4; ++ks) Bq[ks] = Bn[ks];
        }
        __syncthreads();
    }
}

DI void phase_moba_combine(const Params& P) {
    const bf16_t* opart = (const bf16_t*)P.out; const f32x2* ML = (const f32x2*)(P.ws + WS_ML); bf16_t* mix = (bf16_t*)(P.ws + WS_R2);
    const int gtid = blockIdx.x * NTHREADS + opq_tid(), gsz = gridDim.x * NTHREADS;
    { const bf16_t* proj = (const bf16_t*)(P.ws + WS_R1); const float* SSQ = (const float*)(P.ws + WS_SSQ);
      for (int i = gtid; i < MT * 128; i += gsz) { const int row = i >> 7, sg = i & 127; bf16_t* mp = mix + (size_t)row * DM + sg * 8; const u32x4 mv = *(const u32x4*)mp, zv = *(const u32x4*)(proj + (size_t)row * NPJ + OFF_GZ + sg * 8);
          const f32x4 p0 = *(const f32x4*)(SSQ + (size_t)row * 64 + (sg >> 4) * 8), p1 = *(const f32x4*)(SSQ + (size_t)row * 64 + (sg >> 4) * 8 + 4);
          const float rs = rsqrtf((((p0[0] + p0[1]) + (p0[2] + p0[3])) + ((p1[0] + p1[1]) + (p1[2] + p1[3]))) * (1.f / 128.f) + 1e-6f);
          u32x4 wv; wv.x = pk2(bflo(mv.x) * rs * silu_f(bflo(zv.x)), bfhi(mv.x) * rs * silu_f(bfhi(zv.x))); wv.y = pk2(bflo(mv.y) * rs * silu_f(bflo(zv.y)), bfhi(mv.y) * rs * silu_f(bfhi(zv.y)));
          wv.z = pk2(bflo(mv.z) * rs * silu_f(bflo(zv.z)), bfhi(mv.z) * rs * silu_f(bfhi(zv.z))); wv.w = pk2(bflo(mv.w) * rs * silu_f(bflo(zv.w)), bfhi(mv.w) * rs * silu_f(bfhi(zv.w))); *(u32x4*)mp = wv; } }
    for (int i = gtid; i < 262144 * 16; i += gsz) { const int rid = i >> 4, sg = i & 15; const int bh = rid >> 14, t = rid & 16383, b = bh >> 3, h = bh & 7;
        f32x2 ml[4]; float M = -INFINITY;
#pragma unroll
        for (int s = 0; s < 4; ++s) { ml[s] = ML[(size_t)s * 262144 + rid]; M = fmaxf(M, ml[s].x); }
        float wgt[4], Lt = 0.f;
#pragma unroll
        for (int s = 0; s < 4; ++s) { wgt[s] = ml[s].y > 0.f ? ml[s].y * exp2f(ml[s].x - M) : 0.f; Lt += wgt[s]; }
        const float iL = 1.f / Lt; float o[8];
#pragma unroll
        for (int k = 0; k < 8; ++k) o[k] = 0.f;
#pragma unroll
        for (int s = 0; s < 4; ++s) { if (wgt[s] > 0.f) { const u32x4 raw = *(const u32x4*)(opart + ((size_t)s * 262144 + rid) * 128 + sg * 8); const float ww = wgt[s] * iL;
                o[0] += ww * bflo(raw.x); o[1] += ww * bfhi(raw.x); o[2] += ww * bflo(raw.y); o[3] += ww * bfhi(raw.y); o[4] += ww * bflo(raw.z); o[5] += ww * bfhi(raw.z); o[6] += ww * bflo(raw.w); o[7] += ww * bfhi(raw.w); } }
        u32x4 wv; wv.x = pk2(o[0], o[1]); wv.y = pk2(o[2], o[3]); wv.z = pk2(o[4], o[5]); wv.w = pk2(o[6], o[7]);
        *(u32x4*)(mix + (size_t)(b * TT + t) * DM + 1024 + h * 128 + sg * 8) = wv; }
}

__global__ void __launch_bounds__(NTHREADS) hybrid_fwd(Params P) {
    extern __shared__ __attribute__((aligned(16))) unsigned char smem[];
    LAS unsigned char* lds = (LAS unsigned char*)smem;
    cg::grid_group grid = cg::this_grid();
    unsigned char* ws = P.ws; const int G = gridDim.x, bx = blockIdx.x;
    bf16_t* R0 = (bf16_t*)(ws + WS_R0); bf16_t* R1 = (bf16_t*)(ws + WS_R1); bf16_t* R2 = (bf16_t*)(ws + WS_R2);
    float* ss1 = (float*)(ws + WS_SS1); float* ss2 = (float*)(ws + WS_SS2);

    phase_prep(P, lds);
    grid.sync();
    { pg8::Gemm g{R0, (const bf16_t*)(ws + WS_WIN), MT, NPJ, DM}; pg8::StaticOrder S; S.init(MT, NPJ, G, bx); EpiProj E{R1, (bf16_t*)(ws + WS_HALO)}; pg8::gemm_phase(lds, g, S, E); }
    phase_ba(P);
    grid.sync();
    phase_gdn_prep(P, lds);
    phase_moba_prep(P, lds);
    grid.sync();
    phase_moba_select(P, lds);
    grid.sync();
    if (bx < 16) phase_gdn_scan(P, lds, bx);
    phase_moba_attn(P, lds);
    if (bx >= 16) phase_wconv_late(P, lds, bx - 16, G - 16);
    grid.sync();
    phase_moba_combine(P);
    grid.sync();
    { pg8::Gemm g{R2, (const bf16_t*)(ws + WS_WO), MT, DM, DM}; pg8::StaticOrder S; S.init(MT, DM, G, bx); EpiResid E{P.x, P.out, R0, ss1}; pg8::gemm_phase(lds, g, S, E); }
    grid.sync();
    { pg8::Gemm g{R0, (const bf16_t*)(ws + WS_WGU), MT, 2 * FF, DM}; pg8::StaticOrder S; S.init(MT, 2 * FF, G, bx); EpiAct E{R1, ss1}; pg8::gemm_phase(lds, g, S, E); }
    grid.sync();
    { pg8::Gemm g{(const bf16_t*)(ws + WS_PB), (const bf16_t*)(ws + WS_WPP), MT, DM, 256}; pg8::StaticOrder S; S.init(MT, DM, G, bx); EpiPlainBf16 E{R0, DM}; pg8::gemm_phase(lds, g, S, E); }
    { pg8::Gemm g{R1, (const bf16_t*)(ws + WS_WDN), MT, DM, FF}; pg8::StaticOrder S; S.init(MT, DM, G, bx); EpiResid E{P.out, P.out, R2, ss2}; pg8::gemm_phase(lds, g, S, E); }
    grid.sync();
    { pg8::Gemm g{R2, (const bf16_t*)(ws + WS_WPG), MT, DM, DM}; pg8::StaticOrder S; S.init(MT, DM, G, bx); EpiOut E{P.out, R0, ss2}; pg8::gemm_phase(lds, g, S, E); }
}

extern "C" void kernel_launch(void* const* d_in, const int* in_sizes, int n_in, void* d_out, int out_size, void* d_ws, size_t ws_size, hipStream_t stream) {
    static int grid_blocks = 0;
    if (!grid_blocks) {
        int dev = 0, cus = 0, per_cu = 0;
        hipGetDevice(&dev);
        hipDeviceGetAttribute(&cus, hipDeviceAttributeMultiprocessorCount, dev);
        hipFuncSetAttribute((const void*)hybrid_fwd, hipFuncAttributeMaxDynamicSharedMemorySize, LDS_BYTES);
        hipOccupancyMaxActiveBlocksPerMultiprocessor(&per_cu, (const void*)hybrid_fwd, NTHREADS, LDS_BYTES);
        if (per_cu < 1) per_cu = 1;
        grid_blocks = cus * per_cu;
        if (ws_size < WS_END) fprintf(stderr, "kernel_launch: workspace too small: %zu < %zu\n", ws_size, (size_t)WS_END);
    }
    Params p{};
    p.x = (const float*)d_in[0]; p.p = (const float*)d_in[1]; p.attn_norm = (const float*)d_in[2]; p.w_in = (const float*)d_in[3]; p.conv_w = (const float*)d_in[4];
    p.A_log = (const float*)d_in[5]; p.dt_bias = (const float*)d_in[6]; p.gdn_norm = (const float*)d_in[7]; p.q_norm = (const float*)d_in[8]; p.k_norm = (const float*)d_in[9];
    p.w_o = (const float*)d_in[10]; p.ffn_norm = (const float*)d_in[11]; p.w_gate = (const float*)d_in[12]; p.w_up = (const float*)d_in[13]; p.w_down = (const float*)d_in[14];
    p.ple_norm = (const float*)d_in[15]; p.w_pg = (const float*)d_in[16]; p.w_pp = (const float*)d_in[17];
    p.out = (float*)d_out; p.ws = (unsigned char*)d_ws;
    void* args[] = {&p};
    hipError_t e = hipLaunchCooperativeKernel((const void*)hybrid_fwd, dim3(grid_blocks), dim3(NTHREADS), args, LDS_BYTES, stream);
    if (e != hipSuccess) fprintf(stderr, "cooperative launch failed: %s (grid %d)\n", hipGetErrorString(e), grid_blocks);
}
```

```cpp
#include <hip/hip_runtime.h>
#include <hip/hip_cooperative_groups.h>
#include <cstdio>
namespace cg = cooperative_groups;

#define LAS __attribute__((address_space(3)))
#define DI __device__ __forceinline__
typedef unsigned short bf16_t;
typedef short bf16x8 __attribute__((ext_vector_type(8)));
typedef float f32x4 __attribute__((ext_vector_type(4)));
typedef float f32x2 __attribute__((ext_vector_type(2)));
typedef unsigned u32x4 __attribute__((ext_vector_type(4)));
typedef unsigned u32x2 __attribute__((ext_vector_type(2)));
typedef __bf16 bfv2 __attribute__((ext_vector_type(2)));

constexpr int DM = 2048, TT = 16384, MT = 32768, NPJ = 7168, FF = 5632, INW = 7184;
constexpr int OFF_GQ = 0, OFF_GK = 1024, OFF_GV = 2048, OFF_GZ = 3072, OFF_MQ = 4096, OFF_MK = 5120, OFF_MV = 6144;
constexpr int LISTN = 516096;
constexpr int NTHREADS = 512;
constexpr int LDS_BYTES = 163840;

constexpr size_t WS_CTL   = 0;
constexpr size_t WS_CNT   = 4096;
constexpr size_t WS_SS1   = 8192;
constexpr size_t WS_SS2   = WS_SS1 + 131072;
constexpr size_t WS_GL    = WS_SS2 + 131072;
constexpr size_t WS_KMEAN = WS_GL + 16384;
constexpr size_t WS_WBA   = WS_KMEAN + 524288;
constexpr size_t WS_BA    = WS_WBA + 65536;
constexpr size_t WS_WIN   = WS_BA + 2097152;
constexpr size_t WS_WO    = WS_WIN + (size_t)7168 * 2048 * 2;
constexpr size_t WS_WGU   = WS_WO + (size_t)2048 * 2048 * 2;
constexpr size_t WS_WDN   = WS_WGU + (size_t)11264 * 2048 * 2;
constexpr size_t WS_WPG   = WS_WDN + (size_t)2048 * 5632 * 2;
constexpr size_t WS_WPP   = WS_WPG + (size_t)2048 * 2048 * 2;
constexpr size_t WS_PB    = WS_WPP + (size_t)2048 * 256 * 2;
constexpr size_t WS_R0    = WS_PB + (size_t)32768 * 256 * 2;
constexpr size_t WS_R1    = WS_R0 + (size_t)32768 * 2048 * 2;
constexpr size_t WS_R2    = WS_R1 + (size_t)32768 * 7168 * 2;
constexpr size_t WS_W2    = WS_R2 + (size_t)32768 * 2048 * 2;
constexpr size_t WS_QKB   = WS_W2 + (size_t)32768 * 1024 * 2;
constexpr size_t WS_HALO  = WS_QKB + (size_t)4096 * 4096 * 2;
constexpr size_t WS_LIST  = WS_HALO + (size_t)513 * 3 * 3072 * 2 + 256 - ((size_t)513 * 3 * 3072 * 2) % 256;
constexpr size_t WS_ML    = WS_LIST + (size_t)16 * LISTN * 4;
constexpr size_t WS_SSQ   = WS_ML + (size_t)4 * 262144 * 8;
constexpr size_t WS_END   = WS_SSQ + (size_t)32768 * 64 * 4;

struct Params {
    const float* x; const float* p; const float* attn_norm; const float* w_in; const float* conv_w; const float* A_log; const float* dt_bias;
    const float* gdn_norm; const float* q_norm; const float* k_norm; const float* w_o; const float* ffn_norm; const float* w_gate; const float* w_up;
    const float* w_down; const float* ple_norm; const float* w_pg; const float* w_pp;
    float* out; unsigned char* ws;
};

DI unsigned pk2(float a, float b) { f32x2 v = {a, b}; bfv2 r = __builtin_convertvector(v, bfv2); return __builtin_bit_cast(unsigned, r); }
DI bf16_t f2bf(float a) { return (bf16_t)(pk2(a, 0.f) & 0xffffu); }
DI float bflo(unsigned w) { return __uint_as_float(w << 16); }
DI float bfhi(unsigned w) { return __uint_as_float(w & 0xffff0000u); }
DI float bf2f(bf16_t v) { return __uint_as_float(((unsigned)v) << 16); }
DI bf16x8 pack8(const f32x4& a, const f32x4& b) { u32x4 w; w.x = pk2(a[0], a[1]); w.y = pk2(a[2], a[3]); w.z = pk2(b[0], b[1]); w.w = pk2(b[2], b[3]); return __builtin_bit_cast(bf16x8, w); }
DI bf16x8 cat8(u32x2 lo, u32x2 hi) { u32x4 w; w.x = lo.x; w.y = lo.y; w.z = hi.x; w.w = hi.y; return __builtin_bit_cast(bf16x8, w); }
DI f32x4 mfma16(bf16x8 a, bf16x8 b, f32x4 c) { return __builtin_amdgcn_mfma_f32_16x16x32_bf16(a, b, c, 0, 0, 0); }
DI int perm4(int d4) { return d4 < 16 ? 2 * d4 : 2 * (d4 - 16) + 4; }
DI float dpp_f(float v, int ctrl_sel) { int x = __float_as_int(v); int r;
    if (ctrl_sel == 0) r = __builtin_amdgcn_mov_dpp(x, 0xB1, 0xf, 0xf, true); else if (ctrl_sel == 1) r = __builtin_amdgcn_mov_dpp(x, 0x4E, 0xf, 0xf, true);
    else if (ctrl_sel == 2) r = __builtin_amdgcn_mov_dpp(x, 0x141, 0xf, 0xf, true); else r = __builtin_amdgcn_mov_dpp(x, 0x140, 0xf, 0xf, true);
    return __int_as_float(r); }
DI float row16_sum(float v) { v += dpp_f(v, 0); v += dpp_f(v, 1); v += dpp_f(v, 2); v += dpp_f(v, 3); return v; }
DI float silu_f(float v) { return v / (1.f + __expf(-v)); }
DI float sigm_f(float v) { return 1.f / (1.f + __expf(-v)); }

DI int opq_tid() { int t = threadIdx.x; asm volatile("" : "+v"(t)); return t; }

namespace pg8 {
constexpr int BM = 256, BK = 64, HALF = 128, HTB = HALF * BK * 2, STAGE_BYTES = 8 * HTB, NXCD = 8, WGM = 8;
DI int lds_byte(int r, int c) { const int st = (r >> 4) * 2 + (c >> 5), rr = r & 15, cc = c & 31, ob = rr * 64 + cc * 2; return st * 1024 + (ob ^ (((ob >> 9) & 1) << 5)); }
DI void stage_rc(int b, int& R, int& C) { const int st = b / 1024, sb = b % 1024, swz = sb ^ (((sb >> 9) & 1) << 5); R = (st >> 1) * 16 + swz / 64; C = (st & 1) * 32 + (swz % 64) / 2; }
DI int perm32(int rho) { const int n = rho >> 4, i = rho & 15; return 8 * (i >> 2) + 4 * n + (i & 3); }
struct Unit { int pm, pn; };
struct Gemm { const bf16_t* A; const bf16_t* Bt; int M, N, K; };
struct StaticOrder {
    int nM, nN, nwg, G, c;
    DI void init(int M, int N, int G_, int c_) { nM = M / BM; nN = N / BM; nwg = nM * nN; G = G_; c = c_; }
    DI bool next(int i, Unit& u) const {
        const long L = (long)i * G + c; if (L >= nwg) return false;
        int wgid = (int)L; { const int q = nwg / NXCD, r = nwg % NXCD, xcd = wgid % NXCD, off = wgid / NXCD; wgid = (xcd < r ? xcd * (q + 1) : r * (q + 1) + (xcd - r) * q) + off; }
        const int nig = WGM * nN, gid = wgid / nig, fm = gid * WGM, gsz = (nM - fm) < WGM ? (nM - fm) : WGM;
        u.pm = fm + ((wgid % nig) % gsz); u.pn = (wgid % nig) / gsz; return true;
    }
};

template <class Epi>
DI void gemm_phase(LAS unsigned char* lds, const Gemm g, const StaticOrder& S, const Epi& E) {
    const int tid = opq_tid(), wid = __builtin_amdgcn_readfirstlane(tid >> 6), lane = tid & 63, wr = wid >> 2, wc = wid & 3, fr = lane & 15, fq = lane >> 4;
    const int K = g.K, nt = K / BK;
    unsigned voffA[2], voffB[2];
#pragma unroll
    for (int i = 0; i < 2; ++i) { int R, C; stage_rc(tid * 16 + i * 8192, R, C); const int Rb = Epi::PERM ? ((R & ~31) + perm32(R & 31)) : R;
        voffA[i] = (unsigned)(R * K + C) * 2u; voffB[i] = (unsigned)(Rb * K + C) * 2u; }
    const size_t kstep = (size_t)(BK * 2);
    const size_t hstep = (size_t)HALF * K * 2;
    const size_t tstep = 2 * hstep;
    const unsigned ldsw = (unsigned)wid * 1024u;
    const int aoff = lds_byte(wr * 64 + fr, fq * 8), boff = lds_byte(wc * 32 + fr, fq * 8);
#define PG8_SA(b, h) (((b) * 2 + (h)) * HTB)
#define PG8_SB(b, h) ((4 + (b) * 2 + (h)) * HTB)
#define PG8_STAGE(bufoff, gbase, voff) do { _Pragma("unroll") for (int _i = 0; _i < 2; ++_i) \
        __builtin_amdgcn_global_load_lds((const unsigned*)((const char*)(gbase) + (voff)[_i]), (LAS unsigned*)(lds + (bufoff) + ldsw + _i * 8192), 16, 0, 0); } while (0)
#define PG8_LDA(dst, b, h) do { _Pragma("unroll") for (int m = 0; m < 4; ++m) _Pragma("unroll") for (int k = 0; k < 2; ++k) dst[m][k] = *(const LAS bf16x8*)(lds + PG8_SA(b, h) + aoff + m * 2048 + k * 1024); } while (0)
#define PG8_LDB(dst, b, h) do { _Pragma("unroll") for (int n = 0; n < 2; ++n) _Pragma("unroll") for (int k = 0; k < 2; ++k) dst[n][k] = *(const LAS bf16x8*)(lds + PG8_SB(b, h) + boff + n * 2048 + k * 1024); } while (0)
#define PG8_MMA(ai, bj, At, Bt) do { __builtin_amdgcn_s_setprio(1); _Pragma("unroll") for (int m = 0; m < 4; ++m) _Pragma("unroll") for (int n = 0; n < 2; ++n) _Pragma("unroll") for (int k = 0; k < 2; ++k) \
        acc[ai][bj][m][n] = __builtin_amdgcn_mfma_f32_16x16x32_bf16(Bt[n][k], At[m][k], acc[ai][bj][m][n], 0, 0, 0); __builtin_amdgcn_s_setprio(0); } while (0)
#define PG8_WAIT_V(n) asm volatile("s_waitcnt vmcnt(" #n ")" ::: "memory")
#define PG8_WAIT_L(n) asm volatile("s_waitcnt lgkmcnt(" #n ")" ::: "memory")
#define PG8_BAR __builtin_amdgcn_s_barrier()
#define PG8_SCHED __builtin_amdgcn_sched_barrier(0)
    Unit cur, nxt; int ui = 0;
    if (!S.next(0, cur)) return;
    f32x4 acc[2][2][4][2];
#pragma unroll
    for (int a = 0; a < 2; ++a)
#pragma unroll
        for (int b = 0; b < 2; ++b)
#pragma unroll
            for (int m = 0; m < 4; ++m)
#pragma unroll
                for (int n = 0; n < 2; ++n) acc[a][b][m][n] = (f32x4){0.f, 0.f, 0.f, 0.f};
    bf16x8 At[4][2], B0[2][2], B1[2][2];
    const char* cA = (const char*)g.A + (size_t)cur.pm * tstep; const char* cB = (const char*)g.Bt + (size_t)cur.pn * tstep;
    PG8_STAGE(PG8_SB(0, 0), cB, voffB); PG8_STAGE(PG8_SA(0, 0), cA, voffA); PG8_STAGE(PG8_SB(0, 1), cB + hstep, voffB); PG8_STAGE(PG8_SA(0, 1), cA + hstep, voffA);
    if (wr == 1) PG8_BAR;
    PG8_WAIT_V(4); PG8_BAR;
    PG8_STAGE(PG8_SB(1, 0), cB + kstep, voffB); PG8_STAGE(PG8_SA(1, 0), cA + kstep, voffA); PG8_STAGE(PG8_SB(1, 1), cB + hstep + kstep, voffB);
    PG8_WAIT_V(6); PG8_BAR;
    for (;;) {
        const bool has_next = S.next(ui + 1, nxt);
        const char* nA = has_next ? (const char*)g.A + (size_t)nxt.pm * tstep : cA; const char* nB = has_next ? (const char*)g.Bt + (size_t)nxt.pn * tstep : cB;
        for (int t = 0; t < nt; t += 2) {
            const bool last = (t == nt - 2);
            const char* a1 = cA + (size_t)(t + 1) * kstep;
            const char* a2 = last ? nA : cA + (size_t)(t + 2) * kstep; const char* b2 = last ? nB : cB + (size_t)(t + 2) * kstep;
            const char* a3 = a2 + kstep; const char* b3 = b2 + kstep;
            PG8_LDB(B0, 0, 0); PG8_SCHED; PG8_LDA(At, 0, 0); PG8_STAGE(PG8_SA(1, 1), a1 + hstep, voffA);
            PG8_WAIT_L(8); PG8_BAR; PG8_WAIT_L(0); PG8_MMA(0, 0, At, B0); PG8_BAR; PG8_SCHED;
            PG8_LDB(B1, 0, 1); PG8_STAGE(PG8_SB(0, 0), b2, voffB);
            PG8_BAR; PG8_WAIT_L(0); PG8_MMA(0, 1, At, B1); PG8_BAR;
            PG8_LDA(At, 0, 1); PG8_STAGE(PG8_SA(0, 0), a2, voffA);
            PG8_BAR; PG8_WAIT_L(0); PG8_MMA(1, 0, At, B0); PG8_BAR; PG8_SCHED;
            PG8_STAGE(PG8_SB(0, 1), b2 + hstep, voffB);
            PG8_WAIT_V(6); PG8_BAR; PG8_MMA(1, 1, At, B1); PG8_BAR;
            PG8_LDB(B0, 1, 0); PG8_SCHED; PG8_LDA(At, 1, 0); PG8_STAGE(PG8_SA(0, 1), a2 + hstep, voffA);
            PG8_WAIT_L(8); PG8_BAR; PG8_WAIT_L(0); PG8_MMA(0, 0, At, B0); PG8_BAR; PG8_SCHED;
            PG8_LDB(B1, 1, 1); PG8_STAGE(PG8_SB(1, 0), b3, voffB);
            PG8_BAR; PG8_WAIT_L(0); PG8_MMA(0, 1, At, B1); PG8_BAR;
            PG8_LDA(At, 1, 1); PG8_STAGE(PG8_SA(1, 0), a3, voffA);
            PG8_BAR; PG8_WAIT_L(0); PG8_MMA(1, 0, At, B0); PG8_BAR; PG8_SCHED;
            PG8_STAGE(PG8_SB(1, 1), b3 + hstep, voffB);
            PG8_WAIT_V(6); PG8_BAR; PG8_MMA(1, 1, At, B1); PG8_BAR;
        }
        E(acc, cur, wr, wc, fr, fq);
        if (!has_next) break;
#pragma unroll
        for (int a = 0; a < 2; ++a)
#pragma unroll
            for (int b = 0; b < 2; ++b)
#pragma unroll
                for (int m = 0; m < 4; ++m)
#pragma unroll
                    for (int n = 0; n < 2; ++n) acc[a][b][m][n] = (f32x4){0.f, 0.f, 0.f, 0.f};
        cur = nxt; cA = nA; cB = nB; ++ui;
    }
    PG8_WAIT_V(0);
    if (wr == 0) PG8_BAR;
    PG8_BAR;
#undef PG8_SA
#undef PG8_SB
#undef PG8_STAGE
#undef PG8_LDA
#undef PG8_LDB
#undef PG8_MMA
#undef PG8_WAIT_V
#undef PG8_WAIT_L
#undef PG8_BAR
#undef PG8_SCHED
}
}
using pg8::Unit;

struct EpiProj {
    static constexpr bool PERM = true;
    bf16_t* O; bf16_t* halo;
    DI void operator()(const f32x4 (&acc)[2][2][4][2], const Unit& u, int wr, int wc, int fr, int fq) const {
        const int row0 = u.pm * 256 + wr * 64 + fr, col0 = u.pn * 256 + wc * 32 + 8 * fq;
#pragma unroll
        for (int ai = 0; ai < 2; ++ai)
#pragma unroll
            for (int m = 0; m < 4; ++m) { const int row = row0 + ai * 128 + m * 16; bf16_t* rowp = O + (size_t)row * NPJ + col0;
#pragma unroll
                for (int bj = 0; bj < 2; ++bj) { const f32x4 v0 = acc[ai][bj][m][0], v1 = acc[ai][bj][m][1];
                    u32x4 w; w.x = pk2(v0[0], v0[1]); w.y = pk2(v0[2], v0[3]); w.z = pk2(v1[0], v1[1]); w.w = pk2(v1[2], v1[3]);
                    *(u32x4*)(rowp + bj * 128) = w;
                    if (m == 3 && fr >= 13 && u.pn < 12) *(u32x4*)(halo + ((size_t)((row >> 6) + 1) * 3 + (fr - 13)) * 3072 + col0 + bj * 128) = w; } }
    }
};
struct EpiPlainBf16 {
    static constexpr bool PERM = true;
    bf16_t* O; int ldc;
    DI void operator()(const f32x4 (&acc)[2][2][4][2], const Unit& u, int wr, int wc, int fr, int fq) const {
        const int row0 = u.pm * 256 + wr * 64 + fr, col0 = u.pn * 256 + wc * 32 + 8 * fq;
#pragma unroll
        for (int ai = 0; ai < 2; ++ai)
#pragma unroll
            for (int m = 0; m < 4; ++m) { bf16_t* rowp = O + (size_t)(row0 + ai * 128 + m * 16) * ldc + col0;
#pragma unroll
                for (int bj = 0; bj < 2; ++bj) { const f32x4 v0 = acc[ai][bj][m][0], v1 = acc[ai][bj][m][1];
                    u32x4 w; w.x = pk2(v0[0], v0[1]); w.y = pk2(v0[2], v0[3]); w.z = pk2(v1[0], v1[1]); w.w = pk2(v1[2], v1[3]);
                    *(u32x4*)(rowp + bj * 128) = w; } }
    }
};
struct EpiResid {
    static constexpr bool PERM = false;
    const float* base; float* out; bf16_t* hb; float* ss;
    DI void operator()(const f32x4 (&acc)[2][2][4][2], const Unit& u, int wr, int wc, int fr, int fq) const {
        const int row0 = u.pm * 256 + wr * 64 + fr, col0 = u.pn * 256 + wc * 32 + 4 * fq;
#pragma unroll
        for (int ai = 0; ai < 2; ++ai) { f32x4 bs[4][4];
#pragma unroll
            for (int m = 0; m < 4; ++m)
#pragma unroll
                for (int q = 0; q < 4; ++q) bs[m][q] = *(const f32x4*)(base + (size_t)(row0 + ai * 128 + m * 16) * DM + col0 + (q >> 1) * 128 + (q & 1) * 16);
#pragma unroll
            for (int m = 0; m < 4; ++m) { const int row = row0 + ai * 128 + m * 16; const size_t off = (size_t)row * DM + col0; float s = 0.f;
#pragma unroll
                for (int q = 0; q < 4; ++q) { const f32x4 hv = bs[m][q] + acc[ai][q >> 1][m][q & 1];
                        *(f32x4*)(out + off + (q >> 1) * 128 + (q & 1) * 16) = hv; u32x2 w; w.x = pk2(hv[0], hv[1]); w.y = pk2(hv[2], hv[3]);
                        *(u32x2*)(hb + off + (q >> 1) * 128 + (q & 1) * 16) = w; s += (hv[0] * hv[0] + hv[1] * hv[1]) + (hv[2] * hv[2] + hv[3] * hv[3]); }
                s += __shfl_xor(s, 16); s += __shfl_xor(s, 32);
                if (fq == 0) atomicAdd(ss + row, s); }
            asm volatile("" ::: "memory"); }
    }
};
struct EpiAct {
    static constexpr bool PERM = true;
    bf16_t* O; const float* ss;
    DI void operator()(const f32x4 (&acc)[2][2][4][2], const Unit& u, int wr, int wc, int fr, int fq) const {
        const int row0 = u.pm * 256 + wr * 64 + fr, col0 = u.pn * 128 + wc * 32 + 8 * fq;
        float rs[8];
#pragma unroll
        for (int g = 0; g < 8; ++g) rs[g] = ss[row0 + (g >> 2) * 128 + (g & 3) * 16];
#pragma unroll
        for (int ai = 0; ai < 2; ++ai)
#pragma unroll
            for (int m = 0; m < 4; ++m) { const int row = row0 + ai * 128 + m * 16; const float r = rsqrtf(rs[ai * 4 + m] * (1.f / 2048.f) + 1e-6f);
                float a[8];
#pragma unroll
                for (int n = 0; n < 2; ++n)
#pragma unroll
                    for (int j = 0; j < 4; ++j) { const float gv = r * acc[ai][0][m][n][j], uv = r * acc[ai][1][m][n][j]; a[n * 4 + j] = silu_f(gv) * uv; }
                u32x4 w; w.x = pk2(a[0], a[1]); w.y = pk2(a[2], a[3]); w.z = pk2(a[4], a[5]); w.w = pk2(a[6], a[7]);
                *(u32x4*)(O + (size_t)row * FF + col0) = w; }
    }
};
struct EpiOut {
    static constexpr bool PERM = false;
    float* out; const bf16_t* pp; const float* ss;
    DI void operator()(const f32x4 (&acc)[2][2][4][2], const Unit& u, int wr, int wc, int fr, int fq) const {
        const int row0 = u.pm * 256 + wr * 64 + fr, col0 = u.pn * 256 + wc * 32 + 4 * fq;
        float rs[8];
#pragma unroll
        for (int g = 0; g < 8; ++g) rs[g] = ss[row0 + (g >> 2) * 128 + (g & 3) * 16];
#pragma unroll
        for (int ai = 0; ai < 2; ++ai) { f32x4 hv[4][4]; u32x2 pw[4][4];
#pragma unroll
            for (int m = 0; m < 4; ++m)
#pragma unroll
                for (int q = 0; q < 4; ++q) { const size_t o2 = (size_t)(row0 + ai * 128 + m * 16) * DM + col0 + (q >> 1) * 128 + (q & 1) * 16; hv[m][q] = *(const f32x4*)(out + o2); pw[m][q] = *(const u32x2*)(pp + o2); }
#pragma unroll
            for (int m = 0; m < 4; ++m) { const int row = row0 + ai * 128 + m * 16; const size_t off = (size_t)row * DM + col0; const float r = rsqrtf(rs[ai * 4 + m] * (1.f / 2048.f) + 1e-6f);
#pragma unroll
                for (int q = 0; q < 4; ++q) { const f32x4 a = acc[ai][q >> 1][m][q & 1]; f32x4 o;
                        o[0] = hv[m][q][0] + sigm_f(r * a[0]) * bflo(pw[m][q].x); o[1] = hv[m][q][1] + sigm_f(r * a[1]) * bfhi(pw[m][q].x);
                        o[2] = hv[m][q][2] + sigm_f(r * a[2]) * bflo(pw[m][q].y); o[3] = hv[m][q][3] + sigm_f(r * a[3]) * bfhi(pw[m][q].y);
                        *(f32x4*)(out + off + (q >> 1) * 128 + (q & 1) * 16) = o; } }
            asm volatile("" ::: "memory"); }
    }
};

DI void tconv_tile(const float* __restrict__ src, int ld, int c0, int k0, bf16_t* __restrict__ dst, int dK, int n0, const float* __restrict__ nw, LAS float* tl) {
    const int tid = opq_tid();
    f32x4 v[8];
#pragma unroll
    for (int i = 0; i < 8; ++i) v[i] = *(const f32x4*)(src + (size_t)(k0 + (tid >> 4) + 32 * i) * ld + c0 + (tid & 15) * 4);
#pragma unroll
    for (int i = 0; i < 8; ++i) { const int k = (tid >> 4) + 32 * i; const float sc = nw ? nw[k0 + k] : 1.f;
        LAS float* q = tl + k * 65 + (tid & 15) * 4; q[0] = v[i][0] * sc; q[1] = v[i][1] * sc; q[2] = v[i][2] * sc; q[3] = v[i][3] * sc; }
    __syncthreads();
    { const int n = tid >> 3, kq = (tid & 7) * 8;
#pragma unroll
      for (int j = 0; j < 4; ++j) { const int ks = kq + 64 * j; float f[8];
#pragma unroll
          for (int i = 0; i < 8; ++i) f[i] = tl[(ks + i) * 65 + n];
          u32x4 w; w.x = pk2(f[0], f[1]); w.y = pk2(f[2], f[3]); w.z = pk2(f[4], f[5]); w.w = pk2(f[6], f[7]);
          *(u32x4*)(dst + (size_t)(n0 + n) * dK + k0 + ks) = w; } }
    __syncthreads();
}

DI void phase_prep(const Params& P, LAS unsigned char* lds) {
    unsigned char* ws = P.ws; const int tid = opq_tid(), G = gridDim.x, bx = blockIdx.x;
    const int gtid = bx * NTHREADS + tid, gsz = G * NTHREADS;
    for (int i = gtid; i < (int)((WS_GL - WS_CTL) / 4); i += gsz) ((unsigned*)(ws + WS_CTL))[i] = 0u;
    { bf16_t* wba = (bf16_t*)(ws + WS_WBA); for (int i = gtid; i < 16 * 2048; i += gsz) { const int n = i >> 11, k = i & 2047; wba[i] = f2bf(P.w_in[(size_t)k * INW + 4096 + n]); } }
    { bf16_t* pb = (bf16_t*)(ws + WS_PB); for (int i = gtid; i < MT * 256 / 8; i += gsz) { const f32x4 a = *(const f32x4*)(P.p + (size_t)i * 8), b = *(const f32x4*)(P.p + (size_t)i * 8 + 4);
        u32x4 w; w.x = pk2(a[0], a[1]); w.y = pk2(a[2], a[3]); w.z = pk2(b[0], b[1]); w.w = pk2(b[2], b[3]); *(u32x4*)(pb + (size_t)i * 8) = w; } }
    { bf16_t* xn = (bf16_t*)(ws + WS_R0); const int lane = tid & 63, gw = bx * 8 + (tid >> 6);
      f32x4 wv[8];
#pragma unroll
      for (int i = 0; i < 8; ++i) wv[i] = *(const f32x4*)(P.attn_norm + lane * 4 + i * 256);
      for (int row = gw * 2; row < MT; row += G * 16) { const float* xr = P.x + (size_t)row * DM; f32x4 v[2][8]; float s0 = 0.f, s1 = 0.f;
#pragma unroll
          for (int r = 0; r < 2; ++r)
#pragma unroll
              for (int i = 0; i < 8; ++i) v[r][i] = *(const f32x4*)(xr + (size_t)r * DM + lane * 4 + i * 256);
#pragma unroll
          for (int i = 0; i < 8; ++i) { s0 += (v[0][i][0] * v[0][i][0] + v[0][i][1] * v[0][i][1]) + (v[0][i][2] * v[0][i][2] + v[0][i][3] * v[0][i][3]);
              s1 += (v[1][i][0] * v[1][i][0] + v[1][i][1] * v[1][i][1]) + (v[1][i][2] * v[1][i][2] + v[1][i][3] * v[1][i][3]); }
#pragma unroll
          for (int o = 1; o < 64; o <<= 1) { s0 += __shfl_xor(s0, o); s1 += __shfl_xor(s1, o); }
          const float r0 = rsqrtf(s0 * (1.f / 2048.f) + 1e-6f), r1 = rsqrtf(s1 * (1.f / 2048.f) + 1e-6f);
#pragma unroll
          for (int r = 0; r < 2; ++r)
#pragma unroll
              for (int i = 0; i < 8; ++i) { const float rr = r ? r1 : r0; u32x2 w; w.x = pk2(v[r][i][0] * rr * wv[i][0], v[r][i][1] * rr * wv[i][1]); w.y = pk2(v[r][i][2] * rr * wv[i][2], v[r][i][3] * rr * wv[i][3]);
                  *(u32x2*)(xn + (size_t)(row + r) * DM + lane * 4 + i * 256) = w; } } }
    LAS float* tl = (LAS float*)lds;
    for (int gi = bx; gi < 896; gi += G) { const int nt = gi >> 3, kg = gi & 7, n0 = nt * 64; tconv_tile(P.w_in, INW, n0 < 4096 ? n0 : n0 + 16, kg * 256, (bf16_t*)(ws + WS_WIN), 2048, n0, nullptr, tl); }
}
DI void phase_wconv_late(const Params& P, LAS unsigned char* lds, int wg0, int nwg) {
    unsigned char* ws = P.ws; LAS float* tl = (LAS float*)lds;
    for (int gi = 896 + wg0; gi < 3552; gi += nwg) {
        if (gi < 1152) { const int t2 = gi - 896, nt = t2 >> 3, kg = t2 & 7; tconv_tile(P.w_o, 2048, nt * 64, kg * 256, (bf16_t*)(ws + WS_WO), 2048, nt * 64, nullptr, tl); }
        else if (gi < 2560) { const int t2 = gi - 1152, nt = t2 >> 3, kg = t2 & 7, n0 = nt * 64, pn = n0 >> 8, r = n0 & 255;
            tconv_tile(r < 128 ? P.w_gate : P.w_up, FF, pn * 128 + (r & 127), kg * 256, (bf16_t*)(ws + WS_WGU), 2048, n0, P.ffn_norm, tl); }
        else if (gi < 3264) { const int t2 = gi - 2560, nt = t2 / 22, kg = t2 % 22; tconv_tile(P.w_down, 2048, nt * 64, kg * 256, (bf16_t*)(ws + WS_WDN), FF, nt * 64, nullptr, tl); }
        else if (gi < 3520) { const int t2 = gi - 3264, nt = t2 >> 3, kg = t2 & 7; tconv_tile(P.w_pg, 2048, nt * 64, kg * 256, (bf16_t*)(ws + WS_WPG), 2048, nt * 64, P.ple_norm, tl); }
        else { const int nt = gi - 3520; tconv_tile(P.w_pp, 2048, nt * 64, 0, (bf16_t*)(ws + WS_WPP), 256, nt * 64, nullptr, tl); }
    }
}

DI void phase_ba(const Params& P) {
    const int tid = opq_tid(), lane = tid & 63, fr = lane & 15, fq = lane >> 4, gw = blockIdx.x * 8 + (tid >> 6);
    const bf16_t* xn = (const bf16_t*)(P.ws + WS_R0); const bf16_t* wba = (const bf16_t*)(P.ws + WS_WBA); float* BA = (float*)(P.ws + WS_BA);
    for (int rt = gw; rt < MT / 16; rt += gridDim.x * 8) {
        f32x4 acc = {0.f, 0.f, 0.f, 0.f}; const bf16_t* ap = xn + (size_t)(rt * 16 + fr) * DM + 8 * fq; const bf16_t* bp = wba + fr * 2048 + 8 * fq;
#pragma unroll 8
        for (int ks = 0; ks < 64; ++ks) acc = mfma16(*(const bf16x8*)(ap + 32 * ks), *(const bf16x8*)(bp + 32 * ks), acc);
#pragma unroll
        for (int j = 0; j < 4; ++j) BA[(size_t)(rt * 16 + 4 * fq + j) * 16 + fr] = acc[j];
    }
}

constexpr int G1_QS = 0, G1_KS = 18432, G1_VT = 36864, G1_KT = 57344, G1_SM = 77824, G1_TEAM = 78848;
DI void phase_gdn_prep(const Params& P, LAS unsigned char* lds) {
    const int tid0 = opq_tid(), team = tid0 >> 8;
    LAS unsigned char* L = lds + team * G1_TEAM;
    LAS bf16_t* QS = (LAS bf16_t*)(L + G1_QS); LAS bf16_t* KS = (LAS bf16_t*)(L + G1_KS); LAS bf16_t* VT = (LAS bf16_t*)(L + G1_VT); LAS bf16_t* KT = (LAS bf16_t*)(L + G1_KT);
    LAS float* AF = (LAS float*)(L + G1_QS); LAS bf16_t* TB = (LAS bf16_t*)(L + G1_KS); LAS float* SM = (LAS float*)(L + G1_SM);
    bf16_t* proj = (bf16_t*)(P.ws + WS_R1); const bf16_t* halo = (const bf16_t*)(P.ws + WS_HALO); const float* BA = (const float*)(P.ws + WS_BA);
    bf16_t* W2 = (bf16_t*)(P.ws + WS_W2); bf16_t* QKB = (bf16_t*)(P.ws + WS_QKB); float* GL = (float*)(P.ws + WS_GL);
    for (int pi = blockIdx.x; pi < 2048; pi += gridDim.x) {
        int tid = tid0; asm volatile("" : "+v"(tid));
        const int tt = tid & 255, tw = __builtin_amdgcn_readfirstlane((tid >> 6) & 3), lane = tid & 63, fr = lane & 15, fq = lane >> 4;
        const int ci = pi * 2 + team, h = ci & 7, n = (ci >> 3) & 255, b = ci >> 11, t0 = b * TT + n * 64;
        if (tw == 0) {
            const float bv = BA[(size_t)(t0 + lane) * 16 + h], av = BA[(size_t)(t0 + lane) * 16 + 8 + h];
            const float beta = sigm_f(bv); const float xx = av + P.dt_bias[h]; const float sp = xx > 20.f ? xx : log1pf(__expf(xx));
            const float gg = -__expf(P.A_log[h]) * sp; float gc = gg;
#pragma unroll
            for (int o = 1; o < 64; o <<= 1) { const float v = __shfl_up(gc, o); if (lane >= o) gc += v; }
            const float glast = __shfl(gc, 63);
            SM[lane] = gc; SM[64 + lane] = beta; SM[128 + lane] = __expf(gc); SM[192 + lane] = __expf(glast - gc);
            if (lane == 63) GL[(b * 8 + h) * 256 + n] = __expf(gc);
        }
        __syncthreads();
        { const int r = tt >> 2, cg0 = (tt & 3) * 32; const float beta_r = SM[64 + r], egc_r = SM[128 + r];
#pragma unroll 1
          for (int x = 0; x < 3; ++x) {
              float val[32]; const int colbase = x * 1024 + h * 128 + cg0;
#pragma unroll
              for (int sg = 0; sg < 4; ++sg) { const int col = colbase + sg * 8; u32x4 raw[4];
#pragma unroll
                  for (int j = 0; j < 4; ++j) { const int rr = r - 3 + j; raw[j] = (u32x4){0u, 0u, 0u, 0u};
                      if (rr >= 0) raw[j] = *(const u32x4*)(proj + (size_t)(t0 + rr) * NPJ + col);
                      else if (n > 0) raw[j] = *(const u32x4*)(halo + ((size_t)(t0 >> 6) * 3 + (rr + 3)) * 3072 + col); }
#pragma unroll
                  for (int i = 0; i < 8; ++i) { const f32x4 w4 = *(const f32x4*)(P.conv_w + (size_t)(col + i) * 4); float a = 0.f;
#pragma unroll
                      for (int j = 0; j < 4; ++j) { const unsigned wd = raw[j][i >> 1]; const float xv = (i & 1) ? bfhi(wd) : bflo(wd); a += w4[j] * xv; }
                      val[sg * 8 + i] = silu_f(a); } }
              if (x < 2) { float ss = 0.f;
#pragma unroll
                  for (int i = 0; i < 32; ++i) ss += val[i] * val[i];
                  ss += __shfl_xor(ss, 1); ss += __shfl_xor(ss, 2);
                  const float sc = rsqrtf(ss + 1e-6f) * (x == 0 ? 0.08838834764831845f : 1.f);
#pragma unroll
                  for (int i = 0; i < 32; ++i) val[i] *= sc; }
              if (x < 2) { LAS bf16_t* dst = (x == 0 ? QS : KS) + r * 144 + cg0;
#pragma unroll
                  for (int i = 0; i < 4; ++i) { u32x4 w; w.x = pk2(val[8 * i], val[8 * i + 1]); w.y = pk2(val[8 * i + 2], val[8 * i + 3]); w.z = pk2(val[8 * i + 4], val[8 * i + 5]); w.w = pk2(val[8 * i + 6], val[8 * i + 7]);
                      *(LAS u32x4*)(dst + 8 * i) = w; } }
              if (x == 1) { const float f = beta_r * egc_r;
#pragma unroll
                  for (int i = 0; i < 32; ++i) KT[(cg0 + i) * 80 + r] = f2bf(val[i] * f); }
              if (x == 2) {
#pragma unroll
                  for (int i = 0; i < 32; ++i) VT[(cg0 + i) * 80 + r] = f2bf(val[i] * beta_r); }
          } }
        __syncthreads();
        f32x4 kk[4], qk[4];
#pragma unroll
        for (int nt = 0; nt < 4; ++nt) { kk[nt] = (f32x4){0.f, 0.f, 0.f, 0.f}; qk[nt] = (f32x4){0.f, 0.f, 0.f, 0.f}; }
#pragma unroll
        for (int ks = 0; ks < 4; ++ks) { const bf16x8 ak = *(const LAS bf16x8*)(KS + (16 * tw + fr) * 144 + 32 * ks + 8 * fq), aq = *(const LAS bf16x8*)(QS + (16 * tw + fr) * 144 + 32 * ks + 8 * fq);
#pragma unroll
            for (int nt = 0; nt < 4; ++nt) { const bf16x8 bk = *(const LAS bf16x8*)(KS + (16 * nt + fr) * 144 + 32 * ks + 8 * fq); kk[nt] = mfma16(ak, bk, kk[nt]); qk[nt] = mfma16(aq, bk, qk[nt]); } }
        { const int r = tt >> 2, cg0 = (tt & 3) * 32; const float e = SM[128 + r];
#pragma unroll
          for (int i = 0; i < 4; ++i) { const u32x4 s = *(const LAS u32x4*)(QS + r * 144 + cg0 + 8 * i); u32x4 w;
              w.x = pk2(bflo(s.x) * e, bfhi(s.x) * e); w.y = pk2(bflo(s.y) * e, bfhi(s.y) * e); w.z = pk2(bflo(s.z) * e, bfhi(s.z) * e); w.w = pk2(bflo(s.w) * e, bfhi(s.w) * e);
              *(u32x4*)(proj + (size_t)(t0 + r) * NPJ + OFF_GQ + h * 128 + cg0 + 8 * i) = w; } }
        { const int d = tt >> 1, cb = (tt & 1) * 32;
#pragma unroll
          for (int i4 = 0; i4 < 4; ++i4) { const int c0 = cb + 8 * i4; float f[8];
#pragma unroll
              for (int i = 0; i < 8; ++i) f[i] = bf2f(KS[(c0 + i) * 144 + d]) * SM[192 + c0 + i];
              u32x4 w; w.x = pk2(f[0], f[1]); w.y = pk2(f[2], f[3]); w.z = pk2(f[4], f[5]); w.w = pk2(f[6], f[7]);
              *(u32x4*)(proj + (size_t)(t0 + (d >> 1)) * NPJ + OFF_GK + h * 128 + (d & 1) * 64 + c0) = w; } }
        __syncthreads();
#pragma unroll
        for (int nt = 0; nt < 4; ++nt)
#pragma unroll
            for (int j = 0; j < 4; ++j) { const int c = 16 * tw + 4 * fq + j, s = 16 * nt + fr; const float dec = (s <= c) ? __expf(SM[c] - SM[s]) : 0.f;
                AF[c * 65 + s] = (s < c) ? SM[64 + c] * kk[nt][j] * dec : (s == c ? 1.f : 0.f);
                QKB[(size_t)ci * 4096 + c * 64 + s] = f2bf(qk[nt][j] * dec); }
        __syncthreads();
        { const int bb = tw * 16;
          if (lane < 16) {
              for (int i = 1; i < 16; ++i) { float a0 = 0.f, a1 = 0.f; int j = 0;
                  for (; j + 2 <= i; j += 2) { a0 += AF[(bb + i) * 65 + bb + j] * AF[(bb + j) * 65 + bb + lane]; a1 += AF[(bb + i) * 65 + bb + j + 1] * AF[(bb + j + 1) * 65 + bb + lane]; }
                  if (j < i) a0 += AF[(bb + i) * 65 + bb + j] * AF[(bb + j) * 65 + bb + lane];
                  AF[(bb + i) * 65 + bb + lane] = lane < i ? -(a0 + a1) : (lane == i ? 1.f : 0.f); } }
#pragma unroll
          for (int k = 0; k < 4; ++k) { const int row = bb + fq + 4 * k; TB[row * 80 + bb + fr] = f2bf(AF[row * 65 + bb + fr]);
              for (int jb = tw + 1; jb < 4; ++jb) TB[row * 80 + 16 * jb + fr] = (bf16_t)0; }
          __syncthreads();
          for (int i = 1; i < 4; ++i) {
              if (tw < i) { const int j = tw; f32x4 X = {0.f, 0.f, 0.f, 0.f};
                  for (int k = j; k < i; ++k) {
#pragma unroll
                      for (int kk = 0; kk < 4; ++kk) { const float av = AF[(16 * i + fr) * 65 + 16 * k + 4 * kk + fq];
                          const float bv = (k == j) ? AF[(16 * k + 4 * kk + fq) * 65 + 16 * j + fr] : bf2f(TB[(16 * k + 4 * kk + fq) * 80 + 16 * j + fr]);
                          X = __builtin_amdgcn_mfma_f32_16x16x4f32(av, bv, X, 0, 0, 0); } }
                  f32x4 O = {0.f, 0.f, 0.f, 0.f};
#pragma unroll
                  for (int kk = 0; kk < 4; ++kk) O = __builtin_amdgcn_mfma_f32_16x16x4f32(AF[(16 * i + fr) * 65 + 16 * i + 4 * fq + kk], X[kk], O, 0, 0, 0);
#pragma unroll
                  for (int jj = 0; jj < 4; ++jj) TB[(16 * i + 4 * fq + jj) * 80 + 16 * j + fr] = f2bf(-O[jj]); }
              __syncthreads(); }
        }
        { bf16x8 at[2];
#pragma unroll
          for (int ks = 0; ks < 2; ++ks) at[ks] = *(const LAS bf16x8*)(TB + (16 * tw + fr) * 80 + 32 * ks + 8 * fq);
#pragma unroll
          for (int nt = 0; nt < 8; ++nt) { f32x4 a = {0.f, 0.f, 0.f, 0.f};
#pragma unroll
              for (int ks = 0; ks < 2; ++ks) a = mfma16(at[ks], *(const LAS bf16x8*)(VT + (16 * nt + fr) * 80 + 32 * ks + 8 * fq), a);
              const int e = 16 * nt + fr; u32x2 w; w.x = pk2(a[0], a[1]); w.y = pk2(a[2], a[3]);
              *(u32x2*)(proj + (size_t)(t0 + (e >> 1)) * NPJ + OFF_GV + h * 128 + (e & 1) * 64 + 16 * tw + 4 * fq) = w; }
#pragma unroll
          for (int mt = 0; mt < 8; ++mt) { f32x4 a = {0.f, 0.f, 0.f, 0.f};
#pragma unroll
              for (int ks = 0; ks < 2; ++ks) a = mfma16(*(const LAS bf16x8*)(KT + (16 * mt + fr) * 80 + 32 * ks + 8 * fq), at[ks], a);
              u32x2 w; w.x = pk2(a[0], a[1]); w.y = pk2(a[2], a[3]);
              *(u32x2*)(W2 + (size_t)(t0 + 16 * tw + fr) * 1024 + h * 128 + 16 * mt + 4 * fq) = w; } }
        __syncthreads();
    }
}

DI void phase_moba_prep(const Params& P, LAS unsigned char* lds) {
    const int tid = opq_tid(), lane = tid & 63, wave = tid >> 6, l16 = lane & 15;
    bf16_t* proj = (bf16_t*)(P.ws + WS_R1); float* kmean = (float*)(P.ws + WS_KMEAN);
    LAS bf16_t* VS = (LAS bf16_t*)lds; LAS float* CS = (LAS float*)(lds + 69632);
    for (int task = blockIdx.x; task < 1024; task += gridDim.x) {
        const int h = task & 7, blk = (task >> 3) & 63, b = task >> 9; const size_t rbase = (size_t)(b * TT + blk * 256);
        f32x4 qg0 = *(const f32x4*)(P.q_norm + l16 * 8), qg1 = *(const f32x4*)(P.q_norm + l16 * 8 + 4), kg0 = *(const f32x4*)(P.k_norm + l16 * 8), kg1 = *(const f32x4*)(P.k_norm + l16 * 8 + 4);
        float cs[8];
#pragma unroll
        for (int i = 0; i < 8; ++i) cs[i] = 0.f;
        u32x4 rq[8], rk[8], rv[8];
#pragma unroll
        for (int ps = 0; ps < 8; ++ps) { const int r = ps * 32 + wave * 4 + (lane >> 4); const bf16_t* rp = proj + (rbase + r) * NPJ + h * 128 + l16 * 8;
            rq[ps] = *(const u32x4*)(rp + OFF_MQ); rk[ps] = *(const u32x4*)(rp + OFF_MK); rv[ps] = *(const u32x4*)(rp + OFF_MV); }
#pragma unroll
        for (int ps = 0; ps < 8; ++ps) { const int r = ps * 32 + wave * 4 + (lane >> 4); bf16_t* rp = proj + (rbase + r) * NPJ + h * 128 + l16 * 8;
#pragma unroll
            for (int x = 0; x < 2; ++x) { bf16_t* ptr = rp + (x == 0 ? OFF_MQ : OFF_MK); const u32x4 raw = x == 0 ? rq[ps] : rk[ps]; float v[8];
                v[0] = bflo(raw.x); v[1] = bfhi(raw.x); v[2] = bflo(raw.y); v[3] = bfhi(raw.y); v[4] = bflo(raw.z); v[5] = bfhi(raw.z); v[6] = bflo(raw.w); v[7] = bfhi(raw.w);
                float ss = 0.f;
#pragma unroll
                for (int i = 0; i < 8; ++i) ss += v[i] * v[i];
                ss = row16_sum(ss);
                const float rs = rsqrtf(ss * (1.f / 128.f) + 1e-6f); const f32x4 g0 = x == 0 ? qg0 : kg0, g1 = x == 0 ? qg1 : kg1;
#pragma unroll
                for (int i = 0; i < 4; ++i) { v[i] *= rs * g0[i]; v[4 + i] *= rs * g1[i]; }
                if (x == 1) {
#pragma unroll
                    for (int i = 0; i < 8; ++i) cs[i] += v[i]; }
                u32x4 w; w.x = pk2(v[0], v[1]); w.y = pk2(v[2], v[3]); w.z = pk2(v[4], v[5]); w.w = pk2(v[6], v[7]); *(u32x4*)ptr = w; }
            *(LAS u32x4*)(VS + r * 136 + l16 * 8) = rv[ps]; }
#pragma unroll
        for (int i = 0; i < 8; ++i) { cs[i] += __shfl_xor(cs[i], 16); cs[i] += __shfl_xor(cs[i], 32); }
        if (lane < 16) {
#pragma unroll
            for (int i = 0; i < 8; ++i) CS[wave * 128 + lane * 8 + i] = cs[i]; }
        __syncthreads();
        if (tid < 128) { float s = 0.f;
#pragma unroll
            for (int w = 0; w < 8; ++w) s += CS[w * 128 + tid];
            kmean[((size_t)(b * 8 + h) * 64 + blk) * 128 + tid] = s * (1.f / 256.f); }
#pragma unroll 2
        for (int i8 = 0; i8 < 8; ++i8) { const int pid = tid + i8 * 512, e = pid >> 5, ks = pid & 31; unsigned short f[8];
#pragma unroll
            for (int i = 0; i < 8; ++i) f[i] = VS[(ks * 8 + i) * 136 + e];
            u32x4 w; w.x = f[0] | ((unsigned)f[1] << 16); w.y = f[2] | ((unsigned)f[3] << 16); w.z = f[4] | ((unsigned)f[5] << 16); w.w = f[6] | ((unsigned)f[7] << 16);
            *(u32x4*)(proj + (rbase + 2 * e + (ks >> 4)) * NPJ + OFF_MV + h * 128 + (ks & 15) * 8) = w; }
        __syncthreads();
    }
}

DI void phase_moba_select(const Params& P, LAS unsigned char* lds) {
    const int tid = opq_tid(), qi = tid >> 1, half = tid & 1;
    const bf16_t* proj = (const bf16_t*)(P.ws + WS_R1); const float* kmean = (const float*)(P.ws + WS_KMEAN);
    int* cnt = (int*)(P.ws + WS_CNT); int* list = (int*)(P.ws + WS_LIST); f32x2* ML = (f32x2*)(P.ws + WS_ML);
    LAS float* KM = (LAS float*)lds; LAS int* hist = (LAS int*)(lds + 32768); LAS int* hbase = (LAS int*)(lds + 32768 + 256);
    for (int task = blockIdx.x; task < 1024; task += gridDim.x) {
        const int blk = task & 63, h = (task >> 6) & 7, b = task >> 9; const int bh = b * 8 + h; const int t = blk * 256 + qi; const size_t rid = (size_t)bh * TT + t;
        for (int i = tid; i < blk * 128; i += NTHREADS) KM[i] = kmean[(size_t)bh * 64 * 128 + i];
        if (tid < 64) hist[tid] = 0;
        float q[64];
        { const bf16_t* qp = proj + (size_t)(b * TT + t) * NPJ + OFF_MQ + h * 128 + half * 64;
#pragma unroll
          for (int i = 0; i < 8; ++i) { const u32x4 raw = *(const u32x4*)(qp + 8 * i); q[8 * i] = bflo(raw.x); q[8 * i + 1] = bfhi(raw.x); q[8 * i + 2] = bflo(raw.y); q[8 * i + 3] = bfhi(raw.y);
              q[8 * i + 4] = bflo(raw.z); q[8 * i + 5] = bfhi(raw.z); q[8 * i + 6] = bflo(raw.w); q[8 * i + 7] = bfhi(raw.w); } }
        __syncthreads();
        float v0 = -INFINITY, v1 = -INFINITY, v2 = -INFINITY; int i0 = -1, i1 = -1, i2 = -1;
        for (int n = 0; n < blk; ++n) { const LAS float* km = KM + n * 128 + half * 64; float d0 = 0.f, d1 = 0.f, d2 = 0.f, d3 = 0.f;
#pragma unroll
            for (int i = 0; i < 16; ++i) { const f32x4 kv = *(const LAS f32x4*)(km + 4 * i); d0 += q[4 * i] * kv[0]; d1 += q[4 * i + 1] * kv[1]; d2 += q[4 * i + 2] * kv[2]; d3 += q[4 * i + 3] * kv[3]; }
            float g = (d0 + d1) + (d2 + d3); g += __shfl_xor(g, 1);
            if (g > v0) { v2 = v1; i2 = i1; v1 = v0; i1 = i0; v0 = g; i0 = n; } else if (g > v1) { v2 = v1; i2 = i1; v1 = g; i1 = n; } else if (g > v2) { v2 = g; i2 = n; } }
        int rk0 = 0, rk1 = 0, rk2 = 0;
        if (half == 0) { if (i0 >= 0) rk0 = __hip_atomic_fetch_add(&hist[i0], 1, __ATOMIC_RELAXED, __HIP_MEMORY_SCOPE_WORKGROUP); if (i1 >= 0) rk1 = __hip_atomic_fetch_add(&hist[i1], 1, __ATOMIC_RELAXED, __HIP_MEMORY_SCOPE_WORKGROUP); if (i2 >= 0) rk2 = __hip_atomic_fetch_add(&hist[i2], 1, __ATOMIC_RELAXED, __HIP_MEMORY_SCOPE_WORKGROUP); }
        __syncthreads();
        if (tid < 64) { const int c = hist[tid]; hbase[tid] = c > 0 ? atomicAdd(&cnt[bh * 64 + tid], c) : 0; }
        __syncthreads();
        if (half == 0) {
            const f32x2 dead = {-INFINITY, 0.f};
            if (i0 >= 0) list[(size_t)bh * LISTN + i0 * 16384 - 128 * i0 * (i0 + 1) + hbase[i0] + rk0] = t; else ML[0 * 262144 + rid] = dead;
            if (i1 >= 0) list[(size_t)bh * LISTN + i1 * 16384 - 128 * i1 * (i1 + 1) + hbase[i1] + rk1] = t | (1 << 14); else ML[1 * 262144 + rid] = dead;
            if (i2 >= 0) list[(size_t)bh * LISTN + i2 * 16384 - 128 * i2 * (i2 + 1) + hbase[i2] + rk2] = t | (2 << 14); else ML[2 * 262144 + rid] = dead;
        }
        __syncthreads();
    }
}

constexpr int G2_W = 0, G2_Q = 18432, G2_QK = 36864, G2_KD = 47104, G2_BUF = 67584, G2_RED = 135168;
DI void phase_gdn_scan(const Params& P, LAS unsigned char* lds, int bh) {
    const int tid = opq_tid(), lane = tid & 63, w = tid >> 6, fr = lane & 15, fq = lane >> 4, b = bh >> 3, h = bh & 7;
    const bf16_t* proj = (const bf16_t*)(P.ws + WS_R1); const bf16_t* W2 = (const bf16_t*)(P.ws + WS_W2); const bf16_t* QKB = (const bf16_t*)(P.ws + WS_QKB);
    const float* GL = (const float*)(P.ws + WS_GL); bf16_t* mix = (bf16_t*)(P.ws + WS_R2);
    float* SSQ = (float*)(P.ws + WS_SSQ);
    const int e = 16 * w + fr; const float gnw = P.gdn_norm[e];
    f32x4 S[8];
#pragma unroll
    for (int i = 0; i < 8; ++i) S[i] = (f32x4){0.f, 0.f, 0.f, 0.f};
    const int wrow0 = tid >> 4, wseg = tid & 15;
    const int qrow = tid >> 3, qseg = tid & 7;
    struct Stage { u32x4 sw[2], sq[2], sqk, skd[2]; };
    u32x2 un[4];
    Stage stA, stB;
#define G2_LOAD(X, nn) do { const int t0_ = b * TT + (nn) * 64; const int ci_ = ((b * 256 + (nn)) << 3) + h; \
        _Pragma("unroll") for (int i_ = 0; i_ < 2; ++i_) { X.sw[i_] = *(const u32x4*)(W2 + (size_t)(t0_ + wrow0 + 32 * i_) * 1024 + h * 128 + wseg * 8); \
            X.sq[i_] = *(const u32x4*)(proj + (size_t)(t0_ + wrow0 + 32 * i_) * NPJ + OFF_GQ + h * 128 + wseg * 8); \
            const int d_ = qrow + 64 * i_; X.skd[i_] = *(const u32x4*)(proj + (size_t)(t0_ + (d_ >> 1)) * NPJ + OFF_GK + h * 128 + (d_ & 1) * 64 + qseg * 8); } \
        X.sqk = *(const u32x4*)(QKB + (size_t)ci_ * 4096 + qrow * 64 + qseg * 8); } while (0)
#define UN_LOAD(nn) do { const int t0_ = b * TT + (nn) * 64; _Pragma("unroll") for (int mt_ = 0; mt_ < 4; ++mt_) un[mt_] = *(const u32x2*)(proj + (size_t)(t0_ + (e >> 1)) * NPJ + OFF_GV + h * 128 + (e & 1) * 64 + 16 * mt_ + 4 * fq); } while (0)
#define G2_ST2(base_, rowoff_, sg_, v_) do { const int g_ = ((sg_) >> 2) * 64, d_ = ((sg_) & 3) * 8; \
        *(LAS u32x2*)(B_ + (base_) + (rowoff_) + g_ + perm4(d_) * 2) = (u32x2){(v_).x, (v_).y}; *(LAS u32x2*)(B_ + (base_) + (rowoff_) + g_ + perm4(d_ + 4) * 2) = (u32x2){(v_).z, (v_).w}; } while (0)
#define G2_STORE(X, bufi) do { LAS unsigned char* B_ = lds + (bufi) * G2_BUF; \
        _Pragma("unroll") for (int i_ = 0; i_ < 2; ++i_) { G2_ST2(G2_W, (wrow0 + 32 * i_) * 288, wseg, X.sw[i_]); G2_ST2(G2_Q, (wrow0 + 32 * i_) * 288, wseg, X.sq[i_]); \
            G2_ST2(G2_KD, (qrow + 64 * i_) * 160, qseg, X.skd[i_]); } \
        G2_ST2(G2_QK, qrow * 160, qseg, X.sqk); } while (0)
    G2_LOAD(stA, 0); G2_STORE(stA, 0); UN_LOAD(0);
    float egl_n = GL[bh * 256];
    u32x2 uc[4];
#pragma unroll
    for (int i = 0; i < 4; ++i) uc[i] = un[i];
    G2_LOAD(stA, 1);
    __syncthreads();
    for (int n2 = 0; n2 < 256; n2 += 2) {
#pragma unroll
      for (int hf2 = 0; hf2 < 2; ++hf2) {
        const int n = n2 + hf2; Stage& LDs = hf2 ? stA : stB; Stage& STs = hf2 ? stB : stA;
        const int cur = hf2, t0 = b * TT + n * 64; LAS unsigned char* Bf = lds + cur * G2_BUF;
        { const int n2c = n + 2 < 256 ? n + 2 : 255, n1c = n + 1 < 256 ? n + 1 : 255; G2_LOAD(LDs, n2c); UN_LOAD(n1c); }
        const float egl = egl_n; egl_n = GL[bh * 256 + (n + 1 < 256 ? n + 1 : 255)];
        f32x4 Pm[4], Om[4];
#pragma unroll
        for (int mt = 0; mt < 4; ++mt) { Pm[mt] = (f32x4){0.f, 0.f, 0.f, 0.f}; Om[mt] = (f32x4){0.f, 0.f, 0.f, 0.f}; }
#define SBAR __builtin_amdgcn_sched_barrier(0)
#define LD_X4(dst, base_, mp_, hf_) do { const int o0_ = (16 * (2 * (mp_)) + fr) * 288 + (64 * (hf_) + 8 * fq) * 2; \
        dst[0] = *(const LAS bf16x8*)(Bf + base_ + o0_); dst[1] = *(const LAS bf16x8*)(Bf + base_ + o0_ + 4608); \
        dst[2] = *(const LAS bf16x8*)(Bf + base_ + o0_ + 64); dst[3] = *(const LAS bf16x8*)(Bf + base_ + o0_ + 4608 + 64); } while (0)
#define MM_X4(src, A0_, A1_) do { A0_ = mfma16(src[0], sb0, A0_); A1_ = mfma16(src[1], sb0, A1_); A0_ = mfma16(src[2], sb1, A0_); A1_ = mfma16(src[3], sb1, A1_); } while (0)
#define LD_PAIR(dst, base_, p_) do { const int o0_ = (16 * (2 * (p_)) + fr) * 160 + (8 * fq) * 2; \
        dst[0] = *(const LAS bf16x8*)(Bf + base_ + o0_); dst[1] = *(const LAS bf16x8*)(Bf + base_ + o0_ + 2560); \
        dst[2] = *(const LAS bf16x8*)(Bf + base_ + o0_ + 64); dst[3] = *(const LAS bf16x8*)(Bf + base_ + o0_ + 2560 + 64); } while (0)
#define MM_PAIR(src, A0_, A1_) do { A0_ = mfma16(src[0], Vb[0], A0_); A1_ = mfma16(src[1], Vb[0], A1_); A0_ = mfma16(src[2], Vb[1], A0_); A1_ = mfma16(src[3], Vb[1], A1_); } while (0)
        bf16x8 fa[4], fb[4];
        LD_X4(fa, G2_W, 0, 0);
        { const bf16x8 sb0 = pack8(S[0], S[1]), sb1 = pack8(S[2], S[3]);
          LD_X4(fb, G2_W, 1, 0); SBAR; MM_X4(fa, Pm[0], Pm[1]); SBAR;
          LD_X4(fa, G2_W, 0, 1); SBAR; MM_X4(fb, Pm[2], Pm[3]); SBAR; }
        { const bf16x8 sb0 = pack8(S[4], S[5]), sb1 = pack8(S[6], S[7]);
          LD_X4(fb, G2_W, 1, 1); SBAR; MM_X4(fa, Pm[0], Pm[1]); SBAR;
          LD_X4(fa, G2_Q, 0, 0); SBAR; MM_X4(fb, Pm[2], Pm[3]); SBAR; }
        f32x4 vn[4];
#pragma unroll
        for (int mt = 0; mt < 4; ++mt) { vn[mt][0] = bflo(uc[mt].x) - Pm[mt][0]; vn[mt][1] = bfhi(uc[mt].x) - Pm[mt][1]; vn[mt][2] = bflo(uc[mt].y) - Pm[mt][2]; vn[mt][3] = bfhi(uc[mt].y) - Pm[mt][3]; }
        bf16x8 Vb[2];
#pragma unroll
        for (int k2 = 0; k2 < 2; ++k2) Vb[k2] = pack8(vn[2 * k2], vn[2 * k2 + 1]);
        { const bf16x8 sb0 = pack8(S[0], S[1]), sb1 = pack8(S[2], S[3]);
          LD_X4(fb, G2_Q, 1, 0); SBAR; MM_X4(fa, Om[0], Om[1]); SBAR;
          LD_X4(fa, G2_Q, 0, 1); SBAR; MM_X4(fb, Om[2], Om[3]); SBAR; }
        { const bf16x8 sb0 = pack8(S[4], S[5]), sb1 = pack8(S[6], S[7]);
          LD_X4(fb, G2_Q, 1, 1); SBAR; MM_X4(fa, Om[0], Om[1]); SBAR;
          LD_PAIR(fa, G2_QK, 0); SBAR; MM_X4(fb, Om[2], Om[3]); SBAR; }
#pragma unroll
        for (int dt = 0; dt < 8; ++dt) S[dt] = S[dt] * egl;
        SBAR;
        LD_PAIR(fb, G2_QK, 1); SBAR; MM_PAIR(fa, Om[0], Om[1]); SBAR;
        LD_PAIR(fa, G2_KD, 0); SBAR; MM_PAIR(fb, Om[2], Om[3]); SBAR;
        LD_PAIR(fb, G2_KD, 1); SBAR; MM_PAIR(fa, S[0], S[1]); SBAR;
        LD_PAIR(fa, G2_KD, 2); SBAR; MM_PAIR(fb, S[2], S[3]); SBAR;
        LD_PAIR(fb, G2_KD, 3); SBAR; MM_PAIR(fa, S[4], S[5]); SBAR;
        MM_PAIR(fb, S[6], S[7]); SBAR;
#undef LD_X4
#undef MM_X4
#undef LD_PAIR
#undef MM_PAIR
#undef SBAR
        { G2_STORE(STs, cur ^ 1);
#pragma unroll
            for (int i = 0; i < 4; ++i) uc[i] = un[i]; }
        { LAS bf16_t* OTW = (LAS bf16_t*)(lds + G2_RED + w * 2048);
#pragma unroll
          for (int mt = 0; mt < 4; ++mt)
#pragma unroll
            for (int j = 0; j < 4; ++j) OTW[(16 * mt + 4 * fq + j) * 16 + fr] = f2bf(Om[mt][j]);
#pragma unroll
          for (int i = 0; i < 2; ++i) { const int row = (lane >> 1) + 32 * i, hv = lane & 1;
              bf16_t* mp_ = mix + (size_t)(t0 + row) * DM + h * 128 + 16 * w + 8 * hv; const u32x4 ov_ = *(const LAS u32x4*)(OTW + row * 16 + hv * 8);
              asm volatile("global_store_dwordx4 %0, %1, off" :: "v"(mp_), "v"(ov_) : "memory"); } }
        __syncthreads();
      }
    }
#undef G2_LOAD
#undef UN_LOAD
#undef G2_STORE
#undef G2_ST2
    __syncthreads();
}

constexpr int AT_KS = 0, AT_VT = 73728, AT_PF = 143360, AT_MISC = 147712;
DI void phase_moba_attn(const Params& P, LAS unsigned char* lds) {
    const int tid = opq_tid(), lane = tid & 63, w = tid >> 6, fr = lane & 15, fq = lane >> 4;
    const bf16_t* proj = (const bf16_t*)(P.ws + WS_R1); const int* cnt = (const int*)(P.ws + WS_CNT); const int* list = (const int*)(P.ws + WS_LIST);
    f32x2* ML = (f32x2*)(P.ws + WS_ML); bf16_t* opart = (bf16_t*)P.out; unsigned* workctr = (unsigned*)(P.ws + WS_CTL);
    LAS bf16_t* KS = (LAS bf16_t*)(lds + AT_KS); LAS bf16_t* VT = (LAS bf16_t*)(lds + AT_VT); LAS int* PF = (LAS int*)(lds + AT_PF); LAS int* MISC = (LAS int*)(lds + AT_MISC);
    { const int c0 = cnt[2 * tid], c1 = cnt[2 * tid + 1]; const int a = (c0 + 511) >> 9, bsum = a + ((c1 + 511) >> 9); int inc = bsum;
#pragma unroll
      for (int o = 1; o < 64; o <<= 1) { const int v = __shfl_up(inc, o); if (lane >= o) inc += v; }
      if (lane == 63) MISC[8 + w] = inc;
      __syncthreads();
      int wb = 0;
#pragma unroll
      for (int i = 0; i < 8; ++i) wb += (i < w) ? MISC[8 + i] : 0;
      const int ex = wb + inc - bsum; PF[2 * tid] = ex; PF[2 * tid + 1] = ex + a; if (tid == 511) PF[1024] = ex + bsum;
      __syncthreads(); }
    const int totalG = PF[1024];
    const float sc2 = 0.08838834764831845f * 1.4426950408889634f;
    const int tid_at = tid;
    for (;;) {
        int tid = tid_at; asm volatile("" : "+v"(tid)); const int lane = tid & 63, w = __builtin_amdgcn_readfirstlane(tid >> 6), fr = lane & 15, fq = lane >> 4;
        if (tid == 0) MISC[0] = (int)atomicAdd(workctr, 1u);
        __syncthreads();
        const int wid = MISC[0];
        __syncthreads();
        if (wid >= totalG + 1024) break;
        int bh, j, causal, qstart, qcount;
        if (wid < totalG) { int lo = 0, hi = 1024; while (hi - lo > 1) { const int mid = (lo + hi) >> 1; if (PF[mid] <= wid) lo = mid; else hi = mid; }
            bh = lo >> 6; j = lo & 63; causal = 0; qstart = (wid - PF[lo]) * 512; const int c = cnt[lo]; qcount = c - qstart; if (qcount > 512) qcount = 512; }
        else { const int o = wid - totalG; bh = o >> 6; j = o & 63; causal = 1; qstart = 0; qcount = 256; }
        const int b = bh >> 3, h = bh & 7; const size_t kbase = (size_t)(b * TT + j * 256);
        { u32x4 kr[8], vr[8];
#pragma unroll
          for (int i8 = 0; i8 < 8; ++i8) { const int pid = tid + i8 * 512; kr[i8] = *(const u32x4*)(proj + (kbase + (pid >> 4)) * NPJ + OFF_MK + h * 128 + (pid & 15) * 8);
              const int e = pid >> 5, ks = pid & 31; vr[i8] = *(const u32x4*)(proj + (kbase + 2 * e + (ks >> 4)) * NPJ + OFF_MV + h * 128 + (ks & 15) * 8); }
#pragma unroll
          for (int i8 = 0; i8 < 8; ++i8) { const int pid = tid + i8 * 512; *(LAS u32x4*)(KS + (pid >> 4) * 144 + (pid & 15) * 8) = kr[i8];
              const int e = pid >> 5, ks = pid & 31; const int g_ = (ks >> 2) * 32, d_ = (ks & 3) * 8;
              *(LAS u32x2*)(VT + e * 272 + g_ + perm4(d_)) = (u32x2){vr[i8].x, vr[i8].y}; *(LAS u32x2*)(VT + e * 272 + g_ + perm4(d_ + 4)) = (u32x2){vr[i8].z, vr[i8].w}; } }
        const int lbase = bh * LISTN + j * 16384 - 128 * j * (j + 1) + qstart;
        const int ntile = (qcount + 127) >> 7;
        int en0, en1, en2, en3;
        { const int q0 = 16 * w + fr, lim = qcount - 1;
          if (causal) { en0 = (j * 256 + q0) | (3 << 14); en1 = (j * 256 + q0 + 128) | (3 << 14); en2 = en1; en3 = en1; }
          else { en0 = list[lbase + (q0 < lim ? q0 : lim)]; en1 = list[lbase + (q0 + 128 < lim ? q0 + 128 : lim)]; en2 = list[lbase + (q0 + 256 < lim ? q0 + 256 : lim)]; en3 = list[lbase + (q0 + 384 < lim ? q0 + 384 : lim)]; } }
        bf16x8 Bq[4], Bn[4];
        { const bf16_t* qp = proj + (size_t)(b * TT + (en0 & 16383)) * NPJ + OFF_MQ + h * 128 + 8 * fq;
#pragma unroll
          for (int ks = 0; ks < 4; ++ks) Bq[ks] = *(const bf16x8*)(qp + 32 * ks); }
        __syncthreads();
        for (int tile = 0; tile < ntile; ++tile) {
            const int en = tile == 0 ? en0 : (tile == 1 ? en1 : (tile == 2 ? en2 : en3));
            { const int enx = tile == 0 ? en1 : (tile == 1 ? en2 : en3); const bf16_t* qp = proj + (size_t)(b * TT + (enx & 16383)) * NPJ + OFF_MQ + h * 128 + 8 * fq;
#pragma unroll
              for (int ks = 0; ks < 4; ++ks) Bn[ks] = *(const bf16x8*)(qp + 32 * ks); }
            const int qi = tile * 128 + 16 * w + fr; const bool valid = qi < qcount; const int t = en & 16383, slot = en >> 14;
            if (tile * 128 + 16 * w < qcount) {
            const int nkt = causal ? (8 * tile + w + 1) : 16;
            f32x4 st[16]; float mx = -INFINITY;
#pragma unroll
            for (int kp = 0; kp < 8; ++kp) { f32x4 a0 = {0.f, 0.f, 0.f, 0.f}, a1 = {0.f, 0.f, 0.f, 0.f};
                if (2 * kp < nkt) { bf16x8 kf[8];
#pragma unroll
                    for (int ks = 0; ks < 4; ++ks) { kf[ks] = *(const LAS bf16x8*)(KS + (32 * kp + fr) * 144 + 32 * ks + 8 * fq); kf[4 + ks] = *(const LAS bf16x8*)(KS + (32 * kp + 16 + fr) * 144 + 32 * ks + 8 * fq); }
#pragma unroll
                    for (int ks = 0; ks < 4; ++ks) { a0 = mfma16(kf[ks], Bq[ks], a0); a1 = mfma16(kf[4 + ks], Bq[ks], a1); }
#pragma unroll
                    for (int jj = 0; jj < 4; ++jj) { float s0 = a0[jj] * sc2, s1 = a1[jj] * sc2;
                        if (causal && (32 * kp + 4 * fq + jj) > qi) s0 = -INFINITY; if ((causal && (32 * kp + 16 + 4 * fq + jj) > qi) || 2 * kp + 1 >= nkt) s1 = -INFINITY;
                        a0[jj] = s0; a1[jj] = s1; mx = fmaxf(mx, fmaxf(s0, s1)); }
                } else { a0 = (f32x4){-INFINITY, -INFINITY, -INFINITY, -INFINITY}; a1 = a0; }
                st[2 * kp] = a0; st[2 * kp + 1] = a1; }
            mx = fmaxf(mx, __shfl_xor(mx, 16)); mx = fmaxf(mx, __shfl_xor(mx, 32));
            float ls = 0.f;
#pragma unroll
            for (int kt = 0; kt < 16; ++kt)
#pragma unroll
                for (int jj = 0; jj < 4; ++jj) { const float pv = exp2f(st[kt][jj] - mx); st[kt][jj] = pv; ls += pv; }
            ls += __shfl_xor(ls, 16); ls += __shfl_xor(ls, 32);
            f32x4 ot[8];
#pragma unroll
            for (int et = 0; et < 8; ++et) ot[et] = (f32x4){0.f, 0.f, 0.f, 0.f};
#pragma unroll
            for (int k2 = 0; k2 < 8; ++k2) { if (2 * k2 < nkt) { const bf16x8 pb = pack8(st[2 * k2], st[2 * k2 + 1]);
#pragma unroll
                    for (int eh = 0; eh < 2; ++eh) { bf16x8 vf[4];
#pragma unroll
                        for (int et = 0; et < 4; ++et) vf[et] = *(const LAS bf16x8*)(VT + (16 * (4 * eh + et) + fr) * 272 + 32 * k2 + 8 * fq);
#pragma unroll
                        for (int et = 0; et < 4; ++et) ot[4 * eh + et] = mfma16(vf[et], pb, ot[4 * eh + et]); } } }
            if (valid) { const float il = 1.f / ls; const size_t rid = (size_t)bh * TT + t; bf16_t* op = opart + ((size_t)slot * 262144 + rid) * 128 + 4 * fq;
#pragma unroll
                for (int et = 0; et < 8; ++et) { u32x2 wv; wv.x = pk2(ot[et][0] * il, ot[et][1] * il); wv.y = pk2(ot[et][2] * il, ot[et][3] * il); *(u32x2*)(op + 16 * et) = wv; }
                if (fq == 0) ML[(size_t)slot * 262144 + rid] = (f32x2){mx, ls}; }
            }
#pragma unroll
            for (int ks = 0; ks < 4; ++ks) Bq[ks] = Bn[ks];
        }
        __syncthreads();
    }
}

DI void phase_moba_combine(const Params& P) {
    const bf16_t* opart = (const bf16_t*)P.out; const f32x2* ML = (const f32x2*)(P.ws + WS_ML); bf16_t* mix = (bf16_t*)(P.ws + WS_R2);
    const int gtid = blockIdx.x * NTHREADS + opq_tid(), gsz = gridDim.x * NTHREADS;
    { const bf16_t* proj = (const bf16_t*)(P.ws + WS_R1);
      for (int i = gtid; i < MT * 128; i += gsz) { const int row = i >> 7, sg = i & 127; bf16_t* mp = mix + (size_t)row * DM + sg * 8; const u32x4 mv = *(const u32x4*)mp, zv = *(const u32x4*)(proj + (size_t)row * NPJ + OFF_GZ + sg * 8);
          const f32x4 g0 = *(const f32x4*)(P.gdn_norm + (sg & 15) * 8), g1 = *(const f32x4*)(P.gdn_norm + (sg & 15) * 8 + 4);
          float o[8]; o[0] = bflo(mv.x); o[1] = bfhi(mv.x); o[2] = bflo(mv.y); o[3] = bfhi(mv.y); o[4] = bflo(mv.z); o[5] = bfhi(mv.z); o[6] = bflo(mv.w); o[7] = bfhi(mv.w);
          float ssl = 0.f;
#pragma unroll
          for (int k = 0; k < 8; ++k) ssl += o[k] * o[k];
          const float rs = rsqrtf(row16_sum(ssl) * (1.f / 128.f) + 1e-6f);
          u32x4 wv; wv.x = pk2(o[0] * rs * g0[0] * silu_f(bflo(zv.x)), o[1] * rs * g0[1] * silu_f(bfhi(zv.x))); wv.y = pk2(o[2] * rs * g0[2] * silu_f(bflo(zv.y)), o[3] * rs * g0[3] * silu_f(bfhi(zv.y)));
          wv.z = pk2(o[4] * rs * g1[0] * silu_f(bflo(zv.z)), o[5] * rs * g1[1] * silu_f(bfhi(zv.z))); wv.w = pk2(o[6] * rs * g1[2] * silu_f(bflo(zv.w)), o[7] * rs * g1[3] * silu_f(bfhi(zv.w))); *(u32x4*)mp = wv; } }
    for (int i = gtid; i < 262144 * 16; i += gsz) { const int rid = i >> 4, sg = i & 15; const int bh = rid >> 14, t = rid & 16383, b = bh >> 3, h = bh & 7;
        f32x2 ml[4]; float M = -INFINITY;
#pragma unroll
        for (int s = 0; s < 4; ++s) { ml[s] = ML[(size_t)s * 262144 + rid]; M = fmaxf(M, ml[s].x); }
        float wgt[4], Lt = 0.f;
#pragma unroll
        for (int s = 0; s < 4; ++s) { wgt[s] = ml[s].y > 0.f ? ml[s].y * exp2f(ml[s].x - M) : 0.f; Lt += wgt[s]; }
        const float iL = 1.f / Lt; float o[8];
#pragma unroll
        for (int k = 0; k < 8; ++k) o[k] = 0.f;
#pragma unroll
        for (int s = 0; s < 4; ++s) { if (wgt[s] > 0.f) { const u32x4 raw = *(const u32x4*)(opart + ((size_t)s * 262144 + rid) * 128 + sg * 8); const float ww = wgt[s] * iL;
                o[0] += ww * bflo(raw.x); o[1] += ww * bfhi(raw.x); o[2] += ww * bflo(raw.y); o[3] += ww * bfhi(raw.y); o[4] += ww * bflo(raw.z); o[5] += ww * bfhi(raw.z); o[6] += ww * bflo(raw.w); o[7] += ww * bfhi(raw.w); } }
        u32x4 wv; wv.x = pk2(o[0], o[1]); wv.y = pk2(o[2], o[3]); wv.z = pk2(o[4], o[5]); wv.w = pk2(o[6], o[7]);
        *(u32x4*)(mix + (size_t)(b * TT + t) * DM + 1024 + h * 128 + sg * 8) = wv; }
}

__global__ void __launch_bounds__(NTHREADS) hybrid_fwd(Params P) {
    extern __shared__ __attribute__((aligned(16))) unsigned char smem[];
    LAS unsigned char* lds = (LAS unsigned char*)smem;
    cg::grid_group grid = cg::this_grid();
    unsigned char* ws = P.ws; const int G = gridDim.x, bx = blockIdx.x;
    bf16_t* R0 = (bf16_t*)(ws + WS_R0); bf16_t* R1 = (bf16_t*)(ws + WS_R1); bf16_t* R2 = (bf16_t*)(ws + WS_R2);
    float* ss1 = (float*)(ws + WS_SS1); float* ss2 = (float*)(ws + WS_SS2);

    phase_prep(P, lds);
    grid.sync();
    { pg8::Gemm g{R0, (const bf16_t*)(ws + WS_WIN), MT, NPJ, DM}; pg8::StaticOrder S; S.init(MT, NPJ, G, bx); EpiProj E{R1, (bf16_t*)(ws + WS_HALO)}; pg8::gemm_phase(lds, g, S, E); }
    phase_ba(P);
    grid.sync();
    phase_gdn_prep(P, lds);
    phase_moba_prep(P, lds);
    grid.sync();
    phase_moba_select(P, lds);
    grid.sync();
    if (bx < 16) phase_gdn_scan(P, lds, bx);
    phase_moba_attn(P, lds);
    if (bx >= 16) phase_wconv_late(P, lds, bx - 16, G - 16);
    grid.sync();
    phase_moba_combine(P);
    grid.sync();
    { pg8::Gemm g{R2, (const bf16_t*)(ws + WS_WO), MT, DM, DM}; pg8::StaticOrder S; S.init(MT, DM, G, bx); EpiResid E{P.x, P.out, R0, ss1}; pg8::gemm_phase(lds, g, S, E); }
    grid.sync();
    { pg8::Gemm g{R0, (const bf16_t*)(ws + WS_WGU), MT, 2 * FF, DM}; pg8::StaticOrder S; S.init(MT, 2 * FF, G, bx); EpiAct E{R1, ss1}; pg8::gemm_phase(lds, g, S, E); }
    grid.sync();
    { pg8::Gemm g{(const bf16_t*)(ws + WS_PB), (const bf16_t*)(ws + WS_WPP), MT, DM, 256}; pg8::StaticOrder S; S.init(MT, DM, G, bx); EpiPlainBf16 E{R0, DM}; pg8::gemm_phase(lds, g, S, E); }
    { pg8::Gemm g{R1, (const bf16_t*)(ws + WS_WDN), MT, DM, FF}; pg8::StaticOrder S; S.init(MT, DM, G, bx); EpiResid E{P.out, P.out, R2, ss2}; pg8::gemm_phase(lds, g, S, E); }
    grid.sync();
    { pg8::Gemm g{R2, (const bf16_t*)(ws + WS_WPG), MT, DM, DM}; pg8::StaticOrder S; S.init(MT, DM, G, bx); EpiOut E{P.out, R0, ss2}; pg8::gemm_phase(lds, g, S, E); }
}

extern "C" void kernel_launch(void* const* d_in, const int* in_sizes, int n_in, void* d_out, int out_size, void* d_ws, size_t ws_size, hipStream_t stream) {
    static int grid_blocks = 0;
    if (!grid_blocks) {
        int dev = 0, cus = 0, per_cu = 0;
        hipGetDevice(&dev);
        hipDeviceGetAttribute(&cus, hipDeviceAttributeMultiprocessorCount, dev);
        hipFuncSetAttribute((const void*)hybrid_fwd, hipFuncAttributeMaxDynamicSharedMemorySize, LDS_BYTES);
        hipOccupancyMaxActiveBlocksPerMultiprocessor(&per_cu, (const void*)hybrid_fwd, NTHREADS, LDS_BYTES);
        if (per_cu < 1) per_cu = 1;
        grid_blocks = cus * per_cu;
        if (ws_size < WS_END) fprintf(stderr, "kernel_launch: workspace too small: %zu < %zu\n", ws_size, (size_t)WS_END);
    }
    Params p{};
    p.x = (const float*)d_in[0]; p.p = (const float*)d_in[1]; p.attn_norm = (const float*)d_in[2]; p.w_in = (const float*)d_in[3]; p.conv_w = (const float*)d_in[4];
    p.A_log = (const float*)d_in[5]; p.dt_bias = (const float*)d_in[6]; p.gdn_norm = (const float*)d_in[7]; p.q_norm = (const float*)d_in[8]; p.k_norm = (const float*)d_in[9];
    p.w_o = (const float*)d_in[10]; p.ffn_norm = (const float*)d_in[11]; p.w_gate = (const float*)d_in[12]; p.w_up = (const float*)d_in[13]; p.w_down = (const float*)d_in[14];
    p.ple_norm = (const float*)d_in[15]; p.w_pg = (const float*)d_in[16]; p.w_pp = (const float*)d_in[17];
    p.out = (float*)d_out; p.ws = (unsigned char*)d_ws;
    void* args[] = {&p};
    hipError_t e = hipLaunchCooperativeKernel((const void*)hybrid_fwd, dim3(grid_blocks), dim3(NTHREADS), args, LDS_BYTES, stream);
    if (e != hipSuccess) fprintf(stderr, "cooperative launch failed: %s (grid %d)\n", hipGetErrorString(e), grid_blocks);
}
```

```cpp
#include <hip/hip_runtime.h>
#include <hip/hip_cooperative_groups.h>
#include <cstdio>
namespace cg = cooperative_groups;

#define LAS __attribute__((address_space(3)))
#define DI __device__ __forceinline__
typedef unsigned short bf16_t;
typedef short bf16x8 __attribute__((ext_vector_type(8)));
typedef float f32x4 __attribute__((ext_vector_type(4)));
typedef float f32x2 __attribute__((ext_vector_type(2)));
typedef unsigned u32x4 __attribute__((ext_vector_type(4)));
typedef unsigned u32x2 __attribute__((ext_vector_type(2)));
typedef __bf16 bfv2 __attribute__((ext_vector_type(2)));

constexpr int DM = 2048, TT = 16384, MT = 32768, NPJ = 7168, FF = 5632, INW = 7184;
constexpr int OFF_GQ = 0, OFF_GK = 1024, OFF_GV = 2048, OFF_GZ = 3072, OFF_MQ = 4096, OFF_MK = 5120, OFF_MV = 6144;
constexpr int LISTN = 516096;
constexpr int NTHREADS = 512;
constexpr int LDS_BYTES = 163840;

constexpr size_t WS_CTL   = 0;
constexpr size_t WS_CNT   = 4096;
constexpr size_t WS_SS1   = 8192;
constexpr size_t WS_SS2   = WS_SS1 + 131072;
constexpr size_t WS_GL    = WS_SS2 + 131072;
constexpr size_t WS_KMEAN = WS_GL + 16384;
constexpr size_t WS_WBA   = WS_KMEAN + 524288;
constexpr size_t WS_BA    = WS_WBA + 65536;
constexpr size_t WS_WIN   = WS_BA + 2097152;
constexpr size_t WS_WO    = WS_WIN + (size_t)7168 * 2048 * 2;
constexpr size_t WS_WGU   = WS_WO + (size_t)2048 * 2048 * 2;
constexpr size_t WS_WDN   = WS_WGU + (size_t)11264 * 2048 * 2;
constexpr size_t WS_WPG   = WS_WDN + (size_t)2048 * 5632 * 2;
constexpr size_t WS_WPP   = WS_WPG + (size_t)2048 * 2048 * 2;
constexpr size_t WS_PB    = WS_WPP + (size_t)2048 * 256 * 2;
constexpr size_t WS_R0    = WS_PB + (size_t)32768 * 256 * 2;
constexpr size_t WS_R1    = WS_R0 + (size_t)32768 * 2048 * 2;
constexpr size_t WS_R2    = WS_R1 + (size_t)32768 * 7168 * 2;
constexpr size_t WS_W2    = WS_R2 + (size_t)32768 * 2048 * 2;
constexpr size_t WS_QKB   = WS_W2 + (size_t)32768 * 1024 * 2;
constexpr size_t WS_HALO  = WS_QKB + (size_t)4096 * 4096 * 2;
constexpr size_t WS_LIST  = WS_HALO + (size_t)513 * 3 * 3072 * 2 + 256 - ((size_t)513 * 3 * 3072 * 2) % 256;
constexpr size_t WS_ML    = WS_LIST + (size_t)16 * LISTN * 4;
constexpr size_t WS_SSQ   = WS_ML + (size_t)4 * 262144 * 8;
constexpr size_t WS_END   = WS_SSQ + (size_t)32768 * 64 * 4;

struct Params {
    const float* x; const float* p; const float* attn_norm; const float* w_in; const float* conv_w; const float* A_log; const float* dt_bias;
    const float* gdn_norm; const float* q_norm; const float* k_norm; const float* w_o; const float* ffn_norm; const float* w_gate; const float* w_up;
    const float* w_down; const float* ple_norm; const float* w_pg; const float* w_pp;
    float* out; unsigned char* ws;
};

DI unsigned pk2(float a, float b) { f32x2 v = {a, b}; bfv2 r = __builtin_convertvector(v, bfv2); return __builtin_bit_cast(unsigned, r); }
DI bf16_t f2bf(float a) { return (bf16_t)(pk2(a, 0.f) & 0xffffu); }
DI float bflo(unsigned w) { return __uint_as_float(w << 16); }
DI float bfhi(unsigned w) { return __uint_as_float(w & 0xffff0000u); }
DI float bf2f(bf16_t v) { return __uint_as_float(((unsigned)v) << 16); }
DI bf16x8 pack8(const f32x4& a, const f32x4& b) { u32x4 w; w.x = pk2(a[0], a[1]); w.y = pk2(a[2], a[3]); w.z = pk2(b[0], b[1]); w.w = pk2(b[2], b[3]); return __builtin_bit_cast(bf16x8, w); }
DI bf16x8 cat8(u32x2 lo, u32x2 hi) { u32x4 w; w.x = lo.x; w.y = lo.y; w.z = hi.x; w.w = hi.y; return __builtin_bit_cast(bf16x8, w); }
DI f32x4 mfma16(bf16x8 a, bf16x8 b, f32x4 c) { return __builtin_amdgcn_mfma_f32_16x16x32_bf16(a, b, c, 0, 0, 0); }
DI int perm4(int d4) { return d4 < 16 ? 2 * d4 : 2 * (d4 - 16) + 4; }
DI float dpp_f(float v, int ctrl_sel) { int x = __float_as_int(v); int r;
    if (ctrl_sel == 0) r = __builtin_amdgcn_mov_dpp(x, 0xB1, 0xf, 0xf, true); else if (ctrl_sel == 1) r = __builtin_amdgcn_mov_dpp(x, 0x4E, 0xf, 0xf, true);
    else if (ctrl_sel == 2) r = __builtin_amdgcn_mov_dpp(x, 0x141, 0xf, 0xf, true); else r = __builtin_amdgcn_mov_dpp(x, 0x140, 0xf, 0xf, true);
    return __int_as_float(r); }
DI float row16_sum(float v) { v += dpp_f(v, 0); v += dpp_f(v, 1); v += dpp_f(v, 2); v += dpp_f(v, 3); return v; }
DI float silu_f(float v) { return v * __builtin_amdgcn_rcpf(1.f + __expf(-v)); }
DI float sigm_f(float v) { return __builtin_amdgcn_rcpf(1.f + __expf(-v)); }

DI int opq_tid() { int t = threadIdx.x; asm volatile("" : "+v"(t)); return t; }

namespace pg8 {
constexpr int BM = 256, BK = 64, HALF = 128, HTB = HALF * BK * 2, STAGE_BYTES = 8 * HTB, NXCD = 8, WGM = 8;
DI int lds_byte(int r, int c) { const int st = (r >> 4) * 2 + (c >> 5), rr = r & 15, cc = c & 31, ob = rr * 64 + cc * 2; return st * 1024 + (ob ^ (((ob >> 9) & 1) << 5)); }
DI void stage_rc(int b, int& R, int& C) { const int st = b / 1024, sb = b % 1024, swz = sb ^ (((sb >> 9) & 1) << 5); R = (st >> 1) * 16 + swz / 64; C = (st & 1) * 32 + (swz % 64) / 2; }
DI int perm32(int rho) { const int n = rho >> 4, i = rho & 15; return 8 * (i >> 2) + 4 * n + (i & 3); }
struct Unit { int pm, pn; };
struct Gemm { const bf16_t* A; const bf16_t* Bt; int M, N, K; };
struct StaticOrder {
    int nM, nN, nwg, G, c;
    DI void init(int M, int N, int G_, int c_) { nM = M / BM; nN = N / BM; nwg = nM * nN; G = G_; c = c_; }
    DI bool next(int i, Unit& u) const {
        const long L = (long)i * G + c; if (L >= nwg) return false;
        int wgid = (int)L; { const int q = nwg / NXCD, r = nwg % NXCD, xcd = wgid % NXCD, off = wgid / NXCD; wgid = (xcd < r ? xcd * (q + 1) : r * (q + 1) + (xcd - r) * q) + off; }
        const int nig = WGM * nN, gid = wgid / nig, fm = gid * WGM, gsz = (nM - fm) < WGM ? (nM - fm) : WGM;
        u.pm = fm + ((wgid % nig) % gsz); u.pn = (wgid % nig) / gsz; return true;
    }
    DI void a_ready(const Unit&) const {}
    DI void done(const Unit&) const {}
};

template <class Epi, class Sched, bool ALIGN_EPI = false, bool SP2 = false>
DI void gemm_phase(LAS unsigned char* lds, const Gemm g, const Sched& S, const Epi& E) {
    const int tid = opq_tid(), wid = __builtin_amdgcn_readfirstlane(tid >> 6), lane = tid & 63, wr = wid >> 2, wc = wid & 3, fr = lane & 15, fq = lane >> 4;
    const int K = g.K, nt = K / BK;
    unsigned voffA[2], voffB[2];
#pragma unroll
    for (int i = 0; i < 2; ++i) { int R, C; stage_rc(tid * 16 + i * 8192, R, C); const int Rb = Epi::PERM ? ((R & ~31) + perm32(R & 31)) : R;
        voffA[i] = (unsigned)(R * K + C) * 2u; voffB[i] = (unsigned)(Rb * K + C) * 2u; }
    const size_t kstep = (size_t)(BK * 2);
    const size_t hstep = (size_t)HALF * K * 2;
    const size_t tstep = 2 * hstep;
    const unsigned ldsw = (unsigned)wid * 1024u;
    const int aoff = lds_byte(wr * 64 + fr, fq * 8), boff = lds_byte(wc * 32 + fr, fq * 8);
#define PG8_SA(b, h) (((b) * 2 + (h)) * HTB)
#define PG8_SB(b, h) ((4 + (b) * 2 + (h)) * HTB)
#define PG8_STAGE(bufoff, gbase, voff) do { _Pragma("unroll") for (int _i = 0; _i < 2; ++_i) \
        __builtin_amdgcn_global_load_lds((const unsigned*)((const char*)(gbase) + (voff)[_i]), (LAS unsigned*)(lds + (bufoff) + ldsw + _i * 8192), 16, 0, 0); } while (0)
#define PG8_LDA(dst, b, h) do { _Pragma("unroll") for (int m = 0; m < 4; ++m) _Pragma("unroll") for (int k = 0; k < 2; ++k) dst[m][k] = *(const LAS bf16x8*)(lds + PG8_SA(b, h) + aoff + m * 2048 + k * 1024); } while (0)
#define PG8_LDB(dst, b, h) do { _Pragma("unroll") for (int n = 0; n < 2; ++n) _Pragma("unroll") for (int k = 0; k < 2; ++k) dst[n][k] = *(const LAS bf16x8*)(lds + PG8_SB(b, h) + boff + n * 2048 + k * 1024); } while (0)
#define PG8_MMA(ai, bj, At, Bt) do { __builtin_amdgcn_s_setprio(1); _Pragma("unroll") for (int m = 0; m < 4; ++m) _Pragma("unroll") for (int n = 0; n < 2; ++n) _Pragma("unroll") for (int k = 0; k < 2; ++k) \
        acc[ai][bj][m][n] = __builtin_amdgcn_mfma_f32_16x16x32_bf16(Bt[n][k], At[m][k], acc[ai][bj][m][n], 0, 0, 0); __builtin_amdgcn_s_setprio(0); } while (0)
#define PG8_WAIT_V(n) asm volatile("s_waitcnt vmcnt(" #n ")" ::: "memory")
#define PG8_WAIT_L(n) asm volatile("s_waitcnt lgkmcnt(" #n ")" ::: "memory")
#define PG8_BAR __builtin_amdgcn_s_barrier()
#define PG8_SCHED __builtin_amdgcn_sched_barrier(0)
    Unit cur, nxt; int ui = 0;
    if (!S.next(0, cur)) return;
    f32x4 acc[2][2][4][2];
#pragma unroll
    for (int a = 0; a < 2; ++a)
#pragma unroll
        for (int b = 0; b < 2; ++b)
#pragma unroll
            for (int m = 0; m < 4; ++m)
#pragma unroll
                for (int n = 0; n < 2; ++n) acc[a][b][m][n] = (f32x4){0.f, 0.f, 0.f, 0.f};
    bf16x8 At[4][2], B0[2][2], B1[2][2];
    const char* cA = (const char*)g.A + (size_t)cur.pm * tstep; const char* cB = (const char*)g.Bt + (size_t)cur.pn * tstep;
    S.a_ready(cur);
    if constexpr (SP2) {
        PG8_STAGE(PG8_SB(0, 0), cB, voffB); PG8_STAGE(PG8_SB(0, 1), cB + hstep, voffB); PG8_STAGE(PG8_SA(0, 0), cA, voffA); PG8_STAGE(PG8_SA(0, 1), cA + hstep, voffA);
        if (wr == 1) PG8_BAR;
        PG8_WAIT_V(2); PG8_BAR;
        PG8_STAGE(PG8_SB(1, 0), cB + kstep, voffB); PG8_STAGE(PG8_SA(1, 0), cA + kstep, voffA); PG8_STAGE(PG8_SB(1, 1), cB + hstep + kstep, voffB);
        PG8_WAIT_V(6); PG8_BAR;
    } else {
        PG8_STAGE(PG8_SB(0, 0), cB, voffB); PG8_STAGE(PG8_SA(0, 0), cA, voffA); PG8_STAGE(PG8_SB(0, 1), cB + hstep, voffB); PG8_STAGE(PG8_SA(0, 1), cA + hstep, voffA);
        if (wr == 1) PG8_BAR;
        PG8_WAIT_V(4); PG8_BAR;
        PG8_STAGE(PG8_SB(1, 0), cB + kstep, voffB); PG8_STAGE(PG8_SA(1, 0), cA + kstep, voffA); PG8_STAGE(PG8_SB(1, 1), cB + hstep + kstep, voffB);
        PG8_WAIT_V(6); PG8_BAR;
    }
    for (;;) {
        const bool has_next = S.next(ui + 1, nxt);
        const char* nA = has_next ? (const char*)g.A + (size_t)nxt.pm * tstep : cA; const char* nB = has_next ? (const char*)g.Bt + (size_t)nxt.pn * tstep : cB;
        for (int t = 0; t < nt; t += 2) {
            const bool last = (t == nt - 2);
            const char* a1 = cA + (size_t)(t + 1) * kstep;
            const char* a2 = last ? nA : cA + (size_t)(t + 2) * kstep; const char* b2 = last ? nB : cB + (size_t)(t + 2) * kstep;
            const char* a3 = a2 + kstep; const char* b3 = b2 + kstep;
            if (last && has_next) S.a_ready(nxt);
            if constexpr (SP2) {
            PG8_LDB(B0, 0, 0); PG8_LDB(B1, 0, 1); PG8_SCHED; PG8_LDA(At, 0, 0); PG8_STAGE(PG8_SA(1, 1), a1 + hstep, voffA);
            PG8_WAIT_V(8); PG8_WAIT_L(0); PG8_BAR; PG8_MMA(0, 0, At, B0); PG8_MMA(0, 1, At, B1); PG8_BAR; PG8_SCHED;
            PG8_LDA(At, 0, 1); PG8_STAGE(PG8_SB(0, 0), b2, voffB); PG8_STAGE(PG8_SB(0, 1), b2 + hstep, voffB); PG8_STAGE(PG8_SA(0, 0), a2, voffA);
            PG8_WAIT_V(8); PG8_WAIT_L(0); PG8_BAR; PG8_MMA(1, 0, At, B0); PG8_MMA(1, 1, At, B1); PG8_BAR; PG8_SCHED;
            PG8_LDB(B0, 1, 0); PG8_LDB(B1, 1, 1); PG8_SCHED; PG8_LDA(At, 1, 0); PG8_STAGE(PG8_SA(0, 1), a2 + hstep, voffA);
            PG8_WAIT_V(8); PG8_WAIT_L(0); PG8_BAR; PG8_MMA(0, 0, At, B0); PG8_MMA(0, 1, At, B1); PG8_BAR; PG8_SCHED;
            PG8_LDA(At, 1, 1); PG8_STAGE(PG8_SB(1, 0), b3, voffB); PG8_STAGE(PG8_SB(1, 1), b3 + hstep, voffB); PG8_STAGE(PG8_SA(1, 0), a3, voffA);
            PG8_WAIT_V(8); PG8_WAIT_L(0); PG8_BAR; PG8_MMA(1, 0, At, B0); PG8_MMA(1, 1, At, B1); PG8_BAR; PG8_SCHED;
            } else {
            PG8_LDB(B0, 0, 0); PG8_SCHED; PG8_LDA(At, 0, 0); PG8_STAGE(PG8_SA(1, 1), a1 + hstep, voffA);
            PG8_WAIT_L(8); PG8_BAR; PG8_WAIT_L(0); PG8_MMA(0, 0, At, B0); PG8_BAR; PG8_SCHED;
            PG8_LDB(B1, 0, 1); PG8_STAGE(PG8_SB(0, 0), b2, voffB);
            PG8_BAR; PG8_WAIT_L(0); PG8_MMA(0, 1, At, B1); PG8_BAR;
            PG8_LDA(At, 0, 1); PG8_STAGE(PG8_SA(0, 0), a2, voffA);
            PG8_BAR; PG8_WAIT_L(0); PG8_MMA(1, 0, At, B0); PG8_BAR; PG8_SCHED;
            PG8_STAGE(PG8_SB(0, 1), b2 + hstep, voffB);
            PG8_WAIT_V(6); PG8_BAR; PG8_MMA(1, 1, At, B1); PG8_BAR;
            PG8_LDB(B0, 1, 0); PG8_SCHED; PG8_LDA(At, 1, 0); PG8_STAGE(PG8_SA(0, 1), a2 + hstep, voffA);
            PG8_WAIT_L(8); PG8_BAR; PG8_WAIT_L(0); PG8_MMA(0, 0, At, B0); PG8_BAR; PG8_SCHED;
            PG8_LDB(B1, 1, 1); PG8_STAGE(PG8_SB(1, 0), b3, voffB);
            PG8_BAR; PG8_WAIT_L(0); PG8_MMA(0, 1, At, B1); PG8_BAR;
            PG8_LDA(At, 1, 1); PG8_STAGE(PG8_SA(1, 0), a3, voffA);
            PG8_BAR; PG8_WAIT_L(0); PG8_MMA(1, 0, At, B0); PG8_BAR; PG8_SCHED;
            PG8_STAGE(PG8_SB(1, 1), b3 + hstep, voffB);
            PG8_WAIT_V(6); PG8_BAR; PG8_MMA(1, 1, At, B1); PG8_BAR;
            }
        }
        if constexpr (ALIGN_EPI) { if (wr == 0) PG8_BAR; }
        if constexpr (!Epi::AFTER_DRAIN) { E(acc, cur, wr, wc, fr, fq); S.done(cur); }
        if (!has_next) break;
#pragma unroll
        for (int a = 0; a < 2; ++a)
#pragma unroll
            for (int b = 0; b < 2; ++b)
#pragma unroll
                for (int m = 0; m < 4; ++m)
#pragma unroll
                    for (int n = 0; n < 2; ++n) acc[a][b][m][n] = (f32x4){0.f, 0.f, 0.f, 0.f};
        cur = nxt; cA = nA; cB = nB; ++ui;
        if constexpr (ALIGN_EPI) { if (wr == 1) PG8_BAR; }
    }
    PG8_WAIT_V(0);
    if constexpr (!ALIGN_EPI) { if (wr == 0) PG8_BAR; }
    PG8_BAR;
    if constexpr (Epi::AFTER_DRAIN) { E.fused(acc, cur, wr, wc, fr, fq, lds, wid, lane); S.done(cur); }
#undef PG8_SA
#undef PG8_SB
#undef PG8_STAGE
#undef PG8_LDA
#undef PG8_LDB
#undef PG8_MMA
#undef PG8_WAIT_V
#undef PG8_WAIT_L
#undef PG8_BAR
#undef PG8_SCHED
}
}
using pg8::Unit;

struct EpiProj {
    static constexpr bool PERM = true, AFTER_DRAIN = false;
    bf16_t* O; bf16_t* halo;
    DI void operator()(const f32x4 (&acc)[2][2][4][2], const Unit& u, int wr, int wc, int fr, int fq) const {
        const int row0 = u.pm * 256 + wr * 64 + fr, col0 = u.pn * 256 + wc * 32 + 8 * fq;
#pragma unroll
        for (int ai = 0; ai < 2; ++ai)
#pragma unroll
            for (int m = 0; m < 4; ++m) { const int row = row0 + ai * 128 + m * 16; bf16_t* rowp = O + (size_t)row * NPJ + col0;
#pragma unroll
                for (int bj = 0; bj < 2; ++bj) { const f32x4 v0 = acc[ai][bj][m][0], v1 = acc[ai][bj][m][1];
                    u32x4 w; w.x = pk2(v0[0], v0[1]); w.y = pk2(v0[2], v0[3]); w.z = pk2(v1[0], v1[1]); w.w = pk2(v1[2], v1[3]);
                    *(u32x4*)(rowp + bj * 128) = w;
                    if (m == 3 && fr >= 13 && u.pn < 12) *(u32x4*)(halo + ((size_t)((row >> 6) + 1) * 3 + (fr - 13)) * 3072 + col0 + bj * 128) = w; } }
    }
};
struct EpiPlainBf16 {
    static constexpr bool PERM = true, AFTER_DRAIN = false;
    bf16_t* O; int ldc;
    DI void operator()(const f32x4 (&acc)[2][2][4][2], const Unit& u, int wr, int wc, int fr, int fq) const {
        const int row0 = u.pm * 256 + wr * 64 + fr, col0 = u.pn * 256 + wc * 32 + 8 * fq;
#pragma unroll
        for (int ai = 0; ai < 2; ++ai)
#pragma unroll
            for (int m = 0; m < 4; ++m) { bf16_t* rowp = O + (size_t)(row0 + ai * 128 + m * 16) * ldc + col0;
#pragma unroll
                for (int bj = 0; bj < 2; ++bj) { const f32x4 v0 = acc[ai][bj][m][0], v1 = acc[ai][bj][m][1];
                    u32x4 w; w.x = pk2(v0[0], v0[1]); w.y = pk2(v0[2], v0[3]); w.z = pk2(v1[0], v1[1]); w.w = pk2(v1[2], v1[3]);
                    *(u32x4*)(rowp + bj * 128) = w; } }
    }
};
struct EpiResid {
    static constexpr bool PERM = false, AFTER_DRAIN = false;
    const float* base; float* out; bf16_t* hb; float* ss;
    DI void operator()(const f32x4 (&acc)[2][2][4][2], const Unit& u, int wr, int wc, int fr, int fq) const {
        const int row0 = u.pm * 256 + wr * 64 + fr, col0 = u.pn * 256 + wc * 32 + 4 * fq;
#pragma unroll
        for (int ai = 0; ai < 2; ++ai) { f32x4 bs[4][4];
#pragma unroll
            for (int m = 0; m < 4; ++m)
#pragma unroll
                for (int q = 0; q < 4; ++q) bs[m][q] = *(const f32x4*)(base + (size_t)(row0 + ai * 128 + m * 16) * DM + col0 + (q >> 1) * 128 + (q & 1) * 16);
#pragma unroll
            for (int m = 0; m < 4; ++m) { const int row = row0 + ai * 128 + m * 16; const size_t off = (size_t)row * DM + col0; float s = 0.f;
#pragma unroll
                for (int q = 0; q < 4; ++q) { const f32x4 hv = bs[m][q] + acc[ai][q >> 1][m][q & 1];
                        *(f32x4*)(out + off + (q >> 1) * 128 + (q & 1) * 16) = hv; u32x2 w; w.x = pk2(hv[0], hv[1]); w.y = pk2(hv[2], hv[3]);
                        *(u32x2*)(hb + off + (q >> 1) * 128 + (q & 1) * 16) = w; s += (hv[0] * hv[0] + hv[1] * hv[1]) + (hv[2] * hv[2] + hv[3] * hv[3]); }
                s += __shfl_xor(s, 16); s += __shfl_xor(s, 32);
                if (fq == 0) atomicAdd(ss + row, s); }
            asm volatile("" ::: "memory"); }
    }
};
struct EpiAct {
    static constexpr bool PERM = true, AFTER_DRAIN = false;
    bf16_t* O; const float* ss;
    DI void operator()(const f32x4 (&acc)[2][2][4][2], const Unit& u, int wr, int wc, int fr, int fq) const {
        const int row0 = u.pm * 256 + wr * 64 + fr, col0 = u.pn * 128 + wc * 32 + 8 * fq;
        float rs[8];
#pragma unroll
        for (int g = 0; g < 8; ++g) rs[g] = ss[row0 + (g >> 2) * 128 + (g & 3) * 16];
#pragma unroll
        for (int ai = 0; ai < 2; ++ai)
#pragma unroll
            for (int m = 0; m < 4; ++m) { const int row = row0 + ai * 128 + m * 16; const float r = rsqrtf(rs[ai * 4 + m] * (1.f / 2048.f) + 1e-6f);
                float a[8];
#pragma unroll
                for (int n = 0; n < 2; ++n)
#pragma unroll
                    for (int j = 0; j < 4; ++j) { const float gv = r * acc[ai][0][m][n][j], uv = r * acc[ai][1][m][n][j]; a[n * 4 + j] = silu_f(gv) * uv; }
                u32x4 w; w.x = pk2(a[0], a[1]); w.y = pk2(a[2], a[3]); w.z = pk2(a[4], a[5]); w.w = pk2(a[6], a[7]);
                *(u32x4*)(O + (size_t)row * FF + col0) = w; }
    }
};
struct EpiOut {
    static constexpr bool PERM = false, AFTER_DRAIN = false;
    float* out; const bf16_t* pp; const float* ss;
    DI void operator()(const f32x4 (&acc)[2][2][4][2], const Unit& u, int wr, int wc, int fr, int fq) const {
        const int row0 = u.pm * 256 + wr * 64 + fr, col0 = u.pn * 256 + wc * 32 + 4 * fq;
        float rs[8];
#pragma unroll
        for (int g = 0; g < 8; ++g) rs[g] = ss[row0 + (g >> 2) * 128 + (g & 3) * 16];
#pragma unroll
        for (int ai = 0; ai < 2; ++ai)
#pragma unroll
            for (int m = 0; m < 4; ++m) { const int row = row0 + ai * 128 + m * 16; const size_t off = (size_t)row * DM + col0; const float r = rsqrtf(rs[ai * 4 + m] * (1.f / 2048.f) + 1e-6f);
                f32x4 hv[4]; u32x2 pw[4];
#pragma unroll
                for (int q = 0; q < 4; ++q) { hv[q] = *(const f32x4*)(out + off + (q >> 1) * 128 + (q & 1) * 16); pw[q] = *(const u32x2*)(pp + off + (q >> 1) * 128 + (q & 1) * 16); }
#pragma unroll
                for (int q = 0; q < 4; ++q) { const f32x4 a = acc[ai][q >> 1][m][q & 1]; f32x4 o;
                        o[0] = hv[q][0] + sigm_f(r * a[0]) * bflo(pw[q].x); o[1] = hv[q][1] + sigm_f(r * a[1]) * bfhi(pw[q].x);
                        o[2] = hv[q][2] + sigm_f(r * a[2]) * bflo(pw[q].y); o[3] = hv[q][3] + sigm_f(r * a[3]) * bfhi(pw[q].y);
                        *(f32x4*)(out + off + (q >> 1) * 128 + (q & 1) * 16) = o; }
                asm volatile("" ::: "memory"); }
    }
};

DI void tconv_tile(const float* __restrict__ src, int ld, int c0, int k0, bf16_t* __restrict__ dst, int dK, int n0, const float* __restrict__ nw, LAS float* tl) {
    const int tid = opq_tid();
    f32x4 v[8];
#pragma unroll
    for (int i = 0; i < 8; ++i) v[i] = *(const f32x4*)(src + (size_t)(k0 + (tid >> 4) + 32 * i) * ld + c0 + (tid & 15) * 4);
#pragma unroll
    for (int i = 0; i < 8; ++i) { const int k = (tid >> 4) + 32 * i; const float sc = nw ? nw[k0 + k] : 1.f;
        LAS float* q = tl + k * 65 + (tid & 15) * 4; q[0] = v[i][0] * sc; q[1] = v[i][1] * sc; q[2] = v[i][2] * sc; q[3] = v[i][3] * sc; }
    __syncthreads();
    { const int n = tid >> 3, kq = (tid & 7) * 8;
#pragma unroll
      for (int j = 0; j < 4; ++j) { const int ks = kq + 64 * j; float f[8];
#pragma unroll
          for (int i = 0; i < 8; ++i) f[i] = tl[(ks + i) * 65 + n];
          u32x4 w; w.x = pk2(f[0], f[1]); w.y = pk2(f[2], f[3]); w.z = pk2(f[4], f[5]); w.w = pk2(f[6], f[7]);
          *(u32x4*)(dst + (size_t)(n0 + n) * dK + k0 + ks) = w; } }
    __syncthreads();
}

DI void phase_prep(const Params& P, LAS unsigned char* lds) {
    unsigned char* ws = P.ws; const int tid = opq_tid(), G = gridDim.x, bx = blockIdx.x;
    const int gtid = bx * NTHREADS + tid, gsz = G * NTHREADS;
    for (int i = gtid; i < (int)((WS_GL - WS_CTL) / 4); i += gsz) ((unsigned*)(ws + WS_CTL))[i] = 0u;
    { bf16_t* wba = (bf16_t*)(ws + WS_WBA); for (int i = gtid; i < 16 * 2048; i += gsz) { const int n = i >> 11, k = i & 2047; wba[i] = f2bf(P.w_in[(size_t)k * INW + 4096 + n]); } }
    { bf16_t* pb = (bf16_t*)(ws + WS_PB); for (int i = gtid; i < MT * 256 / 8; i += gsz) { const f32x4 a = *(const f32x4*)(P.p + (size_t)i * 8), b = *(const f32x4*)(P.p + (size_t)i * 8 + 4);
        u32x4 w; w.x = pk2(a[0], a[1]); w.y = pk2(a[2], a[3]); w.z = pk2(b[0], b[1]); w.w = pk2(b[2], b[3]); *(u32x4*)(pb + (size_t)i * 8) = w; } }
    { bf16_t* xn = (bf16_t*)(ws + WS_R0); const int lane = tid & 63, gw = bx * 8 + (tid >> 6);
      f32x4 wv[8];
#pragma unroll
      for (int i = 0; i < 8; ++i) wv[i] = *(const f32x4*)(P.attn_norm + lane * 4 + i * 256);
      for (int row = gw * 2; row < MT; row += G * 16) { const float* xr = P.x + (size_t)row * DM; f32x4 v[2][8]; float s0 = 0.f, s1 = 0.f;
#pragma unroll
          for (int r = 0; r < 2; ++r)
#pragma unroll
              for (int i = 0; i < 8; ++i) v[r][i] = *(const f32x4*)(xr + (size_t)r * DM + lane * 4 + i * 256);
#pragma unroll
          for (int i = 0; i < 8; ++i) { s0 += (v[0][i][0] * v[0][i][0] + v[0][i][1] * v[0][i][1]) + (v[0][i][2] * v[0][i][2] + v[0][i][3] * v[0][i][3]);
              s1 += (v[1][i][0] * v[1][i][0] + v[1][i][1] * v[1][i][1]) + (v[1][i][2] * v[1][i][2] + v[1][i][3] * v[1][i][3]); }
#pragma unroll
          for (int o = 1; o < 64; o <<= 1) { s0 += __shfl_xor(s0, o); s1 += __shfl_xor(s1, o); }
          const float r0 = rsqrtf(s0 * (1.f / 2048.f) + 1e-6f), r1 = rsqrtf(s1 * (1.f / 2048.f) + 1e-6f);
#pragma unroll
          for (int r = 0; r < 2; ++r)
#pragma unroll
              for (int i = 0; i < 8; ++i) { const float rr = r ? r1 : r0; u32x2 w; w.x = pk2(v[r][i][0] * rr * wv[i][0], v[r][i][1] * rr * wv[i][1]); w.y = pk2(v[r][i][2] * rr * wv[i][2], v[r][i][3] * rr * wv[i][3]);
                  *(u32x2*)(xn + (size_t)(row + r) * DM + lane * 4 + i * 256) = w; } } }
    LAS float* tl = (LAS float*)lds;
    for (int gi = bx; gi < 896; gi += G) { const int nt = gi >> 3, kg = gi & 7, n0 = nt * 64; tconv_tile(P.w_in, INW, n0 < 4096 ? n0 : n0 + 16, kg * 256, (bf16_t*)(ws + WS_WIN), 2048, n0, nullptr, tl); }
}
DI void phase_wconv_late(const Params& P, LAS unsigned char* lds, int wg0, int nwg) {
    unsigned char* ws = P.ws; LAS float* tl = (LAS float*)lds;
    for (int gi = 896 + wg0; gi < 3552; gi += nwg) {
        if (gi < 1152) { const int t2 = gi - 896, nt = t2 >> 3, kg = t2 & 7; tconv_tile(P.w_o, 2048, nt * 64, kg * 256, (bf16_t*)(ws + WS_WO), 2048, nt * 64, nullptr, tl); }
        else if (gi < 2560) { const int t2 = gi - 1152, nt = t2 >> 3, kg = t2 & 7, n0 = nt * 64, pn = n0 >> 8, r = n0 & 255;
            tconv_tile(r < 128 ? P.w_gate : P.w_up, FF, pn * 128 + (r & 127), kg * 256, (bf16_t*)(ws + WS_WGU), 2048, n0, P.ffn_norm, tl); }
        else if (gi < 3264) { const int t2 = gi - 2560, nt = t2 / 22, kg = t2 % 22; tconv_tile(P.w_down, 2048, nt * 64, kg * 256, (bf16_t*)(ws + WS_WDN), FF, nt * 64, nullptr, tl); }
        else if (gi < 3520) { const int t2 = gi - 3264, nt = t2 >> 3, kg = t2 & 7; tconv_tile(P.w_pg, 2048, nt * 64, kg * 256, (bf16_t*)(ws + WS_WPG), 2048, nt * 64, P.ple_norm, tl); }
        else { const int nt = gi - 3520; tconv_tile(P.w_pp, 2048, nt * 64, 0, (bf16_t*)(ws + WS_WPP), 256, nt * 64, nullptr, tl); }
    }
}

DI void phase_ba(const Params& P) {
    const int tid = opq_tid(), lane = tid & 63, fr = lane & 15, fq = lane >> 4, gw = blockIdx.x * 8 + (tid >> 6);
    const bf16_t* xn = (const bf16_t*)(P.ws + WS_R0); const bf16_t* wba = (const bf16_t*)(P.ws + WS_WBA); float* BA = (float*)(P.ws + WS_BA);
    for (int rt = gw; rt < MT / 16; rt += gridDim.x * 8) {
        f32x4 acc = {0.f, 0.f, 0.f, 0.f}; const bf16_t* ap = xn + (size_t)(rt * 16 + fr) * DM + 8 * fq; const bf16_t* bp = wba + fr * 2048 + 8 * fq;
#pragma unroll 8
        for (int ks = 0; ks < 64; ++ks) acc = mfma16(*(const bf16x8*)(ap + 32 * ks), *(const bf16x8*)(bp + 32 * ks), acc);
#pragma unroll
        for (int j = 0; j < 4; ++j) BA[(size_t)(rt * 16 + 4 * fq + j) * 16 + fr] = acc[j];
    }
}

constexpr int G1_QS = 0, G1_KS = 18432, G1_VT = 36864, G1_KT = 57344, G1_SM = 77824, G1_TEAM = 78848;
DI void phase_gdn_prep(const Params& P, LAS unsigned char* lds) {
    const int tid0 = opq_tid(), team = tid0 >> 8;
    LAS unsigned char* L = lds + team * G1_TEAM;
    LAS bf16_t* QS = (LAS bf16_t*)(L + G1_QS); LAS bf16_t* KS = (LAS bf16_t*)(L + G1_KS); LAS bf16_t* VT = (LAS bf16_t*)(L + G1_VT); LAS bf16_t* KT = (LAS bf16_t*)(L + G1_KT);
    LAS float* AF = (LAS float*)(L + G1_QS); LAS bf16_t* TB = (LAS bf16_t*)(L + G1_KS); LAS float* SM = (LAS float*)(L + G1_SM);
    bf16_t* proj = (bf16_t*)(P.ws + WS_R1); const bf16_t* halo = (const bf16_t*)(P.ws + WS_HALO); const float* BA = (const float*)(P.ws + WS_BA);
    bf16_t* W2 = (bf16_t*)(P.ws + WS_W2); bf16_t* QKB = (bf16_t*)(P.ws + WS_QKB); float* GL = (float*)(P.ws + WS_GL);
    for (int pi = blockIdx.x; pi < 2048; pi += gridDim.x) {
        int tid = tid0; asm volatile("" : "+v"(tid));
        const int tt = tid & 255, tw = __builtin_amdgcn_readfirstlane((tid >> 6) & 3), lane = tid & 63, fr = lane & 15, fq = lane >> 4;
        const int ci = pi * 2 + team, h = ci & 7, n = (ci >> 3) & 255, b = ci >> 11, t0 = b * TT + n * 64;
        if (tw == 0) {
            const float bv = BA[(size_t)(t0 + lane) * 16 + h], av = BA[(size_t)(t0 + lane) * 16 + 8 + h];
            const float beta = sigm_f(bv); const float xx = av + P.dt_bias[h]; const float sp = xx > 20.f ? xx : log1pf(__expf(xx));
            const float gg = -__expf(P.A_log[h]) * sp; float gc = gg;
#pragma unroll
            for (int o = 1; o < 64; o <<= 1) { const float v = __shfl_up(gc, o); if (lane >= o) gc += v; }
            const float glast = __shfl(gc, 63);
            SM[lane] = gc; SM[64 + lane] = beta; SM[128 + lane] = __expf(gc); SM[192 + lane] = __expf(glast - gc);
            if (lane == 63) GL[(b * 8 + h) * 256 + n] = __expf(gc);
        }
        __syncthreads();
        { const int r = tt >> 2, cg0 = (tt & 3) * 32; const float beta_r = SM[64 + r], egc_r = SM[128 + r];
#pragma unroll 1
          for (int x = 0; x < 3; ++x) {
              float val[32]; const int colbase = x * 1024 + h * 128 + cg0;
#pragma unroll
              for (int sg = 0; sg < 4; ++sg) { const int col = colbase + sg * 8; u32x4 raw[4];
#pragma unroll
                  for (int j = 0; j < 4; ++j) { const int rr = r - 3 + j; raw[j] = (u32x4){0u, 0u, 0u, 0u};
                      if (rr >= 0) raw[j] = *(const u32x4*)(proj + (size_t)(t0 + rr) * NPJ + col);
                      else if (n > 0) raw[j] = *(const u32x4*)(halo + ((size_t)(t0 >> 6) * 3 + (rr + 3)) * 3072 + col); }
#pragma unroll
                  for (int i = 0; i < 8; ++i) { const f32x4 w4 = *(const f32x4*)(P.conv_w + (size_t)(col + i) * 4); float a = 0.f;
#pragma unroll
                      for (int j = 0; j < 4; ++j) { const unsigned wd = raw[j][i >> 1]; const float xv = (i & 1) ? bfhi(wd) : bflo(wd); a += w4[j] * xv; }
                      val[sg * 8 + i] = silu_f(a); } }
              if (x < 2) { float ss = 0.f;
#pragma unroll
                  for (int i = 0; i < 32; ++i) ss += val[i] * val[i];
                  ss += __shfl_xor(ss, 1); ss += __shfl_xor(ss, 2);
                  const float sc = rsqrtf(ss + 1e-6f) * (x == 0 ? 0.08838834764831845f : 1.f);
#pragma unroll
                  for (int i = 0; i < 32; ++i) val[i] *= sc; }
              if (x < 2) { LAS bf16_t* dst = (x == 0 ? QS : KS) + r * 144 + cg0;
#pragma unroll
                  for (int i = 0; i < 4; ++i) { u32x4 w; w.x = pk2(val[8 * i], val[8 * i + 1]); w.y = pk2(val[8 * i + 2], val[8 * i + 3]); w.z = pk2(val[8 * i + 4], val[8 * i + 5]); w.w = pk2(val[8 * i + 6], val[8 * i + 7]);
                      *(LAS u32x4*)(dst + 8 * i) = w; } }
              if (x == 1) { const float f = beta_r * egc_r;
#pragma unroll
                  for (int i = 0; i < 32; ++i) KT[(cg0 + i) * 80 + r] = f2bf(val[i] * f); }
              if (x == 2) {
#pragma unroll
                  for (int i = 0; i < 32; ++i) VT[(cg0 + i) * 80 + r] = f2bf(val[i] * beta_r); }
          } }
        __syncthreads();
        f32x4 kk[4], qk[4];
#pragma unroll
        for (int nt = 0; nt < 4; ++nt) { kk[nt] = (f32x4){0.f, 0.f, 0.f, 0.f}; qk[nt] = (f32x4){0.f, 0.f, 0.f, 0.f}; }
#pragma unroll
        for (int ks = 0; ks < 4; ++ks) { const bf16x8 ak = *(const LAS bf16x8*)(KS + (16 * tw + fr) * 144 + 32 * ks + 8 * fq), aq = *(const LAS bf16x8*)(QS + (16 * tw + fr) * 144 + 32 * ks + 8 * fq);
#pragma unroll
            for (int nt = 0; nt < 4; ++nt) { const bf16x8 bk = *(const LAS bf16x8*)(KS + (16 * nt + fr) * 144 + 32 * ks + 8 * fq); kk[nt] = mfma16(ak, bk, kk[nt]); qk[nt] = mfma16(aq, bk, qk[nt]); } }
        { const int r = tt >> 2, cg0 = (tt & 3) * 32; const float e = SM[128 + r];
#pragma unroll
          for (int i = 0; i < 4; ++i) { const u32x4 s = *(const LAS u32x4*)(QS + r * 144 + cg0 + 8 * i); u32x4 w;
              w.x = pk2(bflo(s.x) * e, bfhi(s.x) * e); w.y = pk2(bflo(s.y) * e, bfhi(s.y) * e); w.z = pk2(bflo(s.z) * e, bfhi(s.z) * e); w.w = pk2(bflo(s.w) * e, bfhi(s.w) * e);
              *(u32x4*)(proj + (size_t)(t0 + r) * NPJ + OFF_GQ + h * 128 + cg0 + 8 * i) = w; } }
        { const int d = tt >> 1, cb = (tt & 1) * 32;
#pragma unroll
          for (int i4 = 0; i4 < 4; ++i4) { const int c0 = cb + 8 * i4; float f[8];
#pragma unroll
              for (int i = 0; i < 8; ++i) f[i] = bf2f(KS[(c0 + i) * 144 + d]) * SM[192 + c0 + i];
              u32x4 w; w.x = pk2(f[0], f[1]); w.y = pk2(f[2], f[3]); w.z = pk2(f[4], f[5]); w.w = pk2(f[6], f[7]);
              *(u32x4*)(proj + (size_t)(t0 + (d >> 1)) * NPJ + OFF_GK + h * 128 + (d & 1) * 64 + c0) = w; } }
        __syncthreads();
#pragma unroll
        for (int nt = 0; nt < 4; ++nt)
#pragma unroll
            for (int j = 0; j < 4; ++j) { const int c = 16 * tw + 4 * fq + j, s = 16 * nt + fr; const float dec = (s <= c) ? __expf(SM[c] - SM[s]) : 0.f;
                AF[c * 65 + s] = (s < c) ? SM[64 + c] * kk[nt][j] * dec : (s == c ? 1.f : 0.f);
                QKB[(size_t)ci * 4096 + c * 64 + s] = f2bf(qk[nt][j] * dec); }
        __syncthreads();
        { const int bb = tw * 16;
          if (lane < 16) {
              for (int i = 1; i < 16; ++i) { float a0 = 0.f, a1 = 0.f; int j = 0;
                  for (; j + 2 <= i; j += 2) { a0 += AF[(bb + i) * 65 + bb + j] * AF[(bb + j) * 65 + bb + lane]; a1 += AF[(bb + i) * 65 + bb + j + 1] * AF[(bb + j + 1) * 65 + bb + lane]; }
                  if (j < i) a0 += AF[(bb + i) * 65 + bb + j] * AF[(bb + j) * 65 + bb + lane];
                  AF[(bb + i) * 65 + bb + lane] = lane < i ? -(a0 + a1) : (lane == i ? 1.f : 0.f); } }
#pragma unroll
          for (int k = 0; k < 4; ++k) { const int row = bb + fq + 4 * k; TB[row * 80 + bb + fr] = f2bf(AF[row * 65 + bb + fr]);
              for (int jb = tw + 1; jb < 4; ++jb) TB[row * 80 + 16 * jb + fr] = (bf16_t)0; }
          __syncthreads();
          for (int i = 1; i < 4; ++i) {
              if (tw < i) { const int j = tw; f32x4 X = {0.f, 0.f, 0.f, 0.f};
                  for (int k = j; k < i; ++k) {
#pragma unroll
                      for (int kk = 0; kk < 4; ++kk) { const float av = AF[(16 * i + fr) * 65 + 16 * k + 4 * kk + fq];
                          const float bv = (k == j) ? AF[(16 * k + 4 * kk + fq) * 65 + 16 * j + fr] : bf2f(TB[(16 * k + 4 * kk + fq) * 80 + 16 * j + fr]);
                          X = __builtin_amdgcn_mfma_f32_16x16x4f32(av, bv, X, 0, 0, 0); } }
                  f32x4 O = {0.f, 0.f, 0.f, 0.f};
#pragma unroll
                  for (int kk = 0; kk < 4; ++kk) O = __builtin_amdgcn_mfma_f32_16x16x4f32(AF[(16 * i + fr) * 65 + 16 * i + 4 * fq + kk], X[kk], O, 0, 0, 0);
#pragma unroll
                  for (int jj = 0; jj < 4; ++jj) TB[(16 * i + 4 * fq + jj) * 80 + 16 * j + fr] = f2bf(-O[jj]); }
              __syncthreads(); }
        }
        { bf16x8 at[2];
#pragma unroll
          for (int ks = 0; ks < 2; ++ks) at[ks] = *(const LAS bf16x8*)(TB + (16 * tw + fr) * 80 + 32 * ks + 8 * fq);
#pragma unroll
          for (int nt = 0; nt < 8; ++nt) { f32x4 a = {0.f, 0.f, 0.f, 0.f};
#pragma unroll
              for (int ks = 0; ks < 2; ++ks) a = mfma16(at[ks], *(const LAS bf16x8*)(VT + (16 * nt + fr) * 80 + 32 * ks + 8 * fq), a);
              const int e = 16 * nt + fr; u32x2 w; w.x = pk2(a[0], a[1]); w.y = pk2(a[2], a[3]);
              *(u32x2*)(proj + (size_t)(t0 + (e >> 1)) * NPJ + OFF_GV + h * 128 + (e & 1) * 64 + 16 * tw + 4 * fq) = w; }
#pragma unroll
          for (int mt = 0; mt < 8; ++mt) { f32x4 a = {0.f, 0.f, 0.f, 0.f};
#pragma unroll
              for (int ks = 0; ks < 2; ++ks) a = mfma16(*(const LAS bf16x8*)(KT + (16 * mt + fr) * 80 + 32 * ks + 8 * fq), at[ks], a);
              u32x2 w; w.x = pk2(a[0], a[1]); w.y = pk2(a[2], a[3]);
              *(u32x2*)(W2 + (size_t)(t0 + 16 * tw + fr) * 1024 + h * 128 + 16 * mt + 4 * fq) = w; } }
        __syncthreads();
    }
}

DI void phase_moba_prep(const Params& P, LAS unsigned char* lds) {
    const int tid = opq_tid(), lane = tid & 63, wave = tid >> 6, l16 = lane & 15;
    bf16_t* proj = (bf16_t*)(P.ws + WS_R1); float* kmean = (float*)(P.ws + WS_KMEAN);
    LAS bf16_t* VS = (LAS bf16_t*)lds; LAS float* CS = (LAS float*)(lds + 69632);
    for (int task = blockIdx.x; task < 1024; task += gridDim.x) {
        const int h = task & 7, blk = (task >> 3) & 63, b = task >> 9; const size_t rbase = (size_t)(b * TT + blk * 256);
        f32x4 qg0 = *(const f32x4*)(P.q_norm + l16 * 8), qg1 = *(const f32x4*)(P.q_norm + l16 * 8 + 4), kg0 = *(const f32x4*)(P.k_norm + l16 * 8), kg1 = *(const f32x4*)(P.k_norm + l16 * 8 + 4);
        float cs[8];
#pragma unroll
        for (int i = 0; i < 8; ++i) cs[i] = 0.f;
        u32x4 rq[8], rk[8], rv[8];
#pragma unroll
        for (int ps = 0; ps < 8; ++ps) { const int r = ps * 32 + wave * 4 + (lane >> 4); const bf16_t* rp = proj + (rbase + r) * NPJ + h * 128 + l16 * 8;
            rq[ps] = *(const u32x4*)(rp + OFF_MQ); rk[ps] = *(const u32x4*)(rp + OFF_MK); rv[ps] = *(const u32x4*)(rp + OFF_MV); }
#pragma unroll
        for (int ps = 0; ps < 8; ++ps) { const int r = ps * 32 + wave * 4 + (lane >> 4); bf16_t* rp = proj + (rbase + r) * NPJ + h * 128 + l16 * 8;
#pragma unroll
            for (int x = 0; x < 2; ++x) { bf16_t* ptr = rp + (x == 0 ? OFF_MQ : OFF_MK); const u32x4 raw = x == 0 ? rq[ps] : rk[ps]; float v[8];
                v[0] = bflo(raw.x); v[1] = bfhi(raw.x); v[2] = bflo(raw.y); v[3] = bfhi(raw.y); v[4] = bflo(raw.z); v[5] = bfhi(raw.z); v[6] = bflo(raw.w); v[7] = bfhi(raw.w);
                float ss = 0.f;
#pragma unroll
                for (int i = 0; i < 8; ++i) ss += v[i] * v[i];
                ss = row16_sum(ss);
                const float rs = rsqrtf(ss * (1.f / 128.f) + 1e-6f); const f32x4 g0 = x == 0 ? qg0 : kg0, g1 = x == 0 ? qg1 : kg1;
#pragma unroll
                for (int i = 0; i < 4; ++i) { v[i] *= rs * g0[i]; v[4 + i] *= rs * g1[i]; }
                if (x == 1) {
#pragma unroll
                    for (int i = 0; i < 8; ++i) cs[i] += v[i]; }
                u32x4 w; w.x = pk2(v[0], v[1]); w.y = pk2(v[2], v[3]); w.z = pk2(v[4], v[5]); w.w = pk2(v[6], v[7]); *(u32x4*)ptr = w; }
            *(LAS u32x4*)(VS + r * 136 + l16 * 8) = rv[ps]; }
#pragma unroll
        for (int i = 0; i < 8; ++i) { cs[i] += __shfl_xor(cs[i], 16); cs[i] += __shfl_xor(cs[i], 32); }
        if (lane < 16) {
#pragma unroll
            for (int i = 0; i < 8; ++i) CS[wave * 128 + lane * 8 + i] = cs[i]; }
        __syncthreads();
        if (tid < 128) { float s = 0.f;
#pragma unroll
            for (int w = 0; w < 8; ++w) s += CS[w * 128 + tid];
            kmean[((size_t)(b * 8 + h) * 64 + blk) * 128 + tid] = s * (1.f / 256.f); }
#pragma unroll 2
        for (int i8 = 0; i8 < 8; ++i8) { const int pid = tid + i8 * 512, e = pid >> 5, ks = pid & 31; unsigned short f[8];
#pragma unroll
            for (int i = 0; i < 8; ++i) f[i] = VS[(ks * 8 + i) * 136 + e];
            u32x4 w; w.x = f[0] | ((unsigned)f[1] << 16); w.y = f[2] | ((unsigned)f[3] << 16); w.z = f[4] | ((unsigned)f[5] << 16); w.w = f[6] | ((unsigned)f[7] << 16);
            *(u32x4*)(proj + (rbase + 2 * e + (ks >> 4)) * NPJ + OFF_MV + h * 128 + (ks & 15) * 8) = w; }
        __syncthreads();
    }
}

DI void phase_moba_select(const Params& P, LAS unsigned char* lds) {
    const int tid = opq_tid(), qi = tid >> 1, half = tid & 1;
    const bf16_t* proj = (const bf16_t*)(P.ws + WS_R1); const float* kmean = (const float*)(P.ws + WS_KMEAN);
    int* cnt = (int*)(P.ws + WS_CNT); int* list = (int*)(P.ws + WS_LIST); f32x2* ML = (f32x2*)(P.ws + WS_ML);
    LAS float* KM = (LAS float*)lds; LAS int* hist = (LAS int*)(lds + 32768); LAS int* hbase = (LAS int*)(lds + 32768 + 256);
    for (int task = blockIdx.x; task < 1024; task += gridDim.x) {
        const int blk = task & 63, h = (task >> 6) & 7, b = task >> 9; const int bh = b * 8 + h; const int t = blk * 256 + qi; const size_t rid = (size_t)bh * TT + t;
        for (int i = tid; i < blk * 128; i += NTHREADS) KM[i] = kmean[(size_t)bh * 64 * 128 + i];
        if (tid < 64) hist[tid] = 0;
        float q[64];
        { const bf16_t* qp = proj + (size_t)(b * TT + t) * NPJ + OFF_MQ + h * 128 + half * 64;
#pragma unroll
          for (int i = 0; i < 8; ++i) { const u32x4 raw = *(const u32x4*)(qp + 8 * i); q[8 * i] = bflo(raw.x); q[8 * i + 1] = bfhi(raw.x); q[8 * i + 2] = bflo(raw.y); q[8 * i + 3] = bfhi(raw.y);
              q[8 * i + 4] = bflo(raw.z); q[8 * i + 5] = bfhi(raw.z); q[8 * i + 6] = bflo(raw.w); q[8 * i + 7] = bfhi(raw.w); } }
        __syncthreads();
        float v0 = -INFINITY, v1 = -INFINITY, v2 = -INFINITY; int i0 = -1, i1 = -1, i2 = -1;
        for (int n = 0; n < blk; ++n) { const LAS float* km = KM + n * 128 + half * 64; float d0 = 0.f, d1 = 0.f, d2 = 0.f, d3 = 0.f;
#pragma unroll
            for (int i = 0; i < 16; ++i) { const f32x4 kv = *(const LAS f32x4*)(km + 4 * i); d0 += q[4 * i] * kv[0]; d1 += q[4 * i + 1] * kv[1]; d2 += q[4 * i + 2] * kv[2]; d3 += q[4 * i + 3] * kv[3]; }
            float g = (d0 + d1) + (d2 + d3); g += __shfl_xor(g, 1);
            if (g > v0) { v2 = v1; i2 = i1; v1 = v0; i1 = i0; v0 = g; i0 = n; } else if (g > v1) { v2 = v1; i2 = i1; v1 = g; i1 = n; } else if (g > v2) { v2 = g; i2 = n; } }
        int rk0 = 0, rk1 = 0, rk2 = 0;
        if (half == 0) { if (i0 >= 0) rk0 = __hip_atomic_fetch_add(&hist[i0], 1, __ATOMIC_RELAXED, __HIP_MEMORY_SCOPE_WORKGROUP); if (i1 >= 0) rk1 = __hip_atomic_fetch_add(&hist[i1], 1, __ATOMIC_RELAXED, __HIP_MEMORY_SCOPE_WORKGROUP); if (i2 >= 0) rk2 = __hip_atomic_fetch_add(&hist[i2], 1, __ATOMIC_RELAXED, __HIP_MEMORY_SCOPE_WORKGROUP); }
        __syncthreads();
        if (tid < 64) { const int c = hist[tid]; hbase[tid] = c > 0 ? atomicAdd(&cnt[bh * 64 + tid], c) : 0; }
        __syncthreads();
        if (half == 0) {
            const f32x2 dead = {-INFINITY, 0.f};
            if (i0 >= 0) list[(size_t)bh * LISTN + i0 * 16384 - 128 * i0 * (i0 + 1) + hbase[i0] + rk0] = t; else ML[0 * 262144 + rid] = dead;
            if (i1 >= 0) list[(size_t)bh * LISTN + i1 * 16384 - 128 * i1 * (i1 + 1) + hbase[i1] + rk1] = t | (1 << 14); else ML[1 * 262144 + rid] = dead;
            if (i2 >= 0) list[(size_t)bh * LISTN + i2 * 16384 - 128 * i2 * (i2 + 1) + hbase[i2] + rk2] = t | (2 << 14); else ML[2 * 262144 + rid] = dead;
        }
        __syncthreads();
    }
}

constexpr int G2_W = 0, G2_Q = 18432, G2_QK = 36864, G2_KD = 47104, G2_BUF = 67584, G2_RED = 135168;
DI void phase_gdn_scan(const Params& P, LAS unsigned char* lds, int bh) {
    const int tid = opq_tid(), lane = tid & 63, w = tid >> 6, fr = lane & 15, fq = lane >> 4, b = bh >> 3, h = bh & 7;
    const bf16_t* proj = (const bf16_t*)(P.ws + WS_R1); const bf16_t* W2 = (const bf16_t*)(P.ws + WS_W2); const bf16_t* QKB = (const bf16_t*)(P.ws + WS_QKB);
    const float* GL = (const float*)(P.ws + WS_GL); bf16_t* mix = (bf16_t*)(P.ws + WS_R2);
    float* SSQ = (float*)(P.ws + WS_SSQ);
    const int e = 16 * w + fr; const float gnw = P.gdn_norm[e];
    f32x4 S[8];
#pragma unroll
    for (int i = 0; i < 8; ++i) S[i] = (f32x4){0.f, 0.f, 0.f, 0.f};
    const int wrow0 = tid >> 4, wseg = tid & 15;
    const int qrow = tid >> 3, qseg = tid & 7;
    struct Stage { u32x4 sw[2], sq[2], sqk, skd[2]; };
    u32x2 un[4];
    Stage stA, stB;
#define G2_LOAD(X, nn) do { const int t0_ = b * TT + (nn) * 64; const int ci_ = ((b * 256 + (nn)) << 3) + h; \
        _Pragma("unroll") for (int i_ = 0; i_ < 2; ++i_) { X.sw[i_] = *(const u32x4*)(W2 + (size_t)(t0_ + wrow0 + 32 * i_) * 1024 + h * 128 + wseg * 8); \
            X.sq[i_] = *(const u32x4*)(proj + (size_t)(t0_ + wrow0 + 32 * i_) * NPJ + OFF_GQ + h * 128 + wseg * 8); \
            const int d_ = qrow + 64 * i_; X.skd[i_] = *(const u32x4*)(proj + (size_t)(t0_ + (d_ >> 1)) * NPJ + OFF_GK + h * 128 + (d_ & 1) * 64 + qseg * 8); } \
        X.sqk = *(const u32x4*)(QKB + (size_t)ci_ * 4096 + qrow * 64 + qseg * 8); } while (0)
#define UN_LOAD(nn) do { const int t0_ = b * TT + (nn) * 64; _Pragma("unroll") for (int mt_ = 0; mt_ < 4; ++mt_) un[mt_] = *(const u32x2*)(proj + (size_t)(t0_ + (e >> 1)) * NPJ + OFF_GV + h * 128 + (e & 1) * 64 + 16 * mt_ + 4 * fq); } while (0)
#define G2_ST2(base_, rowoff_, sg_, v_) do { const int g_ = ((sg_) >> 2) * 64, d_ = ((sg_) & 3) * 8; \
        *(LAS u32x2*)(B_ + (base_) + (rowoff_) + g_ + perm4(d_) * 2) = (u32x2){(v_).x, (v_).y}; *(LAS u32x2*)(B_ + (base_) + (rowoff_) + g_ + perm4(d_ + 4) * 2) = (u32x2){(v_).z, (v_).w}; } while (0)
#define G2_STORE(X, bufi) do { LAS unsigned char* B_ = lds + (bufi) * G2_BUF; \
        _Pragma("unroll") for (int i_ = 0; i_ < 2; ++i_) { G2_ST2(G2_W, (wrow0 + 32 * i_) * 288, wseg, X.sw[i_]); G2_ST2(G2_Q, (wrow0 + 32 * i_) * 288, wseg, X.sq[i_]); \
            G2_ST2(G2_KD, (qrow + 64 * i_) * 160, qseg, X.skd[i_]); } \
        G2_ST2(G2_QK, qrow * 160, qseg, X.sqk); } while (0)
    G2_LOAD(stA, 0); G2_STORE(stA, 0); UN_LOAD(0);
    float egl_n = GL[bh * 256];
    u32x2 uc[4];
#pragma unroll
    for (int i = 0; i < 4; ++i) uc[i] = un[i];
    G2_LOAD(stA, 1);
    __syncthreads();
    for (int n2 = 0; n2 < 256; n2 += 2) {
#pragma unroll
      for (int hf2 = 0; hf2 < 2; ++hf2) {
        const int n = n2 + hf2; Stage& LDs = hf2 ? stA : stB; Stage& STs = hf2 ? stB : stA;
        const int cur = hf2, t0 = b * TT + n * 64; LAS unsigned char* Bf = lds + cur * G2_BUF;
        { const int n2c = n + 2 < 256 ? n + 2 : 255, n1c = n + 1 < 256 ? n + 1 : 255; G2_LOAD(LDs, n2c); UN_LOAD(n1c); }
        const float egl = egl_n; egl_n = GL[bh * 256 + (n + 1 < 256 ? n + 1 : 255)];
        f32x4 Pm[4], Om[4];
#pragma unroll
        for (int mt = 0; mt < 4; ++mt) { Pm[mt] = (f32x4){0.f, 0.f, 0.f, 0.f}; Om[mt] = (f32x4){0.f, 0.f, 0.f, 0.f}; }
#define SBAR __builtin_amdgcn_sched_barrier(0)
#define LD_K4(dst, base_, ks_) do { const int o0_ = fr * 288 + (32 * (ks_) + 8 * fq) * 2; \
        dst[0] = *(const LAS bf16x8*)(Bf + base_ + o0_); dst[1] = *(const LAS bf16x8*)(Bf + base_ + o0_ + 4608); \
        dst[2] = *(const LAS bf16x8*)(Bf + base_ + o0_ + 9216); dst[3] = *(const LAS bf16x8*)(Bf + base_ + o0_ + 13824); } while (0)
#define MM_K4(src, sb_, A_) do { A_[0] = mfma16(src[0], sb_, A_[0]); A_[1] = mfma16(src[1], sb_, A_[1]); A_[2] = mfma16(src[2], sb_, A_[2]); A_[3] = mfma16(src[3], sb_, A_[3]); } while (0)
#define LD_R4(dst, base_, r0_, k2_) do { const int o0_ = (16 * (r0_) + fr) * 160 + (32 * (k2_) + 8 * fq) * 2; \
        dst[0] = *(const LAS bf16x8*)(Bf + base_ + o0_); dst[1] = *(const LAS bf16x8*)(Bf + base_ + o0_ + 2560); \
        dst[2] = *(const LAS bf16x8*)(Bf + base_ + o0_ + 5120); dst[3] = *(const LAS bf16x8*)(Bf + base_ + o0_ + 7680); } while (0)
#define MM_R4(src, vb_, A0_, A1_, A2_, A3_) do { A0_ = mfma16(src[0], vb_, A0_); A1_ = mfma16(src[1], vb_, A1_); A2_ = mfma16(src[2], vb_, A2_); A3_ = mfma16(src[3], vb_, A3_); } while (0)
        bf16x8 fa[4], fb[4];
        LD_K4(fa, G2_W, 0);
        const bf16x8 sb0 = pack8(S[0], S[1]), sb1 = pack8(S[2], S[3]), sb2 = pack8(S[4], S[5]), sb3 = pack8(S[6], S[7]);
        LD_K4(fb, G2_W, 1); SBAR; MM_K4(fa, sb0, Pm); SBAR;
        LD_K4(fa, G2_W, 2); SBAR; MM_K4(fb, sb1, Pm); SBAR;
        LD_K4(fb, G2_W, 3); SBAR; MM_K4(fa, sb2, Pm); SBAR;
        LD_K4(fa, G2_Q, 0); SBAR; MM_K4(fb, sb3, Pm); SBAR;
        f32x4 vn[4];
#pragma unroll
        for (int mt = 0; mt < 4; ++mt) { vn[mt][0] = bflo(uc[mt].x) - Pm[mt][0]; vn[mt][1] = bfhi(uc[mt].x) - Pm[mt][1]; vn[mt][2] = bflo(uc[mt].y) - Pm[mt][2]; vn[mt][3] = bfhi(uc[mt].y) - Pm[mt][3]; }
        bf16x8 Vb[2];
#pragma unroll
        for (int k2 = 0; k2 < 2; ++k2) Vb[k2] = pack8(vn[2 * k2], vn[2 * k2 + 1]);
        LD_K4(fb, G2_Q, 1); SBAR; MM_K4(fa, sb0, Om); SBAR;
        LD_K4(fa, G2_Q, 2); SBAR; MM_K4(fb, sb1, Om); SBAR;
        LD_K4(fb, G2_Q, 3); SBAR; MM_K4(fa, sb2, Om); SBAR;
        LD_R4(fa, G2_QK, 0, 0); SBAR; MM_K4(fb, sb3, Om); SBAR;
#pragma unroll
        for (int dt = 0; dt < 8; ++dt) S[dt] = S[dt] * egl;
        SBAR;
        LD_R4(fb, G2_QK, 0, 1); SBAR; MM_R4(fa, Vb[0], Om[0], Om[1], Om[2], Om[3]); SBAR;
        LD_R4(fa, G2_KD, 0, 0); SBAR; MM_R4(fb, Vb[1], Om[0], Om[1], Om[2], Om[3]); SBAR;
        LD_R4(fb, G2_KD, 0, 1); SBAR; MM_R4(fa, Vb[0], S[0], S[1], S[2], S[3]); SBAR;
        LD_R4(fa, G2_KD, 4, 0); SBAR; MM_R4(fb, Vb[1], S[0], S[1], S[2], S[3]); SBAR;
        LD_R4(fb, G2_KD, 4, 1); SBAR; MM_R4(fa, Vb[0], S[4], S[5], S[6], S[7]); SBAR;
        MM_R4(fb, Vb[1], S[4], S[5], S[6], S[7]); SBAR;
#undef LD_K4
#undef MM_K4
#undef LD_R4
#undef MM_R4
#undef SBAR
        { G2_STORE(STs, cur ^ 1);
#pragma unroll
            for (int i = 0; i < 4; ++i) uc[i] = un[i]; }
        { LAS bf16_t* OTW = (LAS bf16_t*)(lds + G2_RED + w * 2048);
#pragma unroll
          for (int mt = 0; mt < 4; ++mt)
#pragma unroll
            for (int j = 0; j < 4; ++j) OTW[(16 * mt + 4 * fq + j) * 16 + fr] = f2bf(Om[mt][j]);
#pragma unroll
          for (int i = 0; i < 2; ++i) { const int row = (lane >> 1) + 32 * i, hv = lane & 1;
              bf16_t* mp_ = mix + (size_t)(t0 + row) * DM + h * 128 + 16 * w + 8 * hv; const u32x4 ov_ = *(const LAS u32x4*)(OTW + row * 16 + hv * 8);
              asm volatile("global_store_dwordx4 %0, %1, off" :: "v"(mp_), "v"(ov_) : "memory"); } }
        __syncthreads();
      }
    }
#undef G2_LOAD
#undef UN_LOAD
#undef G2_STORE
#undef G2_ST2
    __syncthreads();
}

constexpr int AT_KS = 0, AT_VT = 73728, AT_PF = 143360, AT_MISC = 147712;
DI void phase_moba_attn(const Params& P, LAS unsigned char* lds) {
    const int tid = opq_tid(), lane = tid & 63, w = tid >> 6, fr = lane & 15, fq = lane >> 4;
    const bf16_t* proj = (const bf16_t*)(P.ws + WS_R1); const int* cnt = (const int*)(P.ws + WS_CNT); const int* list = (const int*)(P.ws + WS_LIST);
    f32x2* ML = (f32x2*)(P.ws + WS_ML); bf16_t* opart = (bf16_t*)P.out; unsigned* workctr = (unsigned*)(P.ws + WS_CTL);
    LAS bf16_t* KS = (LAS bf16_t*)(lds + AT_KS); LAS bf16_t* VT = (LAS bf16_t*)(lds + AT_VT); LAS int* PF = (LAS int*)(lds + AT_PF); LAS int* MISC = (LAS int*)(lds + AT_MISC);
    { const int c0 = cnt[2 * tid], c1 = cnt[2 * tid + 1]; const int a = (c0 + 511) >> 9, bsum = a + ((c1 + 511) >> 9); int inc = bsum;
#pragma unroll
      for (int o = 1; o < 64; o <<= 1) { const int v = __shfl_up(inc, o); if (lane >= o) inc += v; }
      if (lane == 63) MISC[8 + w] = inc;
      __syncthreads();
      int wb = 0;
#pragma unroll
      for (int i = 0; i < 8; ++i) wb += (i < w) ? MISC[8 + i] : 0;
      const int ex = wb + inc - bsum; PF[2 * tid] = ex; PF[2 * tid + 1] = ex + a; if (tid == 511) PF[1024] = ex + bsum;
      __syncthreads(); }
    const int totalG = PF[1024];
    const float sc2 = 0.08838834764831845f * 1.4426950408889634f;
    const int tid_at = tid;
    for (;;) {
        int tid = tid_at; asm volatile("" : "+v"(tid)); const int lane = tid & 63, w = __builtin_amdgcn_readfirstlane(tid >> 6), fr = lane & 15, fq = lane >> 4;
        if (tid == 0) MISC[0] = (int)atomicAdd(workctr, 1u);
        __syncthreads();
        const int wid = MISC[0];
        __syncthreads();
        if (wid >= totalG + 1024) break;
        int bh, j, causal, qstart, qcount;
        if (wid < totalG) { int lo = 0, hi = 1024; while (hi - lo > 1) { const int mid = (lo + hi) >> 1; if (PF[mid] <= wid) lo = mid; else hi = mid; }
            bh = lo >> 6; j = lo & 63; causal = 0; qstart = (wid - PF[lo]) * 512; const int c = cnt[lo]; qcount = c - qstart; if (qcount > 512) qcount = 512; }
        else { const int o = wid - totalG; bh = o >> 6; j = o & 63; causal = 1; qstart = 0; qcount = 256; }
        const int b = bh >> 3, h = bh & 7; const size_t kbase = (size_t)(b * TT + j * 256);
        { u32x4 kr[8], vr[8];
#pragma unroll
          for (int i8 = 0; i8 < 8; ++i8) { const int pid = tid + i8 * 512; kr[i8] = *(const u32x4*)(proj + (kbase + (pid >> 4)) * NPJ + OFF_MK + h * 128 + (pid & 15) * 8);
              const int e = pid >> 5, ks = pid & 31; vr[i8] = *(const u32x4*)(proj + (kbase + 2 * e + (ks >> 4)) * NPJ + OFF_MV + h * 128 + (ks & 15) * 8); }
#pragma unroll
          for (int i8 = 0; i8 < 8; ++i8) { const int pid = tid + i8 * 512; *(LAS u32x4*)(KS + (pid >> 4) * 144 + (pid & 15) * 8) = kr[i8];
              const int e = pid >> 5, ks = pid & 31; const int g_ = (ks >> 2) * 32, d_ = (ks & 3) * 8;
              *(LAS u32x2*)(VT + e * 272 + g_ + perm4(d_)) = (u32x2){vr[i8].x, vr[i8].y}; *(LAS u32x2*)(VT + e * 272 + g_ + perm4(d_ + 4)) = (u32x2){vr[i8].z, vr[i8].w}; } }
        const int lbase = bh * LISTN + j * 16384 - 128 * j * (j + 1) + qstart;
        const int ntile = (qcount + 127) >> 7;
        int en0, en1, en2, en3;
        { const int q0 = 16 * w + fr, lim = qcount - 1;
          if (causal) { en0 = (j * 256 + q0) | (3 << 14); en1 = (j * 256 + q0 + 128) | (3 << 14); en2 = en1; en3 = en1; }
          else { en0 = list[lbase + (q0 < lim ? q0 : lim)]; en1 = list[lbase + (q0 + 128 < lim ? q0 + 128 : lim)]; en2 = list[lbase + (q0 + 256 < lim ? q0 + 256 : lim)]; en3 = list[lbase + (q0 + 384 < lim ? q0 + 384 : lim)]; } }
        bf16x8 Bq[4], Bn[4];
        { const bf16_t* qp = proj + (size_t)(b * TT + (en0 & 16383)) * NPJ + OFF_MQ + h * 128 + 8 * fq;
#pragma unroll
          for (int ks = 0; ks < 4; ++ks) Bq[ks] = *(const bf16x8*)(qp + 32 * ks); }
        __syncthreads();
        for (int tile = 0; tile < ntile; ++tile) {
            const int en = tile == 0 ? en0 : (tile == 1 ? en1 : (tile == 2 ? en2 : en3));
            { const int enx = tile == 0 ? en1 : (tile == 1 ? en2 : en3); const bf16_t* qp = proj + (size_t)(b * TT + (enx & 16383)) * NPJ + OFF_MQ + h * 128 + 8 * fq;
#pragma unroll
              for (int ks = 0; ks < 4; ++ks) Bn[ks] = *(const bf16x8*)(qp + 32 * ks); }
            const int qi = tile * 128 + 16 * w + fr; const bool valid = qi < qcount; const int t = en & 16383, slot = en >> 14;
            if (tile * 128 + 16 * w < qcount) {
            const int nkt = causal ? (8 * tile + w + 1) : 16;
            f32x4 st[16]; float mx = -INFINITY;
#pragma unroll
            for (int kp = 0; kp < 8; ++kp) { f32x4 a0 = {0.f, 0.f, 0.f, 0.f}, a1 = {0.f, 0.f, 0.f, 0.f};
                if (2 * kp < nkt) { bf16x8 kf[8];
#pragma unroll
                    for (int ks = 0; ks < 4; ++ks) { kf[ks] = *(const LAS bf16x8*)(KS + (32 * kp + fr) * 144 + 32 * ks + 8 * fq); kf[4 + ks] = *(const LAS bf16x8*)(KS + (32 * kp + 16 + fr) * 144 + 32 * ks + 8 * fq); }
#pragma unroll
                    for (int ks = 0; ks < 4; ++ks) { a0 = mfma16(kf[ks], Bq[ks], a0); a1 = mfma16(kf[4 + ks], Bq[ks], a1); }
#pragma unroll
                    for (int jj = 0; jj < 4; ++jj) { float s0 = a0[jj] * sc2, s1 = a1[jj] * sc2;
                        if (causal && (32 * kp + 4 * fq + jj) > qi) s0 = -INFINITY; if ((causal && (32 * kp + 16 + 4 * fq + jj) > qi) || 2 * kp + 1 >= nkt) s1 = -INFINITY;
                        a0[jj] = s0; a1[jj] = s1; mx = fmaxf(mx, fmaxf(s0, s1)); }
                } else { a0 = (f32x4){-INFINITY, -INFINITY, -INFINITY, -INFINITY}; a1 = a0; }
                st[2 * kp] = a0; st[2 * kp + 1] = a1; }
            mx = fmaxf(mx, __shfl_xor(mx, 16)); mx = fmaxf(mx, __shfl_xor(mx, 32));
            float ls = 0.f;
#pragma unroll
            for (int kt = 0; kt < 16; ++kt)
#pragma unroll
                for (int jj = 0; jj < 4; ++jj) { const float pv = exp2f(st[kt][jj] - mx); st[kt][jj] = pv; ls += pv; }
            ls += __shfl_xor(ls, 16); ls += __shfl_xor(ls, 32);
            f32x4 ot[8];
#pragma unroll
            for (int et = 0; et < 8; ++et) ot[et] = (f32x4){0.f, 0.f, 0.f, 0.f};
#pragma unroll
            for (int k2 = 0; k2 < 8; ++k2) { if (2 * k2 < nkt) { const bf16x8 pb = pack8(st[2 * k2], st[2 * k2 + 1]);
#pragma unroll
                    for (int eh = 0; eh < 2; ++eh) { bf16x8 vf[4];
#pragma unroll
                        for (int et = 0; et < 4; ++et) vf[et] = *(const LAS bf16x8*)(VT + (16 * (4 * eh + et) + fr) * 272 + 32 * k2 + 8 * fq);
#pragma unroll
                        for (int et = 0; et < 4; ++et) ot[4 * eh + et] = mfma16(vf[et], pb, ot[4 * eh + et]); } } }
            if (valid) { const float il = 1.f / ls; const size_t rid = (size_t)bh * TT + t; bf16_t* op = opart + ((size_t)slot * 262144 + rid) * 128 + 4 * fq;
#pragma unroll
                for (int et = 0; et < 8; ++et) { u32x2 wv; wv.x = pk2(ot[et][0] * il, ot[et][1] * il); wv.y = pk2(ot[et][2] * il, ot[et][3] * il); *(u32x2*)(op + 16 * et) = wv; }
                if (fq == 0) ML[(size_t)slot * 262144 + rid] = (f32x2){mx, ls}; }
            }
#pragma unroll
            for (int ks = 0; ks < 4; ++ks) Bq[ks] = Bn[ks];
        }
        __syncthreads();
    }
}

DI void phase_moba_combine(const Params& P) {
    const bf16_t* opart = (const bf16_t*)P.out; const f32x2* ML = (const f32x2*)(P.ws + WS_ML); bf16_t* mix = (bf16_t*)(P.ws + WS_R2);
    const int gtid = blockIdx.x * NTHREADS + opq_tid(), gsz = gridDim.x * NTHREADS;
    { const bf16_t* proj = (const bf16_t*)(P.ws + WS_R1);
      for (int i = gtid; i < MT * 128; i += gsz) { const int row = i >> 7, sg = i & 127; bf16_t* mp = mix + (size_t)row * DM + sg * 8; const u32x4 mv = *(const u32x4*)mp, zv = *(const u32x4*)(proj + (size_t)row * NPJ + OFF_GZ + sg * 8);
          const f32x4 g0 = *(const f32x4*)(P.gdn_norm + (sg & 15) * 8), g1 = *(const f32x4*)(P.gdn_norm + (sg & 15) * 8 + 4);
          float o[8]; o[0] = bflo(mv.x); o[1] = bfhi(mv.x); o[2] = bflo(mv.y); o[3] = bfhi(mv.y); o[4] = bflo(mv.z); o[5] = bfhi(mv.z); o[6] = bflo(mv.w); o[7] = bfhi(mv.w);
          float ssl = 0.f;
#pragma unroll
          for (int k = 0; k < 8; ++k) ssl += o[k] * o[k];
          const float rs = rsqrtf(row16_sum(ssl) * (1.f / 128.f) + 1e-6f);
          u32x4 wv; wv.x = pk2(o[0] * rs * g0[0] * silu_f(bflo(zv.x)), o[1] * rs * g0[1] * silu_f(bfhi(zv.x))); wv.y = pk2(o[2] * rs * g0[2] * silu_f(bflo(zv.y)), o[3] * rs * g0[3] * silu_f(bfhi(zv.y)));
          wv.z = pk2(o[4] * rs * g1[0] * silu_f(bflo(zv.z)), o[5] * rs * g1[1] * silu_f(bfhi(zv.z))); wv.w = pk2(o[6] * rs * g1[2] * silu_f(bflo(zv.w)), o[7] * rs * g1[3] * silu_f(bfhi(zv.w))); *(u32x4*)mp = wv; } }
    for (int i = gtid; i < 262144 * 16; i += gsz) { const int rid = i >> 4, sg = i & 15; const int bh = rid >> 14, t = rid & 16383, b = bh >> 3, h = bh & 7;
        f32x2 ml[4]; float M = -INFINITY;
#pragma unroll
        for (int s = 0; s < 4; ++s) { ml[s] = ML[(size_t)s * 262144 + rid]; M = fmaxf(M, ml[s].x); }
        float wgt[4], Lt = 0.f;
#pragma unroll
        for (int s = 0; s < 4; ++s) { wgt[s] = ml[s].y > 0.f ? ml[s].y * exp2f(ml[s].x - M) : 0.f; Lt += wgt[s]; }
        const float iL = 1.f / Lt; float o[8];
#pragma unroll
        for (int k = 0; k < 8; ++k) o[k] = 0.f;
#pragma unroll
        for (int s = 0; s < 4; ++s) { if (wgt[s] > 0.f) { const u32x4 raw = *(const u32x4*)(opart + ((size_t)s * 262144 + rid) * 128 + sg * 8); const float ww = wgt[s] * iL;
                o[0] += ww * bflo(raw.x); o[1] += ww * bfhi(raw.x); o[2] += ww * bflo(raw.y); o[3] += ww * bfhi(raw.y); o[4] += ww * bflo(raw.z); o[5] += ww * bfhi(raw.z); o[6] += ww * bflo(raw.w); o[7] += ww * bfhi(raw.w); } }
        u32x4 wv; wv.x = pk2(o[0], o[1]); wv.y = pk2(o[2], o[3]); wv.z = pk2(o[4], o[5]); wv.w = pk2(o[6], o[7]);
        *(u32x4*)(mix + (size_t)(b * TT + t) * DM + 1024 + h * 128 + sg * 8) = wv; }
}

__global__ void __launch_bounds__(NTHREADS) hybrid_fwd(Params P) {
    extern __shared__ __attribute__((aligned(16))) unsigned char smem[];
    LAS unsigned char* lds = (LAS unsigned char*)smem;
    cg::grid_group grid = cg::this_grid();
    unsigned char* ws = P.ws; const int G = gridDim.x, bx = blockIdx.x;
    bf16_t* R0 = (bf16_t*)(ws + WS_R0); bf16_t* R1 = (bf16_t*)(ws + WS_R1); bf16_t* R2 = (bf16_t*)(ws + WS_R2);
    float* ss1 = (float*)(ws + WS_SS1); float* ss2 = (float*)(ws + WS_SS2);

    phase_prep(P, lds);
    grid.sync();
    { pg8::Gemm g{R0, (const bf16_t*)(ws + WS_WIN), MT, NPJ, DM}; pg8::StaticOrder S; S.init(MT, NPJ, G, bx); EpiProj E{R1, (bf16_t*)(ws + WS_HALO)}; pg8::gemm_phase<decltype(E), pg8::StaticOrder, true, true>(lds, g, S, E); }
    phase_ba(P);
    grid.sync();
    phase_gdn_prep(P, lds);
    phase_moba_prep(P, lds);
    grid.sync();
    phase_moba_select(P, lds);
    grid.sync();
    if (bx < 16) phase_gdn_scan(P, lds, bx);
    phase_moba_attn(P, lds);
    if (bx >= 16) phase_wconv_late(P, lds, bx - 16, G - 16);
    grid.sync();
    phase_moba_combine(P);
    grid.sync();
    { pg8::Gemm g{R2, (const bf16_t*)(ws + WS_WO), MT, DM, DM}; pg8::StaticOrder S; S.init(MT, DM, G, bx); EpiResid E{P.x, P.out, R0, ss1}; pg8::gemm_phase<decltype(E), pg8::StaticOrder, true, false>(lds, g, S, E); }
    grid.sync();
    { pg8::Gemm g{R0, (const bf16_t*)(ws + WS_WGU), MT, 2 * FF, DM}; pg8::StaticOrder S; S.init(MT, 2 * FF, G, bx); EpiAct E{R1, ss1}; pg8::gemm_phase<decltype(E), pg8::StaticOrder, true, true>(lds, g, S, E); }
    grid.sync();
    { pg8::Gemm g{(const bf16_t*)(ws + WS_PB), (const bf16_t*)(ws + WS_WPP), MT, DM, 256}; pg8::StaticOrder S; S.init(MT, DM, G, bx); EpiPlainBf16 E{R0, DM}; pg8::gemm_phase<decltype(E), pg8::StaticOrder, true, false>(lds, g, S, E); }
    { pg8::Gemm g{R1, (const bf16_t*)(ws + WS_WDN), MT, DM, FF}; pg8::StaticOrder S; S.init(MT, DM, G, bx); EpiResid E{P.out, P.out, R2, ss2}; pg8::gemm_phase<decltype(E), pg8::StaticOrder, true, false>(lds, g, S, E); }
    grid.sync();
    { pg8::Gemm g{R2, (const bf16_t*)(ws + WS_WPG), MT, DM, DM}; pg8::StaticOrder S; S.init(MT, DM, G, bx); EpiOut E{P.out, R0, ss2}; pg8::gemm_phase<decltype(E), pg8::StaticOrder, true, false>(lds, g, S, E); }
}

extern "C" void kernel_launch(void* const* d_in, const int* in_sizes, int n_in, void* d_out, int out_size, void* d_ws, size_t ws_size, hipStream_t stream) {
    static int grid_blocks = 0;
    if (!grid_blocks) {
        int dev = 0, cus = 0, per_cu = 0;
        hipGetDevice(&dev);
        hipDeviceGetAttribute(&cus, hipDeviceAttributeMultiprocessorCount, dev);
        hipFuncSetAttribute((const void*)hybrid_fwd, hipFuncAttributeMaxDynamicSharedMemorySize, LDS_BYTES);
        hipOccupancyMaxActiveBlocksPerMultiprocessor(&per_cu, (const void*)hybrid_fwd, NTHREADS, LDS_BYTES);
        if (per_cu < 1) per_cu = 1;
        grid_blocks = cus * per_cu;
        if (ws_size < WS_END) fprintf(stderr, "kernel_launch: workspace too small: %zu < %zu\n", ws_size, (size_t)WS_END);
    }
    Params p{};
    p.x = (const float*)d_in[0]; p.p = (const float*)d_in[1]; p.attn_norm = (const float*)d_in[2]; p.w_in = (const float*)d_in[3]; p.conv_w = (const float*)d_in[4];
    p.A_log = (const float*)d_in[5]; p.dt_bias = (const float*)d_in[6]; p.gdn_norm = (const float*)d_in[7]; p.q_norm = (const float*)d_in[8]; p.k_norm = (const float*)d_in[9];
    p.w_o = (const float*)d_in[10]; p.ffn_norm = (const float*)d_in[11]; p.w_gate = (const float*)d_in[12]; p.w_up = (const float*)d_in[13]; p.w_down = (const float*)d_in[14];
    p.ple_norm = (const float*)d_in[15]; p.w_pg = (const float*)d_in[16]; p.w_pp = (const float*)d_in[17];
    p.out = (float*)d_out; p.ws = (unsigned char*)d_ws;
    void* args[] = {&p};
    hipError_t e = hipLaunchCooperativeKernel((const void*)hybrid_fwd, dim3(grid_blocks), dim3(NTHREADS), args, LDS_BYTES, stream);
    if (e != hipSuccess) fprintf(stderr, "cooperative launch failed: %s (grid %d)\n", hipGetErrorString(e), grid_blocks);
}
```

```cpp
#include <hip/hip_runtime.h>
#include <hip/hip_cooperative_groups.h>
#include <cstdio>
namespace cg = cooperative_groups;

#define LAS __attribute__((address_space(3)))
#define DI __device__ __forceinline__
typedef unsigned short bf16_t;
typedef short bf16x8 __attribute__((ext_vector_type(8)));
typedef float f32x4 __attribute__((ext_vector_type(4)));
typedef float f32x2 __attribute__((ext_vector_type(2)));
typedef unsigned u32x4 __attribute__((ext_vector_type(4)));
typedef unsigned u32x2 __attribute__((ext_vector_type(2)));
typedef __bf16 bfv2 __attribute__((ext_vector_type(2)));

constexpr int DM = 2048, TT = 16384, MT = 32768, NPJ = 7168, FF = 5632, INW = 7184;
constexpr int OFF_GQ = 0, OFF_GK = 1024, OFF_GV = 2048, OFF_GZ = 3072, OFF_MQ = 4096, OFF_MK = 5120, OFF_MV = 6144;
constexpr int LISTN = 516096;
constexpr int NTHREADS = 512;
constexpr int LDS_BYTES = 163840;

constexpr size_t WS_CTL   = 0;
constexpr size_t WS_CNT   = 4096;
constexpr size_t WS_SS1   = 8192;
constexpr size_t WS_SS2   = WS_SS1 + 131072;
constexpr size_t WS_GL    = WS_SS2 + 131072;
constexpr size_t WS_KMEAN = WS_GL + 16384;
constexpr size_t WS_WBA   = WS_KMEAN + 524288;
constexpr size_t WS_BA    = WS_WBA + 65536;
constexpr size_t WS_WIN   = WS_BA + 2097152;
constexpr size_t WS_WO    = WS_WIN + (size_t)7168 * 2048 * 2;
constexpr size_t WS_WGU   = WS_WO + (size_t)2048 * 2048 * 2;
constexpr size_t WS_WDN   = WS_WGU + (size_t)11264 * 2048 * 2;
constexpr size_t WS_WPG   = WS_WDN + (size_t)2048 * 5632 * 2;
constexpr size_t WS_WPP   = WS_WPG + (size_t)2048 * 2048 * 2;
constexpr size_t WS_PB    = WS_WPP + (size_t)2048 * 256 * 2;
constexpr size_t WS_R0    = WS_PB + (size_t)32768 * 256 * 2;
constexpr size_t WS_R1    = WS_R0 + (size_t)32768 * 2048 * 2;
constexpr size_t WS_R2    = WS_R1 + (size_t)32768 * 7168 * 2;
constexpr size_t WS_W2    = WS_R2 + (size_t)32768 * 2048 * 2;
constexpr size_t WS_QKB   = WS_W2 + (size_t)32768 * 1024 * 2;
constexpr size_t WS_HALO  = WS_QKB + (size_t)4096 * 4096 * 2;
constexpr size_t WS_LIST  = WS_HALO + (size_t)513 * 3 * 3072 * 2 + 256 - ((size_t)513 * 3 * 3072 * 2) % 256;
constexpr size_t WS_ML    = WS_LIST + (size_t)16 * LISTN * 4;
constexpr size_t WS_SSQ   = WS_ML + (size_t)4 * 262144 * 8;
constexpr size_t WS_END   = WS_SSQ + (size_t)32768 * 64 * 4;

struct Params {
    const float* x; const float* p; const float* attn_norm; const float* w_in; const float* conv_w; const float* A_log; const float* dt_bias;
    const float* gdn_norm; const float* q_norm; const float* k_norm; const float* w_o; const float* ffn_norm; const float* w_gate; const float* w_up;
    const float* w_down; const float* ple_norm; const float* w_pg; const float* w_pp;
    float* out; unsigned char* ws;
};

DI unsigned pk2(float a, float b) { f32x2 v = {a, b}; bfv2 r = __builtin_convertvector(v, bfv2); return __builtin_bit_cast(unsigned, r); }
DI bf16_t f2bf(float a) { return (bf16_t)(pk2(a, 0.f) & 0xffffu); }
DI float bflo(unsigned w) { return __uint_as_float(w << 16); }
DI float bfhi(unsigned w) { return __uint_as_float(w & 0xffff0000u); }
DI float bf2f(bf16_t v) { return __uint_as_float(((unsigned)v) << 16); }
DI bf16x8 pack8(const f32x4& a, const f32x4& b) { u32x4 w; w.x = pk2(a[0], a[1]); w.y = pk2(a[2], a[3]); w.z = pk2(b[0], b[1]); w.w = pk2(b[2], b[3]); return __builtin_bit_cast(bf16x8, w); }
DI bf16x8 cat8(u32x2 lo, u32x2 hi) { u32x4 w; w.x = lo.x; w.y = lo.y; w.z = hi.x; w.w = hi.y; return __builtin_bit_cast(bf16x8, w); }
DI f32x4 mfma16(bf16x8 a, bf16x8 b, f32x4 c) { return __builtin_amdgcn_mfma_f32_16x16x32_bf16(a, b, c, 0, 0, 0); }
DI int perm4(int d4) { return d4 < 16 ? 2 * d4 : 2 * (d4 - 16) + 4; }
DI float dpp_f(float v, int ctrl_sel) { int x = __float_as_int(v); int r;
    if (ctrl_sel == 0) r = __builtin_amdgcn_mov_dpp(x, 0xB1, 0xf, 0xf, true); else if (ctrl_sel == 1) r = __builtin_amdgcn_mov_dpp(x, 0x4E, 0xf, 0xf, true);
    else if (ctrl_sel == 2) r = __builtin_amdgcn_mov_dpp(x, 0x141, 0xf, 0xf, true); else r = __builtin_amdgcn_mov_dpp(x, 0x140, 0xf, 0xf, true);
    return __int_as_float(r); }
DI float row16_sum(float v) { v += dpp_f(v, 0); v += dpp_f(v, 1); v += dpp_f(v, 2); v += dpp_f(v, 3); return v; }
DI float silu_f(float v) { return v * __builtin_amdgcn_rcpf(1.f + __expf(-v)); }
DI float sigm_f(float v) { return __builtin_amdgcn_rcpf(1.f + __expf(-v)); }

DI int opq_tid() { int t = threadIdx.x; asm volatile("" : "+v"(t)); return t; }

namespace pg8 {
constexpr int BM = 256, BK = 64, HALF = 128, HTB = HALF * BK * 2, STAGE_BYTES = 8 * HTB, NXCD = 8, WGM = 8;
DI int lds_byte(int r, int c) { const int st = (r >> 4) * 2 + (c >> 5), rr = r & 15, cc = c & 31, ob = rr * 64 + cc * 2; return st * 1024 + (ob ^ (((ob >> 9) & 1) << 5)); }
DI void stage_rc(int b, int& R, int& C) { const int st = b / 1024, sb = b % 1024, swz = sb ^ (((sb >> 9) & 1) << 5); R = (st >> 1) * 16 + swz / 64; C = (st & 1) * 32 + (swz % 64) / 2; }
DI int perm32(int rho) { const int n = rho >> 4, i = rho & 15; return 8 * (i >> 2) + 4 * n + (i & 3); }
struct Unit { int pm, pn; };
struct Gemm { const bf16_t* A; const bf16_t* Bt; int M, N, K; };
struct StaticOrder {
    int nM, nN, nwg, G, c;
    DI void init(int M, int N, int G_, int c_) { nM = M / BM; nN = N / BM; nwg = nM * nN; G = G_; c = c_; }
    DI bool next(int i, Unit& u) const {
        const long L = (long)i * G + c; if (L >= nwg) return false;
        int wgid = (int)L; { const int q = nwg / NXCD, r = nwg % NXCD, xcd = wgid % NXCD, off = wgid / NXCD; wgid = (xcd < r ? xcd * (q + 1) : r * (q + 1) + (xcd - r) * q) + off; }
        const int nig = WGM * nN, gid = wgid / nig, fm = gid * WGM, gsz = (nM - fm) < WGM ? (nM - fm) : WGM;
        u.pm = fm + ((wgid % nig) % gsz); u.pn = (wgid % nig) / gsz; return true;
    }
    DI void a_ready(const Unit&) const {}
    DI void done(const Unit&) const {}
};

template <class Epi, class Sched, bool ALIGN_EPI = false, bool SP2 = false>
DI void gemm_phase(LAS unsigned char* lds, const Gemm g, const Sched& S, const Epi& E) {
    const int tid = opq_tid(), wid = __builtin_amdgcn_readfirstlane(tid >> 6), lane = tid & 63, wr = wid >> 2, wc = wid & 3, fr = lane & 15, fq = lane >> 4;
    const int K = g.K, nt = K / BK;
    unsigned voffA[2], voffB[2];
#pragma unroll
    for (int i = 0; i < 2; ++i) { int R, C; stage_rc(tid * 16 + i * 8192, R, C); const int Rb = Epi::PERM ? ((R & ~31) + perm32(R & 31)) : R;
        voffA[i] = (unsigned)(R * K + C) * 2u; voffB[i] = (unsigned)(Rb * K + C) * 2u; }
    const size_t kstep = (size_t)(BK * 2);
    const size_t hstep = (size_t)HALF * K * 2;
    const size_t tstep = 2 * hstep;
    const unsigned ldsw = (unsigned)wid * 1024u;
    const int aoff = lds_byte(wr * 64 + fr, fq * 8), boff = lds_byte(wc * 32 + fr, fq * 8);
#define PG8_SA(b, h) (((b) * 2 + (h)) * HTB)
#define PG8_SB(b, h) ((4 + (b) * 2 + (h)) * HTB)
#define PG8_STAGE(bufoff, gbase, voff) do { _Pragma("unroll") for (int _i = 0; _i < 2; ++_i) \
        __builtin_amdgcn_global_load_lds((const unsigned*)((const char*)(gbase) + (voff)[_i]), (LAS unsigned*)(lds + (bufoff) + ldsw + _i * 8192), 16, 0, 0); } while (0)
#define PG8_LDA(dst, b, h) do { _Pragma("unroll") for (int m = 0; m < 4; ++m) _Pragma("unroll") for (int k = 0; k < 2; ++k) dst[m][k] = *(const LAS bf16x8*)(lds + PG8_SA(b, h) + aoff + m * 2048 + k * 1024); } while (0)
#define PG8_LDB(dst, b, h) do { _Pragma("unroll") for (int n = 0; n < 2; ++n) _Pragma("unroll") for (int k = 0; k < 2; ++k) dst[n][k] = *(const LAS bf16x8*)(lds + PG8_SB(b, h) + boff + n * 2048 + k * 1024); } while (0)
#define PG8_MMA(ai, bj, At, Bt) do { __builtin_amdgcn_s_setprio(1); _Pragma("unroll") for (int m = 0; m < 4; ++m) _Pragma("unroll") for (int n = 0; n < 2; ++n) _Pragma("unroll") for (int k = 0; k < 2; ++k) \
        acc[ai][bj][m][n] = __builtin_amdgcn_mfma_f32_16x16x32_bf16(Bt[n][k], At[m][k], acc[ai][bj][m][n], 0, 0, 0); __builtin_amdgcn_s_setprio(0); } while (0)
#define PG8_WAIT_V(n) asm volatile("s_waitcnt vmcnt(" #n ")" ::: "memory")
#define PG8_WAIT_L(n) asm volatile("s_waitcnt lgkmcnt(" #n ")" ::: "memory")
#define PG8_BAR __builtin_amdgcn_s_barrier()
#define PG8_SCHED __builtin_amdgcn_sched_barrier(0)
    Unit cur, nxt; int ui = 0;
    if (!S.next(0, cur)) return;
    f32x4 acc[2][2][4][2];
#pragma unroll
    for (int a = 0; a < 2; ++a)
#pragma unroll
        for (int b = 0; b < 2; ++b)
#pragma unroll
            for (int m = 0; m < 4; ++m)
#pragma unroll
                for (int n = 0; n < 2; ++n) acc[a][b][m][n] = (f32x4){0.f, 0.f, 0.f, 0.f};
    bf16x8 At[4][2], B0[2][2], B1[2][2];
    const char* cA = (const char*)g.A + (size_t)cur.pm * tstep; const char* cB = (const char*)g.Bt + (size_t)cur.pn * tstep;
    S.a_ready(cur);
    if constexpr (SP2) {
        PG8_STAGE(PG8_SB(0, 0), cB, voffB); PG8_STAGE(PG8_SB(0, 1), cB + hstep, voffB); PG8_STAGE(PG8_SA(0, 0), cA, voffA); PG8_STAGE(PG8_SA(0, 1), cA + hstep, voffA);
        if (wr == 1) PG8_BAR;
        PG8_WAIT_V(2); PG8_BAR;
        PG8_STAGE(PG8_SB(1, 0), cB + kstep, voffB); PG8_STAGE(PG8_SA(1, 0), cA + kstep, voffA); PG8_STAGE(PG8_SB(1, 1), cB + hstep + kstep, voffB);
        PG8_WAIT_V(6); PG8_BAR;
    } else {
        PG8_STAGE(PG8_SB(0, 0), cB, voffB); PG8_STAGE(PG8_SA(0, 0), cA, voffA); PG8_STAGE(PG8_SB(0, 1), cB + hstep, voffB); PG8_STAGE(PG8_SA(0, 1), cA + hstep, voffA);
        if (wr == 1) PG8_BAR;
        PG8_WAIT_V(4); PG8_BAR;
        PG8_STAGE(PG8_SB(1, 0), cB + kstep, voffB); PG8_STAGE(PG8_SA(1, 0), cA + kstep, voffA); PG8_STAGE(PG8_SB(1, 1), cB + hstep + kstep, voffB);
        PG8_WAIT_V(6); PG8_BAR;
    }
    for (;;) {
        const bool has_next = S.next(ui + 1, nxt);
        const char* nA = has_next ? (const char*)g.A + (size_t)nxt.pm * tstep : cA; const char* nB = has_next ? (const char*)g.Bt + (size_t)nxt.pn * tstep : cB;
        for (int t = 0; t < nt; t += 2) {
            const bool last = (t == nt - 2);
            const char* a1 = cA + (size_t)(t + 1) * kstep;
            const char* a2 = last ? nA : cA + (size_t)(t + 2) * kstep; const char* b2 = last ? nB : cB + (size_t)(t + 2) * kstep;
            const char* a3 = a2 + kstep; const char* b3 = b2 + kstep;
            if (last && has_next) S.a_ready(nxt);
            if constexpr (SP2) {
            PG8_LDB(B0, 0, 0); PG8_LDB(B1, 0, 1); PG8_SCHED; PG8_LDA(At, 0, 0); PG8_STAGE(PG8_SA(1, 1), a1 + hstep, voffA);
            PG8_WAIT_V(8); PG8_WAIT_L(0); PG8_BAR; PG8_MMA(0, 0, At, B0); PG8_MMA(0, 1, At, B1); PG8_BAR; PG8_SCHED;
            PG8_LDA(At, 0, 1); PG8_STAGE(PG8_SB(0, 0), b2, voffB); PG8_STAGE(PG8_SB(0, 1), b2 + hstep, voffB); PG8_STAGE(PG8_SA(0, 0), a2, voffA);
            PG8_WAIT_V(8); PG8_WAIT_L(0); PG8_BAR; PG8_MMA(1, 0, At, B0); PG8_MMA(1, 1, At, B1); PG8_BAR; PG8_SCHED;
            PG8_LDB(B0, 1, 0); PG8_LDB(B1, 1, 1); PG8_SCHED; PG8_LDA(At, 1, 0); PG8_STAGE(PG8_SA(0, 1), a2 + hstep, voffA);
            PG8_WAIT_V(8); PG8_WAIT_L(0); PG8_BAR; PG8_MMA(0, 0, At, B0); PG8_MMA(0, 1, At, B1); PG8_BAR; PG8_SCHED;
            PG8_LDA(At, 1, 1); PG8_STAGE(PG8_SB(1, 0), b3, voffB); PG8_STAGE(PG8_SB(1, 1), b3 + hstep, voffB); PG8_STAGE(PG8_SA(1, 0), a3, voffA);
            PG8_WAIT_V(8); PG8_WAIT_L(0); PG8_BAR; PG8_MMA(1, 0, At, B0); PG8_MMA(1, 1, At, B1); PG8_BAR; PG8_SCHED;
            } else {
            PG8_LDB(B0, 0, 0); PG8_SCHED; PG8_LDA(At, 0, 0); PG8_STAGE(PG8_SA(1, 1), a1 + hstep, voffA);
            PG8_WAIT_L(8); PG8_BAR; PG8_WAIT_L(0); PG8_MMA(0, 0, At, B0); PG8_BAR; PG8_SCHED;
            PG8_LDB(B1, 0, 1); PG8_STAGE(PG8_SB(0, 0), b2, voffB);
            PG8_BAR; PG8_WAIT_L(0); PG8_MMA(0, 1, At, B1); PG8_BAR;
            PG8_LDA(At, 0, 1); PG8_STAGE(PG8_SA(0, 0), a2, voffA);
            PG8_BAR; PG8_WAIT_L(0); PG8_MMA(1, 0, At, B0); PG8_BAR; PG8_SCHED;
            PG8_STAGE(PG8_SB(0, 1), b2 + hstep, voffB);
            PG8_WAIT_V(6); PG8_BAR; PG8_MMA(1, 1, At, B1); PG8_BAR;
            PG8_LDB(B0, 1, 0); PG8_SCHED; PG8_LDA(At, 1, 0); PG8_STAGE(PG8_SA(0, 1), a2 + hstep, voffA);
            PG8_WAIT_L(8); PG8_BAR; PG8_WAIT_L(0); PG8_MMA(0, 0, At, B0); PG8_BAR; PG8_SCHED;
            PG8_LDB(B1, 1, 1); PG8_STAGE(PG8_SB(1, 0), b3, voffB);
            PG8_BAR; PG8_WAIT_L(0); PG8_MMA(0, 1, At, B1); PG8_BAR;
            PG8_LDA(At, 1, 1); PG8_STAGE(PG8_SA(1, 0), a3, voffA);
            PG8_BAR; PG8_WAIT_L(0); PG8_MMA(1, 0, At, B0); PG8_BAR; PG8_SCHED;
            PG8_STAGE(PG8_SB(1, 1), b3 + hstep, voffB);
            PG8_WAIT_V(6); PG8_BAR; PG8_MMA(1, 1, At, B1); PG8_BAR;
            }
        }
        if constexpr (ALIGN_EPI) { if (wr == 0) PG8_BAR; }
        if constexpr (!Epi::AFTER_DRAIN) { E(acc, cur, wr, wc, fr, fq); S.done(cur); }
        if (!has_next) break;
#pragma unroll
        for (int a = 0; a < 2; ++a)
#pragma unroll
            for (int b = 0; b < 2; ++b)
#pragma unroll
                for (int m = 0; m < 4; ++m)
#pragma unroll
                    for (int n = 0; n < 2; ++n) acc[a][b][m][n] = (f32x4){0.f, 0.f, 0.f, 0.f};
        cur = nxt; cA = nA; cB = nB; ++ui;
        if constexpr (ALIGN_EPI) { if (wr == 1) PG8_BAR; }
    }
    PG8_WAIT_V(0);
    if constexpr (!ALIGN_EPI) { if (wr == 0) PG8_BAR; }
    PG8_BAR;
    if constexpr (Epi::AFTER_DRAIN) { E.fused(acc, cur, wr, wc, fr, fq, lds, wid, lane); S.done(cur); }
#undef PG8_SA
#undef PG8_SB
#undef PG8_STAGE
#undef PG8_LDA
#undef PG8_LDB
#undef PG8_MMA
#undef PG8_WAIT_V
#undef PG8_WAIT_L
#undef PG8_BAR
#undef PG8_SCHED
}
}
using pg8::Unit;

struct EpiProj {
    static constexpr bool PERM = true, AFTER_DRAIN = false;
    bf16_t* O; bf16_t* halo;
    DI void operator()(const f32x4 (&acc)[2][2][4][2], const Unit& u, int wr, int wc, int fr, int fq) const {
        const int row0 = u.pm * 256 + wr * 64 + fr, col0 = u.pn * 256 + wc * 32 + 8 * fq;
#pragma unroll
        for (int ai = 0; ai < 2; ++ai)
#pragma unroll
            for (int m = 0; m < 4; ++m) { const int row = row0 + ai * 128 + m * 16; bf16_t* rowp = O + (size_t)row * NPJ + col0;
#pragma unroll
                for (int bj = 0; bj < 2; ++bj) { const f32x4 v0 = acc[ai][bj][m][0], v1 = acc[ai][bj][m][1];
                    u32x4 w; w.x = pk2(v0[0], v0[1]); w.y = pk2(v0[2], v0[3]); w.z = pk2(v1[0], v1[1]); w.w = pk2(v1[2], v1[3]);
                    *(u32x4*)(rowp + bj * 128) = w;
                    if (m == 3 && fr >= 13 && u.pn < 12) *(u32x4*)(halo + ((size_t)((row >> 6) + 1) * 3 + (fr - 13)) * 3072 + col0 + bj * 128) = w; } }
    }
};
struct EpiPlainBf16 {
    static constexpr bool PERM = true, AFTER_DRAIN = false;
    bf16_t* O; int ldc;
    DI void operator()(const f32x4 (&acc)[2][2][4][2], const Unit& u, int wr, int wc, int fr, int fq) const {
        const int row0 = u.pm * 256 + wr * 64 + fr, col0 = u.pn * 256 + wc * 32 + 8 * fq;
#pragma unroll
        for (int ai = 0; ai < 2; ++ai)
#pragma unroll
            for (int m = 0; m < 4; ++m) { bf16_t* rowp = O + (size_t)(row0 + ai * 128 + m * 16) * ldc + col0;
#pragma unroll
                for (int bj = 0; bj < 2; ++bj) { const f32x4 v0 = acc[ai][bj][m][0], v1 = acc[ai][bj][m][1];
                    u32x4 w; w.x = pk2(v0[0], v0[1]); w.y = pk2(v0[2], v0[3]); w.z = pk2(v1[0], v1[1]); w.w = pk2(v1[2], v1[3]);
                    *(u32x4*)(rowp + bj * 128) = w; } }
    }
};
struct EpiResid {
    static constexpr bool PERM = false, AFTER_DRAIN = false;
    const float* base; float* out; bf16_t* hb; float* ss;
    DI void operator()(const f32x4 (&acc)[2][2][4][2], const Unit& u, int wr, int wc, int fr, int fq) const {
        const int row0 = u.pm * 256 + wr * 64 + fr, col0 = u.pn * 256 + wc * 32 + 4 * fq;
#pragma unroll
        for (int ai = 0; ai < 2; ++ai) { f32x4 bs[4][4];
#pragma unroll
            for (int m = 0; m < 4; ++m)
#pragma unroll
                for (int q = 0; q < 4; ++q) bs[m][q] = *(const f32x4*)(base + (size_t)(row0 + ai * 128 + m * 16) * DM + col0 + (q >> 1) * 128 + (q & 1) * 16);
#pragma unroll
            for (int m = 0; m < 4; ++m) { const int row = row0 + ai * 128 + m * 16; const size_t off = (size_t)row * DM + col0; float s = 0.f;
#pragma unroll
                for (int q = 0; q < 4; ++q) { const f32x4 hv = bs[m][q] + acc[ai][q >> 1][m][q & 1];
                        *(f32x4*)(out + off + (q >> 1) * 128 + (q & 1) * 16) = hv; u32x2 w; w.x = pk2(hv[0], hv[1]); w.y = pk2(hv[2], hv[3]);
                        *(u32x2*)(hb + off + (q >> 1) * 128 + (q & 1) * 16) = w; s += (hv[0] * hv[0] + hv[1] * hv[1]) + (hv[2] * hv[2] + hv[3] * hv[3]); }
                s += __shfl_xor(s, 16); s += __shfl_xor(s, 32);
                if (fq == 0) atomicAdd(ss + row, s); }
            asm volatile("" ::: "memory"); }
    }
};
struct EpiAct {
    static constexpr bool PERM = true, AFTER_DRAIN = false;
    bf16_t* O; const float* ss;
    DI void operator()(const f32x4 (&acc)[2][2][4][2], const Unit& u, int wr, int wc, int fr, int fq) const {
        const int row0 = u.pm * 256 + wr * 64 + fr, col0 = u.pn * 128 + wc * 32 + 8 * fq;
        float rs[8];
#pragma unroll
        for (int g = 0; g < 8; ++g) rs[g] = ss[row0 + (g >> 2) * 128 + (g & 3) * 16];
#pragma unroll
        for (int ai = 0; ai < 2; ++ai)
#pragma unroll
            for (int m = 0; m < 4; ++m) { const int row = row0 + ai * 128 + m * 16; const float r = rsqrtf(rs[ai * 4 + m] * (1.f / 2048.f) + 1e-6f);
                float a[8];
#pragma unroll
                for (int n = 0; n < 2; ++n)
#pragma unroll
                    for (int j = 0; j < 4; ++j) { const float gv = r * acc[ai][0][m][n][j], uv = r * acc[ai][1][m][n][j]; a[n * 4 + j] = silu_f(gv) * uv; }
                u32x4 w; w.x = pk2(a[0], a[1]); w.y = pk2(a[2], a[3]); w.z = pk2(a[4], a[5]); w.w = pk2(a[6], a[7]);
                *(u32x4*)(O + (size_t)row * FF + col0) = w; }
    }
};
struct EpiOut {
    static constexpr bool PERM = false, AFTER_DRAIN = false;
    float* out; const bf16_t* pp; const float* ss;
    DI void operator()(const f32x4 (&acc)[2][2][4][2], const Unit& u, int wr, int wc, int fr, int fq) const {
        const int row0 = u.pm * 256 + wr * 64 + fr, col0 = u.pn * 256 + wc * 32 + 4 * fq;
        float rs[8];
#pragma unroll
        for (int g = 0; g < 8; ++g) rs[g] = ss[row0 + (g >> 2) * 128 + (g & 3) * 16];
#pragma unroll
        for (int ai = 0; ai < 2; ++ai)
#pragma unroll
            for (int m = 0; m < 4; ++m) { const int row = row0 + ai * 128 + m * 16; const size_t off = (size_t)row * DM + col0; const float r = rsqrtf(rs[ai * 4 + m] * (1.f / 2048.f) + 1e-6f);
                f32x4 hv[4]; u32x2 pw[4];
#pragma unroll
                for (int q = 0; q < 4; ++q) { hv[q] = *(const f32x4*)(out + off + (q >> 1) * 128 + (q & 1) * 16); pw[q] = *(const u32x2*)(pp + off + (q >> 1) * 128 + (q & 1) * 16); }
#pragma unroll
                for (int q = 0; q < 4; ++q) { const f32x4 a = acc[ai][q >> 1][m][q & 1]; f32x4 o;
                        o[0] = hv[q][0] + sigm_f(r * a[0]) * bflo(pw[q].x); o[1] = hv[q][1] + sigm_f(r * a[1]) * bfhi(pw[q].x);
                        o[2] = hv[q][2] + sigm_f(r * a[2]) * bflo(pw[q].y); o[3] = hv[q][3] + sigm_f(r * a[3]) * bfhi(pw[q].y);
                        *(f32x4*)(out + off + (q >> 1) * 128 + (q & 1) * 16) = o; }
                asm volatile("" ::: "memory"); }
    }
};

DI void tconv_tile(const float* __restrict__ src, int ld, int c0, int k0, bf16_t* __restrict__ dst, int dK, int n0, const float* __restrict__ nw, LAS float* tl) {
    const int tid = opq_tid();
    f32x4 v[8];
#pragma unroll
    for (int i = 0; i < 8; ++i) v[i] = *(const f32x4*)(src + (size_t)(k0 + (tid >> 4) + 32 * i) * ld + c0 + (tid & 15) * 4);
#pragma unroll
    for (int i = 0; i < 8; ++i) { const int k = (tid >> 4) + 32 * i; const float sc = nw ? nw[k0 + k] : 1.f;
        LAS float* q = tl + k * 65 + (tid & 15) * 4; q[0] = v[i][0] * sc; q[1] = v[i][1] * sc; q[2] = v[i][2] * sc; q[3] = v[i][3] * sc; }
    __syncthreads();
    { const int n = tid >> 3, kq = (tid & 7) * 8;
#pragma unroll
      for (int j = 0; j < 4; ++j) { const int ks = kq + 64 * j; float f[8];
#pragma unroll
          for (int i = 0; i < 8; ++i) f[i] = tl[(ks + i) * 65 + n];
          u32x4 w; w.x = pk2(f[0], f[1]); w.y = pk2(f[2], f[3]); w.z = pk2(f[4], f[5]); w.w = pk2(f[6], f[7]);
          *(u32x4*)(dst + (size_t)(n0 + n) * dK + k0 + ks) = w; } }
    __syncthreads();
}

DI void phase_prep(const Params& P, LAS unsigned char* lds) {
    unsigned char* ws = P.ws; const int tid = opq_tid(), G = gridDim.x, bx = blockIdx.x;
    const int gtid = bx * NTHREADS + tid, gsz = G * NTHREADS;
    for (int i = gtid; i < (int)((WS_GL - WS_CTL) / 4); i += gsz) ((unsigned*)(ws + WS_CTL))[i] = 0u;
    { bf16_t* wba = (bf16_t*)(ws + WS_WBA); for (int i = gtid; i < 16 * 2048; i += gsz) { const int n = i >> 11, k = i & 2047; wba[i] = f2bf(P.w_in[(size_t)k * INW + 4096 + n]); } }
    { bf16_t* pb = (bf16_t*)(ws + WS_PB); for (int i = gtid; i < MT * 256 / 8; i += gsz) { const f32x4 a = *(const f32x4*)(P.p + (size_t)i * 8), b = *(const f32x4*)(P.p + (size_t)i * 8 + 4);
        u32x4 w; w.x = pk2(a[0], a[1]); w.y = pk2(a[2], a[3]); w.z = pk2(b[0], b[1]); w.w = pk2(b[2], b[3]); *(u32x4*)(pb + (size_t)i * 8) = w; } }
    { bf16_t* xn = (bf16_t*)(ws + WS_R0); const int lane = tid & 63, gw = bx * 8 + (tid >> 6);
      f32x4 wv[8];
#pragma unroll
      for (int i = 0; i < 8; ++i) wv[i] = *(const f32x4*)(P.attn_norm + lane * 4 + i * 256);
      for (int row = gw * 2; row < MT; row += G * 16) { const float* xr = P.x + (size_t)row * DM; f32x4 v[2][8]; float s0 = 0.f, s1 = 0.f;
#pragma unroll
          for (int r = 0; r < 2; ++r)
#pragma unroll
              for (int i = 0; i < 8; ++i) v[r][i] = *(const f32x4*)(xr + (size_t)r * DM + lane * 4 + i * 256);
#pragma unroll
          for (int i = 0; i < 8; ++i) { s0 += (v[0][i][0] * v[0][i][0] + v[0][i][1] * v[0][i][1]) + (v[0][i][2] * v[0][i][2] + v[0][i][3] * v[0][i][3]);
              s1 += (v[1][i][0] * v[1][i][0] + v[1][i][1] * v[1][i][1]) + (v[1][i][2] * v[1][i][2] + v[1][i][3] * v[1][i][3]); }
#pragma unroll
          for (int o = 1; o < 64; o <<= 1) { s0 += __shfl_xor(s0, o); s1 += __shfl_xor(s1, o); }
          const float r0 = rsqrtf(s0 * (1.f / 2048.f) + 1e-6f), r1 = rsqrtf(s1 * (1.f / 2048.f) + 1e-6f);
#pragma unroll
          for (int r = 0; r < 2; ++r)
#pragma unroll
              for (int i = 0; i < 8; ++i) { const float rr = r ? r1 : r0; u32x2 w; w.x = pk2(v[r][i][0] * rr * wv[i][0], v[r][i][1] * rr * wv[i][1]); w.y = pk2(v[r][i][2] * rr * wv[i][2], v[r][i][3] * rr * wv[i][3]);
                  *(u32x2*)(xn + (size_t)(row + r) * DM + lane * 4 + i * 256) = w; } } }
    LAS float* tl = (LAS float*)lds;
    for (int gi = bx; gi < 896; gi += G) { const int nt = gi >> 3, kg = gi & 7, n0 = nt * 64; tconv_tile(P.w_in, INW, n0 < 4096 ? n0 : n0 + 16, kg * 256, (bf16_t*)(ws + WS_WIN), 2048, n0, nullptr, tl); }
}
DI void phase_wconv_late(const Params& P, LAS unsigned char* lds, int wg0, int nwg) {
    unsigned char* ws = P.ws; LAS float* tl = (LAS float*)lds;
    for (int gi = 896 + wg0; gi < 3552; gi += nwg) {
        if (gi < 1152) { const int t2 = gi - 896, nt = t2 >> 3, kg = t2 & 7; tconv_tile(P.w_o, 2048, nt * 64, kg * 256, (bf16_t*)(ws + WS_WO), 2048, nt * 64, nullptr, tl); }
        else if (gi < 2560) { const int t2 = gi - 1152, nt = t2 >> 3, kg = t2 & 7, n0 = nt * 64, pn = n0 >> 8, r = n0 & 255;
            tconv_tile(r < 128 ? P.w_gate : P.w_up, FF, pn * 128 + (r & 127), kg * 256, (bf16_t*)(ws + WS_WGU), 2048, n0, P.ffn_norm, tl); }
        else if (gi < 3264) { const int t2 = gi - 2560, nt = t2 / 22, kg = t2 % 22; tconv_tile(P.w_down, 2048, nt * 64, kg * 256, (bf16_t*)(ws + WS_WDN), FF, nt * 64, nullptr, tl); }
        else if (gi < 3520) { const int t2 = gi - 3264, nt = t2 >> 3, kg = t2 & 7; tconv_tile(P.w_pg, 2048, nt * 64, kg * 256, (bf16_t*)(ws + WS_WPG), 2048, nt * 64, P.ple_norm, tl); }
        else { const int nt = gi - 3520; tconv_tile(P.w_pp, 2048, nt * 64, 0, (bf16_t*)(ws + WS_WPP), 256, nt * 64, nullptr, tl); }
    }
}

DI void phase_ba(const Params& P) {
    const int tid = opq_tid(), lane = tid & 63, fr = lane & 15, fq = lane >> 4, gw = blockIdx.x * 8 + (tid >> 6);
    const bf16_t* xn = (const bf16_t*)(P.ws + WS_R0); const bf16_t* wba = (const bf16_t*)(P.ws + WS_WBA); float* BA = (float*)(P.ws + WS_BA);
    for (int rt = gw; rt < MT / 16; rt += gridDim.x * 8) {
        f32x4 acc = {0.f, 0.f, 0.f, 0.f}; const bf16_t* ap = xn + (size_t)(rt * 16 + fr) * DM + 8 * fq; const bf16_t* bp = wba + fr * 2048 + 8 * fq;
#pragma unroll 16
        for (int ks = 0; ks < 64; ++ks) acc = mfma16(*(const bf16x8*)(ap + 32 * ks), *(const bf16x8*)(bp + 32 * ks), acc);
#pragma unroll
        for (int j = 0; j < 4; ++j) BA[(size_t)(rt * 16 + 4 * fq + j) * 16 + fr] = acc[j];
    }
}

constexpr int G1_QS = 0, G1_KS = 18432, G1_VT = 36864, G1_KT = 57344, G1_SM = 77824, G1_TEAM = 78848;
DI void phase_gdn_prep(const Params& P, LAS unsigned char* lds) {
    const int tid0 = opq_tid(), team = tid0 >> 8;
    LAS unsigned char* L = lds + team * G1_TEAM;
    LAS bf16_t* QS = (LAS bf16_t*)(L + G1_QS); LAS bf16_t* KS = (LAS bf16_t*)(L + G1_KS); LAS bf16_t* VT = (LAS bf16_t*)(L + G1_VT); LAS bf16_t* KT = (LAS bf16_t*)(L + G1_KT);
    LAS float* AF = (LAS float*)(L + G1_QS); LAS bf16_t* TB = (LAS bf16_t*)(L + G1_KS); LAS float* SM = (LAS float*)(L + G1_SM);
    bf16_t* proj = (bf16_t*)(P.ws + WS_R1); const bf16_t* halo = (const bf16_t*)(P.ws + WS_HALO); const float* BA = (const float*)(P.ws + WS_BA);
    bf16_t* W2 = (bf16_t*)(P.ws + WS_W2); bf16_t* QKB = (bf16_t*)(P.ws + WS_QKB); float* GL = (float*)(P.ws + WS_GL);
    for (int pi = blockIdx.x; pi < 2048; pi += gridDim.x) {
        int tid = tid0; asm volatile("" : "+v"(tid));
        const int tt = tid & 255, tw = __builtin_amdgcn_readfirstlane((tid >> 6) & 3), lane = tid & 63, fr = lane & 15, fq = lane >> 4;
        const int ci = pi * 2 + team, h = ci & 7, n = (ci >> 3) & 255, b = ci >> 11, t0 = b * TT + n * 64;
        if (tw == 0) {
            const float bv = BA[(size_t)(t0 + lane) * 16 + h], av = BA[(size_t)(t0 + lane) * 16 + 8 + h];
            const float beta = sigm_f(bv); const float xx = av + P.dt_bias[h]; const float sp = xx > 20.f ? xx : log1pf(__expf(xx));
            const float gg = -__expf(P.A_log[h]) * sp; float gc = gg;
#pragma unroll
            for (int o = 1; o < 64; o <<= 1) { const float v = __shfl_up(gc, o); if (lane >= o) gc += v; }
            const float glast = __shfl(gc, 63);
            SM[lane] = gc; SM[64 + lane] = beta; SM[128 + lane] = __expf(gc); SM[192 + lane] = __expf(glast - gc);
            if (lane == 63) GL[(b * 8 + h) * 256 + n] = __expf(gc);
        }
        __syncthreads();
        { const int r = tt >> 2, cg0 = (tt & 3) * 32; const float beta_r = SM[64 + r], egc_r = SM[128 + r];
#pragma unroll 1
          for (int x = 0; x < 3; ++x) {
              float val[32]; const int colbase = x * 1024 + h * 128 + cg0;
              u32x4 rawa[4][4];
#pragma unroll
              for (int sg = 0; sg < 4; ++sg) { const int col = colbase + sg * 8;
#pragma unroll
                  for (int j = 0; j < 4; ++j) { const int rr = r - 3 + j; rawa[sg][j] = (u32x4){0u, 0u, 0u, 0u};
                      if (rr >= 0) rawa[sg][j] = *(const u32x4*)(proj + (size_t)(t0 + rr) * NPJ + col);
                      else if (n > 0) rawa[sg][j] = *(const u32x4*)(halo + ((size_t)(t0 >> 6) * 3 + (rr + 3)) * 3072 + col); } }
#pragma unroll
              for (int sg = 0; sg < 4; ++sg) { const int col = colbase + sg * 8;
#pragma unroll
                  for (int i = 0; i < 8; ++i) { const f32x4 w4 = *(const f32x4*)(P.conv_w + (size_t)(col + i) * 4); float a = 0.f;
#pragma unroll
                      for (int j = 0; j < 4; ++j) { const unsigned wd = rawa[sg][j][i >> 1]; const float xv = (i & 1) ? bfhi(wd) : bflo(wd); a += w4[j] * xv; }
                      val[sg * 8 + i] = silu_f(a); } }
              if (x < 2) { float ss = 0.f;
#pragma unroll
                  for (int i = 0; i < 32; ++i) ss += val[i] * val[i];
                  ss += __shfl_xor(ss, 1); ss += __shfl_xor(ss, 2);
                  const float sc = rsqrtf(ss + 1e-6f) * (x == 0 ? 0.08838834764831845f : 1.f);
#pragma unroll
                  for (int i = 0; i < 32; ++i) val[i] *= sc; }
              if (x < 2) { LAS bf16_t* dst = (x == 0 ? QS : KS) + r * 144 + cg0;
#pragma unroll
                  for (int i = 0; i < 4; ++i) { u32x4 w; w.x = pk2(val[8 * i], val[8 * i + 1]); w.y = pk2(val[8 * i + 2], val[8 * i + 3]); w.z = pk2(val[8 * i + 4], val[8 * i + 5]); w.w = pk2(val[8 * i + 6], val[8 * i + 7]);
                      *(LAS u32x4*)(dst + 8 * i) = w; } }
              if (x == 1) { const float f = beta_r * egc_r;
#pragma unroll
                  for (int i = 0; i < 32; ++i) KT[(cg0 + i) * 80 + r] = f2bf(val[i] * f); }
              if (x == 2) {
#pragma unroll
                  for (int i = 0; i < 32; ++i) VT[(cg0 + i) * 80 + r] = f2bf(val[i] * beta_r); }
          } }
        __syncthreads();
        f32x4 kk[4], qk[4];
#pragma unroll
        for (int nt = 0; nt < 4; ++nt) { kk[nt] = (f32x4){0.f, 0.f, 0.f, 0.f}; qk[nt] = (f32x4){0.f, 0.f, 0.f, 0.f}; }
#pragma unroll
        for (int ks = 0; ks < 4; ++ks) { const bf16x8 ak = *(const LAS bf16x8*)(KS + (16 * tw + fr) * 144 + 32 * ks + 8 * fq), aq = *(const LAS bf16x8*)(QS + (16 * tw + fr) * 144 + 32 * ks + 8 * fq);
#pragma unroll
            for (int nt = 0; nt < 4; ++nt) { const bf16x8 bk = *(const LAS bf16x8*)(KS + (16 * nt + fr) * 144 + 32 * ks + 8 * fq); kk[nt] = mfma16(ak, bk, kk[nt]); qk[nt] = mfma16(aq, bk, qk[nt]); } }
        { const int r = tt >> 2, cg0 = (tt & 3) * 32; const float e = SM[128 + r];
#pragma unroll
          for (int i = 0; i < 4; ++i) { const u32x4 s = *(const LAS u32x4*)(QS + r * 144 + cg0 + 8 * i); u32x4 w;
              w.x = pk2(bflo(s.x) * e, bfhi(s.x) * e); w.y = pk2(bflo(s.y) * e, bfhi(s.y) * e); w.z = pk2(bflo(s.z) * e, bfhi(s.z) * e); w.w = pk2(bflo(s.w) * e, bfhi(s.w) * e);
              *(u32x4*)(proj + (size_t)(t0 + r) * NPJ + OFF_GQ + h * 128 + cg0 + 8 * i) = w; } }
        { const int d = tt >> 1, cb = (tt & 1) * 32;
#pragma unroll
          for (int i4 = 0; i4 < 4; ++i4) { const int c0 = cb + 8 * i4; float f[8];
#pragma unroll
              for (int i = 0; i < 8; ++i) f[i] = bf2f(KS[(c0 + i) * 144 + d]) * SM[192 + c0 + i];
              u32x4 w; w.x = pk2(f[0], f[1]); w.y = pk2(f[2], f[3]); w.z = pk2(f[4], f[5]); w.w = pk2(f[6], f[7]);
              *(u32x4*)(proj + (size_t)(t0 + (d >> 1)) * NPJ + OFF_GK + h * 128 + (d & 1) * 64 + c0) = w; } }
        __syncthreads();
#pragma unroll
        for (int nt = 0; nt < 4; ++nt)
#pragma unroll
            for (int j = 0; j < 4; ++j) { const int c = 16 * tw + 4 * fq + j, s = 16 * nt + fr; const float dec = (s <= c) ? __expf(SM[c] - SM[s]) : 0.f;
                AF[c * 65 + s] = (s < c) ? SM[64 + c] * kk[nt][j] * dec : (s == c ? 1.f : 0.f);
                QKB[(size_t)ci * 4096 + c * 64 + s] = f2bf(qk[nt][j] * dec); }
        __syncthreads();
        { const int bb = tw * 16;
          if (lane < 16) {
              for (int i = 1; i < 16; ++i) { float a0 = 0.f, a1 = 0.f; int j = 0;
                  for (; j + 2 <= i; j += 2) { a0 += AF[(bb + i) * 65 + bb + j] * AF[(bb + j) * 65 + bb + lane]; a1 += AF[(bb + i) * 65 + bb + j + 1] * AF[(bb + j + 1) * 65 + bb + lane]; }
                  if (j < i) a0 += AF[(bb + i) * 65 + bb + j] * AF[(bb + j) * 65 + bb + lane];
                  AF[(bb + i) * 65 + bb + lane] = lane < i ? -(a0 + a1) : (lane == i ? 1.f : 0.f); } }
#pragma unroll
          for (int k = 0; k < 4; ++k) { const int row = bb + fq + 4 * k; TB[row * 80 + bb + fr] = f2bf(AF[row * 65 + bb + fr]);
              for (int jb = tw + 1; jb < 4; ++jb) TB[row * 80 + 16 * jb + fr] = (bf16_t)0; }
          __syncthreads();
          for (int i = 1; i < 4; ++i) {
              if (tw < i) { const int j = tw; f32x4 X = {0.f, 0.f, 0.f, 0.f};
                  for (int k = j; k < i; ++k) {
#pragma unroll
                      for (int kk = 0; kk < 4; ++kk) { const float av = AF[(16 * i + fr) * 65 + 16 * k + 4 * kk + fq];
                          const float bv = (k == j) ? AF[(16 * k + 4 * kk + fq) * 65 + 16 * j + fr] : bf2f(TB[(16 * k + 4 * kk + fq) * 80 + 16 * j + fr]);
                          X = __builtin_amdgcn_mfma_f32_16x16x4f32(av, bv, X, 0, 0, 0); } }
                  f32x4 O = {0.f, 0.f, 0.f, 0.f};
#pragma unroll
                  for (int kk = 0; kk < 4; ++kk) O = __builtin_amdgcn_mfma_f32_16x16x4f32(AF[(16 * i + fr) * 65 + 16 * i + 4 * fq + kk], X[kk], O, 0, 0, 0);
#pragma unroll
                  for (int jj = 0; jj < 4; ++jj) TB[(16 * i + 4 * fq + jj) * 80 + 16 * j + fr] = f2bf(-O[jj]); }
              __syncthreads(); }
        }
        { bf16x8 at[2];
#pragma unroll
          for (int ks = 0; ks < 2; ++ks) at[ks] = *(const LAS bf16x8*)(TB + (16 * tw + fr) * 80 + 32 * ks + 8 * fq);
#pragma unroll
          for (int nt = 0; nt < 8; ++nt) { f32x4 a = {0.f, 0.f, 0.f, 0.f};
#pragma unroll
              for (int ks = 0; ks < 2; ++ks) a = mfma16(at[ks], *(const LAS bf16x8*)(VT + (16 * nt + fr) * 80 + 32 * ks + 8 * fq), a);
              const int e = 16 * nt + fr; u32x2 w; w.x = pk2(a[0], a[1]); w.y = pk2(a[2], a[3]);
              *(u32x2*)(proj + (size_t)(t0 + (e >> 1)) * NPJ + OFF_GV + h * 128 + (e & 1) * 64 + 16 * tw + 4 * fq) = w; }
#pragma unroll
          for (int mt = 0; mt < 8; ++mt) { f32x4 a = {0.f, 0.f, 0.f, 0.f};
#pragma unroll
              for (int ks = 0; ks < 2; ++ks) a = mfma16(*(const LAS bf16x8*)(KT + (16 * mt + fr) * 80 + 32 * ks + 8 * fq), at[ks], a);
              u32x2 w; w.x = pk2(a[0], a[1]); w.y = pk2(a[2], a[3]);
              *(u32x2*)(W2 + (size_t)(t0 + 16 * tw + fr) * 1024 + h * 128 + 16 * mt + 4 * fq) = w; } }
        __syncthreads();
    }
}

DI void phase_moba_prep(const Params& P, LAS unsigned char* lds) {
    const int tid = opq_tid(), lane = tid & 63, wave = tid >> 6, l16 = lane & 15;
    bf16_t* proj = (bf16_t*)(P.ws + WS_R1); float* kmean = (float*)(P.ws + WS_KMEAN);
    LAS bf16_t* VS = (LAS bf16_t*)lds; LAS float* CS = (LAS float*)(lds + 69632);
    for (int task = blockIdx.x; task < 1024; task += gridDim.x) {
        const int h = task & 7, blk = (task >> 3) & 63, b = task >> 9; const size_t rbase = (size_t)(b * TT + blk * 256);
        f32x4 qg0 = *(const f32x4*)(P.q_norm + l16 * 8), qg1 = *(const f32x4*)(P.q_norm + l16 * 8 + 4), kg0 = *(const f32x4*)(P.k_norm + l16 * 8), kg1 = *(const f32x4*)(P.k_norm + l16 * 8 + 4);
        float cs[8];
#pragma unroll
        for (int i = 0; i < 8; ++i) cs[i] = 0.f;
        u32x4 rq[8], rk[8], rv[8];
#pragma unroll
        for (int ps = 0; ps < 8; ++ps) { const int r = ps * 32 + wave * 4 + (lane >> 4); const bf16_t* rp = proj + (rbase + r) * NPJ + h * 128 + l16 * 8;
            rq[ps] = *(const u32x4*)(rp + OFF_MQ); rk[ps] = *(const u32x4*)(rp + OFF_MK); rv[ps] = *(const u32x4*)(rp + OFF_MV); }
#pragma unroll
        for (int ps = 0; ps < 8; ++ps) { const int r = ps * 32 + wave * 4 + (lane >> 4); bf16_t* rp = proj + (rbase + r) * NPJ + h * 128 + l16 * 8;
#pragma unroll
            for (int x = 0; x < 2; ++x) { bf16_t* ptr = rp + (x == 0 ? OFF_MQ : OFF_MK); const u32x4 raw = x == 0 ? rq[ps] : rk[ps]; float v[8];
                v[0] = bflo(raw.x); v[1] = bfhi(raw.x); v[2] = bflo(raw.y); v[3] = bfhi(raw.y); v[4] = bflo(raw.z); v[5] = bfhi(raw.z); v[6] = bflo(raw.w); v[7] = bfhi(raw.w);
                float ss = 0.f;
#pragma unroll
                for (int i = 0; i < 8; ++i) ss += v[i] * v[i];
                ss = row16_sum(ss);
                const float rs = rsqrtf(ss * (1.f / 128.f) + 1e-6f); const f32x4 g0 = x == 0 ? qg0 : kg0, g1 = x == 0 ? qg1 : kg1;
#pragma unroll
                for (int i = 0; i < 4; ++i) { v[i] *= rs * g0[i]; v[4 + i] *= rs * g1[i]; }
                if (x == 1) {
#pragma unroll
                    for (int i = 0; i < 8; ++i) cs[i] += v[i]; }
                u32x4 w; w.x = pk2(v[0], v[1]); w.y = pk2(v[2], v[3]); w.z = pk2(v[4], v[5]); w.w = pk2(v[6], v[7]); *(u32x4*)ptr = w; }
            *(LAS u32x4*)(VS + r * 136 + l16 * 8) = rv[ps]; }
#pragma unroll
        for (int i = 0; i < 8; ++i) { cs[i] += __shfl_xor(cs[i], 16); cs[i] += __shfl_xor(cs[i], 32); }
        if (lane < 16) {
#pragma unroll
            for (int i = 0; i < 8; ++i) CS[wave * 128 + lane * 8 + i] = cs[i]; }
        __syncthreads();
        if (tid < 128) { float s = 0.f;
#pragma unroll
            for (int w = 0; w < 8; ++w) s += CS[w * 128 + tid];
            kmean[((size_t)(b * 8 + h) * 64 + blk) * 128 + tid] = s * (1.f / 256.f); }
#pragma unroll 2
        for (int i8 = 0; i8 < 8; ++i8) { const int pid = tid + i8 * 512, e = pid >> 5, ks = pid & 31; unsigned short f[8];
#pragma unroll
            for (int i = 0; i < 8; ++i) f[i] = VS[(ks * 8 + i) * 136 + e];
            u32x4 w; w.x = f[0] | ((unsigned)f[1] << 16); w.y = f[2] | ((unsigned)f[3] << 16); w.z = f[4] | ((unsigned)f[5] << 16); w.w = f[6] | ((unsigned)f[7] << 16);
            *(u32x4*)(proj + (rbase + 2 * e + (ks >> 4)) * NPJ + OFF_MV + h * 128 + (ks & 15) * 8) = w; }
        __syncthreads();
    }
}

DI void phase_moba_select(const Params& P, LAS unsigned char* lds) {
    const int tid = opq_tid(), qi = tid >> 1, half = tid & 1;
    const bf16_t* proj = (const bf16_t*)(P.ws + WS_R1); const float* kmean = (const float*)(P.ws + WS_KMEAN);
    int* cnt = (int*)(P.ws + WS_CNT); int* list = (int*)(P.ws + WS_LIST); f32x2* ML = (f32x2*)(P.ws + WS_ML);
    LAS float* KM = (LAS float*)lds; LAS int* hist = (LAS int*)(lds + 32768); LAS int* hbase = (LAS int*)(lds + 32768 + 256);
    for (int task = blockIdx.x; task < 1024; task += gridDim.x) {
        const int blk = task & 63, h = (task >> 6) & 7, b = task >> 9; const int bh = b * 8 + h; const int t = blk * 256 + qi; const size_t rid = (size_t)bh * TT + t;
        for (int i = tid; i < blk * 128; i += NTHREADS) KM[i] = kmean[(size_t)bh * 64 * 128 + i];
        if (tid < 64) hist[tid] = 0;
        float q[64];
        { const bf16_t* qp = proj + (size_t)(b * TT + t) * NPJ + OFF_MQ + h * 128 + half * 64;
#pragma unroll
          for (int i = 0; i < 8; ++i) { const u32x4 raw = *(const u32x4*)(qp + 8 * i); q[8 * i] = bflo(raw.x); q[8 * i + 1] = bfhi(raw.x); q[8 * i + 2] = bflo(raw.y); q[8 * i + 3] = bfhi(raw.y);
              q[8 * i + 4] = bflo(raw.z); q[8 * i + 5] = bfhi(raw.z); q[8 * i + 6] = bflo(raw.w); q[8 * i + 7] = bfhi(raw.w); } }
        __syncthreads();
        float v0 = -INFINITY, v1 = -INFINITY, v2 = -INFINITY; int i0 = -1, i1 = -1, i2 = -1;
        for (int n = 0; n < blk; ++n) { const LAS float* km = KM + n * 128 + half * 64; float d0 = 0.f, d1 = 0.f, d2 = 0.f, d3 = 0.f;
#pragma unroll
            for (int i = 0; i < 16; ++i) { const f32x4 kv = *(const LAS f32x4*)(km + 4 * i); d0 += q[4 * i] * kv[0]; d1 += q[4 * i + 1] * kv[1]; d2 += q[4 * i + 2] * kv[2]; d3 += q[4 * i + 3] * kv[3]; }
            float g = (d0 + d1) + (d2 + d3); g += __shfl_xor(g, 1);
            if (g > v0) { v2 = v1; i2 = i1; v1 = v0; i1 = i0; v0 = g; i0 = n; } else if (g > v1) { v2 = v1; i2 = i1; v1 = g; i1 = n; } else if (g > v2) { v2 = g; i2 = n; } }
        int rk0 = 0, rk1 = 0, rk2 = 0;
        if (half == 0) { if (i0 >= 0) rk0 = __hip_atomic_fetch_add(&hist[i0], 1, __ATOMIC_RELAXED, __HIP_MEMORY_SCOPE_WORKGROUP); if (i1 >= 0) rk1 = __hip_atomic_fetch_add(&hist[i1], 1, __ATOMIC_RELAXED, __HIP_MEMORY_SCOPE_WORKGROUP); if (i2 >= 0) rk2 = __hip_atomic_fetch_add(&hist[i2], 1, __ATOMIC_RELAXED, __HIP_MEMORY_SCOPE_WORKGROUP); }
        __syncthreads();
        if (tid < 64) { const int c = hist[tid]; hbase[tid] = c > 0 ? atomicAdd(&cnt[bh * 64 + tid], c) : 0; }
        __syncthreads();
        if (half == 0) {
            const f32x2 dead = {-INFINITY, 0.f};
            if (i0 >= 0) list[(size_t)bh * LISTN + i0 * 16384 - 128 * i0 * (i0 + 1) + hbase[i0] + rk0] = t; else ML[0 * 262144 + rid] = dead;
            if (i1 >= 0) list[(size_t)bh * LISTN + i1 * 16384 - 128 * i1 * (i1 + 1) + hbase[i1] + rk1] = t | (1 << 14); else ML[1 * 262144 + rid] = dead;
            if (i2 >= 0) list[(size_t)bh * LISTN + i2 * 16384 - 128 * i2 * (i2 + 1) + hbase[i2] + rk2] = t | (2 << 14); else ML[2 * 262144 + rid] = dead;
        }
        __syncthreads();
    }
}

constexpr int G2_W = 0, G2_Q = 18432, G2_QK = 36864, G2_KD = 47104, G2_BUF = 67584, G2_RED = 135168;
DI void phase_gdn_scan(const Params& P, LAS unsigned char* lds, int bh) {
    const int tid = opq_tid(), lane = tid & 63, w = tid >> 6, fr = lane & 15, fq = lane >> 4, b = bh >> 3, h = bh & 7;
    const bf16_t* proj = (const bf16_t*)(P.ws + WS_R1); const bf16_t* W2 = (const bf16_t*)(P.ws + WS_W2); const bf16_t* QKB = (const bf16_t*)(P.ws + WS_QKB);
    const float* GL = (const float*)(P.ws + WS_GL); bf16_t* mix = (bf16_t*)(P.ws + WS_R2);
    float* SSQ = (float*)(P.ws + WS_SSQ);
    const int e = 16 * w + fr; const float gnw = P.gdn_norm[e];
    f32x4 S[8];
#pragma unroll
    for (int i = 0; i < 8; ++i) S[i] = (f32x4){0.f, 0.f, 0.f, 0.f};
    const int wrow0 = tid >> 4, wseg = tid & 15;
    const int qrow = tid >> 3, qseg = tid & 7;
    struct Stage { u32x4 sw[2], sq[2], sqk, skd[2]; };
    u32x2 un[4];
    Stage stA, stB;
#define G2_LOAD(X, nn) do { const int t0_ = b * TT + (nn) * 64; const int ci_ = ((b * 256 + (nn)) << 3) + h; \
        _Pragma("unroll") for (int i_ = 0; i_ < 2; ++i_) { X.sw[i_] = *(const u32x4*)(W2 + (size_t)(t0_ + wrow0 + 32 * i_) * 1024 + h * 128 + wseg * 8); \
            X.sq[i_] = *(const u32x4*)(proj + (size_t)(t0_ + wrow0 + 32 * i_) * NPJ + OFF_GQ + h * 128 + wseg * 8); \
            const int d_ = qrow + 64 * i_; X.skd[i_] = *(const u32x4*)(proj + (size_t)(t0_ + (d_ >> 1)) * NPJ + OFF_GK + h * 128 + (d_ & 1) * 64 + qseg * 8); } \
        X.sqk = *(const u32x4*)(QKB + (size_t)ci_ * 4096 + qrow * 64 + qseg * 8); } while (0)
#define UN_LOAD(nn) do { const int t0_ = b * TT + (nn) * 64; _Pragma("unroll") for (int mt_ = 0; mt_ < 4; ++mt_) un[mt_] = *(const u32x2*)(proj + (size_t)(t0_ + (e >> 1)) * NPJ + OFF_GV + h * 128 + (e & 1) * 64 + 16 * mt_ + 4 * fq); } while (0)
#define G2_ST2(base_, rowoff_, sg_, v_) do { const int g_ = ((sg_) >> 2) * 64, d_ = ((sg_) & 3) * 8; \
        *(LAS u32x2*)(B_ + (base_) + (rowoff_) + g_ + perm4(d_) * 2) = (u32x2){(v_).x, (v_).y}; *(LAS u32x2*)(B_ + (base_) + (rowoff_) + g_ + perm4(d_ + 4) * 2) = (u32x2){(v_).z, (v_).w}; } while (0)
#define G2_STORE(X, bufi) do { LAS unsigned char* B_ = lds + (bufi) * G2_BUF; \
        _Pragma("unroll") for (int i_ = 0; i_ < 2; ++i_) { G2_ST2(G2_W, (wrow0 + 32 * i_) * 288, wseg, X.sw[i_]); G2_ST2(G2_Q, (wrow0 + 32 * i_) * 288, wseg, X.sq[i_]); \
            G2_ST2(G2_KD, (qrow + 64 * i_) * 160, qseg, X.skd[i_]); } \
        G2_ST2(G2_QK, qrow * 160, qseg, X.sqk); } while (0)
    G2_LOAD(stA, 0); G2_STORE(stA, 0); UN_LOAD(0);
    float egl_n = GL[bh * 256];
    u32x2 uc[4];
#pragma unroll
    for (int i = 0; i < 4; ++i) uc[i] = un[i];
    G2_LOAD(stA, 1);
    __syncthreads();
    for (int n2 = 0; n2 < 256; n2 += 2) {
#pragma unroll
      for (int hf2 = 0; hf2 < 2; ++hf2) {
        const int n = n2 + hf2; Stage& LDs = hf2 ? stA : stB; Stage& STs = hf2 ? stB : stA;
        const int cur = hf2, t0 = b * TT + n * 64; LAS unsigned char* Bf = lds + cur * G2_BUF;
        { const int n2c = n + 2 < 256 ? n + 2 : 255, n1c = n + 1 < 256 ? n + 1 : 255; G2_LOAD(LDs, n2c); UN_LOAD(n1c); }
        const float egl = egl_n; egl_n = GL[bh * 256 + (n + 1 < 256 ? n + 1 : 255)];
        f32x4 Pm[4], Om[4];
#pragma unroll
        for (int mt = 0; mt < 4; ++mt) { Pm[mt] = (f32x4){0.f, 0.f, 0.f, 0.f}; Om[mt] = (f32x4){0.f, 0.f, 0.f, 0.f}; }
#define SBAR __builtin_amdgcn_sched_barrier(0)
#define LD_K4(dst, base_, ks_) do { const int o0_ = fr * 288 + (32 * (ks_) + 8 * fq) * 2; \
        dst[0] = *(const LAS bf16x8*)(Bf + base_ + o0_); dst[1] = *(const LAS bf16x8*)(Bf + base_ + o0_ + 4608); \
        dst[2] = *(const LAS bf16x8*)(Bf + base_ + o0_ + 9216); dst[3] = *(const LAS bf16x8*)(Bf + base_ + o0_ + 13824); } while (0)
#define MM_K4(src, sb_, A_) do { A_[0] = mfma16(src[0], sb_, A_[0]); A_[1] = mfma16(src[1], sb_, A_[1]); A_[2] = mfma16(src[2], sb_, A_[2]); A_[3] = mfma16(src[3], sb_, A_[3]); } while (0)
#define LD_R4(dst, base_, r0_, k2_) do { const int o0_ = (16 * (r0_) + fr) * 160 + (32 * (k2_) + 8 * fq) * 2; \
        dst[0] = *(const LAS bf16x8*)(Bf + base_ + o0_); dst[1] = *(const LAS bf16x8*)(Bf + base_ + o0_ + 2560); \
        dst[2] = *(const LAS bf16x8*)(Bf + base_ + o0_ + 5120); dst[3] = *(const LAS bf16x8*)(Bf + base_ + o0_ + 7680); } while (0)
#define MM_R4(src, vb_, A0_, A1_, A2_, A3_) do { A0_ = mfma16(src[0], vb_, A0_); A1_ = mfma16(src[1], vb_, A1_); A2_ = mfma16(src[2], vb_, A2_); A3_ = mfma16(src[3], vb_, A3_); } while (0)
        bf16x8 fa[4], fb[4];
        LD_K4(fa, G2_W, 0);
        const bf16x8 sb0 = pack8(S[0], S[1]), sb1 = pack8(S[2], S[3]), sb2 = pack8(S[4], S[5]), sb3 = pack8(S[6], S[7]);
        LD_K4(fb, G2_W, 1); SBAR; MM_K4(fa, sb0, Pm); SBAR;
        LD_K4(fa, G2_W, 2); SBAR; MM_K4(fb, sb1, Pm); SBAR;
        LD_K4(fb, G2_W, 3); SBAR; MM_K4(fa, sb2, Pm); SBAR;
        LD_K4(fa, G2_Q, 0); SBAR; MM_K4(fb, sb3, Pm); SBAR;
        f32x4 vn[4];
#pragma unroll
        for (int mt = 0; mt < 4; ++mt) { vn[mt][0] = bflo(uc[mt].x) - Pm[mt][0]; vn[mt][1] = bfhi(uc[mt].x) - Pm[mt][1]; vn[mt][2] = bflo(uc[mt].y) - Pm[mt][2]; vn[mt][3] = bfhi(uc[mt].y) - Pm[mt][3]; }
        bf16x8 Vb[2];
#pragma unroll
        for (int k2 = 0; k2 < 2; ++k2) Vb[k2] = pack8(vn[2 * k2], vn[2 * k2 + 1]);
        LD_K4(fb, G2_Q, 1); SBAR; MM_K4(fa, sb0, Om); SBAR;
        LD_K4(fa, G2_Q, 2); SBAR; MM_K4(fb, sb1, Om); SBAR;
        LD_K4(fb, G2_Q, 3); SBAR; MM_K4(fa, sb2, Om); SBAR;
        LD_R4(fa, G2_QK, 0, 0); SBAR; MM_K4(fb, sb3, Om); SBAR;
#pragma unroll
        for (int dt = 0; dt < 8; ++dt) S[dt] = S[dt] * egl;
        SBAR;
        LD_R4(fb, G2_QK, 0, 1); SBAR; MM_R4(fa, Vb[0], Om[0], Om[1], Om[2], Om[3]); SBAR;
        LD_R4(fa, G2_KD, 0, 0); SBAR; MM_R4(fb, Vb[1], Om[0], Om[1], Om[2], Om[3]); SBAR;
        LD_R4(fb, G2_KD, 0, 1); SBAR; MM_R4(fa, Vb[0], S[0], S[1], S[2], S[3]); SBAR;
        LD_R4(fa, G2_KD, 4, 0); SBAR; MM_R4(fb, Vb[1], S[0], S[1], S[2], S[3]); SBAR;
        LD_R4(fb, G2_KD, 4, 1); SBAR; MM_R4(fa, Vb[0], S[4], S[5], S[6], S[7]); SBAR;
        MM_R4(fb, Vb[1], S[4], S[5], S[6], S[7]); SBAR;
#undef LD_K4
#undef MM_K4
#undef LD_R4
#undef MM_R4
#undef SBAR
        { G2_STORE(STs, cur ^ 1);
#pragma unroll
            for (int i = 0; i < 4; ++i) uc[i] = un[i]; }
        { LAS bf16_t* OTW = (LAS bf16_t*)(lds + G2_RED + w * 2048);
#pragma unroll
          for (int mt = 0; mt < 4; ++mt)
#pragma unroll
            for (int j = 0; j < 4; ++j) OTW[(16 * mt + 4 * fq + j) * 16 + fr] = f2bf(Om[mt][j]);
#pragma unroll
          for (int i = 0; i < 2; ++i) { const int row = (lane >> 1) + 32 * i, hv = lane & 1;
              bf16_t* mp_ = mix + (size_t)(t0 + row) * DM + h * 128 + 16 * w + 8 * hv; const u32x4 ov_ = *(const LAS u32x4*)(OTW + row * 16 + hv * 8);
              asm volatile("global_store_dwordx4 %0, %1, off" :: "v"(mp_), "v"(ov_) : "memory"); } }
        __syncthreads();
      }
    }
#undef G2_LOAD
#undef UN_LOAD
#undef G2_STORE
#undef G2_ST2
    asm volatile("s_waitcnt vmcnt(0)" ::: "memory");
    __syncthreads();
}

constexpr int AT_KS = 0, AT_VT = 73728, AT_PF = 143360, AT_MISC = 147712;
DI void phase_moba_attn(const Params& P, LAS unsigned char* lds) {
    const int tid = opq_tid(), lane = tid & 63, w = tid >> 6, fr = lane & 15, fq = lane >> 4;
    const bf16_t* proj = (const bf16_t*)(P.ws + WS_R1); const int* cnt = (const int*)(P.ws + WS_CNT); const int* list = (const int*)(P.ws + WS_LIST);
    f32x2* ML = (f32x2*)(P.ws + WS_ML); bf16_t* opart = (bf16_t*)P.out; unsigned* workctr = (unsigned*)(P.ws + WS_CTL);
    LAS bf16_t* KS = (LAS bf16_t*)(lds + AT_KS); LAS bf16_t* VT = (LAS bf16_t*)(lds + AT_VT); LAS int* PF = (LAS int*)(lds + AT_PF); LAS int* MISC = (LAS int*)(lds + AT_MISC);
    { const int c0 = cnt[2 * tid], c1 = cnt[2 * tid + 1]; const int a = (c0 + 511) >> 9, bsum = a + ((c1 + 511) >> 9); int inc = bsum;
#pragma unroll
      for (int o = 1; o < 64; o <<= 1) { const int v = __shfl_up(inc, o); if (lane >= o) inc += v; }
      if (lane == 63) MISC[8 + w] = inc;
      __syncthreads();
      int wb = 0;
#pragma unroll
      for (int i = 0; i < 8; ++i) wb += (i < w) ? MISC[8 + i] : 0;
      const int ex = wb + inc - bsum; PF[2 * tid] = ex; PF[2 * tid + 1] = ex + a; if (tid == 511) PF[1024] = ex + bsum;
      __syncthreads(); }
    const int totalG = PF[1024];
    const float sc2 = 0.08838834764831845f * 1.4426950408889634f;
    const int tid_at = tid;
    for (;;) {
        int tid = tid_at; asm volatile("" : "+v"(tid)); const int lane = tid & 63, w = __builtin_amdgcn_readfirstlane(tid >> 6), fr = lane & 15, fq = lane >> 4;
        if (tid == 0) MISC[0] = (int)atomicAdd(workctr, 1u);
        __syncthreads();
        const int wid = MISC[0];
        __syncthreads();
        if (wid >= totalG + 1024) break;
        int bh, j, causal, qstart, qcount;
        if (wid < totalG) { int lo = 0, hi = 1024; while (hi - lo > 1) { const int mid = (lo + hi) >> 1; if (PF[mid] <= wid) lo = mid; else hi = mid; }
            bh = lo >> 6; j = lo & 63; causal = 0; qstart = (wid - PF[lo]) * 512; const int c = cnt[lo]; qcount = c - qstart; if (qcount > 512) qcount = 512; }
        else { const int o = wid - totalG; bh = o >> 6; j = o & 63; causal = 1; qstart = 0; qcount = 256; }
        const int b = bh >> 3, h = bh & 7; const size_t kbase = (size_t)(b * TT + j * 256);
        { u32x4 kr[8], vr[8];
#pragma unroll
          for (int i8 = 0; i8 < 8; ++i8) { const int pid = tid + i8 * 512; kr[i8] = *(const u32x4*)(proj + (kbase + (pid >> 4)) * NPJ + OFF_MK + h * 128 + (pid & 15) * 8);
              const int e = pid >> 5, ks = pid & 31; vr[i8] = *(const u32x4*)(proj + (kbase + 2 * e + (ks >> 4)) * NPJ + OFF_MV + h * 128 + (ks & 15) * 8); }
#pragma unroll
          for (int i8 = 0; i8 < 8; ++i8) { const int pid = tid + i8 * 512; *(LAS u32x4*)(KS + (pid >> 4) * 144 + (pid & 15) * 8) = kr[i8];
              const int e = pid >> 5, ks = pid & 31; const int g_ = (ks >> 2) * 32, d_ = (ks & 3) * 8;
              *(LAS u32x2*)(VT + e * 272 + g_ + perm4(d_)) = (u32x2){vr[i8].x, vr[i8].y}; *(LAS u32x2*)(VT + e * 272 + g_ + perm4(d_ + 4)) = (u32x2){vr[i8].z, vr[i8].w}; } }
        const int lbase = bh * LISTN + j * 16384 - 128 * j * (j + 1) + qstart;
        const int ntile = (qcount + 127) >> 7;
        int en0, en1, en2, en3;
        { const int q0 = 16 * w + fr, lim = qcount - 1;
          if (causal) { en0 = (j * 256 + q0) | (3 << 14); en1 = (j * 256 + q0 + 128) | (3 << 14); en2 = en1; en3 = en1; }
          else { en0 = list[lbase + (q0 < lim ? q0 : lim)]; en1 = list[lbase + (q0 + 128 < lim ? q0 + 128 : lim)]; en2 = list[lbase + (q0 + 256 < lim ? q0 + 256 : lim)]; en3 = list[lbase + (q0 + 384 < lim ? q0 + 384 : lim)]; } }
        bf16x8 Bq[4], Bn[4];
        { const bf16_t* qp = proj + (size_t)(b * TT + (en0 & 16383)) * NPJ + OFF_MQ + h * 128 + 8 * fq;
#pragma unroll
          for (int ks = 0; ks < 4; ++ks) Bq[ks] = *(const bf16x8*)(qp + 32 * ks); }
        __syncthreads();
        for (int tile = 0; tile < ntile; ++tile) {
            const int en = tile == 0 ? en0 : (tile == 1 ? en1 : (tile == 2 ? en2 : en3));
            { const int enx = tile == 0 ? en1 : (tile == 1 ? en2 : en3); const bf16_t* qp = proj + (size_t)(b * TT + (enx & 16383)) * NPJ + OFF_MQ + h * 128 + 8 * fq;
#pragma unroll
              for (int ks = 0; ks < 4; ++ks) Bn[ks] = *(const bf16x8*)(qp + 32 * ks); }
            const int qi = tile * 128 + 16 * w + fr; const bool valid = qi < qcount; const int t = en & 16383, slot = en >> 14;
            if (tile * 128 + 16 * w < qcount) {
            const int nkt = causal ? (8 * tile + w + 1) : 16;
            f32x4 st[16]; float mx = -INFINITY;
#pragma unroll
            for (int kp = 0; kp < 8; ++kp) { f32x4 a0 = {0.f, 0.f, 0.f, 0.f}, a1 = {0.f, 0.f, 0.f, 0.f};
                if (2 * kp < nkt) { bf16x8 kf[8];
#pragma unroll
                    for (int ks = 0; ks < 4; ++ks) { kf[ks] = *(const LAS bf16x8*)(KS + (32 * kp + fr) * 144 + 32 * ks + 8 * fq); kf[4 + ks] = *(const LAS bf16x8*)(KS + (32 * kp + 16 + fr) * 144 + 32 * ks + 8 * fq); }
#pragma unroll
                    for (int ks = 0; ks < 4; ++ks) { a0 = mfma16(kf[ks], Bq[ks], a0); a1 = mfma16(kf[4 + ks], Bq[ks], a1); }
#pragma unroll
                    for (int jj = 0; jj < 4; ++jj) { float s0 = a0[jj] * sc2, s1 = a1[jj] * sc2;
                        if (causal && (32 * kp + 4 * fq + jj) > qi) s0 = -INFINITY; if ((causal && (32 * kp + 16 + 4 * fq + jj) > qi) || 2 * kp + 1 >= nkt) s1 = -INFINITY;
                        a0[jj] = s0; a1[jj] = s1; mx = fmaxf(mx, fmaxf(s0, s1)); }
                } else { a0 = (f32x4){-INFINITY, -INFINITY, -INFINITY, -INFINITY}; a1 = a0; }
                st[2 * kp] = a0; st[2 * kp + 1] = a1; }
            mx = fmaxf(mx, __shfl_xor(mx, 16)); mx = fmaxf(mx, __shfl_xor(mx, 32));
            float ls = 0.f;
#pragma unroll
            for (int kt = 0; kt < 16; ++kt)
#pragma unroll
                for (int jj = 0; jj < 4; ++jj) { const float pv = exp2f(st[kt][jj] - mx); st[kt][jj] = pv; ls += pv; }
            ls += __shfl_xor(ls, 16); ls += __shfl_xor(ls, 32);
            f32x4 ot[8];
#pragma unroll
            for (int et = 0; et < 8; ++et) ot[et] = (f32x4){0.f, 0.f, 0.f, 0.f};
#pragma unroll
            for (int k2 = 0; k2 < 8; ++k2) { if (2 * k2 < nkt) { const bf16x8 pb = pack8(st[2 * k2], st[2 * k2 + 1]);
#pragma unroll
                    for (int eh = 0; eh < 2; ++eh) { bf16x8 vf[4];
#pragma unroll
                        for (int et = 0; et < 4; ++et) vf[et] = *(const LAS bf16x8*)(VT + (16 * (4 * eh + et) + fr) * 272 + 32 * k2 + 8 * fq);
#pragma unroll
                        for (int et = 0; et < 4; ++et) ot[4 * eh + et] = mfma16(vf[et], pb, ot[4 * eh + et]); } } }
            if (valid) { const float il = 1.f / ls; const size_t rid = (size_t)bh * TT + t; bf16_t* op = opart + ((size_t)slot * 262144 + rid) * 128 + 4 * fq;
#pragma unroll
                for (int et = 0; et < 8; ++et) { u32x2 wv; wv.x = pk2(ot[et][0] * il, ot[et][1] * il); wv.y = pk2(ot[et][2] * il, ot[et][3] * il); *(u32x2*)(op + 16 * et) = wv; }
                if (fq == 0) ML[(size_t)slot * 262144 + rid] = (f32x2){mx, ls}; }
            }
#pragma unroll
            for (int ks = 0; ks < 4; ++ks) Bq[ks] = Bn[ks];
        }
        __syncthreads();
    }
}

DI void phase_moba_combine(const Params& P) {
    const bf16_t* opart = (const bf16_t*)P.out; const f32x2* ML = (const f32x2*)(P.ws + WS_ML); bf16_t* mix = (bf16_t*)(P.ws + WS_R2);
    const int gtid = blockIdx.x * NTHREADS + opq_tid(), gsz = gridDim.x * NTHREADS;
    { const bf16_t* proj = (const bf16_t*)(P.ws + WS_R1);
      for (int i0 = gtid; i0 < MT * 128; i0 += 4 * gsz) { u32x4 mv[4], zv[4];
#pragma unroll
          for (int k = 0; k < 4; ++k) { const int i = i0 + k * gsz < MT * 128 ? i0 + k * gsz : i0; const int row = i >> 7, sg = i & 127; mv[k] = *(const u32x4*)(mix + (size_t)row * DM + sg * 8); zv[k] = *(const u32x4*)(proj + (size_t)row * NPJ + OFF_GZ + sg * 8); }
          const int sg0 = i0 & 127; const f32x4 g0 = *(const f32x4*)(P.gdn_norm + (sg0 & 15) * 8), g1 = *(const f32x4*)(P.gdn_norm + (sg0 & 15) * 8 + 4);
#pragma unroll
          for (int k = 0; k < 4; ++k) { const int i = i0 + k * gsz; const int row = i >> 7, sg = i & 127;
              float o[8]; o[0] = bflo(mv[k].x); o[1] = bfhi(mv[k].x); o[2] = bflo(mv[k].y); o[3] = bfhi(mv[k].y); o[4] = bflo(mv[k].z); o[5] = bfhi(mv[k].z); o[6] = bflo(mv[k].w); o[7] = bfhi(mv[k].w);
              float ssl = 0.f;
#pragma unroll
              for (int q = 0; q < 8; ++q) ssl += o[q] * o[q];
              const float rs = rsqrtf(row16_sum(ssl) * (1.f / 128.f) + 1e-6f); const u32x4 z = zv[k];
              u32x4 wv; wv.x = pk2(o[0] * rs * g0[0] * silu_f(bflo(z.x)), o[1] * rs * g0[1] * silu_f(bfhi(z.x))); wv.y = pk2(o[2] * rs * g0[2] * silu_f(bflo(z.y)), o[3] * rs * g0[3] * silu_f(bfhi(z.y)));
              wv.z = pk2(o[4] * rs * g1[0] * silu_f(bflo(z.z)), o[5] * rs * g1[1] * silu_f(bfhi(z.z))); wv.w = pk2(o[6] * rs * g1[2] * silu_f(bflo(z.w)), o[7] * rs * g1[3] * silu_f(bfhi(z.w)));
              if (i < MT * 128) *(u32x4*)(mix + (size_t)row * DM + sg * 8) = wv; } } }
    for (int i0 = gtid; i0 < 262144 * 16; i0 += 2 * gsz) {
        f32x2 ml[2][4]; u32x4 raw[2][4];
#pragma unroll
        for (int k = 0; k < 2; ++k) { const int i = i0 + k * gsz < 262144 * 16 ? i0 + k * gsz : i0; const int rid = i >> 4, sg = i & 15;
#pragma unroll
            for (int s = 0; s < 4; ++s) { ml[k][s] = ML[(size_t)s * 262144 + rid]; raw[k][s] = *(const u32x4*)(opart + ((size_t)s * 262144 + rid) * 128 + sg * 8); } }
#pragma unroll
        for (int k = 0; k < 2; ++k) { const int i = i0 + k * gsz; const int rid = i >> 4, sg = i & 15; const int bh = rid >> 14, t = rid & 16383, b = bh >> 3, h = bh & 7;
            float M = -INFINITY;
#pragma unroll
            for (int s = 0; s < 4; ++s) M = fmaxf(M, ml[k][s].x);
            float wgt[4], Lt = 0.f;
#pragma unroll
            for (int s = 0; s < 4; ++s) { wgt[s] = ml[k][s].y > 0.f ? ml[k][s].y * exp2f(ml[k][s].x - M) : 0.f; Lt += wgt[s]; }
            const float iL = 1.f / Lt; float o[8];
#pragma unroll
            for (int q = 0; q < 8; ++q) o[q] = 0.f;
#pragma unroll
            for (int s = 0; s < 4; ++s) { const float ww = wgt[s] * iL; const u32x4 r = raw[k][s];
                if (wgt[s] > 0.f) { o[0] += ww * bflo(r.x); o[1] += ww * bfhi(r.x); o[2] += ww * bflo(r.y); o[3] += ww * bfhi(r.y); o[4] += ww * bflo(r.z); o[5] += ww * bfhi(r.z); o[6] += ww * bflo(r.w); o[7] += ww * bfhi(r.w); } }
            u32x4 wv; wv.x = pk2(o[0], o[1]); wv.y = pk2(o[2], o[3]); wv.z = pk2(o[4], o[5]); wv.w = pk2(o[6], o[7]);
            if (i < 262144 * 16) *(u32x4*)(mix + (size_t)(b * TT + t) * DM + 1024 + h * 128 + sg * 8) = wv; } }
}

__global__ void __launch_bounds__(NTHREADS) hybrid_fwd(Params P) {
    extern __shared__ __attribute__((aligned(16))) unsigned char smem[];
    LAS unsigned char* lds = (LAS unsigned char*)smem;
    cg::grid_group grid = cg::this_grid();
    unsigned char* ws = P.ws; const int G = gridDim.x, bx = blockIdx.x;
    bf16_t* R0 = (bf16_t*)(ws + WS_R0); bf16_t* R1 = (bf16_t*)(ws + WS_R1); bf16_t* R2 = (bf16_t*)(ws + WS_R2);
    float* ss1 = (float*)(ws + WS_SS1); float* ss2 = (float*)(ws + WS_SS2);

    phase_prep(P, lds);
    grid.sync();
    { pg8::Gemm g{R0, (const bf16_t*)(ws + WS_WIN), MT, NPJ, DM}; pg8::StaticOrder S; S.init(MT, NPJ, G, bx); EpiProj E{R1, (bf16_t*)(ws + WS_HALO)}; pg8::gemm_phase<decltype(E), pg8::StaticOrder, true, true>(lds, g, S, E); }
    phase_ba(P);
    grid.sync();
    phase_gdn_prep(P, lds);
    phase_moba_prep(P, lds);
    grid.sync();
    phase_moba_select(P, lds);
    grid.sync();
    if (bx < 16) phase_gdn_scan(P, lds, bx);
    phase_moba_attn(P, lds);
    if (bx >= 16) phase_wconv_late(P, lds, bx - 16, G - 16);
    grid.sync();
    phase_moba_combine(P);
    grid.sync();
    { pg8::Gemm g{R2, (const bf16_t*)(ws + WS_WO), MT, DM, DM}; pg8::StaticOrder S; S.init(MT, DM, G, bx); EpiResid E{P.x, P.out, R0, ss1}; pg8::gemm_phase<decltype(E), pg8::StaticOrder, true, false>(lds, g, S, E); }
    grid.sync();
    { pg8::Gemm g{R0, (const bf16_t*)(ws + WS_WGU), MT, 2 * FF, DM}; pg8::StaticOrder S; S.init(MT, 2 * FF, G, bx); EpiAct E{R1, ss1}; pg8::gemm_phase<decltype(E), pg8::StaticOrder, true, true>(lds, g, S, E); }
    grid.sync();
    { pg8::Gemm g{(const bf16_t*)(ws + WS_PB), (const bf16_t*)(ws + WS_WPP), MT, DM, 256}; pg8::StaticOrder S; S.init(MT, DM, G, bx); EpiPlainBf16 E{R0, DM}; pg8::gemm_phase<decltype(E), pg8::StaticOrder, true, false>(lds, g, S, E); }
    { pg8::Gemm g{R1, (const bf16_t*)(ws + WS_WDN), MT, DM, FF}; pg8::StaticOrder S; S.init(MT, DM, G, bx); EpiResid E{P.out, P.out, R2, ss2}; pg8::gemm_phase<decltype(E), pg8::StaticOrder, true, false>(lds, g, S, E); }
    grid.sync();
    { pg8::Gemm g{R2, (const bf16_t*)(ws + WS_WPG), MT, DM, DM}; pg8::StaticOrder S; S.init(MT, DM, G, bx); EpiOut E{P.out, R0, ss2}; pg8::gemm_phase<decltype(E), pg8::StaticOrder, true, false>(lds, g, S, E); }
}

extern "C" void kernel_launch(void* const* d_in, const int* in_sizes, int n_in, void* d_out, int out_size, void* d_ws, size_t ws_size, hipStream_t stream) {
    static int grid_blocks = 0;
    if (!grid_blocks) {
        int dev = 0, cus = 0, per_cu = 0;
        hipGetDevice(&dev);
        hipDeviceGetAttribute(&cus, hipDeviceAttributeMultiprocessorCount, dev);
        hipFuncSetAttribute((const void*)hybrid_fwd, hipFuncAttributeMaxDynamicSharedMemorySize, LDS_BYTES);
        hipOccupancyMaxActiveBlocksPerMultiprocessor(&per_cu, (const void*)hybrid_fwd, NTHREADS, LDS_BYTES);
        if (per_cu < 1) per_cu = 1;
        grid_blocks = cus * per_cu;
        if (ws_size < WS_END) fprintf(stderr, "kernel_launch: workspace too small: %zu < %zu\n", ws_size, (size_t)WS_END);
    }
    Params p{};
    p.x = (const float*)d_in[0]; p.p = (const float*)d_in[1]; p.attn_norm = (const float*)d_in[2]; p.w_in = (const float*)d_in[3]; p.conv_w = (const float*)d_in[4];
    p.A_log = (const float*)d_in[5]; p.dt_bias = (const float*)d_in[6]; p.gdn_norm = (const float*)d_in[7]; p.q_norm = (const float*)d_in[8]; p.k_norm = (const float*)d_in[9];
    p.w_o = (const float*)d_in[10]; p.ffn_norm = (const float*)d_in[11]; p.w_gate = (const float*)d_in[12]; p.w_up = (const float*)d_in[13]; p.w_down = (const float*)d_in[14];
    p.ple_norm = (const float*)d_in[15]; p.w_pg = (const float*)d_in[16]; p.w_pp = (const float*)d_in[17];
    p.out = (float*)d_out; p.ws = (unsigned char*)d_ws;
    void* args[] = {&p};
    hipError_t e = hipLaunchCooperativeKernel((const void*)hybrid_fwd, dim3(grid_blocks), dim3(NTHREADS), args, LDS_BYTES, stream);
    if (e != hipSuccess) fprintf(stderr, "cooperative launch failed: %s (grid %d)\n", hipGetErrorString(e), grid_blocks);
}
```

```cpp
#include <hip/hip_runtime.h>
#include <hip/hip_cooperative_groups.h>
#include <cstdio>
namespace cg = cooperative_groups;

#define LAS __attribute__((address_space(3)))
#define DI __device__ __forceinline__
typedef unsigned short bf16_t;
typedef short bf16x8 __attribute__((ext_vector_type(8)));
typedef float f32x4 __attribute__((ext_vector_type(4)));
typedef float f32x2 __attribute__((ext_vector_type(2)));
typedef unsigned u32x4 __attribute__((ext_vector_type(4)));
typedef unsigned u32x2 __attribute__((ext_vector_type(2)));
typedef __bf16 bfv2 __attribute__((ext_vector_type(2)));

constexpr int DM = 2048, TT = 16384, MT = 32768, NPJ = 7168, FF = 5632, INW = 7184;
constexpr int OFF_GQ = 0, OFF_GK = 1024, OFF_GV = 2048, OFF_GZ = 3072, OFF_MQ = 4096, OFF_MK = 5120, OFF_MV = 6144;
constexpr int LISTN = 516096;
constexpr int NTHREADS = 512;
constexpr int LDS_BYTES = 163840;

constexpr size_t WS_CTL   = 0;
constexpr size_t WS_CNT   = 4096;
constexpr size_t WS_SS1   = 8192;
constexpr size_t WS_SS2   = WS_SS1 + 131072;
constexpr size_t WS_GL    = WS_SS2 + 131072;
constexpr size_t WS_KMEAN = WS_GL + 16384;
constexpr size_t WS_WBA   = WS_KMEAN + 524288;
constexpr size_t WS_BA    = WS_WBA + 65536;
constexpr size_t WS_WIN   = WS_BA + 2097152;
constexpr size_t WS_WO    = WS_WIN + (size_t)7168 * 2048 * 2;
constexpr size_t WS_WGU   = WS_WO + (size_t)2048 * 2048 * 2;
constexpr size_t WS_WDN   = WS_WGU + (size_t)11264 * 2048 * 2;
constexpr size_t WS_WPG   = WS_WDN + (size_t)2048 * 5632 * 2;
constexpr size_t WS_WPP   = WS_WPG + (size_t)2048 * 2048 * 2;
constexpr size_t WS_PB    = WS_WPP + (size_t)2048 * 256 * 2;
constexpr size_t WS_R0    = WS_PB + (size_t)32768 * 256 * 2;
constexpr size_t WS_R1    = WS_R0 + (size_t)32768 * 2048 * 2;
constexpr size_t WS_R2    = WS_R1 + (size_t)32768 * 7168 * 2;
constexpr size_t WS_W2    = WS_R2 + (size_t)32768 * 2048 * 2;
constexpr size_t WS_QKB   = WS_W2 + (size_t)32768 * 1024 * 2;
constexpr size_t WS_HALO  = WS_QKB + (size_t)4096 * 4096 * 2;
constexpr size_t WS_LIST  = WS_HALO + (size_t)513 * 3 * 3072 * 2 + 256 - ((size_t)513 * 3 * 3072 * 2) % 256;
constexpr size_t WS_ML    = WS_LIST + (size_t)16 * LISTN * 4;
constexpr size_t WS_SSQ   = WS_ML + (size_t)4 * 262144 * 8;
constexpr size_t WS_END   = WS_SSQ + (size_t)32768 * 64 * 4;

struct Params {
    const float* x; const float* p; const float* attn_norm; const float* w_in; const float* conv_w; const float* A_log; const float* dt_bias;
    const float* gdn_norm; const float* q_norm; const float* k_norm; const float* w_o; const float* ffn_norm; const float* w_gate; const float* w_up;
    const float* w_down; const float* ple_norm; const float* w_pg; const float* w_pp;
    float* out; unsigned char* ws;
};

DI unsigned pk2(float a, float b) { f32x2 v = {a, b}; bfv2 r = __builtin_convertvector(v, bfv2); return __builtin_bit_cast(unsigned, r); }
DI bf16_t f2bf(float a) { return (bf16_t)(pk2(a, 0.f) & 0xffffu); }
DI float bflo(unsigned w) { return __uint_as_float(w << 16); }
DI float bfhi(unsigned w) { return __uint_as_float(w & 0xffff0000u); }
DI float bf2f(bf16_t v) { return __uint_as_float(((unsigned)v) << 16); }
DI bf16x8 pack8(const f32x4& a, const f32x4& b) { u32x4 w; w.x = pk2(a[0], a[1]); w.y = pk2(a[2], a[3]); w.z = pk2(b[0], b[1]); w.w = pk2(b[2], b[3]); return __builtin_bit_cast(bf16x8, w); }
DI bf16x8 cat8(u32x2 lo, u32x2 hi) { u32x4 w; w.x = lo.x; w.y = lo.y; w.z = hi.x; w.w = hi.y; return __builtin_bit_cast(bf16x8, w); }
DI f32x4 mfma16(bf16x8 a, bf16x8 b, f32x4 c) { return __builtin_amdgcn_mfma_f32_16x16x32_bf16(a, b, c, 0, 0, 0); }
DI int perm4(int d4) { return d4 < 16 ? 2 * d4 : 2 * (d4 - 16) + 4; }
DI float dpp_f(float v, int ctrl_sel) { int x = __float_as_int(v); int r;
    if (ctrl_sel == 0) r = __builtin_amdgcn_mov_dpp(x, 0xB1, 0xf, 0xf, true); else if (ctrl_sel == 1) r = __builtin_amdgcn_mov_dpp(x, 0x4E, 0xf, 0xf, true);
    else if (ctrl_sel == 2) r = __builtin_amdgcn_mov_dpp(x, 0x141, 0xf, 0xf, true); else r = __builtin_amdgcn_mov_dpp(x, 0x140, 0xf, 0xf, true);
    return __int_as_float(r); }
DI float row16_sum(float v) { v += dpp_f(v, 0); v += dpp_f(v, 1); v += dpp_f(v, 2); v += dpp_f(v, 3); return v; }
DI float silu_f(float v) { return v * __builtin_amdgcn_rcpf(1.f + __expf(-v)); }
DI float sigm_f(float v) { return __builtin_amdgcn_rcpf(1.f + __expf(-v)); }

DI int opq_tid() { int t = threadIdx.x; asm volatile("" : "+v"(t)); return t; }

namespace pg8 {
constexpr int BM = 256, BK = 64, HALF = 128, HTB = HALF * BK * 2, STAGE_BYTES = 8 * HTB, NXCD = 8, WGM = 8;
DI int lds_byte(int r, int c) { const int st = (r >> 4) * 2 + (c >> 5), rr = r & 15, cc = c & 31, ob = rr * 64 + cc * 2; return st * 1024 + (ob ^ (((ob >> 9) & 1) << 5)); }
DI void stage_rc(int b, int& R, int& C) { const int st = b / 1024, sb = b % 1024, swz = sb ^ (((sb >> 9) & 1) << 5); R = (st >> 1) * 16 + swz / 64; C = (st & 1) * 32 + (swz % 64) / 2; }
DI int perm32(int rho) { const int n = rho >> 4, i = rho & 15; return 8 * (i >> 2) + 4 * n + (i & 3); }
struct Unit { int pm, pn; };
struct Gemm { const bf16_t* A; const bf16_t* Bt; int M, N, K; };
struct StaticOrder {
    int nM, nN, nwg, G, c;
    DI void init(int M, int N, int G_, int c_) { nM = M / BM; nN = N / BM; nwg = nM * nN; G = G_; c = c_; }
    DI bool next(int i, Unit& u) const {
        const long L = (long)i * G + c; if (L >= nwg) return false;
        int wgid = (int)L; { const int q = nwg / NXCD, r = nwg % NXCD, xcd = wgid % NXCD, off = wgid / NXCD; wgid = (xcd < r ? xcd * (q + 1) : r * (q + 1) + (xcd - r) * q) + off; }
        const int nig = WGM * nN, gid = wgid / nig, fm = gid * WGM, gsz = (nM - fm) < WGM ? (nM - fm) : WGM;
        u.pm = fm + ((wgid % nig) % gsz); u.pn = (wgid % nig) / gsz; return true;
    }
    DI void a_ready(const Unit&) const {}
    DI void done(const Unit&) const {}
};

template <class Epi, class Sched, bool ALIGN_EPI = false, bool SP2 = false>
DI void gemm_phase(LAS unsigned char* lds, const Gemm g, const Sched& S, const Epi& E) {
    const int tid = opq_tid(), wid = __builtin_amdgcn_readfirstlane(tid >> 6), lane = tid & 63, wr = wid >> 2, wc = wid & 3, fr = lane & 15, fq = lane >> 4;
    const int K = g.K, nt = K / BK;
    unsigned voffA[2], voffB[2];
#pragma unroll
    for (int i = 0; i < 2; ++i) { int R, C; stage_rc(tid * 16 + i * 8192, R, C); const int Rb = Epi::PERM ? ((R & ~31) + perm32(R & 31)) : R;
        voffA[i] = (unsigned)(R * K + C) * 2u; voffB[i] = (unsigned)(Rb * K + C) * 2u; }
    const size_t kstep = (size_t)(BK * 2);
    const size_t hstep = (size_t)HALF * K * 2;
    const size_t tstep = 2 * hstep;
    const unsigned ldsw = (unsigned)wid * 1024u;
    const int aoff = lds_byte(wr * 64 + fr, fq * 8), boff = lds_byte(wc * 32 + fr, fq * 8);
#define PG8_SA(b, h) (((b) * 2 + (h)) * HTB)
#define PG8_SB(b, h) ((4 + (b) * 2 + (h)) * HTB)
#define PG8_STAGE(bufoff, gbase, voff) do { _Pragma("unroll") for (int _i = 0; _i < 2; ++_i) \
        __builtin_amdgcn_global_load_lds((const unsigned*)((const char*)(gbase) + (voff)[_i]), (LAS unsigned*)(lds + (bufoff) + ldsw + _i * 8192), 16, 0, 0); } while (0)
#define PG8_LDA(dst, b, h) do { _Pragma("unroll") for (int m = 0; m < 4; ++m) _Pragma("unroll") for (int k = 0; k < 2; ++k) dst[m][k] = *(const LAS bf16x8*)(lds + PG8_SA(b, h) + aoff + m * 2048 + k * 1024); } while (0)
#define PG8_LDB(dst, b, h) do { _Pragma("unroll") for (int n = 0; n < 2; ++n) _Pragma("unroll") for (int k = 0; k < 2; ++k) dst[n][k] = *(const LAS bf16x8*)(lds + PG8_SB(b, h) + boff + n * 2048 + k * 1024); } while (0)
#define PG8_MMA(ai, bj, At, Bt) do { __builtin_amdgcn_s_setprio(1); _Pragma("unroll") for (int m = 0; m < 4; ++m) _Pragma("unroll") for (int n = 0; n < 2; ++n) _Pragma("unroll") for (int k = 0; k < 2; ++k) \
        acc[ai][bj][m][n] = __builtin_amdgcn_mfma_f32_16x16x32_bf16(Bt[n][k], At[m][k], acc[ai][bj][m][n], 0, 0, 0); __builtin_amdgcn_s_setprio(0); } while (0)
#define PG8_WAIT_V(n) asm volatile("s_waitcnt vmcnt(" #n ")" ::: "memory")
#define PG8_WAIT_L(n) asm volatile("s_waitcnt lgkmcnt(" #n ")" ::: "memory")
#define PG8_BAR __builtin_amdgcn_s_barrier()
#define PG8_SCHED __builtin_amdgcn_sched_barrier(0)
    Unit cur, nxt; int ui = 0;
    if (!S.next(0, cur)) return;
    f32x4 acc[2][2][4][2];
#pragma unroll
    for (int a = 0; a < 2; ++a)
#pragma unroll
        for (int b = 0; b < 2; ++b)
#pragma unroll
            for (int m = 0; m < 4; ++m)
#pragma unroll
                for (int n = 0; n < 2; ++n) acc[a][b][m][n] = (f32x4){0.f, 0.f, 0.f, 0.f};
    bf16x8 At[4][2], B0[2][2], B1[2][2];
    const char* cA = (const char*)g.A + (size_t)cur.pm * tstep; const char* cB = (const char*)g.Bt + (size_t)cur.pn * tstep;
    S.a_ready(cur);
    if constexpr (SP2) {
        PG8_STAGE(PG8_SB(0, 0), cB, voffB); PG8_STAGE(PG8_SB(0, 1), cB + hstep, voffB); PG8_STAGE(PG8_SA(0, 0), cA, voffA); PG8_STAGE(PG8_SA(0, 1), cA + hstep, voffA);
        if (wr == 1) PG8_BAR;
        PG8_WAIT_V(2); PG8_BAR;
        PG8_STAGE(PG8_SB(1, 0), cB + kstep, voffB); PG8_STAGE(PG8_SA(1, 0), cA + kstep, voffA); PG8_STAGE(PG8_SB(1, 1), cB + hstep + kstep, voffB);
        PG8_WAIT_V(6); PG8_BAR;
    } else {
        PG8_STAGE(PG8_SB(0, 0), cB, voffB); PG8_STAGE(PG8_SA(0, 0), cA, voffA); PG8_STAGE(PG8_SB(0, 1), cB + hstep, voffB); PG8_STAGE(PG8_SA(0, 1), cA + hstep, voffA);
        if (wr == 1) PG8_BAR;
        PG8_WAIT_V(4); PG8_BAR;
        PG8_STAGE(PG8_SB(1, 0), cB + kstep, voffB); PG8_STAGE(PG8_SA(1, 0), cA + kstep, voffA); PG8_STAGE(PG8_SB(1, 1), cB + hstep + kstep, voffB);
        PG8_WAIT_V(6); PG8_BAR;
    }
    for (;;) {
        const bool has_next = S.next(ui + 1, nxt);
        const char* nA = has_next ? (const char*)g.A + (size_t)nxt.pm * tstep : cA; const char* nB = has_next ? (const char*)g.Bt + (size_t)nxt.pn * tstep : cB;
        for (int t = 0; t < nt; t += 2) {
            const bool last = (t == nt - 2);
            const char* a1 = cA + (size_t)(t + 1) * kstep;
            const char* a2 = last ? nA : cA + (size_t)(t + 2) * kstep; const char* b2 = last ? nB : cB + (size_t)(t + 2) * kstep;
            const char* a3 = a2 + kstep; const char* b3 = b2 + kstep;
            if (last && has_next) S.a_ready(nxt);
            if constexpr (SP2) {
            PG8_LDB(B0, 0, 0); PG8_LDB(B1, 0, 1); PG8_SCHED; PG8_LDA(At, 0, 0); PG8_STAGE(PG8_SA(1, 1), a1 + hstep, voffA);
            PG8_WAIT_V(8); PG8_WAIT_L(0); PG8_BAR; PG8_MMA(0, 0, At, B0); PG8_MMA(0, 1, At, B1); PG8_BAR; PG8_SCHED;
            PG8_LDA(At, 0, 1); PG8_STAGE(PG8_SB(0, 0), b2, voffB); PG8_STAGE(PG8_SB(0, 1), b2 + hstep, voffB); PG8_STAGE(PG8_SA(0, 0), a2, voffA);
            PG8_WAIT_V(8); PG8_WAIT_L(0); PG8_BAR; PG8_MMA(1, 0, At, B0); PG8_MMA(1, 1, At, B1); PG8_BAR; PG8_SCHED;
            PG8_LDB(B0, 1, 0); PG8_LDB(B1, 1, 1); PG8_SCHED; PG8_LDA(At, 1, 0); PG8_STAGE(PG8_SA(0, 1), a2 + hstep, voffA);
            PG8_WAIT_V(8); PG8_WAIT_L(0); PG8_BAR; PG8_MMA(0, 0, At, B0); PG8_MMA(0, 1, At, B1); PG8_BAR; PG8_SCHED;
            PG8_LDA(At, 1, 1); PG8_STAGE(PG8_SB(1, 0), b3, voffB); PG8_STAGE(PG8_SB(1, 1), b3 + hstep, voffB); PG8_STAGE(PG8_SA(1, 0), a3, voffA);
            PG8_WAIT_V(8); PG8_WAIT_L(0); PG8_BAR; PG8_MMA(1, 0, At, B0); PG8_MMA(1, 1, At, B1); PG8_BAR; PG8_SCHED;
            } else {
            PG8_LDB(B0, 0, 0); PG8_SCHED; PG8_LDA(At, 0, 0); PG8_STAGE(PG8_SA(1, 1), a1 + hstep, voffA);
            PG8_WAIT_L(8); PG8_BAR; PG8_WAIT_L(0); PG8_MMA(0, 0, At, B0); PG8_BAR; PG8_SCHED;
            PG8_LDB(B1, 0, 1); PG8_STAGE(PG8_SB(0, 0), b2, voffB);
            PG8_BAR; PG8_WAIT_L(0); PG8_MMA(0, 1, At, B1); PG8_BAR;
            PG8_LDA(At, 0, 1); PG8_STAGE(PG8_SA(0, 0), a2, voffA);
            PG8_BAR; PG8_WAIT_L(0); PG8_MMA(1, 0, At, B0); PG8_BAR; PG8_SCHED;
            PG8_STAGE(PG8_SB(0, 1), b2 + hstep, voffB);
            PG8_WAIT_V(6); PG8_BAR; PG8_MMA(1, 1, At, B1); PG8_BAR;
            PG8_LDB(B0, 1, 0); PG8_SCHED; PG8_LDA(At, 1, 0); PG8_STAGE(PG8_SA(0, 1), a2 + hstep, voffA);
            PG8_WAIT_L(8); PG8_BAR; PG8_WAIT_L(0); PG8_MMA(0, 0, At, B0); PG8_BAR; PG8_SCHED;
            PG8_LDB(B1, 1, 1); PG8_STAGE(PG8_SB(1, 0), b3, voffB);
            PG8_BAR; PG8_WAIT_L(0); PG8_MMA(0, 1, At, B1); PG8_BAR;
            PG8_LDA(At, 1, 1); PG8_STAGE(PG8_SA(1, 0), a3, voffA);
            PG8_BAR; PG8_WAIT_L(0); PG8_MMA(1, 0, At, B0); PG8_BAR; PG8_SCHED;
            PG8_STAGE(PG8_SB(1, 1), b3 + hstep, voffB);
            PG8_WAIT_V(6); PG8_BAR; PG8_MMA(1, 1, At, B1); PG8_BAR;
            }
        }
        if constexpr (ALIGN_EPI) { if (wr == 0) PG8_BAR; }
        if constexpr (!Epi::AFTER_DRAIN) { E(acc, cur, wr, wc, fr, fq); S.done(cur); }
        if (!has_next) break;
#pragma unroll
        for (int a = 0; a < 2; ++a)
#pragma unroll
            for (int b = 0; b < 2; ++b)
#pragma unroll
                for (int m = 0; m < 4; ++m)
#pragma unroll
                    for (int n = 0; n < 2; ++n) acc[a][b][m][n] = (f32x4){0.f, 0.f, 0.f, 0.f};
        cur = nxt; cA = nA; cB = nB; ++ui;
        if constexpr (ALIGN_EPI) { if (wr == 1) PG8_BAR; }
    }
    PG8_WAIT_V(0);
    if constexpr (!ALIGN_EPI) { if (wr == 0) PG8_BAR; }
    PG8_BAR;
    if constexpr (Epi::AFTER_DRAIN) { E.fused(acc, cur, wr, wc, fr, fq, lds, wid, lane); S.done(cur); }
#undef PG8_SA
#undef PG8_SB
#undef PG8_STAGE
#undef PG8_LDA
#undef PG8_LDB
#undef PG8_MMA
#undef PG8_WAIT_V
#undef PG8_WAIT_L
#undef PG8_BAR
#undef PG8_SCHED
}
}
using pg8::Unit;

struct EpiProj {
    static constexpr bool PERM = true, AFTER_DRAIN = false;
    bf16_t* O; bf16_t* halo;
    DI void operator()(const f32x4 (&acc)[2][2][4][2], const Unit& u, int wr, int wc, int fr, int fq) const {
        const int row0 = u.pm * 256 + wr * 64 + fr, col0 = u.pn * 256 + wc * 32 + 8 * fq;
#pragma unroll
        for (int ai = 0; ai < 2; ++ai)
#pragma unroll
            for (int m = 0; m < 4; ++m) { const int row = row0 + ai * 128 + m * 16; bf16_t* rowp = O + (size_t)row * NPJ + col0;
#pragma unroll
                for (int bj = 0; bj < 2; ++bj) { const f32x4 v0 = acc[ai][bj][m][0], v1 = acc[ai][bj][m][1];
                    u32x4 w; w.x = pk2(v0[0], v0[1]); w.y = pk2(v0[2], v0[3]); w.z = pk2(v1[0], v1[1]); w.w = pk2(v1[2], v1[3]);
                    *(u32x4*)(rowp + bj * 128) = w;
                    if (m == 3 && fr >= 13 && u.pn < 12) *(u32x4*)(halo + ((size_t)((row >> 6) + 1) * 3 + (fr - 13)) * 3072 + col0 + bj * 128) = w; } }
    }
};
struct EpiPlainBf16 {
    static constexpr bool PERM = true, AFTER_DRAIN = false;
    bf16_t* O; int ldc;
    DI void operator()(const f32x4 (&acc)[2][2][4][2], const Unit& u, int wr, int wc, int fr, int fq) const {
        const int row0 = u.pm * 256 + wr * 64 + fr, col0 = u.pn * 256 + wc * 32 + 8 * fq;
#pragma unroll
        for (int ai = 0; ai < 2; ++ai)
#pragma unroll
            for (int m = 0; m < 4; ++m) { bf16_t* rowp = O + (size_t)(row0 + ai * 128 + m * 16) * ldc + col0;
#pragma unroll
                for (int bj = 0; bj < 2; ++bj) { const f32x4 v0 = acc[ai][bj][m][0], v1 = acc[ai][bj][m][1];
                    u32x4 w; w.x = pk2(v0[0], v0[1]); w.y = pk2(v0[2], v0[3]); w.z = pk2(v1[0], v1[1]); w.w = pk2(v1[2], v1[3]);
                    *(u32x4*)(rowp + bj * 128) = w; } }
    }
};
struct EpiResid {
    static constexpr bool PERM = false, AFTER_DRAIN = false;
    const float* base; float* out; bf16_t* hb; float* ss;
    DI void operator()(const f32x4 (&acc)[2][2][4][2], const Unit& u, int wr, int wc, int fr, int fq) const {
        const int row0 = u.pm * 256 + wr * 64 + fr, col0 = u.pn * 256 + wc * 32 + 4 * fq;
#pragma unroll
        for (int ai = 0; ai < 2; ++ai) { f32x4 bs[4][4];
#pragma unroll
            for (int m = 0; m < 4; ++m)
#pragma unroll
                for (int q = 0; q < 4; ++q) bs[m][q] = *(const f32x4*)(base + (size_t)(row0 + ai * 128 + m * 16) * DM + col0 + (q >> 1) * 128 + (q & 1) * 16);
#pragma unroll
            for (int m = 0; m < 4; ++m) { const int row = row0 + ai * 128 + m * 16; const size_t off = (size_t)row * DM + col0; float s = 0.f;
#pragma unroll
                for (int q = 0; q < 4; ++q) { const f32x4 hv = bs[m][q] + acc[ai][q >> 1][m][q & 1];
                        *(f32x4*)(out + off + (q >> 1) * 128 + (q & 1) * 16) = hv; u32x2 w; w.x = pk2(hv[0], hv[1]); w.y = pk2(hv[2], hv[3]);
                        *(u32x2*)(hb + off + (q >> 1) * 128 + (q & 1) * 16) = w; s += (hv[0] * hv[0] + hv[1] * hv[1]) + (hv[2] * hv[2] + hv[3] * hv[3]); }
                s += __shfl_xor(s, 16); s += __shfl_xor(s, 32);
                if (fq == 0) atomicAdd(ss + row, s); }
            asm volatile("" ::: "memory"); }
    }
};
struct EpiAct {
    static constexpr bool PERM = true, AFTER_DRAIN = false;
    bf16_t* O; const float* ss;
    DI void operator()(const f32x4 (&acc)[2][2][4][2], const Unit& u, int wr, int wc, int fr, int fq) const {
        const int row0 = u.pm * 256 + wr * 64 + fr, col0 = u.pn * 128 + wc * 32 + 8 * fq;
        float rs[8];
#pragma unroll
        for (int g = 0; g < 8; ++g) rs[g] = ss[row0 + (g >> 2) * 128 + (g & 3) * 16];
#pragma unroll
        for (int ai = 0; ai < 2; ++ai)
#pragma unroll
            for (int m = 0; m < 4; ++m) { const int row = row0 + ai * 128 + m * 16; const float r = rsqrtf(rs[ai * 4 + m] * (1.f / 2048.f) + 1e-6f);
                float a[8];
#pragma unroll
                for (int n = 0; n < 2; ++n)
#pragma unroll
                    for (int j = 0; j < 4; ++j) { const float gv = r * acc[ai][0][m][n][j], uv = r * acc[ai][1][m][n][j]; a[n * 4 + j] = silu_f(gv) * uv; }
                u32x4 w; w.x = pk2(a[0], a[1]); w.y = pk2(a[2], a[3]); w.z = pk2(a[4], a[5]); w.w = pk2(a[6], a[7]);
                *(u32x4*)(O + (size_t)row * FF + col0) = w; }
    }
};
struct EpiOut {
    static constexpr bool PERM = false, AFTER_DRAIN = false;
    float* out; const bf16_t* pp; const float* ss;
    DI void operator()(const f32x4 (&acc)[2][2][4][2], const Unit& u, int wr, int wc, int fr, int fq) const {
        const int row0 = u.pm * 256 + wr * 64 + fr, col0 = u.pn * 256 + wc * 32 + 4 * fq;
        float rs[8];
#pragma unroll
        for (int g = 0; g < 8; ++g) rs[g] = ss[row0 + (g >> 2) * 128 + (g & 3) * 16];
#pragma unroll
        for (int ai = 0; ai < 2; ++ai)
#pragma unroll
            for (int m = 0; m < 4; ++m) { const int row = row0 + ai * 128 + m * 16; const size_t off = (size_t)row * DM + col0; const float r = rsqrtf(rs[ai * 4 + m] * (1.f / 2048.f) + 1e-6f);
                f32x4 hv[4]; u32x2 pw[4];
#pragma unroll
                for (int q = 0; q < 4; ++q) { hv[q] = *(const f32x4*)(out + off + (q >> 1) * 128 + (q & 1) * 16); pw[q] = *(const u32x2*)(pp + off + (q >> 1) * 128 + (q & 1) * 16); }
#pragma unroll
                for (int q = 0; q < 4; ++q) { const f32x4 a = acc[ai][q >> 1][m][q & 1]; f32x4 o;
                        o[0] = hv[q][0] + sigm_f(r * a[0]) * bflo(pw[q].x); o[1] = hv[q][1] + sigm_f(r * a[1]) * bfhi(pw[q].x);
                        o[2] = hv[q][2] + sigm_f(r * a[2]) * bflo(pw[q].y); o[3] = hv[q][3] + sigm_f(r * a[3]) * bfhi(pw[q].y);
                        *(f32x4*)(out + off + (q >> 1) * 128 + (q & 1) * 16) = o; }
                asm volatile("" ::: "memory"); }
    }
};

DI void tconv_tile(const float* __restrict__ src, int ld, int c0, int k0, bf16_t* __restrict__ dst, int dK, int n0, const float* __restrict__ nw, LAS float* tl) {
    const int tid = opq_tid();
    f32x4 v[8];
#pragma unroll
    for (int i = 0; i < 8; ++i) v[i] = *(const f32x4*)(src + (size_t)(k0 + (tid >> 4) + 32 * i) * ld + c0 + (tid & 15) * 4);
#pragma unroll
    for (int i = 0; i < 8; ++i) { const int k = (tid >> 4) + 32 * i; const float sc = nw ? nw[k0 + k] : 1.f;
        LAS float* q = tl + k * 65 + (tid & 15) * 4; q[0] = v[i][0] * sc; q[1] = v[i][1] * sc; q[2] = v[i][2] * sc; q[3] = v[i][3] * sc; }
    __syncthreads();
    { const int n = tid >> 3, kq = (tid & 7) * 8;
#pragma unroll
      for (int j = 0; j < 4; ++j) { const int ks = kq + 64 * j; float f[8];
#pragma unroll
          for (int i = 0; i < 8; ++i) f[i] = tl[(ks + i) * 65 + n];
          u32x4 w; w.x = pk2(f[0], f[1]); w.y = pk2(f[2], f[3]); w.z = pk2(f[4], f[5]); w.w = pk2(f[6], f[7]);
          *(u32x4*)(dst + (size_t)(n0 + n) * dK + k0 + ks) = w; } }
    __syncthreads();
}

DI void phase_prep(const Params& P, LAS unsigned char* lds) {
    unsigned char* ws = P.ws; const int tid = opq_tid(), G = gridDim.x, bx = blockIdx.x;
    const int gtid = bx * NTHREADS + tid, gsz = G * NTHREADS;
    for (int i = gtid; i < (int)((WS_GL - WS_CTL) / 4); i += gsz) ((unsigned*)(ws + WS_CTL))[i] = 0u;
    { bf16_t* wba = (bf16_t*)(ws + WS_WBA); for (int i = gtid; i < 16 * 2048; i += gsz) { const int n = i >> 11, k = i & 2047; wba[i] = f2bf(P.w_in[(size_t)k * INW + 4096 + n]); } }
    { bf16_t* pb = (bf16_t*)(ws + WS_PB); for (int i = gtid; i < MT * 256 / 8; i += gsz) { const f32x4 a = *(const f32x4*)(P.p + (size_t)i * 8), b = *(const f32x4*)(P.p + (size_t)i * 8 + 4);
        u32x4 w; w.x = pk2(a[0], a[1]); w.y = pk2(a[2], a[3]); w.z = pk2(b[0], b[1]); w.w = pk2(b[2], b[3]); *(u32x4*)(pb + (size_t)i * 8) = w; } }
    { bf16_t* xn = (bf16_t*)(ws + WS_R0); const int lane = tid & 63, gw = bx * 8 + (tid >> 6);
      f32x4 wv[8];
#pragma unroll
      for (int i = 0; i < 8; ++i) wv[i] = *(const f32x4*)(P.attn_norm + lane * 4 + i * 256);
      for (int row = gw * 2; row < MT; row += G * 16) { const float* xr = P.x + (size_t)row * DM; f32x4 v[2][8]; float s0 = 0.f, s1 = 0.f;
#pragma unroll
          for (int r = 0; r < 2; ++r)
#pragma unroll
              for (int i = 0; i < 8; ++i) v[r][i] = *(const f32x4*)(xr + (size_t)r * DM + lane * 4 + i * 256);
#pragma unroll
          for (int i = 0; i < 8; ++i) { s0 += (v[0][i][0] * v[0][i][0] + v[0][i][1] * v[0][i][1]) + (v[0][i][2] * v[0][i][2] + v[0][i][3] * v[0][i][3]);
              s1 += (v[1][i][0] * v[1][i][0] + v[1][i][1] * v[1][i][1]) + (v[1][i][2] * v[1][i][2] + v[1][i][3] * v[1][i][3]); }
#pragma unroll
          for (int o = 1; o < 64; o <<= 1) { s0 += __shfl_xor(s0, o); s1 += __shfl_xor(s1, o); }
          const float r0 = rsqrtf(s0 * (1.f / 2048.f) + 1e-6f), r1 = rsqrtf(s1 * (1.f / 2048.f) + 1e-6f);
#pragma unroll
          for (int r = 0; r < 2; ++r)
#pragma unroll
              for (int i = 0; i < 8; ++i) { const float rr = r ? r1 : r0; u32x2 w; w.x = pk2(v[r][i][0] * rr * wv[i][0], v[r][i][1] * rr * wv[i][1]); w.y = pk2(v[r][i][2] * rr * wv[i][2], v[r][i][3] * rr * wv[i][3]);
                  *(u32x2*)(xn + (size_t)(row + r) * DM + lane * 4 + i * 256) = w; } } }
    LAS float* tl = (LAS float*)lds;
    for (int gi = bx; gi < 896; gi += G) { const int nt = gi >> 3, kg = gi & 7, n0 = nt * 64; tconv_tile(P.w_in, INW, n0 < 4096 ? n0 : n0 + 16, kg * 256, (bf16_t*)(ws + WS_WIN), 2048, n0, nullptr, tl); }
}
DI void phase_wconv_late(const Params& P, LAS unsigned char* lds, int wg0, int nwg) {
    unsigned char* ws = P.ws; LAS float* tl = (LAS float*)lds;
    for (int gi = 896 + wg0; gi < 3552; gi += nwg) {
        if (gi < 1152) { const int t2 = gi - 896, nt = t2 >> 3, kg = t2 & 7; tconv_tile(P.w_o, 2048, nt * 64, kg * 256, (bf16_t*)(ws + WS_WO), 2048, nt * 64, nullptr, tl); }
        else if (gi < 2560) { const int t2 = gi - 1152, nt = t2 >> 3, kg = t2 & 7, n0 = nt * 64, pn = n0 >> 8, r = n0 & 255;
            tconv_tile(r < 128 ? P.w_gate : P.w_up, FF, pn * 128 + (r & 127), kg * 256, (bf16_t*)(ws + WS_WGU), 2048, n0, P.ffn_norm, tl); }
        else if (gi < 3264) { const int t2 = gi - 2560, nt = t2 / 22, kg = t2 % 22; tconv_tile(P.w_down, 2048, nt * 64, kg * 256, (bf16_t*)(ws + WS_WDN), FF, nt * 64, nullptr, tl); }
        else if (gi < 3520) { const int t2 = gi - 3264, nt = t2 >> 3, kg = t2 & 7; tconv_tile(P.w_pg, 2048, nt * 64, kg * 256, (bf16_t*)(ws + WS_WPG), 2048, nt * 64, P.ple_norm, tl); }
        else { const int nt = gi - 3520; tconv_tile(P.w_pp, 2048, nt * 64, 0, (bf16_t*)(ws + WS_WPP), 256, nt * 64, nullptr, tl); }
    }
}

DI void phase_ba(const Params& P) {
    const int tid = opq_tid(), lane = tid & 63, fr = lane & 15, fq = lane >> 4, gw = blockIdx.x * 8 + (tid >> 6);
    const bf16_t* xn = (const bf16_t*)(P.ws + WS_R0); const bf16_t* wba = (const bf16_t*)(P.ws + WS_WBA); float* BA = (float*)(P.ws + WS_BA);
    for (int rt = gw; rt < MT / 16; rt += gridDim.x * 8) {
        f32x4 acc = {0.f, 0.f, 0.f, 0.f}; const bf16_t* ap = xn + (size_t)(rt * 16 + fr) * DM + 8 * fq; const bf16_t* bp = wba + fr * 2048 + 8 * fq;
#pragma unroll 16
        for (int ks = 0; ks < 64; ++ks) acc = mfma16(*(const bf16x8*)(ap + 32 * ks), *(const bf16x8*)(bp + 32 * ks), acc);
#pragma unroll
        for (int j = 0; j < 4; ++j) BA[(size_t)(rt * 16 + 4 * fq + j) * 16 + fr] = acc[j];
    }
}

constexpr int G1_QS = 0, G1_KS = 18432, G1_VT = 36864, G1_KT = 57344, G1_SM = 77824, G1_TEAM = 78848;
DI void phase_gdn_prep(const Params& P, LAS unsigned char* lds) {
    const int tid0 = opq_tid(), team = tid0 >> 8;
    LAS unsigned char* L = lds + team * G1_TEAM;
    LAS bf16_t* QS = (LAS bf16_t*)(L + G1_QS); LAS bf16_t* KS = (LAS bf16_t*)(L + G1_KS); LAS bf16_t* VT = (LAS bf16_t*)(L + G1_VT); LAS bf16_t* KT = (LAS bf16_t*)(L + G1_KT);
    LAS float* AF = (LAS float*)(L + G1_QS); LAS bf16_t* TB = (LAS bf16_t*)(L + G1_KS); LAS float* SM = (LAS float*)(L + G1_SM);
    bf16_t* proj = (bf16_t*)(P.ws + WS_R1); const bf16_t* halo = (const bf16_t*)(P.ws + WS_HALO); const float* BA = (const float*)(P.ws + WS_BA);
    bf16_t* W2 = (bf16_t*)(P.ws + WS_W2); bf16_t* QKB = (bf16_t*)(P.ws + WS_QKB); float* GL = (float*)(P.ws + WS_GL);
    for (int pi = blockIdx.x; pi < 2048; pi += gridDim.x) {
        int tid = tid0; asm volatile("" : "+v"(tid));
        const int tt = tid & 255, tw = __builtin_amdgcn_readfirstlane((tid >> 6) & 3), lane = tid & 63, fr = lane & 15, fq = lane >> 4;
        const int ci = pi * 2 + team, h = ci & 7, n = (ci >> 3) & 255, b = ci >> 11, t0 = b * TT + n * 64;
        if (tw == 0) {
            const float bv = BA[(size_t)(t0 + lane) * 16 + h], av = BA[(size_t)(t0 + lane) * 16 + 8 + h];
            const float beta = sigm_f(bv); const float xx = av + P.dt_bias[h]; const float sp = xx > 20.f ? xx : log1pf(__expf(xx));
            const float gg = -__expf(P.A_log[h]) * sp; float gc = gg;
#pragma unroll
            for (int o = 1; o < 64; o <<= 1) { const float v = __shfl_up(gc, o); if (lane >= o) gc += v; }
            const float glast = __shfl(gc, 63);
            SM[lane] = gc; SM[64 + lane] = beta; SM[128 + lane] = __expf(gc); SM[192 + lane] = __expf(glast - gc);
            if (lane == 63) GL[(b * 8 + h) * 256 + n] = __expf(gc);
        }
        __syncthreads();
        { const int r = tt >> 2, cg0 = (tt & 3) * 32; const float beta_r = SM[64 + r], egc_r = SM[128 + r];
#pragma unroll 1
          for (int x = 0; x < 3; ++x) {
              float val[32]; const int colbase = x * 1024 + h * 128 + cg0;
              u32x4 rawa[4][4];
#pragma unroll
              for (int sg = 0; sg < 4; ++sg) { const int col = colbase + sg * 8;
#pragma unroll
                  for (int j = 0; j < 4; ++j) { const int rr = r - 3 + j; rawa[sg][j] = (u32x4){0u, 0u, 0u, 0u};
                      if (rr >= 0) rawa[sg][j] = *(const u32x4*)(proj + (size_t)(t0 + rr) * NPJ + col);
                      else if (n > 0) rawa[sg][j] = *(const u32x4*)(halo + ((size_t)(t0 >> 6) * 3 + (rr + 3)) * 3072 + col); } }
#pragma unroll
              for (int sg = 0; sg < 4; ++sg) { const int col = colbase + sg * 8;
#pragma unroll
                  for (int i = 0; i < 8; ++i) { const f32x4 w4 = *(const f32x4*)(P.conv_w + (size_t)(col + i) * 4); float a = 0.f;
#pragma unroll
                      for (int j = 0; j < 4; ++j) { const unsigned wd = rawa[sg][j][i >> 1]; const float xv = (i & 1) ? bfhi(wd) : bflo(wd); a += w4[j] * xv; }
                      val[sg * 8 + i] = silu_f(a); } }
              if (x < 2) { float ss = 0.f;
#pragma unroll
                  for (int i = 0; i < 32; ++i) ss += val[i] * val[i];
                  ss += __shfl_xor(ss, 1); ss += __shfl_xor(ss, 2);
                  const float sc = rsqrtf(ss + 1e-6f) * (x == 0 ? 0.08838834764831845f : 1.f);
#pragma unroll
                  for (int i = 0; i < 32; ++i) val[i] *= sc; }
              if (x < 2) { LAS bf16_t* dst = (x == 0 ? QS : KS) + r * 144 + cg0;
#pragma unroll
                  for (int i = 0; i < 4; ++i) { u32x4 w; w.x = pk2(val[8 * i], val[8 * i + 1]); w.y = pk2(val[8 * i + 2], val[8 * i + 3]); w.z = pk2(val[8 * i + 4], val[8 * i + 5]); w.w = pk2(val[8 * i + 6], val[8 * i + 7]);
                      *(LAS u32x4*)(dst + 8 * i) = w; } }
              if (x == 1) { const float f = beta_r * egc_r;
#pragma unroll
                  for (int i = 0; i < 32; ++i) KT[(cg0 + i) * 80 + r] = f2bf(val[i] * f); }
              if (x == 2) {
#pragma unroll
                  for (int i = 0; i < 32; ++i) VT[(cg0 + i) * 80 + r] = f2bf(val[i] * beta_r); }
          } }
        __syncthreads();
        f32x4 kk[4], qk[4];
#pragma unroll
        for (int nt = 0; nt < 4; ++nt) { kk[nt] = (f32x4){0.f, 0.f, 0.f, 0.f}; qk[nt] = (f32x4){0.f, 0.f, 0.f, 0.f}; }
#pragma unroll
        for (int ks = 0; ks < 4; ++ks) { const bf16x8 ak = *(const LAS bf16x8*)(KS + (16 * tw + fr) * 144 + 32 * ks + 8 * fq), aq = *(const LAS bf16x8*)(QS + (16 * tw + fr) * 144 + 32 * ks + 8 * fq);
#pragma unroll
            for (int nt = 0; nt < 4; ++nt) { const bf16x8 bk = *(const LAS bf16x8*)(KS + (16 * nt + fr) * 144 + 32 * ks + 8 * fq); kk[nt] = mfma16(ak, bk, kk[nt]); qk[nt] = mfma16(aq, bk, qk[nt]); } }
        { const int r = tt >> 2, cg0 = (tt & 3) * 32; const float e = SM[128 + r];
#pragma unroll
          for (int i = 0; i < 4; ++i) { const u32x4 s = *(const LAS u32x4*)(QS + r * 144 + cg0 + 8 * i); u32x4 w;
              w.x = pk2(bflo(s.x) * e, bfhi(s.x) * e); w.y = pk2(bflo(s.y) * e, bfhi(s.y) * e); w.z = pk2(bflo(s.z) * e, bfhi(s.z) * e); w.w = pk2(bflo(s.w) * e, bfhi(s.w) * e);
              *(u32x4*)(proj + (size_t)(t0 + r) * NPJ + OFF_GQ + h * 128 + cg0 + 8 * i) = w; } }
        { const int d = tt >> 1, cb = (tt & 1) * 32;
#pragma unroll
          for (int i4 = 0; i4 < 4; ++i4) { const int c0 = cb + 8 * i4; float f[8];
#pragma unroll
              for (int i = 0; i < 8; ++i) f[i] = bf2f(KS[(c0 + i) * 144 + d]) * SM[192 + c0 + i];
              u32x4 w; w.x = pk2(f[0], f[1]); w.y = pk2(f[2], f[3]); w.z = pk2(f[4], f[5]); w.w = pk2(f[6], f[7]);
              *(u32x4*)(proj + (size_t)(t0 + (d >> 1)) * NPJ + OFF_GK + h * 128 + (d & 1) * 64 + c0) = w; } }
        __syncthreads();
#pragma unroll
        for (int nt = 0; nt < 4; ++nt)
#pragma unroll
            for (int j = 0; j < 4; ++j) { const int c = 16 * tw + 4 * fq + j, s = 16 * nt + fr; const float dec = (s <= c) ? __expf(SM[c] - SM[s]) : 0.f;
                AF[c * 65 + s] = (s < c) ? SM[64 + c] * kk[nt][j] * dec : (s == c ? 1.f : 0.f);
                QKB[(size_t)ci * 4096 + c * 64 + s] = f2bf(qk[nt][j] * dec); }
        __syncthreads();
        { const int bb = tw * 16;
          if (lane < 16) {
              for (int i = 1; i < 16; ++i) { float a0 = 0.f, a1 = 0.f; int j = 0;
                  for (; j + 2 <= i; j += 2) { a0 += AF[(bb + i) * 65 + bb + j] * AF[(bb + j) * 65 + bb + lane]; a1 += AF[(bb + i) * 65 + bb + j + 1] * AF[(bb + j + 1) * 65 + bb + lane]; }
                  if (j < i) a0 += AF[(bb + i) * 65 + bb + j] * AF[(bb + j) * 65 + bb + lane];
                  AF[(bb + i) * 65 + bb + lane] = lane < i ? -(a0 + a1) : (lane == i ? 1.f : 0.f); } }
#pragma unroll
          for (int k = 0; k < 4; ++k) { const int row = bb + fq + 4 * k; TB[row * 80 + bb + fr] = f2bf(AF[row * 65 + bb + fr]);
              for (int jb = tw + 1; jb < 4; ++jb) TB[row * 80 + 16 * jb + fr] = (bf16_t)0; }
          __syncthreads();
          for (int i = 1; i < 4; ++i) {
              if (tw < i) { const int j = tw; f32x4 X = {0.f, 0.f, 0.f, 0.f};
                  for (int k = j; k < i; ++k) {
#pragma unroll
                      for (int kk = 0; kk < 4; ++kk) { const float av = AF[(16 * i + fr) * 65 + 16 * k + 4 * kk + fq];
                          const float bv = (k == j) ? AF[(16 * k + 4 * kk + fq) * 65 + 16 * j + fr] : bf2f(TB[(16 * k + 4 * kk + fq) * 80 + 16 * j + fr]);
                          X = __builtin_amdgcn_mfma_f32_16x16x4f32(av, bv, X, 0, 0, 0); } }
                  f32x4 O = {0.f, 0.f, 0.f, 0.f};
#pragma unroll
                  for (int kk = 0; kk < 4; ++kk) O = __builtin_amdgcn_mfma_f32_16x16x4f32(AF[(16 * i + fr) * 65 + 16 * i + 4 * fq + kk], X[kk], O, 0, 0, 0);
#pragma unroll
                  for (int jj = 0; jj < 4; ++jj) TB[(16 * i + 4 * fq + jj) * 80 + 16 * j + fr] = f2bf(-O[jj]); }
              __syncthreads(); }
        }
        { bf16x8 at[2];
#pragma unroll
          for (int ks = 0; ks < 2; ++ks) at[ks] = *(const LAS bf16x8*)(TB + (16 * tw + fr) * 80 + 32 * ks + 8 * fq);
#pragma unroll
          for (int nt = 0; nt < 8; ++nt) { f32x4 a = {0.f, 0.f, 0.f, 0.f};
#pragma unroll
              for (int ks = 0; ks < 2; ++ks) a = mfma16(at[ks], *(const LAS bf16x8*)(VT + (16 * nt + fr) * 80 + 32 * ks + 8 * fq), a);
              const int e = 16 * nt + fr; u32x2 w; w.x = pk2(a[0], a[1]); w.y = pk2(a[2], a[3]);
              *(u32x2*)(proj + (size_t)(t0 + (e >> 1)) * NPJ + OFF_GV + h * 128 + (e & 1) * 64 + 16 * tw + 4 * fq) = w; }
#pragma unroll
          for (int mt = 0; mt < 8; ++mt) { f32x4 a = {0.f, 0.f, 0.f, 0.f};
#pragma unroll
              for (int ks = 0; ks < 2; ++ks) a = mfma16(*(const LAS bf16x8*)(KT + (16 * mt + fr) * 80 + 32 * ks + 8 * fq), at[ks], a);
              u32x2 w; w.x = pk2(a[0], a[1]); w.y = pk2(a[2], a[3]);
              *(u32x2*)(W2 + (size_t)(t0 + 16 * tw + fr) * 1024 + h * 128 + 16 * mt + 4 * fq) = w; } }
        __syncthreads();
    }
}

DI void phase_moba_prep(const Params& P, LAS unsigned char* lds) {
    const int tid = opq_tid(), lane = tid & 63, wave = tid >> 6, l16 = lane & 15;
    bf16_t* proj = (bf16_t*)(P.ws + WS_R1); float* kmean = (float*)(P.ws + WS_KMEAN);
    LAS bf16_t* VS = (LAS bf16_t*)lds; LAS float* CS = (LAS float*)(lds + 69632);
    for (int task = blockIdx.x; task < 1024; task += gridDim.x) {
        const int h = task & 7, blk = (task >> 3) & 63, b = task >> 9; const size_t rbase = (size_t)(b * TT + blk * 256);
        f32x4 qg0 = *(const f32x4*)(P.q_norm + l16 * 8), qg1 = *(const f32x4*)(P.q_norm + l16 * 8 + 4), kg0 = *(const f32x4*)(P.k_norm + l16 * 8), kg1 = *(const f32x4*)(P.k_norm + l16 * 8 + 4);
        float cs[8];
#pragma unroll
        for (int i = 0; i < 8; ++i) cs[i] = 0.f;
        u32x4 rq[8], rk[8], rv[8];
#pragma unroll
        for (int ps = 0; ps < 8; ++ps) { const int r = ps * 32 + wave * 4 + (lane >> 4); const bf16_t* rp = proj + (rbase + r) * NPJ + h * 128 + l16 * 8;
            rq[ps] = *(const u32x4*)(rp + OFF_MQ); rk[ps] = *(const u32x4*)(rp + OFF_MK); rv[ps] = *(const u32x4*)(rp + OFF_MV); }
#pragma unroll
        for (int ps = 0; ps < 8; ++ps) { const int r = ps * 32 + wave * 4 + (lane >> 4); bf16_t* rp = proj + (rbase + r) * NPJ + h * 128 + l16 * 8;
#pragma unroll
            for (int x = 0; x < 2; ++x) { bf16_t* ptr = rp + (x == 0 ? OFF_MQ : OFF_MK); const u32x4 raw = x == 0 ? rq[ps] : rk[ps]; float v[8];
                v[0] = bflo(raw.x); v[1] = bfhi(raw.x); v[2] = bflo(raw.y); v[3] = bfhi(raw.y); v[4] = bflo(raw.z); v[5] = bfhi(raw.z); v[6] = bflo(raw.w); v[7] = bfhi(raw.w);
                float ss = 0.f;
#pragma unroll
                for (int i = 0; i < 8; ++i) ss += v[i] * v[i];
                ss = row16_sum(ss);
                const float rs = rsqrtf(ss * (1.f / 128.f) + 1e-6f); const f32x4 g0 = x == 0 ? qg0 : kg0, g1 = x == 0 ? qg1 : kg1;
#pragma unroll
                for (int i = 0; i < 4; ++i) { v[i] *= rs * g0[i]; v[4 + i] *= rs * g1[i]; }
                if (x == 1) {
#pragma unroll
                    for (int i = 0; i < 8; ++i) cs[i] += v[i]; }
                u32x4 w; w.x = pk2(v[0], v[1]); w.y = pk2(v[2], v[3]); w.z = pk2(v[4], v[5]); w.w = pk2(v[6], v[7]); *(u32x4*)ptr = w; }
            *(LAS u32x4*)(VS + r * 136 + l16 * 8) = rv[ps]; }
#pragma unroll
        for (int i = 0; i < 8; ++i) { cs[i] += __shfl_xor(cs[i], 16); cs[i] += __shfl_xor(cs[i], 32); }
        if (lane < 16) {
#pragma unroll
            for (int i = 0; i < 8; ++i) CS[wave * 128 + lane * 8 + i] = cs[i]; }
        __syncthreads();
        if (tid < 128) { float s = 0.f;
#pragma unroll
            for (int w = 0; w < 8; ++w) s += CS[w * 128 + tid];
            kmean[((size_t)(b * 8 + h) * 64 + blk) * 128 + tid] = s * (1.f / 256.f); }
#pragma unroll 2
        for (int i8 = 0; i8 < 8; ++i8) { const int pid = tid + i8 * 512, e = pid >> 5, ks = pid & 31; unsigned short f[8];
#pragma unroll
            for (int i = 0; i < 8; ++i) f[i] = VS[(ks * 8 + i) * 136 + e];
            u32x4 w; w.x = f[0] | ((unsigned)f[1] << 16); w.y = f[2] | ((unsigned)f[3] << 16); w.z = f[4] | ((unsigned)f[5] << 16); w.w = f[6] | ((unsigned)f[7] << 16);
            *(u32x4*)(proj + (rbase + 2 * e + (ks >> 4)) * NPJ + OFF_MV + h * 128 + (ks & 15) * 8) = w; }
        __syncthreads();
    }
}

DI void phase_moba_select(const Params& P, LAS unsigned char* lds) {
    const int tid = opq_tid(), qi = tid >> 1, half = tid & 1;
    const bf16_t* proj = (const bf16_t*)(P.ws + WS_R1); const float* kmean = (const float*)(P.ws + WS_KMEAN);
    int* cnt = (int*)(P.ws + WS_CNT); int* list = (int*)(P.ws + WS_LIST); f32x2* ML = (f32x2*)(P.ws + WS_ML);
    LAS float* KM = (LAS float*)lds; LAS int* hist = (LAS int*)(lds + 32768); LAS int* hbase = (LAS int*)(lds + 32768 + 256);
    for (int task = blockIdx.x; task < 1024; task += gridDim.x) {
        const int tk = task >> 8, tw_ = task & 255, bhx = (tw_ >> 6) * 4 + tk, blk = (tk & 1) ? 63 - (tw_ & 63) : (tw_ & 63), h = bhx & 7, b = bhx >> 3; const int bh = b * 8 + h; const int t = blk * 256 + qi; const size_t rid = (size_t)bh * TT + t;
        for (int i = tid; i < blk * 128; i += NTHREADS) KM[i] = kmean[(size_t)bh * 64 * 128 + i];
        if (tid < 64) hist[tid] = 0;
        float q[64];
        { const bf16_t* qp = proj + (size_t)(b * TT + t) * NPJ + OFF_MQ + h * 128 + half * 64;
#pragma unroll
          for (int i = 0; i < 8; ++i) { const u32x4 raw = *(const u32x4*)(qp + 8 * i); q[8 * i] = bflo(raw.x); q[8 * i + 1] = bfhi(raw.x); q[8 * i + 2] = bflo(raw.y); q[8 * i + 3] = bfhi(raw.y);
              q[8 * i + 4] = bflo(raw.z); q[8 * i + 5] = bfhi(raw.z); q[8 * i + 6] = bflo(raw.w); q[8 * i + 7] = bfhi(raw.w); } }
        __syncthreads();
        float v0 = -INFINITY, v1 = -INFINITY, v2 = -INFINITY; int i0 = -1, i1 = -1, i2 = -1;
        for (int n = 0; n < blk; ++n) { const LAS float* km = KM + n * 128 + half * 64; float d0 = 0.f, d1 = 0.f, d2 = 0.f, d3 = 0.f;
#pragma unroll
            for (int i = 0; i < 16; ++i) { const f32x4 kv = *(const LAS f32x4*)(km + 4 * i); d0 += q[4 * i] * kv[0]; d1 += q[4 * i + 1] * kv[1]; d2 += q[4 * i + 2] * kv[2]; d3 += q[4 * i + 3] * kv[3]; }
            float g = (d0 + d1) + (d2 + d3); g += __shfl_xor(g, 1);
            if (g > v0) { v2 = v1; i2 = i1; v1 = v0; i1 = i0; v0 = g; i0 = n; } else if (g > v1) { v2 = v1; i2 = i1; v1 = g; i1 = n; } else if (g > v2) { v2 = g; i2 = n; } }
        int rk0 = 0, rk1 = 0, rk2 = 0;
        if (half == 0) { if (i0 >= 0) rk0 = __hip_atomic_fetch_add(&hist[i0], 1, __ATOMIC_RELAXED, __HIP_MEMORY_SCOPE_WORKGROUP); if (i1 >= 0) rk1 = __hip_atomic_fetch_add(&hist[i1], 1, __ATOMIC_RELAXED, __HIP_MEMORY_SCOPE_WORKGROUP); if (i2 >= 0) rk2 = __hip_atomic_fetch_add(&hist[i2], 1, __ATOMIC_RELAXED, __HIP_MEMORY_SCOPE_WORKGROUP); }
        __syncthreads();
        if (tid < 64) { const int c = hist[tid]; hbase[tid] = c > 0 ? atomicAdd(&cnt[bh * 64 + tid], c) : 0; }
        __syncthreads();
        if (half == 0) {
            const f32x2 dead = {-INFINITY, 0.f};
            if (i0 >= 0) list[(size_t)bh * LISTN + i0 * 16384 - 128 * i0 * (i0 + 1) + hbase[i0] + rk0] = t; else ML[0 * 262144 + rid] = dead;
            if (i1 >= 0) list[(size_t)bh * LISTN + i1 * 16384 - 128 * i1 * (i1 + 1) + hbase[i1] + rk1] = t | (1 << 14); else ML[1 * 262144 + rid] = dead;
            if (i2 >= 0) list[(size_t)bh * LISTN + i2 * 16384 - 128 * i2 * (i2 + 1) + hbase[i2] + rk2] = t | (2 << 14); else ML[2 * 262144 + rid] = dead;
        }
        __syncthreads();
    }
}

constexpr int G2_W = 0, G2_Q = 18432, G2_QK = 36864, G2_KD = 47104, G2_BUF = 67584, G2_RED = 135168;
DI void phase_gdn_scan(const Params& P, LAS unsigned char* lds, int bh) {
    const int tid = opq_tid(), lane = tid & 63, w = tid >> 6, fr = lane & 15, fq = lane >> 4, b = bh >> 3, h = bh & 7;
    const bf16_t* proj = (const bf16_t*)(P.ws + WS_R1); const bf16_t* W2 = (const bf16_t*)(P.ws + WS_W2); const bf16_t* QKB = (const bf16_t*)(P.ws + WS_QKB);
    const float* GL = (const float*)(P.ws + WS_GL); bf16_t* mix = (bf16_t*)(P.ws + WS_R2);
    float* SSQ = (float*)(P.ws + WS_SSQ);
    const int e = 16 * w + fr; const float gnw = P.gdn_norm[e];
    f32x4 S[8];
#pragma unroll
    for (int i = 0; i < 8; ++i) S[i] = (f32x4){0.f, 0.f, 0.f, 0.f};
    const int wrow0 = tid >> 4, wseg = tid & 15;
    const int qrow = tid >> 3, qseg = tid & 7;
    struct Stage { u32x4 sw[2], sq[2], sqk, skd[2]; };
    u32x2 un[4];
    Stage stA, stB;
#define G2_LOAD(X, nn) do { const int t0_ = b * TT + (nn) * 64; const int ci_ = ((b * 256 + (nn)) << 3) + h; \
        _Pragma("unroll") for (int i_ = 0; i_ < 2; ++i_) { X.sw[i_] = *(const u32x4*)(W2 + (size_t)(t0_ + wrow0 + 32 * i_) * 1024 + h * 128 + wseg * 8); \
            X.sq[i_] = *(const u32x4*)(proj + (size_t)(t0_ + wrow0 + 32 * i_) * NPJ + OFF_GQ + h * 128 + wseg * 8); \
            const int d_ = qrow + 64 * i_; X.skd[i_] = *(const u32x4*)(proj + (size_t)(t0_ + (d_ >> 1)) * NPJ + OFF_GK + h * 128 + (d_ & 1) * 64 + qseg * 8); } \
        X.sqk = *(const u32x4*)(QKB + (size_t)ci_ * 4096 + qrow * 64 + qseg * 8); } while (0)
#define UN_LOAD(nn) do { const int t0_ = b * TT + (nn) * 64; _Pragma("unroll") for (int mt_ = 0; mt_ < 4; ++mt_) un[mt_] = *(const u32x2*)(proj + (size_t)(t0_ + (e >> 1)) * NPJ + OFF_GV + h * 128 + (e & 1) * 64 + 16 * mt_ + 4 * fq); } while (0)
#define G2_ST2(base_, rowoff_, sg_, v_) do { const int g_ = ((sg_) >> 2) * 64, d_ = ((sg_) & 3) * 8; \
        *(LAS u32x2*)(B_ + (base_) + (rowoff_) + g_ + perm4(d_) * 2) = (u32x2){(v_).x, (v_).y}; *(LAS u32x2*)(B_ + (base_) + (rowoff_) + g_ + perm4(d_ + 4) * 2) = (u32x2){(v_).z, (v_).w}; } while (0)
#define G2_STORE(X, bufi) do { LAS unsigned char* B_ = lds + (bufi) * G2_BUF; \
        _Pragma("unroll") for (int i_ = 0; i_ < 2; ++i_) { G2_ST2(G2_W, (wrow0 + 32 * i_) * 288, wseg, X.sw[i_]); G2_ST2(G2_Q, (wrow0 + 32 * i_) * 288, wseg, X.sq[i_]); \
            G2_ST2(G2_KD, (qrow + 64 * i_) * 160, qseg, X.skd[i_]); } \
        G2_ST2(G2_QK, qrow * 160, qseg, X.sqk); } while (0)
    G2_LOAD(stA, 0); G2_STORE(stA, 0); UN_LOAD(0);
    float egl_n = GL[bh * 256];
    u32x2 uc[4];
#pragma unroll
    for (int i = 0; i < 4; ++i) uc[i] = un[i];
    G2_LOAD(stA, 1);
    __syncthreads();
    for (int n2 = 0; n2 < 256; n2 += 2) {
#pragma unroll
      for (int hf2 = 0; hf2 < 2; ++hf2) {
        const int n = n2 + hf2; Stage& LDs = hf2 ? stA : stB; Stage& STs = hf2 ? stB : stA;
        const int cur = hf2, t0 = b * TT + n * 64; LAS unsigned char* Bf = lds + cur * G2_BUF;
        { const int n2c = n + 2 < 256 ? n + 2 : 255, n1c = n + 1 < 256 ? n + 1 : 255; G2_LOAD(LDs, n2c); UN_LOAD(n1c); }
        const float egl = egl_n; egl_n = GL[bh * 256 + (n + 1 < 256 ? n + 1 : 255)];
        f32x4 Pm[4], Om[4];
#pragma unroll
        for (int mt = 0; mt < 4; ++mt) { Pm[mt] = (f32x4){0.f, 0.f, 0.f, 0.f}; Om[mt] = (f32x4){0.f, 0.f, 0.f, 0.f}; }
#define SBAR __builtin_amdgcn_sched_barrier(0)
#define LD_K4(dst, base_, ks_) do { const int o0_ = fr * 288 + (32 * (ks_) + 8 * fq) * 2; \
        dst[0] = *(const LAS bf16x8*)(Bf + base_ + o0_); dst[1] = *(const LAS bf16x8*)(Bf + base_ + o0_ + 4608); \
        dst[2] = *(const LAS bf16x8*)(Bf + base_ + o0_ + 9216); dst[3] = *(const LAS bf16x8*)(Bf + base_ + o0_ + 13824); } while (0)
#define MM_K4(src, sb_, A_) do { A_[0] = mfma16(src[0], sb_, A_[0]); A_[1] = mfma16(src[1], sb_, A_[1]); A_[2] = mfma16(src[2], sb_, A_[2]); A_[3] = mfma16(src[3], sb_, A_[3]); } while (0)
#define LD_R4(dst, base_, r0_, k2_) do { const int o0_ = (16 * (r0_) + fr) * 160 + (32 * (k2_) + 8 * fq) * 2; \
        dst[0] = *(const LAS bf16x8*)(Bf + base_ + o0_); dst[1] = *(const LAS bf16x8*)(Bf + base_ + o0_ + 2560); \
        dst[2] = *(const LAS bf16x8*)(Bf + base_ + o0_ + 5120); dst[3] = *(const LAS bf16x8*)(Bf + base_ + o0_ + 7680); } while (0)
#define MM_R4(src, vb_, A0_, A1_, A2_, A3_) do { A0_ = mfma16(src[0], vb_, A0_); A1_ = mfma16(src[1], vb_, A1_); A2_ = mfma16(src[2], vb_, A2_); A3_ = mfma16(src[3], vb_, A3_); } while (0)
        bf16x8 fa[4], fb[4];
        LD_K4(fa, G2_W, 0);
        const bf16x8 sb0 = pack8(S[0], S[1]), sb1 = pack8(S[2], S[3]), sb2 = pack8(S[4], S[5]), sb3 = pack8(S[6], S[7]);
        LD_K4(fb, G2_W, 1); SBAR; MM_K4(fa, sb0, Pm); SBAR;
        LD_K4(fa, G2_W, 2); SBAR; MM_K4(fb, sb1, Pm); SBAR;
        LD_K4(fb, G2_W, 3); SBAR; MM_K4(fa, sb2, Pm); SBAR;
        LD_K4(fa, G2_Q, 0); SBAR; MM_K4(fb, sb3, Pm); SBAR;
        f32x4 vn[4];
#pragma unroll
        for (int mt = 0; mt < 4; ++mt) { vn[mt][0] = bflo(uc[mt].x) - Pm[mt][0]; vn[mt][1] = bfhi(uc[mt].x) - Pm[mt][1]; vn[mt][2] = bflo(uc[mt].y) - Pm[mt][2]; vn[mt][3] = bfhi(uc[mt].y) - Pm[mt][3]; }
        bf16x8 Vb[2];
#pragma unroll
        for (int k2 = 0; k2 < 2; ++k2) Vb[k2] = pack8(vn[2 * k2], vn[2 * k2 + 1]);
        LD_K4(fb, G2_Q, 1); SBAR; MM_K4(fa, sb0, Om); SBAR;
        LD_K4(fa, G2_Q, 2); SBAR; MM_K4(fb, sb1, Om); SBAR;
        LD_K4(fb, G2_Q, 3); SBAR; MM_K4(fa, sb2, Om); SBAR;
        LD_R4(fa, G2_QK, 0, 0); SBAR; MM_K4(fb, sb3, Om); SBAR;
#pragma unroll
        for (int dt = 0; dt < 8; ++dt) S[dt] = S[dt] * egl;
        SBAR;
        LD_R4(fb, G2_QK, 0, 1); SBAR; MM_R4(fa, Vb[0], Om[0], Om[1], Om[2], Om[3]); SBAR;
        LD_R4(fa, G2_KD, 0, 0); SBAR; MM_R4(fb, Vb[1], Om[0], Om[1], Om[2], Om[3]); SBAR;
        LD_R4(fb, G2_KD, 0, 1); SBAR; MM_R4(fa, Vb[0], S[0], S[1], S[2], S[3]); SBAR;
        LD_R4(fa, G2_KD, 4, 0); SBAR; MM_R4(fb, Vb[1], S[0], S[1], S[2], S[3]); SBAR;
        LD_R4(fb, G2_KD, 4, 1); SBAR; MM_R4(fa, Vb[0], S[4], S[5], S[6], S[7]); SBAR;
        MM_R4(fb, Vb[1], S[4], S[5], S[6], S[7]); SBAR;
#undef LD_K4
#undef MM_K4
#undef LD_R4
#undef MM_R4
#undef SBAR
        { G2_STORE(STs, cur ^ 1);
#pragma unroll
            for (int i = 0; i < 4; ++i) uc[i] = un[i]; }
        { LAS bf16_t* OTW = (LAS bf16_t*)(lds + G2_RED + w * 2048);
#pragma unroll
          for (int mt = 0; mt < 4; ++mt)
#pragma unroll
            for (int j = 0; j < 4; ++j) OTW[(16 * mt + 4 * fq + j) * 16 + fr] = f2bf(Om[mt][j]);
#pragma unroll
          for (int i = 0; i < 2; ++i) { const int row = (lane >> 1) + 32 * i, hv = lane & 1;
              bf16_t* mp_ = mix + (size_t)(t0 + row) * DM + h * 128 + 16 * w + 8 * hv; const u32x4 ov_ = *(const LAS u32x4*)(OTW + row * 16 + hv * 8);
              asm volatile("global_store_dwordx4 %0, %1, off" :: "v"(mp_), "v"(ov_) : "memory"); } }
        __syncthreads();
      }
    }
#undef G2_LOAD
#undef UN_LOAD
#undef G2_STORE
#undef G2_ST2
    asm volatile("s_waitcnt vmcnt(0)" ::: "memory");
    __syncthreads();
}

constexpr int AT_KS = 0, AT_VT = 73728, AT_PF = 143360, AT_MISC = 147712;
DI void phase_moba_attn(const Params& P, LAS unsigned char* lds) {
    const int tid = opq_tid(), lane = tid & 63, w = tid >> 6, fr = lane & 15, fq = lane >> 4;
    const bf16_t* proj = (const bf16_t*)(P.ws + WS_R1); const int* cnt = (const int*)(P.ws + WS_CNT); const int* list = (const int*)(P.ws + WS_LIST);
    f32x2* ML = (f32x2*)(P.ws + WS_ML); bf16_t* opart = (bf16_t*)P.out; unsigned* workctr = (unsigned*)(P.ws + WS_CTL);
    LAS bf16_t* KS = (LAS bf16_t*)(lds + AT_KS); LAS bf16_t* VT = (LAS bf16_t*)(lds + AT_VT); LAS int* PF = (LAS int*)(lds + AT_PF); LAS int* MISC = (LAS int*)(lds + AT_MISC);
    { const int c0 = cnt[2 * tid], c1 = cnt[2 * tid + 1]; const int a = (c0 + 511) >> 9, bsum = a + ((c1 + 511) >> 9); int inc = bsum;
#pragma unroll
      for (int o = 1; o < 64; o <<= 1) { const int v = __shfl_up(inc, o); if (lane >= o) inc += v; }
      if (lane == 63) MISC[8 + w] = inc;
      __syncthreads();
      int wb = 0;
#pragma unroll
      for (int i = 0; i < 8; ++i) wb += (i < w) ? MISC[8 + i] : 0;
      const int ex = wb + inc - bsum; PF[2 * tid] = ex; PF[2 * tid + 1] = ex + a; if (tid == 511) PF[1024] = ex + bsum;
      __syncthreads(); }
    const int totalG = PF[1024];
    const float sc2 = 0.08838834764831845f * 1.4426950408889634f;
    const int tid_at = tid;
    for (;;) {
        int tid = tid_at; asm volatile("" : "+v"(tid)); const int lane = tid & 63, w = __builtin_amdgcn_readfirstlane(tid >> 6), fr = lane & 15, fq = lane >> 4;
        if (tid == 0) MISC[0] = (int)atomicAdd(workctr, 1u);
        __syncthreads();
        const int wid = MISC[0];
        __syncthreads();
        if (wid >= totalG + 1024) break;
        int bh, j, causal, qstart, qcount;
        if (wid < totalG) { int lo = 0, hi = 1024; while (hi - lo > 1) { const int mid = (lo + hi) >> 1; if (PF[mid] <= wid) lo = mid; else hi = mid; }
            bh = lo >> 6; j = lo & 63; causal = 0; qstart = (wid - PF[lo]) * 512; const int c = cnt[lo]; qcount = c - qstart; if (qcount > 512) qcount = 512; }
        else { const int o = wid - totalG; bh = o >> 6; j = o & 63; causal = 1; qstart = 0; qcount = 256; }
        const int b = bh >> 3, h = bh & 7; const size_t kbase = (size_t)(b * TT + j * 256);
        { u32x4 kr[8], vr[8];
#pragma unroll
          for (int i8 = 0; i8 < 8; ++i8) { const int pid = tid + i8 * 512; kr[i8] = *(const u32x4*)(proj + (kbase + (pid >> 4)) * NPJ + OFF_MK + h * 128 + (pid & 15) * 8);
              const int e = pid >> 5, ks = pid & 31; vr[i8] = *(const u32x4*)(proj + (kbase + 2 * e + (ks >> 4)) * NPJ + OFF_MV + h * 128 + (ks & 15) * 8); }
#pragma unroll
          for (int i8 = 0; i8 < 8; ++i8) { const int pid = tid + i8 * 512; *(LAS u32x4*)(KS + (pid >> 4) * 144 + (pid & 15) * 8) = kr[i8];
              const int e = pid >> 5, ks = pid & 31; const int g_ = (ks >> 2) * 32, d_ = (ks & 3) * 8;
              *(LAS u32x2*)(VT + e * 272 + g_ + perm4(d_)) = (u32x2){vr[i8].x, vr[i8].y}; *(LAS u32x2*)(VT + e * 272 + g_ + perm4(d_ + 4)) = (u32x2){vr[i8].z, vr[i8].w}; } }
        const int lbase = bh * LISTN + j * 16384 - 128 * j * (j + 1) + qstart;
        const int ntile = (qcount + 127) >> 7;
        int en0, en1, en2, en3;
        { const int q0 = 16 * w + fr, lim = qcount - 1;
          if (causal) { en0 = (j * 256 + q0) | (3 << 14); en1 = (j * 256 + q0 + 128) | (3 << 14); en2 = en1; en3 = en1; }
          else { en0 = list[lbase + (q0 < lim ? q0 : lim)]; en1 = list[lbase + (q0 + 128 < lim ? q0 + 128 : lim)]; en2 = list[lbase + (q0 + 256 < lim ? q0 + 256 : lim)]; en3 = list[lbase + (q0 + 384 < lim ? q0 + 384 : lim)]; } }
        bf16x8 Bq[4], Bn[4];
        { const bf16_t* qp = proj + (size_t)(b * TT + (en0 & 16383)) * NPJ + OFF_MQ + h * 128 + 8 * fq;
#pragma unroll
          for (int ks = 0; ks < 4; ++ks) Bq[ks] = *(const bf16x8*)(qp + 32 * ks); }
        __syncthreads();
        for (int tile = 0; tile < ntile; ++tile) {
            const int en = tile == 0 ? en0 : (tile == 1 ? en1 : (tile == 2 ? en2 : en3));
            { const int enx = tile == 0 ? en1 : (tile == 1 ? en2 : en3); const bf16_t* qp = proj + (size_t)(b * TT + (enx & 16383)) * NPJ + OFF_MQ + h * 128 + 8 * fq;
#pragma unroll
              for (int ks = 0; ks < 4; ++ks) Bn[ks] = *(const bf16x8*)(qp + 32 * ks); }
            const int qi = tile * 128 + 16 * w + fr; const bool valid = qi < qcount; const int t = en & 16383, slot = en >> 14;
            if (tile * 128 + 16 * w < qcount) {
            const int nkt = causal ? (8 * tile + w + 1) : 16;
            f32x4 st[16]; float mx = -INFINITY;
#pragma unroll
            for (int kp = 0; kp < 8; ++kp) { f32x4 a0 = {0.f, 0.f, 0.f, 0.f}, a1 = {0.f, 0.f, 0.f, 0.f};
                if (2 * kp < nkt) { bf16x8 kf[8];
#pragma unroll
                    for (int ks = 0; ks < 4; ++ks) { kf[ks] = *(const LAS bf16x8*)(KS + (32 * kp + fr) * 144 + 32 * ks + 8 * fq); kf[4 + ks] = *(const LAS bf16x8*)(KS + (32 * kp + 16 + fr) * 144 + 32 * ks + 8 * fq); }
#pragma unroll
                    for (int ks = 0; ks < 4; ++ks) { a0 = mfma16(kf[ks], Bq[ks], a0); a1 = mfma16(kf[4 + ks], Bq[ks], a1); }
#pragma unroll
                    for (int jj = 0; jj < 4; ++jj) { float s0 = a0[jj] * sc2, s1 = a1[jj] * sc2;
                        if (causal && (32 * kp + 4 * fq + jj) > qi) s0 = -INFINITY; if ((causal && (32 * kp + 16 + 4 * fq + jj) > qi) || 2 * kp + 1 >= nkt) s1 = -INFINITY;
                        a0[jj] = s0; a1[jj] = s1; mx = fmaxf(mx, fmaxf(s0, s1)); }
                } else { a0 = (f32x4){-INFINITY, -INFINITY, -INFINITY, -INFINITY}; a1 = a0; }
                st[2 * kp] = a0; st[2 * kp + 1] = a1; }
            mx = fmaxf(mx, __shfl_xor(mx, 16)); mx = fmaxf(mx, __shfl_xor(mx, 32));
            float ls = 0.f;
#pragma unroll
            for (int kt = 0; kt < 16; ++kt)
#pragma unroll
                for (int jj = 0; jj < 4; ++jj) { const float pv = exp2f(st[kt][jj] - mx); st[kt][jj] = pv; ls += pv; }
            ls += __shfl_xor(ls, 16); ls += __shfl_xor(ls, 32);
            f32x4 ot[8];
#pragma unroll
            for (int et = 0; et < 8; ++et) ot[et] = (f32x4){0.f, 0.f, 0.f, 0.f};
#pragma unroll
            for (int k2 = 0; k2 < 8; ++k2) { if (2 * k2 < nkt) { const bf16x8 pb = pack8(st[2 * k2], st[2 * k2 + 1]);
#pragma unroll
                    for (int eh = 0; eh < 2; ++eh) { bf16x8 vf[4];
#pragma unroll
                        for (int et = 0; et < 4; ++et) vf[et] = *(const LAS bf16x8*)(VT + (16 * (4 * eh + et) + fr) * 272 + 32 * k2 + 8 * fq);
#pragma unroll
                        for (int et = 0; et < 4; ++et) ot[4 * eh + et] = mfma16(vf[et], pb, ot[4 * eh + et]); } } }
            if (valid) { const float il = 1.f / ls; const size_t rid = (size_t)bh * TT + t; bf16_t* op = opart + ((size_t)slot * 262144 + rid) * 128 + 4 * fq;
#pragma unroll
                for (int et = 0; et < 8; ++et) { u32x2 wv; wv.x = pk2(ot[et][0] * il, ot[et][1] * il); wv.y = pk2(ot[et][2] * il, ot[et][3] * il); *(u32x2*)(op + 16 * et) = wv; }
                if (fq == 0) ML[(size_t)slot * 262144 + rid] = (f32x2){mx, ls}; }
            }
#pragma unroll
            for (int ks = 0; ks < 4; ++ks) Bq[ks] = Bn[ks];
        }
        __syncthreads();
    }
}

DI void phase_moba_combine(const Params& P) {
    const bf16_t* opart = (const bf16_t*)P.out; const f32x2* ML = (const f32x2*)(P.ws + WS_ML); bf16_t* mix = (bf16_t*)(P.ws + WS_R2);
    const int gtid = blockIdx.x * NTHREADS + opq_tid(), gsz = gridDim.x * NTHREADS;
    { const bf16_t* proj = (const bf16_t*)(P.ws + WS_R1);
      for (int i0 = gtid; i0 < MT * 128; i0 += 4 * gsz) { u32x4 mv[4], zv[4];
#pragma unroll
          for (int k = 0; k < 4; ++k) { const int i = i0 + k * gsz < MT * 128 ? i0 + k * gsz : i0; const int row = i >> 7, sg = i & 127; mv[k] = *(const u32x4*)(mix + (size_t)row * DM + sg * 8); zv[k] = *(const u32x4*)(proj + (size_t)row * NPJ + OFF_GZ + sg * 8); }
          const int sg0 = i0 & 127; const f32x4 g0 = *(const f32x4*)(P.gdn_norm + (sg0 & 15) * 8), g1 = *(const f32x4*)(P.gdn_norm + (sg0 & 15) * 8 + 4);
#pragma unroll
          for (int k = 0; k < 4; ++k) { const int i = i0 + k * gsz; const int row = i >> 7, sg = i & 127;
              float o[8]; o[0] = bflo(mv[k].x); o[1] = bfhi(mv[k].x); o[2] = bflo(mv[k].y); o[3] = bfhi(mv[k].y); o[4] = bflo(mv[k].z); o[5] = bfhi(mv[k].z); o[6] = bflo(mv[k].w); o[7] = bfhi(mv[k].w);
              float ssl = 0.f;
#pragma unroll
              for (int q = 0; q < 8; ++q) ssl += o[q] * o[q];
              const float rs = rsqrtf(row16_sum(ssl) * (1.f / 128.f) + 1e-6f); const u32x4 z = zv[k];
              u32x4 wv; wv.x = pk2(o[0] * rs * g0[0] * silu_f(bflo(z.x)), o[1] * rs * g0[1] * silu_f(bfhi(z.x))); wv.y = pk2(o[2] * rs * g0[2] * silu_f(bflo(z.y)), o[3] * rs * g0[3] * silu_f(bfhi(z.y)));
              wv.z = pk2(o[4] * rs * g1[0] * silu_f(bflo(z.z)), o[5] * rs * g1[1] * silu_f(bfhi(z.z))); wv.w = pk2(o[6] * rs * g1[2] * silu_f(bflo(z.w)), o[7] * rs * g1[3] * silu_f(bfhi(z.w)));
              if (i < MT * 128) *(u32x4*)(mix + (size_t)row * DM + sg * 8) = wv; } } }
    for (int i0 = gtid; i0 < 262144 * 16; i0 += 2 * gsz) {
        f32x2 ml[2][4]; u32x4 raw[2][4];
#pragma unroll
        for (int k = 0; k < 2; ++k) { const int i = i0 + k * gsz < 262144 * 16 ? i0 + k * gsz : i0; const int rid = i >> 4, sg = i & 15;
#pragma unroll
            for (int s = 0; s < 4; ++s) { ml[k][s] = ML[(size_t)s * 262144 + rid]; raw[k][s] = *(const u32x4*)(opart + ((size_t)s * 262144 + rid) * 128 + sg * 8); } }
#pragma unroll
        for (int k = 0; k < 2; ++k) { const int i = i0 + k * gsz; const int rid = i >> 4, sg = i & 15; const int bh = rid >> 14, t = rid & 16383, b = bh >> 3, h = bh & 7;
            float M = -INFINITY;
#pragma unroll
            for (int s = 0; s < 4; ++s) M = fmaxf(M, ml[k][s].x);
            float wgt[4], Lt = 0.f;
#pragma unroll
            for (int s = 0; s < 4; ++s) { wgt[s] = ml[k][s].y > 0.f ? ml[k][s].y * exp2f(ml[k][s].x - M) : 0.f; Lt += wgt[s]; }
            const float iL = 1.f / Lt; float o[8];
#pragma unroll
            for (int q = 0; q < 8; ++q) o[q] = 0.f;
#pragma unroll
            for (int s = 0; s < 4; ++s) { const float ww = wgt[s] * iL; const u32x4 r = raw[k][s];
                if (wgt[s] > 0.f) { o[0] += ww * bflo(r.x); o[1] += ww * bfhi(r.x); o[2] += ww * bflo(r.y); o[3] += ww * bfhi(r.y); o[4] += ww * bflo(r.z); o[5] += ww * bfhi(r.z); o[6] += ww * bflo(r.w); o[7] += ww * bfhi(r.w); } }
            u32x4 wv; wv.x = pk2(o[0], o[1]); wv.y = pk2(o[2], o[3]); wv.z = pk2(o[4], o[5]); wv.w = pk2(o[6], o[7]);
            if (i < 262144 * 16) *(u32x4*)(mix + (size_t)(b * TT + t) * DM + 1024 + h * 128 + sg * 8) = wv; } }
}

__global__ void __launch_bounds__(NTHREADS) hybrid_fwd(Params P) {
    extern __shared__ __attribute__((aligned(16))) unsigned char smem[];
    LAS unsigned char* lds = (LAS unsigned char*)smem;
    cg::grid_group grid = cg::this_grid();
    unsigned char* ws = P.ws; const int G = gridDim.x, bx = blockIdx.x;
    bf16_t* R0 = (bf16_t*)(ws + WS_R0); bf16_t* R1 = (bf16_t*)(ws + WS_R1); bf16_t* R2 = (bf16_t*)(ws + WS_R2);
    float* ss1 = (float*)(ws + WS_SS1); float* ss2 = (float*)(ws + WS_SS2);

    phase_prep(P, lds);
    grid.sync();
    { pg8::Gemm g{R0, (const bf16_t*)(ws + WS_WIN), MT, NPJ, DM}; pg8::StaticOrder S; S.init(MT, NPJ, G, bx); EpiProj E{R1, (bf16_t*)(ws + WS_HALO)}; pg8::gemm_phase<decltype(E), pg8::StaticOrder, true, true>(lds, g, S, E); }
    phase_ba(P);
    grid.sync();
    phase_gdn_prep(P, lds);
    phase_moba_prep(P, lds);
    grid.sync();
    phase_moba_select(P, lds);
    grid.sync();
    if (bx < 16) phase_gdn_scan(P, lds, bx);
    phase_moba_attn(P, lds);
    if (bx >= 16) phase_wconv_late(P, lds, bx - 16, G - 16);
    grid.sync();
    phase_moba_combine(P);
    grid.sync();
    { pg8::Gemm g{R2, (const bf16_t*)(ws + WS_WO), MT, DM, DM}; pg8::StaticOrder S; S.init(MT, DM, G, bx); EpiResid E{P.x, P.out, R0, ss1}; pg8::gemm_phase<decltype(E), pg8::StaticOrder, true, false>(lds, g, S, E); }
    grid.sync();
    { pg8::Gemm g{R0, (const bf16_t*)(ws + WS_WGU), MT, 2 * FF, DM}; pg8::StaticOrder S; S.init(MT, 2 * FF, G, bx); EpiAct E{R1, ss1}; pg8::gemm_phase<decltype(E), pg8::StaticOrder, true, true>(lds, g, S, E); }
    grid.sync();
    { pg8::Gemm g{(const bf16_t*)(ws + WS_PB), (const bf16_t*)(ws + WS_WPP), MT, DM, 256}; pg8::StaticOrder S; S.init(MT, DM, G, bx); EpiPlainBf16 E{R0, DM}; pg8::gemm_phase<decltype(E), pg8::StaticOrder, true, false>(lds, g, S, E); }
    { pg8::Gemm g{R1, (const bf16_t*)(ws + WS_WDN), MT, DM, FF}; pg8::StaticOrder S; S.init(MT, DM, G, bx); EpiResid E{P.out, P.out, R2, ss2}; pg8::gemm_phase<decltype(E), pg8::StaticOrder, true, false>(lds, g, S, E); }
    grid.sync();
    { pg8::Gemm g{R2, (const bf16_t*)(ws + WS_WPG), MT, DM, DM}; pg8::StaticOrder S; S.init(MT, DM, G, bx); EpiOut E{P.out, R0, ss2}; pg8::gemm_phase<decltype(E), pg8::StaticOrder, true, false>(lds, g, S, E); }
}

extern "C" void kernel_launch(void* const* d_in, const int* in_sizes, int n_in, void* d_out, int out_size, void* d_ws, size_t ws_size, hipStream_t stream) {
    static int grid_blocks = 0;
    if (!grid_blocks) {
        int dev = 0, cus = 0, per_cu = 0;
        hipGetDevice(&dev);
        hipDeviceGetAttribute(&cus, hipDeviceAttributeMultiprocessorCount, dev);
        hipFuncSetAttribute((const void*)hybrid_fwd, hipFuncAttributeMaxDynamicSharedMemorySize, LDS_BYTES);
        hipOccupancyMaxActiveBlocksPerMultiprocessor(&per_cu, (const void*)hybrid_fwd, NTHREADS, LDS_BYTES);
        if (per_cu < 1) per_cu = 1;
        grid_blocks = cus * per_cu;
        if (ws_size < WS_END) fprintf(stderr, "kernel_launch: workspace too small: %zu < %zu\n", ws_size, (size_t)WS_END);
    }
    Params p{};
    p.x = (const float*)d_in[0]; p.p = (const float*)d_in[1]; p.attn_norm = (const float*)d_in[2]; p.w_in = (const float*)d_in[3]; p.conv_w = (const float*)d_in[4];
    p.A_log = (const float*)d_in[5]; p.dt_bias = (const float*)d_in[6]; p.gdn_norm = (const float*)d_in[7]; p.q_norm = (const float*)d_in[8]; p.k_norm = (const float*)d_in[9];
    p.w_o = (const float*)d_in[10]; p.ffn_norm = (const float*)d_in[11]; p.w_gate = (const float*)d_in[12]; p.w_up = (const float*)d_in[13]; p.w_down = (const float*)d_in[14];
    p.ple_norm = (const float*)d_in[15]; p.w_pg = (const float*)d_in[16]; p.w_pp = (const float*)d_in[17];
    p.out = (float*)d_out; p.ws = (unsigned char*)d_ws;
    void* args[] = {&p};
    hipError_t e = hipLaunchCooperativeKernel((const void*)hybrid_fwd, dim3(grid_blocks), dim3(NTHREADS), args, LDS_BYTES, stream);
    if (e != hipSuccess) fprintf(stderr, "cooperative launch failed: %s (grid %d)\n", hipGetErrorString(e), grid_blocks);
}
```

```cpp
#include <hip/hip_runtime.h>
#include <hip/hip_cooperative_groups.h>
#include <cstdio>
namespace cg = cooperative_groups;

#define LAS __attribute__((address_space(3)))
#define DI __device__ __forceinline__
typedef unsigned short bf16_t;
typedef short bf16x8 __attribute__((ext_vector_type(8)));
typedef float f32x4 __attribute__((ext_vector_type(4)));
typedef float f32x2 __attribute__((ext_vector_type(2)));
typedef unsigned u32x4 __attribute__((ext_vector_type(4)));
typedef unsigned u32x2 __attribute__((ext_vector_type(2)));
typedef __bf16 bfv2 __attribute__((ext_vector_type(2)));

constexpr int DM = 2048, TT = 16384, MT = 32768, NPJ = 7168, FF = 5632, INW = 7184;
constexpr int OFF_GQ = 0, OFF_GK = 1024, OFF_GV = 2048, OFF_GZ = 3072, OFF_MQ = 4096, OFF_MK = 5120, OFF_MV = 6144;
constexpr int LISTN = 516096;
constexpr int NTHREADS = 512;
constexpr int LDS_BYTES = 163840;

constexpr size_t WS_CTL   = 0;
constexpr size_t WS_CNT   = 4096;
constexpr size_t WS_SS1   = 8192;
constexpr size_t WS_SS2   = WS_SS1 + 131072;
constexpr size_t WS_GL    = WS_SS2 + 131072;
constexpr size_t WS_KMEAN = WS_GL + 16384;
constexpr size_t WS_WBA   = WS_KMEAN + 524288;
constexpr size_t WS_BA    = WS_WBA + 65536;
constexpr size_t WS_WIN   = WS_BA + 2097152;
constexpr size_t WS_WO    = WS_WIN + (size_t)7168 * 2048 * 2;
constexpr size_t WS_WGU   = WS_WO + (size_t)2048 * 2048 * 2;
constexpr size_t WS_WDN   = WS_WGU + (size_t)11264 * 2048 * 2;
constexpr size_t WS_WPG   = WS_WDN + (size_t)2048 * 5632 * 2;
constexpr size_t WS_WPP   = WS_WPG + (size_t)2048 * 2048 * 2;
constexpr size_t WS_PB    = WS_WPP + (size_t)2048 * 256 * 2;
constexpr size_t WS_R0    = WS_PB + (size_t)32768 * 256 * 2;
constexpr size_t WS_R1    = WS_R0 + (size_t)32768 * 2048 * 2;
constexpr size_t WS_R2    = WS_R1 + (size_t)32768 * 7168 * 2;
constexpr size_t WS_W2    = WS_R2 + (size_t)32768 * 2048 * 2;
constexpr size_t WS_QKB   = WS_W2 + (size_t)32768 * 1024 * 2;
constexpr size_t WS_HALO  = WS_QKB + (size_t)4096 * 4096 * 2;
constexpr size_t WS_LIST  = WS_HALO + (size_t)513 * 3 * 3072 * 2 + 256 - ((size_t)513 * 3 * 3072 * 2) % 256;
constexpr size_t WS_ML    = WS_LIST + (size_t)16 * LISTN * 4;
constexpr size_t WS_SSQ   = WS_ML + (size_t)4 * 262144 * 8;
constexpr size_t WS_END   = WS_SSQ + (size_t)32768 * 64 * 4;

struct Params {
    const float* x; const float* p; const float* attn_norm; const float* w_in; const float* conv_w; const float* A_log; const float* dt_bias;
    const float* gdn_norm; const float* q_norm; const float* k_norm; const float* w_o; const float* ffn_norm; const float* w_gate; const float* w_up;
    const float* w_down; const float* ple_norm; const float* w_pg; const float* w_pp;
    float* out; unsigned char* ws;
};

DI unsigned pk2(float a, float b) { f32x2 v = {a, b}; bfv2 r = __builtin_convertvector(v, bfv2); return __builtin_bit_cast(unsigned, r); }
DI bf16_t f2bf(float a) { return (bf16_t)(pk2(a, 0.f) & 0xffffu); }
DI float bflo(unsigned w) { return __uint_as_float(w << 16); }
DI float bfhi(unsigned w) { return __uint_as_float(w & 0xffff0000u); }
DI float bf2f(bf16_t v) { return __uint_as_float(((unsigned)v) << 16); }
DI bf16x8 pack8(const f32x4& a, const f32x4& b) { u32x4 w; w.x = pk2(a[0], a[1]); w.y = pk2(a[2], a[3]); w.z = pk2(b[0], b[1]); w.w = pk2(b[2], b[3]); return __builtin_bit_cast(bf16x8, w); }
DI bf16x8 cat8(u32x2 lo, u32x2 hi) { u32x4 w; w.x = lo.x; w.y = lo.y; w.z = hi.x; w.w = hi.y; return __builtin_bit_cast(bf16x8, w); }
DI f32x4 mfma16(bf16x8 a, bf16x8 b, f32x4 c) { return __builtin_amdgcn_mfma_f32_16x16x32_bf16(a, b, c, 0, 0, 0); }
DI int perm4(int d4) { return d4 < 16 ? 2 * d4 : 2 * (d4 - 16) + 4; }
DI float dpp_f(float v, int ctrl_sel) { int x = __float_as_int(v); int r;
    if (ctrl_sel == 0) r = __builtin_amdgcn_mov_dpp(x, 0xB1, 0xf, 0xf, true); else if (ctrl_sel == 1) r = __builtin_amdgcn_mov_dpp(x, 0x4E, 0xf, 0xf, true);
    else if (ctrl_sel == 2) r = __builtin_amdgcn_mov_dpp(x, 0x141, 0xf, 0xf, true); else r = __builtin_amdgcn_mov_dpp(x, 0x140, 0xf, 0xf, true);
    return __int_as_float(r); }
DI float row16_sum(float v) { v += dpp_f(v, 0); v += dpp_f(v, 1); v += dpp_f(v, 2); v += dpp_f(v, 3); return v; }
DI float silu_f(float v) { return v * __builtin_amdgcn_rcpf(1.f + __expf(-v)); }
DI float sigm_f(float v) { return __builtin_amdgcn_rcpf(1.f + __expf(-v)); }

DI int opq_tid() { int t = threadIdx.x; asm volatile("" : "+v"(t)); return t; }

namespace pg8 {
constexpr int BM = 256, BK = 64, HALF = 128, HTB = HALF * BK * 2, STAGE_BYTES = 8 * HTB, NXCD = 8, WGM = 8;
DI int lds_byte(int r, int c) { const int st = (r >> 4) * 2 + (c >> 5), rr = r & 15, cc = c & 31, ob = rr * 64 + cc * 2; return st * 1024 + (ob ^ (((ob >> 9) & 1) << 5)); }
DI void stage_rc(int b, int& R, int& C) { const int st = b / 1024, sb = b % 1024, swz = sb ^ (((sb >> 9) & 1) << 5); R = (st >> 1) * 16 + swz / 64; C = (st & 1) * 32 + (swz % 64) / 2; }
DI int perm32(int rho) { const int n = rho >> 4, i = rho & 15; return 8 * (i >> 2) + 4 * n + (i & 3); }
struct Unit { int pm, pn; };
struct Gemm { const bf16_t* A; const bf16_t* Bt; int M, N, K; };
struct StaticOrder {
    int nM, nN, nwg, G, c;
    DI void init(int M, int N, int G_, int c_) { nM = M / BM; nN = N / BM; nwg = nM * nN; G = G_; c = c_; }
    DI bool next(int i, Unit& u) const {
        const long L = (long)i * G + c; if (L >= nwg) return false;
        int wgid = (int)L; { const int q = nwg / NXCD, r = nwg % NXCD, xcd = wgid % NXCD, off = wgid / NXCD; wgid = (xcd < r ? xcd * (q + 1) : r * (q + 1) + (xcd - r) * q) + off; }
        const int nig = WGM * nN, gid = wgid / nig, fm = gid * WGM, gsz = (nM - fm) < WGM ? (nM - fm) : WGM;
        u.pm = fm + ((wgid % nig) % gsz); u.pn = (wgid % nig) / gsz; return true;
    }
    DI void a_ready(const Unit&) const {}
    DI void done(const Unit&) const {}
};

template <class Epi, class Sched, bool ALIGN_EPI = false, bool SP2 = false>
DI void gemm_phase(LAS unsigned char* lds, const Gemm g, const Sched& S, const Epi& E) {
    const int tid = opq_tid(), wid = __builtin_amdgcn_readfirstlane(tid >> 6), lane = tid & 63, wr = wid >> 2, wc = wid & 3, fr = lane & 15, fq = lane >> 4;
    const int K = g.K, nt = K / BK;
    unsigned voffA[2], voffB[2];
#pragma unroll
    for (int i = 0; i < 2; ++i) { int R, C; stage_rc(tid * 16 + i * 8192, R, C); const int Rb = Epi::PERM ? ((R & ~31) + perm32(R & 31)) : R;
        voffA[i] = (unsigned)(R * K + C) * 2u; voffB[i] = (unsigned)(Rb * K + C) * 2u; }
    const size_t kstep = (size_t)(BK * 2);
    const size_t hstep = (size_t)HALF * K * 2;
    const size_t tstep = 2 * hstep;
    const unsigned ldsw = (unsigned)wid * 1024u;
    const int aoff = lds_byte(wr * 64 + fr, fq * 8), boff = lds_byte(wc * 32 + fr, fq * 8);
#define PG8_SA(b, h) (((b) * 2 + (h)) * HTB)
#define PG8_SB(b, h) ((4 + (b) * 2 + (h)) * HTB)
#define PG8_STAGE(bufoff, gbase, voff) do { _Pragma("unroll") for (int _i = 0; _i < 2; ++_i) \
        __builtin_amdgcn_global_load_lds((const unsigned*)((const char*)(gbase) + (voff)[_i]), (LAS unsigned*)(lds + (bufoff) + ldsw + _i * 8192), 16, 0, 0); } while (0)
#define PG8_LDA(dst, b, h) do { _Pragma("unroll") for (int m = 0; m < 4; ++m) _Pragma("unroll") for (int k = 0; k < 2; ++k) dst[m][k] = *(const LAS bf16x8*)(lds + PG8_SA(b, h) + aoff + m * 2048 + k * 1024); } while (0)
#define PG8_LDB(dst, b, h) do { _Pragma("unroll") for (int n = 0; n < 2; ++n) _Pragma("unroll") for (int k = 0; k < 2; ++k) dst[n][k] = *(const LAS bf16x8*)(lds + PG8_SB(b, h) + boff + n * 2048 + k * 1024); } while (0)
#define PG8_MMA(ai, bj, At, Bt) do { __builtin_amdgcn_s_setprio(1); _Pragma("unroll") for (int m = 0; m < 4; ++m) _Pragma("unroll") for (int n = 0; n < 2; ++n) _Pragma("unroll") for (int k = 0; k < 2; ++k) \
        acc[ai][bj][m][n] = __builtin_amdgcn_mfma_f32_16x16x32_bf16(Bt[n][k], At[m][k], acc[ai][bj][m][n], 0, 0, 0); __builtin_amdgcn_s_setprio(0); } while (0)
#define PG8_WAIT_V(n) asm volatile("s_waitcnt vmcnt(" #n ")" ::: "memory")
#define PG8_WAIT_L(n) asm volatile("s_waitcnt lgkmcnt(" #n ")" ::: "memory")
#define PG8_BAR __builtin_amdgcn_s_barrier()
#define PG8_SCHED __builtin_amdgcn_sched_barrier(0)
    Unit cur, nxt; int ui = 0;
    if (!S.next(0, cur)) return;
    f32x4 acc[2][2][4][2];
#pragma unroll
    for (int a = 0; a < 2; ++a)
#pragma unroll
        for (int b = 0; b < 2; ++b)
#pragma unroll
            for (int m = 0; m < 4; ++m)
#pragma unroll
                for (int n = 0; n < 2; ++n) acc[a][b][m][n] = (f32x4){0.f, 0.f, 0.f, 0.f};
    bf16x8 At[4][2], B0[2][2], B1[2][2];
    const char* cA = (const char*)g.A + (size_t)cur.pm * tstep; const char* cB = (const char*)g.Bt + (size_t)cur.pn * tstep;
    S.a_ready(cur);
    if constexpr (SP2) {
        PG8_STAGE(PG8_SB(0, 0), cB, voffB); PG8_STAGE(PG8_SB(0, 1), cB + hstep, voffB); PG8_STAGE(PG8_SA(0, 0), cA, voffA); PG8_STAGE(PG8_SA(0, 1), cA + hstep, voffA);
        if (wr == 1) PG8_BAR;
        PG8_WAIT_V(2); PG8_BAR;
        PG8_STAGE(PG8_SB(1, 0), cB + kstep, voffB); PG8_STAGE(PG8_SA(1, 0), cA + kstep, voffA); PG8_STAGE(PG8_SB(1, 1), cB + hstep + kstep, voffB);
        PG8_WAIT_V(6); PG8_BAR;
    } else {
        PG8_STAGE(PG8_SB(0, 0), cB, voffB); PG8_STAGE(PG8_SA(0, 0), cA, voffA); PG8_STAGE(PG8_SB(0, 1), cB + hstep, voffB); PG8_STAGE(PG8_SA(0, 1), cA + hstep, voffA);
        if (wr == 1) PG8_BAR;
        PG8_WAIT_V(4); PG8_BAR;
        PG8_STAGE(PG8_SB(1, 0), cB + kstep, voffB); PG8_STAGE(PG8_SA(1, 0), cA + kstep, voffA); PG8_STAGE(PG8_SB(1, 1), cB + hstep + kstep, voffB);
        PG8_WAIT_V(6); PG8_BAR;
    }
    for (;;) {
        const bool has_next = S.next(ui + 1, nxt);
        const char* nA = has_next ? (const char*)g.A + (size_t)nxt.pm * tstep : cA; const char* nB = has_next ? (const char*)g.Bt + (size_t)nxt.pn * tstep : cB;
        for (int t = 0; t < nt; t += 2) {
            const bool last = (t == nt - 2);
            const char* a1 = cA + (size_t)(t + 1) * kstep;
            const char* a2 = last ? nA : cA + (size_t)(t + 2) * kstep; const char* b2 = last ? nB : cB + (size_t)(t + 2) * kstep;
            const char* a3 = a2 + kstep; const char* b3 = b2 + kstep;
            if (last && has_next) S.a_ready(nxt);
            if constexpr (SP2) {
            PG8_LDB(B0, 0, 0); PG8_LDB(B1, 0, 1); PG8_SCHED; PG8_LDA(At, 0, 0); PG8_STAGE(PG8_SA(1, 1), a1 + hstep, voffA);
            PG8_WAIT_V(8); PG8_WAIT_L(0); PG8_BAR; PG8_MMA(0, 0, At, B0); PG8_MMA(0, 1, At, B1); PG8_BAR; PG8_SCHED;
            PG8_LDA(At, 0, 1); PG8_STAGE(PG8_SB(0, 0), b2, voffB); PG8_STAGE(PG8_SB(0, 1), b2 + hstep, voffB); PG8_STAGE(PG8_SA(0, 0), a2, voffA);
            PG8_WAIT_V(8); PG8_WAIT_L(0); PG8_BAR; PG8_MMA(1, 0, At, B0); PG8_MMA(1, 1, At, B1); PG8_BAR; PG8_SCHED;
            PG8_LDB(B0, 1, 0); PG8_LDB(B1, 1, 1); PG8_SCHED; PG8_LDA(At, 1, 0); PG8_STAGE(PG8_SA(0, 1), a2 + hstep, voffA);
            PG8_WAIT_V(8); PG8_WAIT_L(0); PG8_BAR; PG8_MMA(0, 0, At, B0); PG8_MMA(0, 1, At, B1); PG8_BAR; PG8_SCHED;
            PG8_LDA(At, 1, 1); PG8_STAGE(PG8_SB(1, 0), b3, voffB); PG8_STAGE(PG8_SB(1, 1), b3 + hstep, voffB); PG8_STAGE(PG8_SA(1, 0), a3, voffA);
            PG8_WAIT_V(8); PG8_WAIT_L(0); PG8_BAR; PG8_MMA(1, 0, At, B0); PG8_MMA(1, 1, At, B1); PG8_BAR; PG8_SCHED;
            } else {
            PG8_LDB(B0, 0, 0); PG8_SCHED; PG8_LDA(At, 0, 0); PG8_STAGE(PG8_SA(1, 1), a1 + hstep, voffA);
            PG8_WAIT_L(8); PG8_BAR; PG8_WAIT_L(0); PG8_MMA(0, 0, At, B0); PG8_BAR; PG8_SCHED;
            PG8_LDB(B1, 0, 1); PG8_STAGE(PG8_SB(0, 0), b2, voffB);
            PG8_BAR; PG8_WAIT_L(0); PG8_MMA(0, 1, At, B1); PG8_BAR;
            PG8_LDA(At, 0, 1); PG8_STAGE(PG8_SA(0, 0), a2, voffA);
            PG8_BAR; PG8_WAIT_L(0); PG8_MMA(1, 0, At, B0); PG8_BAR; PG8_SCHED;
            PG8_STAGE(PG8_SB(0, 1), b2 + hstep, voffB);
            PG8_WAIT_V(6); PG8_BAR; PG8_MMA(1, 1, At, B1); PG8_BAR;
            PG8_LDB(B0, 1, 0); PG8_SCHED; PG8_LDA(At, 1, 0); PG8_STAGE(PG8_SA(0, 1), a2 + hstep, voffA);
            PG8_WAIT_L(8); PG8_BAR; PG8_WAIT_L(0); PG8_MMA(0, 0, At, B0); PG8_BAR; PG8_SCHED;
            PG8_LDB(B1, 1, 1); PG8_STAGE(PG8_SB(1, 0), b3, voffB);
            PG8_BAR; PG8_WAIT_L(0); PG8_MMA(0, 1, At, B1); PG8_BAR;
            PG8_LDA(At, 1, 1); PG8_STAGE(PG8_SA(1, 0), a3, voffA);
            PG8_BAR; PG8_WAIT_L(0); PG8_MMA(1, 0, At, B0); PG8_BAR; PG8_SCHED;
            PG8_STAGE(PG8_SB(1, 1), b3 + hstep, voffB);
            PG8_WAIT_V(6); PG8_BAR; PG8_MMA(1, 1, At, B1); PG8_BAR;
            }
        }
        if constexpr (ALIGN_EPI) { if (wr == 0) PG8_BAR; }
        if constexpr (!Epi::AFTER_DRAIN) { E(acc, cur, wr, wc, fr, fq); S.done(cur); }
        if (!has_next) break;
#pragma unroll
        for (int a = 0; a < 2; ++a)
#pragma unroll
            for (int b = 0; b < 2; ++b)
#pragma unroll
                for (int m = 0; m < 4; ++m)
#pragma unroll
                    for (int n = 0; n < 2; ++n) acc[a][b][m][n] = (f32x4){0.f, 0.f, 0.f, 0.f};
        cur = nxt; cA = nA; cB = nB; ++ui;
        if constexpr (ALIGN_EPI) { if (wr == 1) PG8_BAR; }
    }
    PG8_WAIT_V(0);
    if constexpr (!ALIGN_EPI) { if (wr == 0) PG8_BAR; }
    PG8_BAR;
    if constexpr (Epi::AFTER_DRAIN) { E.fused(acc, cur, wr, wc, fr, fq, lds, wid, lane); S.done(cur); }
#undef PG8_SA
#undef PG8_SB
#undef PG8_STAGE
#undef PG8_LDA
#undef PG8_LDB
#undef PG8_MMA
#undef PG8_WAIT_V
#undef PG8_WAIT_L
#undef PG8_BAR
#undef PG8_SCHED
}
}
using pg8::Unit;

struct EpiProj {
    static constexpr bool PERM = true, AFTER_DRAIN = false;
    bf16_t* O; bf16_t* halo;
    DI void operator()(const f32x4 (&acc)[2][2][4][2], const Unit& u, int wr, int wc, int fr, int fq) const {
        const int row0 = u.pm * 256 + wr * 64 + fr, col0 = u.pn * 256 + wc * 32 + 8 * fq;
#pragma unroll
        for (int ai = 0; ai < 2; ++ai)
#pragma unroll
            for (int m = 0; m < 4; ++m) { const int row = row0 + ai * 128 + m * 16; bf16_t* rowp = O + (size_t)row * NPJ + col0;
#pragma unroll
                for (int bj = 0; bj < 2; ++bj) { const f32x4 v0 = acc[ai][bj][m][0], v1 = acc[ai][bj][m][1];
                    u32x4 w; w.x = pk2(v0[0], v0[1]); w.y = pk2(v0[2], v0[3]); w.z = pk2(v1[0], v1[1]); w.w = pk2(v1[2], v1[3]);
                    *(u32x4*)(rowp + bj * 128) = w;
                    if (m == 3 && fr >= 13 && u.pn < 12) *(u32x4*)(halo + ((size_t)((row >> 6) + 1) * 3 + (fr - 13)) * 3072 + col0 + bj * 128) = w; } }
    }
};
struct EpiPlainBf16 {
    static constexpr bool PERM = true, AFTER_DRAIN = false;
    bf16_t* O; int ldc;
    DI void operator()(const f32x4 (&acc)[2][2][4][2], const Unit& u, int wr, int wc, int fr, int fq) const {
        const int row0 = u.pm * 256 + wr * 64 + fr, col0 = u.pn * 256 + wc * 32 + 8 * fq;
#pragma unroll
        for (int ai = 0; ai < 2; ++ai)
#pragma unroll
            for (int m = 0; m < 4; ++m) { bf16_t* rowp = O + (size_t)(row0 + ai * 128 + m * 16) * ldc + col0;
#pragma unroll
                for (int bj = 0; bj < 2; ++bj) { const f32x4 v0 = acc[ai][bj][m][0], v1 = acc[ai][bj][m][1];
                    u32x4 w; w.x = pk2(v0[0], v0[1]); w.y = pk2(v0[2], v0[3]); w.z = pk2(v1[0], v1[1]); w.w = pk2(v1[2], v1[3]);
                    *(u32x4*)(rowp + bj * 128) = w; } }
    }
};
struct EpiResid {
    static constexpr bool PERM = false, AFTER_DRAIN = false;
    const float* base; float* out; bf16_t* hb; float* ss;
    DI void operator()(const f32x4 (&acc)[2][2][4][2], const Unit& u, int wr, int wc, int fr, int fq) const {
        const int row0 = u.pm * 256 + wr * 64 + fr, col0 = u.pn * 256 + wc * 32 + 4 * fq;
#pragma unroll
        for (int ai = 0; ai < 2; ++ai) { f32x4 bs[4][4];
#pragma unroll
            for (int m = 0; m < 4; ++m)
#pragma unroll
                for (int q = 0; q < 4; ++q) bs[m][q] = *(const f32x4*)(base + (size_t)(row0 + ai * 128 + m * 16) * DM + col0 + (q >> 1) * 128 + (q & 1) * 16);
#pragma unroll
            for (int m = 0; m < 4; ++m) { const int row = row0 + ai * 128 + m * 16; const size_t off = (size_t)row * DM + col0; float s = 0.f;
#pragma unroll
                for (int q = 0; q < 4; ++q) { const f32x4 hv = bs[m][q] + acc[ai][q >> 1][m][q & 1];
                        *(f32x4*)(out + off + (q >> 1) * 128 + (q & 1) * 16) = hv; u32x2 w; w.x = pk2(hv[0], hv[1]); w.y = pk2(hv[2], hv[3]);
                        *(u32x2*)(hb + off + (q >> 1) * 128 + (q & 1) * 16) = w; s += (hv[0] * hv[0] + hv[1] * hv[1]) + (hv[2] * hv[2] + hv[3] * hv[3]); }
                s += __shfl_xor(s, 16); s += __shfl_xor(s, 32);
                if (fq == 0) atomicAdd(ss + row, s); }
            asm volatile("" ::: "memory"); }
    }
};
struct EpiAct {
    static constexpr bool PERM = true, AFTER_DRAIN = false;
    bf16_t* O; const float* ss;
    DI void operator()(const f32x4 (&acc)[2][2][4][2], const Unit& u, int wr, int wc, int fr, int fq) const {
        const int row0 = u.pm * 256 + wr * 64 + fr, col0 = u.pn * 128 + wc * 32 + 8 * fq;
        float rs[8];
#pragma unroll
        for (int g = 0; g < 8; ++g) rs[g] = ss[row0 + (g >> 2) * 128 + (g & 3) * 16];
#pragma unroll
        for (int ai = 0; ai < 2; ++ai)
#pragma unroll
            for (int m = 0; m < 4; ++m) { const int row = row0 + ai * 128 + m * 16; const float r = rsqrtf(rs[ai * 4 + m] * (1.f / 2048.f) + 1e-6f);
                float a[8];
#pragma unroll
                for (int n = 0; n < 2; ++n)
#pragma unroll
                    for (int j = 0; j < 4; ++j) { const float gv = r * acc[ai][0][m][n][j], uv = r * acc[ai][1][m][n][j]; a[n * 4 + j] = silu_f(gv) * uv; }
                u32x4 w; w.x = pk2(a[0], a[1]); w.y = pk2(a[2], a[3]); w.z = pk2(a[4], a[5]); w.w = pk2(a[6], a[7]);
                *(u32x4*)(O + (size_t)row * FF + col0) = w; }
    }
};
struct EpiOut {
    static constexpr bool PERM = false, AFTER_DRAIN = false;
    float* out; const bf16_t* pp; const float* ss;
    DI void operator()(const f32x4 (&acc)[2][2][4][2], const Unit& u, int wr, int wc, int fr, int fq) const {
        const int row0 = u.pm * 256 + wr * 64 + fr, col0 = u.pn * 256 + wc * 32 + 4 * fq;
        float rs[8];
#pragma unroll
        for (int g = 0; g < 8; ++g) rs[g] = ss[row0 + (g >> 2) * 128 + (g & 3) * 16];
#pragma unroll
        for (int ai = 0; ai < 2; ++ai)
#pragma unroll
            for (int m = 0; m < 4; ++m) { const int row = row0 + ai * 128 + m * 16; const size_t off = (size_t)row * DM + col0; const float r = rsqrtf(rs[ai * 4 + m] * (1.f / 2048.f) + 1e-6f);
                f32x4 hv[4]; u32x2 pw[4];
#pragma unroll
                for (int q = 0; q < 4; ++q) { hv[q] = *(const f32x4*)(out + off + (q >> 1) * 128 + (q & 1) * 16); pw[q] = *(const u32x2*)(pp + off + (q >> 1) * 128 + (q & 1) * 16); }
#pragma unroll
                for (int q = 0; q < 4; ++q) { const f32x4 a = acc[ai][q >> 1][m][q & 1]; f32x4 o;
                        o[0] = hv[q][0] + sigm_f(r * a[0]) * bflo(pw[q].x); o[1] = hv[q][1] + sigm_f(r * a[1]) * bfhi(pw[q].x);
                        o[2] = hv[q][2] + sigm_f(r * a[2]) * bflo(pw[q].y); o[3] = hv[q][3] + sigm_f(r * a[3]) * bfhi(pw[q].y);
                        *(f32x4*)(out + off + (q >> 1) * 128 + (q & 1) * 16) = o; }
                asm volatile("" ::: "memory"); }
    }
};

DI void tconv_tile(const float* __restrict__ src, int ld, int c0, int k0, bf16_t* __restrict__ dst, int dK, int n0, const float* __restrict__ nw, LAS float* tl) {
    const int tid = opq_tid();
    f32x4 v[8];
#pragma unroll
    for (int i = 0; i < 8; ++i) v[i] = *(const f32x4*)(src + (size_t)(k0 + (tid >> 4) + 32 * i) * ld + c0 + (tid & 15) * 4);
#pragma unroll
    for (int i = 0; i < 8; ++i) { const int k = (tid >> 4) + 32 * i; const float sc = nw ? nw[k0 + k] : 1.f;
        LAS float* q = tl + k * 65 + (tid & 15) * 4; q[0] = v[i][0] * sc; q[1] = v[i][1] * sc; q[2] = v[i][2] * sc; q[3] = v[i][3] * sc; }
    __syncthreads();
    { const int n = tid >> 3, kq = (tid & 7) * 8;
#pragma unroll
      for (int j = 0; j < 4; ++j) { const int ks = kq + 64 * j; float f[8];
#pragma unroll
          for (int i = 0; i < 8; ++i) f[i] = tl[(ks + i) * 65 + n];
          u32x4 w; w.x = pk2(f[0], f[1]); w.y = pk2(f[2], f[3]); w.z = pk2(f[4], f[5]); w.w = pk2(f[6], f[7]);
          *(u32x4*)(dst + (size_t)(n0 + n) * dK + k0 + ks) = w; } }
    __syncthreads();
}

DI void phase_prep(const Params& P, LAS unsigned char* lds) {
    unsigned char* ws = P.ws; const int tid = opq_tid(), G = gridDim.x, bx = blockIdx.x;
    const int gtid = bx * NTHREADS + tid, gsz = G * NTHREADS;
    for (int i = gtid; i < (int)((WS_GL - WS_CTL) / 4); i += gsz) ((unsigned*)(ws + WS_CTL))[i] = 0u;
    { bf16_t* wba = (bf16_t*)(ws + WS_WBA); for (int i = gtid; i < 16 * 2048; i += gsz) { const int n = i >> 11, k = i & 2047; wba[i] = f2bf(P.w_in[(size_t)k * INW + 4096 + n]); } }
    { bf16_t* pb = (bf16_t*)(ws + WS_PB); for (int i = gtid; i < MT * 256 / 8; i += gsz) { const f32x4 a = *(const f32x4*)(P.p + (size_t)i * 8), b = *(const f32x4*)(P.p + (size_t)i * 8 + 4);
        u32x4 w; w.x = pk2(a[0], a[1]); w.y = pk2(a[2], a[3]); w.z = pk2(b[0], b[1]); w.w = pk2(b[2], b[3]); *(u32x4*)(pb + (size_t)i * 8) = w; } }
    { bf16_t* xn = (bf16_t*)(ws + WS_R0); const int lane = tid & 63, gw = bx * 8 + (tid >> 6);
      f32x4 wv[8];
#pragma unroll
      for (int i = 0; i < 8; ++i) wv[i] = *(const f32x4*)(P.attn_norm + lane * 4 + i * 256);
      for (int row = gw * 2; row < MT; row += G * 16) { const float* xr = P.x + (size_t)row * DM; f32x4 v[2][8]; float s0 = 0.f, s1 = 0.f;
#pragma unroll
          for (int r = 0; r < 2; ++r)
#pragma unroll
              for (int i = 0; i < 8; ++i) v[r][i] = *(const f32x4*)(xr + (size_t)r * DM + lane * 4 + i * 256);
#pragma unroll
          for (int i = 0; i < 8; ++i) { s0 += (v[0][i][0] * v[0][i][0] + v[0][i][1] * v[0][i][1]) + (v[0][i][2] * v[0][i][2] + v[0][i][3] * v[0][i][3]);
              s1 += (v[1][i][0] * v[1][i][0] + v[1][i][1] * v[1][i][1]) + (v[1][i][2] * v[1][i][2] + v[1][i][3] * v[1][i][3]); }
#pragma unroll
          for (int o = 1; o < 64; o <<= 1) { s0 += __shfl_xor(s0, o); s1 += __shfl_xor(s1, o); }
          const float r0 = rsqrtf(s0 * (1.f / 2048.f) + 1e-6f), r1 = rsqrtf(s1 * (1.f / 2048.f) + 1e-6f);
#pragma unroll
          for (int r = 0; r < 2; ++r)
#pragma unroll
              for (int i = 0; i < 8; ++i) { const float rr = r ? r1 : r0; u32x2 w; w.x = pk2(v[r][i][0] * rr * wv[i][0], v[r][i][1] * rr * wv[i][1]); w.y = pk2(v[r][i][2] * rr * wv[i][2], v[r][i][3] * rr * wv[i][3]);
                  *(u32x2*)(xn + (size_t)(row + r) * DM + lane * 4 + i * 256) = w; } } }
    LAS float* tl = (LAS float*)lds;
    for (int gi = bx; gi < 896; gi += G) { const int nt = gi >> 3, kg = gi & 7, n0 = nt * 64; tconv_tile(P.w_in, INW, n0 < 4096 ? n0 : n0 + 16, kg * 256, (bf16_t*)(ws + WS_WIN), 2048, n0, nullptr, tl); }
}
DI void phase_wconv_late(const Params& P, LAS unsigned char* lds, int wg0, int nwg) {
    unsigned char* ws = P.ws; LAS float* tl = (LAS float*)lds;
    for (int gi = 896 + wg0; gi < 3552; gi += nwg) {
        if (gi < 1152) { const int t2 = gi - 896, nt = t2 >> 3, kg = t2 & 7; tconv_tile(P.w_o, 2048, nt * 64, kg * 256, (bf16_t*)(ws + WS_WO), 2048, nt * 64, nullptr, tl); }
        else if (gi < 2560) { const int t2 = gi - 1152, nt = t2 >> 3, kg = t2 & 7, n0 = nt * 64, pn = n0 >> 8, r = n0 & 255;
            tconv_tile(r < 128 ? P.w_gate : P.w_up, FF, pn * 128 + (r & 127), kg * 256, (bf16_t*)(ws + WS_WGU), 2048, n0, P.ffn_norm, tl); }
        else if (gi < 3264) { const int t2 = gi - 2560, nt = t2 / 22, kg = t2 % 22; tconv_tile(P.w_down, 2048, nt * 64, kg * 256, (bf16_t*)(ws + WS_WDN), FF, nt * 64, nullptr, tl); }
        else if (gi < 3520) { const int t2 = gi - 3264, nt = t2 >> 3, kg = t2 & 7; tconv_tile(P.w_pg, 2048, nt * 64, kg * 256, (bf16_t*)(ws + WS_WPG), 2048, nt * 64, P.ple_norm, tl); }
        else { const int nt = gi - 3520; tconv_tile(P.w_pp, 2048, nt * 64, 0, (bf16_t*)(ws + WS_WPP), 256, nt * 64, nullptr, tl); }
    }
}

DI void phase_ba(const Params& P) {
    const int tid = opq_tid(), lane = tid & 63, fr = lane & 15, fq = lane >> 4, gw = blockIdx.x * 8 + (tid >> 6);
    const bf16_t* xn = (const bf16_t*)(P.ws + WS_R0); const bf16_t* wba = (const bf16_t*)(P.ws + WS_WBA); float* BA = (float*)(P.ws + WS_BA);
    for (int rt = gw; rt < MT / 16; rt += gridDim.x * 8) {
        f32x4 acc = {0.f, 0.f, 0.f, 0.f}; const bf16_t* ap = xn + (size_t)(rt * 16 + fr) * DM + 8 * fq; const bf16_t* bp = wba + fr * 2048 + 8 * fq;
#pragma unroll 16
        for (int ks = 0; ks < 64; ++ks) acc = mfma16(*(const bf16x8*)(ap + 32 * ks), *(const bf16x8*)(bp + 32 * ks), acc);
#pragma unroll
        for (int j = 0; j < 4; ++j) BA[(size_t)(rt * 16 + 4 * fq + j) * 16 + fr] = acc[j];
    }
}

constexpr int G1_QS = 0, G1_KS = 18432, G1_VT = 36864, G1_KT = 57344, G1_SM = 77824, G1_TEAM = 78848;
DI void phase_gdn_prep(const Params& P, LAS unsigned char* lds) {
    const int tid0 = opq_tid(), team = tid0 >> 8;
    LAS unsigned char* L = lds + team * G1_TEAM;
    LAS bf16_t* QS = (LAS bf16_t*)(L + G1_QS); LAS bf16_t* KS = (LAS bf16_t*)(L + G1_KS); LAS bf16_t* VT = (LAS bf16_t*)(L + G1_VT); LAS bf16_t* KT = (LAS bf16_t*)(L + G1_KT);
    LAS float* AF = (LAS float*)(L + G1_QS); LAS bf16_t* TB = (LAS bf16_t*)(L + G1_KS); LAS float* SM = (LAS float*)(L + G1_SM);
    bf16_t* proj = (bf16_t*)(P.ws + WS_R1); const bf16_t* halo = (const bf16_t*)(P.ws + WS_HALO); const float* BA = (const float*)(P.ws + WS_BA);
    bf16_t* W2 = (bf16_t*)(P.ws + WS_W2); bf16_t* QKB = (bf16_t*)(P.ws + WS_QKB); float* GL = (float*)(P.ws + WS_GL);
    for (int pi = blockIdx.x; pi < 2048; pi += gridDim.x) {
        int tid = tid0; asm volatile("" : "+v"(tid));
        const int tt = tid & 255, tw = __builtin_amdgcn_readfirstlane((tid >> 6) & 3), lane = tid & 63, fr = lane & 15, fq = lane >> 4;
        const int ci = pi * 2 + team, h = ci & 7, n = (ci >> 3) & 255, b = ci >> 11, t0 = b * TT + n * 64;
        if (tw == 0) {
            const float bv = BA[(size_t)(t0 + lane) * 16 + h], av = BA[(size_t)(t0 + lane) * 16 + 8 + h];
            const float beta = sigm_f(bv); const float xx = av + P.dt_bias[h]; const float sp = xx > 20.f ? xx : log1pf(__expf(xx));
            const float gg = -__expf(P.A_log[h]) * sp; float gc = gg;
#pragma unroll
            for (int o = 1; o < 64; o <<= 1) { const float v = __shfl_up(gc, o); if (lane >= o) gc += v; }
            const float glast = __shfl(gc, 63);
            SM[lane] = gc; SM[64 + lane] = beta; SM[128 + lane] = __expf(gc); SM[192 + lane] = __expf(glast - gc);
            if (lane == 63) GL[(b * 8 + h) * 256 + n] = __expf(gc);
        }
        __syncthreads();
        { const int r = tt >> 2, cg0 = (tt & 3) * 32; const float beta_r = SM[64 + r], egc_r = SM[128 + r];
#pragma unroll 1
          for (int x = 0; x < 3; ++x) {
              float val[32]; const int colbase = x * 1024 + h * 128 + cg0;
              u32x4 rawa[4][4];
#pragma unroll
              for (int sg = 0; sg < 4; ++sg) { const int col = colbase + sg * 8;
#pragma unroll
                  for (int j = 0; j < 4; ++j) { const int rr = r - 3 + j; rawa[sg][j] = (u32x4){0u, 0u, 0u, 0u};
                      if (rr >= 0) rawa[sg][j] = *(const u32x4*)(proj + (size_t)(t0 + rr) * NPJ + col);
                      else if (n > 0) rawa[sg][j] = *(const u32x4*)(halo + ((size_t)(t0 >> 6) * 3 + (rr + 3)) * 3072 + col); } }
#pragma unroll
              for (int sg = 0; sg < 4; ++sg) { const int col = colbase + sg * 8;
#pragma unroll
                  for (int i = 0; i < 8; ++i) { const f32x4 w4 = *(const f32x4*)(P.conv_w + (size_t)(col + i) * 4); float a = 0.f;
#pragma unroll
                      for (int j = 0; j < 4; ++j) { const unsigned wd = rawa[sg][j][i >> 1]; const float xv = (i & 1) ? bfhi(wd) : bflo(wd); a += w4[j] * xv; }
                      val[sg * 8 + i] = silu_f(a); } }
              if (x < 2) { float ss = 0.f;
#pragma unroll
                  for (int i = 0; i < 32; ++i) ss += val[i] * val[i];
                  ss += __shfl_xor(ss, 1); ss += __shfl_xor(ss, 2);
                  const float sc = rsqrtf(ss + 1e-6f) * (x == 0 ? 0.08838834764831845f : 1.f);
#pragma unroll
                  for (int i = 0; i < 32; ++i) val[i] *= sc; }
              if (x < 2) { LAS bf16_t* dst = (x == 0 ? QS : KS) + r * 144 + cg0;
#pragma unroll
                  for (int i = 0; i < 4; ++i) { u32x4 w; w.x = pk2(val[8 * i], val[8 * i + 1]); w.y = pk2(val[8 * i + 2], val[8 * i + 3]); w.z = pk2(val[8 * i + 4], val[8 * i + 5]); w.w = pk2(val[8 * i + 6], val[8 * i + 7]);
                      *(LAS u32x4*)(dst + 8 * i) = w; } }
              if (x == 1) { const float f = beta_r * egc_r;
#pragma unroll
                  for (int i = 0; i < 32; ++i) KT[(cg0 + i) * 80 + r] = f2bf(val[i] * f); }
              if (x == 2) {
#pragma unroll
                  for (int i = 0; i < 32; ++i) VT[(cg0 + i) * 80 + r] = f2bf(val[i] * beta_r); }
          } }
        __syncthreads();
        f32x4 kk[4], qk[4];
#pragma unroll
        for (int nt = 0; nt < 4; ++nt) { kk[nt] = (f32x4){0.f, 0.f, 0.f, 0.f}; qk[nt] = (f32x4){0.f, 0.f, 0.f, 0.f}; }
#pragma unroll
        for (int ks = 0; ks < 4; ++ks) { const bf16x8 ak = *(const LAS bf16x8*)(KS + (16 * tw + fr) * 144 + 32 * ks + 8 * fq), aq = *(const LAS bf16x8*)(QS + (16 * tw + fr) * 144 + 32 * ks + 8 * fq);
#pragma unroll
            for (int nt = 0; nt < 4; ++nt) { const bf16x8 bk = *(const LAS bf16x8*)(KS + (16 * nt + fr) * 144 + 32 * ks + 8 * fq); kk[nt] = mfma16(ak, bk, kk[nt]); qk[nt] = mfma16(aq, bk, qk[nt]); } }
        { const int r = tt >> 2, cg0 = (tt & 3) * 32; const float e = SM[128 + r];
#pragma unroll
          for (int i = 0; i < 4; ++i) { const u32x4 s = *(const LAS u32x4*)(QS + r * 144 + cg0 + 8 * i); u32x4 w;
              w.x = pk2(bflo(s.x) * e, bfhi(s.x) * e); w.y = pk2(bflo(s.y) * e, bfhi(s.y) * e); w.z = pk2(bflo(s.z) * e, bfhi(s.z) * e); w.w = pk2(bflo(s.w) * e, bfhi(s.w) * e);
              *(u32x4*)(proj + (size_t)(t0 + r) * NPJ + OFF_GQ + h * 128 + cg0 + 8 * i) = w; } }
        { const int d = tt >> 1, cb = (tt & 1) * 32;
#pragma unroll
          for (int i4 = 0; i4 < 4; ++i4) { const int c0 = cb + 8 * i4; float f[8];
#pragma unroll
              for (int i = 0; i < 8; ++i) f[i] = bf2f(KS[(c0 + i) * 144 + d]) * SM[192 + c0 + i];
              u32x4 w; w.x = pk2(f[0], f[1]); w.y = pk2(f[2], f[3]); w.z = pk2(f[4], f[5]); w.w = pk2(f[6], f[7]);
              *(u32x4*)(proj + (size_t)(t0 + (d >> 1)) * NPJ + OFF_GK + h * 128 + (d & 1) * 64 + c0) = w; } }
        __syncthreads();
#pragma unroll
        for (int nt = 0; nt < 4; ++nt)
#pragma unroll
            for (int j = 0; j < 4; ++j) { const int c = 16 * tw + 4 * fq + j, s = 16 * nt + fr; const float dec = (s <= c) ? __expf(SM[c] - SM[s]) : 0.f;
                AF[c * 65 + s] = (s < c) ? SM[64 + c] * kk[nt][j] * dec : (s == c ? 1.f : 0.f);
                QKB[(size_t)ci * 4096 + c * 64 + s] = f2bf(qk[nt][j] * dec); }
        __syncthreads();
        { const int bb = tw * 16;
          if (lane < 16) {
              for (int i = 1; i < 16; ++i) { float a0 = 0.f, a1 = 0.f; int j = 0;
                  for (; j + 2 <= i; j += 2) { a0 += AF[(bb + i) * 65 + bb + j] * AF[(bb + j) * 65 + bb + lane]; a1 += AF[(bb + i) * 65 + bb + j + 1] * AF[(bb + j + 1) * 65 + bb + lane]; }
                  if (j < i) a0 += AF[(bb + i) * 65 + bb + j] * AF[(bb + j) * 65 + bb + lane];
                  AF[(bb + i) * 65 + bb + lane] = lane < i ? -(a0 + a1) : (lane == i ? 1.f : 0.f); } }
#pragma unroll
          for (int k = 0; k < 4; ++k) { const int row = bb + fq + 4 * k; TB[row * 80 + bb + fr] = f2bf(AF[row * 65 + bb + fr]);
              for (int jb = tw + 1; jb < 4; ++jb) TB[row * 80 + 16 * jb + fr] = (bf16_t)0; }
          __syncthreads();
          for (int i = 1; i < 4; ++i) {
              if (tw < i) { const int j = tw; f32x4 X = {0.f, 0.f, 0.f, 0.f};
                  for (int k = j; k < i; ++k) {
#pragma unroll
                      for (int kk = 0; kk < 4; ++kk) { const float av = AF[(16 * i + fr) * 65 + 16 * k + 4 * kk + fq];
                          const float bv = (k == j) ? AF[(16 * k + 4 * kk + fq) * 65 + 16 * j + fr] : bf2f(TB[(16 * k + 4 * kk + fq) * 80 + 16 * j + fr]);
                          X = __builtin_amdgcn_mfma_f32_16x16x4f32(av, bv, X, 0, 0, 0); } }
                  f32x4 O = {0.f, 0.f, 0.f, 0.f};
#pragma unroll
                  for (int kk = 0; kk < 4; ++kk) O = __builtin_amdgcn_mfma_f32_16x16x4f32(AF[(16 * i + fr) * 65 + 16 * i + 4 * fq + kk], X[kk], O, 0, 0, 0);
#pragma unroll
                  for (int jj = 0; jj < 4; ++jj) TB[(16 * i + 4 * fq + jj) * 80 + 16 * j + fr] = f2bf(-O[jj]); }
              __syncthreads(); }
        }
        { bf16x8 at[2];
#pragma unroll
          for (int ks = 0; ks < 2; ++ks) at[ks] = *(const LAS bf16x8*)(TB + (16 * tw + fr) * 80 + 32 * ks + 8 * fq);
#pragma unroll
          for (int nt = 0; nt < 8; ++nt) { f32x4 a = {0.f, 0.f, 0.f, 0.f};
#pragma unroll
              for (int ks = 0; ks < 2; ++ks) a = mfma16(at[ks], *(const LAS bf16x8*)(VT + (16 * nt + fr) * 80 + 32 * ks + 8 * fq), a);
              const int e = 16 * nt + fr; u32x2 w; w.x = pk2(a[0], a[1]); w.y = pk2(a[2], a[3]);
              *(u32x2*)(proj + (size_t)(t0 + (e >> 1)) * NPJ + OFF_GV + h * 128 + (e & 1) * 64 + 16 * tw + 4 * fq) = w; }
#pragma unroll
          for (int mt = 0; mt < 8; ++mt) { f32x4 a = {0.f, 0.f, 0.f, 0.f};
#pragma unroll
              for (int ks = 0; ks < 2; ++ks) a = mfma16(*(const LAS bf16x8*)(KT + (16 * mt + fr) * 80 + 32 * ks + 8 * fq), at[ks], a);
              u32x2 w; w.x = pk2(a[0], a[1]); w.y = pk2(a[2], a[3]);
              *(u32x2*)(W2 + (size_t)(t0 + 16 * tw + fr) * 1024 + h * 128 + 16 * mt + 4 * fq) = w; } }
        __syncthreads();
    }
}

DI void phase_moba_prep(const Params& P, LAS unsigned char* lds) {
    const int tid = opq_tid(), lane = tid & 63, wave = tid >> 6, l16 = lane & 15;
    bf16_t* proj = (bf16_t*)(P.ws + WS_R1); float* kmean = (float*)(P.ws + WS_KMEAN);
    LAS bf16_t* VS = (LAS bf16_t*)lds; LAS float* CS = (LAS float*)(lds + 69632);
    for (int task = blockIdx.x; task < 1024; task += gridDim.x) {
        const int h = task & 7, blk = (task >> 3) & 63, b = task >> 9; const size_t rbase = (size_t)(b * TT + blk * 256);
        f32x4 qg0 = *(const f32x4*)(P.q_norm + l16 * 8), qg1 = *(const f32x4*)(P.q_norm + l16 * 8 + 4), kg0 = *(const f32x4*)(P.k_norm + l16 * 8), kg1 = *(const f32x4*)(P.k_norm + l16 * 8 + 4);
        float cs[8];
#pragma unroll
        for (int i = 0; i < 8; ++i) cs[i] = 0.f;
        u32x4 rq[8], rk[8], rv[8];
#pragma unroll
        for (int ps = 0; ps < 8; ++ps) { const int r = ps * 32 + wave * 4 + (lane >> 4); const bf16_t* rp = proj + (rbase + r) * NPJ + h * 128 + l16 * 8;
            rq[ps] = *(const u32x4*)(rp + OFF_MQ); rk[ps] = *(const u32x4*)(rp + OFF_MK); rv[ps] = *(const u32x4*)(rp + OFF_MV); }
#pragma unroll
        for (int ps = 0; ps < 8; ++ps) { const int r = ps * 32 + wave * 4 + (lane >> 4); bf16_t* rp = proj + (rbase + r) * NPJ + h * 128 + l16 * 8;
#pragma unroll
            for (int x = 0; x < 2; ++x) { bf16_t* ptr = rp + (x == 0 ? OFF_MQ : OFF_MK); const u32x4 raw = x == 0 ? rq[ps] : rk[ps]; float v[8];
                v[0] = bflo(raw.x); v[1] = bfhi(raw.x); v[2] = bflo(raw.y); v[3] = bfhi(raw.y); v[4] = bflo(raw.z); v[5] = bfhi(raw.z); v[6] = bflo(raw.w); v[7] = bfhi(raw.w);
                float ss = 0.f;
#pragma unroll
                for (int i = 0; i < 8; ++i) ss += v[i] * v[i];
                ss = row16_sum(ss);
                const float rs = rsqrtf(ss * (1.f / 128.f) + 1e-6f); const f32x4 g0 = x == 0 ? qg0 : kg0, g1 = x == 0 ? qg1 : kg1;
#pragma unroll
                for (int i = 0; i < 4; ++i) { v[i] *= rs * g0[i]; v[4 + i] *= rs * g1[i]; }
                if (x == 1) {
#pragma unroll
                    for (int i = 0; i < 8; ++i) cs[i] += v[i]; }
                u32x4 w; w.x = pk2(v[0], v[1]); w.y = pk2(v[2], v[3]); w.z = pk2(v[4], v[5]); w.w = pk2(v[6], v[7]); *(u32x4*)ptr = w; }
            *(LAS u32x4*)(VS + r * 136 + l16 * 8) = rv[ps]; }
#pragma unroll
        for (int i = 0; i < 8; ++i) { cs[i] += __shfl_xor(cs[i], 16); cs[i] += __shfl_xor(cs[i], 32); }
        if (lane < 16) {
#pragma unroll
            for (int i = 0; i < 8; ++i) CS[wave * 128 + lane * 8 + i] = cs[i]; }
        __syncthreads();
        if (tid < 128) { float s = 0.f;
#pragma unroll
            for (int w = 0; w < 8; ++w) s += CS[w * 128 + tid];
            kmean[((size_t)(b * 8 + h) * 64 + blk) * 128 + tid] = s * (1.f / 256.f); }
#pragma unroll 2
        for (int i8 = 0; i8 < 8; ++i8) { const int pid = tid + i8 * 512, e = (pid & 63) + 64 * (pid >> 11), ks = (pid >> 6) & 31; unsigned short f[8];
#pragma unroll
            for (int i = 0; i < 8; ++i) f[i] = VS[(ks * 8 + i) * 136 + e];
            u32x4 w; w.x = f[0] | ((unsigned)f[1] << 16); w.y = f[2] | ((unsigned)f[3] << 16); w.z = f[4] | ((unsigned)f[5] << 16); w.w = f[6] | ((unsigned)f[7] << 16);
            *(u32x4*)(proj + (rbase + 2 * e + (ks >> 4)) * NPJ + OFF_MV + h * 128 + (ks & 15) * 8) = w; }
        __syncthreads();
    }
}

DI void phase_moba_select(const Params& P, LAS unsigned char* lds) {
    const int tid = opq_tid(), qi = tid >> 1, half = tid & 1;
    const bf16_t* proj = (const bf16_t*)(P.ws + WS_R1); const float* kmean = (const float*)(P.ws + WS_KMEAN);
    int* cnt = (int*)(P.ws + WS_CNT); int* list = (int*)(P.ws + WS_LIST); f32x2* ML = (f32x2*)(P.ws + WS_ML);
    LAS float* KM = (LAS float*)lds; LAS int* hist = (LAS int*)(lds + 32768); LAS int* hbase = (LAS int*)(lds + 32768 + 256);
    for (int task = blockIdx.x; task < 1024; task += gridDim.x) {
        const int tk = task >> 8, tw_ = task & 255, bhx = (tw_ >> 6) * 4 + tk, blk = (tk & 1) ? 63 - (tw_ & 63) : (tw_ & 63), h = bhx & 7, b = bhx >> 3; const int bh = b * 8 + h; const int t = blk * 256 + qi; const size_t rid = (size_t)bh * TT + t;
        for (int i = tid; i < blk * 128; i += NTHREADS) KM[i] = kmean[(size_t)bh * 64 * 128 + i];
        if (tid < 64) hist[tid] = 0;
        float q[64];
        { const bf16_t* qp = proj + (size_t)(b * TT + t) * NPJ + OFF_MQ + h * 128 + half * 64;
#pragma unroll
          for (int i = 0; i < 8; ++i) { const u32x4 raw = *(const u32x4*)(qp + 8 * i); q[8 * i] = bflo(raw.x); q[8 * i + 1] = bfhi(raw.x); q[8 * i + 2] = bflo(raw.y); q[8 * i + 3] = bfhi(raw.y);
              q[8 * i + 4] = bflo(raw.z); q[8 * i + 5] = bfhi(raw.z); q[8 * i + 6] = bflo(raw.w); q[8 * i + 7] = bfhi(raw.w); } }
        __syncthreads();
        float v0 = -INFINITY, v1 = -INFINITY, v2 = -INFINITY; int i0 = -1, i1 = -1, i2 = -1;
        for (int n = 0; n < blk; ++n) { const LAS float* km = KM + n * 128 + half * 64; float d0 = 0.f, d1 = 0.f, d2 = 0.f, d3 = 0.f;
#pragma unroll
            for (int i = 0; i < 16; ++i) { const f32x4 kv = *(const LAS f32x4*)(km + 4 * i); d0 += q[4 * i] * kv[0]; d1 += q[4 * i + 1] * kv[1]; d2 += q[4 * i + 2] * kv[2]; d3 += q[4 * i + 3] * kv[3]; }
            float g = (d0 + d1) + (d2 + d3); g += __shfl_xor(g, 1);
            if (g > v0) { v2 = v1; i2 = i1; v1 = v0; i1 = i0; v0 = g; i0 = n; } else if (g > v1) { v2 = v1; i2 = i1; v1 = g; i1 = n; } else if (g > v2) { v2 = g; i2 = n; } }
        int rk0 = 0, rk1 = 0, rk2 = 0;
        if (half == 0) { if (i0 >= 0) rk0 = __hip_atomic_fetch_add(&hist[i0], 1, __ATOMIC_RELAXED, __HIP_MEMORY_SCOPE_WORKGROUP); if (i1 >= 0) rk1 = __hip_atomic_fetch_add(&hist[i1], 1, __ATOMIC_RELAXED, __HIP_MEMORY_SCOPE_WORKGROUP); if (i2 >= 0) rk2 = __hip_atomic_fetch_add(&hist[i2], 1, __ATOMIC_RELAXED, __HIP_MEMORY_SCOPE_WORKGROUP); }
        __syncthreads();
        if (tid < 64) { const int c = hist[tid]; hbase[tid] = c > 0 ? atomicAdd(&cnt[bh * 64 + tid], c) : 0; }
        __syncthreads();
        if (half == 0) {
            const f32x2 dead = {-INFINITY, 0.f};
            if (i0 >= 0) list[(size_t)bh * LISTN + i0 * 16384 - 128 * i0 * (i0 + 1) + hbase[i0] + rk0] = t; else ML[0 * 262144 + rid] = dead;
            if (i1 >= 0) list[(size_t)bh * LISTN + i1 * 16384 - 128 * i1 * (i1 + 1) + hbase[i1] + rk1] = t | (1 << 14); else ML[1 * 262144 + rid] = dead;
            if (i2 >= 0) list[(size_t)bh * LISTN + i2 * 16384 - 128 * i2 * (i2 + 1) + hbase[i2] + rk2] = t | (2 << 14); else ML[2 * 262144 + rid] = dead;
        }
        __syncthreads();
    }
}

constexpr int G2_W = 0, G2_Q = 18432, G2_QK = 36864, G2_KD = 47104, G2_BUF = 67584, G2_RED = 135168;
DI void phase_gdn_scan(const Params& P, LAS unsigned char* lds, int bh) {
    const int tid = opq_tid(), lane = tid & 63, w = tid >> 6, fr = lane & 15, fq = lane >> 4, b = bh >> 3, h = bh & 7;
    const bf16_t* proj = (const bf16_t*)(P.ws + WS_R1); const bf16_t* W2 = (const bf16_t*)(P.ws + WS_W2); const bf16_t* QKB = (const bf16_t*)(P.ws + WS_QKB);
    const float* GL = (const float*)(P.ws + WS_GL); bf16_t* mix = (bf16_t*)(P.ws + WS_R2);
    float* SSQ = (float*)(P.ws + WS_SSQ);
    const int e = 16 * w + fr; const float gnw = P.gdn_norm[e];
    f32x4 S[8];
#pragma unroll
    for (int i = 0; i < 8; ++i) S[i] = (f32x4){0.f, 0.f, 0.f, 0.f};
    const int wrow0 = tid >> 4, wseg = tid & 15;
    const int qrow = tid >> 3, qseg = tid & 7;
    struct Stage { u32x4 sw[2], sq[2], sqk, skd[2]; };
    u32x2 un[4];
    Stage stA, stB;
#define G2_LOAD(X, nn) do { const int t0_ = b * TT + (nn) * 64; const int ci_ = ((b * 256 + (nn)) << 3) + h; \
        _Pragma("unroll") for (int i_ = 0; i_ < 2; ++i_) { X.sw[i_] = *(const u32x4*)(W2 + (size_t)(t0_ + wrow0 + 32 * i_) * 1024 + h * 128 + wseg * 8); \
            X.sq[i_] = *(const u32x4*)(proj + (size_t)(t0_ + wrow0 + 32 * i_) * NPJ + OFF_GQ + h * 128 + wseg * 8); \
            const int d_ = qrow + 64 * i_; X.skd[i_] = *(const u32x4*)(proj + (size_t)(t0_ + (d_ >> 1)) * NPJ + OFF_GK + h * 128 + (d_ & 1) * 64 + qseg * 8); } \
        X.sqk = *(const u32x4*)(QKB + (size_t)ci_ * 4096 + qrow * 64 + qseg * 8); } while (0)
#define UN_LOAD(nn) do { const int t0_ = b * TT + (nn) * 64; _Pragma("unroll") for (int mt_ = 0; mt_ < 4; ++mt_) un[mt_] = *(const u32x2*)(proj + (size_t)(t0_ + (e >> 1)) * NPJ + OFF_GV + h * 128 + (e & 1) * 64 + 16 * mt_ + 4 * fq); } while (0)
#define G2_ST2(base_, rowoff_, sg_, v_) do { const int g_ = ((sg_) >> 2) * 64, d_ = ((sg_) & 3) * 8; \
        *(LAS u32x2*)(B_ + (base_) + (rowoff_) + g_ + perm4(d_) * 2) = (u32x2){(v_).x, (v_).y}; *(LAS u32x2*)(B_ + (base_) + (rowoff_) + g_ + perm4(d_ + 4) * 2) = (u32x2){(v_).z, (v_).w}; } while (0)
#define G2_STORE(X, bufi) do { LAS unsigned char* B_ = lds + (bufi) * G2_BUF; \
        _Pragma("unroll") for (int i_ = 0; i_ < 2; ++i_) { G2_ST2(G2_W, (wrow0 + 32 * i_) * 288, wseg, X.sw[i_]); G2_ST2(G2_Q, (wrow0 + 32 * i_) * 288, wseg, X.sq[i_]); \
            G2_ST2(G2_KD, (qrow + 64 * i_) * 160, qseg, X.skd[i_]); } \
        G2_ST2(G2_QK, qrow * 160, qseg, X.sqk); } while (0)
    G2_LOAD(stA, 0); G2_STORE(stA, 0); UN_LOAD(0);
    float egl_n = GL[bh * 256];
    u32x2 uc[4];
#pragma unroll
    for (int i = 0; i < 4; ++i) uc[i] = un[i];
    G2_LOAD(stA, 1);
    __syncthreads();
    for (int n2 = 0; n2 < 256; n2 += 2) {
#pragma unroll
      for (int hf2 = 0; hf2 < 2; ++hf2) {
        const int n = n2 + hf2; Stage& LDs = hf2 ? stA : stB; Stage& STs = hf2 ? stB : stA;
        const int cur = hf2, t0 = b * TT + n * 64; LAS unsigned char* Bf = lds + cur * G2_BUF;
        { const int n2c = n + 2 < 256 ? n + 2 : 255, n1c = n + 1 < 256 ? n + 1 : 255; G2_LOAD(LDs, n2c); UN_LOAD(n1c); }
        const float egl = egl_n; egl_n = GL[bh * 256 + (n + 1 < 256 ? n + 1 : 255)];
        f32x4 Pm[4], Om[4];
#pragma unroll
        for (int mt = 0; mt < 4; ++mt) { Pm[mt] = (f32x4){0.f, 0.f, 0.f, 0.f}; Om[mt] = (f32x4){0.f, 0.f, 0.f, 0.f}; }
#define SBAR __builtin_amdgcn_sched_barrier(0)
#define LD_K4(dst, base_, ks_) do { const int o0_ = fr * 288 + (32 * (ks_) + 8 * fq) * 2; \
        dst[0] = *(const LAS bf16x8*)(Bf + base_ + o0_); dst[1] = *(const LAS bf16x8*)(Bf + base_ + o0_ + 4608); \
        dst[2] = *(const LAS bf16x8*)(Bf + base_ + o0_ + 9216); dst[3] = *(const LAS bf16x8*)(Bf + base_ + o0_ + 13824); } while (0)
#define MM_K4(src, sb_, A_) do { A_[0] = mfma16(src[0], sb_, A_[0]); A_[1] = mfma16(src[1], sb_, A_[1]); A_[2] = mfma16(src[2], sb_, A_[2]); A_[3] = mfma16(src[3], sb_, A_[3]); } while (0)
#define LD_R4(dst, base_, r0_, k2_) do { const int o0_ = (16 * (r0_) + fr) * 160 + (32 * (k2_) + 8 * fq) * 2; \
        dst[0] = *(const LAS bf16x8*)(Bf + base_ + o0_); dst[1] = *(const LAS bf16x8*)(Bf + base_ + o0_ + 2560); \
        dst[2] = *(const LAS bf16x8*)(Bf + base_ + o0_ + 5120); dst[3] = *(const LAS bf16x8*)(Bf + base_ + o0_ + 7680); } while (0)
#define MM_R4(src, vb_, A0_, A1_, A2_, A3_) do { A0_ = mfma16(src[0], vb_, A0_); A1_ = mfma16(src[1], vb_, A1_); A2_ = mfma16(src[2], vb_, A2_); A3_ = mfma16(src[3], vb_, A3_); } while (0)
        bf16x8 fa[4], fb[4];
        LD_K4(fa, G2_W, 0);
        const bf16x8 sb0 = pack8(S[0], S[1]), sb1 = pack8(S[2], S[3]), sb2 = pack8(S[4], S[5]), sb3 = pack8(S[6], S[7]);
        LD_K4(fb, G2_W, 1); SBAR; MM_K4(fa, sb0, Pm); SBAR;
        LD_K4(fa, G2_W, 2); SBAR; MM_K4(fb, sb1, Pm); SBAR;
        LD_K4(fb, G2_W, 3); SBAR; MM_K4(fa, sb2, Pm); SBAR;
        LD_K4(fa, G2_Q, 0); SBAR; MM_K4(fb, sb3, Pm); SBAR;
        f32x4 vn[4];
#pragma unroll
        for (int mt = 0; mt < 4; ++mt) { vn[mt][0] = bflo(uc[mt].x) - Pm[mt][0]; vn[mt][1] = bfhi(uc[mt].x) - Pm[mt][1]; vn[mt][2] = bflo(uc[mt].y) - Pm[mt][2]; vn[mt][3] = bfhi(uc[mt].y) - Pm[mt][3]; }
        bf16x8 Vb[2];
#pragma unroll
        for (int k2 = 0; k2 < 2; ++k2) Vb[k2] = pack8(vn[2 * k2], vn[2 * k2 + 1]);
        LD_K4(fb, G2_Q, 1); SBAR; MM_K4(fa, sb0, Om); SBAR;
        LD_K4(fa, G2_Q, 2); SBAR; MM_K4(fb, sb1, Om); SBAR;
        LD_K4(fb, G2_Q, 3); SBAR; MM_K4(fa, sb2, Om); SBAR;
        LD_R4(fa, G2_QK, 0, 0); SBAR; MM_K4(fb, sb3, Om); SBAR;
#pragma unroll
        for (int dt = 0; dt < 8; ++dt) S[dt] = S[dt] * egl;
        SBAR;
        LD_R4(fb, G2_QK, 0, 1); SBAR; MM_R4(fa, Vb[0], Om[0], Om[1], Om[2], Om[3]); SBAR;
        LD_R4(fa, G2_KD, 0, 0); SBAR; MM_R4(fb, Vb[1], Om[0], Om[1], Om[2], Om[3]); SBAR;
        LD_R4(fb, G2_KD, 0, 1); SBAR; MM_R4(fa, Vb[0], S[0], S[1], S[2], S[3]); SBAR;
        LD_R4(fa, G2_KD, 4, 0); SBAR; MM_R4(fb, Vb[1], S[0], S[1], S[2], S[3]); SBAR;
        LD_R4(fb, G2_KD, 4, 1); SBAR; MM_R4(fa, Vb[0], S[4], S[5], S[6], S[7]); SBAR;
        MM_R4(fb, Vb[1], S[4], S[5], S[6], S[7]); SBAR;
#undef LD_K4
#undef MM_K4
#undef LD_R4
#undef MM_R4
#undef SBAR
        { G2_STORE(STs, cur ^ 1);
#pragma unroll
            for (int i = 0; i < 4; ++i) uc[i] = un[i]; }
        { LAS bf16_t* OTW = (LAS bf16_t*)(lds + G2_RED + w * 2048);
#pragma unroll
          for (int mt = 0; mt < 4; ++mt)
#pragma unroll
            for (int j = 0; j < 4; ++j) OTW[(16 * mt + 4 * fq + j) * 16 + fr] = f2bf(Om[mt][j]);
#pragma unroll
          for (int i = 0; i < 2; ++i) { const int row = (lane >> 1) + 32 * i, hv = lane & 1;
              bf16_t* mp_ = mix + (size_t)(t0 + row) * DM + h * 128 + 16 * w + 8 * hv; const u32x4 ov_ = *(const LAS u32x4*)(OTW + row * 16 + hv * 8);
              asm volatile("global_store_dwordx4 %0, %1, off" :: "v"(mp_), "v"(ov_) : "memory"); } }
        __syncthreads();
      }
    }
#undef G2_LOAD
#undef UN_LOAD
#undef G2_STORE
#undef G2_ST2
    asm volatile("s_waitcnt vmcnt(0)" ::: "memory");
    __syncthreads();
}

constexpr int AT_KS = 0, AT_VT = 73728, AT_PF = 143360, AT_MISC = 147712;
DI void phase_moba_attn(const Params& P, LAS unsigned char* lds) {
    const int tid = opq_tid(), lane = tid & 63, w = tid >> 6, fr = lane & 15, fq = lane >> 4;
    const bf16_t* proj = (const bf16_t*)(P.ws + WS_R1); const int* cnt = (const int*)(P.ws + WS_CNT); const int* list = (const int*)(P.ws + WS_LIST);
    f32x2* ML = (f32x2*)(P.ws + WS_ML); bf16_t* opart = (bf16_t*)P.out; unsigned* workctr = (unsigned*)(P.ws + WS_CTL);
    LAS bf16_t* KS = (LAS bf16_t*)(lds + AT_KS); LAS bf16_t* VT = (LAS bf16_t*)(lds + AT_VT); LAS int* PF = (LAS int*)(lds + AT_PF); LAS int* MISC = (LAS int*)(lds + AT_MISC);
    { const int c0 = cnt[2 * tid], c1 = cnt[2 * tid + 1]; const int a = (c0 + 511) >> 9, bsum = a + ((c1 + 511) >> 9); int inc = bsum;
#pragma unroll
      for (int o = 1; o < 64; o <<= 1) { const int v = __shfl_up(inc, o); if (lane >= o) inc += v; }
      if (lane == 63) MISC[8 + w] = inc;
      __syncthreads();
      int wb = 0;
#pragma unroll
      for (int i = 0; i < 8; ++i) wb += (i < w) ? MISC[8 + i] : 0;
      const int ex = wb + inc - bsum; PF[2 * tid] = ex; PF[2 * tid + 1] = ex + a; if (tid == 511) PF[1024] = ex + bsum;
      __syncthreads(); }
    const int totalG = PF[1024];
    const float sc2 = 0.08838834764831845f * 1.4426950408889634f;
    const int tid_at = tid;
    for (;;) {
        int tid = tid_at; asm volatile("" : "+v"(tid)); const int lane = tid & 63, w = __builtin_amdgcn_readfirstlane(tid >> 6), fr = lane & 15, fq = lane >> 4;
        if (tid == 0) MISC[0] = (int)atomicAdd(workctr, 1u);
        __syncthreads();
        const int wid = MISC[0];
        __syncthreads();
        if (wid >= totalG + 1024) break;
        int bh, j, causal, qstart, qcount;
        if (wid < totalG) { int lo = 0, hi = 1024; while (hi - lo > 1) { const int mid = (lo + hi) >> 1; if (PF[mid] <= wid) lo = mid; else hi = mid; }
            bh = lo >> 6; j = lo & 63; causal = 0; qstart = (wid - PF[lo]) * 512; const int c = cnt[lo]; qcount = c - qstart; if (qcount > 512) qcount = 512; }
        else { const int o = wid - totalG; bh = o >> 6; j = o & 63; causal = 1; qstart = 0; qcount = 256; }
        const int b = bh >> 3, h = bh & 7; const size_t kbase = (size_t)(b * TT + j * 256);
        { u32x4 kr[8], vr[8];
#pragma unroll
          for (int i8 = 0; i8 < 8; ++i8) { const int pid = tid + i8 * 512; kr[i8] = *(const u32x4*)(proj + (kbase + (pid >> 4)) * NPJ + OFF_MK + h * 128 + (pid & 15) * 8);
              const int e = pid >> 5, ks = pid & 31; vr[i8] = *(const u32x4*)(proj + (kbase + 2 * e + (ks >> 4)) * NPJ + OFF_MV + h * 128 + (ks & 15) * 8); }
#pragma unroll
          for (int i8 = 0; i8 < 8; ++i8) { const int pid = tid + i8 * 512; *(LAS u32x4*)(KS + (pid >> 4) * 144 + (pid & 15) * 8) = kr[i8];
              const int e = pid >> 5, ks = pid & 31; const int g_ = (ks >> 2) * 32, d_ = (ks & 3) * 8;
              *(LAS u32x2*)(VT + e * 272 + g_ + perm4(d_)) = (u32x2){vr[i8].x, vr[i8].y}; *(LAS u32x2*)(VT + e * 272 + g_ + perm4(d_ + 4)) = (u32x2){vr[i8].z, vr[i8].w}; } }
        const int lbase = bh * LISTN + j * 16384 - 128 * j * (j + 1) + qstart;
        const int ntile = (qcount + 127) >> 7;
        int en0, en1, en2, en3;
        { const int q0 = 16 * w + fr, lim = qcount - 1;
          if (causal) { en0 = (j * 256 + q0) | (3 << 14); en1 = (j * 256 + q0 + 128) | (3 << 14); en2 = en1; en3 = en1; }
          else { en0 = list[lbase + (q0 < lim ? q0 : lim)]; en1 = list[lbase + (q0 + 128 < lim ? q0 + 128 : lim)]; en2 = list[lbase + (q0 + 256 < lim ? q0 + 256 : lim)]; en3 = list[lbase + (q0 + 384 < lim ? q0 + 384 : lim)]; } }
        bf16x8 Bq[4], Bn[4];
        { const bf16_t* qp = proj + (size_t)(b * TT + (en0 & 16383)) * NPJ + OFF_MQ + h * 128 + 8 * fq;
#pragma unroll
          for (int ks = 0; ks < 4; ++ks) Bq[ks] = *(const bf16x8*)(qp + 32 * ks); }
        __syncthreads();
        for (int tile = 0; tile < ntile; ++tile) {
            const int en = tile == 0 ? en0 : (tile == 1 ? en1 : (tile == 2 ? en2 : en3));
            { const int enx = tile == 0 ? en1 : (tile == 1 ? en2 : en3); const bf16_t* qp = proj + (size_t)(b * TT + (enx & 16383)) * NPJ + OFF_MQ + h * 128 + 8 * fq;
#pragma unroll
              for (int ks = 0; ks < 4; ++ks) Bn[ks] = *(const bf16x8*)(qp + 32 * ks); }
            const int qi = tile * 128 + 16 * w + fr; const bool valid = qi < qcount; const int t = en & 16383, slot = en >> 14;
            if (tile * 128 + 16 * w < qcount) {
            const int nkt = causal ? (8 * tile + w + 1) : 16;
            f32x4 st[16]; float mx = -INFINITY;
#pragma unroll
            for (int kp = 0; kp < 8; ++kp) { f32x4 a0 = {0.f, 0.f, 0.f, 0.f}, a1 = {0.f, 0.f, 0.f, 0.f};
                if (2 * kp < nkt) { bf16x8 kf[8];
#pragma unroll
                    for (int ks = 0; ks < 4; ++ks) { kf[ks] = *(const LAS bf16x8*)(KS + (32 * kp + fr) * 144 + 32 * ks + 8 * fq); kf[4 + ks] = *(const LAS bf16x8*)(KS + (32 * kp + 16 + fr) * 144 + 32 * ks + 8 * fq); }
#pragma unroll
                    for (int ks = 0; ks < 4; ++ks) { a0 = mfma16(kf[ks], Bq[ks], a0); a1 = mfma16(kf[4 + ks], Bq[ks], a1); }
#pragma unroll
                    for (int jj = 0; jj < 4; ++jj) { float s0 = a0[jj] * sc2, s1 = a1[jj] * sc2;
                        if (causal && (32 * kp + 4 * fq + jj) > qi) s0 = -INFINITY; if ((causal && (32 * kp + 16 + 4 * fq + jj) > qi) || 2 * kp + 1 >= nkt) s1 = -INFINITY;
                        a0[jj] = s0; a1[jj] = s1; mx = fmaxf(mx, fmaxf(s0, s1)); }
                } else { a0 = (f32x4){-INFINITY, -INFINITY, -INFINITY, -INFINITY}; a1 = a0; }
                st[2 * kp] = a0; st[2 * kp + 1] = a1; }
            mx = fmaxf(mx, __shfl_xor(mx, 16)); mx = fmaxf(mx, __shfl_xor(mx, 32));
            float ls = 0.f;
#pragma unroll
            for (int kt = 0; kt < 16; ++kt)
#pragma unroll
                for (int jj = 0; jj < 4; ++jj) { const float pv = exp2f(st[kt][jj] - mx); st[kt][jj] = pv; ls += pv; }
            ls += __shfl_xor(ls, 16); ls += __shfl_xor(ls, 32);
            f32x4 ot[8];
#pragma unroll
            for (int et = 0; et < 8; ++et) ot[et] = (f32x4){0.f, 0.f, 0.f, 0.f};
#pragma unroll
            for (int k2 = 0; k2 < 8; ++k2) { if (2 * k2 < nkt) { const bf16x8 pb = pack8(st[2 * k2], st[2 * k2 + 1]);
#pragma unroll
                    for (int eh = 0; eh < 2; ++eh) { bf16x8 vf[4];
#pragma unroll
                        for (int et = 0; et < 4; ++et) vf[et] = *(const LAS bf16x8*)(VT + (16 * (4 * eh + et) + fr) * 272 + 32 * k2 + 8 * fq);
#pragma unroll
                        for (int et = 0; et < 4; ++et) ot[4 * eh + et] = mfma16(vf[et], pb, ot[4 * eh + et]); } } }
            if (valid) { const float il = 1.f / ls; const size_t rid = (size_t)bh * TT + t; bf16_t* op = opart + ((size_t)slot * 262144 + rid) * 128 + 4 * fq;
#pragma unroll
                for (int et = 0; et < 8; ++et) { u32x2 wv; wv.x = pk2(ot[et][0] * il, ot[et][1] * il); wv.y = pk2(ot[et][2] * il, ot[et][3] * il); *(u32x2*)(op + 16 * et) = wv; }
                if (fq == 0) ML[(size_t)slot * 262144 + rid] = (f32x2){mx, ls}; }
            }
#pragma unroll
            for (int ks = 0; ks < 4; ++ks) Bq[ks] = Bn[ks];
        }
        __syncthreads();
    }
}

DI void phase_moba_combine(const Params& P) {
    const bf16_t* opart = (const bf16_t*)P.out; const f32x2* ML = (const f32x2*)(P.ws + WS_ML); bf16_t* mix = (bf16_t*)(P.ws + WS_R2);
    const int gtid = blockIdx.x * NTHREADS + opq_tid(), gsz = gridDim.x * NTHREADS;
    { const bf16_t* proj = (const bf16_t*)(P.ws + WS_R1);
      for (int i0 = gtid; i0 < MT * 128; i0 += 4 * gsz) { u32x4 mv[4], zv[4];
#pragma unroll
          for (int k = 0; k < 4; ++k) { const int i = i0 + k * gsz < MT * 128 ? i0 + k * gsz : i0; const int row = i >> 7, sg = i & 127; mv[k] = *(const u32x4*)(mix + (size_t)row * DM + sg * 8); zv[k] = *(const u32x4*)(proj + (size_t)row * NPJ + OFF_GZ + sg * 8); }
          const int sg0 = i0 & 127; const f32x4 g0 = *(const f32x4*)(P.gdn_norm + (sg0 & 15) * 8), g1 = *(const f32x4*)(P.gdn_norm + (sg0 & 15) * 8 + 4);
#pragma unroll
          for (int k = 0; k < 4; ++k) { const int i = i0 + k * gsz; const int row = i >> 7, sg = i & 127;
              float o[8]; o[0] = bflo(mv[k].x); o[1] = bfhi(mv[k].x); o[2] = bflo(mv[k].y); o[3] = bfhi(mv[k].y); o[4] = bflo(mv[k].z); o[5] = bfhi(mv[k].z); o[6] = bflo(mv[k].w); o[7] = bfhi(mv[k].w);
              float ssl = 0.f;
#pragma unroll
              for (int q = 0; q < 8; ++q) ssl += o[q] * o[q];
              const float rs = rsqrtf(row16_sum(ssl) * (1.f / 128.f) + 1e-6f); const u32x4 z = zv[k];
              u32x4 wv; wv.x = pk2(o[0] * rs * g0[0] * silu_f(bflo(z.x)), o[1] * rs * g0[1] * silu_f(bfhi(z.x))); wv.y = pk2(o[2] * rs * g0[2] * silu_f(bflo(z.y)), o[3] * rs * g0[3] * silu_f(bfhi(z.y)));
              wv.z = pk2(o[4] * rs * g1[0] * silu_f(bflo(z.z)), o[5] * rs * g1[1] * silu_f(bfhi(z.z))); wv.w = pk2(o[6] * rs * g1[2] * silu_f(bflo(z.w)), o[7] * rs * g1[3] * silu_f(bfhi(z.w)));
              if (i < MT * 128) *(u32x4*)(mix + (size_t)row * DM + sg * 8) = wv; } } }
    for (int i0 = gtid; i0 < 262144 * 16; i0 += 2 * gsz) {
        f32x2 ml[2][4]; u32x4 raw[2][4];
#pragma unroll
        for (int k = 0; k < 2; ++k) { const int i = i0 + k * gsz < 262144 * 16 ? i0 + k * gsz : i0; const int rid = i >> 4, sg = i & 15;
#pragma unroll
            for (int s = 0; s < 4; ++s) { ml[k][s] = ML[(size_t)s * 262144 + rid]; raw[k][s] = *(const u32x4*)(opart + ((size_t)s * 262144 + rid) * 128 + sg * 8); } }
#pragma unroll
        for (int k = 0; k < 2; ++k) { const int i = i0 + k * gsz; const int rid = i >> 4, sg = i & 15; const int bh = rid >> 14, t = rid & 16383, b = bh >> 3, h = bh & 7;
            float M = -INFINITY;
#pragma unroll
            for (int s = 0; s < 4; ++s) M = fmaxf(M, ml[k][s].x);
            float wgt[4], Lt = 0.f;
#pragma unroll
            for (int s = 0; s < 4; ++s) { wgt[s] = ml[k][s].y > 0.f ? ml[k][s].y * exp2f(ml[k][s].x - M) : 0.f; Lt += wgt[s]; }
            const float iL = 1.f / Lt; float o[8];
#pragma unroll
            for (int q = 0; q < 8; ++q) o[q] = 0.f;
#pragma unroll
            for (int s = 0; s < 4; ++s) { const float ww = wgt[s] * iL; const u32x4 r = raw[k][s];
                if (wgt[s] > 0.f) { o[0] += ww * bflo(r.x); o[1] += ww * bfhi(r.x); o[2] += ww * bflo(r.y); o[3] += ww * bfhi(r.y); o[4] += ww * bflo(r.z); o[5] += ww * bfhi(r.z); o[6] += ww * bflo(r.w); o[7] += ww * bfhi(r.w); } }
            u32x4 wv; wv.x = pk2(o[0], o[1]); wv.y = pk2(o[2], o[3]); wv.z = pk2(o[4], o[5]); wv.w = pk2(o[6], o[7]);
            if (i < 262144 * 16) *(u32x4*)(mix + (size_t)(b * TT + t) * DM + 1024 + h * 128 + sg * 8) = wv; } }
}

__global__ void __launch_bounds__(NTHREADS) hybrid_fwd(Params P) {
    extern __shared__ __attribute__((aligned(16))) unsigned char smem[];
    LAS unsigned char* lds = (LAS unsigned char*)smem;
    cg::grid_group grid = cg::this_grid();
    unsigned char* ws = P.ws; const int G = gridDim.x, bx = blockIdx.x;
    bf16_t* R0 = (bf16_t*)(ws + WS_R0); bf16_t* R1 = (bf16_t*)(ws + WS_R1); bf16_t* R2 = (bf16_t*)(ws + WS_R2);
    float* ss1 = (float*)(ws + WS_SS1); float* ss2 = (float*)(ws + WS_SS2);

    phase_prep(P, lds);
    grid.sync();
    { pg8::Gemm g{R0, (const bf16_t*)(ws + WS_WIN), MT, NPJ, DM}; pg8::StaticOrder S; S.init(MT, NPJ, G, bx); EpiProj E{R1, (bf16_t*)(ws + WS_HALO)}; pg8::gemm_phase<decltype(E), pg8::StaticOrder, true, true>(lds, g, S, E); }
    phase_ba(P);
    grid.sync();
    phase_gdn_prep(P, lds);
    phase_moba_prep(P, lds);
    grid.sync();
    phase_moba_select(P, lds);
    grid.sync();
    if (bx < 16) phase_gdn_scan(P, lds, bx);
    phase_moba_attn(P, lds);
    if (bx >= 16) phase_wconv_late(P, lds, bx - 16, G - 16);
    grid.sync();
    phase_moba_combine(P);
    grid.sync();
    { pg8::Gemm g{R2, (const bf16_t*)(ws + WS_WO), MT, DM, DM}; pg8::StaticOrder S; S.init(MT, DM, G, bx); EpiResid E{P.x, P.out, R0, ss1}; pg8::gemm_phase<decltype(E), pg8::StaticOrder, true, false>(lds, g, S, E); }
    grid.sync();
    { pg8::Gemm g{R0, (const bf16_t*)(ws + WS_WGU), MT, 2 * FF, DM}; pg8::StaticOrder S; S.init(MT, 2 * FF, G, bx); EpiAct E{R1, ss1}; pg8::gemm_phase<decltype(E), pg8::StaticOrder, true, true>(lds, g, S, E); }
    grid.sync();
    { pg8::Gemm g{(const bf16_t*)(ws + WS_PB), (const bf16_t*)(ws + WS_WPP), MT, DM, 256}; pg8::StaticOrder S; S.init(MT, DM, G, bx); EpiPlainBf16 E{R0, DM}; pg8::gemm_phase<decltype(E), pg8::StaticOrder, true, false>(lds, g, S, E); }
    { pg8::Gemm g{R1, (const bf16_t*)(ws + WS_WDN), MT, DM, FF}; pg8::StaticOrder S; S.init(MT, DM, G, bx); EpiResid E{P.out, P.out, R2, ss2}; pg8::gemm_phase<decltype(E), pg8::StaticOrder, true, false>(lds, g, S, E); }
    grid.sync();
    { pg8::Gemm g{R2, (const bf16_t*)(ws + WS_WPG), MT, DM, DM}; pg8::StaticOrder S; S.init(MT, DM, G, bx); EpiOut E{P.out, R0, ss2}; pg8::gemm_phase<decltype(E), pg8::StaticOrder, true, false>(lds, g, S, E); }
}

extern "C" void kernel_launch(void* const* d_in, const int* in_sizes, int n_in, void* d_out, int out_size, void* d_ws, size_t ws_size, hipStream_t stream) {
    static int grid_blocks = 0;
    if (!grid_blocks) {
        int dev = 0, cus = 0, per_cu = 0;
        hipGetDevice(&dev);
        hipDeviceGetAttribute(&cus, hipDeviceAttributeMultiprocessorCount, dev);
        hipFuncSetAttribute((const void*)hybrid_fwd, hipFuncAttributeMaxDynamicSharedMemorySize, LDS_BYTES);
        hipOccupancyMaxActiveBlocksPerMultiprocessor(&per_cu, (const void*)hybrid_fwd, NTHREADS, LDS_BYTES);
        if (per_cu < 1) per_cu = 1;
        grid_blocks = cus * per_cu;
        if (ws_size < WS_END) fprintf(stderr, "kernel_launch: workspace too small: %zu < %zu\n", ws_size, (size_t)WS_END);
    }
    Params p{};
    p.x = (const float*)d_in[0]; p.p = (const float*)d_in[1]; p.attn_norm = (const float*)d_in[2]; p.w_in = (const float*)d_in[3]; p.conv_w = (const float*)d_in[4];
    p.A_log = (const float*)d_in[5]; p.dt_bias = (const float*)d_in[6]; p.gdn_norm = (const float*)d_in[7]; p.q_norm = (const float*)d_in[8]; p.k_norm = (const float*)d_in[9];
    p.w_o = (const float*)d_in[10]; p.ffn_norm = (const float*)d_in[11]; p.w_gate = (const float*)d_in[12]; p.w_up = (const float*)d_in[13]; p.w_down = (const float*)d_in[14];
    p.ple_norm = (const float*)d_in[15]; p.w_pg = (const float*)d_in[16]; p.w_pp = (const float*)d_in[17];
    p.out = (float*)d_out; p.ws = (unsigned char*)d_ws;
    void* args[] = {&p};
    hipError_t e = hipLaunchCooperativeKernel((const void*)hybrid_fwd, dim3(grid_blocks), dim3(NTHREADS), args, LDS_BYTES, stream);
    if (e != hipSuccess) fprintf(stderr, "cooperative launch failed: %s (grid %d)\n", hipGetErrorString(e), grid_blocks);
}
```

```cpp
#include <hip/hip_runtime.h>
#include <hip/hip_cooperative_groups.h>
#include <cstdio>
namespace cg = cooperative_groups;

#define LAS __attribute__((address_space(3)))
#define DI __device__ __forceinline__
typedef unsigned short bf16_t;
typedef short bf16x8 __attribute__((ext_vector_type(8)));
typedef float f32x4 __attribute__((ext_vector_type(4)));
typedef float f32x2 __attribute__((ext_vector_type(2)));
typedef unsigned u32x4 __attribute__((ext_vector_type(4)));
typedef unsigned u32x2 __attribute__((ext_vector_type(2)));
typedef __bf16 bfv2 __attribute__((ext_vector_type(2)));

constexpr int DM = 2048, TT = 16384, MT = 32768, NPJ = 7168, FF = 5632, INW = 7184;
constexpr int OFF_GQ = 0, OFF_GK = 1024, OFF_GV = 2048, OFF_GZ = 3072, OFF_MQ = 4096, OFF_MK = 5120, OFF_MV = 6144;
constexpr int LISTN = 516096;
constexpr int NTHREADS = 512;
constexpr int LDS_BYTES = 163840;

constexpr size_t WS_CTL   = 0;
constexpr size_t WS_CNT   = 4096;
constexpr size_t WS_SS1   = 8192;
constexpr size_t WS_SS2   = WS_SS1 + 131072;
constexpr size_t WS_GL    = WS_SS2 + 131072;
constexpr size_t WS_KMEAN = WS_GL + 16384;
constexpr size_t WS_WBA   = WS_KMEAN + 524288;
constexpr size_t WS_BA    = WS_WBA + 65536;
constexpr size_t WS_WIN   = WS_BA + 2097152;
constexpr size_t WS_WO    = WS_WIN + (size_t)7168 * 2048 * 2;
constexpr size_t WS_WGU   = WS_WO + (size_t)2048 * 2048 * 2;
constexpr size_t WS_WDN   = WS_WGU + (size_t)11264 * 2048 * 2;
constexpr size_t WS_WPG   = WS_WDN + (size_t)2048 * 5632 * 2;
constexpr size_t WS_WPP   = WS_WPG + (size_t)2048 * 2048 * 2;
constexpr size_t WS_PB    = WS_WPP + (size_t)2048 * 256 * 2;
constexpr size_t WS_R0    = WS_PB + (size_t)32768 * 256 * 2;
constexpr size_t WS_R1    = WS_R0 + (size_t)32768 * 2048 * 2;
constexpr size_t WS_R2    = WS_R1 + (size_t)32768 * 7168 * 2;
constexpr size_t WS_W2    = WS_R2 + (size_t)32768 * 2048 * 2;
constexpr size_t WS_QKB   = WS_W2 + (size_t)32768 * 1024 * 2;
constexpr size_t WS_HALO  = WS_QKB + (size_t)4096 * 4096 * 2;
constexpr size_t WS_LIST  = WS_HALO + (size_t)513 * 3 * 3072 * 2 + 256 - ((size_t)513 * 3 * 3072 * 2) % 256;
constexpr size_t WS_ML    = WS_LIST + (size_t)16 * LISTN * 4;
constexpr size_t WS_SSQ   = WS_ML + (size_t)4 * 262144 * 8;
constexpr size_t WS_END   = WS_SSQ + (size_t)32768 * 64 * 4;

struct Params {
    const float* x; const float* p; const float* attn_norm; const float* w_in; const float* conv_w; const float* A_log; const float* dt_bias;
    const float* gdn_norm; const float* q_norm; const float* k_norm; const float* w_o; const float* ffn_norm; const float* w_gate; const float* w_up;
    const float* w_down; const float* ple_norm; const float* w_pg; const float* w_pp;
    float* out; unsigned char* ws;
};

DI unsigned pk2(float a, float b) { f32x2 v = {a, b}; bfv2 r = __builtin_convertvector(v, bfv2); return __builtin_bit_cast(unsigned, r); }
DI bf16_t f2bf(float a) { return (bf16_t)(pk2(a, 0.f) & 0xffffu); }
DI float bflo(unsigned w) { return __uint_as_float(w << 16); }
DI float bfhi(unsigned w) { return __uint_as_float(w & 0xffff0000u); }
DI float bf2f(bf16_t v) { return __uint_as_float(((unsigned)v) << 16); }
DI bf16x8 pack8(const f32x4& a, const f32x4& b) { u32x4 w; w.x = pk2(a[0], a[1]); w.y = pk2(a[2], a[3]); w.z = pk2(b[0], b[1]); w.w = pk2(b[2], b[3]); return __builtin_bit_cast(bf16x8, w); }
DI bf16x8 cat8(u32x2 lo, u32x2 hi) { u32x4 w; w.x = lo.x; w.y = lo.y; w.z = hi.x; w.w = hi.y; return __builtin_bit_cast(bf16x8, w); }
DI f32x4 mfma16(bf16x8 a, bf16x8 b, f32x4 c) { return __builtin_amdgcn_mfma_f32_16x16x32_bf16(a, b, c, 0, 0, 0); }
DI int perm4(int d4) { return d4 < 16 ? 2 * d4 : 2 * (d4 - 16) + 4; }
DI float dpp_f(float v, int ctrl_sel) { int x = __float_as_int(v); int r;
    if (ctrl_sel == 0) r = __builtin_amdgcn_mov_dpp(x, 0xB1, 0xf, 0xf, true); else if (ctrl_sel == 1) r = __builtin_amdgcn_mov_dpp(x, 0x4E, 0xf, 0xf, true);
    else if (ctrl_sel == 2) r = __builtin_amdgcn_mov_dpp(x, 0x141, 0xf, 0xf, true); else r = __builtin_amdgcn_mov_dpp(x, 0x140, 0xf, 0xf, true);
    return __int_as_float(r); }
DI float row16_sum(float v) { v += dpp_f(v, 0); v += dpp_f(v, 1); v += dpp_f(v, 2); v += dpp_f(v, 3); return v; }
DI float silu_f(float v) { return v * __builtin_amdgcn_rcpf(1.f + __expf(-v)); }
DI float sigm_f(float v) { return __builtin_amdgcn_rcpf(1.f + __expf(-v)); }

DI int opq_tid() { int t = threadIdx.x; asm volatile("" : "+v"(t)); return t; }

namespace pg8 {
constexpr int BM = 256, BK = 64, HALF = 128, HTB = HALF * BK * 2, STAGE_BYTES = 8 * HTB, NXCD = 8, WGM = 8;
DI int lds_byte(int r, int c) { const int st = (r >> 4) * 2 + (c >> 5), rr = r & 15, cc = c & 31, ob = rr * 64 + cc * 2; return st * 1024 + (ob ^ (((ob >> 9) & 1) << 5)); }
DI void stage_rc(int b, int& R, int& C) { const int st = b / 1024, sb = b % 1024, swz = sb ^ (((sb >> 9) & 1) << 5); R = (st >> 1) * 16 + swz / 64; C = (st & 1) * 32 + (swz % 64) / 2; }
DI int perm32(int rho) { const int n = rho >> 4, i = rho & 15; return 8 * (i >> 2) + 4 * n + (i & 3); }
struct Unit { int pm, pn; };
struct Gemm { const bf16_t* A; const bf16_t* Bt; int M, N, K; };
struct StaticOrder {
    int nM, nN, nwg, G, c;
    DI void init(int M, int N, int G_, int c_) { nM = M / BM; nN = N / BM; nwg = nM * nN; G = G_; c = c_; }
    DI bool next(int i, Unit& u) const {
        const long L = (long)i * G + c; if (L >= nwg) return false;
        int wgid = (int)L; { const int q = nwg / NXCD, r = nwg % NXCD, xcd = wgid % NXCD, off = wgid / NXCD; wgid = (xcd < r ? xcd * (q + 1) : r * (q + 1) + (xcd - r) * q) + off; }
        const int nig = WGM * nN, gid = wgid / nig, fm = gid * WGM, gsz = (nM - fm) < WGM ? (nM - fm) : WGM;
        u.pm = fm + ((wgid % nig) % gsz); u.pn = (wgid % nig) / gsz; return true;
    }
    DI void a_ready(const Unit&) const {}
    DI void done(const Unit&) const {}
};

template <class Epi, class Sched, bool ALIGN_EPI = false, bool SP2 = false>
DI void gemm_phase(LAS unsigned char* lds, const Gemm g, const Sched& S, const Epi& E) {
    const int tid = opq_tid(), wid = __builtin_amdgcn_readfirstlane(tid >> 6), lane = tid & 63, wr = wid >> 2, wc = wid & 3, fr = lane & 15, fq = lane >> 4;
    const int K = g.K, nt = K / BK;
    unsigned voffA[2], voffB[2];
#pragma unroll
    for (int i = 0; i < 2; ++i) { int R, C; stage_rc(tid * 16 + i * 8192, R, C); const int Rb = Epi::PERM ? ((R & ~31) + perm32(R & 31)) : R;
        voffA[i] = (unsigned)(R * K + C) * 2u; voffB[i] = (unsigned)(Rb * K + C) * 2u; }
    const size_t kstep = (size_t)(BK * 2);
    const size_t hstep = (size_t)HALF * K * 2;
    const size_t tstep = 2 * hstep;
    const unsigned ldsw = (unsigned)wid * 1024u;
    const int aoff = lds_byte(wr * 64 + fr, fq * 8), boff = lds_byte(wc * 32 + fr, fq * 8);
#define PG8_SA(b, h) (((b) * 2 + (h)) * HTB)
#define PG8_SB(b, h) ((4 + (b) * 2 + (h)) * HTB)
#define PG8_STAGE(bufoff, gbase, voff) do { _Pragma("unroll") for (int _i = 0; _i < 2; ++_i) \
        __builtin_amdgcn_global_load_lds((const unsigned*)((const char*)(gbase) + (voff)[_i]), (LAS unsigned*)(lds + (bufoff) + ldsw + _i * 8192), 16, 0, 0); } while (0)
#define PG8_LDA(dst, b, h) do { _Pragma("unroll") for (int m = 0; m < 4; ++m) _Pragma("unroll") for (int k = 0; k < 2; ++k) dst[m][k] = *(const LAS bf16x8*)(lds + PG8_SA(b, h) + aoff + m * 2048 + k * 1024); } while (0)
#define PG8_LDB(dst, b, h) do { _Pragma("unroll") for (int n = 0; n < 2; ++n) _Pragma("unroll") for (int k = 0; k < 2; ++k) dst[n][k] = *(const LAS bf16x8*)(lds + PG8_SB(b, h) + boff + n * 2048 + k * 1024); } while (0)
#define PG8_MMA(ai, bj, At, Bt) do { __builtin_amdgcn_s_setprio(1); _Pragma("unroll") for (int m = 0; m < 4; ++m) _Pragma("unroll") for (int n = 0; n < 2; ++n) _Pragma("unroll") for (int k = 0; k < 2; ++k) \
        acc[ai][bj][m][n] = __builtin_amdgcn_mfma_f32_16x16x32_bf16(Bt[n][k], At[m][k], acc[ai][bj][m][n], 0, 0, 0); __builtin_amdgcn_s_setprio(0); } while (0)
#define PG8_WAIT_V(n) asm volatile("s_waitcnt vmcnt(" #n ")" ::: "memory")
#define PG8_WAIT_L(n) asm volatile("s_waitcnt lgkmcnt(" #n ")" ::: "memory")
#define PG8_BAR __builtin_amdgcn_s_barrier()
#define PG8_SCHED __builtin_amdgcn_sched_barrier(0)
    Unit cur, nxt; int ui = 0;
    if (!S.next(0, cur)) return;
    f32x4 acc[2][2][4][2];
#pragma unroll
    for (int a = 0; a < 2; ++a)
#pragma unroll
        for (int b = 0; b < 2; ++b)
#pragma unroll
            for (int m = 0; m < 4; ++m)
#pragma unroll
                for (int n = 0; n < 2; ++n) acc[a][b][m][n] = (f32x4){0.f, 0.f, 0.f, 0.f};
    bf16x8 At[4][2], B0[2][2], B1[2][2];
    const char* cA = (const char*)g.A + (size_t)cur.pm * tstep; const char* cB = (const char*)g.Bt + (size_t)cur.pn * tstep;
    S.a_ready(cur);
    if constexpr (SP2) {
        PG8_STAGE(PG8_SB(0, 0), cB, voffB); PG8_STAGE(PG8_SB(0, 1), cB + hstep, voffB); PG8_STAGE(PG8_SA(0, 0), cA, voffA); PG8_STAGE(PG8_SA(0, 1), cA + hstep, voffA);
        if (wr == 1) PG8_BAR;
        PG8_WAIT_V(2); PG8_BAR;
        PG8_STAGE(PG8_SB(1, 0), cB + kstep, voffB); PG8_STAGE(PG8_SA(1, 0), cA + kstep, voffA); PG8_STAGE(PG8_SB(1, 1), cB + hstep + kstep, voffB);
        PG8_WAIT_V(6); PG8_BAR;
    } else {
        PG8_STAGE(PG8_SB(0, 0), cB, voffB); PG8_STAGE(PG8_SA(0, 0), cA, voffA); PG8_STAGE(PG8_SB(0, 1), cB + hstep, voffB); PG8_STAGE(PG8_SA(0, 1), cA + hstep, voffA);
        if (wr == 1) PG8_BAR;
        PG8_WAIT_V(4); PG8_BAR;
        PG8_STAGE(PG8_SB(1, 0), cB + kstep, voffB); PG8_STAGE(PG8_SA(1, 0), cA + kstep, voffA); PG8_STAGE(PG8_SB(1, 1), cB + hstep + kstep, voffB);
        PG8_WAIT_V(6); PG8_BAR;
    }
    for (;;) {
        const bool has_next = S.next(ui + 1, nxt);
        const char* nA = has_next ? (const char*)g.A + (size_t)nxt.pm * tstep : cA; const char* nB = has_next ? (const char*)g.Bt + (size_t)nxt.pn * tstep : cB;
        for (int t = 0; t < nt; t += 2) {
            const bool last = (t == nt - 2);
            const char* a1 = cA + (size_t)(t + 1) * kstep;
            const char* a2 = last ? nA : cA + (size_t)(t + 2) * kstep; const char* b2 = last ? nB : cB + (size_t)(t + 2) * kstep;
            const char* a3 = a2 + kstep; const char* b3 = b2 + kstep;
            if (last && has_next) S.a_ready(nxt);
            if constexpr (SP2) {
            PG8_LDB(B0, 0, 0); PG8_LDB(B1, 0, 1); PG8_SCHED; PG8_LDA(At, 0, 0); PG8_STAGE(PG8_SA(1, 1), a1 + hstep, voffA);
            PG8_WAIT_V(8); PG8_WAIT_L(0); PG8_BAR; PG8_MMA(0, 0, At, B0); PG8_MMA(0, 1, At, B1); PG8_BAR; PG8_SCHED;
            PG8_LDA(At, 0, 1); PG8_STAGE(PG8_SB(0, 0), b2, voffB); PG8_STAGE(PG8_SB(0, 1), b2 + hstep, voffB); PG8_STAGE(PG8_SA(0, 0), a2, voffA);
            PG8_WAIT_V(8); PG8_WAIT_L(0); PG8_BAR; PG8_MMA(1, 0, At, B0); PG8_MMA(1, 1, At, B1); PG8_BAR; PG8_SCHED;
            PG8_LDB(B0, 1, 0); PG8_LDB(B1, 1, 1); PG8_SCHED; PG8_LDA(At, 1, 0); PG8_STAGE(PG8_SA(0, 1), a2 + hstep, voffA);
            PG8_WAIT_V(8); PG8_WAIT_L(0); PG8_BAR; PG8_MMA(0, 0, At, B0); PG8_MMA(0, 1, At, B1); PG8_BAR; PG8_SCHED;
            PG8_LDA(At, 1, 1); PG8_STAGE(PG8_SB(1, 0), b3, voffB); PG8_STAGE(PG8_SB(1, 1), b3 + hstep, voffB); PG8_STAGE(PG8_SA(1, 0), a3, voffA);
            PG8_WAIT_V(8); PG8_WAIT_L(0); PG8_BAR; PG8_MMA(1, 0, At, B0); PG8_MMA(1, 1, At, B1); PG8_BAR; PG8_SCHED;
            } else {
            PG8_LDB(B0, 0, 0); PG8_SCHED; PG8_LDA(At, 0, 0); PG8_STAGE(PG8_SA(1, 1), a1 + hstep, voffA);
            PG8_WAIT_L(8); PG8_BAR; PG8_WAIT_L(0); PG8_MMA(0, 0, At, B0); PG8_BAR; PG8_SCHED;
            PG8_LDB(B1, 0, 1); PG8_STAGE(PG8_SB(0, 0), b2, voffB);
            PG8_BAR; PG8_WAIT_L(0); PG8_MMA(0, 1, At, B1); PG8_BAR;
            PG8_LDA(At, 0, 1); PG8_STAGE(PG8_SA(0, 0), a2, voffA);
            PG8_BAR; PG8_WAIT_L(0); PG8_MMA(1, 0, At, B0); PG8_BAR; PG8_SCHED;
            PG8_STAGE(PG8_SB(0, 1), b2 + hstep, voffB);
            PG8_WAIT_V(6); PG8_BAR; PG8_MMA(1, 1, At, B1); PG8_BAR;
            PG8_LDB(B0, 1, 0); PG8_SCHED; PG8_LDA(At, 1, 0); PG8_STAGE(PG8_SA(0, 1), a2 + hstep, voffA);
            PG8_WAIT_L(8); PG8_BAR; PG8_WAIT_L(0); PG8_MMA(0, 0, At, B0); PG8_BAR; PG8_SCHED;
            PG8_LDB(B1, 1, 1); PG8_STAGE(PG8_SB(1, 0), b3, voffB);
            PG8_BAR; PG8_WAIT_L(0); PG8_MMA(0, 1, At, B1); PG8_BAR;
            PG8_LDA(At, 1, 1); PG8_STAGE(PG8_SA(1, 0), a3, voffA);
            PG8_BAR; PG8_WAIT_L(0); PG8_MMA(1, 0, At, B0); PG8_BAR; PG8_SCHED;
            PG8_STAGE(PG8_SB(1, 1), b3 + hstep, voffB);
            PG8_WAIT_V(6); PG8_BAR; PG8_MMA(1, 1, At, B1); PG8_BAR;
            }
        }
        if constexpr (ALIGN_EPI) { if (wr == 0) PG8_BAR; }
        if constexpr (!Epi::AFTER_DRAIN) { E(acc, cur, wr, wc, fr, fq); S.done(cur); }
        if (!has_next) break;
#pragma unroll
        for (int a = 0; a < 2; ++a)
#pragma unroll
            for (int b = 0; b < 2; ++b)
#pragma unroll
                for (int m = 0; m < 4; ++m)
#pragma unroll
                    for (int n = 0; n < 2; ++n) acc[a][b][m][n] = (f32x4){0.f, 0.f, 0.f, 0.f};
        cur = nxt; cA = nA; cB = nB; ++ui;
        if constexpr (ALIGN_EPI) { if (wr == 1) PG8_BAR; }
    }
    PG8_WAIT_V(0);
    if constexpr (!ALIGN_EPI) { if (wr == 0) PG8_BAR; }
    PG8_BAR;
    if constexpr (Epi::AFTER_DRAIN) { E.fused(acc, cur, wr, wc, fr, fq, lds, wid, lane); S.done(cur); }
#undef PG8_SA
#undef PG8_SB
#undef PG8_STAGE
#undef PG8_LDA
#undef PG8_LDB
#undef PG8_MMA
#undef PG8_WAIT_V
#undef PG8_WAIT_L
#undef PG8_BAR
#undef PG8_SCHED
}
}
using pg8::Unit;

struct EpiProj {
    static constexpr bool PERM = true, AFTER_DRAIN = false;
    bf16_t* O; bf16_t* halo;
    DI void operator()(const f32x4 (&acc)[2][2][4][2], const Unit& u, int wr, int wc, int fr, int fq) const {
        const int row0 = u.pm * 256 + wr * 64 + fr, col0 = u.pn * 256 + wc * 32 + 8 * fq;
#pragma unroll
        for (int ai = 0; ai < 2; ++ai)
#pragma unroll
            for (int m = 0; m < 4; ++m) { const int row = row0 + ai * 128 + m * 16; bf16_t* rowp = O + (size_t)row * NPJ + col0;
#pragma unroll
                for (int bj = 0; bj < 2; ++bj) { const f32x4 v0 = acc[ai][bj][m][0], v1 = acc[ai][bj][m][1];
                    u32x4 w; w.x = pk2(v0[0], v0[1]); w.y = pk2(v0[2], v0[3]); w.z = pk2(v1[0], v1[1]); w.w = pk2(v1[2], v1[3]);
                    *(u32x4*)(rowp + bj * 128) = w;
                    if (m == 3 && fr >= 13 && u.pn < 12) *(u32x4*)(halo + ((size_t)((row >> 6) + 1) * 3 + (fr - 13)) * 3072 + col0 + bj * 128) = w; } }
    }
};
struct EpiPlainBf16 {
    static constexpr bool PERM = true, AFTER_DRAIN = false;
    bf16_t* O; int ldc;
    DI void operator()(const f32x4 (&acc)[2][2][4][2], const Unit& u, int wr, int wc, int fr, int fq) const {
        const int row0 = u.pm * 256 + wr * 64 + fr, col0 = u.pn * 256 + wc * 32 + 8 * fq;
#pragma unroll
        for (int ai = 0; ai < 2; ++ai)
#pragma unroll
            for (int m = 0; m < 4; ++m) { bf16_t* rowp = O + (size_t)(row0 + ai * 128 + m * 16) * ldc + col0;
#pragma unroll
                for (int bj = 0; bj < 2; ++bj) { const f32x4 v0 = acc[ai][bj][m][0], v1 = acc[ai][bj][m][1];
                    u32x4 w; w.x = pk2(v0[0], v0[1]); w.y = pk2(v0[2], v0[3]); w.z = pk2(v1[0], v1[1]); w.w = pk2(v1[2], v1[3]);
                    *(u32x4*)(rowp + bj * 128) = w; } }
    }
};
struct EpiResid {
    static constexpr bool PERM = false, AFTER_DRAIN = false;
    const float* base; float* out; bf16_t* hb; float* ss;
    DI void operator()(const f32x4 (&acc)[2][2][4][2], const Unit& u, int wr, int wc, int fr, int fq) const {
        const int row0 = u.pm * 256 + wr * 64 + fr, col0 = u.pn * 256 + wc * 32 + 4 * fq;
#pragma unroll
        for (int ai = 0; ai < 2; ++ai) { f32x4 bs[4][4];
#pragma unroll
            for (int m = 0; m < 4; ++m)
#pragma unroll
                for (int q = 0; q < 4; ++q) bs[m][q] = *(const f32x4*)(base + (size_t)(row0 + ai * 128 + m * 16) * DM + col0 + (q >> 1) * 128 + (q & 1) * 16);
#pragma unroll
            for (int m = 0; m < 4; ++m) { const int row = row0 + ai * 128 + m * 16; const size_t off = (size_t)row * DM + col0; float s = 0.f;
#pragma unroll
                for (int q = 0; q < 4; ++q) { const f32x4 hv = bs[m][q] + acc[ai][q >> 1][m][q & 1];
                        *(f32x4*)(out + off + (q >> 1) * 128 + (q & 1) * 16) = hv; u32x2 w; w.x = pk2(hv[0], hv[1]); w.y = pk2(hv[2], hv[3]);
                        *(u32x2*)(hb + off + (q >> 1) * 128 + (q & 1) * 16) = w; s += (hv[0] * hv[0] + hv[1] * hv[1]) + (hv[2] * hv[2] + hv[3] * hv[3]); }
                s += __shfl_xor(s, 16); s += __shfl_xor(s, 32);
                if (fq == 0) atomicAdd(ss + row, s); }
            asm volatile("" ::: "memory"); }
    }
};
struct EpiAct {
    static constexpr bool PERM = true, AFTER_DRAIN = false;
    bf16_t* O; const float* ss;
    DI void operator()(const f32x4 (&acc)[2][2][4][2], const Unit& u, int wr, int wc, int fr, int fq) const {
        const int row0 = u.pm * 256 + wr * 64 + fr, col0 = u.pn * 128 + wc * 32 + 8 * fq;
        float rs[8];
#pragma unroll
        for (int g = 0; g < 8; ++g) rs[g] = ss[row0 + (g >> 2) * 128 + (g & 3) * 16];
#pragma unroll
        for (int ai = 0; ai < 2; ++ai)
#pragma unroll
            for (int m = 0; m < 4; ++m) { const int row = row0 + ai * 128 + m * 16; const float r = rsqrtf(rs[ai * 4 + m] * (1.f / 2048.f) + 1e-6f);
                float a[8];
#pragma unroll
                for (int n = 0; n < 2; ++n)
#pragma unroll
                    for (int j = 0; j < 4; ++j) { const float gv = r * acc[ai][0][m][n][j], uv = r * acc[ai][1][m][n][j]; a[n * 4 + j] = silu_f(gv) * uv; }
                u32x4 w; w.x = pk2(a[0], a[1]); w.y = pk2(a[2], a[3]); w.z = pk2(a[4], a[5]); w.w = pk2(a[6], a[7]);
                *(u32x4*)(O + (size_t)row * FF + col0) = w; }
    }
};
struct EpiOut {
    static constexpr bool PERM = false, AFTER_DRAIN = false;
    float* out; const bf16_t* pp; const float* ss;
    DI void operator()(const f32x4 (&acc)[2][2][4][2], const Unit& u, int wr, int wc, int fr, int fq) const {
        const int row0 = u.pm * 256 + wr * 64 + fr, col0 = u.pn * 256 + wc * 32 + 4 * fq;
        float rs[8];
#pragma unroll
        for (int g = 0; g < 8; ++g) rs[g] = ss[row0 + (g >> 2) * 128 + (g & 3) * 16];
#pragma unroll
        for (int ai = 0; ai < 2; ++ai)
#pragma unroll
            for (int m = 0; m < 4; ++m) { const int row = row0 + ai * 128 + m * 16; const size_t off = (size_t)row * DM + col0; const float r = rsqrtf(rs[ai * 4 + m] * (1.f / 2048.f) + 1e-6f);
                f32x4 hv[4]; u32x2 pw[4];
#pragma unroll
                for (int q = 0; q < 4; ++q) { hv[q] = *(const f32x4*)(out + off + (q >> 1) * 128 + (q & 1) * 16); pw[q] = *(const u32x2*)(pp + off + (q >> 1) * 128 + (q & 1) * 16); }
#pragma unroll
                for (int q = 0; q < 4; ++q) { const f32x4 a = acc[ai][q >> 1][m][q & 1]; f32x4 o;
                        o[0] = hv[q][0] + sigm_f(r * a[0]) * bflo(pw[q].x); o[1] = hv[q][1] + sigm_f(r * a[1]) * bfhi(pw[q].x);
                        o[2] = hv[q][2] + sigm_f(r * a[2]) * bflo(pw[q].y); o[3] = hv[q][3] + sigm_f(r * a[3]) * bfhi(pw[q].y);
                        *(f32x4*)(out + off + (q >> 1) * 128 + (q & 1) * 16) = o; }
                asm volatile("" ::: "memory"); }
    }
};

DI void tconv_tile(const float* __restrict__ src, int ld, int c0, int k0, bf16_t* __restrict__ dst, int dK, int n0, const float* __restrict__ nw, LAS float* tl) {
    const int tid = opq_tid();
    f32x4 v[8];
#pragma unroll
    for (int i = 0; i < 8; ++i) v[i] = *(const f32x4*)(src + (size_t)(k0 + (tid >> 4) + 32 * i) * ld + c0 + (tid & 15) * 4);
#pragma unroll
    for (int i = 0; i < 8; ++i) { const int k = (tid >> 4) + 32 * i; const float sc = nw ? nw[k0 + k] : 1.f;
        LAS float* q = tl + k * 65 + (tid & 15) * 4; q[0] = v[i][0] * sc; q[1] = v[i][1] * sc; q[2] = v[i][2] * sc; q[3] = v[i][3] * sc; }
    __syncthreads();
    { const int n = tid >> 3, kq = (tid & 7) * 8;
#pragma unroll
      for (int j = 0; j < 4; ++j) { const int ks = kq + 64 * j; float f[8];
#pragma unroll
          for (int i = 0; i < 8; ++i) f[i] = tl[(ks + i) * 65 + n];
          u32x4 w; w.x = pk2(f[0], f[1]); w.y = pk2(f[2], f[3]); w.z = pk2(f[4], f[5]); w.w = pk2(f[6], f[7]);
          *(u32x4*)(dst + (size_t)(n0 + n) * dK + k0 + ks) = w; } }
    __syncthreads();
}

DI void phase_prep(const Params& P, LAS unsigned char* lds) {
    unsigned char* ws = P.ws; const int tid = opq_tid(), G = gridDim.x, bx = blockIdx.x;
    const int gtid = bx * NTHREADS + tid, gsz = G * NTHREADS;
    for (int i = gtid; i < (int)((WS_GL - WS_CTL) / 4); i += gsz) ((unsigned*)(ws + WS_CTL))[i] = 0u;
    { bf16_t* wba = (bf16_t*)(ws + WS_WBA); for (int i = gtid; i < 16 * 2048; i += gsz) { const int n = i >> 11, k = i & 2047; wba[i] = f2bf(P.w_in[(size_t)k * INW + 4096 + n]); } }
    { bf16_t* pb = (bf16_t*)(ws + WS_PB); for (int i = gtid; i < MT * 256 / 8; i += gsz) { const f32x4 a = *(const f32x4*)(P.p + (size_t)i * 8), b = *(const f32x4*)(P.p + (size_t)i * 8 + 4);
        u32x4 w; w.x = pk2(a[0], a[1]); w.y = pk2(a[2], a[3]); w.z = pk2(b[0], b[1]); w.w = pk2(b[2], b[3]); *(u32x4*)(pb + (size_t)i * 8) = w; } }
    { bf16_t* xn = (bf16_t*)(ws + WS_R0); const int lane = tid & 63, gw = bx * 8 + (tid >> 6);
      f32x4 wv[8];
#pragma unroll
      for (int i = 0; i < 8; ++i) wv[i] = *(const f32x4*)(P.attn_norm + lane * 4 + i * 256);
      for (int row = gw * 2; row < MT; row += G * 16) { const float* xr = P.x + (size_t)row * DM; f32x4 v[2][8]; float s0 = 0.f, s1 = 0.f;
#pragma unroll
          for (int r = 0; r < 2; ++r)
#pragma unroll
              for (int i = 0; i < 8; ++i) v[r][i] = *(const f32x4*)(xr + (size_t)r * DM + lane * 4 + i * 256);
#pragma unroll
          for (int i = 0; i < 8; ++i) { s0 += (v[0][i][0] * v[0][i][0] + v[0][i][1] * v[0][i][1]) + (v[0][i][2] * v[0][i][2] + v[0][i][3] * v[0][i][3]);
              s1 += (v[1][i][0] * v[1][i][0] + v[1][i][1] * v[1][i][1]) + (v[1][i][2] * v[1][i][2] + v[1][i][3] * v[1][i][3]); }
#pragma unroll
          for (int o = 1; o < 64; o <<= 1) { s0 += __shfl_xor(s0, o); s1 += __shfl_xor(s1, o); }
          const float r0 = rsqrtf(s0 * (1.f / 2048.f) + 1e-6f), r1 = rsqrtf(s1 * (1.f / 2048.f) + 1e-6f);
#pragma unroll
          for (int r = 0; r < 2; ++r)
#pragma unroll
              for (int i = 0; i < 8; ++i) { const float rr = r ? r1 : r0; u32x2 w; w.x = pk2(v[r][i][0] * rr * wv[i][0], v[r][i][1] * rr * wv[i][1]); w.y = pk2(v[r][i][2] * rr * wv[i][2], v[r][i][3] * rr * wv[i][3]);
                  *(u32x2*)(xn + (size_t)(row + r) * DM + lane * 4 + i * 256) = w; } } }
    LAS float* tl = (LAS float*)lds;
    for (int gi = bx; gi < 896; gi += G) { const int nt = gi >> 3, kg = gi & 7, n0 = nt * 64; tconv_tile(P.w_in, INW, n0 < 4096 ? n0 : n0 + 16, kg * 256, (bf16_t*)(ws + WS_WIN), 2048, n0, nullptr, tl); }
}
DI void phase_wconv_late(const Params& P, LAS unsigned char* lds, int wg0, int nwg) {
    unsigned char* ws = P.ws; LAS float* tl = (LAS float*)lds;
    for (int gi = 896 + wg0; gi < 3552; gi += nwg) {
        if (gi < 1152) { const int t2 = gi - 896, nt = t2 >> 3, kg = t2 & 7; tconv_tile(P.w_o, 2048, nt * 64, kg * 256, (bf16_t*)(ws + WS_WO), 2048, nt * 64, nullptr, tl); }
        else if (gi < 2560) { const int t2 = gi - 1152, nt = t2 >> 3, kg = t2 & 7, n0 = nt * 64, pn = n0 >> 8, r = n0 & 255;
            tconv_tile(r < 128 ? P.w_gate : P.w_up, FF, pn * 128 + (r & 127), kg * 256, (bf16_t*)(ws + WS_WGU), 2048, n0, P.ffn_norm, tl); }
        else if (gi < 3264) { const int t2 = gi - 2560, nt = t2 / 22, kg = t2 % 22; tconv_tile(P.w_down, 2048, nt * 64, kg * 256, (bf16_t*)(ws + WS_WDN), FF, nt * 64, nullptr, tl); }
        else if (gi < 3520) { const int t2 = gi - 3264, nt = t2 >> 3, kg = t2 & 7; tconv_tile(P.w_pg, 2048, nt * 64, kg * 256, (bf16_t*)(ws + WS_WPG), 2048, nt * 64, P.ple_norm, tl); }
        else { const int nt = gi - 3520; tconv_tile(P.w_pp, 2048, nt * 64, 0, (bf16_t*)(ws + WS_WPP), 256, nt * 64, nullptr, tl); }
    }
}

DI void phase_ba(const Params& P) {
    const int tid = opq_tid(), lane = tid & 63, fr = lane & 15, fq = lane >> 4, gw = blockIdx.x * 8 + (tid >> 6);
    const bf16_t* xn = (const bf16_t*)(P.ws + WS_R0); const bf16_t* wba = (const bf16_t*)(P.ws + WS_WBA); float* BA = (float*)(P.ws + WS_BA);
    for (int rt = gw; rt < MT / 16; rt += gridDim.x * 8) {
        f32x4 acc = {0.f, 0.f, 0.f, 0.f}; const bf16_t* ap = xn + (size_t)(rt * 16 + fr) * DM + 8 * fq; const bf16_t* bp = wba + fr * 2048 + 8 * fq;
#pragma unroll 16
        for (int ks = 0; ks < 64; ++ks) acc = mfma16(*(const bf16x8*)(ap + 32 * ks), *(const bf16x8*)(bp + 32 * ks), acc);
#pragma unroll
        for (int j = 0; j < 4; ++j) BA[(size_t)(rt * 16 + 4 * fq + j) * 16 + fr] = acc[j];
    }
}

constexpr int G1_QS = 0, G1_KS = 18432, G1_VT = 36864, G1_KT = 57344, G1_SM = 77824, G1_TEAM = 78848;
DI void phase_gdn_prep(const Params& P, LAS unsigned char* lds) {
    const int tid0 = opq_tid(), team = tid0 >> 8;
    LAS unsigned char* L = lds + team * G1_TEAM;
    LAS bf16_t* QS = (LAS bf16_t*)(L + G1_QS); LAS bf16_t* KS = (LAS bf16_t*)(L + G1_KS); LAS bf16_t* VT = (LAS bf16_t*)(L + G1_VT); LAS bf16_t* KT = (LAS bf16_t*)(L + G1_KT);
    LAS float* AF = (LAS float*)(L + G1_QS); LAS bf16_t* TB = (LAS bf16_t*)(L + G1_KS); LAS float* SM = (LAS float*)(L + G1_SM);
    bf16_t* proj = (bf16_t*)(P.ws + WS_R1); const bf16_t* halo = (const bf16_t*)(P.ws + WS_HALO); const float* BA = (const float*)(P.ws + WS_BA);
    bf16_t* W2 = (bf16_t*)(P.ws + WS_W2); bf16_t* QKB = (bf16_t*)(P.ws + WS_QKB); float* GL = (float*)(P.ws + WS_GL);
    for (int pi = blockIdx.x; pi < 2048; pi += gridDim.x) {
        int tid = tid0; asm volatile("" : "+v"(tid));
        const int tt = tid & 255, tw = __builtin_amdgcn_readfirstlane((tid >> 6) & 3), lane = tid & 63, fr = lane & 15, fq = lane >> 4;
        const int ci = pi * 2 + team, h = ci & 7, n = (ci >> 3) & 255, b = ci >> 11, t0 = b * TT + n * 64;
        if (tw == 0) {
            const float bv = BA[(size_t)(t0 + lane) * 16 + h], av = BA[(size_t)(t0 + lane) * 16 + 8 + h];
            const float beta = sigm_f(bv); const float xx = av + P.dt_bias[h]; const float sp = xx > 20.f ? xx : log1pf(__expf(xx));
            const float gg = -__expf(P.A_log[h]) * sp; float gc = gg;
#pragma unroll
            for (int o = 1; o < 64; o <<= 1) { const float v = __shfl_up(gc, o); if (lane >= o) gc += v; }
            const float glast = __shfl(gc, 63);
            SM[lane] = gc; SM[64 + lane] = beta; SM[128 + lane] = __expf(gc); SM[192 + lane] = __expf(glast - gc);
            if (lane == 63) GL[(b * 8 + h) * 256 + n] = __expf(gc);
        }
        __syncthreads();
        { const int r = tt >> 2, cg0 = (tt & 3) * 32; const float beta_r = SM[64 + r], egc_r = SM[128 + r];
#pragma unroll 1
          for (int x = 0; x < 3; ++x) {
              float val[32]; const int colbase = x * 1024 + h * 128 + cg0;
              u32x4 rawa[4][4];
#pragma unroll
              for (int sg = 0; sg < 4; ++sg) { const int col = colbase + sg * 8;
#pragma unroll
                  for (int j = 0; j < 4; ++j) { const int rr = r - 3 + j; rawa[sg][j] = (u32x4){0u, 0u, 0u, 0u};
                      if (rr >= 0) rawa[sg][j] = *(const u32x4*)(proj + (size_t)(t0 + rr) * NPJ + col);
                      else if (n > 0) rawa[sg][j] = *(const u32x4*)(halo + ((size_t)(t0 >> 6) * 3 + (rr + 3)) * 3072 + col); } }
#pragma unroll
              for (int sg = 0; sg < 4; ++sg) { const int col = colbase + sg * 8;
#pragma unroll
                  for (int i = 0; i < 8; ++i) { const f32x4 w4 = *(const f32x4*)(P.conv_w + (size_t)(col + i) * 4); float a = 0.f;
#pragma unroll
                      for (int j = 0; j < 4; ++j) { const unsigned wd = rawa[sg][j][i >> 1]; const float xv = (i & 1) ? bfhi(wd) : bflo(wd); a += w4[j] * xv; }
                      val[sg * 8 + i] = silu_f(a); } }
              if (x < 2) { float ss = 0.f;
#pragma unroll
                  for (int i = 0; i < 32; ++i) ss += val[i] * val[i];
                  ss += __shfl_xor(ss, 1); ss += __shfl_xor(ss, 2);
                  const float sc = rsqrtf(ss + 1e-6f) * (x == 0 ? 0.08838834764831845f : 1.f);
#pragma unroll
                  for (int i = 0; i < 32; ++i) val[i] *= sc; }
              if (x < 2) { LAS bf16_t* dst = (x == 0 ? QS : KS) + r * 144 + cg0;
#pragma unroll
                  for (int i = 0; i < 4; ++i) { u32x4 w; w.x = pk2(val[8 * i], val[8 * i + 1]); w.y = pk2(val[8 * i + 2], val[8 * i + 3]); w.z = pk2(val[8 * i + 4], val[8 * i + 5]); w.w = pk2(val[8 * i + 6], val[8 * i + 7]);
                      *(LAS u32x4*)(dst + 8 * i) = w; } }
              if (x == 1) { const float f = beta_r * egc_r;
#pragma unroll
                  for (int i = 0; i < 32; ++i) KT[(cg0 + i) * 80 + r] = f2bf(val[i] * f); }
              if (x == 2) {
#pragma unroll
                  for (int i = 0; i < 32; ++i) VT[(cg0 + i) * 80 + r] = f2bf(val[i] * beta_r); }
          } }
        __syncthreads();
        f32x4 kk[4], qk[4];
#pragma unroll
        for (int nt = 0; nt < 4; ++nt) { kk[nt] = (f32x4){0.f, 0.f, 0.f, 0.f}; qk[nt] = (f32x4){0.f, 0.f, 0.f, 0.f}; }
#pragma unroll
        for (int ks = 0; ks < 4; ++ks) { const bf16x8 ak = *(const LAS bf16x8*)(KS + (16 * tw + fr) * 144 + 32 * ks + 8 * fq), aq = *(const LAS bf16x8*)(QS + (16 * tw + fr) * 144 + 32 * ks + 8 * fq);
#pragma unroll
            for (int nt = 0; nt < 4; ++nt) { const bf16x8 bk = *(const LAS bf16x8*)(KS + (16 * nt + fr) * 144 + 32 * ks + 8 * fq); kk[nt] = mfma16(ak, bk, kk[nt]); qk[nt] = mfma16(aq, bk, qk[nt]); } }
        { const int r = tt >> 2, cg0 = (tt & 3) * 32; const float e = SM[128 + r];
#pragma unroll
          for (int i = 0; i < 4; ++i) { const u32x4 s = *(const LAS u32x4*)(QS + r * 144 + cg0 + 8 * i); u32x4 w;
              w.x = pk2(bflo(s.x) * e, bfhi(s.x) * e); w.y = pk2(bflo(s.y) * e, bfhi(s.y) * e); w.z = pk2(bflo(s.z) * e, bfhi(s.z) * e); w.w = pk2(bflo(s.w) * e, bfhi(s.w) * e);
              *(u32x4*)(proj + (size_t)(t0 + r) * NPJ + OFF_GQ + h * 128 + cg0 + 8 * i) = w; } }
        { const int d = tt >> 1, cb = (tt & 1) * 32;
#pragma unroll
          for (int i4 = 0; i4 < 4; ++i4) { const int c0 = cb + 8 * i4; float f[8];
#pragma unroll
              for (int i = 0; i < 8; ++i) f[i] = bf2f(KS[(c0 + i) * 144 + d]) * SM[192 + c0 + i];
              u32x4 w; w.x = pk2(f[0], f[1]); w.y = pk2(f[2], f[3]); w.z = pk2(f[4], f[5]); w.w = pk2(f[6], f[7]);
              *(u32x4*)(proj + (size_t)(t0 + (d >> 1)) * NPJ + OFF_GK + h * 128 + (d & 1) * 64 + c0) = w; } }
        __syncthreads();
#pragma unroll
        for (int nt = 0; nt < 4; ++nt)
#pragma unroll
            for (int j = 0; j < 4; ++j) { const int c = 16 * tw + 4 * fq + j, s = 16 * nt + fr; const float dec = (s <= c) ? __expf(SM[c] - SM[s]) : 0.f;
                AF[c * 65 + s] = (s < c) ? SM[64 + c] * kk[nt][j] * dec : (s == c ? 1.f : 0.f);
                QKB[(size_t)ci * 4096 + c * 64 + s] = f2bf(qk[nt][j] * dec); }
        __syncthreads();
        { const int bb = tw * 16;
          if (lane < 16) {
              for (int i = 1; i < 16; ++i) { float a0 = 0.f, a1 = 0.f; int j = 0;
                  for (; j + 2 <= i; j += 2) { a0 += AF[(bb + i) * 65 + bb + j] * AF[(bb + j) * 65 + bb + lane]; a1 += AF[(bb + i) * 65 + bb + j + 1] * AF[(bb + j + 1) * 65 + bb + lane]; }
                  if (j < i) a0 += AF[(bb + i) * 65 + bb + j] * AF[(bb + j) * 65 + bb + lane];
                  AF[(bb + i) * 65 + bb + lane] = lane < i ? -(a0 + a1) : (lane == i ? 1.f : 0.f); } }
#pragma unroll
          for (int k = 0; k < 4; ++k) { const int row = bb + fq + 4 * k; TB[row * 80 + bb + fr] = f2bf(AF[row * 65 + bb + fr]);
              for (int jb = tw + 1; jb < 4; ++jb) TB[row * 80 + 16 * jb + fr] = (bf16_t)0; }
          __syncthreads();
          for (int i = 1; i < 4; ++i) {
              if (tw < i) { const int j = tw; f32x4 X = {0.f, 0.f, 0.f, 0.f};
                  for (int k = j; k < i; ++k) {
#pragma unroll
                      for (int kk = 0; kk < 4; ++kk) { const float av = AF[(16 * i + fr) * 65 + 16 * k + 4 * kk + fq];
                          const float bv = (k == j) ? AF[(16 * k + 4 * kk + fq) * 65 + 16 * j + fr] : bf2f(TB[(16 * k + 4 * kk + fq) * 80 + 16 * j + fr]);
                          X = __builtin_amdgcn_mfma_f32_16x16x4f32(av, bv, X, 0, 0, 0); } }
                  f32x4 O = {0.f, 0.f, 0.f, 0.f};
#pragma unroll
                  for (int kk = 0; kk < 4; ++kk) O = __builtin_amdgcn_mfma_f32_16x16x4f32(AF[(16 * i + fr) * 65 + 16 * i + 4 * fq + kk], X[kk], O, 0, 0, 0);
#pragma unroll
                  for (int jj = 0; jj < 4; ++jj) TB[(16 * i + 4 * fq + jj) * 80 + 16 * j + fr] = f2bf(-O[jj]); }
              __syncthreads(); }
        }
        { bf16x8 at[2];
#pragma unroll
          for (int ks = 0; ks < 2; ++ks) at[ks] = *(const LAS bf16x8*)(TB + (16 * tw + fr) * 80 + 32 * ks + 8 * fq);
#pragma unroll
          for (int nt = 0; nt < 8; ++nt) { f32x4 a = {0.f, 0.f, 0.f, 0.f};
#pragma unroll
              for (int ks = 0; ks < 2; ++ks) a = mfma16(at[ks], *(const LAS bf16x8*)(VT + (16 * nt + fr) * 80 + 32 * ks + 8 * fq), a);
              const int e = 16 * nt + fr; u32x2 w; w.x = pk2(a[0], a[1]); w.y = pk2(a[2], a[3]);
              *(u32x2*)(proj + (size_t)(t0 + (e >> 1)) * NPJ + OFF_GV + h * 128 + (e & 1) * 64 + 16 * tw + 4 * fq) = w; }
#pragma unroll
          for (int mt = 0; mt < 8; ++mt) { f32x4 a = {0.f, 0.f, 0.f, 0.f};
#pragma unroll
              for (int ks = 0; ks < 2; ++ks) a = mfma16(*(const LAS bf16x8*)(KT + (16 * mt + fr) * 80 + 32 * ks + 8 * fq), at[ks], a);
              u32x2 w; w.x = pk2(a[0], a[1]); w.y = pk2(a[2], a[3]);
              *(u32x2*)(W2 + (size_t)(t0 + 16 * tw + fr) * 1024 + h * 128 + 16 * mt + 4 * fq) = w; } }
        __syncthreads();
    }
}

DI void phase_moba_prep(const Params& P, LAS unsigned char* lds, int wg0, int nwg) {
    const int tid = opq_tid(), lane = tid & 63, wave = tid >> 6, l16 = lane & 15;
    bf16_t* proj = (bf16_t*)(P.ws + WS_R1); float* kmean = (float*)(P.ws + WS_KMEAN);
    LAS bf16_t* VS = (LAS bf16_t*)lds; LAS float* CS = (LAS float*)(lds + 69632);
    for (int task = wg0; task < 1024; task += nwg) {
        const int h = task & 7, blk = (task >> 3) & 63, b = task >> 9; const size_t rbase = (size_t)(b * TT + blk * 256);
        f32x4 qg0 = *(const f32x4*)(P.q_norm + l16 * 8), qg1 = *(const f32x4*)(P.q_norm + l16 * 8 + 4), kg0 = *(const f32x4*)(P.k_norm + l16 * 8), kg1 = *(const f32x4*)(P.k_norm + l16 * 8 + 4);
        float cs[8];
#pragma unroll
        for (int i = 0; i < 8; ++i) cs[i] = 0.f;
        u32x4 rq[8], rk[8], rv[8];
#pragma unroll
        for (int ps = 0; ps < 8; ++ps) { const int r = ps * 32 + wave * 4 + (lane >> 4); const bf16_t* rp = proj + (rbase + r) * NPJ + h * 128 + l16 * 8;
            rq[ps] = *(const u32x4*)(rp + OFF_MQ); rk[ps] = *(const u32x4*)(rp + OFF_MK); rv[ps] = *(const u32x4*)(rp + OFF_MV); }
#pragma unroll
        for (int ps = 0; ps < 8; ++ps) { const int r = ps * 32 + wave * 4 + (lane >> 4); bf16_t* rp = proj + (rbase + r) * NPJ + h * 128 + l16 * 8;
#pragma unroll
            for (int x = 0; x < 2; ++x) { bf16_t* ptr = rp + (x == 0 ? OFF_MQ : OFF_MK); const u32x4 raw = x == 0 ? rq[ps] : rk[ps]; float v[8];
                v[0] = bflo(raw.x); v[1] = bfhi(raw.x); v[2] = bflo(raw.y); v[3] = bfhi(raw.y); v[4] = bflo(raw.z); v[5] = bfhi(raw.z); v[6] = bflo(raw.w); v[7] = bfhi(raw.w);
                float ss = 0.f;
#pragma unroll
                for (int i = 0; i < 8; ++i) ss += v[i] * v[i];
                ss = row16_sum(ss);
                const float rs = rsqrtf(ss * (1.f / 128.f) + 1e-6f); const f32x4 g0 = x == 0 ? qg0 : kg0, g1 = x == 0 ? qg1 : kg1;
#pragma unroll
                for (int i = 0; i < 4; ++i) { v[i] *= rs * g0[i]; v[4 + i] *= rs * g1[i]; }
                if (x == 1) {
#pragma unroll
                    for (int i = 0; i < 8; ++i) cs[i] += v[i]; }
                u32x4 w; w.x = pk2(v[0], v[1]); w.y = pk2(v[2], v[3]); w.z = pk2(v[4], v[5]); w.w = pk2(v[6], v[7]); *(u32x4*)ptr = w; }
            *(LAS u32x4*)(VS + r * 136 + l16 * 8) = rv[ps]; }
#pragma unroll
        for (int i = 0; i < 8; ++i) { cs[i] += __shfl_xor(cs[i], 16); cs[i] += __shfl_xor(cs[i], 32); }
        if (lane < 16) {
#pragma unroll
            for (int i = 0; i < 8; ++i) CS[wave * 128 + lane * 8 + i] = cs[i]; }
        __syncthreads();
        if (tid < 128) { float s = 0.f;
#pragma unroll
            for (int w = 0; w < 8; ++w) s += CS[w * 128 + tid];
            kmean[((size_t)(b * 8 + h) * 64 + blk) * 128 + tid] = s * (1.f / 256.f); }
#pragma unroll 2
        for (int i8 = 0; i8 < 8; ++i8) { const int pid = tid + i8 * 512, e = (pid & 63) + 64 * (pid >> 11), ks = (pid >> 6) & 31; unsigned short f[8];
#pragma unroll
            for (int i = 0; i < 8; ++i) f[i] = VS[(ks * 8 + i) * 136 + e];
            u32x4 w; w.x = f[0] | ((unsigned)f[1] << 16); w.y = f[2] | ((unsigned)f[3] << 16); w.z = f[4] | ((unsigned)f[5] << 16); w.w = f[6] | ((unsigned)f[7] << 16);
            *(u32x4*)(proj + (rbase + 2 * e + (ks >> 4)) * NPJ + OFF_MV + h * 128 + (ks & 15) * 8) = w; }
        __syncthreads();
    }
}

DI void phase_moba_select(const Params& P, LAS unsigned char* lds, int wg0, int nwg) {
    const int tid = opq_tid(), qi = tid >> 1, half = tid & 1;
    const bf16_t* proj = (const bf16_t*)(P.ws + WS_R1); const float* kmean = (const float*)(P.ws + WS_KMEAN);
    int* cnt = (int*)(P.ws + WS_CNT); int* list = (int*)(P.ws + WS_LIST); f32x2* ML = (f32x2*)(P.ws + WS_ML);
    LAS float* KM = (LAS float*)lds; LAS int* hist = (LAS int*)(lds + 32768); LAS int* hbase = (LAS int*)(lds + 32768 + 256);
    for (int task = wg0; task < 1024; task += nwg) {
        const int tk = task >> 8, tw_ = task & 255, bhx = (tw_ >> 6) * 4 + tk, blk = (tk & 1) ? 63 - (tw_ & 63) : (tw_ & 63), h = bhx & 7, b = bhx >> 3; const int bh = b * 8 + h; const int t = blk * 256 + qi; const size_t rid = (size_t)bh * TT + t;
        for (int i = tid; i < blk * 128; i += NTHREADS) KM[i] = kmean[(size_t)bh * 64 * 128 + i];
        if (tid < 64) hist[tid] = 0;
        float q[64];
        { const bf16_t* qp = proj + (size_t)(b * TT + t) * NPJ + OFF_MQ + h * 128 + half * 64;
#pragma unroll
          for (int i = 0; i < 8; ++i) { const u32x4 raw = *(const u32x4*)(qp + 8 * i); q[8 * i] = bflo(raw.x); q[8 * i + 1] = bfhi(raw.x); q[8 * i + 2] = bflo(raw.y); q[8 * i + 3] = bfhi(raw.y);
              q[8 * i + 4] = bflo(raw.z); q[8 * i + 5] = bfhi(raw.z); q[8 * i + 6] = bflo(raw.w); q[8 * i + 7] = bfhi(raw.w); } }
        __syncthreads();
        float v0 = -INFINITY, v1 = -INFINITY, v2 = -INFINITY; int i0 = -1, i1 = -1, i2 = -1;
        for (int n = 0; n < blk; ++n) { const LAS float* km = KM + n * 128 + half * 64; float d0 = 0.f, d1 = 0.f, d2 = 0.f, d3 = 0.f;
#pragma unroll
            for (int i = 0; i < 16; ++i) { const f32x4 kv = *(const LAS f32x4*)(km + 4 * i); d0 += q[4 * i] * kv[0]; d1 += q[4 * i + 1] * kv[1]; d2 += q[4 * i + 2] * kv[2]; d3 += q[4 * i + 3] * kv[3]; }
            float g = (d0 + d1) + (d2 + d3); g += __shfl_xor(g, 1);
            if (g > v0) { v2 = v1; i2 = i1; v1 = v0; i1 = i0; v0 = g; i0 = n; } else if (g > v1) { v2 = v1; i2 = i1; v1 = g; i1 = n; } else if (g > v2) { v2 = g; i2 = n; } }
        int rk0 = 0, rk1 = 0, rk2 = 0;
        if (half == 0) { if (i0 >= 0) rk0 = __hip_atomic_fetch_add(&hist[i0], 1, __ATOMIC_RELAXED, __HIP_MEMORY_SCOPE_WORKGROUP); if (i1 >= 0) rk1 = __hip_atomic_fetch_add(&hist[i1], 1, __ATOMIC_RELAXED, __HIP_MEMORY_SCOPE_WORKGROUP); if (i2 >= 0) rk2 = __hip_atomic_fetch_add(&hist[i2], 1, __ATOMIC_RELAXED, __HIP_MEMORY_SCOPE_WORKGROUP); }
        __syncthreads();
        if (tid < 64) { const int c = hist[tid]; hbase[tid] = c > 0 ? atomicAdd(&cnt[bh * 64 + tid], c) : 0; }
        __syncthreads();
        if (half == 0) {
            const f32x2 dead = {-INFINITY, 0.f};
            if (i0 >= 0) list[(size_t)bh * LISTN + i0 * 16384 - 128 * i0 * (i0 + 1) + hbase[i0] + rk0] = t; else ML[0 * 262144 + rid] = dead;
            if (i1 >= 0) list[(size_t)bh * LISTN + i1 * 16384 - 128 * i1 * (i1 + 1) + hbase[i1] + rk1] = t | (1 << 14); else ML[1 * 262144 + rid] = dead;
            if (i2 >= 0) list[(size_t)bh * LISTN + i2 * 16384 - 128 * i2 * (i2 + 1) + hbase[i2] + rk2] = t | (2 << 14); else ML[2 * 262144 + rid] = dead;
        }
        __syncthreads();
    }
}

constexpr int G2_W = 0, G2_Q = 18432, G2_QK = 36864, G2_KD = 47104, G2_BUF = 67584, G2_RED = 135168;
DI void phase_gdn_scan(const Params& P, LAS unsigned char* lds, int bh) {
    const int tid = opq_tid(), lane = tid & 63, w = tid >> 6, fr = lane & 15, fq = lane >> 4, b = bh >> 3, h = bh & 7;
    const bf16_t* proj = (const bf16_t*)(P.ws + WS_R1); const bf16_t* W2 = (const bf16_t*)(P.ws + WS_W2); const bf16_t* QKB = (const bf16_t*)(P.ws + WS_QKB);
    const float* GL = (const float*)(P.ws + WS_GL); bf16_t* mix = (bf16_t*)(P.ws + WS_R2);
    float* SSQ = (float*)(P.ws + WS_SSQ);
    const int e = 16 * w + fr; const float gnw = P.gdn_norm[e];
    f32x4 S[8];
#pragma unroll
    for (int i = 0; i < 8; ++i) S[i] = (f32x4){0.f, 0.f, 0.f, 0.f};
    const int wrow0 = tid >> 4, wseg = tid & 15;
    const int qrow = tid >> 3, qseg = tid & 7;
    struct Stage { u32x4 sw[2], sq[2], sqk, skd[2]; };
    u32x2 un[4];
    Stage stA, stB;
#define G2_LOAD(X, nn) do { const int t0_ = b * TT + (nn) * 64; const int ci_ = ((b * 256 + (nn)) << 3) + h; \
        _Pragma("unroll") for (int i_ = 0; i_ < 2; ++i_) { X.sw[i_] = *(const u32x4*)(W2 + (size_t)(t0_ + wrow0 + 32 * i_) * 1024 + h * 128 + wseg * 8); \
            X.sq[i_] = *(const u32x4*)(proj + (size_t)(t0_ + wrow0 + 32 * i_) * NPJ + OFF_GQ + h * 128 + wseg * 8); \
            const int d_ = qrow + 64 * i_; X.skd[i_] = *(const u32x4*)(proj + (size_t)(t0_ + (d_ >> 1)) * NPJ + OFF_GK + h * 128 + (d_ & 1) * 64 + qseg * 8); } \
        X.sqk = *(const u32x4*)(QKB + (size_t)ci_ * 4096 + qrow * 64 + qseg * 8); } while (0)
#define UN_LOAD(nn) do { const int t0_ = b * TT + (nn) * 64; _Pragma("unroll") for (int mt_ = 0; mt_ < 4; ++mt_) un[mt_] = *(const u32x2*)(proj + (size_t)(t0_ + (e >> 1)) * NPJ + OFF_GV + h * 128 + (e & 1) * 64 + 16 * mt_ + 4 * fq); } while (0)
#define G2_ST2(base_, rowoff_, sg_, v_) do { const int g_ = ((sg_) >> 2) * 64, d_ = ((sg_) & 3) * 8; \
        *(LAS u32x2*)(B_ + (base_) + (rowoff_) + g_ + perm4(d_) * 2) = (u32x2){(v_).x, (v_).y}; *(LAS u32x2*)(B_ + (base_) + (rowoff_) + g_ + perm4(d_ + 4) * 2) = (u32x2){(v_).z, (v_).w}; } while (0)
#define G2_STORE(X, bufi) do { LAS unsigned char* B_ = lds + (bufi) * G2_BUF; \
        _Pragma("unroll") for (int i_ = 0; i_ < 2; ++i_) { G2_ST2(G2_W, (wrow0 + 32 * i_) * 288, wseg, X.sw[i_]); G2_ST2(G2_Q, (wrow0 + 32 * i_) * 288, wseg, X.sq[i_]); \
            G2_ST2(G2_KD, (qrow + 64 * i_) * 160, qseg, X.skd[i_]); } \
        G2_ST2(G2_QK, qrow * 160, qseg, X.sqk); } while (0)
    G2_LOAD(stA, 0); G2_STORE(stA, 0); UN_LOAD(0);
    float egl_n = GL[bh * 256];
    u32x2 uc[4];
#pragma unroll
    for (int i = 0; i < 4; ++i) uc[i] = un[i];
    G2_LOAD(stA, 1);
    __syncthreads();
    for (int n2 = 0; n2 < 256; n2 += 2) {
#pragma unroll
      for (int hf2 = 0; hf2 < 2; ++hf2) {
        const int n = n2 + hf2; Stage& LDs = hf2 ? stA : stB; Stage& STs = hf2 ? stB : stA;
        const int cur = hf2, t0 = b * TT + n * 64; LAS unsigned char* Bf = lds + cur * G2_BUF;
        { const int n2c = n + 2 < 256 ? n + 2 : 255, n1c = n + 1 < 256 ? n + 1 : 255; G2_LOAD(LDs, n2c); UN_LOAD(n1c); }
        const float egl = egl_n; egl_n = GL[bh * 256 + (n + 1 < 256 ? n + 1 : 255)];
        f32x4 Pm[4], Om[4];
#pragma unroll
        for (int mt = 0; mt < 4; ++mt) { Pm[mt] = (f32x4){0.f, 0.f, 0.f, 0.f}; Om[mt] = (f32x4){0.f, 0.f, 0.f, 0.f}; }
#define SBAR __builtin_amdgcn_sched_barrier(0)
#define LD_K4(dst, base_, ks_) do { const int o0_ = fr * 288 + (32 * (ks_) + 8 * fq) * 2; \
        dst[0] = *(const LAS bf16x8*)(Bf + base_ + o0_); dst[1] = *(const LAS bf16x8*)(Bf + base_ + o0_ + 4608); \
        dst[2] = *(const LAS bf16x8*)(Bf + base_ + o0_ + 9216); dst[3] = *(const LAS bf16x8*)(Bf + base_ + o0_ + 13824); } while (0)
#define MM_K4(src, sb_, A_) do { A_[0] = mfma16(src[0], sb_, A_[0]); A_[1] = mfma16(src[1], sb_, A_[1]); A_[2] = mfma16(src[2], sb_, A_[2]); A_[3] = mfma16(src[3], sb_, A_[3]); } while (0)
#define LD_R4(dst, base_, r0_, k2_) do { const int o0_ = (16 * (r0_) + fr) * 160 + (32 * (k2_) + 8 * fq) * 2; \
        dst[0] = *(const LAS bf16x8*)(Bf + base_ + o0_); dst[1] = *(const LAS bf16x8*)(Bf + base_ + o0_ + 2560); \
        dst[2] = *(const LAS bf16x8*)(Bf + base_ + o0_ + 5120); dst[3] = *(const LAS bf16x8*)(Bf + base_ + o0_ + 7680); } while (0)
#define MM_R4(src, vb_, A0_, A1_, A2_, A3_) do { A0_ = mfma16(src[0], vb_, A0_); A1_ = mfma16(src[1], vb_, A1_); A2_ = mfma16(src[2], vb_, A2_); A3_ = mfma16(src[3], vb_, A3_); } while (0)
        bf16x8 fa[4], fb[4];
        LD_K4(fa, G2_W, 0);
        const bf16x8 sb0 = pack8(S[0], S[1]), sb1 = pack8(S[2], S[3]), sb2 = pack8(S[4], S[5]), sb3 = pack8(S[6], S[7]);
        LD_K4(fb, G2_W, 1); SBAR; MM_K4(fa, sb0, Pm); SBAR;
        LD_K4(fa, G2_W, 2); SBAR; MM_K4(fb, sb1, Pm); SBAR;
        LD_K4(fb, G2_W, 3); SBAR; MM_K4(fa, sb2, Pm); SBAR;
        LD_K4(fa, G2_Q, 0); SBAR; MM_K4(fb, sb3, Pm); SBAR;
        f32x4 vn[4];
#pragma unroll
        for (int mt = 0; mt < 4; ++mt) { vn[mt][0] = bflo(uc[mt].x) - Pm[mt][0]; vn[mt][1] = bfhi(uc[mt].x) - Pm[mt][1]; vn[mt][2] = bflo(uc[mt].y) - Pm[mt][2]; vn[mt][3] = bfhi(uc[mt].y) - Pm[mt][3]; }
        bf16x8 Vb[2];
#pragma unroll
        for (int k2 = 0; k2 < 2; ++k2) Vb[k2] = pack8(vn[2 * k2], vn[2 * k2 + 1]);
        LD_K4(fb, G2_Q, 1); SBAR; MM_K4(fa, sb0, Om); SBAR;
        LD_K4(fa, G2_Q, 2); SBAR; MM_K4(fb, sb1, Om); SBAR;
        LD_K4(fb, G2_Q, 3); SBAR; MM_K4(fa, sb2, Om); SBAR;
        LD_R4(fa, G2_QK, 0, 0); SBAR; MM_K4(fb, sb3, Om); SBAR;
#pragma unroll
        for (int dt = 0; dt < 8; ++dt) S[dt] = S[dt] * egl;
        SBAR;
        LD_R4(fb, G2_QK, 0, 1); SBAR; MM_R4(fa, Vb[0], Om[0], Om[1], Om[2], Om[3]); SBAR;
        LD_R4(fa, G2_KD, 0, 0); SBAR; MM_R4(fb, Vb[1], Om[0], Om[1], Om[2], Om[3]); SBAR;
        LD_R4(fb, G2_KD, 0, 1); SBAR; MM_R4(fa, Vb[0], S[0], S[1], S[2], S[3]); SBAR;
        LD_R4(fa, G2_KD, 4, 0); SBAR; MM_R4(fb, Vb[1], S[0], S[1], S[2], S[3]); SBAR;
        LD_R4(fb, G2_KD, 4, 1); SBAR; MM_R4(fa, Vb[0], S[4], S[5], S[6], S[7]); SBAR;
        MM_R4(fb, Vb[1], S[4], S[5], S[6], S[7]); SBAR;
#undef LD_K4
#undef MM_K4
#undef LD_R4
#undef MM_R4
#undef SBAR
        { G2_STORE(STs, cur ^ 1);
#pragma unroll
            for (int i = 0; i < 4; ++i) uc[i] = un[i]; }
        { LAS bf16_t* OTW = (LAS bf16_t*)(lds + G2_RED + w * 2048);
#pragma unroll
          for (int mt = 0; mt < 4; ++mt)
#pragma unroll
            for (int j = 0; j < 4; ++j) OTW[(16 * mt + 4 * fq + j) * 16 + fr] = f2bf(Om[mt][j]);
#pragma unroll
          for (int i = 0; i < 2; ++i) { const int row = (lane >> 1) + 32 * i, hv = lane & 1;
              bf16_t* mp_ = mix + (size_t)(t0 + row) * DM + h * 128 + 16 * w + 8 * hv; const u32x4 ov_ = *(const LAS u32x4*)(OTW + row * 16 + hv * 8);
              asm volatile("global_store_dwordx4 %0, %1, off" :: "v"(mp_), "v"(ov_) : "memory"); } }
        __syncthreads();
      }
    }
#undef G2_LOAD
#undef UN_LOAD
#undef G2_STORE
#undef G2_ST2
    asm volatile("s_waitcnt vmcnt(0)" ::: "memory");
    __syncthreads();
}

constexpr int AT_KS = 0, AT_VT = 73728, AT_PF = 143360, AT_MISC = 147712;
DI void phase_moba_attn(const Params& P, LAS unsigned char* lds) {
    const int tid = opq_tid(), lane = tid & 63, w = tid >> 6, fr = lane & 15, fq = lane >> 4;
    const bf16_t* proj = (const bf16_t*)(P.ws + WS_R1); const int* cnt = (const int*)(P.ws + WS_CNT); const int* list = (const int*)(P.ws + WS_LIST);
    f32x2* ML = (f32x2*)(P.ws + WS_ML); bf16_t* opart = (bf16_t*)P.out; unsigned* workctr = (unsigned*)(P.ws + WS_CTL);
    LAS bf16_t* KS = (LAS bf16_t*)(lds + AT_KS); LAS bf16_t* VT = (LAS bf16_t*)(lds + AT_VT); LAS int* PF = (LAS int*)(lds + AT_PF); LAS int* MISC = (LAS int*)(lds + AT_MISC);
    { const int c0 = cnt[2 * tid], c1 = cnt[2 * tid + 1]; const int a = (c0 + 511) >> 9, bsum = a + ((c1 + 511) >> 9); int inc = bsum;
#pragma unroll
      for (int o = 1; o < 64; o <<= 1) { const int v = __shfl_up(inc, o); if (lane >= o) inc += v; }
      if (lane == 63) MISC[8 + w] = inc;
      __syncthreads();
      int wb = 0;
#pragma unroll
      for (int i = 0; i < 8; ++i) wb += (i < w) ? MISC[8 + i] : 0;
      const int ex = wb + inc - bsum; PF[2 * tid] = ex; PF[2 * tid + 1] = ex + a; if (tid == 511) PF[1024] = ex + bsum;
      __syncthreads(); }
    const int totalG = PF[1024];
    const float sc2 = 0.08838834764831845f * 1.4426950408889634f;
    const int tid_at = tid;
    for (;;) {
        int tid = tid_at; asm volatile("" : "+v"(tid)); const int lane = tid & 63, w = __builtin_amdgcn_readfirstlane(tid >> 6), fr = lane & 15, fq = lane >> 4;
        if (tid == 0) MISC[0] = (int)atomicAdd(workctr, 1u);
        __syncthreads();
        const int wid = MISC[0];
        __syncthreads();
        if (wid >= totalG + 1024) break;
        int bh, j, causal, qstart, qcount;
        if (wid < totalG) { int lo = 0, hi = 1024; while (hi - lo > 1) { const int mid = (lo + hi) >> 1; if (PF[mid] <= wid) lo = mid; else hi = mid; }
            bh = lo >> 6; j = lo & 63; causal = 0; qstart = (wid - PF[lo]) * 512; const int c = cnt[lo]; qcount = c - qstart; if (qcount > 512) qcount = 512; }
        else { const int o = wid - totalG; bh = o >> 6; j = o & 63; causal = 1; qstart = 0; qcount = 256; }
        const int b = bh >> 3, h = bh & 7; const size_t kbase = (size_t)(b * TT + j * 256);
        { u32x4 kr[8], vr[8];
#pragma unroll
          for (int i8 = 0; i8 < 8; ++i8) { const int pid = tid + i8 * 512; kr[i8] = *(const u32x4*)(proj + (kbase + (pid >> 4)) * NPJ + OFF_MK + h * 128 + (pid & 15) * 8);
              const int e = pid >> 5, ks = pid & 31; vr[i8] = *(const u32x4*)(proj + (kbase + 2 * e + (ks >> 4)) * NPJ + OFF_MV + h * 128 + (ks & 15) * 8); }
#pragma unroll
          for (int i8 = 0; i8 < 8; ++i8) { const int pid = tid + i8 * 512; *(LAS u32x4*)(KS + (pid >> 4) * 144 + (pid & 15) * 8) = kr[i8];
              const int e = pid >> 5, ks = pid & 31; const int g_ = (ks >> 2) * 32, d_ = (ks & 3) * 8;
              *(LAS u32x2*)(VT + e * 272 + g_ + perm4(d_)) = (u32x2){vr[i8].x, vr[i8].y}; *(LAS u32x2*)(VT + e * 272 + g_ + perm4(d_ + 4)) = (u32x2){vr[i8].z, vr[i8].w}; } }
        const int lbase = bh * LISTN + j * 16384 - 128 * j * (j + 1) + qstart;
        const int ntile = (qcount + 127) >> 7;
        int en0, en1, en2, en3;
        { const int q0 = 16 * w + fr, lim = qcount - 1;
          if (causal) { en0 = (j * 256 + q0) | (3 << 14); en1 = (j * 256 + q0 + 128) | (3 << 14); en2 = en1; en3 = en1; }
          else { en0 = list[lbase + (q0 < lim ? q0 : lim)]; en1 = list[lbase + (q0 + 128 < lim ? q0 + 128 : lim)]; en2 = list[lbase + (q0 + 256 < lim ? q0 + 256 : lim)]; en3 = list[lbase + (q0 + 384 < lim ? q0 + 384 : lim)]; } }
        bf16x8 Bq[4], Bn[4];
        { const bf16_t* qp = proj + (size_t)(b * TT + (en0 & 16383)) * NPJ + OFF_MQ + h * 128 + 8 * fq;
#pragma unroll
          for (int ks = 0; ks < 4; ++ks) Bq[ks] = *(const bf16x8*)(qp + 32 * ks); }
        __syncthreads();
        for (int tile = 0; tile < ntile; ++tile) {
            const int en = tile == 0 ? en0 : (tile == 1 ? en1 : (tile == 2 ? en2 : en3));
            { const int enx = tile == 0 ? en1 : (tile == 1 ? en2 : en3); const bf16_t* qp = proj + (size_t)(b * TT + (enx & 16383)) * NPJ + OFF_MQ + h * 128 + 8 * fq;
#pragma unroll
              for (int ks = 0; ks < 4; ++ks) Bn[ks] = *(const bf16x8*)(qp + 32 * ks); }
            const int qi = tile * 128 + 16 * w + fr; const bool valid = qi < qcount; const int t = en & 16383, slot = en >> 14;
            if (tile * 128 + 16 * w < qcount) {
            const int nkt = causal ? (8 * tile + w + 1) : 16;
            f32x4 st[16]; float mx = -INFINITY;
#pragma unroll
            for (int kp = 0; kp < 8; ++kp) { f32x4 a0 = {0.f, 0.f, 0.f, 0.f}, a1 = {0.f, 0.f, 0.f, 0.f};
                if (2 * kp < nkt) { bf16x8 kf[8];
#pragma unroll
                    for (int ks = 0; ks < 4; ++ks) { kf[ks] = *(const LAS bf16x8*)(KS + (32 * kp + fr) * 144 + 32 * ks + 8 * fq); kf[4 + ks] = *(const LAS bf16x8*)(KS + (32 * kp + 16 + fr) * 144 + 32 * ks + 8 * fq); }
#pragma unroll
                    for (int ks = 0; ks < 4; ++ks) { a0 = mfma16(kf[ks], Bq[ks], a0); a1 = mfma16(kf[4 + ks], Bq[ks], a1); }
#pragma unroll
                    for (int jj = 0; jj < 4; ++jj) { float s0 = a0[jj] * sc2, s1 = a1[jj] * sc2;
                        if (causal && (32 * kp + 4 * fq + jj) > qi) s0 = -INFINITY; if ((causal && (32 * kp + 16 + 4 * fq + jj) > qi) || 2 * kp + 1 >= nkt) s1 = -INFINITY;
                        a0[jj] = s0; a1[jj] = s1; mx = fmaxf(mx, fmaxf(s0, s1)); }
                } else { a0 = (f32x4){-INFINITY, -INFINITY, -INFINITY, -INFINITY}; a1 = a0; }
                st[2 * kp] = a0; st[2 * kp + 1] = a1; }
            mx = fmaxf(mx, __shfl_xor(mx, 16)); mx = fmaxf(mx, __shfl_xor(mx, 32));
            float ls = 0.f;
#pragma unroll
            for (int kt = 0; kt < 16; ++kt)
#pragma unroll
                for (int jj = 0; jj < 4; ++jj) { const float pv = exp2f(st[kt][jj] - mx); st[kt][jj] = pv; ls += pv; }
            ls += __shfl_xor(ls, 16); ls += __shfl_xor(ls, 32);
            f32x4 ot[8];
#pragma unroll
            for (int et = 0; et < 8; ++et) ot[et] = (f32x4){0.f, 0.f, 0.f, 0.f};
#pragma unroll
            for (int k2 = 0; k2 < 8; ++k2) { if (2 * k2 < nkt) { const bf16x8 pb = pack8(st[2 * k2], st[2 * k2 + 1]);
#pragma unroll
                    for (int eh = 0; eh < 2; ++eh) { bf16x8 vf[4];
#pragma unroll
                        for (int et = 0; et < 4; ++et) vf[et] = *(const LAS bf16x8*)(VT + (16 * (4 * eh + et) + fr) * 272 + 32 * k2 + 8 * fq);
#pragma unroll
                        for (int et = 0; et < 4; ++et) ot[4 * eh + et] = mfma16(vf[et], pb, ot[4 * eh + et]); } } }
            if (valid) { const float il = 1.f / ls; const size_t rid = (size_t)bh * TT + t; bf16_t* op = opart + ((size_t)slot * 262144 + rid) * 128 + 4 * fq;
#pragma unroll
                for (int et = 0; et < 8; ++et) { u32x2 wv; wv.x = pk2(ot[et][0] * il, ot[et][1] * il); wv.y = pk2(ot[et][2] * il, ot[et][3] * il); *(u32x2*)(op + 16 * et) = wv; }
                if (fq == 0) ML[(size_t)slot * 262144 + rid] = (f32x2){mx, ls}; }
            }
#pragma unroll
            for (int ks = 0; ks < 4; ++ks) Bq[ks] = Bn[ks];
        }
        __syncthreads();
    }
}

DI void phase_moba_combine(const Params& P) {
    const bf16_t* opart = (const bf16_t*)P.out; const f32x2* ML = (const f32x2*)(P.ws + WS_ML); bf16_t* mix = (bf16_t*)(P.ws + WS_R2);
    const int gtid = blockIdx.x * NTHREADS + opq_tid(), gsz = gridDim.x * NTHREADS;
    { const bf16_t* proj = (const bf16_t*)(P.ws + WS_R1);
      for (int i0 = gtid; i0 < MT * 128; i0 += 4 * gsz) { u32x4 mv[4], zv[4];
#pragma unroll
          for (int k = 0; k < 4; ++k) { const int i = i0 + k * gsz < MT * 128 ? i0 + k * gsz : i0; const int row = i >> 7, sg = i & 127; mv[k] = *(const u32x4*)(mix + (size_t)row * DM + sg * 8); zv[k] = *(const u32x4*)(proj + (size_t)row * NPJ + OFF_GZ + sg * 8); }
          const int sg0 = i0 & 127; const f32x4 g0 = *(const f32x4*)(P.gdn_norm + (sg0 & 15) * 8), g1 = *(const f32x4*)(P.gdn_norm + (sg0 & 15) * 8 + 4);
#pragma unroll
          for (int k = 0; k < 4; ++k) { const int i = i0 + k * gsz; const int row = i >> 7, sg = i & 127;
              float o[8]; o[0] = bflo(mv[k].x); o[1] = bfhi(mv[k].x); o[2] = bflo(mv[k].y); o[3] = bfhi(mv[k].y); o[4] = bflo(mv[k].z); o[5] = bfhi(mv[k].z); o[6] = bflo(mv[k].w); o[7] = bfhi(mv[k].w);
              float ssl = 0.f;
#pragma unroll
              for (int q = 0; q < 8; ++q) ssl += o[q] * o[q];
              const float rs = rsqrtf(row16_sum(ssl) * (1.f / 128.f) + 1e-6f); const u32x4 z = zv[k];
              u32x4 wv; wv.x = pk2(o[0] * rs * g0[0] * silu_f(bflo(z.x)), o[1] * rs * g0[1] * silu_f(bfhi(z.x))); wv.y = pk2(o[2] * rs * g0[2] * silu_f(bflo(z.y)), o[3] * rs * g0[3] * silu_f(bfhi(z.y)));
              wv.z = pk2(o[4] * rs * g1[0] * silu_f(bflo(z.z)), o[5] * rs * g1[1] * silu_f(bfhi(z.z))); wv.w = pk2(o[6] * rs * g1[2] * silu_f(bflo(z.w)), o[7] * rs * g1[3] * silu_f(bfhi(z.w)));
              if (i < MT * 128) *(u32x4*)(mix + (size_t)row * DM + sg * 8) = wv; } } }
    for (int i0 = gtid; i0 < 262144 * 16; i0 += 2 * gsz) {
        f32x2 ml[2][4]; u32x4 raw[2][4];
#pragma unroll
        for (int k = 0; k < 2; ++k) { const int i = i0 + k * gsz < 262144 * 16 ? i0 + k * gsz : i0; const int rid = i >> 4, sg = i & 15;
#pragma unroll
            for (int s = 0; s < 4; ++s) { ml[k][s] = ML[(size_t)s * 262144 + rid]; raw[k][s] = *(const u32x4*)(opart + ((size_t)s * 262144 + rid) * 128 + sg * 8); } }
#pragma unroll
        for (int k = 0; k < 2; ++k) { const int i = i0 + k * gsz; const int rid = i >> 4, sg = i & 15; const int bh = rid >> 14, t = rid & 16383, b = bh >> 3, h = bh & 7;
            float M = -INFINITY;
#pragma unroll
            for (int s = 0; s < 4; ++s) M = fmaxf(M, ml[k][s].x);
            float wgt[4], Lt = 0.f;
#pragma unroll
            for (int s = 0; s < 4; ++s) { wgt[s] = ml[k][s].y > 0.f ? ml[k][s].y * exp2f(ml[k][s].x - M) : 0.f; Lt += wgt[s]; }
            const float iL = 1.f / Lt; float o[8];
#pragma unroll
            for (int q = 0; q < 8; ++q) o[q] = 0.f;
#pragma unroll
            for (int s = 0; s < 4; ++s) { const float ww = wgt[s] * iL; const u32x4 r = raw[k][s];
                if (wgt[s] > 0.f) { o[0] += ww * bflo(r.x); o[1] += ww * bfhi(r.x); o[2] += ww * bflo(r.y); o[3] += ww * bfhi(r.y); o[4] += ww * bflo(r.z); o[5] += ww * bfhi(r.z); o[6] += ww * bflo(r.w); o[7] += ww * bfhi(r.w); } }
            u32x4 wv; wv.x = pk2(o[0], o[1]); wv.y = pk2(o[2], o[3]); wv.z = pk2(o[4], o[5]); wv.w = pk2(o[6], o[7]);
            if (i < 262144 * 16) *(u32x4*)(mix + (size_t)(b * TT + t) * DM + 1024 + h * 128 + sg * 8) = wv; } }
}

DI void sub_barrier(unsigned* ctr, unsigned nwg) {
    asm volatile("s_waitcnt vmcnt(0)" ::: "memory");
    __syncthreads();
    if (threadIdx.x == 0) {
        __builtin_amdgcn_fence(__ATOMIC_RELEASE, "agent");
        __hip_atomic_fetch_add(ctr, 1u, __ATOMIC_RELAXED, __HIP_MEMORY_SCOPE_AGENT);
        while (__hip_atomic_load(ctr, __ATOMIC_RELAXED, __HIP_MEMORY_SCOPE_AGENT) < nwg) __builtin_amdgcn_s_sleep(8);
        __builtin_amdgcn_fence(__ATOMIC_ACQUIRE, "agent");
        asm volatile("s_waitcnt vmcnt(0)" ::: "memory");
    }
    __syncthreads();
}

__global__ void __launch_bounds__(NTHREADS) hybrid_fwd(Params P) {
    extern __shared__ __attribute__((aligned(16))) unsigned char smem[];
    LAS unsigned char* lds = (LAS unsigned char*)smem;
    cg::grid_group grid = cg::this_grid();
    unsigned char* ws = P.ws; const int G = gridDim.x, bx = blockIdx.x;
    bf16_t* R0 = (bf16_t*)(ws + WS_R0); bf16_t* R1 = (bf16_t*)(ws + WS_R1); bf16_t* R2 = (bf16_t*)(ws + WS_R2);
    float* ss1 = (float*)(ws + WS_SS1); float* ss2 = (float*)(ws + WS_SS2);

    phase_prep(P, lds);
    grid.sync();
    { pg8::Gemm g{R0, (const bf16_t*)(ws + WS_WIN), MT, NPJ, DM}; pg8::StaticOrder S; S.init(MT, NPJ, G, bx); EpiProj E{R1, (bf16_t*)(ws + WS_HALO)}; pg8::gemm_phase<decltype(E), pg8::StaticOrder, true, true>(lds, g, S, E); }
    phase_ba(P);
    grid.sync();
    phase_gdn_prep(P, lds);
    grid.sync();
    if (bx < 16) phase_gdn_scan(P, lds, bx);
    else { unsigned* ctl = (unsigned*)(ws + WS_CTL);
        phase_moba_prep(P, lds, bx - 16, G - 16); sub_barrier(ctl + 8, (unsigned)(G - 16));
        phase_moba_select(P, lds, bx - 16, G - 16); sub_barrier(ctl + 9, (unsigned)(G - 16));
        phase_moba_attn(P, lds);
        phase_wconv_late(P, lds, bx - 16, G - 16); }
    grid.sync();
    phase_moba_combine(P);
    grid.sync();
    { pg8::Gemm g{R2, (const bf16_t*)(ws + WS_WO), MT, DM, DM}; pg8::StaticOrder S; S.init(MT, DM, G, bx); EpiResid E{P.x, P.out, R0, ss1}; pg8::gemm_phase<decltype(E), pg8::StaticOrder, true, false>(lds, g, S, E); }
    grid.sync();
    { pg8::Gemm g{R0, (const bf16_t*)(ws + WS_WGU), MT, 2 * FF, DM}; pg8::StaticOrder S; S.init(MT, 2 * FF, G, bx); EpiAct E{R1, ss1}; pg8::gemm_phase<decltype(E), pg8::StaticOrder, true, true>(lds, g, S, E); }
    grid.sync();
    { pg8::Gemm g{(const bf16_t*)(ws + WS_PB), (const bf16_t*)(ws + WS_WPP), MT, DM, 256}; pg8::StaticOrder S; S.init(MT, DM, G, bx); EpiPlainBf16 E{R0, DM}; pg8::gemm_phase<decltype(E), pg8::StaticOrder, true, false>(lds, g, S, E); }
    { pg8::Gemm g{R1, (const bf16_t*)(ws + WS_WDN), MT, DM, FF}; pg8::StaticOrder S; S.init(MT, DM, G, bx); EpiResid E{P.out, P.out, R2, ss2}; pg8::gemm_phase<decltype(E), pg8::StaticOrder, true, false>(lds, g, S, E); }
    grid.sync();
    { pg8::Gemm g{R2, (const bf16_t*)(ws + WS_WPG), MT, DM, DM}; pg8::StaticOrder S; S.init(MT, DM, G, bx); EpiOut E{P.out, R0, ss2}; pg8::gemm_phase<decltype(E), pg8::StaticOrder, true, false>(lds, g, S, E); }
}

extern "C" void kernel_launch(void* const* d_in, const int* in_sizes, int n_in, void* d_out, int out_size, void* d_ws, size_t ws_size, hipStream_t stream) {
    static int grid_blocks = 0;
    if (!grid_blocks) {
        int dev = 0, cus = 0, per_cu = 0;
        hipGetDevice(&dev);
        hipDeviceGetAttribute(&cus, hipDeviceAttributeMultiprocessorCount, dev);
        hipFuncSetAttribute((const void*)hybrid_fwd, hipFuncAttributeMaxDynamicSharedMemorySize, LDS_BYTES);
        hipOccupancyMaxActiveBlocksPerMultiprocessor(&per_cu, (const void*)hybrid_fwd, NTHREADS, LDS_BYTES);
        if (per_cu < 1) per_cu = 1;
        grid_blocks = cus * per_cu;
        if (ws_size < WS_END) fprintf(stderr, "kernel_launch: workspace too small: %zu < %zu\n", ws_size, (size_t)WS_END);
    }
    Params p{};
    p.x = (const float*)d_in[0]; p.p = (const float*)d_in[1]; p.attn_norm = (const float*)d_in[2]; p.w_in = (const float*)d_in[3]; p.conv_w = (const float*)d_in[4];
    p.A_log = (const float*)d_in[5]; p.dt_bias = (const float*)d_in[6]; p.gdn_norm = (const float*)d_in[7]; p.q_norm = (const float*)d_in[8]; p.k_norm = (const float*)d_in[9];
    p.w_o = (const float*)d_in[10]; p.ffn_norm = (const float*)d_in[11]; p.w_gate = (const float*)d_in[12]; p.w_up = (const float*)d_in[13]; p.w_down = (const float*)d_in[14];
    p.ple_norm = (const float*)d_in[15]; p.w_pg = (const float*)d_in[16]; p.w_pp = (const float*)d_in[17];
    p.out = (float*)d_out; p.ws = (unsigned char*)d_ws;
    void* args[] = {&p};
    hipError_t e = hipLaunchCooperativeKernel((const void*)hybrid_fwd, dim3(grid_blocks), dim3(NTHREADS), args, LDS_BYTES, stream);
    if (e != hipSuccess) fprintf(stderr, "cooperative launch failed: %s (grid %d)\n", hipGetErrorString(e), grid_blocks);
}
```

```cpp
#include <hip/hip_runtime.h>
#include <hip/hip_cooperative_groups.h>
#include <cstdio>
namespace cg = cooperative_groups;

#define LAS __attribute__((address_space(3)))
#define DI __device__ __forceinline__
typedef unsigned short bf16_t;
typedef short bf16x8 __attribute__((ext_vector_type(8)));
typedef float f32x4 __attribute__((ext_vector_type(4)));
typedef float f32x2 __attribute__((ext_vector_type(2)));
typedef unsigned u32x4 __attribute__((ext_vector_type(4)));
typedef unsigned u32x2 __attribute__((ext_vector_type(2)));
typedef __bf16 bfv2 __attribute__((ext_vector_type(2)));

constexpr int DM = 2048, TT = 16384, MT = 32768, NPJ = 7168, FF = 5632, INW = 7184;
constexpr int OFF_GQ = 0, OFF_GK = 1024, OFF_GV = 2048, OFF_GZ = 3072, OFF_MQ = 4096, OFF_MK = 5120, OFF_MV = 6144;
constexpr int LISTN = 516096;
constexpr int NTHREADS = 512;
constexpr int LDS_BYTES = 163840;

constexpr size_t WS_CTL   = 0;
constexpr size_t WS_CNT   = 4096;
constexpr size_t WS_SS1   = 8192;
constexpr size_t WS_SS2   = WS_SS1 + 131072;
constexpr size_t WS_GL    = WS_SS2 + 131072;
constexpr size_t WS_KMEAN = WS_GL + 16384;
constexpr size_t WS_WBA   = WS_KMEAN + 524288;
constexpr size_t WS_BA    = WS_WBA + 65536;
constexpr size_t WS_WIN   = WS_BA + 2097152;
constexpr size_t WS_WO    = WS_WIN + (size_t)7168 * 2048 * 2;
constexpr size_t WS_WGU   = WS_WO + (size_t)2048 * 2048 * 2;
constexpr size_t WS_WDN   = WS_WGU + (size_t)11264 * 2048 * 2;
constexpr size_t WS_WPG   = WS_WDN + (size_t)2048 * 5632 * 2;
constexpr size_t WS_WPP   = WS_WPG + (size_t)2048 * 2048 * 2;
constexpr size_t WS_PB    = WS_WPP + (size_t)2048 * 256 * 2;
constexpr size_t WS_R0    = WS_PB + (size_t)32768 * 256 * 2;
constexpr size_t WS_R1    = WS_R0 + (size_t)32768 * 2048 * 2;
constexpr size_t WS_R2    = WS_R1 + (size_t)32768 * 7168 * 2;
constexpr size_t WS_W2    = WS_R2 + (size_t)32768 * 2048 * 2;
constexpr size_t WS_QKB   = WS_W2 + (size_t)32768 * 1024 * 2;
constexpr size_t WS_HALO  = WS_QKB + (size_t)4096 * 4096 * 2;
constexpr size_t WS_LIST  = WS_HALO + (size_t)513 * 3 * 3072 * 2 + 256 - ((size_t)513 * 3 * 3072 * 2) % 256;
constexpr size_t WS_ML    = WS_LIST + (size_t)16 * LISTN * 4;
constexpr size_t WS_SSQ   = WS_ML + (size_t)4 * 262144 * 8;
constexpr size_t WS_END   = WS_SSQ + (size_t)32768 * 64 * 4;

struct Params {
    const float* x; const float* p; const float* attn_norm; const float* w_in; const float* conv_w; const float* A_log; const float* dt_bias;
    const float* gdn_norm; const float* q_norm; const float* k_norm; const float* w_o; const float* ffn_norm; const float* w_gate; const float* w_up;
    const float* w_down; const float* ple_norm; const float* w_pg; const float* w_pp;
    float* out; unsigned char* ws;
};

DI unsigned pk2(float a, float b) { f32x2 v = {a, b}; bfv2 r = __builtin_convertvector(v, bfv2); return __builtin_bit_cast(unsigned, r); }
DI bf16_t f2bf(float a) { return (bf16_t)(pk2(a, 0.f) & 0xffffu); }
DI float bflo(unsigned w) { return __uint_as_float(w << 16); }
DI float bfhi(unsigned w) { return __uint_as_float(w & 0xffff0000u); }
DI float bf2f(bf16_t v) { return __uint_as_float(((unsigned)v) << 16); }
DI bf16x8 pack8(const f32x4& a, const f32x4& b) { u32x4 w; w.x = pk2(a[0], a[1]); w.y = pk2(a[2], a[3]); w.z = pk2(b[0], b[1]); w.w = pk2(b[2], b[3]); return __builtin_bit_cast(bf16x8, w); }
DI bf16x8 cat8(u32x2 lo, u32x2 hi) { u32x4 w; w.x = lo.x; w.y = lo.y; w.z = hi.x; w.w = hi.y; return __builtin_bit_cast(bf16x8, w); }
DI f32x4 mfma16(bf16x8 a, bf16x8 b, f32x4 c) { return __builtin_amdgcn_mfma_f32_16x16x32_bf16(a, b, c, 0, 0, 0); }
DI int perm4(int d4) { return d4 < 16 ? 2 * d4 : 2 * (d4 - 16) + 4; }
DI float dpp_f(float v, int ctrl_sel) { int x = __float_as_int(v); int r;
    if (ctrl_sel == 0) r = __builtin_amdgcn_mov_dpp(x, 0xB1, 0xf, 0xf, true); else if (ctrl_sel == 1) r = __builtin_amdgcn_mov_dpp(x, 0x4E, 0xf, 0xf, true);
    else if (ctrl_sel == 2) r = __builtin_amdgcn_mov_dpp(x, 0x141, 0xf, 0xf, true); else r = __builtin_amdgcn_mov_dpp(x, 0x140, 0xf, 0xf, true);
    return __int_as_float(r); }
DI float row16_sum(float v) { v += dpp_f(v, 0); v += dpp_f(v, 1); v += dpp_f(v, 2); v += dpp_f(v, 3); return v; }
DI float silu_f(float v) { return v * __builtin_amdgcn_rcpf(1.f + __expf(-v)); }
DI float sigm_f(float v) { return __builtin_amdgcn_rcpf(1.f + __expf(-v)); }

DI int opq_tid() { int t = threadIdx.x; asm volatile("" : "+v"(t)); return t; }

namespace pg8 {
constexpr int BM = 256, BK = 64, HALF = 128, HTB = HALF * BK * 2, STAGE_BYTES = 8 * HTB, NXCD = 8, WGM = 8;
DI int lds_byte(int r, int c) { const int st = (r >> 4) * 2 + (c >> 5), rr = r & 15, cc = c & 31, ob = rr * 64 + cc * 2; return st * 1024 + (ob ^ (((ob >> 9) & 1) << 5)); }
DI void stage_rc(int b, int& R, int& C) { const int st = b / 1024, sb = b % 1024, swz = sb ^ (((sb >> 9) & 1) << 5); R = (st >> 1) * 16 + swz / 64; C = (st & 1) * 32 + (swz % 64) / 2; }
DI int perm32(int rho) { const int n = rho >> 4, i = rho & 15; return 8 * (i >> 2) + 4 * n + (i & 3); }
struct Unit { int pm, pn; };
struct Gemm { const bf16_t* A; const bf16_t* Bt; int M, N, K; };
struct StaticOrder {
    int nM, nN, nwg, G, c;
    DI void init(int M, int N, int G_, int c_) { nM = M / BM; nN = N / BM; nwg = nM * nN; G = G_; c = c_; }
    DI bool next(int i, Unit& u) const {
        const long L = (long)i * G + c; if (L >= nwg) return false;
        int wgid = (int)L; { const int q = nwg / NXCD, r = nwg % NXCD, xcd = wgid % NXCD, off = wgid / NXCD; wgid = (xcd < r ? xcd * (q + 1) : r * (q + 1) + (xcd - r) * q) + off; }
        const int nig = WGM * nN, gid = wgid / nig, fm = gid * WGM, gsz = (nM - fm) < WGM ? (nM - fm) : WGM;
        u.pm = fm + ((wgid % nig) % gsz); u.pn = (wgid % nig) / gsz; return true;
    }
    DI void a_ready(const Unit&) const {}
    DI void done(const Unit&) const {}
};

template <class Epi, class Sched, bool ALIGN_EPI = false, bool SP2 = false>
DI void gemm_phase(LAS unsigned char* lds, const Gemm g, const Sched& S, const Epi& E) {
    const int tid = opq_tid(), wid = __builtin_amdgcn_readfirstlane(tid >> 6), lane = tid & 63, wr = wid >> 2, wc = wid & 3, fr = lane & 15, fq = lane >> 4;
    const int K = g.K, nt = K / BK;
    unsigned voffA[2], voffB[2];
#pragma unroll
    for (int i = 0; i < 2; ++i) { int R, C; stage_rc(tid * 16 + i * 8192, R, C); const int Rb = Epi::PERM ? ((R & ~31) + perm32(R & 31)) : R;
        voffA[i] = (unsigned)(R * K + C) * 2u; voffB[i] = (unsigned)(Rb * K + C) * 2u; }
    const size_t kstep = (size_t)(BK * 2);
    const size_t hstep = (size_t)HALF * K * 2;
    const size_t tstep = 2 * hstep;
    const unsigned ldsw = (unsigned)wid * 1024u;
    const int aoff = lds_byte(wr * 64 + fr, fq * 8), boff = lds_byte(wc * 32 + fr, fq * 8);
#define PG8_SA(b, h) (((b) * 2 + (h)) * HTB)
#define PG8_SB(b, h) ((4 + (b) * 2 + (h)) * HTB)
#define PG8_STAGE(bufoff, gbase, voff) do { _Pragma("unroll") for (int _i = 0; _i < 2; ++_i) \
        __builtin_amdgcn_global_load_lds((const unsigned*)((const char*)(gbase) + (voff)[_i]), (LAS unsigned*)(lds + (bufoff) + ldsw + _i * 8192), 16, 0, 0); } while (0)
#define PG8_LDA(dst, b, h) do { _Pragma("unroll") for (int m = 0; m < 4; ++m) _Pragma("unroll") for (int k = 0; k < 2; ++k) dst[m][k] = *(const LAS bf16x8*)(lds + PG8_SA(b, h) + aoff + m * 2048 + k * 1024); } while (0)
#define PG8_LDB(dst, b, h) do { _Pragma("unroll") for (int n = 0; n < 2; ++n) _Pragma("unroll") for (int k = 0; k < 2; ++k) dst[n][k] = *(const LAS bf16x8*)(lds + PG8_SB(b, h) + boff + n * 2048 + k * 1024); } while (0)
#define PG8_MMA(ai, bj, At, Bt) do { __builtin_amdgcn_s_setprio(1); _Pragma("unroll") for (int m = 0; m < 4; ++m) _Pragma("unroll") for (int n = 0; n < 2; ++n) _Pragma("unroll") for (int k = 0; k < 2; ++k) \
        acc[ai][bj][m][n] = __builtin_amdgcn_mfma_f32_16x16x32_bf16(Bt[n][k], At[m][k], acc[ai][bj][m][n], 0, 0, 0); __builtin_amdgcn_s_setprio(0); } while (0)
#define PG8_WAIT_V(n) asm volatile("s_waitcnt vmcnt(" #n ")" ::: "memory")
#define PG8_WAIT_L(n) asm volatile("s_waitcnt lgkmcnt(" #n ")" ::: "memory")
#define PG8_BAR __builtin_amdgcn_s_barrier()
#define PG8_SCHED __builtin_amdgcn_sched_barrier(0)
    Unit cur, nxt; int ui = 0;
    if (!S.next(0, cur)) return;
    f32x4 acc[2][2][4][2];
#pragma unroll
    for (int a = 0; a < 2; ++a)
#pragma unroll
        for (int b = 0; b < 2; ++b)
#pragma unroll
            for (int m = 0; m < 4; ++m)
#pragma unroll
                for (int n = 0; n < 2; ++n) acc[a][b][m][n] = (f32x4){0.f, 0.f, 0.f, 0.f};
    bf16x8 At[4][2], B0[2][2], B1[2][2];
    const char* cA = (const char*)g.A + (size_t)cur.pm * tstep; const char* cB = (const char*)g.Bt + (size_t)cur.pn * tstep;
    S.a_ready(cur);
    if constexpr (SP2) {
        PG8_STAGE(PG8_SB(0, 0), cB, voffB); PG8_STAGE(PG8_SB(0, 1), cB + hstep, voffB); PG8_STAGE(PG8_SA(0, 0), cA, voffA); PG8_STAGE(PG8_SA(0, 1), cA + hstep, voffA);
        if (wr == 1) PG8_BAR;
        PG8_WAIT_V(2); PG8_BAR;
        PG8_STAGE(PG8_SB(1, 0), cB + kstep, voffB); PG8_STAGE(PG8_SA(1, 0), cA + kstep, voffA); PG8_STAGE(PG8_SB(1, 1), cB + hstep + kstep, voffB);
        PG8_WAIT_V(6); PG8_BAR;
    } else {
        PG8_STAGE(PG8_SB(0, 0), cB, voffB); PG8_STAGE(PG8_SA(0, 0), cA, voffA); PG8_STAGE(PG8_SB(0, 1), cB + hstep, voffB); PG8_STAGE(PG8_SA(0, 1), cA + hstep, voffA);
        if (wr == 1) PG8_BAR;
        PG8_WAIT_V(4); PG8_BAR;
        PG8_STAGE(PG8_SB(1, 0), cB + kstep, voffB); PG8_STAGE(PG8_SA(1, 0), cA + kstep, voffA); PG8_STAGE(PG8_SB(1, 1), cB + hstep + kstep, voffB);
        PG8_WAIT_V(6); PG8_BAR;
    }
    for (;;) {
        const bool has_next = S.next(ui + 1, nxt);
        const char* nA = has_next ? (const char*)g.A + (size_t)nxt.pm * tstep : cA; const char* nB = has_next ? (const char*)g.Bt + (size_t)nxt.pn * tstep : cB;
        for (int t = 0; t < nt; t += 2) {
            const bool last = (t == nt - 2);
            const char* a1 = cA + (size_t)(t + 1) * kstep;
            const char* a2 = last ? nA : cA + (size_t)(t + 2) * kstep; const char* b2 = last ? nB : cB + (size_t)(t + 2) * kstep;
            const char* a3 = a2 + kstep; const char* b3 = b2 + kstep;
            if (last && has_next) S.a_ready(nxt);
            if constexpr (SP2) {
            PG8_LDB(B0, 0, 0); PG8_LDB(B1, 0, 1); PG8_SCHED; PG8_LDA(At, 0, 0); PG8_STAGE(PG8_SA(1, 1), a1 + hstep, voffA);
            PG8_WAIT_V(8); PG8_WAIT_L(0); PG8_BAR; PG8_MMA(0, 0, At, B0); PG8_MMA(0, 1, At, B1); PG8_BAR; PG8_SCHED;
            PG8_LDA(At, 0, 1); PG8_STAGE(PG8_SB(0, 0), b2, voffB); PG8_STAGE(PG8_SB(0, 1), b2 + hstep, voffB); PG8_STAGE(PG8_SA(0, 0), a2, voffA);
            PG8_WAIT_V(8); PG8_WAIT_L(0); PG8_BAR; PG8_MMA(1, 0, At, B0); PG8_MMA(1, 1, At, B1); PG8_BAR; PG8_SCHED;
            PG8_LDB(B0, 1, 0); PG8_LDB(B1, 1, 1); PG8_SCHED; PG8_LDA(At, 1, 0); PG8_STAGE(PG8_SA(0, 1), a2 + hstep, voffA);
            PG8_WAIT_V(8); PG8_WAIT_L(0); PG8_BAR; PG8_MMA(0, 0, At, B0); PG8_MMA(0, 1, At, B1); PG8_BAR; PG8_SCHED;
            PG8_LDA(At, 1, 1); PG8_STAGE(PG8_SB(1, 0), b3, voffB); PG8_STAGE(PG8_SB(1, 1), b3 + hstep, voffB); PG8_STAGE(PG8_SA(1, 0), a3, voffA);
            PG8_WAIT_V(8); PG8_WAIT_L(0); PG8_BAR; PG8_MMA(1, 0, At, B0); PG8_MMA(1, 1, At, B1); PG8_BAR; PG8_SCHED;
            } else {
            PG8_LDB(B0, 0, 0); PG8_SCHED; PG8_LDA(At, 0, 0); PG8_STAGE(PG8_SA(1, 1), a1 + hstep, voffA);
            PG8_WAIT_L(8); PG8_BAR; PG8_WAIT_L(0); PG8_MMA(0, 0, At, B0); PG8_BAR; PG8_SCHED;
            PG8_LDB(B1, 0, 1); PG8_STAGE(PG8_SB(0, 0), b2, voffB);
            PG8_BAR; PG8_WAIT_L(0); PG8_MMA(0, 1, At, B1); PG8_BAR;
            PG8_LDA(At, 0, 1); PG8_STAGE(PG8_SA(0, 0), a2, voffA);
            PG8_BAR; PG8_WAIT_L(0); PG8_MMA(1, 0, At, B0); PG8_BAR; PG8_SCHED;
            PG8_STAGE(PG8_SB(0, 1), b2 + hstep, voffB);
            PG8_WAIT_V(6); PG8_BAR; PG8_MMA(1, 1, At, B1); PG8_BAR;
            PG8_LDB(B0, 1, 0); PG8_SCHED; PG8_LDA(At, 1, 0); PG8_STAGE(PG8_SA(0, 1), a2 + hstep, voffA);
            PG8_WAIT_L(8); PG8_BAR; PG8_WAIT_L(0); PG8_MMA(0, 0, At, B0); PG8_BAR; PG8_SCHED;
            PG8_LDB(B1, 1, 1); PG8_STAGE(PG8_SB(1, 0), b3, voffB);
            PG8_BAR; PG8_WAIT_L(0); PG8_MMA(0, 1, At, B1); PG8_BAR;
            PG8_LDA(At, 1, 1); PG8_STAGE(PG8_SA(1, 0), a3, voffA);
            PG8_BAR; PG8_WAIT_L(0); PG8_MMA(1, 0, At, B0); PG8_BAR; PG8_SCHED;
            PG8_STAGE(PG8_SB(1, 1), b3 + hstep, voffB);
            PG8_WAIT_V(6); PG8_BAR; PG8_MMA(1, 1, At, B1); PG8_BAR;
            }
        }
        if constexpr (ALIGN_EPI) { if (wr == 0) PG8_BAR; }
        if constexpr (!Epi::AFTER_DRAIN) { E(acc, cur, wr, wc, fr, fq); S.done(cur); }
        if (!has_next) break;
#pragma unroll
        for (int a = 0; a < 2; ++a)
#pragma unroll
            for (int b = 0; b < 2; ++b)
#pragma unroll
                for (int m = 0; m < 4; ++m)
#pragma unroll
                    for (int n = 0; n < 2; ++n) acc[a][b][m][n] = (f32x4){0.f, 0.f, 0.f, 0.f};
        cur = nxt; cA = nA; cB = nB; ++ui;
        if constexpr (ALIGN_EPI) { if (wr == 1) PG8_BAR; }
    }
    PG8_WAIT_V(0);
    if constexpr (!ALIGN_EPI) { if (wr == 0) PG8_BAR; }
    PG8_BAR;
    if constexpr (Epi::AFTER_DRAIN) { E.fused(acc, cur, wr, wc, fr, fq, lds, wid, lane); S.done(cur); }
#undef PG8_SA
#undef PG8_SB
#undef PG8_STAGE
#undef PG8_LDA
#undef PG8_LDB
#undef PG8_MMA
#undef PG8_WAIT_V
#undef PG8_WAIT_L
#undef PG8_BAR
#undef PG8_SCHED
}
}
using pg8::Unit;

struct EpiProj {
    static constexpr bool PERM = true, AFTER_DRAIN = false;
    bf16_t* O; bf16_t* halo;
    DI void operator()(const f32x4 (&acc)[2][2][4][2], const Unit& u, int wr, int wc, int fr, int fq) const {
        const int row0 = u.pm * 256 + wr * 64 + fr, col0 = u.pn * 256 + wc * 32 + 8 * fq;
#pragma unroll
        for (int ai = 0; ai < 2; ++ai)
#pragma unroll
            for (int m = 0; m < 4; ++m) { const int row = row0 + ai * 128 + m * 16; bf16_t* rowp = O + (size_t)row * NPJ + col0;
#pragma unroll
                for (int bj = 0; bj < 2; ++bj) { const f32x4 v0 = acc[ai][bj][m][0], v1 = acc[ai][bj][m][1];
                    u32x4 w; w.x = pk2(v0[0], v0[1]); w.y = pk2(v0[2], v0[3]); w.z = pk2(v1[0], v1[1]); w.w = pk2(v1[2], v1[3]);
                    *(u32x4*)(rowp + bj * 128) = w;
                    if (m == 3 && fr >= 13 && u.pn < 12) *(u32x4*)(halo + ((size_t)((row >> 6) + 1) * 3 + (fr - 13)) * 3072 + col0 + bj * 128) = w; } }
    }
};
struct EpiPlainBf16 {
    static constexpr bool PERM = true, AFTER_DRAIN = false;
    bf16_t* O; int ldc;
    DI void operator()(const f32x4 (&acc)[2][2][4][2], const Unit& u, int wr, int wc, int fr, int fq) const {
        const int row0 = u.pm * 256 + wr * 64 + fr, col0 = u.pn * 256 + wc * 32 + 8 * fq;
#pragma unroll
        for (int ai = 0; ai < 2; ++ai)
#pragma unroll
            for (int m = 0; m < 4; ++m) { bf16_t* rowp = O + (size_t)(row0 + ai * 128 + m * 16) * ldc + col0;
#pragma unroll
                for (int bj = 0; bj < 2; ++bj) { const f32x4 v0 = acc[ai][bj][m][0], v1 = acc[ai][bj][m][1];
                    u32x4 w; w.x = pk2(v0[0], v0[1]); w.y = pk2(v0[2], v0[3]); w.z = pk2(v1[0], v1[1]); w.w = pk2(v1[2], v1[3]);
                    *(u32x4*)(rowp + bj * 128) = w; } }
    }
};
struct EpiResid {
    static constexpr bool PERM = false, AFTER_DRAIN = false;
    const float* base; float* out; bf16_t* hb; float* ss;
    DI void operator()(const f32x4 (&acc)[2][2][4][2], const Unit& u, int wr, int wc, int fr, int fq) const {
        const int row0 = u.pm * 256 + wr * 64 + fr, col0 = u.pn * 256 + wc * 32 + 4 * fq;
#pragma unroll
        for (int ai = 0; ai < 2; ++ai) { f32x4 bs[4][4];
#pragma unroll
            for (int m = 0; m < 4; ++m)
#pragma unroll
                for (int q = 0; q < 4; ++q) bs[m][q] = *(const f32x4*)(base + (size_t)(row0 + ai * 128 + m * 16) * DM + col0 + (q >> 1) * 128 + (q & 1) * 16);
#pragma unroll
            for (int m = 0; m < 4; ++m) { const int row = row0 + ai * 128 + m * 16; const size_t off = (size_t)row * DM + col0; float s = 0.f;
#pragma unroll
                for (int q = 0; q < 4; ++q) { const f32x4 hv = bs[m][q] + acc[ai][q >> 1][m][q & 1];
                        *(f32x4*)(out + off + (q >> 1) * 128 + (q & 1) * 16) = hv; u32x2 w; w.x = pk2(hv[0], hv[1]); w.y = pk2(hv[2], hv[3]);
                        *(u32x2*)(hb + off + (q >> 1) * 128 + (q & 1) * 16) = w; s += (hv[0] * hv[0] + hv[1] * hv[1]) + (hv[2] * hv[2] + hv[3] * hv[3]); }
                s += __shfl_xor(s, 16); s += __shfl_xor(s, 32);
                if (fq == 0) atomicAdd(ss + row, s); }
            asm volatile("" ::: "memory"); }
    }
};
struct EpiAct {
    static constexpr bool PERM = true, AFTER_DRAIN = false;
    bf16_t* O; const float* ss;
    DI void operator()(const f32x4 (&acc)[2][2][4][2], const Unit& u, int wr, int wc, int fr, int fq) const {
        const int row0 = u.pm * 256 + wr * 64 + fr, col0 = u.pn * 128 + wc * 32 + 8 * fq;
        float rs[8];
#pragma unroll
        for (int g = 0; g < 8; ++g) rs[g] = ss[row0 + (g >> 2) * 128 + (g & 3) * 16];
#pragma unroll
        for (int ai = 0; ai < 2; ++ai)
#pragma unroll
            for (int m = 0; m < 4; ++m) { const int row = row0 + ai * 128 + m * 16; const float r = rsqrtf(rs[ai * 4 + m] * (1.f / 2048.f) + 1e-6f);
                float a[8];
#pragma unroll
                for (int n = 0; n < 2; ++n)
#pragma unroll
                    for (int j = 0; j < 4; ++j) { const float gv = r * acc[ai][0][m][n][j], uv = r * acc[ai][1][m][n][j]; a[n * 4 + j] = silu_f(gv) * uv; }
                u32x4 w; w.x = pk2(a[0], a[1]); w.y = pk2(a[2], a[3]); w.z = pk2(a[4], a[5]); w.w = pk2(a[6], a[7]);
                *(u32x4*)(O + (size_t)row * FF + col0) = w; }
    }
};
struct EpiOut {
    static constexpr bool PERM = false, AFTER_DRAIN = false;
    float* out; const bf16_t* pp; const float* ss;
    DI void operator()(const f32x4 (&acc)[2][2][4][2], const Unit& u, int wr, int wc, int fr, int fq) const {
        const int row0 = u.pm * 256 + wr * 64 + fr, col0 = u.pn * 256 + wc * 32 + 4 * fq;
        float rs[8];
#pragma unroll
        for (int g = 0; g < 8; ++g) rs[g] = ss[row0 + (g >> 2) * 128 + (g & 3) * 16];
#pragma unroll
        for (int ai = 0; ai < 2; ++ai)
#pragma unroll
            for (int m = 0; m < 4; ++m) { const int row = row0 + ai * 128 + m * 16; const size_t off = (size_t)row * DM + col0; const float r = rsqrtf(rs[ai * 4 + m] * (1.f / 2048.f) + 1e-6f);
                f32x4 hv[4]; u32x2 pw[4];
#pragma unroll
                for (int q = 0; q < 4; ++q) { hv[q] = *(const f32x4*)(out + off + (q >> 1) * 128 + (q & 1) * 16); pw[q] = *(const u32x2*)(pp + off + (q >> 1) * 128 + (q & 1) * 16); }
#pragma unroll
                for (int q = 0; q < 4; ++q) { const f32x4 a = acc[ai][q >> 1][m][q & 1]; f32x4 o;
                        o[0] = hv[q][0] + sigm_f(r * a[0]) * bflo(pw[q].x); o[1] = hv[q][1] + sigm_f(r * a[1]) * bfhi(pw[q].x);
                        o[2] = hv[q][2] + sigm_f(r * a[2]) * bflo(pw[q].y); o[3] = hv[q][3] + sigm_f(r * a[3]) * bfhi(pw[q].y);
                        *(f32x4*)(out + off + (q >> 1) * 128 + (q & 1) * 16) = o; }
                asm volatile("" ::: "memory"); }
    }
};

DI void tconv_tile(const float* __restrict__ src, int ld, int c0, int k0, bf16_t* __restrict__ dst, int dK, int n0, const float* __restrict__ nw, LAS float* tl) {
    const int tid = opq_tid();
    f32x4 v[8];
#pragma unroll
    for (int i = 0; i < 8; ++i) v[i] = *(const f32x4*)(src + (size_t)(k0 + (tid >> 4) + 32 * i) * ld + c0 + (tid & 15) * 4);
#pragma unroll
    for (int i = 0; i < 8; ++i) { const int k = (tid >> 4) + 32 * i; const float sc = nw ? nw[k0 + k] : 1.f;
        LAS float* q = tl + k * 65 + (tid & 15) * 4; q[0] = v[i][0] * sc; q[1] = v[i][1] * sc; q[2] = v[i][2] * sc; q[3] = v[i][3] * sc; }
    __syncthreads();
    { const int n = tid >> 3, kq = (tid & 7) * 8;
#pragma unroll
      for (int j = 0; j < 4; ++j) { const int ks = kq + 64 * j; float f[8];
#pragma unroll
          for (int i = 0; i < 8; ++i) f[i] = tl[(ks + i) * 65 + n];
          u32x4 w; w.x = pk2(f[0], f[1]); w.y = pk2(f[2], f[3]); w.z = pk2(f[4], f[5]); w.w = pk2(f[6], f[7]);
          *(u32x4*)(dst + (size_t)(n0 + n) * dK + k0 + ks) = w; } }
    __syncthreads();
}

DI void phase_prep(const Params& P, LAS unsigned char* lds) {
    unsigned char* ws = P.ws; const int tid = opq_tid(), G = gridDim.x, bx = blockIdx.x;
    const int gtid = bx * NTHREADS + tid, gsz = G * NTHREADS;
    for (int i = gtid; i < (int)((WS_GL - WS_CTL) / 4); i += gsz) ((unsigned*)(ws + WS_CTL))[i] = 0u;
    { bf16_t* wba = (bf16_t*)(ws + WS_WBA); for (int i = gtid; i < 16 * 2048; i += gsz) { const int n = i >> 11, k = i & 2047; wba[i] = f2bf(P.w_in[(size_t)k * INW + 4096 + n]); } }
    { bf16_t* pb = (bf16_t*)(ws + WS_PB); for (int i = gtid; i < MT * 256 / 8; i += gsz) { const f32x4 a = *(const f32x4*)(P.p + (size_t)i * 8), b = *(const f32x4*)(P.p + (size_t)i * 8 + 4);
        u32x4 w; w.x = pk2(a[0], a[1]); w.y = pk2(a[2], a[3]); w.z = pk2(b[0], b[1]); w.w = pk2(b[2], b[3]); *(u32x4*)(pb + (size_t)i * 8) = w; } }
    { bf16_t* xn = (bf16_t*)(ws + WS_R0); const int lane = tid & 63, gw = bx * 8 + (tid >> 6);
      f32x4 wv[8];
#pragma unroll
      for (int i = 0; i < 8; ++i) wv[i] = *(const f32x4*)(P.attn_norm + lane * 4 + i * 256);
      for (int row = gw * 2; row < MT; row += G * 16) { const float* xr = P.x + (size_t)row * DM; f32x4 v[2][8]; float s0 = 0.f, s1 = 0.f;
#pragma unroll
          for (int r = 0; r < 2; ++r)
#pragma unroll
              for (int i = 0; i < 8; ++i) v[r][i] = *(const f32x4*)(xr + (size_t)r * DM + lane * 4 + i * 256);
#pragma unroll
          for (int i = 0; i < 8; ++i) { s0 += (v[0][i][0] * v[0][i][0] + v[0][i][1] * v[0][i][1]) + (v[0][i][2] * v[0][i][2] + v[0][i][3] * v[0][i][3]);
              s1 += (v[1][i][0] * v[1][i][0] + v[1][i][1] * v[1][i][1]) + (v[1][i][2] * v[1][i][2] + v[1][i][3] * v[1][i][3]); }
#pragma unroll
          for (int o = 1; o < 64; o <<= 1) { s0 += __shfl_xor(s0, o); s1 += __shfl_xor(s1, o); }
          const float r0 = rsqrtf(s0 * (1.f / 2048.f) + 1e-6f), r1 = rsqrtf(s1 * (1.f / 2048.f) + 1e-6f);
#pragma unroll
          for (int r = 0; r < 2; ++r)
#pragma unroll
              for (int i = 0; i < 8; ++i) { const float rr = r ? r1 : r0; u32x2 w; w.x = pk2(v[r][i][0] * rr * wv[i][0], v[r][i][1] * rr * wv[i][1]); w.y = pk2(v[r][i][2] * rr * wv[i][2], v[r][i][3] * rr * wv[i][3]);
                  *(u32x2*)(xn + (size_t)(row + r) * DM + lane * 4 + i * 256) = w; } } }
    LAS float* tl = (LAS float*)lds;
    for (int gi = bx; gi < 896; gi += G) { const int nt = gi >> 3, kg = gi & 7, n0 = nt * 64; tconv_tile(P.w_in, INW, n0 < 4096 ? n0 : n0 + 16, kg * 256, (bf16_t*)(ws + WS_WIN), 2048, n0, nullptr, tl); }
}
DI void phase_wconv_late(const Params& P, LAS unsigned char* lds, int wg0, int nwg) {
    unsigned char* ws = P.ws; LAS float* tl = (LAS float*)lds;
    for (int gi = 896 + wg0; gi < 3552; gi += nwg) {
        if (gi < 1152) { const int t2 = gi - 896, nt = t2 >> 3, kg = t2 & 7; tconv_tile(P.w_o, 2048, nt * 64, kg * 256, (bf16_t*)(ws + WS_WO), 2048, nt * 64, nullptr, tl); }
        else if (gi < 2560) { const int t2 = gi - 1152, nt = t2 >> 3, kg = t2 & 7, n0 = nt * 64, pn = n0 >> 8, r = n0 & 255;
            tconv_tile(r < 128 ? P.w_gate : P.w_up, FF, pn * 128 + (r & 127), kg * 256, (bf16_t*)(ws + WS_WGU), 2048, n0, P.ffn_norm, tl); }
        else if (gi < 3264) { const int t2 = gi - 2560, nt = t2 / 22, kg = t2 % 22; tconv_tile(P.w_down, 2048, nt * 64, kg * 256, (bf16_t*)(ws + WS_WDN), FF, nt * 64, nullptr, tl); }
        else if (gi < 3520) { const int t2 = gi - 3264, nt = t2 >> 3, kg = t2 & 7; tconv_tile(P.w_pg, 2048, nt * 64, kg * 256, (bf16_t*)(ws + WS_WPG), 2048, nt * 64, P.ple_norm, tl); }
        else { const int nt = gi - 3520; tconv_tile(P.w_pp, 2048, nt * 64, 0, (bf16_t*)(ws + WS_WPP), 256, nt * 64, nullptr, tl); }
    }
}

DI void phase_ba(const Params& P) {
    const int tid = opq_tid(), lane = tid & 63, fr = lane & 15, fq = lane >> 4, gw = blockIdx.x * 8 + (tid >> 6);
    const bf16_t* xn = (const bf16_t*)(P.ws + WS_R0); const bf16_t* wba = (const bf16_t*)(P.ws + WS_WBA); float* BA = (float*)(P.ws + WS_BA);
    for (int rt = gw; rt < MT / 16; rt += gridDim.x * 8) {
        f32x4 acc = {0.f, 0.f, 0.f, 0.f}; const bf16_t* ap = xn + (size_t)(rt * 16 + fr) * DM + 8 * fq; const bf16_t* bp = wba + fr * 2048 + 8 * fq;
#pragma unroll 16
        for (int ks = 0; ks < 64; ++ks) acc = mfma16(*(const bf16x8*)(ap + 32 * ks), *(const bf16x8*)(bp + 32 * ks), acc);
#pragma unroll
        for (int j = 0; j < 4; ++j) BA[(size_t)(rt * 16 + 4 * fq + j) * 16 + fr] = acc[j];
    }
}

constexpr int G1_QS = 0, G1_KS = 18432, G1_VT = 36864, G1_KT = 57344, G1_SM = 77824, G1_TEAM = 78848;
DI void phase_gdn_prep(const Params& P, LAS unsigned char* lds) {
    const int tid0 = opq_tid(), team = tid0 >> 8;
    LAS unsigned char* L = lds + team * G1_TEAM;
    LAS bf16_t* QS = (LAS bf16_t*)(L + G1_QS); LAS bf16_t* KS = (LAS bf16_t*)(L + G1_KS); LAS bf16_t* VT = (LAS bf16_t*)(L + G1_VT); LAS bf16_t* KT = (LAS bf16_t*)(L + G1_KT);
    LAS float* AF = (LAS float*)(L + G1_QS); LAS bf16_t* TB = (LAS bf16_t*)(L + G1_KS); LAS float* SM = (LAS float*)(L + G1_SM);
    bf16_t* proj = (bf16_t*)(P.ws + WS_R1); const bf16_t* halo = (const bf16_t*)(P.ws + WS_HALO); const float* BA = (const float*)(P.ws + WS_BA);
    bf16_t* W2 = (bf16_t*)(P.ws + WS_W2); bf16_t* QKB = (bf16_t*)(P.ws + WS_QKB); float* GL = (float*)(P.ws + WS_GL);
    for (int pi = blockIdx.x; pi < 2048; pi += gridDim.x) {
        int tid = tid0; asm volatile("" : "+v"(tid));
        const int tt = tid & 255, tw = __builtin_amdgcn_readfirstlane((tid >> 6) & 3), lane = tid & 63, fr = lane & 15, fq = lane >> 4;
        const int ci = pi * 2 + team, h = ci & 7, n = (ci >> 3) & 255, b = ci >> 11, t0 = b * TT + n * 64;
        if (tw == 0) {
            const float bv = BA[(size_t)(t0 + lane) * 16 + h], av = BA[(size_t)(t0 + lane) * 16 + 8 + h];
            const float beta = sigm_f(bv); const float xx = av + P.dt_bias[h]; const float sp = xx > 20.f ? xx : log1pf(__expf(xx));
            const float gg = -__expf(P.A_log[h]) * sp; float gc = gg;
#pragma unroll
            for (int o = 1; o < 64; o <<= 1) { const float v = __shfl_up(gc, o); if (lane >= o) gc += v; }
            const float glast = __shfl(gc, 63);
            SM[lane] = gc; SM[64 + lane] = beta; SM[128 + lane] = __expf(gc); SM[192 + lane] = __expf(glast - gc);
            if (lane == 63) GL[(b * 8 + h) * 256 + n] = __expf(gc);
        }
        __syncthreads();
        { const int r = tt >> 2, cg0 = (tt & 3) * 32; const float beta_r = SM[64 + r], egc_r = SM[128 + r];
#pragma unroll 1
          for (int x = 0; x < 3; ++x) {
              float val[32]; const int colbase = x * 1024 + h * 128 + cg0;
              u32x4 rawa[4][4];
#pragma unroll
              for (int sg = 0; sg < 4; ++sg) { const int col = colbase + sg * 8;
#pragma unroll
                  for (int j = 0; j < 4; ++j) { const int rr = r - 3 + j; rawa[sg][j] = (u32x4){0u, 0u, 0u, 0u};
                      if (rr >= 0) rawa[sg][j] = *(const u32x4*)(proj + (size_t)(t0 + rr) * NPJ + col);
                      else if (n > 0) rawa[sg][j] = *(const u32x4*)(halo + ((size_t)(t0 >> 6) * 3 + (rr + 3)) * 3072 + col); } }
#pragma unroll
              for (int sg = 0; sg < 4; ++sg) { const int col = colbase + sg * 8;
#pragma unroll
                  for (int i = 0; i < 8; ++i) { const f32x4 w4 = *(const f32x4*)(P.conv_w + (size_t)(col + i) * 4); float a = 0.f;
#pragma unroll
                      for (int j = 0; j < 4; ++j) { const unsigned wd = rawa[sg][j][i >> 1]; const float xv = (i & 1) ? bfhi(wd) : bflo(wd); a += w4[j] * xv; }
                      val[sg * 8 + i] = silu_f(a); } }
              if (x < 2) { float ss = 0.f;
#pragma unroll
                  for (int i = 0; i < 32; ++i) ss += val[i] * val[i];
                  ss += __shfl_xor(ss, 1); ss += __shfl_xor(ss, 2);
                  const float sc = rsqrtf(ss + 1e-6f) * (x == 0 ? 0.08838834764831845f : 1.f);
#pragma unroll
                  for (int i = 0; i < 32; ++i) val[i] *= sc; }
              if (x < 2) { LAS bf16_t* dst = (x == 0 ? QS : KS) + r * 144 + cg0;
#pragma unroll
                  for (int i = 0; i < 4; ++i) { u32x4 w; w.x = pk2(val[8 * i], val[8 * i + 1]); w.y = pk2(val[8 * i + 2], val[8 * i + 3]); w.z = pk2(val[8 * i + 4], val[8 * i + 5]); w.w = pk2(val[8 * i + 6], val[8 * i + 7]);
                      *(LAS u32x4*)(dst + 8 * i) = w; } }
              if (x == 1) { const float f = beta_r * egc_r;
#pragma unroll
                  for (int i = 0; i < 32; ++i) KT[(cg0 + i) * 80 + r] = f2bf(val[i] * f); }
              if (x == 2) {
#pragma unroll
                  for (int i = 0; i < 32; ++i) VT[(cg0 + i) * 80 + r] = f2bf(val[i] * beta_r); }
          } }
        __syncthreads();
        f32x4 kk[4], qk[4];
#pragma unroll
        for (int nt = 0; nt < 4; ++nt) { kk[nt] = (f32x4){0.f, 0.f, 0.f, 0.f}; qk[nt] = (f32x4){0.f, 0.f, 0.f, 0.f}; }
#pragma unroll
        for (int ks = 0; ks < 4; ++ks) { const bf16x8 ak = *(const LAS bf16x8*)(KS + (16 * tw + fr) * 144 + 32 * ks + 8 * fq), aq = *(const LAS bf16x8*)(QS + (16 * tw + fr) * 144 + 32 * ks + 8 * fq);
#pragma unroll
            for (int nt = 0; nt < 4; ++nt) { const bf16x8 bk = *(const LAS bf16x8*)(KS + (16 * nt + fr) * 144 + 32 * ks + 8 * fq); kk[nt] = mfma16(ak, bk, kk[nt]); qk[nt] = mfma16(aq, bk, qk[nt]); } }
        { const int r = tt >> 2, cg0 = (tt & 3) * 32; const float e = SM[128 + r];
#pragma unroll
          for (int i = 0; i < 4; ++i) { const u32x4 s = *(const LAS u32x4*)(QS + r * 144 + cg0 + 8 * i); u32x4 w;
              w.x = pk2(bflo(s.x) * e, bfhi(s.x) * e); w.y = pk2(bflo(s.y) * e, bfhi(s.y) * e); w.z = pk2(bflo(s.z) * e, bfhi(s.z) * e); w.w = pk2(bflo(s.w) * e, bfhi(s.w) * e);
              *(u32x4*)(proj + (size_t)(t0 + r) * NPJ + OFF_GQ + h * 128 + cg0 + 8 * i) = w; } }
        { const int d = tt >> 1, cb = (tt & 1) * 32;
#pragma unroll
          for (int i4 = 0; i4 < 4; ++i4) { const int c0 = cb + 8 * i4; float f[8];
#pragma unroll
              for (int i = 0; i < 8; ++i) f[i] = bf2f(KS[(c0 + i) * 144 + d]) * SM[192 + c0 + i];
              u32x4 w; w.x = pk2(f[0], f[1]); w.y = pk2(f[2], f[3]); w.z = pk2(f[4], f[5]); w.w = pk2(f[6], f[7]);
              *(u32x4*)(proj + (size_t)(t0 + (d >> 1)) * NPJ + OFF_GK + h * 128 + (d & 1) * 64 + c0) = w; } }
        __syncthreads();
#pragma unroll
        for (int nt = 0; nt < 4; ++nt)
#pragma unroll
            for (int j = 0; j < 4; ++j) { const int c = 16 * tw + 4 * fq + j, s = 16 * nt + fr; const float dec = (s <= c) ? __expf(SM[c] - SM[s]) : 0.f;
                AF[c * 65 + s] = (s < c) ? SM[64 + c] * kk[nt][j] * dec : (s == c ? 1.f : 0.f);
                QKB[(size_t)ci * 4096 + c * 64 + s] = f2bf(qk[nt][j] * dec); }
        __syncthreads();
        { const int bb = tw * 16;
          if (lane < 16) {
              for (int i = 1; i < 16; ++i) { float a0 = 0.f, a1 = 0.f; int j = 0;
                  for (; j + 2 <= i; j += 2) { a0 += AF[(bb + i) * 65 + bb + j] * AF[(bb + j) * 65 + bb + lane]; a1 += AF[(bb + i) * 65 + bb + j + 1] * AF[(bb + j + 1) * 65 + bb + lane]; }
                  if (j < i) a0 += AF[(bb + i) * 65 + bb + j] * AF[(bb + j) * 65 + bb + lane];
                  AF[(bb + i) * 65 + bb + lane] = lane < i ? -(a0 + a1) : (lane == i ? 1.f : 0.f); } }
#pragma unroll
          for (int k = 0; k < 4; ++k) { const int row = bb + fq + 4 * k; TB[row * 80 + bb + fr] = f2bf(AF[row * 65 + bb + fr]);
              for (int jb = tw + 1; jb < 4; ++jb) TB[row * 80 + 16 * jb + fr] = (bf16_t)0; }
          __syncthreads();
          for (int i = 1; i < 4; ++i) {
              if (tw < i) { const int j = tw; f32x4 X = {0.f, 0.f, 0.f, 0.f};
                  for (int k = j; k < i; ++k) {
#pragma unroll
                      for (int kk = 0; kk < 4; ++kk) { const float av = AF[(16 * i + fr) * 65 + 16 * k + 4 * kk + fq];
                          const float bv = (k == j) ? AF[(16 * k + 4 * kk + fq) * 65 + 16 * j + fr] : bf2f(TB[(16 * k + 4 * kk + fq) * 80 + 16 * j + fr]);
                          X = __builtin_amdgcn_mfma_f32_16x16x4f32(av, bv, X, 0, 0, 0); } }
                  f32x4 O = {0.f, 0.f, 0.f, 0.f};
#pragma unroll
                  for (int kk = 0; kk < 4; ++kk) O = __builtin_amdgcn_mfma_f32_16x16x4f32(AF[(16 * i + fr) * 65 + 16 * i + 4 * fq + kk], X[kk], O, 0, 0, 0);
#pragma unroll
                  for (int jj = 0; jj < 4; ++jj) TB[(16 * i + 4 * fq + jj) * 80 + 16 * j + fr] = f2bf(-O[jj]); }
              __syncthreads(); }
        }
        { bf16x8 at[2];
#pragma unroll
          for (int ks = 0; ks < 2; ++ks) at[ks] = *(const LAS bf16x8*)(TB + (16 * tw + fr) * 80 + 32 * ks + 8 * fq);
#pragma unroll
          for (int nt = 0; nt < 8; ++nt) { f32x4 a = {0.f, 0.f, 0.f, 0.f};
#pragma unroll
              for (int ks = 0; ks < 2; ++ks) a = mfma16(at[ks], *(const LAS bf16x8*)(VT + (16 * nt + fr) * 80 + 32 * ks + 8 * fq), a);
              const int e = 16 * nt + fr; u32x2 w; w.x = pk2(a[0], a[1]); w.y = pk2(a[2], a[3]);
              *(u32x2*)(proj + (size_t)(t0 + (e >> 1)) * NPJ + OFF_GV + h * 128 + (e & 1) * 64 + 16 * tw + 4 * fq) = w; }
#pragma unroll
          for (int mt = 0; mt < 8; ++mt) { f32x4 a = {0.f, 0.f, 0.f, 0.f};
#pragma unroll
              for (int ks = 0; ks < 2; ++ks) a = mfma16(*(const LAS bf16x8*)(KT + (16 * mt + fr) * 80 + 32 * ks + 8 * fq), at[ks], a);
              u32x2 w; w.x = pk2(a[0], a[1]); w.y = pk2(a[2], a[3]);
              *(u32x2*)(W2 + (size_t)(t0 + 16 * tw + fr) * 1024 + h * 128 + 16 * mt + 4 * fq) = w; } }
        __syncthreads();
    }
}

DI void phase_moba_prep(const Params& P, LAS unsigned char* lds, int wg0, int nwg) {
    const int tid = opq_tid(), lane = tid & 63, wave = tid >> 6, l16 = lane & 15;
    bf16_t* proj = (bf16_t*)(P.ws + WS_R1); float* kmean = (float*)(P.ws + WS_KMEAN);
    LAS bf16_t* VS = (LAS bf16_t*)lds; LAS float* CS = (LAS float*)(lds + 69632);
    for (int task = wg0; task < 1024; task += nwg) {
        const int h = task & 7, blk = (task >> 3) & 63, b = task >> 9; const size_t rbase = (size_t)(b * TT + blk * 256);
        f32x4 qg0 = *(const f32x4*)(P.q_norm + l16 * 8), qg1 = *(const f32x4*)(P.q_norm + l16 * 8 + 4), kg0 = *(const f32x4*)(P.k_norm + l16 * 8), kg1 = *(const f32x4*)(P.k_norm + l16 * 8 + 4);
        float cs[8];
#pragma unroll
        for (int i = 0; i < 8; ++i) cs[i] = 0.f;
        u32x4 rq[8], rk[8], rv[8];
#pragma unroll
        for (int ps = 0; ps < 8; ++ps) { const int r = ps * 32 + wave * 4 + (lane >> 4); const bf16_t* rp = proj + (rbase + r) * NPJ + h * 128 + l16 * 8;
            rq[ps] = *(const u32x4*)(rp + OFF_MQ); rk[ps] = *(const u32x4*)(rp + OFF_MK); rv[ps] = *(const u32x4*)(rp + OFF_MV); }
#pragma unroll
        for (int ps = 0; ps < 8; ++ps) { const int r = ps * 32 + wave * 4 + (lane >> 4); bf16_t* rp = proj + (rbase + r) * NPJ + h * 128 + l16 * 8;
#pragma unroll
            for (int x = 0; x < 2; ++x) { bf16_t* ptr = rp + (x == 0 ? OFF_MQ : OFF_MK); const u32x4 raw = x == 0 ? rq[ps] : rk[ps]; float v[8];
                v[0] = bflo(raw.x); v[1] = bfhi(raw.x); v[2] = bflo(raw.y); v[3] = bfhi(raw.y); v[4] = bflo(raw.z); v[5] = bfhi(raw.z); v[6] = bflo(raw.w); v[7] = bfhi(raw.w);
                float ss = 0.f;
#pragma unroll
                for (int i = 0; i < 8; ++i) ss += v[i] * v[i];
                ss = row16_sum(ss);
                const float rs = rsqrtf(ss * (1.f / 128.f) + 1e-6f); const f32x4 g0 = x == 0 ? qg0 : kg0, g1 = x == 0 ? qg1 : kg1;
#pragma unroll
                for (int i = 0; i < 4; ++i) { v[i] *= rs * g0[i]; v[4 + i] *= rs * g1[i]; }
                if (x == 1) {
#pragma unroll
                    for (int i = 0; i < 8; ++i) cs[i] += v[i]; }
                u32x4 w; w.x = pk2(v[0], v[1]); w.y = pk2(v[2], v[3]); w.z = pk2(v[4], v[5]); w.w = pk2(v[6], v[7]); *(u32x4*)ptr = w; }
            *(LAS u32x4*)(VS + r * 136 + l16 * 8) = rv[ps]; }
#pragma unroll
        for (int i = 0; i < 8; ++i) { cs[i] += __shfl_xor(cs[i], 16); cs[i] += __shfl_xor(cs[i], 32); }
        if (lane < 16) {
#pragma unroll
            for (int i = 0; i < 8; ++i) CS[wave * 128 + lane * 8 + i] = cs[i]; }
        __syncthreads();
        if (tid < 128) { float s = 0.f;
#pragma unroll
            for (int w = 0; w < 8; ++w) s += CS[w * 128 + tid];
            kmean[((size_t)(b * 8 + h) * 64 + blk) * 128 + tid] = s * (1.f / 256.f); }
#pragma unroll 2
        for (int i8 = 0; i8 < 8; ++i8) { const int pid = tid + i8 * 512, e = (pid & 63) + 64 * (pid >> 11), ks = (pid >> 6) & 31; unsigned short f[8];
#pragma unroll
            for (int i = 0; i < 8; ++i) f[i] = VS[(ks * 8 + i) * 136 + e];
            u32x4 w; w.x = f[0] | ((unsigned)f[1] << 16); w.y = f[2] | ((unsigned)f[3] << 16); w.z = f[4] | ((unsigned)f[5] << 16); w.w = f[6] | ((unsigned)f[7] << 16);
            *(u32x4*)(proj + (rbase + 2 * e + (ks >> 4)) * NPJ + OFF_MV + h * 128 + (ks & 15) * 8) = w; }
        __syncthreads();
    }
}

DI void phase_moba_select(const Params& P, LAS unsigned char* lds, int wg0, int nwg) {
    const int tid = opq_tid(), qi = tid >> 1, half = tid & 1;
    const bf16_t* proj = (const bf16_t*)(P.ws + WS_R1); const float* kmean = (const float*)(P.ws + WS_KMEAN);
    int* cnt = (int*)(P.ws + WS_CNT); int* list = (int*)(P.ws + WS_LIST); f32x2* ML = (f32x2*)(P.ws + WS_ML);
    LAS float* KM = (LAS float*)lds; LAS int* hist = (LAS int*)(lds + 32768); LAS int* hbase = (LAS int*)(lds + 32768 + 256);
    for (int task = wg0; task < 1024; task += nwg) {
        const int tk = task >> 8, tw_ = task & 255, bhx = (tw_ >> 6) * 4 + tk, blk = (tk & 1) ? 63 - (tw_ & 63) : (tw_ & 63), h = bhx & 7, b = bhx >> 3; const int bh = b * 8 + h; const int t = blk * 256 + qi; const size_t rid = (size_t)bh * TT + t;
        for (int i = tid; i < blk * 128; i += NTHREADS) KM[i] = kmean[(size_t)bh * 64 * 128 + i];
        if (tid < 64) hist[tid] = 0;
        float q[64];
        { const bf16_t* qp = proj + (size_t)(b * TT + t) * NPJ + OFF_MQ + h * 128 + half * 64;
#pragma unroll
          for (int i = 0; i < 8; ++i) { const u32x4 raw = *(const u32x4*)(qp + 8 * i); q[8 * i] = bflo(raw.x); q[8 * i + 1] = bfhi(raw.x); q[8 * i + 2] = bflo(raw.y); q[8 * i + 3] = bfhi(raw.y);
              q[8 * i + 4] = bflo(raw.z); q[8 * i + 5] = bfhi(raw.z); q[8 * i + 6] = bflo(raw.w); q[8 * i + 7] = bfhi(raw.w); } }
        __syncthreads();
        float v0 = -INFINITY, v1 = -INFINITY, v2 = -INFINITY; int i0 = -1, i1 = -1, i2 = -1;
        for (int n = 0; n < blk; ++n) { const LAS float* km = KM + n * 128 + half * 64; float d0 = 0.f, d1 = 0.f, d2 = 0.f, d3 = 0.f;
#pragma unroll
            for (int i = 0; i < 16; ++i) { const f32x4 kv = *(const LAS f32x4*)(km + 4 * i); d0 += q[4 * i] * kv[0]; d1 += q[4 * i + 1] * kv[1]; d2 += q[4 * i + 2] * kv[2]; d3 += q[4 * i + 3] * kv[3]; }
            float g = (d0 + d1) + (d2 + d3); g += __shfl_xor(g, 1);
            if (g > v0) { v2 = v1; i2 = i1; v1 = v0; i1 = i0; v0 = g; i0 = n; } else if (g > v1) { v2 = v1; i2 = i1; v1 = g; i1 = n; } else if (g > v2) { v2 = g; i2 = n; } }
        int rk0 = 0, rk1 = 0, rk2 = 0;
        if (half == 0) { if (i0 >= 0) rk0 = __hip_atomic_fetch_add(&hist[i0], 1, __ATOMIC_RELAXED, __HIP_MEMORY_SCOPE_WORKGROUP); if (i1 >= 0) rk1 = __hip_atomic_fetch_add(&hist[i1], 1, __ATOMIC_RELAXED, __HIP_MEMORY_SCOPE_WORKGROUP); if (i2 >= 0) rk2 = __hip_atomic_fetch_add(&hist[i2], 1, __ATOMIC_RELAXED, __HIP_MEMORY_SCOPE_WORKGROUP); }
        __syncthreads();
        if (tid < 64) { const int c = hist[tid]; hbase[tid] = c > 0 ? atomicAdd(&cnt[bh * 64 + tid], c) : 0; }
        __syncthreads();
        if (half == 0) {
            const f32x2 dead = {-INFINITY, 0.f};
            if (i0 >= 0) list[(size_t)bh * LISTN + i0 * 16384 - 128 * i0 * (i0 + 1) + hbase[i0] + rk0] = t; else ML[0 * 262144 + rid] = dead;
            if (i1 >= 0) list[(size_t)bh * LISTN + i1 * 16384 - 128 * i1 * (i1 + 1) + hbase[i1] + rk1] = t | (1 << 14); else ML[1 * 262144 + rid] = dead;
            if (i2 >= 0) list[(size_t)bh * LISTN + i2 * 16384 - 128 * i2 * (i2 + 1) + hbase[i2] + rk2] = t | (2 << 14); else ML[2 * 262144 + rid] = dead;
        }
        __syncthreads();
    }
}

constexpr int G2_W = 0, G2_Q = 18432, G2_QK = 36864, G2_KD = 47104, G2_BUF = 67584, G2_RED = 135168;
DI void phase_gdn_scan(const Params& P, LAS unsigned char* lds, int bh) {
    const int tid = opq_tid(), lane = tid & 63, w = tid >> 6, fr = lane & 15, fq = lane >> 4, b = bh >> 3, h = bh & 7;
    const bf16_t* proj = (const bf16_t*)(P.ws + WS_R1); const bf16_t* W2 = (const bf16_t*)(P.ws + WS_W2); const bf16_t* QKB = (const bf16_t*)(P.ws + WS_QKB);
    const float* GL = (const float*)(P.ws + WS_GL); bf16_t* mix = (bf16_t*)(P.ws + WS_R2);
    float* SSQ = (float*)(P.ws + WS_SSQ);
    const int e = 16 * w + fr; const float gnw = P.gdn_norm[e];
    f32x4 S[8];
#pragma unroll
    for (int i = 0; i < 8; ++i) S[i] = (f32x4){0.f, 0.f, 0.f, 0.f};
    const int wrow0 = tid >> 4, wseg = tid & 15;
    const int qrow = tid >> 3, qseg = tid & 7;
    struct Stage { u32x4 sw[2], sq[2], sqk, skd[2]; };
    u32x2 un[4];
    Stage stA, stB;
#define G2_LOAD(X, nn) do { const int t0_ = b * TT + (nn) * 64; const int ci_ = ((b * 256 + (nn)) << 3) + h; \
        _Pragma("unroll") for (int i_ = 0; i_ < 2; ++i_) { X.sw[i_] = *(const u32x4*)(W2 + (size_t)(t0_ + wrow0 + 32 * i_) * 1024 + h * 128 + wseg * 8); \
            X.sq[i_] = *(const u32x4*)(proj + (size_t)(t0_ + wrow0 + 32 * i_) * NPJ + OFF_GQ + h * 128 + wseg * 8); \
            const int d_ = qrow + 64 * i_; X.skd[i_] = *(const u32x4*)(proj + (size_t)(t0_ + (d_ >> 1)) * NPJ + OFF_GK + h * 128 + (d_ & 1) * 64 + qseg * 8); } \
        X.sqk = *(const u32x4*)(QKB + (size_t)ci_ * 4096 + qrow * 64 + qseg * 8); } while (0)
#define UN_LOAD(nn) do { const int t0_ = b * TT + (nn) * 64; _Pragma("unroll") for (int mt_ = 0; mt_ < 4; ++mt_) un[mt_] = *(const u32x2*)(proj + (size_t)(t0_ + (e >> 1)) * NPJ + OFF_GV + h * 128 + (e & 1) * 64 + 16 * mt_ + 4 * fq); } while (0)
#define G2_ST2(base_, rowoff_, sg_, v_) do { const int g_ = ((sg_) >> 2) * 64, d_ = ((sg_) & 3) * 8; \
        *(LAS u32x2*)(B_ + (base_) + (rowoff_) + g_ + perm4(d_) * 2) = (u32x2){(v_).x, (v_).y}; *(LAS u32x2*)(B_ + (base_) + (rowoff_) + g_ + perm4(d_ + 4) * 2) = (u32x2){(v_).z, (v_).w}; } while (0)
#define G2_STORE(X, bufi) do { LAS unsigned char* B_ = lds + (bufi) * G2_BUF; \
        _Pragma("unroll") for (int i_ = 0; i_ < 2; ++i_) { G2_ST2(G2_W, (wrow0 + 32 * i_) * 288, wseg, X.sw[i_]); G2_ST2(G2_Q, (wrow0 + 32 * i_) * 288, wseg, X.sq[i_]); \
            G2_ST2(G2_KD, (qrow + 64 * i_) * 160, qseg, X.skd[i_]); } \
        G2_ST2(G2_QK, qrow * 160, qseg, X.sqk); } while (0)
    G2_LOAD(stA, 0); G2_STORE(stA, 0); UN_LOAD(0);
    float egl_n = GL[bh * 256];
    u32x2 uc[4];
#pragma unroll
    for (int i = 0; i < 4; ++i) uc[i] = un[i];
    G2_LOAD(stA, 1);
    __syncthreads();
    for (int n2 = 0; n2 < 256; n2 += 2) {
#pragma unroll
      for (int hf2 = 0; hf2 < 2; ++hf2) {
        const int n = n2 + hf2; Stage& LDs = hf2 ? stA : stB; Stage& STs = hf2 ? stB : stA;
        const int cur = hf2, t0 = b * TT + n * 64; LAS unsigned char* Bf = lds + cur * G2_BUF;
        { const int n2c = n + 2 < 256 ? n + 2 : 255, n1c = n + 1 < 256 ? n + 1 : 255; G2_LOAD(LDs, n2c); UN_LOAD(n1c); }
        const float egl = egl_n; egl_n = GL[bh * 256 + (n + 1 < 256 ? n + 1 : 255)];
        f32x4 Pm[4], Om[4];
#pragma unroll
        for (int mt = 0; mt < 4; ++mt) { Pm[mt] = (f32x4){0.f, 0.f, 0.f, 0.f}; Om[mt] = (f32x4){0.f, 0.f, 0.f, 0.f}; }
#define SBAR __builtin_amdgcn_sched_barrier(0)
#define LD_K4(dst, base_, ks_) do { const int o0_ = fr * 288 + (32 * (ks_) + 8 * fq) * 2; \
        dst[0] = *(const LAS bf16x8*)(Bf + base_ + o0_); dst[1] = *(const LAS bf16x8*)(Bf + base_ + o0_ + 4608); \
        dst[2] = *(const LAS bf16x8*)(Bf + base_ + o0_ + 9216); dst[3] = *(const LAS bf16x8*)(Bf + base_ + o0_ + 13824); } while (0)
#define MM_K4(src, sb_, A_) do { A_[0] = mfma16(src[0], sb_, A_[0]); A_[1] = mfma16(src[1], sb_, A_[1]); A_[2] = mfma16(src[2], sb_, A_[2]); A_[3] = mfma16(src[3], sb_, A_[3]); } while (0)
#define LD_R4(dst, base_, r0_, k2_) do { const int o0_ = (16 * (r0_) + fr) * 160 + (32 * (k2_) + 8 * fq) * 2; \
        dst[0] = *(const LAS bf16x8*)(Bf + base_ + o0_); dst[1] = *(const LAS bf16x8*)(Bf + base_ + o0_ + 2560); \
        dst[2] = *(const LAS bf16x8*)(Bf + base_ + o0_ + 5120); dst[3] = *(const LAS bf16x8*)(Bf + base_ + o0_ + 7680); } while (0)
#define MM_R4(src, vb_, A0_, A1_, A2_, A3_) do { A0_ = mfma16(src[0], vb_, A0_); A1_ = mfma16(src[1], vb_, A1_); A2_ = mfma16(src[2], vb_, A2_); A3_ = mfma16(src[3], vb_, A3_); } while (0)
        bf16x8 fa[4], fb[4];
        LD_K4(fa, G2_W, 0);
        const bf16x8 sb0 = pack8(S[0], S[1]), sb1 = pack8(S[2], S[3]), sb2 = pack8(S[4], S[5]), sb3 = pack8(S[6], S[7]);
        LD_K4(fb, G2_W, 1); SBAR; MM_K4(fa, sb0, Pm); SBAR;
        LD_K4(fa, G2_W, 2); SBAR; MM_K4(fb, sb1, Pm); SBAR;
        LD_K4(fb, G2_W, 3); SBAR; MM_K4(fa, sb2, Pm); SBAR;
        LD_K4(fa, G2_Q, 0); SBAR; MM_K4(fb, sb3, Pm); SBAR;
        f32x4 vn[4];
#pragma unroll
        for (int mt = 0; mt < 4; ++mt) { vn[mt][0] = bflo(uc[mt].x) - Pm[mt][0]; vn[mt][1] = bfhi(uc[mt].x) - Pm[mt][1]; vn[mt][2] = bflo(uc[mt].y) - Pm[mt][2]; vn[mt][3] = bfhi(uc[mt].y) - Pm[mt][3]; }
        bf16x8 Vb[2];
#pragma unroll
        for (int k2 = 0; k2 < 2; ++k2) Vb[k2] = pack8(vn[2 * k2], vn[2 * k2 + 1]);
        LD_K4(fb, G2_Q, 1); SBAR; MM_K4(fa, sb0, Om); SBAR;
        LD_K4(fa, G2_Q, 2); SBAR; MM_K4(fb, sb1, Om); SBAR;
        LD_K4(fb, G2_Q, 3); SBAR; MM_K4(fa, sb2, Om); SBAR;
        LD_R4(fa, G2_QK, 0, 0); SBAR; MM_K4(fb, sb3, Om); SBAR;
#pragma unroll
        for (int dt = 0; dt < 8; ++dt) S[dt] = S[dt] * egl;
        SBAR;
        LD_R4(fb, G2_QK, 0, 1); SBAR; MM_R4(fa, Vb[0], Om[0], Om[1], Om[2], Om[3]); SBAR;
        LD_R4(fa, G2_KD, 0, 0); SBAR; MM_R4(fb, Vb[1], Om[0], Om[1], Om[2], Om[3]); SBAR;
        LD_R4(fb, G2_KD, 0, 1); SBAR; MM_R4(fa, Vb[0], S[0], S[1], S[2], S[3]); SBAR;
        LD_R4(fa, G2_KD, 4, 0); SBAR; MM_R4(fb, Vb[1], S[0], S[1], S[2], S[3]); SBAR;
        LD_R4(fb, G2_KD, 4, 1); SBAR; MM_R4(fa, Vb[0], S[4], S[5], S[6], S[7]); SBAR;
        MM_R4(fb, Vb[1], S[4], S[5], S[6], S[7]); SBAR;
#undef LD_K4
#undef MM_K4
#undef LD_R4
#undef MM_R4
#undef SBAR
        { G2_STORE(STs, cur ^ 1);
#pragma unroll
            for (int i = 0; i < 4; ++i) uc[i] = un[i]; }
        { LAS bf16_t* OTW = (LAS bf16_t*)(lds + G2_RED + w * 2048);
#pragma unroll
          for (int mt = 0; mt < 4; ++mt)
#pragma unroll
            for (int j = 0; j < 4; ++j) OTW[(16 * mt + 4 * fq + j) * 16 + fr] = f2bf(Om[mt][j]);
#pragma unroll
          for (int i = 0; i < 2; ++i) { const int row = (lane >> 1) + 32 * i, hv = lane & 1;
              bf16_t* mp_ = mix + (size_t)(t0 + row) * DM + h * 128 + 16 * w + 8 * hv; const u32x4 ov_ = *(const LAS u32x4*)(OTW + row * 16 + hv * 8);
              asm volatile("global_store_dwordx4 %0, %1, off" :: "v"(mp_), "v"(ov_) : "memory"); } }
        __syncthreads();
      }
    }
#undef G2_LOAD
#undef UN_LOAD
#undef G2_STORE
#undef G2_ST2
    asm volatile("s_waitcnt vmcnt(0)" ::: "memory");
    __syncthreads();
}

constexpr int AT_KS = 0, AT_VT = 73728, AT_PF = 143360, AT_MISC = 147712;
DI void phase_moba_attn(const Params& P, LAS unsigned char* lds) {
    const int tid = opq_tid(), lane = tid & 63, w = tid >> 6, fr = lane & 15, fq = lane >> 4;
    const bf16_t* proj = (const bf16_t*)(P.ws + WS_R1); const int* cnt = (const int*)(P.ws + WS_CNT); const int* list = (const int*)(P.ws + WS_LIST);
    f32x2* ML = (f32x2*)(P.ws + WS_ML); bf16_t* opart = (bf16_t*)P.out; unsigned* workctr = (unsigned*)(P.ws + WS_CTL);
    LAS bf16_t* KS = (LAS bf16_t*)(lds + AT_KS); LAS bf16_t* VT = (LAS bf16_t*)(lds + AT_VT); LAS int* PF = (LAS int*)(lds + AT_PF); LAS int* MISC = (LAS int*)(lds + AT_MISC);
    { const int c0 = cnt[2 * tid], c1 = cnt[2 * tid + 1]; const int a = (c0 + 511) >> 9, bsum = a + ((c1 + 511) >> 9); int inc = bsum;
#pragma unroll
      for (int o = 1; o < 64; o <<= 1) { const int v = __shfl_up(inc, o); if (lane >= o) inc += v; }
      if (lane == 63) MISC[8 + w] = inc;
      __syncthreads();
      int wb = 0;
#pragma unroll
      for (int i = 0; i < 8; ++i) wb += (i < w) ? MISC[8 + i] : 0;
      const int ex = wb + inc - bsum; PF[2 * tid] = ex; PF[2 * tid + 1] = ex + a; if (tid == 511) PF[1024] = ex + bsum;
      __syncthreads(); }
    const int totalG = PF[1024];
    const float sc2 = 0.08838834764831845f * 1.4426950408889634f;
    const int tid_at = tid;
    for (;;) {
        int tid = tid_at; asm volatile("" : "+v"(tid)); const int lane = tid & 63, w = __builtin_amdgcn_readfirstlane(tid >> 6), fr = lane & 15, fq = lane >> 4;
        if (tid == 0) MISC[0] = (int)atomicAdd(workctr, 1u);
        __syncthreads();
        const int wid = MISC[0];
        __syncthreads();
        if (wid >= totalG + 1024) break;
        int bh, j, causal, qstart, qcount;
        if (wid < totalG) { int lo = 0, hi = 1024; while (hi - lo > 1) { const int mid = (lo + hi) >> 1; if (PF[mid] <= wid) lo = mid; else hi = mid; }
            bh = lo >> 6; j = lo & 63; causal = 0; qstart = (wid - PF[lo]) * 512; const int c = cnt[lo]; qcount = c - qstart; if (qcount > 512) qcount = 512; }
        else { const int o = wid - totalG; bh = o >> 6; j = o & 63; causal = 1; qstart = 0; qcount = 256; }
        const int b = bh >> 3, h = bh & 7; const size_t kbase = (size_t)(b * TT + j * 256);
        { u32x4 kr[8], vr[8];
#pragma unroll
          for (int i8 = 0; i8 < 8; ++i8) { const int pid = tid + i8 * 512; kr[i8] = *(const u32x4*)(proj + (kbase + (pid >> 4)) * NPJ + OFF_MK + h * 128 + (pid & 15) * 8);
              const int e = pid >> 5, ks = pid & 31; vr[i8] = *(const u32x4*)(proj + (kbase + 2 * e + (ks >> 4)) * NPJ + OFF_MV + h * 128 + (ks & 15) * 8); }
#pragma unroll
          for (int i8 = 0; i8 < 8; ++i8) { const int pid = tid + i8 * 512; *(LAS u32x4*)(KS + (pid >> 4) * 144 + (pid & 15) * 8) = kr[i8];
              const int e = pid >> 5, ks = pid & 31; const int g_ = (ks >> 2) * 32, d_ = (ks & 3) * 8;
              *(LAS u32x2*)(VT + e * 272 + g_ + perm4(d_)) = (u32x2){vr[i8].x, vr[i8].y}; *(LAS u32x2*)(VT + e * 272 + g_ + perm4(d_ + 4)) = (u32x2){vr[i8].z, vr[i8].w}; } }
        const int lbase = bh * LISTN + j * 16384 - 128 * j * (j + 1) + qstart;
        const int ntile = (qcount + 127) >> 7;
        int en0, en1, en2, en3;
        { const int q0 = 16 * w + fr, lim = qcount - 1;
          if (causal) { en0 = (j * 256 + q0) | (3 << 14); en1 = (j * 256 + q0 + 128) | (3 << 14); en2 = en1; en3 = en1; }
          else { en0 = list[lbase + (q0 < lim ? q0 : lim)]; en1 = list[lbase + (q0 + 128 < lim ? q0 + 128 : lim)]; en2 = list[lbase + (q0 + 256 < lim ? q0 + 256 : lim)]; en3 = list[lbase + (q0 + 384 < lim ? q0 + 384 : lim)]; } }
        bf16x8 Bq[4], Bn[4];
        { const bf16_t* qp = proj + (size_t)(b * TT + (en0 & 16383)) * NPJ + OFF_MQ + h * 128 + 8 * fq;
#pragma unroll
          for (int ks = 0; ks < 4; ++ks) Bq[ks] = *(const bf16x8*)(qp + 32 * ks); }
        __syncthreads();
        for (int tile = 0; tile < ntile; ++tile) {
            const int en = tile == 0 ? en0 : (tile == 1 ? en1 : (tile == 2 ? en2 : en3));
            { const int enx = tile == 0 ? en1 : (tile == 1 ? en2 : en3); const bf16_t* qp = proj + (size_t)(b * TT + (enx & 16383)) * NPJ + OFF_MQ + h * 128 + 8 * fq;
#pragma unroll
              for (int ks = 0; ks < 4; ++ks) Bn[ks] = *(const bf16x8*)(qp + 32 * ks); }
            const int qi = tile * 128 + 16 * w + fr; const bool valid = qi < qcount; const int t = en & 16383, slot = en >> 14;
            if (tile * 128 + 16 * w < qcount) {
            const int nkt = causal ? (8 * tile + w + 1) : 16;
            f32x4 st[16]; float mx = -INFINITY;
#pragma unroll
            for (int kp = 0; kp < 8; ++kp) { f32x4 a0 = {0.f, 0.f, 0.f, 0.f}, a1 = {0.f, 0.f, 0.f, 0.f};
                if (2 * kp < nkt) { bf16x8 kf[8];
#pragma unroll
                    for (int ks = 0; ks < 4; ++ks) { kf[ks] = *(const LAS bf16x8*)(KS + (32 * kp + fr) * 144 + 32 * ks + 8 * fq); kf[4 + ks] = *(const LAS bf16x8*)(KS + (32 * kp + 16 + fr) * 144 + 32 * ks + 8 * fq); }
#pragma unroll
                    for (int ks = 0; ks < 4; ++ks) { a0 = mfma16(kf[ks], Bq[ks], a0); a1 = mfma16(kf[4 + ks], Bq[ks], a1); }
#pragma unroll
                    for (int jj = 0; jj < 4; ++jj) { float s0 = a0[jj] * sc2, s1 = a1[jj] * sc2;
                        if (causal && (32 * kp + 4 * fq + jj) > qi) s0 = -INFINITY; if ((causal && (32 * kp + 16 + 4 * fq + jj) > qi) || 2 * kp + 1 >= nkt) s1 = -INFINITY;
                        a0[jj] = s0; a1[jj] = s1; mx = fmaxf(mx, fmaxf(s0, s1)); }
                } else { a0 = (f32x4){-INFINITY, -INFINITY, -INFINITY, -INFINITY}; a1 = a0; }
                st[2 * kp] = a0; st[2 * kp + 1] = a1; }
            mx = fmaxf(mx, __shfl_xor(mx, 16)); mx = fmaxf(mx, __shfl_xor(mx, 32));
            float ls = 0.f;
#pragma unroll
            for (int kt = 0; kt < 16; ++kt)
#pragma unroll
                for (int jj = 0; jj < 4; ++jj) { const float pv = exp2f(st[kt][jj] - mx); st[kt][jj] = pv; ls += pv; }
            ls += __shfl_xor(ls, 16); ls += __shfl_xor(ls, 32);
            f32x4 ot[8];
#pragma unroll
            for (int et = 0; et < 8; ++et) ot[et] = (f32x4){0.f, 0.f, 0.f, 0.f};
#pragma unroll
            for (int k2 = 0; k2 < 8; ++k2) { if (2 * k2 < nkt) { const bf16x8 pb = pack8(st[2 * k2], st[2 * k2 + 1]);
#pragma unroll
                    for (int eh = 0; eh < 2; ++eh) { bf16x8 vf[4];
#pragma unroll
                        for (int et = 0; et < 4; ++et) vf[et] = *(const LAS bf16x8*)(VT + (16 * (4 * eh + et) + fr) * 272 + 32 * k2 + 8 * fq);
#pragma unroll
                        for (int et = 0; et < 4; ++et) ot[4 * eh + et] = mfma16(vf[et], pb, ot[4 * eh + et]); } } }
            if (valid) { const float il = 1.f / ls; const size_t rid = (size_t)bh * TT + t; bf16_t* op = opart + ((size_t)slot * 262144 + rid) * 128 + 4 * fq;
#pragma unroll
                for (int et = 0; et < 8; ++et) { u32x2 wv; wv.x = pk2(ot[et][0] * il, ot[et][1] * il); wv.y = pk2(ot[et][2] * il, ot[et][3] * il); *(u32x2*)(op + 16 * et) = wv; }
                if (fq == 0) ML[(size_t)slot * 262144 + rid] = (f32x2){mx, ls}; }
            }
#pragma unroll
            for (int ks = 0; ks < 4; ++ks) Bq[ks] = Bn[ks];
        }
        __syncthreads();
    }
}

DI void phase_moba_combine(const Params& P, bool do_gate, bool do_moba, int wg0, int nwg) {
    const bf16_t* opart = (const bf16_t*)P.out; const f32x2* ML = (const f32x2*)(P.ws + WS_ML); bf16_t* mix = (bf16_t*)(P.ws + WS_R2);
    const int gtid = wg0 * NTHREADS + opq_tid(), gsz = nwg * NTHREADS;
    if (do_gate) { const bf16_t* proj = (const bf16_t*)(P.ws + WS_R1);
      for (int i0 = gtid; i0 < MT * 128; i0 += 4 * gsz) { u32x4 mv[4], zv[4];
#pragma unroll
          for (int k = 0; k < 4; ++k) { const int i = i0 + k * gsz < MT * 128 ? i0 + k * gsz : i0; const int row = i >> 7, sg = i & 127; mv[k] = *(const u32x4*)(mix + (size_t)row * DM + sg * 8); zv[k] = *(const u32x4*)(proj + (size_t)row * NPJ + OFF_GZ + sg * 8); }
          const int sg0 = i0 & 127; const f32x4 g0 = *(const f32x4*)(P.gdn_norm + (sg0 & 15) * 8), g1 = *(const f32x4*)(P.gdn_norm + (sg0 & 15) * 8 + 4);
#pragma unroll
          for (int k = 0; k < 4; ++k) { const int i = i0 + k * gsz; const int row = i >> 7, sg = i & 127;
              float o[8]; o[0] = bflo(mv[k].x); o[1] = bfhi(mv[k].x); o[2] = bflo(mv[k].y); o[3] = bfhi(mv[k].y); o[4] = bflo(mv[k].z); o[5] = bfhi(mv[k].z); o[6] = bflo(mv[k].w); o[7] = bfhi(mv[k].w);
              float ssl = 0.f;
#pragma unroll
              for (int q = 0; q < 8; ++q) ssl += o[q] * o[q];
              const float rs = rsqrtf(row16_sum(ssl) * (1.f / 128.f) + 1e-6f); const u32x4 z = zv[k];
              u32x4 wv; wv.x = pk2(o[0] * rs * g0[0] * silu_f(bflo(z.x)), o[1] * rs * g0[1] * silu_f(bfhi(z.x))); wv.y = pk2(o[2] * rs * g0[2] * silu_f(bflo(z.y)), o[3] * rs * g0[3] * silu_f(bfhi(z.y)));
              wv.z = pk2(o[4] * rs * g1[0] * silu_f(bflo(z.z)), o[5] * rs * g1[1] * silu_f(bfhi(z.z))); wv.w = pk2(o[6] * rs * g1[2] * silu_f(bflo(z.w)), o[7] * rs * g1[3] * silu_f(bfhi(z.w)));
              if (i < MT * 128) *(u32x4*)(mix + (size_t)row * DM + sg * 8) = wv; } } }
    if (do_moba) for (int i0 = gtid; i0 < 262144 * 16; i0 += 2 * gsz) {
        f32x2 ml[2][4]; u32x4 raw[2][4];
#pragma unroll
        for (int k = 0; k < 2; ++k) { const int i = i0 + k * gsz < 262144 * 16 ? i0 + k * gsz : i0; const int rid = i >> 4, sg = i & 15;
#pragma unroll
            for (int s = 0; s < 4; ++s) { ml[k][s] = ML[(size_t)s * 262144 + rid]; raw[k][s] = *(const u32x4*)(opart + ((size_t)s * 262144 + rid) * 128 + sg * 8); } }
#pragma unroll
        for (int k = 0; k < 2; ++k) { const int i = i0 + k * gsz; const int rid = i >> 4, sg = i & 15; const int bh = rid >> 14, t = rid & 16383, b = bh >> 3, h = bh & 7;
            float M = -INFINITY;
#pragma unroll
            for (int s = 0; s < 4; ++s) M = fmaxf(M, ml[k][s].x);
            float wgt[4], Lt = 0.f;
#pragma unroll
            for (int s = 0; s < 4; ++s) { wgt[s] = ml[k][s].y > 0.f ? ml[k][s].y * exp2f(ml[k][s].x - M) : 0.f; Lt += wgt[s]; }
            const float iL = 1.f / Lt; float o[8];
#pragma unroll
            for (int q = 0; q < 8; ++q) o[q] = 0.f;
#pragma unroll
            for (int s = 0; s < 4; ++s) { const float ww = wgt[s] * iL; const u32x4 r = raw[k][s];
                if (wgt[s] > 0.f) { o[0] += ww * bflo(r.x); o[1] += ww * bfhi(r.x); o[2] += ww * bflo(r.y); o[3] += ww * bfhi(r.y); o[4] += ww * bflo(r.z); o[5] += ww * bfhi(r.z); o[6] += ww * bflo(r.w); o[7] += ww * bfhi(r.w); } }
            u32x4 wv; wv.x = pk2(o[0], o[1]); wv.y = pk2(o[2], o[3]); wv.z = pk2(o[4], o[5]); wv.w = pk2(o[6], o[7]);
            if (i < 262144 * 16) *(u32x4*)(mix + (size_t)(b * TT + t) * DM + 1024 + h * 128 + sg * 8) = wv; } }
}

DI void sub_barrier(unsigned* ctr, unsigned nwg) {
    asm volatile("s_waitcnt vmcnt(0)" ::: "memory");
    __syncthreads();
    if (threadIdx.x == 0) {
        __builtin_amdgcn_fence(__ATOMIC_RELEASE, "agent");
        __hip_atomic_fetch_add(ctr, 1u, __ATOMIC_RELAXED, __HIP_MEMORY_SCOPE_AGENT);
        while (__hip_atomic_load(ctr, __ATOMIC_RELAXED, __HIP_MEMORY_SCOPE_AGENT) < nwg) __builtin_amdgcn_s_sleep(8);
        __builtin_amdgcn_fence(__ATOMIC_ACQUIRE, "agent");
        asm volatile("s_waitcnt vmcnt(0)" ::: "memory");
    }
    __syncthreads();
}

__global__ void __launch_bounds__(NTHREADS) hybrid_fwd(Params P) {
    extern __shared__ __attribute__((aligned(16))) unsigned char smem[];
    LAS unsigned char* lds = (LAS unsigned char*)smem;
    cg::grid_group grid = cg::this_grid();
    unsigned char* ws = P.ws; const int G = gridDim.x, bx = blockIdx.x;
    bf16_t* R0 = (bf16_t*)(ws + WS_R0); bf16_t* R1 = (bf16_t*)(ws + WS_R1); bf16_t* R2 = (bf16_t*)(ws + WS_R2);
    float* ss1 = (float*)(ws + WS_SS1); float* ss2 = (float*)(ws + WS_SS2);

    phase_prep(P, lds);
    grid.sync();
    { pg8::Gemm g{R0, (const bf16_t*)(ws + WS_WIN), MT, NPJ, DM}; pg8::StaticOrder S; S.init(MT, NPJ, G, bx); EpiProj E{R1, (bf16_t*)(ws + WS_HALO)}; pg8::gemm_phase<decltype(E), pg8::StaticOrder, true, true>(lds, g, S, E); }
    phase_ba(P);
    grid.sync();
    phase_gdn_prep(P, lds);
    grid.sync();
    if (bx < 16) phase_gdn_scan(P, lds, bx);
    else { unsigned* ctl = (unsigned*)(ws + WS_CTL);
        phase_moba_prep(P, lds, bx - 16, G - 16); sub_barrier(ctl + 8, (unsigned)(G - 16));
        phase_moba_select(P, lds, bx - 16, G - 16); sub_barrier(ctl + 9, (unsigned)(G - 16));
        phase_moba_attn(P, lds);
        phase_wconv_late(P, lds, bx - 16, G - 16);
        sub_barrier(ctl + 10, (unsigned)(G - 16)); phase_moba_combine(P, false, true, bx - 16, G - 16); }
    grid.sync();
    phase_moba_combine(P, true, false, bx, G);
    grid.sync();
    { pg8::Gemm g{R2, (const bf16_t*)(ws + WS_WO), MT, DM, DM}; pg8::StaticOrder S; S.init(MT, DM, G, bx); EpiResid E{P.x, P.out, R0, ss1}; pg8::gemm_phase<decltype(E), pg8::StaticOrder, true, false>(lds, g, S, E); }
    grid.sync();
    { pg8::Gemm g{R0, (const bf16_t*)(ws + WS_WGU), MT, 2 * FF, DM}; pg8::StaticOrder S; S.init(MT, 2 * FF, G, bx); EpiAct E{R1, ss1}; pg8::gemm_phase<decltype(E), pg8::StaticOrder, true, true>(lds, g, S, E); }
    grid.sync();
    { pg8::Gemm g{(const bf16_t*)(ws + WS_PB), (const bf16_t*)(ws + WS_WPP), MT, DM, 256}; pg8::StaticOrder S; S.init(MT, DM, G, bx); EpiPlainBf16 E{R0, DM}; pg8::gemm_phase<decltype(E), pg8::StaticOrder, true, false>(lds, g, S, E); }
    { pg8::Gemm g{R1, (const bf16_t*)(ws + WS_WDN), MT, DM, FF}; pg8::StaticOrder S; S.init(MT, DM, G, bx); EpiResid E{P.out, P.out, R2, ss2}; pg8::gemm_phase<decltype(E), pg8::StaticOrder, true, false>(lds, g, S, E); }
    grid.sync();
    { pg8::Gemm g{R2, (const bf16_t*)(ws + WS_WPG), MT, DM, DM}; pg8::StaticOrder S; S.init(MT, DM, G, bx); EpiOut E{P.out, R0, ss2}; pg8::gemm_phase<decltype(E), pg8::StaticOrder, true, false>(lds, g, S, E); }
}

extern "C" void kernel_launch(void* const* d_in, const int* in_sizes, int n_in, void* d_out, int out_size, void* d_ws, size_t ws_size, hipStream_t stream) {
    static int grid_blocks = 0;
    if (!grid_blocks) {
        int dev = 0, cus = 0, per_cu = 0;
        hipGetDevice(&dev);
        hipDeviceGetAttribute(&cus, hipDeviceAttributeMultiprocessorCount, dev);
        hipFuncSetAttribute((const void*)hybrid_fwd, hipFuncAttributeMaxDynamicSharedMemorySize, LDS_BYTES);
        hipOccupancyMaxActiveBlocksPerMultiprocessor(&per_cu, (const void*)hybrid_fwd, NTHREADS, LDS_BYTES);
        if (per_cu < 1) per_cu = 1;
        grid_blocks = cus * per_cu;
        if (ws_size < WS_END) fprintf(stderr, "kernel_launch: workspace too small: %zu < %zu\n", ws_size, (size_t)WS_END);
    }
    Params p{};
    p.x = (const float*)d_in[0]; p.p = (const float*)d_in[1]; p.attn_norm = (const float*)d_in[2]; p.w_in = (const float*)d_in[3]; p.conv_w = (const float*)d_in[4];
    p.A_log = (const float*)d_in[5]; p.dt_bias = (const float*)d_in[6]; p.gdn_norm = (const float*)d_in[7]; p.q_norm = (const float*)d_in[8]; p.k_norm = (const float*)d_in[9];
    p.w_o = (const float*)d_in[10]; p.ffn_norm = (const float*)d_in[11]; p.w_gate = (const float*)d_in[12]; p.w_up = (const float*)d_in[13]; p.w_down = (const float*)d_in[14];
    p.ple_norm = (const float*)d_in[15]; p.w_pg = (const float*)d_in[16]; p.w_pp = (const float*)d_in[17];
    p.out = (float*)d_out; p.ws = (unsigned char*)d_ws;
    void* args[] = {&p};
    hipError_t e = hipLaunchCooperativeKernel((const void*)hybrid_fwd, dim3(grid_blocks), dim3(NTHREADS), args, LDS_BYTES, stream);
    if (e != hipSuccess) fprintf(stderr, "cooperative launch failed: %s (grid %d)\n", hipGetErrorString(e), grid_blocks);
}
```

```cpp
#include <hip/hip_runtime.h>
#include <hip/hip_cooperative_groups.h>
#include <cstdio>
namespace cg = cooperative_groups;

#define LAS __attribute__((address_space(3)))
#define DI __device__ __forceinline__
typedef unsigned short bf16_t;
typedef short bf16x8 __attribute__((ext_vector_type(8)));
typedef float f32x4 __attribute__((ext_vector_type(4)));
typedef float f32x2 __attribute__((ext_vector_type(2)));
typedef unsigned u32x4 __attribute__((ext_vector_type(4)));
typedef unsigned u32x2 __attribute__((ext_vector_type(2)));
typedef __bf16 bfv2 __attribute__((ext_vector_type(2)));

constexpr int DM = 2048, TT = 16384, MT = 32768, NPJ = 7168, FF = 5632, INW = 7184;
constexpr int OFF_GQ = 0, OFF_GK = 1024, OFF_GV = 2048, OFF_GZ = 3072, OFF_MQ = 4096, OFF_MK = 5120, OFF_MV = 6144;
constexpr int LISTN = 516096;
constexpr int NTHREADS = 512;
constexpr int LDS_BYTES = 163840;

constexpr size_t WS_CTL   = 0;
constexpr size_t WS_CNT   = 4096;
constexpr size_t WS_SS1   = 8192;
constexpr size_t WS_SS2   = WS_SS1 + 131072;
constexpr size_t WS_GL    = WS_SS2 + 131072;
constexpr size_t WS_KMEAN = WS_GL + 16384;
constexpr size_t WS_WBA   = WS_KMEAN + 524288;
constexpr size_t WS_BA    = WS_WBA + 65536;
constexpr size_t WS_WIN   = WS_BA + 2097152;
constexpr size_t WS_WO    = WS_WIN + (size_t)7168 * 2048 * 2;
constexpr size_t WS_WGU   = WS_WO + (size_t)2048 * 2048 * 2;
constexpr size_t WS_WDN   = WS_WGU + (size_t)11264 * 2048 * 2;
constexpr size_t WS_WPG   = WS_WDN + (size_t)2048 * 5632 * 2;
constexpr size_t WS_WPP   = WS_WPG + (size_t)2048 * 2048 * 2;
constexpr size_t WS_PB    = WS_WPP + (size_t)2048 * 256 * 2;
constexpr size_t WS_R0    = WS_PB + (size_t)32768 * 256 * 2;
constexpr size_t WS_R1    = WS_R0 + (size_t)32768 * 2048 * 2;
constexpr size_t WS_R2    = WS_R1 + (size_t)32768 * 7168 * 2;
constexpr size_t WS_W2    = WS_R2 + (size_t)32768 * 2048 * 2;
constexpr size_t WS_QKB   = WS_W2 + (size_t)32768 * 1024 * 2;
constexpr size_t WS_HALO  = WS_QKB + (size_t)4096 * 4096 * 2;
constexpr size_t WS_LIST  = WS_HALO + (size_t)513 * 3 * 3072 * 2 + 256 - ((size_t)513 * 3 * 3072 * 2) % 256;
constexpr size_t WS_ML    = WS_LIST + (size_t)16 * LISTN * 4;
constexpr size_t WS_SSQ   = WS_ML + (size_t)4 * 262144 * 8;
constexpr size_t WS_END   = WS_SSQ + (size_t)32768 * 64 * 4;

struct Params {
    const float* x; const float* p; const float* attn_norm; const float* w_in; const float* conv_w; const float* A_log; const float* dt_bias;
    const float* gdn_norm; const float* q_norm; const float* k_norm; const float* w_o; const float* ffn_norm; const float* w_gate; const float* w_up;
    const float* w_down; const float* ple_norm; const float* w_pg; const float* w_pp;
    float* out; unsigned char* ws;
};

DI unsigned pk2(float a, float b) { f32x2 v = {a, b}; bfv2 r = __builtin_convertvector(v, bfv2); return __builtin_bit_cast(unsigned, r); }
DI bf16_t f2bf(float a) { return (bf16_t)(pk2(a, 0.f) & 0xffffu); }
DI float bflo(unsigned w) { return __uint_as_float(w << 16); }
DI float bfhi(unsigned w) { return __uint_as_float(w & 0xffff0000u); }
DI float bf2f(bf16_t v) { return __uint_as_float(((unsigned)v) << 16); }
DI bf16x8 pack8(const f32x4& a, const f32x4& b) { u32x4 w; w.x = pk2(a[0], a[1]); w.y = pk2(a[2], a[3]); w.z = pk2(b[0], b[1]); w.w = pk2(b[2], b[3]); return __builtin_bit_cast(bf16x8, w); }
DI bf16x8 cat8(u32x2 lo, u32x2 hi) { u32x4 w; w.x = lo.x; w.y = lo.y; w.z = hi.x; w.w = hi.y; return __builtin_bit_cast(bf16x8, w); }
DI f32x4 mfma16(bf16x8 a, bf16x8 b, f32x4 c) { return __builtin_amdgcn_mfma_f32_16x16x32_bf16(a, b, c, 0, 0, 0); }
DI int perm4(int d4) { return d4 < 16 ? 2 * d4 : 2 * (d4 - 16) + 4; }
DI float dpp_f(float v, int ctrl_sel) { int x = __float_as_int(v); int r;
    if (ctrl_sel == 0) r = __builtin_amdgcn_mov_dpp(x, 0xB1, 0xf, 0xf, true); else if (ctrl_sel == 1) r = __builtin_amdgcn_mov_dpp(x, 0x4E, 0xf, 0xf, true);
    else if (ctrl_sel == 2) r = __builtin_amdgcn_mov_dpp(x, 0x141, 0xf, 0xf, true); else r = __builtin_amdgcn_mov_dpp(x, 0x140, 0xf, 0xf, true);
    return __int_as_float(r); }
DI float row16_sum(float v) { v += dpp_f(v, 0); v += dpp_f(v, 1); v += dpp_f(v, 2); v += dpp_f(v, 3); return v; }
DI float silu_f(float v) { return v * __builtin_amdgcn_rcpf(1.f + __expf(-v)); }
DI float sigm_f(float v) { return __builtin_amdgcn_rcpf(1.f + __expf(-v)); }

DI int opq_tid() { int t = threadIdx.x; asm volatile("" : "+v"(t)); return t; }

namespace pg8 {
constexpr int BM = 256, BK = 64, HALF = 128, HTB = HALF * BK * 2, STAGE_BYTES = 8 * HTB, NXCD = 8, WGM = 8;
DI int lds_byte(int r, int c) { const int st = (r >> 4) * 2 + (c >> 5), rr = r & 15, cc = c & 31, ob = rr * 64 + cc * 2; return st * 1024 + (ob ^ (((ob >> 9) & 1) << 5)); }
DI void stage_rc(int b, int& R, int& C) { const int st = b / 1024, sb = b % 1024, swz = sb ^ (((sb >> 9) & 1) << 5); R = (st >> 1) * 16 + swz / 64; C = (st & 1) * 32 + (swz % 64) / 2; }
DI int perm32(int rho) { const int n = rho >> 4, i = rho & 15; return 8 * (i >> 2) + 4 * n + (i & 3); }
struct Unit { int pm, pn; };
struct Gemm { const bf16_t* A; const bf16_t* Bt; int M, N, K; };
struct StaticOrder {
    int nM, nN, nwg, G, c;
    DI void init(int M, int N, int G_, int c_) { nM = M / BM; nN = N / BM; nwg = nM * nN; G = G_; c = c_; }
    DI bool next(int i, Unit& u) const {
        const long L = (long)i * G + c; if (L >= nwg) return false;
        int wgid = (int)L; { const int q = nwg / NXCD, r = nwg % NXCD, xcd = wgid % NXCD, off = wgid / NXCD; wgid = (xcd < r ? xcd * (q + 1) : r * (q + 1) + (xcd - r) * q) + off; }
        const int nig = WGM * nN, gid = wgid / nig, fm = gid * WGM, gsz = (nM - fm) < WGM ? (nM - fm) : WGM;
        u.pm = fm + ((wgid % nig) % gsz); u.pn = (wgid % nig) / gsz; return true;
    }
    DI void a_ready(const Unit&) const {}
    DI void done(const Unit&) const {}
};

template <class Epi, class Sched, bool ALIGN_EPI = false, bool SP2 = false>
DI void gemm_phase(LAS unsigned char* lds, const Gemm g, const Sched& S, const Epi& E) {
    const int tid = opq_tid(), wid = __builtin_amdgcn_readfirstlane(tid >> 6), lane = tid & 63, wr = wid >> 2, wc = wid & 3, fr = lane & 15, fq = lane >> 4;
    const int K = g.K, nt = K / BK;
    unsigned voffA[2], voffB[2];
#pragma unroll
    for (int i = 0; i < 2; ++i) { int R, C; stage_rc(tid * 16 + i * 8192, R, C); const int Rb = Epi::PERM ? ((R & ~31) + perm32(R & 31)) : R;
        voffA[i] = (unsigned)(R * K + C) * 2u; voffB[i] = (unsigned)(Rb * K + C) * 2u; }
    const size_t kstep = (size_t)(BK * 2);
    const size_t hstep = (size_t)HALF * K * 2;
    const size_t tstep = 2 * hstep;
    const unsigned ldsw = (unsigned)wid * 1024u;
    const int aoff = lds_byte(wr * 64 + fr, fq * 8), boff = lds_byte(wc * 32 + fr, fq * 8);
#define PG8_SA(b, h) (((b) * 2 + (h)) * HTB)
#define PG8_SB(b, h) ((4 + (b) * 2 + (h)) * HTB)
#define PG8_STAGE(bufoff, gbase, voff) do { _Pragma("unroll") for (int _i = 0; _i < 2; ++_i) \
        __builtin_amdgcn_global_load_lds((const unsigned*)((const char*)(gbase) + (voff)[_i]), (LAS unsigned*)(lds + (bufoff) + ldsw + _i * 8192), 16, 0, 0); } while (0)
#define PG8_LDA(dst, b, h) do { _Pragma("unroll") for (int m = 0; m < 4; ++m) _Pragma("unroll") for (int k = 0; k < 2; ++k) dst[m][k] = *(const LAS bf16x8*)(lds + PG8_SA(b, h) + aoff + m * 2048 + k * 1024); } while (0)
#define PG8_LDB(dst, b, h) do { _Pragma("unroll") for (int n = 0; n < 2; ++n) _Pragma("unroll") for (int k = 0; k < 2; ++k) dst[n][k] = *(const LAS bf16x8*)(lds + PG8_SB(b, h) + boff + n * 2048 + k * 1024); } while (0)
#define PG8_MMA(ai, bj, At, Bt) do { __builtin_amdgcn_s_setprio(1); _Pragma("unroll") for (int m = 0; m < 4; ++m) _Pragma("unroll") for (int n = 0; n < 2; ++n) _Pragma("unroll") for (int k = 0; k < 2; ++k) \
        acc[ai][bj][m][n] = __builtin_amdgcn_mfma_f32_16x16x32_bf16(Bt[n][k], At[m][k], acc[ai][bj][m][n], 0, 0, 0); __builtin_amdgcn_s_setprio(0); } while (0)
#define PG8_WAIT_V(n) asm volatile("s_waitcnt vmcnt(" #n ")" ::: "memory")
#define PG8_WAIT_L(n) asm volatile("s_waitcnt lgkmcnt(" #n ")" ::: "memory")
#define PG8_BAR __builtin_amdgcn_s_barrier()
#define PG8_SCHED __builtin_amdgcn_sched_barrier(0)
    Unit cur, nxt; int ui = 0;
    if (!S.next(0, cur)) return;
    f32x4 acc[2][2][4][2];
#pragma unroll
    for (int a = 0; a < 2; ++a)
#pragma unroll
        for (int b = 0; b < 2; ++b)
#pragma unroll
            for (int m = 0; m < 4; ++m)
#pragma unroll
                for (int n = 0; n < 2; ++n) acc[a][b][m][n] = (f32x4){0.f, 0.f, 0.f, 0.f};
    bf16x8 At[4][2], B0[2][2], B1[2][2];
    const char* cA = (const char*)g.A + (size_t)cur.pm * tstep; const char* cB = (const char*)g.Bt + (size_t)cur.pn * tstep;
    S.a_ready(cur);
    if constexpr (SP2) {
        PG8_STAGE(PG8_SB(0, 0), cB, voffB); PG8_STAGE(PG8_SB(0, 1), cB + hstep, voffB); PG8_STAGE(PG8_SA(0, 0), cA, voffA); PG8_STAGE(PG8_SA(0, 1), cA + hstep, voffA);
        if (wr == 1) PG8_BAR;
        PG8_WAIT_V(2); PG8_BAR;
        PG8_STAGE(PG8_SB(1, 0), cB + kstep, voffB); PG8_STAGE(PG8_SA(1, 0), cA + kstep, voffA); PG8_STAGE(PG8_SB(1, 1), cB + hstep + kstep, voffB);
        PG8_WAIT_V(6); PG8_BAR;
    } else {
        PG8_STAGE(PG8_SB(0, 0), cB, voffB); PG8_STAGE(PG8_SA(0, 0), cA, voffA); PG8_STAGE(PG8_SB(0, 1), cB + hstep, voffB); PG8_STAGE(PG8_SA(0, 1), cA + hstep, voffA);
        if (wr == 1) PG8_BAR;
        PG8_WAIT_V(4); PG8_BAR;
        PG8_STAGE(PG8_SB(1, 0), cB + kstep, voffB); PG8_STAGE(PG8_SA(1, 0), cA + kstep, voffA); PG8_STAGE(PG8_SB(1, 1), cB + hstep + kstep, voffB);
        PG8_WAIT_V(6); PG8_BAR;
    }
    for (;;) {
        const bool has_next = S.next(ui + 1, nxt);
        const char* nA = has_next ? (const char*)g.A + (size_t)nxt.pm * tstep : cA; const char* nB = has_next ? (const char*)g.Bt + (size_t)nxt.pn * tstep : cB;
        for (int t = 0; t < nt; t += 2) {
            const bool last = (t == nt - 2);
            const char* a1 = cA + (size_t)(t + 1) * kstep;
            const char* a2 = last ? nA : cA + (size_t)(t + 2) * kstep; const char* b2 = last ? nB : cB + (size_t)(t + 2) * kstep;
            const char* a3 = a2 + kstep; const char* b3 = b2 + kstep;
            if (last && has_next) S.a_ready(nxt);
            if constexpr (SP2) {
            PG8_LDB(B0, 0, 0); PG8_LDB(B1, 0, 1); PG8_SCHED; PG8_LDA(At, 0, 0); PG8_STAGE(PG8_SA(1, 1), a1 + hstep, voffA);
            PG8_WAIT_V(8); PG8_WAIT_L(0); PG8_BAR; PG8_MMA(0, 0, At, B0); PG8_MMA(0, 1, At, B1); PG8_BAR; PG8_SCHED;
            PG8_LDA(At, 0, 1); PG8_STAGE(PG8_SB(0, 0), b2, voffB); PG8_STAGE(PG8_SB(0, 1), b2 + hstep, voffB); PG8_STAGE(PG8_SA(0, 0), a2, voffA);
            PG8_WAIT_V(8); PG8_WAIT_L(0); PG8_BAR; PG8_MMA(1, 0, At, B0); PG8_MMA(1, 1, At, B1); PG8_BAR; PG8_SCHED;
            PG8_LDB(B0, 1, 0); PG8_LDB(B1, 1, 1); PG8_SCHED; PG8_LDA(At, 1, 0); PG8_STAGE(PG8_SA(0, 1), a2 + hstep, voffA);
            PG8_WAIT_V(8); PG8_WAIT_L(0); PG8_BAR; PG8_MMA(0, 0, At, B0); PG8_MMA(0, 1, At, B1); PG8_BAR; PG8_SCHED;
            PG8_LDA(At, 1, 1); PG8_STAGE(PG8_SB(1, 0), b3, voffB); PG8_STAGE(PG8_SB(1, 1), b3 + hstep, voffB); PG8_STAGE(PG8_SA(1, 0), a3, voffA);
            PG8_WAIT_V(8); PG8_WAIT_L(0); PG8_BAR; PG8_MMA(1, 0, At, B0); PG8_MMA(1, 1, At, B1); PG8_BAR; PG8_SCHED;
            } else {
            PG8_LDB(B0, 0, 0); PG8_SCHED; PG8_LDA(At, 0, 0); PG8_STAGE(PG8_SA(1, 1), a1 + hstep, voffA);
            PG8_WAIT_L(8); PG8_BAR; PG8_WAIT_L(0); PG8_MMA(0, 0, At, B0); PG8_BAR; PG8_SCHED;
            PG8_LDB(B1, 0, 1); PG8_STAGE(PG8_SB(0, 0), b2, voffB);
            PG8_BAR; PG8_WAIT_L(0); PG8_MMA(0, 1, At, B1); PG8_BAR;
            PG8_LDA(At, 0, 1); PG8_STAGE(PG8_SA(0, 0), a2, voffA);
            PG8_BAR; PG8_WAIT_L(0); PG8_MMA(1, 0, At, B0); PG8_BAR; PG8_SCHED;
            PG8_STAGE(PG8_SB(0, 1), b2 + hstep, voffB);
            PG8_WAIT_V(6); PG8_BAR; PG8_MMA(1, 1, At, B1); PG8_BAR;
            PG8_LDB(B0, 1, 0); PG8_SCHED; PG8_LDA(At, 1, 0); PG8_STAGE(PG8_SA(0, 1), a2 + hstep, voffA);
            PG8_WAIT_L(8); PG8_BAR; PG8_WAIT_L(0); PG8_MMA(0, 0, At, B0); PG8_BAR; PG8_SCHED;
            PG8_LDB(B1, 1, 1); PG8_STAGE(PG8_SB(1, 0), b3, voffB);
            PG8_BAR; PG8_WAIT_L(0); PG8_MMA(0, 1, At, B1); PG8_BAR;
            PG8_LDA(At, 1, 1); PG8_STAGE(PG8_SA(1, 0), a3, voffA);
            PG8_BAR; PG8_WAIT_L(0); PG8_MMA(1, 0, At, B0); PG8_BAR; PG8_SCHED;
            PG8_STAGE(PG8_SB(1, 1), b3 + hstep, voffB);
            PG8_WAIT_V(6); PG8_BAR; PG8_MMA(1, 1, At, B1); PG8_BAR;
            }
        }
        if constexpr (ALIGN_EPI) { if (wr == 0) PG8_BAR; }
        if constexpr (!Epi::AFTER_DRAIN) { E(acc, cur, wr, wc, fr, fq); S.done(cur); }
        if (!has_next) break;
#pragma unroll
        for (int a = 0; a < 2; ++a)
#pragma unroll
            for (int b = 0; b < 2; ++b)
#pragma unroll
                for (int m = 0; m < 4; ++m)
#pragma unroll
                    for (int n = 0; n < 2; ++n) acc[a][b][m][n] = (f32x4){0.f, 0.f, 0.f, 0.f};
        cur = nxt; cA = nA; cB = nB; ++ui;
        if constexpr (ALIGN_EPI) { if (wr == 1) PG8_BAR; }
    }
    PG8_WAIT_V(0);
    if constexpr (!ALIGN_EPI) { if (wr == 0) PG8_BAR; }
    PG8_BAR;
    if constexpr (Epi::AFTER_DRAIN) { E.fused(acc, cur, wr, wc, fr, fq, lds, wid, lane); S.done(cur); }
#undef PG8_SA
#undef PG8_SB
#undef PG8_STAGE
#undef PG8_LDA
#undef PG8_LDB
#undef PG8_MMA
#undef PG8_WAIT_V
#undef PG8_WAIT_L
#undef PG8_BAR
#undef PG8_SCHED
}
}
using pg8::Unit;

struct EpiProj {
    static constexpr bool PERM = true, AFTER_DRAIN = false;
    bf16_t* O; bf16_t* halo;
    DI void operator()(const f32x4 (&acc)[2][2][4][2], const Unit& u, int wr, int wc, int fr, int fq) const {
        const int row0 = u.pm * 256 + wr * 64 + fr, col0 = u.pn * 256 + wc * 32 + 8 * fq;
#pragma unroll
        for (int ai = 0; ai < 2; ++ai)
#pragma unroll
            for (int m = 0; m < 4; ++m) { const int row = row0 + ai * 128 + m * 16; bf16_t* rowp = O + (size_t)row * NPJ + col0;
#pragma unroll
                for (int bj = 0; bj < 2; ++bj) { const f32x4 v0 = acc[ai][bj][m][0], v1 = acc[ai][bj][m][1];
                    u32x4 w; w.x = pk2(v0[0], v0[1]); w.y = pk2(v0[2], v0[3]); w.z = pk2(v1[0], v1[1]); w.w = pk2(v1[2], v1[3]);
                    *(u32x4*)(rowp + bj * 128) = w;
                    if (m == 3 && fr >= 13 && u.pn < 12) *(u32x4*)(halo + ((size_t)((row >> 6) + 1) * 3 + (fr - 13)) * 3072 + col0 + bj * 128) = w; } }
    }
};
struct EpiPlainBf16 {
    static constexpr bool PERM = true, AFTER_DRAIN = false;
    bf16_t* O; int ldc;
    DI void operator()(const f32x4 (&acc)[2][2][4][2], const Unit& u, int wr, int wc, int fr, int fq) const {
        const int row0 = u.pm * 256 + wr * 64 + fr, col0 = u.pn * 256 + wc * 32 + 8 * fq;
#pragma unroll
        for (int ai = 0; ai < 2; ++ai)
#pragma unroll
            for (int m = 0; m < 4; ++m) { bf16_t* rowp = O + (size_t)(row0 + ai * 128 + m * 16) * ldc + col0;
#pragma unroll
                for (int bj = 0; bj < 2; ++bj) { const f32x4 v0 = acc[ai][bj][m][0], v1 = acc[ai][bj][m][1];
                    u32x4 w; w.x = pk2(v0[0], v0[1]); w.y = pk2(v0[2], v0[3]); w.z = pk2(v1[0], v1[1]); w.w = pk2(v1[2], v1[3]);
                    *(u32x4*)(rowp + bj * 128) = w; } }
    }
};
struct EpiResid {
    static constexpr bool PERM = false, AFTER_DRAIN = false;
    const float* base; float* out; bf16_t* hb; float* ss;
    DI void operator()(const f32x4 (&acc)[2][2][4][2], const Unit& u, int wr, int wc, int fr, int fq) const {
        const int row0 = u.pm * 256 + wr * 64 + fr, col0 = u.pn * 256 + wc * 32 + 4 * fq;
#pragma unroll
        for (int ai = 0; ai < 2; ++ai) { f32x4 bs[4][4];
#pragma unroll
            for (int m = 0; m < 4; ++m)
#pragma unroll
                for (int q = 0; q < 4; ++q) bs[m][q] = *(const f32x4*)(base + (size_t)(row0 + ai * 128 + m * 16) * DM + col0 + (q >> 1) * 128 + (q & 1) * 16);
#pragma unroll
            for (int m = 0; m < 4; ++m) { const int row = row0 + ai * 128 + m * 16; const size_t off = (size_t)row * DM + col0; float s = 0.f;
#pragma unroll
                for (int q = 0; q < 4; ++q) { const f32x4 hv = bs[m][q] + acc[ai][q >> 1][m][q & 1];
                        *(f32x4*)(out + off + (q >> 1) * 128 + (q & 1) * 16) = hv; u32x2 w; w.x = pk2(hv[0], hv[1]); w.y = pk2(hv[2], hv[3]);
                        *(u32x2*)(hb + off + (q >> 1) * 128 + (q & 1) * 16) = w; s += (hv[0] * hv[0] + hv[1] * hv[1]) + (hv[2] * hv[2] + hv[3] * hv[3]); }
                s += __shfl_xor(s, 16); s += __shfl_xor(s, 32);
                if (fq == 0) atomicAdd(ss + row, s); }
            asm volatile("" ::: "memory"); }
    }
};
struct EpiAct {
    static constexpr bool PERM = true, AFTER_DRAIN = false;
    bf16_t* O; const float* ss;
    DI void operator()(const f32x4 (&acc)[2][2][4][2], const Unit& u, int wr, int wc, int fr, int fq) const {
        const int row0 = u.pm * 256 + wr * 64 + fr, col0 = u.pn * 128 + wc * 32 + 8 * fq;
        float rs[8];
#pragma unroll
        for (int g = 0; g < 8; ++g) rs[g] = ss[row0 + (g >> 2) * 128 + (g & 3) * 16];
#pragma unroll
        for (int ai = 0; ai < 2; ++ai)
#pragma unroll
            for (int m = 0; m < 4; ++m) { const int row = row0 + ai * 128 + m * 16; const float r = rsqrtf(rs[ai * 4 + m] * (1.f / 2048.f) + 1e-6f);
                float a[8];
#pragma unroll
                for (int n = 0; n < 2; ++n)
#pragma unroll
                    for (int j = 0; j < 4; ++j) { const float gv = r * acc[ai][0][m][n][j], uv = r * acc[ai][1][m][n][j]; a[n * 4 + j] = silu_f(gv) * uv; }
                u32x4 w; w.x = pk2(a[0], a[1]); w.y = pk2(a[2], a[3]); w.z = pk2(a[4], a[5]); w.w = pk2(a[6], a[7]);
                *(u32x4*)(O + (size_t)row * FF + col0) = w; }
    }
};
struct EpiOut {
    static constexpr bool PERM = false, AFTER_DRAIN = false;
    float* out; const bf16_t* pp; const float* ss;
    DI void operator()(const f32x4 (&acc)[2][2][4][2], const Unit& u, int wr, int wc, int fr, int fq) const {
        const int row0 = u.pm * 256 + wr * 64 + fr, col0 = u.pn * 256 + wc * 32 + 4 * fq;
        float rs[8];
#pragma unroll
        for (int g = 0; g < 8; ++g) rs[g] = ss[row0 + (g >> 2) * 128 + (g & 3) * 16];
#pragma unroll
        for (int ai = 0; ai < 2; ++ai)
#pragma unroll
            for (int m = 0; m < 4; ++m) { const int row = row0 + ai * 128 + m * 16; const size_t off = (size_t)row * DM + col0; const float r = rsqrtf(rs[ai * 4 + m] * (1.f / 2048.f) + 1e-6f);
                f32x4 hv[4]; u32x2 pw[4];
#pragma unroll
                for (int q = 0; q < 4; ++q) { hv[q] = *(const f32x4*)(out + off + (q >> 1) * 128 + (q & 1) * 16); pw[q] = *(const u32x2*)(pp + off + (q >> 1) * 128 + (q & 1) * 16); }
#pragma unroll
                for (int q = 0; q < 4; ++q) { const f32x4 a = acc[ai][q >> 1][m][q & 1]; f32x4 o;
                        o[0] = hv[q][0] + sigm_f(r * a[0]) * bflo(pw[q].x); o[1] = hv[q][1] + sigm_f(r * a[1]) * bfhi(pw[q].x);
                        o[2] = hv[q][2] + sigm_f(r * a[2]) * bflo(pw[q].y); o[3] = hv[q][3] + sigm_f(r * a[3]) * bfhi(pw[q].y);
                        *(f32x4*)(out + off + (q >> 1) * 128 + (q & 1) * 16) = o; }
                asm volatile("" ::: "memory"); }
    }
};

DI void tconv_tile(const float* __restrict__ src, int ld, int c0, int k0, bf16_t* __restrict__ dst, int dK, int n0, const float* __restrict__ nw, LAS float* tl) {
    const int tid = opq_tid();
    f32x4 v[8];
#pragma unroll
    for (int i = 0; i < 8; ++i) v[i] = *(const f32x4*)(src + (size_t)(k0 + (tid >> 4) + 32 * i) * ld + c0 + (tid & 15) * 4);
#pragma unroll
    for (int i = 0; i < 8; ++i) { const int k = (tid >> 4) + 32 * i; const float sc = nw ? nw[k0 + k] : 1.f;
        LAS float* q = tl + k * 65 + (tid & 15) * 4; q[0] = v[i][0] * sc; q[1] = v[i][1] * sc; q[2] = v[i][2] * sc; q[3] = v[i][3] * sc; }
    __syncthreads();
    { const int n = tid >> 3, kq = (tid & 7) * 8;
#pragma unroll
      for (int j = 0; j < 4; ++j) { const int ks = kq + 64 * j; float f[8];
#pragma unroll
          for (int i = 0; i < 8; ++i) f[i] = tl[(ks + i) * 65 + n];
          u32x4 w; w.x = pk2(f[0], f[1]); w.y = pk2(f[2], f[3]); w.z = pk2(f[4], f[5]); w.w = pk2(f[6], f[7]);
          *(u32x4*)(dst + (size_t)(n0 + n) * dK + k0 + ks) = w; } }
    __syncthreads();
}

DI void phase_prep(const Params& P, LAS unsigned char* lds) {
    unsigned char* ws = P.ws; const int tid = opq_tid(), G = gridDim.x, bx = blockIdx.x;
    const int gtid = bx * NTHREADS + tid, gsz = G * NTHREADS;
    for (int i = gtid; i < (int)((WS_GL - WS_CTL) / 4); i += gsz) ((unsigned*)(ws + WS_CTL))[i] = 0u;
    { bf16_t* wba = (bf16_t*)(ws + WS_WBA); for (int i = gtid; i < 16 * 2048; i += gsz) { const int n = i >> 11, k = i & 2047; wba[i] = f2bf(P.w_in[(size_t)k * INW + 4096 + n]); } }
    { bf16_t* pb = (bf16_t*)(ws + WS_PB); for (int i = gtid; i < MT * 256 / 8; i += gsz) { const f32x4 a = *(const f32x4*)(P.p + (size_t)i * 8), b = *(const f32x4*)(P.p + (size_t)i * 8 + 4);
        u32x4 w; w.x = pk2(a[0], a[1]); w.y = pk2(a[2], a[3]); w.z = pk2(b[0], b[1]); w.w = pk2(b[2], b[3]); *(u32x4*)(pb + (size_t)i * 8) = w; } }
    { bf16_t* xn = (bf16_t*)(ws + WS_R0); const int lane = tid & 63, gw = bx * 8 + (tid >> 6);
      f32x4 wv[8];
#pragma unroll
      for (int i = 0; i < 8; ++i) wv[i] = *(const f32x4*)(P.attn_norm + lane * 4 + i * 256);
      for (int row = gw * 2; row < MT; row += G * 16) { const float* xr = P.x + (size_t)row * DM; f32x4 v[2][8]; float s0 = 0.f, s1 = 0.f;
#pragma unroll
          for (int r = 0; r < 2; ++r)
#pragma unroll
              for (int i = 0; i < 8; ++i) v[r][i] = *(const f32x4*)(xr + (size_t)r * DM + lane * 4 + i * 256);
#pragma unroll
          for (int i = 0; i < 8; ++i) { s0 += (v[0][i][0] * v[0][i][0] + v[0][i][1] * v[0][i][1]) + (v[0][i][2] * v[0][i][2] + v[0][i][3] * v[0][i][3]);
              s1 += (v[1][i][0] * v[1][i][0] + v[1][i][1] * v[1][i][1]) + (v[1][i][2] * v[1][i][2] + v[1][i][3] * v[1][i][3]); }
#pragma unroll
          for (int o = 1; o < 64; o <<= 1) { s0 += __shfl_xor(s0, o); s1 += __shfl_xor(s1, o); }
          const float r0 = rsqrtf(s0 * (1.f / 2048.f) + 1e-6f), r1 = rsqrtf(s1 * (1.f / 2048.f) + 1e-6f);
#pragma unroll
          for (int r = 0; r < 2; ++r)
#pragma unroll
              for (int i = 0; i < 8; ++i) { const float rr = r ? r1 : r0; u32x2 w; w.x = pk2(v[r][i][0] * rr * wv[i][0], v[r][i][1] * rr * wv[i][1]); w.y = pk2(v[r][i][2] * rr * wv[i][2], v[r][i][3] * rr * wv[i][3]);
                  *(u32x2*)(xn + (size_t)(row + r) * DM + lane * 4 + i * 256) = w; } } }
    LAS float* tl = (LAS float*)lds;
    for (int gi = bx; gi < 896; gi += G) { const int nt = gi >> 3, kg = gi & 7, n0 = nt * 64; tconv_tile(P.w_in, INW, n0 < 4096 ? n0 : n0 + 16, kg * 256, (bf16_t*)(ws + WS_WIN), 2048, n0, nullptr, tl); }
}
DI void phase_wconv_late(const Params& P, LAS unsigned char* lds, int wg0, int nwg) {
    unsigned char* ws = P.ws; LAS float* tl = (LAS float*)lds;
    for (int gi = 896 + wg0; gi < 3552; gi += nwg) {
        if (gi < 1152) { const int t2 = gi - 896, nt = t2 >> 3, kg = t2 & 7; tconv_tile(P.w_o, 2048, nt * 64, kg * 256, (bf16_t*)(ws + WS_WO), 2048, nt * 64, nullptr, tl); }
        else if (gi < 2560) { const int t2 = gi - 1152, nt = t2 >> 3, kg = t2 & 7, n0 = nt * 64, pn = n0 >> 8, r = n0 & 255;
            tconv_tile(r < 128 ? P.w_gate : P.w_up, FF, pn * 128 + (r & 127), kg * 256, (bf16_t*)(ws + WS_WGU), 2048, n0, P.ffn_norm, tl); }
        else if (gi < 3264) { const int t2 = gi - 2560, nt = t2 / 22, kg = t2 % 22; tconv_tile(P.w_down, 2048, nt * 64, kg * 256, (bf16_t*)(ws + WS_WDN), FF, nt * 64, nullptr, tl); }
        else if (gi < 3520) { const int t2 = gi - 3264, nt = t2 >> 3, kg = t2 & 7; tconv_tile(P.w_pg, 2048, nt * 64, kg * 256, (bf16_t*)(ws + WS_WPG), 2048, nt * 64, P.ple_norm, tl); }
        else { const int nt = gi - 3520; tconv_tile(P.w_pp, 2048, nt * 64, 0, (bf16_t*)(ws + WS_WPP), 256, nt * 64, nullptr, tl); }
    }
}

DI void phase_ba(const Params& P) {
    const int tid = opq_tid(), lane = tid & 63, fr = lane & 15, fq = lane >> 4, gw = blockIdx.x * 8 + (tid >> 6);
    const bf16_t* xn = (const bf16_t*)(P.ws + WS_R0); const bf16_t* wba = (const bf16_t*)(P.ws + WS_WBA); float* BA = (float*)(P.ws + WS_BA);
    for (int rt = gw; rt < MT / 16; rt += gridDim.x * 8) {
        f32x4 acc = {0.f, 0.f, 0.f, 0.f}; const bf16_t* ap = xn + (size_t)(rt * 16 + fr) * DM + 8 * fq; const bf16_t* bp = wba + fr * 2048 + 8 * fq;
#pragma unroll 16
        for (int ks = 0; ks < 64; ++ks) acc = mfma16(*(const bf16x8*)(ap + 32 * ks), *(const bf16x8*)(bp + 32 * ks), acc);
#pragma unroll
        for (int j = 0; j < 4; ++j) BA[(size_t)(rt * 16 + 4 * fq + j) * 16 + fr] = acc[j];
    }
}

constexpr int G1_QS = 0, G1_KS = 18432, G1_VT = 36864, G1_KT = 57344, G1_SM = 77824, G1_TEAM = 78848;
DI void phase_gdn_prep(const Params& P, LAS unsigned char* lds, int n_lo, int n_cnt, int wg0, int nwg) {
    const int tid0 = opq_tid(), team = tid0 >> 8;
    LAS unsigned char* L = lds + team * G1_TEAM;
    LAS bf16_t* QS = (LAS bf16_t*)(L + G1_QS); LAS bf16_t* KS = (LAS bf16_t*)(L + G1_KS); LAS bf16_t* VT = (LAS bf16_t*)(L + G1_VT); LAS bf16_t* KT = (LAS bf16_t*)(L + G1_KT);
    LAS float* AF = (LAS float*)(L + G1_QS); LAS bf16_t* TB = (LAS bf16_t*)(L + G1_KS); LAS float* SM = (LAS float*)(L + G1_SM);
    bf16_t* proj = (bf16_t*)(P.ws + WS_R1); const bf16_t* halo = (const bf16_t*)(P.ws + WS_HALO); const float* BA = (const float*)(P.ws + WS_BA);
    bf16_t* W2 = (bf16_t*)(P.ws + WS_W2); bf16_t* QKB = (bf16_t*)(P.ws + WS_QKB); float* GL = (float*)(P.ws + WS_GL);
    for (int pi = wg0; pi < n_cnt * 8; pi += nwg) {
        int tid = tid0; asm volatile("" : "+v"(tid));
        const int tt = tid & 255, tw = __builtin_amdgcn_readfirstlane((tid >> 6) & 3), lane = tid & 63, fr = lane & 15, fq = lane >> 4;
        const int cq = pi * 2 + team, h = cq & 7, b = (cq >> 3) & 1, n = n_lo + (cq >> 4), ci = ((b * 256 + n) << 3) + h, t0 = b * TT + n * 64;
        if (tw == 0) {
            const float bv = BA[(size_t)(t0 + lane) * 16 + h], av = BA[(size_t)(t0 + lane) * 16 + 8 + h];
            const float beta = sigm_f(bv); const float xx = av + P.dt_bias[h]; const float sp = xx > 20.f ? xx : log1pf(__expf(xx));
            const float gg = -__expf(P.A_log[h]) * sp; float gc = gg;
#pragma unroll
            for (int o = 1; o < 64; o <<= 1) { const float v = __shfl_up(gc, o); if (lane >= o) gc += v; }
            const float glast = __shfl(gc, 63);
            SM[lane] = gc; SM[64 + lane] = beta; SM[128 + lane] = __expf(gc); SM[192 + lane] = __expf(glast - gc);
            if (lane == 63) GL[(b * 8 + h) * 256 + n] = __expf(gc);
        }
        __syncthreads();
        { const int r = tt >> 2, cg0 = (tt & 3) * 32; const float beta_r = SM[64 + r], egc_r = SM[128 + r];
#pragma unroll 1
          for (int x = 0; x < 3; ++x) {
              float val[32]; const int colbase = x * 1024 + h * 128 + cg0;
              u32x4 rawa[4][4];
#pragma unroll
              for (int sg = 0; sg < 4; ++sg) { const int col = colbase + sg * 8;
#pragma unroll
                  for (int j = 0; j < 4; ++j) { const int rr = r - 3 + j; rawa[sg][j] = (u32x4){0u, 0u, 0u, 0u};
                      if (rr >= 0) rawa[sg][j] = *(const u32x4*)(proj + (size_t)(t0 + rr) * NPJ + col);
                      else if (n > 0) rawa[sg][j] = *(const u32x4*)(halo + ((size_t)(t0 >> 6) * 3 + (rr + 3)) * 3072 + col); } }
#pragma unroll
              for (int sg = 0; sg < 4; ++sg) { const int col = colbase + sg * 8;
#pragma unroll
                  for (int i = 0; i < 8; ++i) { const f32x4 w4 = *(const f32x4*)(P.conv_w + (size_t)(col + i) * 4); float a = 0.f;
#pragma unroll
                      for (int j = 0; j < 4; ++j) { const unsigned wd = rawa[sg][j][i >> 1]; const float xv = (i & 1) ? bfhi(wd) : bflo(wd); a += w4[j] * xv; }
                      val[sg * 8 + i] = silu_f(a); } }
              if (x < 2) { float ss = 0.f;
#pragma unroll
                  for (int i = 0; i < 32; ++i) ss += val[i] * val[i];
                  ss += __shfl_xor(ss, 1); ss += __shfl_xor(ss, 2);
                  const float sc = rsqrtf(ss + 1e-6f) * (x == 0 ? 0.08838834764831845f : 1.f);
#pragma unroll
                  for (int i = 0; i < 32; ++i) val[i] *= sc; }
              if (x < 2) { LAS bf16_t* dst = (x == 0 ? QS : KS) + r * 144 + cg0;
#pragma unroll
                  for (int i = 0; i < 4; ++i) { u32x4 w; w.x = pk2(val[8 * i], val[8 * i + 1]); w.y = pk2(val[8 * i + 2], val[8 * i + 3]); w.z = pk2(val[8 * i + 4], val[8 * i + 5]); w.w = pk2(val[8 * i + 6], val[8 * i + 7]);
                      *(LAS u32x4*)(dst + 8 * i) = w; } }
              if (x == 1) { const float f = beta_r * egc_r;
#pragma unroll
                  for (int i = 0; i < 32; ++i) KT[(cg0 + i) * 80 + r] = f2bf(val[i] * f); }
              if (x == 2) {
#pragma unroll
                  for (int i = 0; i < 32; ++i) VT[(cg0 + i) * 80 + r] = f2bf(val[i] * beta_r); }
          } }
        __syncthreads();
        f32x4 kk[4], qk[4];
#pragma unroll
        for (int nt = 0; nt < 4; ++nt) { kk[nt] = (f32x4){0.f, 0.f, 0.f, 0.f}; qk[nt] = (f32x4){0.f, 0.f, 0.f, 0.f}; }
#pragma unroll
        for (int ks = 0; ks < 4; ++ks) { const bf16x8 ak = *(const LAS bf16x8*)(KS + (16 * tw + fr) * 144 + 32 * ks + 8 * fq), aq = *(const LAS bf16x8*)(QS + (16 * tw + fr) * 144 + 32 * ks + 8 * fq);
#pragma unroll
            for (int nt = 0; nt < 4; ++nt) { const bf16x8 bk = *(const LAS bf16x8*)(KS + (16 * nt + fr) * 144 + 32 * ks + 8 * fq); kk[nt] = mfma16(ak, bk, kk[nt]); qk[nt] = mfma16(aq, bk, qk[nt]); } }
        { const int r = tt >> 2, cg0 = (tt & 3) * 32; const float e = SM[128 + r];
#pragma unroll
          for (int i = 0; i < 4; ++i) { const u32x4 s = *(const LAS u32x4*)(QS + r * 144 + cg0 + 8 * i); u32x4 w;
              w.x = pk2(bflo(s.x) * e, bfhi(s.x) * e); w.y = pk2(bflo(s.y) * e, bfhi(s.y) * e); w.z = pk2(bflo(s.z) * e, bfhi(s.z) * e); w.w = pk2(bflo(s.w) * e, bfhi(s.w) * e);
              *(u32x4*)(proj + (size_t)(t0 + r) * NPJ + OFF_GQ + h * 128 + cg0 + 8 * i) = w; } }
        { const int d = tt >> 1, cb = (tt & 1) * 32;
#pragma unroll
          for (int i4 = 0; i4 < 4; ++i4) { const int c0 = cb + 8 * i4; float f[8];
#pragma unroll
              for (int i = 0; i < 8; ++i) f[i] = bf2f(KS[(c0 + i) * 144 + d]) * SM[192 + c0 + i];
              u32x4 w; w.x = pk2(f[0], f[1]); w.y = pk2(f[2], f[3]); w.z = pk2(f[4], f[5]); w.w = pk2(f[6], f[7]);
              *(u32x4*)(proj + (size_t)(t0 + (d >> 1)) * NPJ + OFF_GK + h * 128 + (d & 1) * 64 + c0) = w; } }
        __syncthreads();
#pragma unroll
        for (int nt = 0; nt < 4; ++nt)
#pragma unroll
            for (int j = 0; j < 4; ++j) { const int c = 16 * tw + 4 * fq + j, s = 16 * nt + fr; const float dec = (s <= c) ? __expf(SM[c] - SM[s]) : 0.f;
                AF[c * 65 + s] = (s < c) ? SM[64 + c] * kk[nt][j] * dec : (s == c ? 1.f : 0.f);
                QKB[(size_t)ci * 4096 + c * 64 + s] = f2bf(qk[nt][j] * dec); }
        __syncthreads();
        { const int bb = tw * 16;
          if (lane < 16) {
              for (int i = 1; i < 16; ++i) { float a0 = 0.f, a1 = 0.f; int j = 0;
                  for (; j + 2 <= i; j += 2) { a0 += AF[(bb + i) * 65 + bb + j] * AF[(bb + j) * 65 + bb + lane]; a1 += AF[(bb + i) * 65 + bb + j + 1] * AF[(bb + j + 1) * 65 + bb + lane]; }
                  if (j < i) a0 += AF[(bb + i) * 65 + bb + j] * AF[(bb + j) * 65 + bb + lane];
                  AF[(bb + i) * 65 + bb + lane] = lane < i ? -(a0 + a1) : (lane == i ? 1.f : 0.f); } }
#pragma unroll
          for (int k = 0; k < 4; ++k) { const int row = bb + fq + 4 * k; TB[row * 80 + bb + fr] = f2bf(AF[row * 65 + bb + fr]);
              for (int jb = tw + 1; jb < 4; ++jb) TB[row * 80 + 16 * jb + fr] = (bf16_t)0; }
          __syncthreads();
          for (int i = 1; i < 4; ++i) {
              if (tw < i) { const int j = tw; f32x4 X = {0.f, 0.f, 0.f, 0.f};
                  for (int k = j; k < i; ++k) {
#pragma unroll
                      for (int kk = 0; kk < 4; ++kk) { const float av = AF[(16 * i + fr) * 65 + 16 * k + 4 * kk + fq];
                          const float bv = (k == j) ? AF[(16 * k + 4 * kk + fq) * 65 + 16 * j + fr] : bf2f(TB[(16 * k + 4 * kk + fq) * 80 + 16 * j + fr]);
                          X = __builtin_amdgcn_mfma_f32_16x16x4f32(av, bv, X, 0, 0, 0); } }
                  f32x4 O = {0.f, 0.f, 0.f, 0.f};
#pragma unroll
                  for (int kk = 0; kk < 4; ++kk) O = __builtin_amdgcn_mfma_f32_16x16x4f32(AF[(16 * i + fr) * 65 + 16 * i + 4 * fq + kk], X[kk], O, 0, 0, 0);
#pragma unroll
                  for (int jj = 0; jj < 4; ++jj) TB[(16 * i + 4 * fq + jj) * 80 + 16 * j + fr] = f2bf(-O[jj]); }
              __syncthreads(); }
        }
        { bf16x8 at[2];
#pragma unroll
          for (int ks = 0; ks < 2; ++ks) at[ks] = *(const LAS bf16x8*)(TB + (16 * tw + fr) * 80 + 32 * ks + 8 * fq);
#pragma unroll
          for (int nt = 0; nt < 8; ++nt) { f32x4 a = {0.f, 0.f, 0.f, 0.f};
#pragma unroll
              for (int ks = 0; ks < 2; ++ks) a = mfma16(at[ks], *(const LAS bf16x8*)(VT + (16 * nt + fr) * 80 + 32 * ks + 8 * fq), a);
              const int e = 16 * nt + fr; u32x2 w; w.x = pk2(a[0], a[1]); w.y = pk2(a[2], a[3]);
              *(u32x2*)(proj + (size_t)(t0 + (e >> 1)) * NPJ + OFF_GV + h * 128 + (e & 1) * 64 + 16 * tw + 4 * fq) = w; }
#pragma unroll
          for (int mt = 0; mt < 8; ++mt) { f32x4 a = {0.f, 0.f, 0.f, 0.f};
#pragma unroll
              for (int ks = 0; ks < 2; ++ks) a = mfma16(*(const LAS bf16x8*)(KT + (16 * mt + fr) * 80 + 32 * ks + 8 * fq), at[ks], a);
              u32x2 w; w.x = pk2(a[0], a[1]); w.y = pk2(a[2], a[3]);
              *(u32x2*)(W2 + (size_t)(t0 + 16 * tw + fr) * 1024 + h * 128 + 16 * mt + 4 * fq) = w; } }
        __syncthreads();
    }
}

DI void phase_moba_prep(const Params& P, LAS unsigned char* lds, int wg0, int nwg) {
    const int tid = opq_tid(), lane = tid & 63, wave = tid >> 6, l16 = lane & 15;
    bf16_t* proj = (bf16_t*)(P.ws + WS_R1); float* kmean = (float*)(P.ws + WS_KMEAN);
    LAS bf16_t* VS = (LAS bf16_t*)lds; LAS float* CS = (LAS float*)(lds + 69632);
    for (int task = wg0; task < 1024; task += nwg) {
        const int h = task & 7, blk = (task >> 3) & 63, b = task >> 9; const size_t rbase = (size_t)(b * TT + blk * 256);
        f32x4 qg0 = *(const f32x4*)(P.q_norm + l16 * 8), qg1 = *(const f32x4*)(P.q_norm + l16 * 8 + 4), kg0 = *(const f32x4*)(P.k_norm + l16 * 8), kg1 = *(const f32x4*)(P.k_norm + l16 * 8 + 4);
        float cs[8];
#pragma unroll
        for (int i = 0; i < 8; ++i) cs[i] = 0.f;
        u32x4 rq[8], rk[8], rv[8];
#pragma unroll
        for (int ps = 0; ps < 8; ++ps) { const int r = ps * 32 + wave * 4 + (lane >> 4); const bf16_t* rp = proj + (rbase + r) * NPJ + h * 128 + l16 * 8;
            rq[ps] = *(const u32x4*)(rp + OFF_MQ); rk[ps] = *(const u32x4*)(rp + OFF_MK); rv[ps] = *(const u32x4*)(rp + OFF_MV); }
#pragma unroll
        for (int ps = 0; ps < 8; ++ps) { const int r = ps * 32 + wave * 4 + (lane >> 4); bf16_t* rp = proj + (rbase + r) * NPJ + h * 128 + l16 * 8;
#pragma unroll
            for (int x = 0; x < 2; ++x) { bf16_t* ptr = rp + (x == 0 ? OFF_MQ : OFF_MK); const u32x4 raw = x == 0 ? rq[ps] : rk[ps]; float v[8];
                v[0] = bflo(raw.x); v[1] = bfhi(raw.x); v[2] = bflo(raw.y); v[3] = bfhi(raw.y); v[4] = bflo(raw.z); v[5] = bfhi(raw.z); v[6] = bflo(raw.w); v[7] = bfhi(raw.w);
                float ss = 0.f;
#pragma unroll
                for (int i = 0; i < 8; ++i) ss += v[i] * v[i];
                ss = row16_sum(ss);
                const float rs = rsqrtf(ss * (1.f / 128.f) + 1e-6f); const f32x4 g0 = x == 0 ? qg0 : kg0, g1 = x == 0 ? qg1 : kg1;
#pragma unroll
                for (int i = 0; i < 4; ++i) { v[i] *= rs * g0[i]; v[4 + i] *= rs * g1[i]; }
                if (x == 1) {
#pragma unroll
                    for (int i = 0; i < 8; ++i) cs[i] += v[i]; }
                u32x4 w; w.x = pk2(v[0], v[1]); w.y = pk2(v[2], v[3]); w.z = pk2(v[4], v[5]); w.w = pk2(v[6], v[7]); *(u32x4*)ptr = w; }
            *(LAS u32x4*)(VS + r * 136 + l16 * 8) = rv[ps]; }
#pragma unroll
        for (int i = 0; i < 8; ++i) { cs[i] += __shfl_xor(cs[i], 16); cs[i] += __shfl_xor(cs[i], 32); }
        if (lane < 16) {
#pragma unroll
            for (int i = 0; i < 8; ++i) CS[wave * 128 + lane * 8 + i] = cs[i]; }
        __syncthreads();
        if (tid < 128) { float s = 0.f;
#pragma unroll
            for (int w = 0; w < 8; ++w) s += CS[w * 128 + tid];
            kmean[((size_t)(b * 8 + h) * 64 + blk) * 128 + tid] = s * (1.f / 256.f); }
#pragma unroll 2
        for (int i8 = 0; i8 < 8; ++i8) { const int pid = tid + i8 * 512, e = (pid & 63) + 64 * (pid >> 11), ks = (pid >> 6) & 31; unsigned short f[8];
#pragma unroll
            for (int i = 0; i < 8; ++i) f[i] = VS[(ks * 8 + i) * 136 + e];
            u32x4 w; w.x = f[0] | ((unsigned)f[1] << 16); w.y = f[2] | ((unsigned)f[3] << 16); w.z = f[4] | ((unsigned)f[5] << 16); w.w = f[6] | ((unsigned)f[7] << 16);
            *(u32x4*)(proj + (rbase + 2 * e + (ks >> 4)) * NPJ + OFF_MV + h * 128 + (ks & 15) * 8) = w; }
        __syncthreads();
    }
}

DI void phase_moba_select(const Params& P, LAS unsigned char* lds, int wg0, int nwg) {
    const int tid = opq_tid(), qi = tid >> 1, half = tid & 1;
    const bf16_t* proj = (const bf16_t*)(P.ws + WS_R1); const float* kmean = (const float*)(P.ws + WS_KMEAN);
    int* cnt = (int*)(P.ws + WS_CNT); int* list = (int*)(P.ws + WS_LIST); f32x2* ML = (f32x2*)(P.ws + WS_ML);
    LAS float* KM = (LAS float*)lds; LAS int* hist = (LAS int*)(lds + 32768); LAS int* hbase = (LAS int*)(lds + 32768 + 256);
    for (int task = wg0; task < 1024; task += nwg) {
        const int tk = task >> 8, tw_ = task & 255, bhx = (tw_ >> 6) * 4 + tk, blk = (tk & 1) ? 63 - (tw_ & 63) : (tw_ & 63), h = bhx & 7, b = bhx >> 3; const int bh = b * 8 + h; const int t = blk * 256 + qi; const size_t rid = (size_t)bh * TT + t;
        for (int i = tid; i < blk * 128; i += NTHREADS) KM[i] = kmean[(size_t)bh * 64 * 128 + i];
        if (tid < 64) hist[tid] = 0;
        float q[64];
        { const bf16_t* qp = proj + (size_t)(b * TT + t) * NPJ + OFF_MQ + h * 128 + half * 64;
#pragma unroll
          for (int i = 0; i < 8; ++i) { const u32x4 raw = *(const u32x4*)(qp + 8 * i); q[8 * i] = bflo(raw.x); q[8 * i + 1] = bfhi(raw.x); q[8 * i + 2] = bflo(raw.y); q[8 * i + 3] = bfhi(raw.y);
              q[8 * i + 4] = bflo(raw.z); q[8 * i + 5] = bfhi(raw.z); q[8 * i + 6] = bflo(raw.w); q[8 * i + 7] = bfhi(raw.w); } }
        __syncthreads();
        float v0 = -INFINITY, v1 = -INFINITY, v2 = -INFINITY; int i0 = -1, i1 = -1, i2 = -1;
        for (int n = 0; n < blk; ++n) { const LAS float* km = KM + n * 128 + half * 64; float d0 = 0.f, d1 = 0.f, d2 = 0.f, d3 = 0.f;
#pragma unroll
            for (int i = 0; i < 16; ++i) { const f32x4 kv = *(const LAS f32x4*)(km + 4 * i); d0 += q[4 * i] * kv[0]; d1 += q[4 * i + 1] * kv[1]; d2 += q[4 * i + 2] * kv[2]; d3 += q[4 * i + 3] * kv[3]; }
            float g = (d0 + d1) + (d2 + d3); g += __shfl_xor(g, 1);
            if (g > v0) { v2 = v1; i2 = i1; v1 = v0; i1 = i0; v0 = g; i0 = n; } else if (g > v1) { v2 = v1; i2 = i1; v1 = g; i1 = n; } else if (g > v2) { v2 = g; i2 = n; } }
        int rk0 = 0, rk1 = 0, rk2 = 0;
        if (half == 0) { if (i0 >= 0) rk0 = __hip_atomic_fetch_add(&hist[i0], 1, __ATOMIC_RELAXED, __HIP_MEMORY_SCOPE_WORKGROUP); if (i1 >= 0) rk1 = __hip_atomic_fetch_add(&hist[i1], 1, __ATOMIC_RELAXED, __HIP_MEMORY_SCOPE_WORKGROUP); if (i2 >= 0) rk2 = __hip_atomic_fetch_add(&hist[i2], 1, __ATOMIC_RELAXED, __HIP_MEMORY_SCOPE_WORKGROUP); }
        __syncthreads();
        if (tid < 64) { const int c = hist[tid]; hbase[tid] = c > 0 ? atomicAdd(&cnt[bh * 64 + tid], c) : 0; }
        __syncthreads();
        if (half == 0) {
            const f32x2 dead = {-INFINITY, 0.f};
            if (i0 >= 0) list[(size_t)bh * LISTN + i0 * 16384 - 128 * i0 * (i0 + 1) + hbase[i0] + rk0] = t; else ML[0 * 262144 + rid] = dead;
            if (i1 >= 0) list[(size_t)bh * LISTN + i1 * 16384 - 128 * i1 * (i1 + 1) + hbase[i1] + rk1] = t | (1 << 14); else ML[1 * 262144 + rid] = dead;
            if (i2 >= 0) list[(size_t)bh * LISTN + i2 * 16384 - 128 * i2 * (i2 + 1) + hbase[i2] + rk2] = t | (2 << 14); else ML[2 * 262144 + rid] = dead;
        }
        __syncthreads();
    }
}

constexpr int G2_W = 0, G2_Q = 18432, G2_QK = 36864, G2_KD = 47104, G2_BUF = 67584, G2_RED = 135168;
DI void phase_gdn_scan(const Params& P, LAS unsigned char* lds, int bh, const unsigned* flag, unsigned need) {
    const int tid = opq_tid(), lane = tid & 63, w = tid >> 6, fr = lane & 15, fq = lane >> 4, b = bh >> 3, h = bh & 7;
    const bf16_t* proj = (const bf16_t*)(P.ws + WS_R1); const bf16_t* W2 = (const bf16_t*)(P.ws + WS_W2); const bf16_t* QKB = (const bf16_t*)(P.ws + WS_QKB);
    const float* GL = (const float*)(P.ws + WS_GL); bf16_t* mix = (bf16_t*)(P.ws + WS_R2);
    float* SSQ = (float*)(P.ws + WS_SSQ);
    const int e = 16 * w + fr; const float gnw = P.gdn_norm[e];
    f32x4 S[8];
#pragma unroll
    for (int i = 0; i < 8; ++i) S[i] = (f32x4){0.f, 0.f, 0.f, 0.f};
    const int wrow0 = tid >> 4, wseg = tid & 15;
    const int qrow = tid >> 3, qseg = tid & 7;
    struct Stage { u32x4 sw[2], sq[2], sqk, skd[2]; };
    u32x2 un[4];
    Stage stA, stB;
#define G2_LOAD(X, nn) do { const int t0_ = b * TT + (nn) * 64; const int ci_ = ((b * 256 + (nn)) << 3) + h; \
        _Pragma("unroll") for (int i_ = 0; i_ < 2; ++i_) { X.sw[i_] = *(const u32x4*)(W2 + (size_t)(t0_ + wrow0 + 32 * i_) * 1024 + h * 128 + wseg * 8); \
            X.sq[i_] = *(const u32x4*)(proj + (size_t)(t0_ + wrow0 + 32 * i_) * NPJ + OFF_GQ + h * 128 + wseg * 8); \
            const int d_ = qrow + 64 * i_; X.skd[i_] = *(const u32x4*)(proj + (size_t)(t0_ + (d_ >> 1)) * NPJ + OFF_GK + h * 128 + (d_ & 1) * 64 + qseg * 8); } \
        X.sqk = *(const u32x4*)(QKB + (size_t)ci_ * 4096 + qrow * 64 + qseg * 8); } while (0)
#define UN_LOAD(nn) do { const int t0_ = b * TT + (nn) * 64; _Pragma("unroll") for (int mt_ = 0; mt_ < 4; ++mt_) un[mt_] = *(const u32x2*)(proj + (size_t)(t0_ + (e >> 1)) * NPJ + OFF_GV + h * 128 + (e & 1) * 64 + 16 * mt_ + 4 * fq); } while (0)
#define G2_ST2(base_, rowoff_, sg_, v_) do { const int g_ = ((sg_) >> 2) * 64, d_ = ((sg_) & 3) * 8; \
        *(LAS u32x2*)(B_ + (base_) + (rowoff_) + g_ + perm4(d_) * 2) = (u32x2){(v_).x, (v_).y}; *(LAS u32x2*)(B_ + (base_) + (rowoff_) + g_ + perm4(d_ + 4) * 2) = (u32x2){(v_).z, (v_).w}; } while (0)
#define G2_STORE(X, bufi) do { LAS unsigned char* B_ = lds + (bufi) * G2_BUF; \
        _Pragma("unroll") for (int i_ = 0; i_ < 2; ++i_) { G2_ST2(G2_W, (wrow0 + 32 * i_) * 288, wseg, X.sw[i_]); G2_ST2(G2_Q, (wrow0 + 32 * i_) * 288, wseg, X.sq[i_]); \
            G2_ST2(G2_KD, (qrow + 64 * i_) * 160, qseg, X.skd[i_]); } \
        G2_ST2(G2_QK, qrow * 160, qseg, X.sqk); } while (0)
    G2_LOAD(stA, 0); G2_STORE(stA, 0); UN_LOAD(0);
    float egl_n = GL[bh * 256];
    u32x2 uc[4];
#pragma unroll
    for (int i = 0; i < 4; ++i) uc[i] = un[i];
    G2_LOAD(stA, 1);
    __syncthreads();
    for (int n2 = 0; n2 < 256; n2 += 2) {
#pragma unroll
      for (int hf2 = 0; hf2 < 2; ++hf2) {
        const int n = n2 + hf2; Stage& LDs = hf2 ? stA : stB; Stage& STs = hf2 ? stB : stA;
        if (n == 126) {
            if (tid == 0) { while (__hip_atomic_load(flag, __ATOMIC_RELAXED, __HIP_MEMORY_SCOPE_AGENT) < need) __builtin_amdgcn_s_sleep(8);
                __builtin_amdgcn_fence(__ATOMIC_ACQUIRE, "agent"); asm volatile("s_waitcnt vmcnt(0)" ::: "memory"); }
            __syncthreads(); }
        const int cur = hf2, t0 = b * TT + n * 64; LAS unsigned char* Bf = lds + cur * G2_BUF;
        { const int n2c = n + 2 < 256 ? n + 2 : 255, n1c = n + 1 < 256 ? n + 1 : 255; G2_LOAD(LDs, n2c); UN_LOAD(n1c); }
        const float egl = egl_n; egl_n = GL[bh * 256 + (n + 1 < 256 ? n + 1 : 255)];
        f32x4 Pm[4], Om[4];
#pragma unroll
        for (int mt = 0; mt < 4; ++mt) { Pm[mt] = (f32x4){0.f, 0.f, 0.f, 0.f}; Om[mt] = (f32x4){0.f, 0.f, 0.f, 0.f}; }
#define SBAR __builtin_amdgcn_sched_barrier(0)
#define LD_K4(dst, base_, ks_) do { const int o0_ = fr * 288 + (32 * (ks_) + 8 * fq) * 2; \
        dst[0] = *(const LAS bf16x8*)(Bf + base_ + o0_); dst[1] = *(const LAS bf16x8*)(Bf + base_ + o0_ + 4608); \
        dst[2] = *(const LAS bf16x8*)(Bf + base_ + o0_ + 9216); dst[3] = *(const LAS bf16x8*)(Bf + base_ + o0_ + 13824); } while (0)
#define MM_K4(src, sb_, A_) do { A_[0] = mfma16(src[0], sb_, A_[0]); A_[1] = mfma16(src[1], sb_, A_[1]); A_[2] = mfma16(src[2], sb_, A_[2]); A_[3] = mfma16(src[3], sb_, A_[3]); } while (0)
#define LD_R4(dst, base_, r0_, k2_) do { const int o0_ = (16 * (r0_) + fr) * 160 + (32 * (k2_) + 8 * fq) * 2; \
        dst[0] = *(const LAS bf16x8*)(Bf + base_ + o0_); dst[1] = *(const LAS bf16x8*)(Bf + base_ + o0_ + 2560); \
        dst[2] = *(const LAS bf16x8*)(Bf + base_ + o0_ + 5120); dst[3] = *(const LAS bf16x8*)(Bf + base_ + o0_ + 7680); } while (0)
#define MM_R4(src, vb_, A0_, A1_, A2_, A3_) do { A0_ = mfma16(src[0], vb_, A0_); A1_ = mfma16(src[1], vb_, A1_); A2_ = mfma16(src[2], vb_, A2_); A3_ = mfma16(src[3], vb_, A3_); } while (0)
        bf16x8 fa[4], fb[4];
        LD_K4(fa, G2_W, 0);
        const bf16x8 sb0 = pack8(S[0], S[1]), sb1 = pack8(S[2], S[3]), sb2 = pack8(S[4], S[5]), sb3 = pack8(S[6], S[7]);
        LD_K4(fb, G2_W, 1); SBAR; MM_K4(fa, sb0, Pm); SBAR;
        LD_K4(fa, G2_W, 2); SBAR; MM_K4(fb, sb1, Pm); SBAR;
        LD_K4(fb, G2_W, 3); SBAR; MM_K4(fa, sb2, Pm); SBAR;
        LD_K4(fa, G2_Q, 0); SBAR; MM_K4(fb, sb3, Pm); SBAR;
        f32x4 vn[4];
#pragma unroll
        for (int mt = 0; mt < 4; ++mt) { vn[mt][0] = bflo(uc[mt].x) - Pm[mt][0]; vn[mt][1] = bfhi(uc[mt].x) - Pm[mt][1]; vn[mt][2] = bflo(uc[mt].y) - Pm[mt][2]; vn[mt][3] = bfhi(uc[mt].y) - Pm[mt][3]; }
        bf16x8 Vb[2];
#pragma unroll
        for (int k2 = 0; k2 < 2; ++k2) Vb[k2] = pack8(vn[2 * k2], vn[2 * k2 + 1]);
        LD_K4(fb, G2_Q, 1); SBAR; MM_K4(fa, sb0, Om); SBAR;
        LD_K4(fa, G2_Q, 2); SBAR; MM_K4(fb, sb1, Om); SBAR;
        LD_K4(fb, G2_Q, 3); SBAR; MM_K4(fa, sb2, Om); SBAR;
        LD_R4(fa, G2_QK, 0, 0); SBAR; MM_K4(fb, sb3, Om); SBAR;
#pragma unroll
        for (int dt = 0; dt < 8; ++dt) S[dt] = S[dt] * egl;
        SBAR;
        LD_R4(fb, G2_QK, 0, 1); SBAR; MM_R4(fa, Vb[0], Om[0], Om[1], Om[2], Om[3]); SBAR;
        LD_R4(fa, G2_KD, 0, 0); SBAR; MM_R4(fb, Vb[1], Om[0], Om[1], Om[2], Om[3]); SBAR;
        LD_R4(fb, G2_KD, 0, 1); SBAR; MM_R4(fa, Vb[0], S[0], S[1], S[2], S[3]); SBAR;
        LD_R4(fa, G2_KD, 4, 0); SBAR; MM_R4(fb, Vb[1], S[0], S[1], S[2], S[3]); SBAR;
        LD_R4(fb, G2_KD, 4, 1); SBAR; MM_R4(fa, Vb[0], S[4], S[5], S[6], S[7]); SBAR;
        MM_R4(fb, Vb[1], S[4], S[5], S[6], S[7]); SBAR;
#undef LD_K4
#undef MM_K4
#undef LD_R4
#undef MM_R4
#undef SBAR
        { G2_STORE(STs, cur ^ 1);
#pragma unroll
            for (int i = 0; i < 4; ++i) uc[i] = un[i]; }
        { LAS bf16_t* OTW = (LAS bf16_t*)(lds + G2_RED + w * 2048);
#pragma unroll
          for (int mt = 0; mt < 4; ++mt)
#pragma unroll
            for (int j = 0; j < 4; ++j) OTW[(16 * mt + 4 * fq + j) * 16 + fr] = f2bf(Om[mt][j]);
#pragma unroll
          for (int i = 0; i < 2; ++i) { const int row = (lane >> 1) + 32 * i, hv = lane & 1;
              bf16_t* mp_ = mix + (size_t)(t0 + row) * DM + h * 128 + 16 * w + 8 * hv; const u32x4 ov_ = *(const LAS u32x4*)(OTW + row * 16 + hv * 8);
              asm volatile("global_store_dwordx4 %0, %1, off" :: "v"(mp_), "v"(ov_) : "memory"); } }
        __syncthreads();
      }
    }
#undef G2_LOAD
#undef UN_LOAD
#undef G2_STORE
#undef G2_ST2
    asm volatile("s_waitcnt vmcnt(0)" ::: "memory");
    __syncthreads();
}

constexpr int AT_KS = 0, AT_VT = 73728, AT_PF = 143360, AT_MISC = 147712;
DI void phase_moba_attn(const Params& P, LAS unsigned char* lds) {
    const int tid = opq_tid(), lane = tid & 63, w = tid >> 6, fr = lane & 15, fq = lane >> 4;
    const bf16_t* proj = (const bf16_t*)(P.ws + WS_R1); const int* cnt = (const int*)(P.ws + WS_CNT); const int* list = (const int*)(P.ws + WS_LIST);
    f32x2* ML = (f32x2*)(P.ws + WS_ML); bf16_t* opart = (bf16_t*)P.out; unsigned* workctr = (unsigned*)(P.ws + WS_CTL);
    LAS bf16_t* KS = (LAS bf16_t*)(lds + AT_KS); LAS bf16_t* VT = (LAS bf16_t*)(lds + AT_VT); LAS int* PF = (LAS int*)(lds + AT_PF); LAS int* MISC = (LAS int*)(lds + AT_MISC);
    { const int c0 = cnt[2 * tid], c1 = cnt[2 * tid + 1]; const int a = (c0 + 511) >> 9, bsum = a + ((c1 + 511) >> 9); int inc = bsum;
#pragma unroll
      for (int o = 1; o < 64; o <<= 1) { const int v = __shfl_up(inc, o); if (lane >= o) inc += v; }
      if (lane == 63) MISC[8 + w] = inc;
      __syncthreads();
      int wb = 0;
#pragma unroll
      for (int i = 0; i < 8; ++i) wb += (i < w) ? MISC[8 + i] : 0;
      const int ex = wb + inc - bsum; PF[2 * tid] = ex; PF[2 * tid + 1] = ex + a; if (tid == 511) PF[1024] = ex + bsum;
      __syncthreads(); }
    const int totalG = PF[1024];
    const float sc2 = 0.08838834764831845f * 1.4426950408889634f;
    const int tid_at = tid;
    for (;;) {
        int tid = tid_at; asm volatile("" : "+v"(tid)); const int lane = tid & 63, w = __builtin_amdgcn_readfirstlane(tid >> 6), fr = lane & 15, fq = lane >> 4;
        if (tid == 0) MISC[0] = (int)atomicAdd(workctr, 1u);
        __syncthreads();
        const int wid = MISC[0];
        __syncthreads();
        if (wid >= totalG + 1024) break;
        int bh, j, causal, qstart, qcount;
        if (wid < totalG) { int lo = 0, hi = 1024; while (hi - lo > 1) { const int mid = (lo + hi) >> 1; if (PF[mid] <= wid) lo = mid; else hi = mid; }
            bh = lo >> 6; j = lo & 63; causal = 0; qstart = (wid - PF[lo]) * 512; const int c = cnt[lo]; qcount = c - qstart; if (qcount > 512) qcount = 512; }
        else { const int o = wid - totalG; bh = o >> 6; j = o & 63; causal = 1; qstart = 0; qcount = 256; }
        const int b = bh >> 3, h = bh & 7; const size_t kbase = (size_t)(b * TT + j * 256);
        { u32x4 kr[8], vr[8];
#pragma unroll
          for (int i8 = 0; i8 < 8; ++i8) { const int pid = tid + i8 * 512; kr[i8] = *(const u32x4*)(proj + (kbase + (pid >> 4)) * NPJ + OFF_MK + h * 128 + (pid & 15) * 8);
              const int e = pid >> 5, ks = pid & 31; vr[i8] = *(const u32x4*)(proj + (kbase + 2 * e + (ks >> 4)) * NPJ + OFF_MV + h * 128 + (ks & 15) * 8); }
#pragma unroll
          for (int i8 = 0; i8 < 8; ++i8) { const int pid = tid + i8 * 512; *(LAS u32x4*)(KS + (pid >> 4) * 144 + (pid & 15) * 8) = kr[i8];
              const int e = pid >> 5, ks = pid & 31; const int g_ = (ks >> 2) * 32, d_ = (ks & 3) * 8;
              *(LAS u32x2*)(VT + e * 272 + g_ + perm4(d_)) = (u32x2){vr[i8].x, vr[i8].y}; *(LAS u32x2*)(VT + e * 272 + g_ + perm4(d_ + 4)) = (u32x2){vr[i8].z, vr[i8].w}; } }
        const int lbase = bh * LISTN + j * 16384 - 128 * j * (j + 1) + qstart;
        const int ntile = (qcount + 127) >> 7;
        int en0, en1, en2, en3;
        { const int q0 = 16 * w + fr, lim = qcount - 1;
          if (causal) { en0 = (j * 256 + q0) | (3 << 14); en1 = (j * 256 + q0 + 128) | (3 << 14); en2 = en1; en3 = en1; }
          else { en0 = list[lbase + (q0 < lim ? q0 : lim)]; en1 = list[lbase + (q0 + 128 < lim ? q0 + 128 : lim)]; en2 = list[lbase + (q0 + 256 < lim ? q0 + 256 : lim)]; en3 = list[lbase + (q0 + 384 < lim ? q0 + 384 : lim)]; } }
        bf16x8 Bq[4], Bn[4];
        { const bf16_t* qp = proj + (size_t)(b * TT + (en0 & 16383)) * NPJ + OFF_MQ + h * 128 + 8 * fq;
#pragma unroll
          for (int ks = 0; ks < 4; ++ks) Bq[ks] = *(const bf16x8*)(qp + 32 * ks); }
        __syncthreads();
        for (int tile = 0; tile < ntile; ++tile) {
            const int en = tile == 0 ? en0 : (tile == 1 ? en1 : (tile == 2 ? en2 : en3));
            { const int enx = tile == 0 ? en1 : (tile == 1 ? en2 : en3); const bf16_t* qp = proj + (size_t)(b * TT + (enx & 16383)) * NPJ + OFF_MQ + h * 128 + 8 * fq;
#pragma unroll
              for (int ks = 0; ks < 4; ++ks) Bn[ks] = *(const bf16x8*)(qp + 32 * ks); }
            const int qi = tile * 128 + 16 * w + fr; const bool valid = qi < qcount; const int t = en & 16383, slot = en >> 14;
            if (tile * 128 + 16 * w < qcount) {
            const int nkt = causal ? (8 * tile + w + 1) : 16;
            f32x4 st[16]; float mx = -INFINITY;
#pragma unroll
            for (int kp = 0; kp < 8; ++kp) { f32x4 a0 = {0.f, 0.f, 0.f, 0.f}, a1 = {0.f, 0.f, 0.f, 0.f};
                if (2 * kp < nkt) { bf16x8 kf[8];
#pragma unroll
                    for (int ks = 0; ks < 4; ++ks) { kf[ks] = *(const LAS bf16x8*)(KS + (32 * kp + fr) * 144 + 32 * ks + 8 * fq); kf[4 + ks] = *(const LAS bf16x8*)(KS + (32 * kp + 16 + fr) * 144 + 32 * ks + 8 * fq); }
#pragma unroll
                    for (int ks = 0; ks < 4; ++ks) { a0 = mfma16(kf[ks], Bq[ks], a0); a1 = mfma16(kf[4 + ks], Bq[ks], a1); }
#pragma unroll
                    for (int jj = 0; jj < 4; ++jj) { float s0 = a0[jj] * sc2, s1 = a1[jj] * sc2;
                        if (causal && (32 * kp + 4 * fq + jj) > qi) s0 = -INFINITY; if ((causal && (32 * kp + 16 + 4 * fq + jj) > qi) || 2 * kp + 1 >= nkt) s1 = -INFINITY;
                        a0[jj] = s0; a1[jj] = s1; mx = fmaxf(mx, fmaxf(s0, s1)); }
                } else { a0 = (f32x4){-INFINITY, -INFINITY, -INFINITY, -INFINITY}; a1 = a0; }
                st[2 * kp] = a0; st[2 * kp + 1] = a1; }
            mx = fmaxf(mx, __shfl_xor(mx, 16)); mx = fmaxf(mx, __shfl_xor(mx, 32));
            float ls = 0.f;
#pragma unroll
            for (int kt = 0; kt < 16; ++kt)
#pragma unroll
                for (int jj = 0; jj < 4; ++jj) { const float pv = exp2f(st[kt][jj] - mx); st[kt][jj] = pv; ls += pv; }
            ls += __shfl_xor(ls, 16); ls += __shfl_xor(ls, 32);
            f32x4 ot[8];
#pragma unroll
            for (int et = 0; et < 8; ++et) ot[et] = (f32x4){0.f, 0.f, 0.f, 0.f};
#pragma unroll
            for (int k2 = 0; k2 < 8; ++k2) { if (2 * k2 < nkt) { const bf16x8 pb = pack8(st[2 * k2], st[2 * k2 + 1]);
#pragma unroll
                    for (int eh = 0; eh < 2; ++eh) { bf16x8 vf[4];
#pragma unroll
                        for (int et = 0; et < 4; ++et) vf[et] = *(const LAS bf16x8*)(VT + (16 * (4 * eh + et) + fr) * 272 + 32 * k2 + 8 * fq);
#pragma unroll
                        for (int et = 0; et < 4; ++et) ot[4 * eh + et] = mfma16(vf[et], pb, ot[4 * eh + et]); } } }
            if (valid) { const float il = 1.f / ls; const size_t rid = (size_t)bh * TT + t; bf16_t* op = opart + ((size_t)slot * 262144 + rid) * 128 + 4 * fq;
#pragma unroll
                for (int et = 0; et < 8; ++et) { u32x2 wv; wv.x = pk2(ot[et][0] * il, ot[et][1] * il); wv.y = pk2(ot[et][2] * il, ot[et][3] * il); *(u32x2*)(op + 16 * et) = wv; }
                if (fq == 0) ML[(size_t)slot * 262144 + rid] = (f32x2){mx, ls}; }
            }
#pragma unroll
            for (int ks = 0; ks < 4; ++ks) Bq[ks] = Bn[ks];
        }
        __syncthreads();
    }
}

DI void phase_moba_combine(const Params& P, bool do_gate, bool do_moba, int wg0, int nwg) {
    const bf16_t* opart = (const bf16_t*)P.out; const f32x2* ML = (const f32x2*)(P.ws + WS_ML); bf16_t* mix = (bf16_t*)(P.ws + WS_R2);
    const int gtid = wg0 * NTHREADS + opq_tid(), gsz = nwg * NTHREADS;
    if (do_gate) { const bf16_t* proj = (const bf16_t*)(P.ws + WS_R1);
      for (int i0 = gtid; i0 < MT * 128; i0 += 4 * gsz) { u32x4 mv[4], zv[4];
#pragma unroll
          for (int k = 0; k < 4; ++k) { const int i = i0 + k * gsz < MT * 128 ? i0 + k * gsz : i0; const int row = i >> 7, sg = i & 127; mv[k] = *(const u32x4*)(mix + (size_t)row * DM + sg * 8); zv[k] = *(const u32x4*)(proj + (size_t)row * NPJ + OFF_GZ + sg * 8); }
          const int sg0 = i0 & 127; const f32x4 g0 = *(const f32x4*)(P.gdn_norm + (sg0 & 15) * 8), g1 = *(const f32x4*)(P.gdn_norm + (sg0 & 15) * 8 + 4);
#pragma unroll
          for (int k = 0; k < 4; ++k) { const int i = i0 + k * gsz; const int row = i >> 7, sg = i & 127;
              float o[8]; o[0] = bflo(mv[k].x); o[1] = bfhi(mv[k].x); o[2] = bflo(mv[k].y); o[3] = bfhi(mv[k].y); o[4] = bflo(mv[k].z); o[5] = bfhi(mv[k].z); o[6] = bflo(mv[k].w); o[7] = bfhi(mv[k].w);
              float ssl = 0.f;
#pragma unroll
              for (int q = 0; q < 8; ++q) ssl += o[q] * o[q];
              const float rs = rsqrtf(row16_sum(ssl) * (1.f / 128.f) + 1e-6f); const u32x4 z = zv[k];
              u32x4 wv; wv.x = pk2(o[0] * rs * g0[0] * silu_f(bflo(z.x)), o[1] * rs * g0[1] * silu_f(bfhi(z.x))); wv.y = pk2(o[2] * rs * g0[2] * silu_f(bflo(z.y)), o[3] * rs * g0[3] * silu_f(bfhi(z.y)));
              wv.z = pk2(o[4] * rs * g1[0] * silu_f(bflo(z.z)), o[5] * rs * g1[1] * silu_f(bfhi(z.z))); wv.w = pk2(o[6] * rs * g1[2] * silu_f(bflo(z.w)), o[7] * rs * g1[3] * silu_f(bfhi(z.w)));
              if (i < MT * 128) *(u32x4*)(mix + (size_t)row * DM + sg * 8) = wv; } } }
    if (do_moba) for (int i0 = gtid; i0 < 262144 * 16; i0 += 2 * gsz) {
        f32x2 ml[2][4]; u32x4 raw[2][4];
#pragma unroll
        for (int k = 0; k < 2; ++k) { const int i = i0 + k * gsz < 262144 * 16 ? i0 + k * gsz : i0; const int rid = i >> 4, sg = i & 15;
#pragma unroll
            for (int s = 0; s < 4; ++s) { ml[k][s] = ML[(size_t)s * 262144 + rid]; raw[k][s] = *(const u32x4*)(opart + ((size_t)s * 262144 + rid) * 128 + sg * 8); } }
#pragma unroll
        for (int k = 0; k < 2; ++k) { const int i = i0 + k * gsz; const int rid = i >> 4, sg = i & 15; const int bh = rid >> 14, t = rid & 16383, b = bh >> 3, h = bh & 7;
            float M = -INFINITY;
#pragma unroll
            for (int s = 0; s < 4; ++s) M = fmaxf(M, ml[k][s].x);
            float wgt[4], Lt = 0.f;
#pragma unroll
            for (int s = 0; s < 4; ++s) { wgt[s] = ml[k][s].y > 0.f ? ml[k][s].y * exp2f(ml[k][s].x - M) : 0.f; Lt += wgt[s]; }
            const float iL = 1.f / Lt; float o[8];
#pragma unroll
            for (int q = 0; q < 8; ++q) o[q] = 0.f;
#pragma unroll
            for (int s = 0; s < 4; ++s) { const float ww = wgt[s] * iL; const u32x4 r = raw[k][s];
                if (wgt[s] > 0.f) { o[0] += ww * bflo(r.x); o[1] += ww * bfhi(r.x); o[2] += ww * bflo(r.y); o[3] += ww * bfhi(r.y); o[4] += ww * bflo(r.z); o[5] += ww * bfhi(r.z); o[6] += ww * bflo(r.w); o[7] += ww * bfhi(r.w); } }
            u32x4 wv; wv.x = pk2(o[0], o[1]); wv.y = pk2(o[2], o[3]); wv.z = pk2(o[4], o[5]); wv.w = pk2(o[6], o[7]);
            if (i < 262144 * 16) *(u32x4*)(mix + (size_t)(b * TT + t) * DM + 1024 + h * 128 + sg * 8) = wv; } }
}

DI void sub_barrier(unsigned* ctr, unsigned nwg) {
    asm volatile("s_waitcnt vmcnt(0)" ::: "memory");
    __syncthreads();
    if (threadIdx.x == 0) {
        __builtin_amdgcn_fence(__ATOMIC_RELEASE, "agent");
        __hip_atomic_fetch_add(ctr, 1u, __ATOMIC_RELAXED, __HIP_MEMORY_SCOPE_AGENT);
        while (__hip_atomic_load(ctr, __ATOMIC_RELAXED, __HIP_MEMORY_SCOPE_AGENT) < nwg) __builtin_amdgcn_s_sleep(8);
        __builtin_amdgcn_fence(__ATOMIC_ACQUIRE, "agent");
        asm volatile("s_waitcnt vmcnt(0)" ::: "memory");
    }
    __syncthreads();
}

__global__ void __launch_bounds__(NTHREADS) hybrid_fwd(Params P) {
    extern __shared__ __attribute__((aligned(16))) unsigned char smem[];
    LAS unsigned char* lds = (LAS unsigned char*)smem;
    cg::grid_group grid = cg::this_grid();
    unsigned char* ws = P.ws; const int G = gridDim.x, bx = blockIdx.x;
    bf16_t* R0 = (bf16_t*)(ws + WS_R0); bf16_t* R1 = (bf16_t*)(ws + WS_R1); bf16_t* R2 = (bf16_t*)(ws + WS_R2);
    float* ss1 = (float*)(ws + WS_SS1); float* ss2 = (float*)(ws + WS_SS2);

    phase_prep(P, lds);
    grid.sync();
    { pg8::Gemm g{R0, (const bf16_t*)(ws + WS_WIN), MT, NPJ, DM}; pg8::StaticOrder S; S.init(MT, NPJ, G, bx); EpiProj E{R1, (bf16_t*)(ws + WS_HALO)}; pg8::gemm_phase<decltype(E), pg8::StaticOrder, true, true>(lds, g, S, E); }
    phase_ba(P);
    grid.sync();
    phase_gdn_prep(P, lds, 0, 128, bx, G);
    grid.sync();
    if (bx < 16) phase_gdn_scan(P, lds, bx, (const unsigned*)(ws + WS_CTL) + 11, (unsigned)(G - 16));
    else { unsigned* ctl = (unsigned*)(ws + WS_CTL);
        phase_gdn_prep(P, lds, 128, 128, bx - 16, G - 16);
        asm volatile("s_waitcnt vmcnt(0)" ::: "memory"); __syncthreads();
        if (threadIdx.x == 0) { __builtin_amdgcn_fence(__ATOMIC_RELEASE, "agent"); __hip_atomic_fetch_add(ctl + 11, 1u, __ATOMIC_RELAXED, __HIP_MEMORY_SCOPE_AGENT); }
        phase_moba_prep(P, lds, bx - 16, G - 16); sub_barrier(ctl + 8, (unsigned)(G - 16));
        phase_moba_select(P, lds, bx - 16, G - 16); sub_barrier(ctl + 9, (unsigned)(G - 16));
        phase_moba_attn(P, lds);
        phase_wconv_late(P, lds, bx - 16, G - 16);
        sub_barrier(ctl + 10, (unsigned)(G - 16)); phase_moba_combine(P, false, true, bx - 16, G - 16); }
    grid.sync();
    phase_moba_combine(P, true, false, bx, G);
    grid.sync();
    { pg8::Gemm g{R2, (const bf16_t*)(ws + WS_WO), MT, DM, DM}; pg8::StaticOrder S; S.init(MT, DM, G, bx); EpiResid E{P.x, P.out, R0, ss1}; pg8::gemm_phase<decltype(E), pg8::StaticOrder, true, false>(lds, g, S, E); }
    grid.sync();
    { pg8::Gemm g{R0, (const bf16_t*)(ws + WS_WGU), MT, 2 * FF, DM}; pg8::StaticOrder S; S.init(MT, 2 * FF, G, bx); EpiAct E{R1, ss1}; pg8::gemm_phase<decltype(E), pg8::StaticOrder, true, true>(lds, g, S, E); }
    grid.sync();
    { pg8::Gemm g{(const bf16_t*)(ws + WS_PB), (const bf16_t*)(ws + WS_WPP), MT, DM, 256}; pg8::StaticOrder S; S.init(MT, DM, G, bx); EpiPlainBf16 E{R0, DM}; pg8::gemm_phase<decltype(E), pg8::StaticOrder, true, false>(lds, g, S, E); }
    { pg8::Gemm g{R1, (const bf16_t*)(ws + WS_WDN), MT, DM, FF}; pg8::StaticOrder S; S.init(MT, DM, G, bx); EpiResid E{P.out, P.out, R2, ss2}; pg8::gemm_phase<decltype(E), pg8::StaticOrder, true, false>(lds, g, S, E); }
    grid.sync();
    { pg8::Gemm g{R2, (const bf16_t*)(ws + WS_WPG), MT, DM, DM}; pg8::StaticOrder S; S.init(MT, DM, G, bx); EpiOut E{P.out, R0, ss2}; pg8::gemm_phase<decltype(E), pg8::StaticOrder, true, false>(lds, g, S, E); }
}

extern "C" void kernel_launch(void* const* d_in, const int* in_sizes, int n_in, void* d_out, int out_size, void* d_ws, size_t ws_size, hipStream_t stream) {
    static int grid_blocks = 0;
    if (!grid_blocks) {
        int dev = 0, cus = 0, per_cu = 0;
        hipGetDevice(&dev);
        hipDeviceGetAttribute(&cus, hipDeviceAttributeMultiprocessorCount, dev);
        hipFuncSetAttribute((const void*)hybrid_fwd, hipFuncAttributeMaxDynamicSharedMemorySize, LDS_BYTES);
        hipOccupancyMaxActiveBlocksPerMultiprocessor(&per_cu, (const void*)hybrid_fwd, NTHREADS, LDS_BYTES);
        if (per_cu < 1) per_cu = 1;
        grid_blocks = cus * per_cu;
        if (ws_size < WS_END) fprintf(stderr, "kernel_launch: workspace too small: %zu < %zu\n", ws_size, (size_t)WS_END);
    }
    Params p{};
    p.x = (const float*)d_in[0]; p.p = (const float*)d_in[1]; p.attn_norm = (const float*)d_in[2]; p.w_in = (const float*)d_in[3]; p.conv_w = (const float*)d_in[4];
    p.A_log = (const float*)d_in[5]; p.dt_bias = (const float*)d_in[6]; p.gdn_norm = (const float*)d_in[7]; p.q_norm = (const float*)d_in[8]; p.k_norm = (const float*)d_in[9];
    p.w_o = (const float*)d_in[10]; p.ffn_norm = (const float*)d_in[11]; p.w_gate = (const float*)d_in[12]; p.w_up = (const float*)d_in[13]; p.w_down = (const float*)d_in[14];
    p.ple_norm = (const float*)d_in[15]; p.w_pg = (const float*)d_in[16]; p.w_pp = (const float*)d_in[17];
    p.out = (float*)d_out; p.ws = (unsigned char*)d_ws;
    void* args[] = {&p};
    hipError_t e = hipLaunchCooperativeKernel((const void*)hybrid_fwd, dim3(grid_blocks), dim3(NTHREADS), args, LDS_BYTES, stream);
    if (e != hipSuccess) fprintf(stderr, "cooperative launch failed: %s (grid %d)\n", hipGetErrorString(e), grid_blocks);
}
```

```cpp
#include <hip/hip_runtime.h>
#include <hip/hip_cooperative_groups.h>
#include <cstdio>
namespace cg = cooperative_groups;

#define LAS __attribute__((address_space(3)))
#define DI __device__ __forceinline__
typedef unsigned short bf16_t;
typedef short bf16x8 __attribute__((ext_vector_type(8)));
typedef float f32x4 __attribute__((ext_vector_type(4)));
typedef float f32x2 __attribute__((ext_vector_type(2)));
typedef unsigned u32x4 __attribute__((ext_vector_type(4)));
typedef unsigned u32x2 __attribute__((ext_vector_type(2)));
typedef __bf16 bfv2 __attribute__((ext_vector_type(2)));

constexpr int DM = 2048, TT = 16384, MT = 32768, NPJ = 7168, FF = 5632, INW = 7184;
constexpr int OFF_GQ = 0, OFF_GK = 1024, OFF_GV = 2048, OFF_GZ = 3072, OFF_MQ = 4096, OFF_MK = 5120, OFF_MV = 6144;
constexpr int LISTN = 516096;
constexpr int NTHREADS = 512;
constexpr int LDS_BYTES = 163840;

constexpr size_t WS_CTL   = 0;
constexpr size_t WS_CNT   = 4096;
constexpr size_t WS_SS1   = 8192;
constexpr size_t WS_SS2   = WS_SS1 + 131072;
constexpr size_t WS_GL    = WS_SS2 + 131072;
constexpr size_t WS_KMEAN = WS_GL + 16384;
constexpr size_t WS_WBA   = WS_KMEAN + 524288;
constexpr size_t WS_BA    = WS_WBA + 65536;
constexpr size_t WS_WIN   = WS_BA + 2097152;
constexpr size_t WS_WO    = WS_WIN + (size_t)7168 * 2048 * 2;
constexpr size_t WS_WGU   = WS_WO + (size_t)2048 * 2048 * 2;
constexpr size_t WS_WDN   = WS_WGU + (size_t)11264 * 2048 * 2;
constexpr size_t WS_WPG   = WS_WDN + (size_t)2048 * 5632 * 2;
constexpr size_t WS_WPP   = WS_WPG + (size_t)2048 * 2048 * 2;
constexpr size_t WS_PB    = WS_WPP + (size_t)2048 * 256 * 2;
constexpr size_t WS_R0    = WS_PB + (size_t)32768 * 256 * 2;
constexpr size_t WS_R1    = WS_R0 + (size_t)32768 * 2048 * 2;
constexpr size_t WS_R2    = WS_R1 + (size_t)32768 * 7168 * 2;
constexpr size_t WS_W2    = WS_R2 + (size_t)32768 * 2048 * 2;
constexpr size_t WS_QKB   = WS_W2 + (size_t)32768 * 1024 * 2;
constexpr size_t WS_HALO  = WS_QKB + (size_t)4096 * 4096 * 2;
constexpr size_t WS_LIST  = WS_HALO + (size_t)513 * 3 * 3072 * 2 + 256 - ((size_t)513 * 3 * 3072 * 2) % 256;
constexpr size_t WS_ML    = WS_LIST + (size_t)16 * LISTN * 4;
constexpr size_t WS_SSQ   = WS_ML + (size_t)4 * 262144 * 8;
constexpr size_t WS_END   = WS_SSQ + (size_t)32768 * 64 * 4;

struct Params {
    const float* x; const float* p; const float* attn_norm; const float* w_in; const float* conv_w; const float* A_log; const float* dt_bias;
    const float* gdn_norm; const float* q_norm; const float* k_norm; const float* w_o; const float* ffn_norm; const float* w_gate; const float* w_up;
    const float* w_down; const float* ple_norm; const float* w_pg; const float* w_pp;
    float* out; unsigned char* ws;
};

DI unsigned pk2(float a, float b) { f32x2 v = {a, b}; bfv2 r = __builtin_convertvector(v, bfv2); return __builtin_bit_cast(unsigned, r); }
DI bf16_t f2bf(float a) { return (bf16_t)(pk2(a, 0.f) & 0xffffu); }
DI float bflo(unsigned w) { return __uint_as_float(w << 16); }
DI float bfhi(unsigned w) { return __uint_as_float(w & 0xffff0000u); }
DI float bf2f(bf16_t v) { return __uint_as_float(((unsigned)v) << 16); }
DI bf16x8 pack8(const f32x4& a, const f32x4& b) { u32x4 w; w.x = pk2(a[0], a[1]); w.y = pk2(a[2], a[3]); w.z = pk2(b[0], b[1]); w.w = pk2(b[2], b[3]); return __builtin_bit_cast(bf16x8, w); }
DI bf16x8 cat8(u32x2 lo, u32x2 hi) { u32x4 w; w.x = lo.x; w.y = lo.y; w.z = hi.x; w.w = hi.y; return __builtin_bit_cast(bf16x8, w); }
DI f32x4 mfma16(bf16x8 a, bf16x8 b, f32x4 c) { return __builtin_amdgcn_mfma_f32_16x16x32_bf16(a, b, c, 0, 0, 0); }
DI int perm4(int d4) { return d4 < 16 ? 2 * d4 : 2 * (d4 - 16) + 4; }
DI float dpp_f(float v, int ctrl_sel) { int x = __float_as_int(v); int r;
    if (ctrl_sel == 0) r = __builtin_amdgcn_mov_dpp(x, 0xB1, 0xf, 0xf, true); else if (ctrl_sel == 1) r = __builtin_amdgcn_mov_dpp(x, 0x4E, 0xf, 0xf, true);
    else if (ctrl_sel == 2) r = __builtin_amdgcn_mov_dpp(x, 0x141, 0xf, 0xf, true); else r = __builtin_amdgcn_mov_dpp(x, 0x140, 0xf, 0xf, true);
    return __int_as_float(r); }
DI float row16_sum(float v) { v += dpp_f(v, 0); v += dpp_f(v, 1); v += dpp_f(v, 2); v += dpp_f(v, 3); return v; }
DI float silu_f(float v) { return v * __builtin_amdgcn_rcpf(1.f + __expf(-v)); }
DI float sigm_f(float v) { return __builtin_amdgcn_rcpf(1.f + __expf(-v)); }

DI int opq_tid() { int t = threadIdx.x; asm volatile("" : "+v"(t)); return t; }

namespace pg8 {
constexpr int BM = 256, BK = 64, HALF = 128, HTB = HALF * BK * 2, STAGE_BYTES = 8 * HTB, NXCD = 8, WGM = 8;
DI int lds_byte(int r, int c) { const int st = (r >> 4) * 2 + (c >> 5), rr = r & 15, cc = c & 31, ob = rr * 64 + cc * 2; return st * 1024 + (ob ^ (((ob >> 9) & 1) << 5)); }
DI void stage_rc(int b, int& R, int& C) { const int st = b / 1024, sb = b % 1024, swz = sb ^ (((sb >> 9) & 1) << 5); R = (st >> 1) * 16 + swz / 64; C = (st & 1) * 32 + (swz % 64) / 2; }
DI int perm32(int rho) { const int n = rho >> 4, i = rho & 15; return 8 * (i >> 2) + 4 * n + (i & 3); }
struct Unit { int pm, pn; };
struct Gemm { const bf16_t* A; const bf16_t* Bt; int M, N, K; };
struct StaticOrder {
    int nM, nN, nwg, G, c;
    DI void init(int M, int N, int G_, int c_) { nM = M / BM; nN = N / BM; nwg = nM * nN; G = G_; c = c_; }
    DI bool next(int i, Unit& u) const {
        const long L = (long)i * G + c; if (L >= nwg) return false;
        int wgid = (int)L; { const int q = nwg / NXCD, r = nwg % NXCD, xcd = wgid % NXCD, off = wgid / NXCD; wgid = (xcd < r ? xcd * (q + 1) : r * (q + 1) + (xcd - r) * q) + off; }
        const int nig = WGM * nN, gid = wgid / nig, fm = gid * WGM, gsz = (nM - fm) < WGM ? (nM - fm) : WGM;
        u.pm = fm + ((wgid % nig) % gsz); u.pn = (wgid % nig) / gsz; return true;
    }
    DI void a_ready(const Unit&) const {}
    DI void done(const Unit&) const {}
};

template <class Epi, class Sched, bool ALIGN_EPI = false, bool SP2 = false>
DI void gemm_phase(LAS unsigned char* lds, const Gemm g, const Sched& S, const Epi& E) {
    const int tid = opq_tid(), wid = __builtin_amdgcn_readfirstlane(tid >> 6), lane = tid & 63, wr = wid >> 2, wc = wid & 3, fr = lane & 15, fq = lane >> 4;
    const int K = g.K, nt = K / BK;
    unsigned voffA[2], voffB[2];
#pragma unroll
    for (int i = 0; i < 2; ++i) { int R, C; stage_rc(tid * 16 + i * 8192, R, C); const int Rb = Epi::PERM ? ((R & ~31) + perm32(R & 31)) : R;
        voffA[i] = (unsigned)(R * K + C) * 2u; voffB[i] = (unsigned)(Rb * K + C) * 2u; }
    const size_t kstep = (size_t)(BK * 2);
    const size_t hstep = (size_t)HALF * K * 2;
    const size_t tstep = 2 * hstep;
    const unsigned ldsw = (unsigned)wid * 1024u;
    const int aoff = lds_byte(wr * 64 + fr, fq * 8), boff = lds_byte(wc * 32 + fr, fq * 8);
#define PG8_SA(b, h) (((b) * 2 + (h)) * HTB)
#define PG8_SB(b, h) ((4 + (b) * 2 + (h)) * HTB)
#define PG8_STAGE(bufoff, gbase, voff) do { _Pragma("unroll") for (int _i = 0; _i < 2; ++_i) \
        __builtin_amdgcn_global_load_lds((const unsigned*)((const char*)(gbase) + (voff)[_i]), (LAS unsigned*)(lds + (bufoff) + ldsw + _i * 8192), 16, 0, 0); } while (0)
#define PG8_LDA(dst, b, h) do { _Pragma("unroll") for (int m = 0; m < 4; ++m) _Pragma("unroll") for (int k = 0; k < 2; ++k) dst[m][k] = *(const LAS bf16x8*)(lds + PG8_SA(b, h) + aoff + m * 2048 + k * 1024); } while (0)
#define PG8_LDB(dst, b, h) do { _Pragma("unroll") for (int n = 0; n < 2; ++n) _Pragma("unroll") for (int k = 0; k < 2; ++k) dst[n][k] = *(const LAS bf16x8*)(lds + PG8_SB(b, h) + boff + n * 2048 + k * 1024); } while (0)
#define PG8_MMA(ai, bj, At, Bt) do { __builtin_amdgcn_s_setprio(1); _Pragma("unroll") for (int m = 0; m < 4; ++m) _Pragma("unroll") for (int n = 0; n < 2; ++n) _Pragma("unroll") for (int k = 0; k < 2; ++k) \
        acc[ai][bj][m][n] = __builtin_amdgcn_mfma_f32_16x16x32_bf16(Bt[n][k], At[m][k], acc[ai][bj][m][n], 0, 0, 0); __builtin_amdgcn_s_setprio(0); } while (0)
#define PG8_WAIT_V(n) asm volatile("s_waitcnt vmcnt(" #n ")" ::: "memory")
#define PG8_WAIT_L(n) asm volatile("s_waitcnt lgkmcnt(" #n ")" ::: "memory")
#define PG8_BAR __builtin_amdgcn_s_barrier()
#define PG8_SCHED __builtin_amdgcn_sched_barrier(0)
    Unit cur, nxt; int ui = 0;
    if (!S.next(0, cur)) return;
    f32x4 acc[2][2][4][2];
#pragma unroll
    for (int a = 0; a < 2; ++a)
#pragma unroll
        for (int b = 0; b < 2; ++b)
#pragma unroll
            for (int m = 0; m < 4; ++m)
#pragma unroll
                for (int n = 0; n < 2; ++n) acc[a][b][m][n] = (f32x4){0.f, 0.f, 0.f, 0.f};
    bf16x8 At[4][2], B0[2][2], B1[2][2];
    const char* cA = (const char*)g.A + (size_t)cur.pm * tstep; const char* cB = (const char*)g.Bt + (size_t)cur.pn * tstep;
    S.a_ready(cur);
    if constexpr (SP2) {
        PG8_STAGE(PG8_SB(0, 0), cB, voffB); PG8_STAGE(PG8_SB(0, 1), cB + hstep, voffB); PG8_STAGE(PG8_SA(0, 0), cA, voffA); PG8_STAGE(PG8_SA(0, 1), cA + hstep, voffA);
        if (wr == 1) PG8_BAR;
        PG8_WAIT_V(2); PG8_BAR;
        PG8_STAGE(PG8_SB(1, 0), cB + kstep, voffB); PG8_STAGE(PG8_SA(1, 0), cA + kstep, voffA); PG8_STAGE(PG8_SB(1, 1), cB + hstep + kstep, voffB);
        PG8_WAIT_V(6); PG8_BAR;
    } else {
        PG8_STAGE(PG8_SB(0, 0), cB, voffB); PG8_STAGE(PG8_SA(0, 0), cA, voffA); PG8_STAGE(PG8_SB(0, 1), cB + hstep, voffB); PG8_STAGE(PG8_SA(0, 1), cA + hstep, voffA);
        if (wr == 1) PG8_BAR;
        PG8_WAIT_V(4); PG8_BAR;
        PG8_STAGE(PG8_SB(1, 0), cB + kstep, voffB); PG8_STAGE(PG8_SA(1, 0), cA + kstep, voffA); PG8_STAGE(PG8_SB(1, 1), cB + hstep + kstep, voffB);
        PG8_WAIT_V(6); PG8_BAR;
    }
    for (;;) {
        const bool has_next = S.next(ui + 1, nxt);
        const char* nA = has_next ? (const char*)g.A + (size_t)nxt.pm * tstep : cA; const char* nB = has_next ? (const char*)g.Bt + (size_t)nxt.pn * tstep : cB;
        for (int t = 0; t < nt; t += 2) {
            const bool last = (t == nt - 2);
            const char* a1 = cA + (size_t)(t + 1) * kstep;
            const char* a2 = last ? nA : cA + (size_t)(t + 2) * kstep; const char* b2 = last ? nB : cB + (size_t)(t + 2) * kstep;
            const char* a3 = a2 + kstep; const char* b3 = b2 + kstep;
            if (last && has_next) S.a_ready(nxt);
            if constexpr (SP2) {
            PG8_LDB(B0, 0, 0); PG8_LDB(B1, 0, 1); PG8_SCHED; PG8_LDA(At, 0, 0); PG8_STAGE(PG8_SA(1, 1), a1 + hstep, voffA);
            PG8_WAIT_V(8); PG8_WAIT_L(0); PG8_BAR; PG8_MMA(0, 0, At, B0); PG8_MMA(0, 1, At, B1); PG8_BAR; PG8_SCHED;
            PG8_LDA(At, 0, 1); PG8_STAGE(PG8_SB(0, 0), b2, voffB); PG8_STAGE(PG8_SB(0, 1), b2 + hstep, voffB); PG8_STAGE(PG8_SA(0, 0), a2, voffA);
            PG8_WAIT_V(8); PG8_WAIT_L(0); PG8_BAR; PG8_MMA(1, 0, At, B0); PG8_MMA(1, 1, At, B1); PG8_BAR; PG8_SCHED;
            PG8_LDB(B0, 1, 0); PG8_LDB(B1, 1, 1); PG8_SCHED; PG8_LDA(At, 1, 0); PG8_STAGE(PG8_SA(0, 1), a2 + hstep, voffA);
            PG8_WAIT_V(8); PG8_WAIT_L(0); PG8_BAR; PG8_MMA(0, 0, At, B0); PG8_MMA(0, 1, At, B1); PG8_BAR; PG8_SCHED;
            PG8_LDA(At, 1, 1); PG8_STAGE(PG8_SB(1, 0), b3, voffB); PG8_STAGE(PG8_SB(1, 1), b3 + hstep, voffB); PG8_STAGE(PG8_SA(1, 0), a3, voffA);
            PG8_WAIT_V(8); PG8_WAIT_L(0); PG8_BAR; PG8_MMA(1, 0, At, B0); PG8_MMA(1, 1, At, B1); PG8_BAR; PG8_SCHED;
            } else {
            PG8_LDB(B0, 0, 0); PG8_SCHED; PG8_LDA(At, 0, 0); PG8_STAGE(PG8_SA(1, 1), a1 + hstep, voffA);
            PG8_WAIT_L(8); PG8_BAR; PG8_WAIT_L(0); PG8_MMA(0, 0, At, B0); PG8_BAR; PG8_SCHED;
            PG8_LDB(B1, 0, 1); PG8_STAGE(PG8_SB(0, 0), b2, voffB);
            PG8_BAR; PG8_WAIT_L(0); PG8_MMA(0, 1, At, B1); PG8_BAR;
            PG8_LDA(At, 0, 1); PG8_STAGE(PG8_SA(0, 0), a2, voffA);
            PG8_BAR; PG8_WAIT_L(0); PG8_MMA(1, 0, At, B0); PG8_BAR; PG8_SCHED;
            PG8_STAGE(PG8_SB(0, 1), b2 + hstep, voffB);
            PG8_WAIT_V(6); PG8_BAR; PG8_MMA(1, 1, At, B1); PG8_BAR;
            PG8_LDB(B0, 1, 0); PG8_SCHED; PG8_LDA(At, 1, 0); PG8_STAGE(PG8_SA(0, 1), a2 + hstep, voffA);
            PG8_WAIT_L(8); PG8_BAR; PG8_WAIT_L(0); PG8_MMA(0, 0, At, B0); PG8_BAR; PG8_SCHED;
            PG8_LDB(B1, 1, 1); PG8_STAGE(PG8_SB(1, 0), b3, voffB);
            PG8_BAR; PG8_WAIT_L(0); PG8_MMA(0, 1, At, B1); PG8_BAR;
            PG8_LDA(At, 1, 1); PG8_STAGE(PG8_SA(1, 0), a3, voffA);
            PG8_BAR; PG8_WAIT_L(0); PG8_MMA(1, 0, At, B0); PG8_BAR; PG8_SCHED;
            PG8_STAGE(PG8_SB(1, 1), b3 + hstep, voffB);
            PG8_WAIT_V(6); PG8_BAR; PG8_MMA(1, 1, At, B1); PG8_BAR;
            }
        }
        if constexpr (ALIGN_EPI) { if (wr == 0) PG8_BAR; }
        if constexpr (!Epi::AFTER_DRAIN) { E(acc, cur, wr, wc, fr, fq); S.done(cur); }
        if (!has_next) break;
#pragma unroll
        for (int a = 0; a < 2; ++a)
#pragma unroll
            for (int b = 0; b < 2; ++b)
#pragma unroll
                for (int m = 0; m < 4; ++m)
#pragma unroll
                    for (int n = 0; n < 2; ++n) acc[a][b][m][n] = (f32x4){0.f, 0.f, 0.f, 0.f};
        cur = nxt; cA = nA; cB = nB; ++ui;
        if constexpr (ALIGN_EPI) { if (wr == 1) PG8_BAR; }
    }
    PG8_WAIT_V(0);
    if constexpr (!ALIGN_EPI) { if (wr == 0) PG8_BAR; }
    PG8_BAR;
    if constexpr (Epi::AFTER_DRAIN) { E.fused(acc, cur, wr, wc, fr, fq, lds, wid, lane); S.done(cur); }
#undef PG8_SA
#undef PG8_SB
#undef PG8_STAGE
#undef PG8_LDA
#undef PG8_LDB
#undef PG8_MMA
#undef PG8_WAIT_V
#undef PG8_WAIT_L
#undef PG8_BAR
#undef PG8_SCHED
}
}
using pg8::Unit;

struct EpiProj {
    static constexpr bool PERM = true, AFTER_DRAIN = false;
    bf16_t* O; bf16_t* halo;
    DI void operator()(const f32x4 (&acc)[2][2][4][2], const Unit& u, int wr, int wc, int fr, int fq) const {
        const int row0 = u.pm * 256 + wr * 64 + fr, col0 = u.pn * 256 + wc * 32 + 8 * fq;
#pragma unroll
        for (int ai = 0; ai < 2; ++ai)
#pragma unroll
            for (int m = 0; m < 4; ++m) { const int row = row0 + ai * 128 + m * 16; bf16_t* rowp = O + (size_t)row * NPJ + col0;
#pragma unroll
                for (int bj = 0; bj < 2; ++bj) { const f32x4 v0 = acc[ai][bj][m][0], v1 = acc[ai][bj][m][1];
                    u32x4 w; w.x = pk2(v0[0], v0[1]); w.y = pk2(v0[2], v0[3]); w.z = pk2(v1[0], v1[1]); w.w = pk2(v1[2], v1[3]);
                    *(u32x4*)(rowp + bj * 128) = w;
                    if (m == 3 && fr >= 13 && u.pn < 12) *(u32x4*)(halo + ((size_t)((row >> 6) + 1) * 3 + (fr - 13)) * 3072 + col0 + bj * 128) = w; } }
    }
};
struct EpiPlainBf16 {
    static constexpr bool PERM = true, AFTER_DRAIN = false;
    bf16_t* O; int ldc;
    DI void operator()(const f32x4 (&acc)[2][2][4][2], const Unit& u, int wr, int wc, int fr, int fq) const {
        const int row0 = u.pm * 256 + wr * 64 + fr, col0 = u.pn * 256 + wc * 32 + 8 * fq;
#pragma unroll
        for (int ai = 0; ai < 2; ++ai)
#pragma unroll
            for (int m = 0; m < 4; ++m) { bf16_t* rowp = O + (size_t)(row0 + ai * 128 + m * 16) * ldc + col0;
#pragma unroll
                for (int bj = 0; bj < 2; ++bj) { const f32x4 v0 = acc[ai][bj][m][0], v1 = acc[ai][bj][m][1];
                    u32x4 w; w.x = pk2(v0[0], v0[1]); w.y = pk2(v0[2], v0[3]); w.z = pk2(v1[0], v1[1]); w.w = pk2(v1[2], v1[3]);
                    *(u32x4*)(rowp + bj * 128) = w; } }
    }
};
struct EpiResid {
    static constexpr bool PERM = false, AFTER_DRAIN = false;
    const float* base; float* out; bf16_t* hb; float* ss;
    DI void operator()(const f32x4 (&acc)[2][2][4][2], const Unit& u, int wr, int wc, int fr, int fq) const {
        const int row0 = u.pm * 256 + wr * 64 + fr, col0 = u.pn * 256 + wc * 32 + 4 * fq;
#pragma unroll
        for (int ai = 0; ai < 2; ++ai) { f32x4 bs[4][4];
#pragma unroll
            for (int m = 0; m < 4; ++m)
#pragma unroll
                for (int q = 0; q < 4; ++q) bs[m][q] = *(const f32x4*)(base + (size_t)(row0 + ai * 128 + m * 16) * DM + col0 + (q >> 1) * 128 + (q & 1) * 16);
#pragma unroll
            for (int m = 0; m < 4; ++m) { const int row = row0 + ai * 128 + m * 16; const size_t off = (size_t)row * DM + col0; float s = 0.f;
#pragma unroll
                for (int q = 0; q < 4; ++q) { const f32x4 hv = bs[m][q] + acc[ai][q >> 1][m][q & 1];
                        *(f32x4*)(out + off + (q >> 1) * 128 + (q & 1) * 16) = hv; u32x2 w; w.x = pk2(hv[0], hv[1]); w.y = pk2(hv[2], hv[3]);
                        *(u32x2*)(hb + off + (q >> 1) * 128 + (q & 1) * 16) = w; s += (hv[0] * hv[0] + hv[1] * hv[1]) + (hv[2] * hv[2] + hv[3] * hv[3]); }
                s += __shfl_xor(s, 16); s += __shfl_xor(s, 32);
                if (fq == 0) atomicAdd(ss + row, s); }
            asm volatile("" ::: "memory"); }
    }
};
struct EpiAct {
    static constexpr bool PERM = true, AFTER_DRAIN = false;
    bf16_t* O; const float* ss;
    DI void operator()(const f32x4 (&acc)[2][2][4][2], const Unit& u, int wr, int wc, int fr, int fq) const {
        const int row0 = u.pm * 256 + wr * 64 + fr, col0 = u.pn * 128 + wc * 32 + 8 * fq;
        float rs[8];
#pragma unroll
        for (int g = 0; g < 8; ++g) rs[g] = ss[row0 + (g >> 2) * 128 + (g & 3) * 16];
#pragma unroll
        for (int ai = 0; ai < 2; ++ai)
#pragma unroll
            for (int m = 0; m < 4; ++m) { const int row = row0 + ai * 128 + m * 16; const float r = rsqrtf(rs[ai * 4 + m] * (1.f / 2048.f) + 1e-6f);
                float a[8];
#pragma unroll
                for (int n = 0; n < 2; ++n)
#pragma unroll
                    for (int j = 0; j < 4; ++j) { const float gv = r * acc[ai][0][m][n][j], uv = r * acc[ai][1][m][n][j]; a[n * 4 + j] = silu_f(gv) * uv; }
                u32x4 w; w.x = pk2(a[0], a[1]); w.y = pk2(a[2], a[3]); w.z = pk2(a[4], a[5]); w.w = pk2(a[6], a[7]);
                *(u32x4*)(O + (size_t)row * FF + col0) = w; }
    }
};
struct EpiOut {
    static constexpr bool PERM = false, AFTER_DRAIN = false;
    float* out; const bf16_t* pp; const float* ss;
    DI void operator()(const f32x4 (&acc)[2][2][4][2], const Unit& u, int wr, int wc, int fr, int fq) const {
        const int row0 = u.pm * 256 + wr * 64 + fr, col0 = u.pn * 256 + wc * 32 + 4 * fq;
        float rs[8];
#pragma unroll
        for (int g = 0; g < 8; ++g) rs[g] = ss[row0 + (g >> 2) * 128 + (g & 3) * 16];
#pragma unroll
        for (int ai = 0; ai < 2; ++ai)
#pragma unroll
            for (int m = 0; m < 4; ++m) { const int row = row0 + ai * 128 + m * 16; const size_t off = (size_t)row * DM + col0; const float r = rsqrtf(rs[ai * 4 + m] * (1.f / 2048.f) + 1e-6f);
                f32x4 hv[4]; u32x2 pw[4];
#pragma unroll
                for (int q = 0; q < 4; ++q) { hv[q] = *(const f32x4*)(out + off + (q >> 1) * 128 + (q & 1) * 16); pw[q] = *(const u32x2*)(pp + off + (q >> 1) * 128 + (q & 1) * 16); }
#pragma unroll
                for (int q = 0; q < 4; ++q) { const f32x4 a = acc[ai][q >> 1][m][q & 1]; f32x4 o;
                        o[0] = hv[q][0] + sigm_f(r * a[0]) * bflo(pw[q].x); o[1] = hv[q][1] + sigm_f(r * a[1]) * bfhi(pw[q].x);
                        o[2] = hv[q][2] + sigm_f(r * a[2]) * bflo(pw[q].y); o[3] = hv[q][3] + sigm_f(r * a[3]) * bfhi(pw[q].y);
                        *(f32x4*)(out + off + (q >> 1) * 128 + (q & 1) * 16) = o; }
                asm volatile("" ::: "memory"); }
    }
};

DI void tconv_tile(const float* __restrict__ src, int ld, int c0, int k0, bf16_t* __restrict__ dst, int dK, int n0, const float* __restrict__ nw, LAS float* tl) {
    const int tid = opq_tid();
    f32x4 v[8];
#pragma unroll
    for (int i = 0; i < 8; ++i) v[i] = *(const f32x4*)(src + (size_t)(k0 + (tid >> 4) + 32 * i) * ld + c0 + (tid & 15) * 4);
#pragma unroll
    for (int i = 0; i < 8; ++i) { const int k = (tid >> 4) + 32 * i; const float sc = nw ? nw[k0 + k] : 1.f;
        LAS float* q = tl + k * 65 + (tid & 15) * 4; q[0] = v[i][0] * sc; q[1] = v[i][1] * sc; q[2] = v[i][2] * sc; q[3] = v[i][3] * sc; }
    __syncthreads();
    { const int n = tid >> 3, kq = (tid & 7) * 8;
#pragma unroll
      for (int j = 0; j < 4; ++j) { const int ks = kq + 64 * j; float f[8];
#pragma unroll
          for (int i = 0; i < 8; ++i) f[i] = tl[(ks + i) * 65 + n];
          u32x4 w; w.x = pk2(f[0], f[1]); w.y = pk2(f[2], f[3]); w.z = pk2(f[4], f[5]); w.w = pk2(f[6], f[7]);
          *(u32x4*)(dst + (size_t)(n0 + n) * dK + k0 + ks) = w; } }
    __syncthreads();
}

DI void phase_prep(const Params& P, LAS unsigned char* lds) {
    unsigned char* ws = P.ws; const int tid = opq_tid(), G = gridDim.x, bx = blockIdx.x;
    const int gtid = bx * NTHREADS + tid, gsz = G * NTHREADS;
    for (int i = gtid; i < (int)((WS_GL - WS_CTL) / 4); i += gsz) ((unsigned*)(ws + WS_CTL))[i] = 0u;
    { bf16_t* wba = (bf16_t*)(ws + WS_WBA); for (int i = gtid; i < 16 * 2048; i += gsz) { const int n = i >> 11, k = i & 2047; wba[i] = f2bf(P.w_in[(size_t)k * INW + 4096 + n]); } }
    { bf16_t* pb = (bf16_t*)(ws + WS_PB); for (int i = gtid; i < MT * 256 / 8; i += gsz) { const f32x4 a = *(const f32x4*)(P.p + (size_t)i * 8), b = *(const f32x4*)(P.p + (size_t)i * 8 + 4);
        u32x4 w; w.x = pk2(a[0], a[1]); w.y = pk2(a[2], a[3]); w.z = pk2(b[0], b[1]); w.w = pk2(b[2], b[3]); *(u32x4*)(pb + (size_t)i * 8) = w; } }
    { bf16_t* xn = (bf16_t*)(ws + WS_R0); const int lane = tid & 63, gw = bx * 8 + (tid >> 6);
      f32x4 wv[8];
#pragma unroll
      for (int i = 0; i < 8; ++i) wv[i] = *(const f32x4*)(P.attn_norm + lane * 4 + i * 256);
      for (int row = gw * 2; row < MT; row += G * 16) { const float* xr = P.x + (size_t)row * DM; f32x4 v[2][8]; float s0 = 0.f, s1 = 0.f;
#pragma unroll
          for (int r = 0; r < 2; ++r)
#pragma unroll
              for (int i = 0; i < 8; ++i) v[r][i] = *(const f32x4*)(xr + (size_t)r * DM + lane * 4 + i * 256);
#pragma unroll
          for (int i = 0; i < 8; ++i) { s0 += (v[0][i][0] * v[0][i][0] + v[0][i][1] * v[0][i][1]) + (v[0][i][2] * v[0][i][2] + v[0][i][3] * v[0][i][3]);
              s1 += (v[1][i][0] * v[1][i][0] + v[1][i][1] * v[1][i][1]) + (v[1][i][2] * v[1][i][2] + v[1][i][3] * v[1][i][3]); }
#pragma unroll
          for (int o = 1; o < 64; o <<= 1) { s0 += __shfl_xor(s0, o); s1 += __shfl_xor(s1, o); }
          const float r0 = rsqrtf(s0 * (1.f / 2048.f) + 1e-6f), r1 = rsqrtf(s1 * (1.f / 2048.f) + 1e-6f);
#pragma unroll
          for (int r = 0; r < 2; ++r)
#pragma unroll
              for (int i = 0; i < 8; ++i) { const float rr = r ? r1 : r0; u32x2 w; w.x = pk2(v[r][i][0] * rr * wv[i][0], v[r][i][1] * rr * wv[i][1]); w.y = pk2(v[r][i][2] * rr * wv[i][2], v[r][i][3] * rr * wv[i][3]);
                  *(u32x2*)(xn + (size_t)(row + r) * DM + lane * 4 + i * 256) = w; } } }
    LAS float* tl = (LAS float*)lds;
    for (int gi = bx; gi < 896; gi += G) { const int nt = gi >> 3, kg = gi & 7, n0 = nt * 64; tconv_tile(P.w_in, INW, n0 < 4096 ? n0 : n0 + 16, kg * 256, (bf16_t*)(ws + WS_WIN), 2048, n0, nullptr, tl); }
}
DI void phase_wconv_late(const Params& P, LAS unsigned char* lds, int wg0, int nwg) {
    unsigned char* ws = P.ws; LAS float* tl = (LAS float*)lds;
    for (int gi = 896 + wg0; gi < 3552; gi += nwg) {
        if (gi < 1152) { const int t2 = gi - 896, nt = t2 >> 3, kg = t2 & 7; tconv_tile(P.w_o, 2048, nt * 64, kg * 256, (bf16_t*)(ws + WS_WO), 2048, nt * 64, nullptr, tl); }
        else if (gi < 2560) { const int t2 = gi - 1152, nt = t2 >> 3, kg = t2 & 7, n0 = nt * 64, pn = n0 >> 8, r = n0 & 255;
            tconv_tile(r < 128 ? P.w_gate : P.w_up, FF, pn * 128 + (r & 127), kg * 256, (bf16_t*)(ws + WS_WGU), 2048, n0, P.ffn_norm, tl); }
        else if (gi < 3264) { const int t2 = gi - 2560, nt = t2 / 22, kg = t2 % 22; tconv_tile(P.w_down, 2048, nt * 64, kg * 256, (bf16_t*)(ws + WS_WDN), FF, nt * 64, nullptr, tl); }
        else if (gi < 3520) { const int t2 = gi - 3264, nt = t2 >> 3, kg = t2 & 7; tconv_tile(P.w_pg, 2048, nt * 64, kg * 256, (bf16_t*)(ws + WS_WPG), 2048, nt * 64, P.ple_norm, tl); }
        else { const int nt = gi - 3520; tconv_tile(P.w_pp, 2048, nt * 64, 0, (bf16_t*)(ws + WS_WPP), 256, nt * 64, nullptr, tl); }
    }
}

DI void phase_ba(const Params& P) {
    const int tid = opq_tid(), lane = tid & 63, fr = lane & 15, fq = lane >> 4, gw = blockIdx.x * 8 + (tid >> 6);
    const bf16_t* xn = (const bf16_t*)(P.ws + WS_R0); const bf16_t* wba = (const bf16_t*)(P.ws + WS_WBA); float* BA = (float*)(P.ws + WS_BA);
    for (int rt = gw; rt < MT / 16; rt += gridDim.x * 8) {
        f32x4 acc = {0.f, 0.f, 0.f, 0.f}; const bf16_t* ap = xn + (size_t)(rt * 16 + fr) * DM + 8 * fq; const bf16_t* bp = wba + fr * 2048 + 8 * fq;
#pragma unroll 16
        for (int ks = 0; ks < 64; ++ks) acc = mfma16(*(const bf16x8*)(ap + 32 * ks), *(const bf16x8*)(bp + 32 * ks), acc);
#pragma unroll
        for (int j = 0; j < 4; ++j) BA[(size_t)(rt * 16 + 4 * fq + j) * 16 + fr] = acc[j];
    }
}

constexpr int G1_QS = 0, G1_KS = 18432, G1_VT = 36864, G1_KT = 57344, G1_SM = 77824, G1_TEAM = 78848;
DI void phase_gdn_prep(const Params& P, LAS unsigned char* lds, int n_lo, int n_cnt, int wg0, int nwg, unsigned* early_flag = nullptr, int early_thr = 0) {
    const int tid0 = opq_tid(), team = tid0 >> 8;
    LAS unsigned char* L = lds + team * G1_TEAM;
    LAS bf16_t* QS = (LAS bf16_t*)(L + G1_QS); LAS bf16_t* KS = (LAS bf16_t*)(L + G1_KS); LAS bf16_t* VT = (LAS bf16_t*)(L + G1_VT); LAS bf16_t* KT = (LAS bf16_t*)(L + G1_KT);
    LAS float* AF = (LAS float*)(L + G1_QS); LAS bf16_t* TB = (LAS bf16_t*)(L + G1_KS); LAS float* SM = (LAS float*)(L + G1_SM);
    bf16_t* proj = (bf16_t*)(P.ws + WS_R1); const bf16_t* halo = (const bf16_t*)(P.ws + WS_HALO); const float* BA = (const float*)(P.ws + WS_BA);
    bf16_t* W2 = (bf16_t*)(P.ws + WS_W2); bf16_t* QKB = (bf16_t*)(P.ws + WS_QKB); float* GL = (float*)(P.ws + WS_GL);
    bool arrived = (early_flag == nullptr);
    for (int pi = wg0; pi < n_cnt * 8; pi += nwg) {
        int tid = tid0; asm volatile("" : "+v"(tid));
        const int tt = tid & 255, tw = __builtin_amdgcn_readfirstlane((tid >> 6) & 3), lane = tid & 63, fr = lane & 15, fq = lane >> 4;
        const int cq = pi * 2 + team, h = cq & 7, b = (cq >> 3) & 1, n = n_lo + (cq >> 4), ci = ((b * 256 + n) << 3) + h, t0 = b * TT + n * 64;
        if (tw == 0) {
            const float bv = BA[(size_t)(t0 + lane) * 16 + h], av = BA[(size_t)(t0 + lane) * 16 + 8 + h];
            const float beta = sigm_f(bv); const float xx = av + P.dt_bias[h]; const float sp = xx > 20.f ? xx : log1pf(__expf(xx));
            const float gg = -__expf(P.A_log[h]) * sp; float gc = gg;
#pragma unroll
            for (int o = 1; o < 64; o <<= 1) { const float v = __shfl_up(gc, o); if (lane >= o) gc += v; }
            const float glast = __shfl(gc, 63);
            SM[lane] = gc; SM[64 + lane] = beta; SM[128 + lane] = __expf(gc); SM[192 + lane] = __expf(glast - gc);
            if (lane == 63) GL[(b * 8 + h) * 256 + n] = __expf(gc);
        }
        __syncthreads();
        { const int r = tt >> 2, cg0 = (tt & 3) * 32; const float beta_r = SM[64 + r], egc_r = SM[128 + r];
#pragma unroll 1
          for (int x = 0; x < 3; ++x) {
              float val[32]; const int colbase = x * 1024 + h * 128 + cg0;
              u32x4 rawa[4][4];
#pragma unroll
              for (int sg = 0; sg < 4; ++sg) { const int col = colbase + sg * 8;
#pragma unroll
                  for (int j = 0; j < 4; ++j) { const int rr = r - 3 + j; rawa[sg][j] = (u32x4){0u, 0u, 0u, 0u};
                      if (rr >= 0) rawa[sg][j] = *(const u32x4*)(proj + (size_t)(t0 + rr) * NPJ + col);
                      else if (n > 0) rawa[sg][j] = *(const u32x4*)(halo + ((size_t)(t0 >> 6) * 3 + (rr + 3)) * 3072 + col); } }
#pragma unroll
              for (int sg = 0; sg < 4; ++sg) { const int col = colbase + sg * 8;
#pragma unroll
                  for (int i = 0; i < 8; ++i) { const f32x4 w4 = *(const f32x4*)(P.conv_w + (size_t)(col + i) * 4); float a = 0.f;
#pragma unroll
                      for (int j = 0; j < 4; ++j) { const unsigned wd = rawa[sg][j][i >> 1]; const float xv = (i & 1) ? bfhi(wd) : bflo(wd); a += w4[j] * xv; }
                      val[sg * 8 + i] = silu_f(a); } }
              if (x < 2) { float ss = 0.f;
#pragma unroll
                  for (int i = 0; i < 32; ++i) ss += val[i] * val[i];
                  ss += __shfl_xor(ss, 1); ss += __shfl_xor(ss, 2);
                  const float sc = rsqrtf(ss + 1e-6f) * (x == 0 ? 0.08838834764831845f : 1.f);
#pragma unroll
                  for (int i = 0; i < 32; ++i) val[i] *= sc; }
              if (x < 2) { LAS bf16_t* dst = (x == 0 ? QS : KS) + r * 144 + cg0;
#pragma unroll
                  for (int i = 0; i < 4; ++i) { u32x4 w; w.x = pk2(val[8 * i], val[8 * i + 1]); w.y = pk2(val[8 * i + 2], val[8 * i + 3]); w.z = pk2(val[8 * i + 4], val[8 * i + 5]); w.w = pk2(val[8 * i + 6], val[8 * i + 7]);
                      *(LAS u32x4*)(dst + 8 * i) = w; } }
              if (x == 1) { const float f = beta_r * egc_r;
#pragma unroll
                  for (int i = 0; i < 32; ++i) KT[(cg0 + i) * 80 + r] = f2bf(val[i] * f); }
              if (x == 2) {
#pragma unroll
                  for (int i = 0; i < 32; ++i) VT[(cg0 + i) * 80 + r] = f2bf(val[i] * beta_r); }
          } }
        __syncthreads();
        f32x4 kk[4], qk[4];
#pragma unroll
        for (int nt = 0; nt < 4; ++nt) { kk[nt] = (f32x4){0.f, 0.f, 0.f, 0.f}; qk[nt] = (f32x4){0.f, 0.f, 0.f, 0.f}; }
#pragma unroll
        for (int ks = 0; ks < 4; ++ks) { const bf16x8 ak = *(const LAS bf16x8*)(KS + (16 * tw + fr) * 144 + 32 * ks + 8 * fq), aq = *(const LAS bf16x8*)(QS + (16 * tw + fr) * 144 + 32 * ks + 8 * fq);
#pragma unroll
            for (int nt = 0; nt < 4; ++nt) { const bf16x8 bk = *(const LAS bf16x8*)(KS + (16 * nt + fr) * 144 + 32 * ks + 8 * fq); kk[nt] = mfma16(ak, bk, kk[nt]); qk[nt] = mfma16(aq, bk, qk[nt]); } }
        { const int r = tt >> 2, cg0 = (tt & 3) * 32; const float e = SM[128 + r];
#pragma unroll
          for (int i = 0; i < 4; ++i) { const u32x4 s = *(const LAS u32x4*)(QS + r * 144 + cg0 + 8 * i); u32x4 w;
              w.x = pk2(bflo(s.x) * e, bfhi(s.x) * e); w.y = pk2(bflo(s.y) * e, bfhi(s.y) * e); w.z = pk2(bflo(s.z) * e, bfhi(s.z) * e); w.w = pk2(bflo(s.w) * e, bfhi(s.w) * e);
              *(u32x4*)(proj + (size_t)(t0 + r) * NPJ + OFF_GQ + h * 128 + cg0 + 8 * i) = w; } }
        { const int d = tt >> 1, cb = (tt & 1) * 32;
#pragma unroll
          for (int i4 = 0; i4 < 4; ++i4) { const int c0 = cb + 8 * i4; float f[8];
#pragma unroll
              for (int i = 0; i < 8; ++i) f[i] = bf2f(KS[(c0 + i) * 144 + d]) * SM[192 + c0 + i];
              u32x4 w; w.x = pk2(f[0], f[1]); w.y = pk2(f[2], f[3]); w.z = pk2(f[4], f[5]); w.w = pk2(f[6], f[7]);
              *(u32x4*)(proj + (size_t)(t0 + (d >> 1)) * NPJ + OFF_GK + h * 128 + (d & 1) * 64 + c0) = w; } }
        __syncthreads();
#pragma unroll
        for (int nt = 0; nt < 4; ++nt)
#pragma unroll
            for (int j = 0; j < 4; ++j) { const int c = 16 * tw + 4 * fq + j, s = 16 * nt + fr; const float dec = (s <= c) ? __expf(SM[c] - SM[s]) : 0.f;
                AF[c * 65 + s] = (s < c) ? SM[64 + c] * kk[nt][j] * dec : (s == c ? 1.f : 0.f);
                QKB[(size_t)ci * 4096 + c * 64 + s] = f2bf(qk[nt][j] * dec); }
        __syncthreads();
        { const int bb = tw * 16;
          if (lane < 16) {
              for (int i = 1; i < 16; ++i) { float a0 = 0.f, a1 = 0.f; int j = 0;
                  for (; j + 2 <= i; j += 2) { a0 += AF[(bb + i) * 65 + bb + j] * AF[(bb + j) * 65 + bb + lane]; a1 += AF[(bb + i) * 65 + bb + j + 1] * AF[(bb + j + 1) * 65 + bb + lane]; }
                  if (j < i) a0 += AF[(bb + i) * 65 + bb + j] * AF[(bb + j) * 65 + bb + lane];
                  AF[(bb + i) * 65 + bb + lane] = lane < i ? -(a0 + a1) : (lane == i ? 1.f : 0.f); } }
#pragma unroll
          for (int k = 0; k < 4; ++k) { const int row = bb + fq + 4 * k; TB[row * 80 + bb + fr] = f2bf(AF[row * 65 + bb + fr]);
              for (int jb = tw + 1; jb < 4; ++jb) TB[row * 80 + 16 * jb + fr] = (bf16_t)0; }
          __syncthreads();
          for (int i = 1; i < 4; ++i) {
              if (tw < i) { const int j = tw; f32x4 X = {0.f, 0.f, 0.f, 0.f};
                  for (int k = j; k < i; ++k) {
#pragma unroll
                      for (int kk = 0; kk < 4; ++kk) { const float av = AF[(16 * i + fr) * 65 + 16 * k + 4 * kk + fq];
                          const float bv = (k == j) ? AF[(16 * k + 4 * kk + fq) * 65 + 16 * j + fr] : bf2f(TB[(16 * k + 4 * kk + fq) * 80 + 16 * j + fr]);
                          X = __builtin_amdgcn_mfma_f32_16x16x4f32(av, bv, X, 0, 0, 0); } }
                  f32x4 O = {0.f, 0.f, 0.f, 0.f};
#pragma unroll
                  for (int kk = 0; kk < 4; ++kk) O = __builtin_amdgcn_mfma_f32_16x16x4f32(AF[(16 * i + fr) * 65 + 16 * i + 4 * fq + kk], X[kk], O, 0, 0, 0);
#pragma unroll
                  for (int jj = 0; jj < 4; ++jj) TB[(16 * i + 4 * fq + jj) * 80 + 16 * j + fr] = f2bf(-O[jj]); }
              __syncthreads(); }
        }
        { bf16x8 at[2];
#pragma unroll
          for (int ks = 0; ks < 2; ++ks) at[ks] = *(const LAS bf16x8*)(TB + (16 * tw + fr) * 80 + 32 * ks + 8 * fq);
#pragma unroll
          for (int nt = 0; nt < 8; ++nt) { f32x4 a = {0.f, 0.f, 0.f, 0.f};
#pragma unroll
              for (int ks = 0; ks < 2; ++ks) a = mfma16(at[ks], *(const LAS bf16x8*)(VT + (16 * nt + fr) * 80 + 32 * ks + 8 * fq), a);
              const int e = 16 * nt + fr; u32x2 w; w.x = pk2(a[0], a[1]); w.y = pk2(a[2], a[3]);
              *(u32x2*)(proj + (size_t)(t0 + (e >> 1)) * NPJ + OFF_GV + h * 128 + (e & 1) * 64 + 16 * tw + 4 * fq) = w; }
#pragma unroll
          for (int mt = 0; mt < 8; ++mt) { f32x4 a = {0.f, 0.f, 0.f, 0.f};
#pragma unroll
              for (int ks = 0; ks < 2; ++ks) a = mfma16(*(const LAS bf16x8*)(KT + (16 * mt + fr) * 80 + 32 * ks + 8 * fq), at[ks], a);
              u32x2 w; w.x = pk2(a[0], a[1]); w.y = pk2(a[2], a[3]);
              *(u32x2*)(W2 + (size_t)(t0 + 16 * tw + fr) * 1024 + h * 128 + 16 * mt + 4 * fq) = w; } }
        __syncthreads();
        if (!arrived && pi + nwg >= early_thr) {
            asm volatile("s_waitcnt vmcnt(0)" ::: "memory"); __syncthreads();
            if (threadIdx.x == 0) { __builtin_amdgcn_fence(__ATOMIC_RELEASE, "agent"); __hip_atomic_fetch_add(early_flag, 1u, __ATOMIC_RELAXED, __HIP_MEMORY_SCOPE_AGENT); }
            arrived = true; }
    }
    if (!arrived) { asm volatile("s_waitcnt vmcnt(0)" ::: "memory"); __syncthreads();
        if (threadIdx.x == 0) { __builtin_amdgcn_fence(__ATOMIC_RELEASE, "agent"); __hip_atomic_fetch_add(early_flag, 1u, __ATOMIC_RELAXED, __HIP_MEMORY_SCOPE_AGENT); } }
}

DI void phase_moba_prep(const Params& P, LAS unsigned char* lds, int wg0, int nwg) {
    const int tid = opq_tid(), lane = tid & 63, wave = tid >> 6, l16 = lane & 15;
    bf16_t* proj = (bf16_t*)(P.ws + WS_R1); float* kmean = (float*)(P.ws + WS_KMEAN);
    LAS bf16_t* VS = (LAS bf16_t*)lds; LAS float* CS = (LAS float*)(lds + 69632);
    for (int task = wg0; task < 1024; task += nwg) {
        const int h = task & 7, blk = (task >> 3) & 63, b = task >> 9; const size_t rbase = (size_t)(b * TT + blk * 256);
        f32x4 qg0 = *(const f32x4*)(P.q_norm + l16 * 8), qg1 = *(const f32x4*)(P.q_norm + l16 * 8 + 4), kg0 = *(const f32x4*)(P.k_norm + l16 * 8), kg1 = *(const f32x4*)(P.k_norm + l16 * 8 + 4);
        float cs[8];
#pragma unroll
        for (int i = 0; i < 8; ++i) cs[i] = 0.f;
        u32x4 rq[8], rk[8], rv[8];
#pragma unroll
        for (int ps = 0; ps < 8; ++ps) { const int r = ps * 32 + wave * 4 + (lane >> 4); const bf16_t* rp = proj + (rbase + r) * NPJ + h * 128 + l16 * 8;
            rq[ps] = *(const u32x4*)(rp + OFF_MQ); rk[ps] = *(const u32x4*)(rp + OFF_MK); rv[ps] = *(const u32x4*)(rp + OFF_MV); }
#pragma unroll
        for (int ps = 0; ps < 8; ++ps) { const int r = ps * 32 + wave * 4 + (lane >> 4); bf16_t* rp = proj + (rbase + r) * NPJ + h * 128 + l16 * 8;
#pragma unroll
            for (int x = 0; x < 2; ++x) { bf16_t* ptr = rp + (x == 0 ? OFF_MQ : OFF_MK); const u32x4 raw = x == 0 ? rq[ps] : rk[ps]; float v[8];
                v[0] = bflo(raw.x); v[1] = bfhi(raw.x); v[2] = bflo(raw.y); v[3] = bfhi(raw.y); v[4] = bflo(raw.z); v[5] = bfhi(raw.z); v[6] = bflo(raw.w); v[7] = bfhi(raw.w);
                float ss = 0.f;
#pragma unroll
                for (int i = 0; i < 8; ++i) ss += v[i] * v[i];
                ss = row16_sum(ss);
                const float rs = rsqrtf(ss * (1.f / 128.f) + 1e-6f); const f32x4 g0 = x == 0 ? qg0 : kg0, g1 = x == 0 ? qg1 : kg1;
#pragma unroll
                for (int i = 0; i < 4; ++i) { v[i] *= rs * g0[i]; v[4 + i] *= rs * g1[i]; }
                if (x == 1) {
#pragma unroll
                    for (int i = 0; i < 8; ++i) cs[i] += v[i]; }
                u32x4 w; w.x = pk2(v[0], v[1]); w.y = pk2(v[2], v[3]); w.z = pk2(v[4], v[5]); w.w = pk2(v[6], v[7]); *(u32x4*)ptr = w; }
            *(LAS u32x4*)(VS + r * 136 + l16 * 8) = rv[ps]; }
#pragma unroll
        for (int i = 0; i < 8; ++i) { cs[i] += __shfl_xor(cs[i], 16); cs[i] += __shfl_xor(cs[i], 32); }
        if (lane < 16) {
#pragma unroll
            for (int i = 0; i < 8; ++i) CS[wave * 128 + lane * 8 + i] = cs[i]; }
        __syncthreads();
        if (tid < 128) { float s = 0.f;
#pragma unroll
            for (int w = 0; w < 8; ++w) s += CS[w * 128 + tid];
            kmean[((size_t)(b * 8 + h) * 64 + blk) * 128 + tid] = s * (1.f / 256.f); }
#pragma unroll 2
        for (int i8 = 0; i8 < 8; ++i8) { const int pid = tid + i8 * 512, e = (pid & 63) + 64 * (pid >> 11), ks = (pid >> 6) & 31; unsigned short f[8];
#pragma unroll
            for (int i = 0; i < 8; ++i) f[i] = VS[(ks * 8 + i) * 136 + e];
            u32x4 w; w.x = f[0] | ((unsigned)f[1] << 16); w.y = f[2] | ((unsigned)f[3] << 16); w.z = f[4] | ((unsigned)f[5] << 16); w.w = f[6] | ((unsigned)f[7] << 16);
            *(u32x4*)(proj + (rbase + 2 * e + (ks >> 4)) * NPJ + OFF_MV + h * 128 + (ks & 15) * 8) = w; }
        __syncthreads();
    }
}

DI void phase_moba_select(const Params& P, LAS unsigned char* lds, int wg0, int nwg) {
    const int tid = opq_tid(), qi = tid >> 1, half = tid & 1;
    const bf16_t* proj = (const bf16_t*)(P.ws + WS_R1); const float* kmean = (const float*)(P.ws + WS_KMEAN);
    int* cnt = (int*)(P.ws + WS_CNT); int* list = (int*)(P.ws + WS_LIST); f32x2* ML = (f32x2*)(P.ws + WS_ML);
    LAS float* KM = (LAS float*)lds; LAS int* hist = (LAS int*)(lds + 32768); LAS int* hbase = (LAS int*)(lds + 32768 + 256);
    for (int task = wg0; task < 1024; task += nwg) {
        const int tk = task >> 8, tw_ = task & 255, bhx = (tw_ >> 6) * 4 + tk, blk = (tk & 1) ? 63 - (tw_ & 63) : (tw_ & 63), h = bhx & 7, b = bhx >> 3; const int bh = b * 8 + h; const int t = blk * 256 + qi; const size_t rid = (size_t)bh * TT + t;
        for (int i = tid; i < blk * 128; i += NTHREADS) KM[i] = kmean[(size_t)bh * 64 * 128 + i];
        if (tid < 64) hist[tid] = 0;
        float q[64];
        { const bf16_t* qp = proj + (size_t)(b * TT + t) * NPJ + OFF_MQ + h * 128 + half * 64;
#pragma unroll
          for (int i = 0; i < 8; ++i) { const u32x4 raw = *(const u32x4*)(qp + 8 * i); q[8 * i] = bflo(raw.x); q[8 * i + 1] = bfhi(raw.x); q[8 * i + 2] = bflo(raw.y); q[8 * i + 3] = bfhi(raw.y);
              q[8 * i + 4] = bflo(raw.z); q[8 * i + 5] = bfhi(raw.z); q[8 * i + 6] = bflo(raw.w); q[8 * i + 7] = bfhi(raw.w); } }
        __syncthreads();
        float v0 = -INFINITY, v1 = -INFINITY, v2 = -INFINITY; int i0 = -1, i1 = -1, i2 = -1;
        for (int n = 0; n < blk; ++n) { const LAS float* km = KM + n * 128 + half * 64; float d0 = 0.f, d1 = 0.f, d2 = 0.f, d3 = 0.f;
#pragma unroll
            for (int i = 0; i < 16; ++i) { const f32x4 kv = *(const LAS f32x4*)(km + 4 * i); d0 += q[4 * i] * kv[0]; d1 += q[4 * i + 1] * kv[1]; d2 += q[4 * i + 2] * kv[2]; d3 += q[4 * i + 3] * kv[3]; }
            float g = (d0 + d1) + (d2 + d3); g += __shfl_xor(g, 1);
            if (g > v0) { v2 = v1; i2 = i1; v1 = v0; i1 = i0; v0 = g; i0 = n; } else if (g > v1) { v2 = v1; i2 = i1; v1 = g; i1 = n; } else if (g > v2) { v2 = g; i2 = n; } }
        int rk0 = 0, rk1 = 0, rk2 = 0;
        if (half == 0) { if (i0 >= 0) rk0 = __hip_atomic_fetch_add(&hist[i0], 1, __ATOMIC_RELAXED, __HIP_MEMORY_SCOPE_WORKGROUP); if (i1 >= 0) rk1 = __hip_atomic_fetch_add(&hist[i1], 1, __ATOMIC_RELAXED, __HIP_MEMORY_SCOPE_WORKGROUP); if (i2 >= 0) rk2 = __hip_atomic_fetch_add(&hist[i2], 1, __ATOMIC_RELAXED, __HIP_MEMORY_SCOPE_WORKGROUP); }
        __syncthreads();
        if (tid < 64) { const int c = hist[tid]; hbase[tid] = c > 0 ? atomicAdd(&cnt[bh * 64 + tid], c) : 0; }
        __syncthreads();
        if (half == 0) {
            const f32x2 dead = {-INFINITY, 0.f};
            if (i0 >= 0) list[(size_t)bh * LISTN + i0 * 16384 - 128 * i0 * (i0 + 1) + hbase[i0] + rk0] = t; else ML[0 * 262144 + rid] = dead;
            if (i1 >= 0) list[(size_t)bh * LISTN + i1 * 16384 - 128 * i1 * (i1 + 1) + hbase[i1] + rk1] = t | (1 << 14); else ML[1 * 262144 + rid] = dead;
            if (i2 >= 0) list[(size_t)bh * LISTN + i2 * 16384 - 128 * i2 * (i2 + 1) + hbase[i2] + rk2] = t | (2 << 14); else ML[2 * 262144 + rid] = dead;
        }
        __syncthreads();
    }
}

constexpr int G2_W = 0, G2_Q = 18432, G2_QK = 36864, G2_KD = 47104, G2_BUF = 67584, G2_RED = 135168;
DI void phase_gdn_scan(const Params& P, LAS unsigned char* lds, int bh, const unsigned* flag, unsigned need, int n_first) {
    const int tid = opq_tid(), lane = tid & 63, w = tid >> 6, fr = lane & 15, fq = lane >> 4, b = bh >> 3, h = bh & 7;
    const bf16_t* proj = (const bf16_t*)(P.ws + WS_R1); const bf16_t* W2 = (const bf16_t*)(P.ws + WS_W2); const bf16_t* QKB = (const bf16_t*)(P.ws + WS_QKB);
    const float* GL = (const float*)(P.ws + WS_GL); bf16_t* mix = (bf16_t*)(P.ws + WS_R2);
    float* SSQ = (float*)(P.ws + WS_SSQ);
    const int e = 16 * w + fr; const float gnw = P.gdn_norm[e];
    f32x4 S[8];
#pragma unroll
    for (int i = 0; i < 8; ++i) S[i] = (f32x4){0.f, 0.f, 0.f, 0.f};
    const int wrow0 = tid >> 4, wseg = tid & 15;
    const int qrow = tid >> 3, qseg = tid & 7;
    struct Stage { u32x4 sw[2], sq[2], sqk, skd[2]; };
    u32x2 un[4];
    Stage stA, stB;
#define G2_LOAD(X, nn) do { const int t0_ = b * TT + (nn) * 64; const int ci_ = ((b * 256 + (nn)) << 3) + h; \
        _Pragma("unroll") for (int i_ = 0; i_ < 2; ++i_) { X.sw[i_] = *(const u32x4*)(W2 + (size_t)(t0_ + wrow0 + 32 * i_) * 1024 + h * 128 + wseg * 8); \
            X.sq[i_] = *(const u32x4*)(proj + (size_t)(t0_ + wrow0 + 32 * i_) * NPJ + OFF_GQ + h * 128 + wseg * 8); \
            const int d_ = qrow + 64 * i_; X.skd[i_] = *(const u32x4*)(proj + (size_t)(t0_ + (d_ >> 1)) * NPJ + OFF_GK + h * 128 + (d_ & 1) * 64 + qseg * 8); } \
        X.sqk = *(const u32x4*)(QKB + (size_t)ci_ * 4096 + qrow * 64 + qseg * 8); } while (0)
#define UN_LOAD(nn) do { const int t0_ = b * TT + (nn) * 64; _Pragma("unroll") for (int mt_ = 0; mt_ < 4; ++mt_) un[mt_] = *(const u32x2*)(proj + (size_t)(t0_ + (e >> 1)) * NPJ + OFF_GV + h * 128 + (e & 1) * 64 + 16 * mt_ + 4 * fq); } while (0)
#define G2_ST2(base_, rowoff_, sg_, v_) do { const int g_ = ((sg_) >> 2) * 64, d_ = ((sg_) & 3) * 8; \
        *(LAS u32x2*)(B_ + (base_) + (rowoff_) + g_ + perm4(d_) * 2) = (u32x2){(v_).x, (v_).y}; *(LAS u32x2*)(B_ + (base_) + (rowoff_) + g_ + perm4(d_ + 4) * 2) = (u32x2){(v_).z, (v_).w}; } while (0)
#define G2_STORE(X, bufi) do { LAS unsigned char* B_ = lds + (bufi) * G2_BUF; \
        _Pragma("unroll") for (int i_ = 0; i_ < 2; ++i_) { G2_ST2(G2_W, (wrow0 + 32 * i_) * 288, wseg, X.sw[i_]); G2_ST2(G2_Q, (wrow0 + 32 * i_) * 288, wseg, X.sq[i_]); \
            G2_ST2(G2_KD, (qrow + 64 * i_) * 160, qseg, X.skd[i_]); } \
        G2_ST2(G2_QK, qrow * 160, qseg, X.sqk); } while (0)
    G2_LOAD(stA, 0); G2_STORE(stA, 0); UN_LOAD(0);
    float egl_n = GL[bh * 256];
    u32x2 uc[4];
#pragma unroll
    for (int i = 0; i < 4; ++i) uc[i] = un[i];
    G2_LOAD(stA, 1);
    __syncthreads();
    for (int n2 = 0; n2 < 256; n2 += 2) {
#pragma unroll
      for (int hf2 = 0; hf2 < 2; ++hf2) {
        const int n = n2 + hf2; Stage& LDs = hf2 ? stA : stB; Stage& STs = hf2 ? stB : stA;
        if (n == n_first - 2 || n == 126) {
            const unsigned* fl = (n == 126) ? flag + 1 : flag;
            if (tid == 0) { while (__hip_atomic_load(fl, __ATOMIC_RELAXED, __HIP_MEMORY_SCOPE_AGENT) < need) __builtin_amdgcn_s_sleep(8);
                __builtin_amdgcn_fence(__ATOMIC_ACQUIRE, "agent"); asm volatile("s_waitcnt vmcnt(0)" ::: "memory"); }
            __syncthreads(); }
        const int cur = hf2, t0 = b * TT + n * 64; LAS unsigned char* Bf = lds + cur * G2_BUF;
        { const int n2c = n + 2 < 256 ? n + 2 : 255, n1c = n + 1 < 256 ? n + 1 : 255; G2_LOAD(LDs, n2c); UN_LOAD(n1c); }
        const float egl = egl_n; egl_n = GL[bh * 256 + (n + 1 < 256 ? n + 1 : 255)];
        f32x4 Pm[4], Om[4];
#pragma unroll
        for (int mt = 0; mt < 4; ++mt) { Pm[mt] = (f32x4){0.f, 0.f, 0.f, 0.f}; Om[mt] = (f32x4){0.f, 0.f, 0.f, 0.f}; }
#define SBAR __builtin_amdgcn_sched_barrier(0)
#define LD_K4(dst, base_, ks_) do { const int o0_ = fr * 288 + (32 * (ks_) + 8 * fq) * 2; \
        dst[0] = *(const LAS bf16x8*)(Bf + base_ + o0_); dst[1] = *(const LAS bf16x8*)(Bf + base_ + o0_ + 4608); \
        dst[2] = *(const LAS bf16x8*)(Bf + base_ + o0_ + 9216); dst[3] = *(const LAS bf16x8*)(Bf + base_ + o0_ + 13824); } while (0)
#define MM_K4(src, sb_, A_) do { A_[0] = mfma16(src[0], sb_, A_[0]); A_[1] = mfma16(src[1], sb_, A_[1]); A_[2] = mfma16(src[2], sb_, A_[2]); A_[3] = mfma16(src[3], sb_, A_[3]); } while (0)
#define LD_R4(dst, base_, r0_, k2_) do { const int o0_ = (16 * (r0_) + fr) * 160 + (32 * (k2_) + 8 * fq) * 2; \
        dst[0] = *(const LAS bf16x8*)(Bf + base_ + o0_); dst[1] = *(const LAS bf16x8*)(Bf + base_ + o0_ + 2560); \
        dst[2] = *(const LAS bf16x8*)(Bf + base_ + o0_ + 5120); dst[3] = *(const LAS bf16x8*)(Bf + base_ + o0_ + 7680); } while (0)
#define MM_R4(src, vb_, A0_, A1_, A2_, A3_) do { A0_ = mfma16(src[0], vb_, A0_); A1_ = mfma16(src[1], vb_, A1_); A2_ = mfma16(src[2], vb_, A2_); A3_ = mfma16(src[3], vb_, A3_); } while (0)
        bf16x8 fa[4], fb[4];
        LD_K4(fa, G2_W, 0);
        const bf16x8 sb0 = pack8(S[0], S[1]), sb1 = pack8(S[2], S[3]), sb2 = pack8(S[4], S[5]), sb3 = pack8(S[6], S[7]);
        LD_K4(fb, G2_W, 1); SBAR; MM_K4(fa, sb0, Pm); SBAR;
        LD_K4(fa, G2_W, 2); SBAR; MM_K4(fb, sb1, Pm); SBAR;
        LD_K4(fb, G2_W, 3); SBAR; MM_K4(fa, sb2, Pm); SBAR;
        LD_K4(fa, G2_Q, 0); SBAR; MM_K4(fb, sb3, Pm); SBAR;
        f32x4 vn[4];
#pragma unroll
        for (int mt = 0; mt < 4; ++mt) { vn[mt][0] = bflo(uc[mt].x) - Pm[mt][0]; vn[mt][1] = bfhi(uc[mt].x) - Pm[mt][1]; vn[mt][2] = bflo(uc[mt].y) - Pm[mt][2]; vn[mt][3] = bfhi(uc[mt].y) - Pm[mt][3]; }
        bf16x8 Vb[2];
#pragma unroll
        for (int k2 = 0; k2 < 2; ++k2) Vb[k2] = pack8(vn[2 * k2], vn[2 * k2 + 1]);
        LD_K4(fb, G2_Q, 1); SBAR; MM_K4(fa, sb0, Om); SBAR;
        LD_K4(fa, G2_Q, 2); SBAR; MM_K4(fb, sb1, Om); SBAR;
        LD_K4(fb, G2_Q, 3); SBAR; MM_K4(fa, sb2, Om); SBAR;
        LD_R4(fa, G2_QK, 0, 0); SBAR; MM_K4(fb, sb3, Om); SBAR;
#pragma unroll
        for (int dt = 0; dt < 8; ++dt) S[dt] = S[dt] * egl;
        SBAR;
        LD_R4(fb, G2_QK, 0, 1); SBAR; MM_R4(fa, Vb[0], Om[0], Om[1], Om[2], Om[3]); SBAR;
        LD_R4(fa, G2_KD, 0, 0); SBAR; MM_R4(fb, Vb[1], Om[0], Om[1], Om[2], Om[3]); SBAR;
        LD_R4(fb, G2_KD, 0, 1); SBAR; MM_R4(fa, Vb[0], S[0], S[1], S[2], S[3]); SBAR;
        LD_R4(fa, G2_KD, 4, 0); SBAR; MM_R4(fb, Vb[1], S[0], S[1], S[2], S[3]); SBAR;
        LD_R4(fb, G2_KD, 4, 1); SBAR; MM_R4(fa, Vb[0], S[4], S[5], S[6], S[7]); SBAR;
        MM_R4(fb, Vb[1], S[4], S[5], S[6], S[7]); SBAR;
#undef LD_K4
#undef MM_K4
#undef LD_R4
#undef MM_R4
#undef SBAR
        { G2_STORE(STs, cur ^ 1);
#pragma unroll
            for (int i = 0; i < 4; ++i) uc[i] = un[i]; }
        { LAS bf16_t* OTW = (LAS bf16_t*)(lds + G2_RED + w * 2048);
#pragma unroll
          for (int mt = 0; mt < 4; ++mt)
#pragma unroll
            for (int j = 0; j < 4; ++j) OTW[(16 * mt + 4 * fq + j) * 16 + fr] = f2bf(Om[mt][j]);
#pragma unroll
          for (int i = 0; i < 2; ++i) { const int row = (lane >> 1) + 32 * i, hv = lane & 1;
              bf16_t* mp_ = mix + (size_t)(t0 + row) * DM + h * 128 + 16 * w + 8 * hv; const u32x4 ov_ = *(const LAS u32x4*)(OTW + row * 16 + hv * 8);
              asm volatile("global_store_dwordx4 %0, %1, off" :: "v"(mp_), "v"(ov_) : "memory"); } }
        __syncthreads();
      }
    }
#undef G2_LOAD
#undef UN_LOAD
#undef G2_STORE
#undef G2_ST2
    asm volatile("s_waitcnt vmcnt(0)" ::: "memory");
    __syncthreads();
}

constexpr int AT_KS = 0, AT_VT = 73728, AT_PF = 143360, AT_MISC = 147712;
DI void phase_moba_attn(const Params& P, LAS unsigned char* lds) {
    const int tid = opq_tid(), lane = tid & 63, w = tid >> 6, fr = lane & 15, fq = lane >> 4;
    const bf16_t* proj = (const bf16_t*)(P.ws + WS_R1); const int* cnt = (const int*)(P.ws + WS_CNT); const int* list = (const int*)(P.ws + WS_LIST);
    f32x2* ML = (f32x2*)(P.ws + WS_ML); bf16_t* opart = (bf16_t*)P.out; unsigned* workctr = (unsigned*)(P.ws + WS_CTL);
    LAS bf16_t* KS = (LAS bf16_t*)(lds + AT_KS); LAS bf16_t* VT = (LAS bf16_t*)(lds + AT_VT); LAS int* PF = (LAS int*)(lds + AT_PF); LAS int* MISC = (LAS int*)(lds + AT_MISC);
    { const int c0 = cnt[2 * tid], c1 = cnt[2 * tid + 1]; const int a = (c0 + 511) >> 9, bsum = a + ((c1 + 511) >> 9); int inc = bsum;
#pragma unroll
      for (int o = 1; o < 64; o <<= 1) { const int v = __shfl_up(inc, o); if (lane >= o) inc += v; }
      if (lane == 63) MISC[8 + w] = inc;
      __syncthreads();
      int wb = 0;
#pragma unroll
      for (int i = 0; i < 8; ++i) wb += (i < w) ? MISC[8 + i] : 0;
      const int ex = wb + inc - bsum; PF[2 * tid] = ex; PF[2 * tid + 1] = ex + a; if (tid == 511) PF[1024] = ex + bsum;
      __syncthreads(); }
    const int totalG = PF[1024];
    const float sc2 = 0.08838834764831845f * 1.4426950408889634f;
    const int tid_at = tid;
    for (;;) {
        int tid = tid_at; asm volatile("" : "+v"(tid)); const int lane = tid & 63, w = __builtin_amdgcn_readfirstlane(tid >> 6), fr = lane & 15, fq = lane >> 4;
        if (tid == 0) MISC[0] = (int)atomicAdd(workctr, 1u);
        __syncthreads();
        const int wid = MISC[0];
        __syncthreads();
        if (wid >= totalG + 1024) break;
        int bh, j, causal, qstart, qcount;
        if (wid < totalG) { int lo = 0, hi = 1024; while (hi - lo > 1) { const int mid = (lo + hi) >> 1; if (PF[mid] <= wid) lo = mid; else hi = mid; }
            bh = lo >> 6; j = lo & 63; causal = 0; qstart = (wid - PF[lo]) * 512; const int c = cnt[lo]; qcount = c - qstart; if (qcount > 512) qcount = 512; }
        else { const int o = wid - totalG; bh = o >> 6; j = o & 63; causal = 1; qstart = 0; qcount = 256; }
        const int b = bh >> 3, h = bh & 7; const size_t kbase = (size_t)(b * TT + j * 256);
        { u32x4 kr[8], vr[8];
#pragma unroll
          for (int i8 = 0; i8 < 8; ++i8) { const int pid = tid + i8 * 512; kr[i8] = *(const u32x4*)(proj + (kbase + (pid >> 4)) * NPJ + OFF_MK + h * 128 + (pid & 15) * 8);
              const int e = pid >> 5, ks = pid & 31; vr[i8] = *(const u32x4*)(proj + (kbase + 2 * e + (ks >> 4)) * NPJ + OFF_MV + h * 128 + (ks & 15) * 8); }
#pragma unroll
          for (int i8 = 0; i8 < 8; ++i8) { const int pid = tid + i8 * 512; *(LAS u32x4*)(KS + (pid >> 4) * 144 + (pid & 15) * 8) = kr[i8];
              const int e = pid >> 5, ks = pid & 31; const int g_ = (ks >> 2) * 32, d_ = (ks & 3) * 8;
              *(LAS u32x2*)(VT + e * 272 + g_ + perm4(d_)) = (u32x2){vr[i8].x, vr[i8].y}; *(LAS u32x2*)(VT + e * 272 + g_ + perm4(d_ + 4)) = (u32x2){vr[i8].z, vr[i8].w}; } }
        const int lbase = bh * LISTN + j * 16384 - 128 * j * (j + 1) + qstart;
        const int ntile = (qcount + 127) >> 7;
        int en0, en1, en2, en3;
        { const int q0 = 16 * w + fr, lim = qcount - 1;
          if (causal) { en0 = (j * 256 + q0) | (3 << 14); en1 = (j * 256 + q0 + 128) | (3 << 14); en2 = en1; en3 = en1; }
          else { en0 = list[lbase + (q0 < lim ? q0 : lim)]; en1 = list[lbase + (q0 + 128 < lim ? q0 + 128 : lim)]; en2 = list[lbase + (q0 + 256 < lim ? q0 + 256 : lim)]; en3 = list[lbase + (q0 + 384 < lim ? q0 + 384 : lim)]; } }
        bf16x8 Bq[4], Bn[4];
        { const bf16_t* qp = proj + (size_t)(b * TT + (en0 & 16383)) * NPJ + OFF_MQ + h * 128 + 8 * fq;
#pragma unroll
          for (int ks = 0; ks < 4; ++ks) Bq[ks] = *(const bf16x8*)(qp + 32 * ks); }
        __syncthreads();
        for (int tile = 0; tile < ntile; ++tile) {
            const int en = tile == 0 ? en0 : (tile == 1 ? en1 : (tile == 2 ? en2 : en3));
            { const int enx = tile == 0 ? en1 : (tile == 1 ? en2 : en3); const bf16_t* qp = proj + (size_t)(b * TT + (enx & 16383)) * NPJ + OFF_MQ + h * 128 + 8 * fq;
#pragma unroll
              for (int ks = 0; ks < 4; ++ks) Bn[ks] = *(const bf16x8*)(qp + 32 * ks); }
            const int qi = tile * 128 + 16 * w + fr; const bool valid = qi < qcount; const int t = en & 16383, slot = en >> 14;
            if (tile * 128 + 16 * w < qcount) {
            const int nkt = causal ? (8 * tile + w + 1) : 16;
            f32x4 st[16]; float mx = -INFINITY;
#pragma unroll
            for (int kp = 0; kp < 8; ++kp) { f32x4 a0 = {0.f, 0.f, 0.f, 0.f}, a1 = {0.f, 0.f, 0.f, 0.f};
                if (2 * kp < nkt) { bf16x8 kf[8];
#pragma unroll
                    for (int ks = 0; ks < 4; ++ks) { kf[ks] = *(const LAS bf16x8*)(KS + (32 * kp + fr) * 144 + 32 * ks + 8 * fq); kf[4 + ks] = *(const LAS bf16x8*)(KS + (32 * kp + 16 + fr) * 144 + 32 * ks + 8 * fq); }
#pragma unroll
                    for (int ks = 0; ks < 4; ++ks) { a0 = mfma16(kf[ks], Bq[ks], a0); a1 = mfma16(kf[4 + ks], Bq[ks], a1); }
#pragma unroll
                    for (int jj = 0; jj < 4; ++jj) { float s0 = a0[jj] * sc2, s1 = a1[jj] * sc2;
                        if (causal && (32 * kp + 4 * fq + jj) > qi) s0 = -INFINITY; if ((causal && (32 * kp + 16 + 4 * fq + jj) > qi) || 2 * kp + 1 >= nkt) s1 = -INFINITY;
                        a0[jj] = s0; a1[jj] = s1; mx = fmaxf(mx, fmaxf(s0, s1)); }
                } else { a0 = (f32x4){-INFINITY, -INFINITY, -INFINITY, -INFINITY}; a1 = a0; }
                st[2 * kp] = a0; st[2 * kp + 1] = a1; }
            mx = fmaxf(mx, __shfl_xor(mx, 16)); mx = fmaxf(mx, __shfl_xor(mx, 32));
            float ls = 0.f;
#pragma unroll
            for (int kt = 0; kt < 16; ++kt)
#pragma unroll
                for (int jj = 0; jj < 4; ++jj) { const float pv = exp2f(st[kt][jj] - mx); st[kt][jj] = pv; ls += pv; }
            ls += __shfl_xor(ls, 16); ls += __shfl_xor(ls, 32);
            f32x4 ot[8];
#pragma unroll
            for (int et = 0; et < 8; ++et) ot[et] = (f32x4){0.f, 0.f, 0.f, 0.f};
#pragma unroll
            for (int k2 = 0; k2 < 8; ++k2) { if (2 * k2 < nkt) { const bf16x8 pb = pack8(st[2 * k2], st[2 * k2 + 1]);
#pragma unroll
                    for (int eh = 0; eh < 2; ++eh) { bf16x8 vf[4];
#pragma unroll
                        for (int et = 0; et < 4; ++et) vf[et] = *(const LAS bf16x8*)(VT + (16 * (4 * eh + et) + fr) * 272 + 32 * k2 + 8 * fq);
#pragma unroll
                        for (int et = 0; et < 4; ++et) ot[4 * eh + et] = mfma16(vf[et], pb, ot[4 * eh + et]); } } }
            if (valid) { const float il = 1.f / ls; const size_t rid = (size_t)bh * TT + t; bf16_t* op = opart + ((size_t)slot * 262144 + rid) * 128 + 4 * fq;
#pragma unroll
                for (int et = 0; et < 8; ++et) { u32x2 wv; wv.x = pk2(ot[et][0] * il, ot[et][1] * il); wv.y = pk2(ot[et][2] * il, ot[et][3] * il); *(u32x2*)(op + 16 * et) = wv; }
                if (fq == 0) ML[(size_t)slot * 262144 + rid] = (f32x2){mx, ls}; }
            }
#pragma unroll
            for (int ks = 0; ks < 4; ++ks) Bq[ks] = Bn[ks];
        }
        __syncthreads();
    }
}

DI void phase_moba_combine(const Params& P, bool do_gate, bool do_moba, int wg0, int nwg) {
    const bf16_t* opart = (const bf16_t*)P.out; const f32x2* ML = (const f32x2*)(P.ws + WS_ML); bf16_t* mix = (bf16_t*)(P.ws + WS_R2);
    const int gtid = wg0 * NTHREADS + opq_tid(), gsz = nwg * NTHREADS;
    if (do_gate) { const bf16_t* proj = (const bf16_t*)(P.ws + WS_R1);
      for (int i0 = gtid; i0 < MT * 128; i0 += 4 * gsz) { u32x4 mv[4], zv[4];
#pragma unroll
          for (int k = 0; k < 4; ++k) { const int i = i0 + k * gsz < MT * 128 ? i0 + k * gsz : i0; const int row = i >> 7, sg = i & 127; mv[k] = *(const u32x4*)(mix + (size_t)row * DM + sg * 8); zv[k] = *(const u32x4*)(proj + (size_t)row * NPJ + OFF_GZ + sg * 8); }
          const int sg0 = i0 & 127; const f32x4 g0 = *(const f32x4*)(P.gdn_norm + (sg0 & 15) * 8), g1 = *(const f32x4*)(P.gdn_norm + (sg0 & 15) * 8 + 4);
#pragma unroll
          for (int k = 0; k < 4; ++k) { const int i = i0 + k * gsz; const int row = i >> 7, sg = i & 127;
              float o[8]; o[0] = bflo(mv[k].x); o[1] = bfhi(mv[k].x); o[2] = bflo(mv[k].y); o[3] = bfhi(mv[k].y); o[4] = bflo(mv[k].z); o[5] = bfhi(mv[k].z); o[6] = bflo(mv[k].w); o[7] = bfhi(mv[k].w);
              float ssl = 0.f;
#pragma unroll
              for (int q = 0; q < 8; ++q) ssl += o[q] * o[q];
              const float rs = rsqrtf(row16_sum(ssl) * (1.f / 128.f) + 1e-6f); const u32x4 z = zv[k];
              u32x4 wv; wv.x = pk2(o[0] * rs * g0[0] * silu_f(bflo(z.x)), o[1] * rs * g0[1] * silu_f(bfhi(z.x))); wv.y = pk2(o[2] * rs * g0[2] * silu_f(bflo(z.y)), o[3] * rs * g0[3] * silu_f(bfhi(z.y)));
              wv.z = pk2(o[4] * rs * g1[0] * silu_f(bflo(z.z)), o[5] * rs * g1[1] * silu_f(bfhi(z.z))); wv.w = pk2(o[6] * rs * g1[2] * silu_f(bflo(z.w)), o[7] * rs * g1[3] * silu_f(bfhi(z.w)));
              if (i < MT * 128) *(u32x4*)(mix + (size_t)row * DM + sg * 8) = wv; } } }
    if (do_moba) for (int i0 = gtid; i0 < 262144 * 16; i0 += 2 * gsz) {
        f32x2 ml[2][4]; u32x4 raw[2][4];
#pragma unroll
        for (int k = 0; k < 2; ++k) { const int i = i0 + k * gsz < 262144 * 16 ? i0 + k * gsz : i0; const int rid = i >> 4, sg = i & 15;
#pragma unroll
            for (int s = 0; s < 4; ++s) { ml[k][s] = ML[(size_t)s * 262144 + rid]; raw[k][s] = *(const u32x4*)(opart + ((size_t)s * 262144 + rid) * 128 + sg * 8); } }
#pragma unroll
        for (int k = 0; k < 2; ++k) { const int i = i0 + k * gsz; const int rid = i >> 4, sg = i & 15; const int bh = rid >> 14, t = rid & 16383, b = bh >> 3, h = bh & 7;
            float M = -INFINITY;
#pragma unroll
            for (int s = 0; s < 4; ++s) M = fmaxf(M, ml[k][s].x);
            float wgt[4], Lt = 0.f;
#pragma unroll
            for (int s = 0; s < 4; ++s) { wgt[s] = ml[k][s].y > 0.f ? ml[k][s].y * exp2f(ml[k][s].x - M) : 0.f; Lt += wgt[s]; }
            const float iL = 1.f / Lt; float o[8];
#pragma unroll
            for (int q = 0; q < 8; ++q) o[q] = 0.f;
#pragma unroll
            for (int s = 0; s < 4; ++s) { const float ww = wgt[s] * iL; const u32x4 r = raw[k][s];
                if (wgt[s] > 0.f) { o[0] += ww * bflo(r.x); o[1] += ww * bfhi(r.x); o[2] += ww * bflo(r.y); o[3] += ww * bfhi(r.y); o[4] += ww * bflo(r.z); o[5] += ww * bfhi(r.z); o[6] += ww * bflo(r.w); o[7] += ww * bfhi(r.w); } }
            u32x4 wv; wv.x = pk2(o[0], o[1]); wv.y = pk2(o[2], o[3]); wv.z = pk2(o[4], o[5]); wv.w = pk2(o[6], o[7]);
            if (i < 262144 * 16) *(u32x4*)(mix + (size_t)(b * TT + t) * DM + 1024 + h * 128 + sg * 8) = wv; } }
}

DI void sub_barrier(unsigned* ctr, unsigned nwg) {
    asm volatile("s_waitcnt vmcnt(0)" ::: "memory");
    __syncthreads();
    if (threadIdx.x == 0) {
        __builtin_amdgcn_fence(__ATOMIC_RELEASE, "agent");
        __hip_atomic_fetch_add(ctr, 1u, __ATOMIC_RELAXED, __HIP_MEMORY_SCOPE_AGENT);
        while (__hip_atomic_load(ctr, __ATOMIC_RELAXED, __HIP_MEMORY_SCOPE_AGENT) < nwg) __builtin_amdgcn_s_sleep(8);
        __builtin_amdgcn_fence(__ATOMIC_ACQUIRE, "agent");
        asm volatile("s_waitcnt vmcnt(0)" ::: "memory");
    }
    __syncthreads();
}

__global__ void __launch_bounds__(NTHREADS) hybrid_fwd(Params P) {
    extern __shared__ __attribute__((aligned(16))) unsigned char smem[];
    LAS unsigned char* lds = (LAS unsigned char*)smem;
    cg::grid_group grid = cg::this_grid();
    unsigned char* ws = P.ws; const int G = gridDim.x, bx = blockIdx.x;
    bf16_t* R0 = (bf16_t*)(ws + WS_R0); bf16_t* R1 = (bf16_t*)(ws + WS_R1); bf16_t* R2 = (bf16_t*)(ws + WS_R2);
    float* ss1 = (float*)(ws + WS_SS1); float* ss2 = (float*)(ws + WS_SS2);

    phase_prep(P, lds);
    grid.sync();
    { pg8::Gemm g{R0, (const bf16_t*)(ws + WS_WIN), MT, NPJ, DM}; pg8::StaticOrder S; S.init(MT, NPJ, G, bx); EpiProj E{R1, (bf16_t*)(ws + WS_HALO)}; pg8::gemm_phase<decltype(E), pg8::StaticOrder, true, true>(lds, g, S, E); }
    phase_ba(P);
    grid.sync();
    phase_gdn_prep(P, lds, 0, 64, bx, G);
    grid.sync();
    if (bx < 16) phase_gdn_scan(P, lds, bx, (const unsigned*)(ws + WS_CTL) + 11, (unsigned)(G - 16), 64);
    else { unsigned* ctl = (unsigned*)(ws + WS_CTL);
        phase_gdn_prep(P, lds, 64, 192, bx - 16, G - 16, ctl + 11, 512);
        asm volatile("s_waitcnt vmcnt(0)" ::: "memory"); __syncthreads();
        if (threadIdx.x == 0) { __builtin_amdgcn_fence(__ATOMIC_RELEASE, "agent"); __hip_atomic_fetch_add(ctl + 12, 1u, __ATOMIC_RELAXED, __HIP_MEMORY_SCOPE_AGENT); }
        phase_moba_prep(P, lds, bx - 16, G - 16); sub_barrier(ctl + 8, (unsigned)(G - 16));
        phase_moba_select(P, lds, bx - 16, G - 16); sub_barrier(ctl + 9, (unsigned)(G - 16));
        phase_moba_attn(P, lds);
        phase_wconv_late(P, lds, bx - 16, G - 16);
        sub_barrier(ctl + 10, (unsigned)(G - 16)); phase_moba_combine(P, false, true, bx - 16, G - 16); }
    grid.sync();
    phase_moba_combine(P, true, false, bx, G);
    grid.sync();
    { pg8::Gemm g{R2, (const bf16_t*)(ws + WS_WO), MT, DM, DM}; pg8::StaticOrder S; S.init(MT, DM, G, bx); EpiResid E{P.x, P.out, R0, ss1}; pg8::gemm_phase<decltype(E), pg8::StaticOrder, true, false>(lds, g, S, E); }
    grid.sync();
    { pg8::Gemm g{R0, (const bf16_t*)(ws + WS_WGU), MT, 2 * FF, DM}; pg8::StaticOrder S; S.init(MT, 2 * FF, G, bx); EpiAct E{R1, ss1}; pg8::gemm_phase<decltype(E), pg8::StaticOrder, true, true>(lds, g, S, E); }
    grid.sync();
    { pg8::Gemm g{(const bf16_t*)(ws + WS_PB), (const bf16_t*)(ws + WS_WPP), MT, DM, 256}; pg8::StaticOrder S; S.init(MT, DM, G, bx); EpiPlainBf16 E{R0, DM}; pg8::gemm_phase<decltype(E), pg8::StaticOrder, true, false>(lds, g, S, E); }
    { pg8::Gemm g{R1, (const bf16_t*)(ws + WS_WDN), MT, DM, FF}; pg8::StaticOrder S; S.init(MT, DM, G, bx); EpiResid E{P.out, P.out, R2, ss2}; pg8::gemm_phase<decltype(E), pg8::StaticOrder, true, false>(lds, g, S, E); }
    grid.sync();
    { pg8::Gemm g{R2, (const bf16_t*)(ws + WS_WPG), MT, DM, DM}; pg8::StaticOrder S; S.init(MT, DM, G, bx); EpiOut E{P.out, R0, ss2}; pg8::gemm_phase<decltype(E), pg8::StaticOrder, true, false>(lds, g, S, E); }
}

extern "C" void kernel_launch(void* const* d_in, const int* in_sizes, int n_in, void* d_out, int out_size, void* d_ws, size_t ws_size, hipStream_t stream) {
    static int grid_blocks = 0;
    if (!grid_blocks) {
        int dev = 0, cus = 0, per_cu = 0;
        hipGetDevice(&dev);
        hipDeviceGetAttribute(&cus, hipDeviceAttributeMultiprocessorCount, dev);
        hipFuncSetAttribute((const void*)hybrid_fwd, hipFuncAttributeMaxDynamicSharedMemorySize, LDS_BYTES);
        hipOccupancyMaxActiveBlocksPerMultiprocessor(&per_cu, (const void*)hybrid_fwd, NTHREADS, LDS_BYTES);
        if (per_cu < 1) per_cu = 1;
        grid_blocks = cus * per_cu;
        if (ws_size < WS_END) fprintf(stderr, "kernel_launch: workspace too small: %zu < %zu\n", ws_size, (size_t)WS_END);
    }
    Params p{};
    p.x = (const float*)d_in[0]; p.p = (const float*)d_in[1]; p.attn_norm = (const float*)d_in[2]; p.w_in = (const float*)d_in[3]; p.conv_w = (const float*)d_in[4];
    p.A_log = (const float*)d_in[5]; p.dt_bias = (const float*)d_in[6]; p.gdn_norm = (const float*)d_in[7]; p.q_norm = (const float*)d_in[8]; p.k_norm = (const float*)d_in[9];
    p.w_o = (const float*)d_in[10]; p.ffn_norm = (const float*)d_in[11]; p.w_gate = (const float*)d_in[12]; p.w_up = (const float*)d_in[13]; p.w_down = (const float*)d_in[14];
    p.ple_norm = (const float*)d_in[15]; p.w_pg = (const float*)d_in[16]; p.w_pp = (const float*)d_in[17];
    p.out = (float*)d_out; p.ws = (unsigned char*)d_ws;
    void* args[] = {&p};
    hipError_t e = hipLaunchCooperativeKernel((const void*)hybrid_fwd, dim3(grid_blocks), dim3(NTHREADS), args, LDS_BYTES, stream);
    if (e != hipSuccess) fprintf(stderr, "cooperative launch failed: %s (grid %d)\n", hipGetErrorString(e), grid_blocks);
}
```

```cpp
#include <hip/hip_runtime.h>
#include <hip/hip_cooperative_groups.h>
#include <cstdio>
namespace cg = cooperative_groups;

#define LAS __attribute__((address_space(3)))
#define DI __device__ __forceinline__
typedef unsigned short bf16_t;
typedef short bf16x8 __attribute__((ext_vector_type(8)));
typedef float f32x4 __attribute__((ext_vector_type(4)));
typedef float f32x2 __attribute__((ext_vector_type(2)));
typedef unsigned u32x4 __attribute__((ext_vector_type(4)));
typedef unsigned u32x2 __attribute__((ext_vector_type(2)));
typedef __bf16 bfv2 __attribute__((ext_vector_type(2)));

constexpr int DM = 2048, TT = 16384, MT = 32768, NPJ = 7168, FF = 5632, INW = 7184;
constexpr int OFF_GQ = 0, OFF_GK = 1024, OFF_GV = 2048, OFF_GZ = 3072, OFF_MQ = 4096, OFF_MK = 5120, OFF_MV = 6144;
constexpr int LISTN = 516096;
constexpr int NTHREADS = 512;
constexpr int LDS_BYTES = 163840;

constexpr size_t WS_CTL   = 0;
constexpr size_t WS_CNT   = 4096;
constexpr size_t WS_SS1   = 8192;
constexpr size_t WS_SS2   = WS_SS1 + 131072;
constexpr size_t WS_GL    = WS_SS2 + 131072;
constexpr size_t WS_KMEAN = WS_GL + 16384;
constexpr size_t WS_WBA   = WS_KMEAN + 524288;
constexpr size_t WS_BA    = WS_WBA + 65536;
constexpr size_t WS_WIN   = WS_BA + 2097152;
constexpr size_t WS_WO    = WS_WIN + (size_t)7168 * 2048 * 2;
constexpr size_t WS_WGU   = WS_WO + (size_t)2048 * 2048 * 2;
constexpr size_t WS_WDN   = WS_WGU + (size_t)11264 * 2048 * 2;
constexpr size_t WS_WPG   = WS_WDN + (size_t)2048 * 5632 * 2;
constexpr size_t WS_WPP   = WS_WPG + (size_t)2048 * 2048 * 2;
constexpr size_t WS_PB    = WS_WPP + (size_t)2048 * 256 * 2;
constexpr size_t WS_R0    = WS_PB + (size_t)32768 * 256 * 2;
constexpr size_t WS_R1    = WS_R0 + (size_t)32768 * 2048 * 2;
constexpr size_t WS_R2    = WS_R1 + (size_t)32768 * 7168 * 2;
constexpr size_t WS_W2    = WS_R2 + (size_t)32768 * 2048 * 2;
constexpr size_t WS_QKB   = WS_W2 + (size_t)32768 * 1024 * 2;
constexpr size_t WS_HALO  = WS_QKB + (size_t)4096 * 4096 * 2;
constexpr size_t WS_LIST  = WS_HALO + (size_t)513 * 3 * 3072 * 2 + 256 - ((size_t)513 * 3 * 3072 * 2) % 256;
constexpr size_t WS_ML    = WS_LIST + (size_t)16 * LISTN * 4;
constexpr size_t WS_SSQ   = WS_ML + (size_t)4 * 262144 * 8;
constexpr size_t WS_END   = WS_SSQ + (size_t)32768 * 64 * 4;

struct Params {
    const float* x; const float* p; const float* attn_norm; const float* w_in; const float* conv_w; const float* A_log; const float* dt_bias;
    const float* gdn_norm; const float* q_norm; const float* k_norm; const float* w_o; const float* ffn_norm; const float* w_gate; const float* w_up;
    const float* w_down; const float* ple_norm; const float* w_pg; const float* w_pp;
    float* out; unsigned char* ws;
};

DI unsigned pk2(float a, float b) { f32x2 v = {a, b}; bfv2 r = __builtin_convertvector(v, bfv2); return __builtin_bit_cast(unsigned, r); }
DI bf16_t f2bf(float a) { return (bf16_t)(pk2(a, 0.f) & 0xffffu); }
DI float bflo(unsigned w) { return __uint_as_float(w << 16); }
DI float bfhi(unsigned w) { return __uint_as_float(w & 0xffff0000u); }
DI float bf2f(bf16_t v) { return __uint_as_float(((unsigned)v) << 16); }
DI bf16x8 pack8(const f32x4& a, const f32x4& b) { u32x4 w; w.x = pk2(a[0], a[1]); w.y = pk2(a[2], a[3]); w.z = pk2(b[0], b[1]); w.w = pk2(b[2], b[3]); return __builtin_bit_cast(bf16x8, w); }
DI bf16x8 cat8(u32x2 lo, u32x2 hi) { u32x4 w; w.x = lo.x; w.y = lo.y; w.z = hi.x; w.w = hi.y; return __builtin_bit_cast(bf16x8, w); }
DI f32x4 mfma16(bf16x8 a, bf16x8 b, f32x4 c) { return __builtin_amdgcn_mfma_f32_16x16x32_bf16(a, b, c, 0, 0, 0); }
DI int perm4(int d4) { return d4 < 16 ? 2 * d4 : 2 * (d4 - 16) + 4; }
DI float dpp_f(float v, int ctrl_sel) { int x = __float_as_int(v); int r;
    if (ctrl_sel == 0) r = __builtin_amdgcn_mov_dpp(x, 0xB1, 0xf, 0xf, true); else if (ctrl_sel == 1) r = __builtin_amdgcn_mov_dpp(x, 0x4E, 0xf, 0xf, true);
    else if (ctrl_sel == 2) r = __builtin_amdgcn_mov_dpp(x, 0x141, 0xf, 0xf, true); else r = __builtin_amdgcn_mov_dpp(x, 0x140, 0xf, 0xf, true);
    return __int_as_float(r); }
DI float row16_sum(float v) { v += dpp_f(v, 0); v += dpp_f(v, 1); v += dpp_f(v, 2); v += dpp_f(v, 3); return v; }
DI float silu_f(float v) { return v * __builtin_amdgcn_rcpf(1.f + __expf(-v)); }
DI float sigm_f(float v) { return __builtin_amdgcn_rcpf(1.f + __expf(-v)); }

DI int opq_tid() { int t = threadIdx.x; asm volatile("" : "+v"(t)); return t; }

namespace pg8 {
constexpr int BM = 256, BK = 64, HALF = 128, HTB = HALF * BK * 2, STAGE_BYTES = 8 * HTB, NXCD = 8, WGM = 8;
DI int lds_byte(int r, int c) { const int st = (r >> 4) * 2 + (c >> 5), rr = r & 15, cc = c & 31, ob = rr * 64 + cc * 2; return st * 1024 + (ob ^ (((ob >> 9) & 1) << 5)); }
DI void stage_rc(int b, int& R, int& C) { const int st = b / 1024, sb = b % 1024, swz = sb ^ (((sb >> 9) & 1) << 5); R = (st >> 1) * 16 + swz / 64; C = (st & 1) * 32 + (swz % 64) / 2; }
DI int perm32(int rho) { const int n = rho >> 4, i = rho & 15; return 8 * (i >> 2) + 4 * n + (i & 3); }
struct Unit { int pm, pn; };
struct Gemm { const bf16_t* A; const bf16_t* Bt; int M, N, K; };
struct StaticOrder {
    int nM, nN, nwg, G, c;
    DI void init(int M, int N, int G_, int c_) { nM = M / BM; nN = N / BM; nwg = nM * nN; G = G_; c = c_; }
    DI bool next(int i, Unit& u) const {
        const long L = (long)i * G + c; if (L >= nwg) return false;
        int wgid = (int)L; { const int q = nwg / NXCD, r = nwg % NXCD, xcd = wgid % NXCD, off = wgid / NXCD; wgid = (xcd < r ? xcd * (q + 1) : r * (q + 1) + (xcd - r) * q) + off; }
        const int nig = WGM * nN, gid = wgid / nig, fm = gid * WGM, gsz = (nM - fm) < WGM ? (nM - fm) : WGM;
        u.pm = fm + ((wgid % nig) % gsz); u.pn = (wgid % nig) / gsz; return true;
    }
    DI void a_ready(const Unit&) const {}
    DI void done(const Unit&) const {}
};

template <class Epi, class Sched, bool ALIGN_EPI = false, bool SP2 = false>
DI void gemm_phase(LAS unsigned char* lds, const Gemm g, const Sched& S, const Epi& E) {
    const int tid = opq_tid(), wid = __builtin_amdgcn_readfirstlane(tid >> 6), lane = tid & 63, wr = wid >> 2, wc = wid & 3, fr = lane & 15, fq = lane >> 4;
    const int K = g.K, nt = K / BK;
    unsigned voffA[2], voffB[2];
#pragma unroll
    for (int i = 0; i < 2; ++i) { int R, C; stage_rc(tid * 16 + i * 8192, R, C); const int Rb = Epi::PERM ? ((R & ~31) + perm32(R & 31)) : R;
        voffA[i] = (unsigned)(R * K + C) * 2u; voffB[i] = (unsigned)(Rb * K + C) * 2u; }
    const size_t kstep = (size_t)(BK * 2);
    const size_t hstep = (size_t)HALF * K * 2;
    const size_t tstep = 2 * hstep;
    const unsigned ldsw = (unsigned)wid * 1024u;
    const int aoff = lds_byte(wr * 64 + fr, fq * 8), boff = lds_byte(wc * 32 + fr, fq * 8);
#define PG8_SA(b, h) (((b) * 2 + (h)) * HTB)
#define PG8_SB(b, h) ((4 + (b) * 2 + (h)) * HTB)
#define PG8_STAGE(bufoff, gbase, voff) do { _Pragma("unroll") for (int _i = 0; _i < 2; ++_i) \
        __builtin_amdgcn_global_load_lds((const unsigned*)((const char*)(gbase) + (voff)[_i]), (LAS unsigned*)(lds + (bufoff) + ldsw + _i * 8192), 16, 0, 0); } while (0)
#define PG8_LDA(dst, b, h) do { _Pragma("unroll") for (int m = 0; m < 4; ++m) _Pragma("unroll") for (int k = 0; k < 2; ++k) dst[m][k] = *(const LAS bf16x8*)(lds + PG8_SA(b, h) + aoff + m * 2048 + k * 1024); } while (0)
#define PG8_LDB(dst, b, h) do { _Pragma("unroll") for (int n = 0; n < 2; ++n) _Pragma("unroll") for (int k = 0; k < 2; ++k) dst[n][k] = *(const LAS bf16x8*)(lds + PG8_SB(b, h) + boff + n * 2048 + k * 1024); } while (0)
#define PG8_MMA(ai, bj, At, Bt) do { __builtin_amdgcn_s_setprio(1); _Pragma("unroll") for (int m = 0; m < 4; ++m) _Pragma("unroll") for (int n = 0; n < 2; ++n) _Pragma("unroll") for (int k = 0; k < 2; ++k) \
        acc[ai][bj][m][n] = __builtin_amdgcn_mfma_f32_16x16x32_bf16(Bt[n][k], At[m][k], acc[ai][bj][m][n], 0, 0, 0); __builtin_amdgcn_s_setprio(0); } while (0)
#define PG8_WAIT_V(n) asm volatile("s_waitcnt vmcnt(" #n ")" ::: "memory")
#define PG8_WAIT_L(n) asm volatile("s_waitcnt lgkmcnt(" #n ")" ::: "memory")
#define PG8_BAR __builtin_amdgcn_s_barrier()
#define PG8_SCHED __builtin_amdgcn_sched_barrier(0)
    Unit cur, nxt; int ui = 0;
    if (!S.next(0, cur)) return;
    f32x4 acc[2][2][4][2];
#pragma unroll
    for (int a = 0; a < 2; ++a)
#pragma unroll
        for (int b = 0; b < 2; ++b)
#pragma unroll
            for (int m = 0; m < 4; ++m)
#pragma unroll
                for (int n = 0; n < 2; ++n) acc[a][b][m][n] = (f32x4){0.f, 0.f, 0.f, 0.f};
    bf16x8 At[4][2], B0[2][2], B1[2][2];
    const char* cA = (const char*)g.A + (size_t)cur.pm * tstep; const char* cB = (const char*)g.Bt + (size_t)cur.pn * tstep;
    S.a_ready(cur);
    if constexpr (SP2) {
        PG8_STAGE(PG8_SB(0, 0), cB, voffB); PG8_STAGE(PG8_SB(0, 1), cB + hstep, voffB); PG8_STAGE(PG8_SA(0, 0), cA, voffA); PG8_STAGE(PG8_SA(0, 1), cA + hstep, voffA);
        if (wr == 1) PG8_BAR;
        PG8_WAIT_V(2); PG8_BAR;
        PG8_STAGE(PG8_SB(1, 0), cB + kstep, voffB); PG8_STAGE(PG8_SA(1, 0), cA + kstep, voffA); PG8_STAGE(PG8_SB(1, 1), cB + hstep + kstep, voffB);
        PG8_WAIT_V(6); PG8_BAR;
    } else {
        PG8_STAGE(PG8_SB(0, 0), cB, voffB); PG8_STAGE(PG8_SA(0, 0), cA, voffA); PG8_STAGE(PG8_SB(0, 1), cB + hstep, voffB); PG8_STAGE(PG8_SA(0, 1), cA + hstep, voffA);
        if (wr == 1) PG8_BAR;
        PG8_WAIT_V(4); PG8_BAR;
        PG8_STAGE(PG8_SB(1, 0), cB + kstep, voffB); PG8_STAGE(PG8_SA(1, 0), cA + kstep, voffA); PG8_STAGE(PG8_SB(1, 1), cB + hstep + kstep, voffB);
        PG8_WAIT_V(6); PG8_BAR;
    }
    for (;;) {
        const bool has_next = S.next(ui + 1, nxt);
        const char* nA = has_next ? (const char*)g.A + (size_t)nxt.pm * tstep : cA; const char* nB = has_next ? (const char*)g.Bt + (size_t)nxt.pn * tstep : cB;
        for (int t = 0; t < nt; t += 2) {
            const bool last = (t == nt - 2);
            const char* a1 = cA + (size_t)(t + 1) * kstep;
            const char* a2 = last ? nA : cA + (size_t)(t + 2) * kstep; const char* b2 = last ? nB : cB + (size_t)(t + 2) * kstep;
            const char* a3 = a2 + kstep; const char* b3 = b2 + kstep;
            if (last && has_next) S.a_ready(nxt);
            if constexpr (SP2) {
            PG8_LDB(B0, 0, 0); PG8_LDB(B1, 0, 1); PG8_SCHED; PG8_LDA(At, 0, 0); PG8_STAGE(PG8_SA(1, 1), a1 + hstep, voffA);
            PG8_WAIT_V(8); PG8_WAIT_L(0); PG8_BAR; PG8_MMA(0, 0, At, B0); PG8_MMA(0, 1, At, B1); PG8_BAR; PG8_SCHED;
            PG8_LDA(At, 0, 1); PG8_STAGE(PG8_SB(0, 0), b2, voffB); PG8_STAGE(PG8_SB(0, 1), b2 + hstep, voffB); PG8_STAGE(PG8_SA(0, 0), a2, voffA);
            PG8_WAIT_V(8); PG8_WAIT_L(0); PG8_BAR; PG8_MMA(1, 0, At, B0); PG8_MMA(1, 1, At, B1); PG8_BAR; PG8_SCHED;
            PG8_LDB(B0, 1, 0); PG8_LDB(B1, 1, 1); PG8_SCHED; PG8_LDA(At, 1, 0); PG8_STAGE(PG8_SA(0, 1), a2 + hstep, voffA);
            PG8_WAIT_V(8); PG8_WAIT_L(0); PG8_BAR; PG8_MMA(0, 0, At, B0); PG8_MMA(0, 1, At, B1); PG8_BAR; PG8_SCHED;
            PG8_LDA(At, 1, 1); PG8_STAGE(PG8_SB(1, 0), b3, voffB); PG8_STAGE(PG8_SB(1, 1), b3 + hstep, voffB); PG8_STAGE(PG8_SA(1, 0), a3, voffA);
            PG8_WAIT_V(8); PG8_WAIT_L(0); PG8_BAR; PG8_MMA(1, 0, At, B0); PG8_MMA(1, 1, At, B1); PG8_BAR; PG8_SCHED;
            } else {
            PG8_LDB(B0, 0, 0); PG8_SCHED; PG8_LDA(At, 0, 0); PG8_STAGE(PG8_SA(1, 1), a1 + hstep, voffA);
            PG8_WAIT_L(8); PG8_BAR; PG8_WAIT_L(0); PG8_MMA(0, 0, At, B0); PG8_BAR; PG8_SCHED;
            PG8_LDB(B1, 0, 1); PG8_STAGE(PG8_SB(0, 0), b2, voffB);
            PG8_BAR; PG8_WAIT_L(0); PG8_MMA(0, 1, At, B1); PG8_BAR;
            PG8_LDA(At, 0, 1); PG8_STAGE(PG8_SA(0, 0), a2, voffA);
            PG8_BAR; PG8_WAIT_L(0); PG8_MMA(1, 0, At, B0); PG8_BAR; PG8_SCHED;
            PG8_STAGE(PG8_SB(0, 1), b2 + hstep, voffB);
            PG8_WAIT_V(6); PG8_BAR; PG8_MMA(1, 1, At, B1); PG8_BAR;
            PG8_LDB(B0, 1, 0); PG8_SCHED; PG8_LDA(At, 1, 0); PG8_STAGE(PG8_SA(0, 1), a2 + hstep, voffA);
            PG8_WAIT_L(8); PG8_BAR; PG8_WAIT_L(0); PG8_MMA(0, 0, At, B0); PG8_BAR; PG8_SCHED;
            PG8_LDB(B1, 1, 1); PG8_STAGE(PG8_SB(1, 0), b3, voffB);
            PG8_BAR; PG8_WAIT_L(0); PG8_MMA(0, 1, At, B1); PG8_BAR;
            PG8_LDA(At, 1, 1); PG8_STAGE(PG8_SA(1, 0), a3, voffA);
            PG8_BAR; PG8_WAIT_L(0); PG8_MMA(1, 0, At, B0); PG8_BAR; PG8_SCHED;
            PG8_STAGE(PG8_SB(1, 1), b3 + hstep, voffB);
            PG8_WAIT_V(6); PG8_BAR; PG8_MMA(1, 1, At, B1); PG8_BAR;
            }
        }
        if constexpr (ALIGN_EPI) { if (wr == 0) PG8_BAR; }
        if constexpr (!Epi::AFTER_DRAIN) { E(acc, cur, wr, wc, fr, fq); S.done(cur); }
        if (!has_next) break;
#pragma unroll
        for (int a = 0; a < 2; ++a)
#pragma unroll
            for (int b = 0; b < 2; ++b)
#pragma unroll
                for (int m = 0; m < 4; ++m)
#pragma unroll
                    for (int n = 0; n < 2; ++n) acc[a][b][m][n] = (f32x4){0.f, 0.f, 0.f, 0.f};
        cur = nxt; cA = nA; cB = nB; ++ui;
        if constexpr (ALIGN_EPI) { if (wr == 1) PG8_BAR; }
    }
    PG8_WAIT_V(0);
    if constexpr (!ALIGN_EPI) { if (wr == 0) PG8_BAR; }
    PG8_BAR;
    if constexpr (Epi::AFTER_DRAIN) { E.fused(acc, cur, wr, wc, fr, fq, lds, wid, lane); S.done(cur); }
#undef PG8_SA
#undef PG8_SB
#undef PG8_STAGE
#undef PG8_LDA
#undef PG8_LDB
#undef PG8_MMA
#undef PG8_WAIT_V
#undef PG8_WAIT_L
#undef PG8_BAR
#undef PG8_SCHED
}
}
using pg8::Unit;

struct EpiProj {
    static constexpr bool PERM = true, AFTER_DRAIN = false;
    bf16_t* O; bf16_t* halo;
    DI void operator()(const f32x4 (&acc)[2][2][4][2], const Unit& u, int wr, int wc, int fr, int fq) const {
        const int row0 = u.pm * 256 + wr * 64 + fr, col0 = u.pn * 256 + wc * 32 + 8 * fq;
#pragma unroll
        for (int ai = 0; ai < 2; ++ai)
#pragma unroll
            for (int m = 0; m < 4; ++m) { const int row = row0 + ai * 128 + m * 16; bf16_t* rowp = O + (size_t)row * NPJ + col0;
#pragma unroll
                for (int bj = 0; bj < 2; ++bj) { const f32x4 v0 = acc[ai][bj][m][0], v1 = acc[ai][bj][m][1];
                    u32x4 w; w.x = pk2(v0[0], v0[1]); w.y = pk2(v0[2], v0[3]); w.z = pk2(v1[0], v1[1]); w.w = pk2(v1[2], v1[3]);
                    *(u32x4*)(rowp + bj * 128) = w;
                    if (m == 3 && fr >= 13 && u.pn < 12) *(u32x4*)(halo + ((size_t)((row >> 6) + 1) * 3 + (fr - 13)) * 3072 + col0 + bj * 128) = w; } }
    }
};
struct EpiPlainBf16 {
    static constexpr bool PERM = true, AFTER_DRAIN = false;
    bf16_t* O; int ldc;
    DI void operator()(const f32x4 (&acc)[2][2][4][2], const Unit& u, int wr, int wc, int fr, int fq) const {
        const int row0 = u.pm * 256 + wr * 64 + fr, col0 = u.pn * 256 + wc * 32 + 8 * fq;
#pragma unroll
        for (int ai = 0; ai < 2; ++ai)
#pragma unroll
            for (int m = 0; m < 4; ++m) { bf16_t* rowp = O + (size_t)(row0 + ai * 128 + m * 16) * ldc + col0;
#pragma unroll
                for (int bj = 0; bj < 2; ++bj) { const f32x4 v0 = acc[ai][bj][m][0], v1 = acc[ai][bj][m][1];
                    u32x4 w; w.x = pk2(v0[0], v0[1]); w.y = pk2(v0[2], v0[3]); w.z = pk2(v1[0], v1[1]); w.w = pk2(v1[2], v1[3]);
                    *(u32x4*)(rowp + bj * 128) = w; } }
    }
};
struct EpiResid {
    static constexpr bool PERM = false, AFTER_DRAIN = false;
    const float* base; float* out; bf16_t* hb; float* ss;
    DI void operator()(const f32x4 (&acc)[2][2][4][2], const Unit& u, int wr, int wc, int fr, int fq) const {
        const int row0 = u.pm * 256 + wr * 64 + fr, col0 = u.pn * 256 + wc * 32 + 4 * fq;
#pragma unroll
        for (int ai = 0; ai < 2; ++ai) { f32x4 bs[4][4];
#pragma unroll
            for (int m = 0; m < 4; ++m)
#pragma unroll
                for (int q = 0; q < 4; ++q) bs[m][q] = *(const f32x4*)(base + (size_t)(row0 + ai * 128 + m * 16) * DM + col0 + (q >> 1) * 128 + (q & 1) * 16);
#pragma unroll
            for (int m = 0; m < 4; ++m) { const int row = row0 + ai * 128 + m * 16; const size_t off = (size_t)row * DM + col0; float s = 0.f;
#pragma unroll
                for (int q = 0; q < 4; ++q) { const f32x4 hv = bs[m][q] + acc[ai][q >> 1][m][q & 1];
                        *(f32x4*)(out + off + (q >> 1) * 128 + (q & 1) * 16) = hv; u32x2 w; w.x = pk2(hv[0], hv[1]); w.y = pk2(hv[2], hv[3]);
                        *(u32x2*)(hb + off + (q >> 1) * 128 + (q & 1) * 16) = w; s += (hv[0] * hv[0] + hv[1] * hv[1]) + (hv[2] * hv[2] + hv[3] * hv[3]); }
                s += __shfl_xor(s, 16); s += __shfl_xor(s, 32);
                if (fq == 0) atomicAdd(ss + row, s); }
            asm volatile("" ::: "memory"); }
    }
};
struct EpiAct {
    static constexpr bool PERM = true, AFTER_DRAIN = false;
    bf16_t* O; const float* ss;
    DI void operator()(const f32x4 (&acc)[2][2][4][2], const Unit& u, int wr, int wc, int fr, int fq) const {
        const int row0 = u.pm * 256 + wr * 64 + fr, col0 = u.pn * 128 + wc * 32 + 8 * fq;
        float rs[8];
#pragma unroll
        for (int g = 0; g < 8; ++g) rs[g] = ss[row0 + (g >> 2) * 128 + (g & 3) * 16];
#pragma unroll
        for (int ai = 0; ai < 2; ++ai)
#pragma unroll
            for (int m = 0; m < 4; ++m) { const int row = row0 + ai * 128 + m * 16; const float r = rsqrtf(rs[ai * 4 + m] * (1.f / 2048.f) + 1e-6f);
                float a[8];
#pragma unroll
                for (int n = 0; n < 2; ++n)
#pragma unroll
                    for (int j = 0; j < 4; ++j) { const float gv = r * acc[ai][0][m][n][j], uv = r * acc[ai][1][m][n][j]; a[n * 4 + j] = silu_f(gv) * uv; }
                u32x4 w; w.x = pk2(a[0], a[1]); w.y = pk2(a[2], a[3]); w.z = pk2(a[4], a[5]); w.w = pk2(a[6], a[7]);
                *(u32x4*)(O + (size_t)row * FF + col0) = w; }
    }
};
struct EpiOut {
    static constexpr bool PERM = false, AFTER_DRAIN = false;
    float* out; const bf16_t* pp; const float* ss;
    DI void operator()(const f32x4 (&acc)[2][2][4][2], const Unit& u, int wr, int wc, int fr, int fq) const {
        const int row0 = u.pm * 256 + wr * 64 + fr, col0 = u.pn * 256 + wc * 32 + 4 * fq;
        float rs[8];
#pragma unroll
        for (int g = 0; g < 8; ++g) rs[g] = ss[row0 + (g >> 2) * 128 + (g & 3) * 16];
#pragma unroll
        for (int ai = 0; ai < 2; ++ai)
#pragma unroll
            for (int m = 0; m < 4; ++m) { const int row = row0 + ai * 128 + m * 16; const size_t off = (size_t)row * DM + col0; const float r = rsqrtf(rs[ai * 4 + m] * (1.f / 2048.f) + 1e-6f);
                f32x4 hv[4]; u32x2 pw[4];
#pragma unroll
                for (int q = 0; q < 4; ++q) { hv[q] = *(const f32x4*)(out + off + (q >> 1) * 128 + (q & 1) * 16); pw[q] = *(const u32x2*)(pp + off + (q >> 1) * 128 + (q & 1) * 16); }
#pragma unroll
                for (int q = 0; q < 4; ++q) { const f32x4 a = acc[ai][q >> 1][m][q & 1]; f32x4 o;
                        o[0] = hv[q][0] + sigm_f(r * a[0]) * bflo(pw[q].x); o[1] = hv[q][1] + sigm_f(r * a[1]) * bfhi(pw[q].x);
                        o[2] = hv[q][2] + sigm_f(r * a[2]) * bflo(pw[q].y); o[3] = hv[q][3] + sigm_f(r * a[3]) * bfhi(pw[q].y);
                        *(f32x4*)(out + off + (q >> 1) * 128 + (q & 1) * 16) = o; }
                asm volatile("" ::: "memory"); }
    }
};

DI void tconv_tile(const float* __restrict__ src, int ld, int c0, int k0, bf16_t* __restrict__ dst, int dK, int n0, const float* __restrict__ nw, LAS float* tl) {
    const int tid = opq_tid();
    f32x4 v[8];
#pragma unroll
    for (int i = 0; i < 8; ++i) v[i] = *(const f32x4*)(src + (size_t)(k0 + (tid >> 4) + 32 * i) * ld + c0 + (tid & 15) * 4);
#pragma unroll
    for (int i = 0; i < 8; ++i) { const int k = (tid >> 4) + 32 * i; const float sc = nw ? nw[k0 + k] : 1.f;
        LAS float* q = tl + k * 65 + (tid & 15) * 4; q[0] = v[i][0] * sc; q[1] = v[i][1] * sc; q[2] = v[i][2] * sc; q[3] = v[i][3] * sc; }
    __syncthreads();
    { const int n = tid >> 3, kq = (tid & 7) * 8;
#pragma unroll
      for (int j = 0; j < 4; ++j) { const int ks = kq + 64 * j; float f[8];
#pragma unroll
          for (int i = 0; i < 8; ++i) f[i] = tl[(ks + i) * 65 + n];
          u32x4 w; w.x = pk2(f[0], f[1]); w.y = pk2(f[2], f[3]); w.z = pk2(f[4], f[5]); w.w = pk2(f[6], f[7]);
          *(u32x4*)(dst + (size_t)(n0 + n) * dK + k0 + ks) = w; } }
    __syncthreads();
}

DI void phase_prep(const Params& P, LAS unsigned char* lds) {
    unsigned char* ws = P.ws; const int tid = opq_tid(), G = gridDim.x, bx = blockIdx.x;
    const int gtid = bx * NTHREADS + tid, gsz = G * NTHREADS;
    for (int i = gtid; i < (int)((WS_GL - WS_CTL) / 4); i += gsz) ((unsigned*)(ws + WS_CTL))[i] = 0u;
    { bf16_t* wba = (bf16_t*)(ws + WS_WBA); for (int i = gtid; i < 16 * 2048; i += gsz) { const int n = i >> 11, k = i & 2047; wba[i] = f2bf(P.w_in[(size_t)k * INW + 4096 + n]); } }
    { bf16_t* pb = (bf16_t*)(ws + WS_PB); for (int i = gtid; i < MT * 256 / 8; i += gsz) { const f32x4 a = *(const f32x4*)(P.p + (size_t)i * 8), b = *(const f32x4*)(P.p + (size_t)i * 8 + 4);
        u32x4 w; w.x = pk2(a[0], a[1]); w.y = pk2(a[2], a[3]); w.z = pk2(b[0], b[1]); w.w = pk2(b[2], b[3]); *(u32x4*)(pb + (size_t)i * 8) = w; } }
    { bf16_t* xn = (bf16_t*)(ws + WS_R0); const int lane = tid & 63, gw = bx * 8 + (tid >> 6);
      f32x4 wv[8];
#pragma unroll
      for (int i = 0; i < 8; ++i) wv[i] = *(const f32x4*)(P.attn_norm + lane * 4 + i * 256);
      for (int row = gw * 2; row < MT; row += G * 16) { const float* xr = P.x + (size_t)row * DM; f32x4 v[2][8]; float s0 = 0.f, s1 = 0.f;
#pragma unroll
          for (int r = 0; r < 2; ++r)
#pragma unroll
              for (int i = 0; i < 8; ++i) v[r][i] = *(const f32x4*)(xr + (size_t)r * DM + lane * 4 + i * 256);
#pragma unroll
          for (int i = 0; i < 8; ++i) { s0 += (v[0][i][0] * v[0][i][0] + v[0][i][1] * v[0][i][1]) + (v[0][i][2] * v[0][i][2] + v[0][i][3] * v[0][i][3]);
              s1 += (v[1][i][0] * v[1][i][0] + v[1][i][1] * v[1][i][1]) + (v[1][i][2] * v[1][i][2] + v[1][i][3] * v[1][i][3]); }
#pragma unroll
          for (int o = 1; o < 64; o <<= 1) { s0 += __shfl_xor(s0, o); s1 += __shfl_xor(s1, o); }
          const float r0 = rsqrtf(s0 * (1.f / 2048.f) + 1e-6f), r1 = rsqrtf(s1 * (1.f / 2048.f) + 1e-6f);
#pragma unroll
          for (int r = 0; r < 2; ++r)
#pragma unroll
              for (int i = 0; i < 8; ++i) { const float rr = r ? r1 : r0; u32x2 w; w.x = pk2(v[r][i][0] * rr * wv[i][0], v[r][i][1] * rr * wv[i][1]); w.y = pk2(v[r][i][2] * rr * wv[i][2], v[r][i][3] * rr * wv[i][3]);
                  *(u32x2*)(xn + (size_t)(row + r) * DM + lane * 4 + i * 256) = w; } } }
    LAS float* tl = (LAS float*)lds;
    for (int gi = bx; gi < 896; gi += G) { const int nt = gi >> 3, kg = gi & 7, n0 = nt * 64; tconv_tile(P.w_in, INW, n0 < 4096 ? n0 : n0 + 16, kg * 256, (bf16_t*)(ws + WS_WIN), 2048, n0, nullptr, tl); }
}
DI void phase_wconv_late(const Params& P, LAS unsigned char* lds, int wg0, int nwg) {
    unsigned char* ws = P.ws; LAS float* tl = (LAS float*)lds;
    for (int gi = 896 + wg0; gi < 3552; gi += nwg) {
        if (gi < 1152) { const int t2 = gi - 896, nt = t2 >> 3, kg = t2 & 7; tconv_tile(P.w_o, 2048, nt * 64, kg * 256, (bf16_t*)(ws + WS_WO), 2048, nt * 64, nullptr, tl); }
        else if (gi < 2560) { const int t2 = gi - 1152, nt = t2 >> 3, kg = t2 & 7, n0 = nt * 64, pn = n0 >> 8, r = n0 & 255;
            tconv_tile(r < 128 ? P.w_gate : P.w_up, FF, pn * 128 + (r & 127), kg * 256, (bf16_t*)(ws + WS_WGU), 2048, n0, P.ffn_norm, tl); }
        else if (gi < 3264) { const int t2 = gi - 2560, nt = t2 / 22, kg = t2 % 22; tconv_tile(P.w_down, 2048, nt * 64, kg * 256, (bf16_t*)(ws + WS_WDN), FF, nt * 64, nullptr, tl); }
        else if (gi < 3520) { const int t2 = gi - 3264, nt = t2 >> 3, kg = t2 & 7; tconv_tile(P.w_pg, 2048, nt * 64, kg * 256, (bf16_t*)(ws + WS_WPG), 2048, nt * 64, P.ple_norm, tl); }
        else { const int nt = gi - 3520; tconv_tile(P.w_pp, 2048, nt * 64, 0, (bf16_t*)(ws + WS_WPP), 256, nt * 64, nullptr, tl); }
    }
}

DI void phase_ba(const Params& P) {
    const int tid = opq_tid(), lane = tid & 63, fr = lane & 15, fq = lane >> 4, gw = blockIdx.x * 8 + (tid >> 6);
    const bf16_t* xn = (const bf16_t*)(P.ws + WS_R0); const bf16_t* wba = (const bf16_t*)(P.ws + WS_WBA); float* BA = (float*)(P.ws + WS_BA);
    for (int rt = gw; rt < MT / 16; rt += gridDim.x * 8) {
        f32x4 acc = {0.f, 0.f, 0.f, 0.f}; const bf16_t* ap = xn + (size_t)(rt * 16 + fr) * DM + 8 * fq; const bf16_t* bp = wba + fr * 2048 + 8 * fq;
#pragma unroll 16
        for (int ks = 0; ks < 64; ++ks) acc = mfma16(*(const bf16x8*)(ap + 32 * ks), *(const bf16x8*)(bp + 32 * ks), acc);
#pragma unroll
        for (int j = 0; j < 4; ++j) BA[(size_t)(rt * 16 + 4 * fq + j) * 16 + fr] = acc[j];
    }
}

constexpr int G1_QS = 0, G1_KS = 18432, G1_VT = 36864, G1_KT = 57344, G1_SM = 77824, G1_TEAM = 78848;
DI void phase_gdn_prep(const Params& P, LAS unsigned char* lds, int n_lo, int n_cnt, int wg0, int nwg, unsigned* early_flag = nullptr, int early_thr = 0, unsigned* early_flag2 = nullptr, int early_thr2 = 0) {
    const int tid0 = opq_tid(), team = tid0 >> 8;
    LAS unsigned char* L = lds + team * G1_TEAM;
    LAS bf16_t* QS = (LAS bf16_t*)(L + G1_QS); LAS bf16_t* KS = (LAS bf16_t*)(L + G1_KS); LAS bf16_t* VT = (LAS bf16_t*)(L + G1_VT); LAS bf16_t* KT = (LAS bf16_t*)(L + G1_KT);
    LAS float* AF = (LAS float*)(L + G1_QS); LAS bf16_t* TB = (LAS bf16_t*)(L + G1_KS); LAS float* SM = (LAS float*)(L + G1_SM);
    bf16_t* proj = (bf16_t*)(P.ws + WS_R1); const bf16_t* halo = (const bf16_t*)(P.ws + WS_HALO); const float* BA = (const float*)(P.ws + WS_BA);
    bf16_t* W2 = (bf16_t*)(P.ws + WS_W2); bf16_t* QKB = (bf16_t*)(P.ws + WS_QKB); float* GL = (float*)(P.ws + WS_GL);
    bool arrived = (early_flag == nullptr), arrived2 = (early_flag2 == nullptr);
    for (int pi = wg0; pi < n_cnt * 8; pi += nwg) {
        int tid = tid0; asm volatile("" : "+v"(tid));
        const int tt = tid & 255, tw = __builtin_amdgcn_readfirstlane((tid >> 6) & 3), lane = tid & 63, fr = lane & 15, fq = lane >> 4;
        const int cq = pi * 2 + team, h = cq & 7, b = (cq >> 3) & 1, n = n_lo + (cq >> 4), ci = ((b * 256 + n) << 3) + h, t0 = b * TT + n * 64;
        if (tw == 0) {
            const float bv = BA[(size_t)(t0 + lane) * 16 + h], av = BA[(size_t)(t0 + lane) * 16 + 8 + h];
            const float beta = sigm_f(bv); const float xx = av + P.dt_bias[h]; const float sp = xx > 20.f ? xx : log1pf(__expf(xx));
            const float gg = -__expf(P.A_log[h]) * sp; float gc = gg;
#pragma unroll
            for (int o = 1; o < 64; o <<= 1) { const float v = __shfl_up(gc, o); if (lane >= o) gc += v; }
            const float glast = __shfl(gc, 63);
            SM[lane] = gc; SM[64 + lane] = beta; SM[128 + lane] = __expf(gc); SM[192 + lane] = __expf(glast - gc);
            if (lane == 63) GL[(b * 8 + h) * 256 + n] = __expf(gc);
        }
        __syncthreads();
        { const int r = tt >> 2, cg0 = (tt & 3) * 32; const float beta_r = SM[64 + r], egc_r = SM[128 + r];
#pragma unroll 1
          for (int x = 0; x < 3; ++x) {
              float val[32]; const int colbase = x * 1024 + h * 128 + cg0;
              u32x4 rawa[4][4];
#pragma unroll
              for (int sg = 0; sg < 4; ++sg) { const int col = colbase + sg * 8;
#pragma unroll
                  for (int j = 0; j < 4; ++j) { const int rr = r - 3 + j; rawa[sg][j] = (u32x4){0u, 0u, 0u, 0u};
                      if (rr >= 0) rawa[sg][j] = *(const u32x4*)(proj + (size_t)(t0 + rr) * NPJ + col);
                      else if (n > 0) rawa[sg][j] = *(const u32x4*)(halo + ((size_t)(t0 >> 6) * 3 + (rr + 3)) * 3072 + col); } }
#pragma unroll
              for (int sg = 0; sg < 4; ++sg) { const int col = colbase + sg * 8;
#pragma unroll
                  for (int i = 0; i < 8; ++i) { const f32x4 w4 = *(const f32x4*)(P.conv_w + (size_t)(col + i) * 4); float a = 0.f;
#pragma unroll
                      for (int j = 0; j < 4; ++j) { const unsigned wd = rawa[sg][j][i >> 1]; const float xv = (i & 1) ? bfhi(wd) : bflo(wd); a += w4[j] * xv; }
                      val[sg * 8 + i] = silu_f(a); } }
              if (x < 2) { float ss = 0.f;
#pragma unroll
                  for (int i = 0; i < 32; ++i) ss += val[i] * val[i];
                  ss += __shfl_xor(ss, 1); ss += __shfl_xor(ss, 2);
                  const float sc = rsqrtf(ss + 1e-6f) * (x == 0 ? 0.08838834764831845f : 1.f);
#pragma unroll
                  for (int i = 0; i < 32; ++i) val[i] *= sc; }
              if (x < 2) { LAS bf16_t* dst = (x == 0 ? QS : KS) + r * 144 + cg0;
#pragma unroll
                  for (int i = 0; i < 4; ++i) { u32x4 w; w.x = pk2(val[8 * i], val[8 * i + 1]); w.y = pk2(val[8 * i + 2], val[8 * i + 3]); w.z = pk2(val[8 * i + 4], val[8 * i + 5]); w.w = pk2(val[8 * i + 6], val[8 * i + 7]);
                      *(LAS u32x4*)(dst + 8 * i) = w; } }
              if (x == 1) { const float f = beta_r * egc_r;
#pragma unroll
                  for (int i = 0; i < 32; ++i) KT[(cg0 + i) * 80 + r] = f2bf(val[i] * f); }
              if (x == 2) {
#pragma unroll
                  for (int i = 0; i < 32; ++i) VT[(cg0 + i) * 80 + r] = f2bf(val[i] * beta_r); }
          } }
        __syncthreads();
        f32x4 kk[4], qk[4];
#pragma unroll
        for (int nt = 0; nt < 4; ++nt) { kk[nt] = (f32x4){0.f, 0.f, 0.f, 0.f}; qk[nt] = (f32x4){0.f, 0.f, 0.f, 0.f}; }
#pragma unroll
        for (int ks = 0; ks < 4; ++ks) { const bf16x8 ak = *(const LAS bf16x8*)(KS + (16 * tw + fr) * 144 + 32 * ks + 8 * fq), aq = *(const LAS bf16x8*)(QS + (16 * tw + fr) * 144 + 32 * ks + 8 * fq);
#pragma unroll
            for (int nt = 0; nt < 4; ++nt) { const bf16x8 bk = *(const LAS bf16x8*)(KS + (16 * nt + fr) * 144 + 32 * ks + 8 * fq); kk[nt] = mfma16(ak, bk, kk[nt]); qk[nt] = mfma16(aq, bk, qk[nt]); } }
        { const int r = tt >> 2, cg0 = (tt & 3) * 32; const float e = SM[128 + r];
#pragma unroll
          for (int i = 0; i < 4; ++i) { const u32x4 s = *(const LAS u32x4*)(QS + r * 144 + cg0 + 8 * i); u32x4 w;
              w.x = pk2(bflo(s.x) * e, bfhi(s.x) * e); w.y = pk2(bflo(s.y) * e, bfhi(s.y) * e); w.z = pk2(bflo(s.z) * e, bfhi(s.z) * e); w.w = pk2(bflo(s.w) * e, bfhi(s.w) * e);
              *(u32x4*)(proj + (size_t)(t0 + r) * NPJ + OFF_GQ + h * 128 + cg0 + 8 * i) = w; } }
        { const int d = tt >> 1, cb = (tt & 1) * 32;
#pragma unroll
          for (int i4 = 0; i4 < 4; ++i4) { const int c0 = cb + 8 * i4; float f[8];
#pragma unroll
              for (int i = 0; i < 8; ++i) f[i] = bf2f(KS[(c0 + i) * 144 + d]) * SM[192 + c0 + i];
              u32x4 w; w.x = pk2(f[0], f[1]); w.y = pk2(f[2], f[3]); w.z = pk2(f[4], f[5]); w.w = pk2(f[6], f[7]);
              *(u32x4*)(proj + (size_t)(t0 + (d >> 1)) * NPJ + OFF_GK + h * 128 + (d & 1) * 64 + c0) = w; } }
        __syncthreads();
#pragma unroll
        for (int nt = 0; nt < 4; ++nt)
#pragma unroll
            for (int j = 0; j < 4; ++j) { const int c = 16 * tw + 4 * fq + j, s = 16 * nt + fr; const float dec = (s <= c) ? __expf(SM[c] - SM[s]) : 0.f;
                AF[c * 65 + s] = (s < c) ? SM[64 + c] * kk[nt][j] * dec : (s == c ? 1.f : 0.f);
                QKB[(size_t)ci * 4096 + c * 64 + s] = f2bf(qk[nt][j] * dec); }
        __syncthreads();
        { const int bb = tw * 16;
          if (lane < 16) {
              for (int i = 1; i < 16; ++i) { float a0 = 0.f, a1 = 0.f; int j = 0;
                  for (; j + 2 <= i; j += 2) { a0 += AF[(bb + i) * 65 + bb + j] * AF[(bb + j) * 65 + bb + lane]; a1 += AF[(bb + i) * 65 + bb + j + 1] * AF[(bb + j + 1) * 65 + bb + lane]; }
                  if (j < i) a0 += AF[(bb + i) * 65 + bb + j] * AF[(bb + j) * 65 + bb + lane];
                  AF[(bb + i) * 65 + bb + lane] = lane < i ? -(a0 + a1) : (lane == i ? 1.f : 0.f); } }
#pragma unroll
          for (int k = 0; k < 4; ++k) { const int row = bb + fq + 4 * k; TB[row * 80 + bb + fr] = f2bf(AF[row * 65 + bb + fr]);
              for (int jb = tw + 1; jb < 4; ++jb) TB[row * 80 + 16 * jb + fr] = (bf16_t)0; }
          __syncthreads();
          for (int i = 1; i < 4; ++i) {
              if (tw < i) { const int j = tw; f32x4 X = {0.f, 0.f, 0.f, 0.f};
                  for (int k = j; k < i; ++k) {
#pragma unroll
                      for (int kk = 0; kk < 4; ++kk) { const float av = AF[(16 * i + fr) * 65 + 16 * k + 4 * kk + fq];
                          const float bv = (k == j) ? AF[(16 * k + 4 * kk + fq) * 65 + 16 * j + fr] : bf2f(TB[(16 * k + 4 * kk + fq) * 80 + 16 * j + fr]);
                          X = __builtin_amdgcn_mfma_f32_16x16x4f32(av, bv, X, 0, 0, 0); } }
                  f32x4 O = {0.f, 0.f, 0.f, 0.f};
#pragma unroll
                  for (int kk = 0; kk < 4; ++kk) O = __builtin_amdgcn_mfma_f32_16x16x4f32(AF[(16 * i + fr) * 65 + 16 * i + 4 * fq + kk], X[kk], O, 0, 0, 0);
#pragma unroll
                  for (int jj = 0; jj < 4; ++jj) TB[(16 * i + 4 * fq + jj) * 80 + 16 * j + fr] = f2bf(-O[jj]); }
              __syncthreads(); }
        }
        { bf16x8 at[2];
#pragma unroll
          for (int ks = 0; ks < 2; ++ks) at[ks] = *(const LAS bf16x8*)(TB + (16 * tw + fr) * 80 + 32 * ks + 8 * fq);
#pragma unroll
          for (int nt = 0; nt < 8; ++nt) { f32x4 a = {0.f, 0.f, 0.f, 0.f};
#pragma unroll
              for (int ks = 0; ks < 2; ++ks) a = mfma16(at[ks], *(const LAS bf16x8*)(VT + (16 * nt + fr) * 80 + 32 * ks + 8 * fq), a);
              const int e = 16 * nt + fr; u32x2 w; w.x = pk2(a[0], a[1]); w.y = pk2(a[2], a[3]);
              *(u32x2*)(proj + (size_t)(t0 + (e >> 1)) * NPJ + OFF_GV + h * 128 + (e & 1) * 64 + 16 * tw + 4 * fq) = w; }
#pragma unroll
          for (int mt = 0; mt < 8; ++mt) { f32x4 a = {0.f, 0.f, 0.f, 0.f};
#pragma unroll
              for (int ks = 0; ks < 2; ++ks) a = mfma16(*(const LAS bf16x8*)(KT + (16 * mt + fr) * 80 + 32 * ks + 8 * fq), at[ks], a);
              u32x2 w; w.x = pk2(a[0], a[1]); w.y = pk2(a[2], a[3]);
              *(u32x2*)(W2 + (size_t)(t0 + 16 * tw + fr) * 1024 + h * 128 + 16 * mt + 4 * fq) = w; } }
        __syncthreads();
        if (!arrived && pi + nwg >= early_thr) {
            asm volatile("s_waitcnt vmcnt(0)" ::: "memory"); __syncthreads();
            if (threadIdx.x == 0) { __builtin_amdgcn_fence(__ATOMIC_RELEASE, "agent"); __hip_atomic_fetch_add(early_flag, 1u, __ATOMIC_RELAXED, __HIP_MEMORY_SCOPE_AGENT); }
            arrived = true; }
        if (!arrived2 && pi + nwg >= early_thr2) {
            asm volatile("s_waitcnt vmcnt(0)" ::: "memory"); __syncthreads();
            if (threadIdx.x == 0) { __builtin_amdgcn_fence(__ATOMIC_RELEASE, "agent"); __hip_atomic_fetch_add(early_flag2, 1u, __ATOMIC_RELAXED, __HIP_MEMORY_SCOPE_AGENT); }
            arrived2 = true; }
    }
    if (!arrived2) { asm volatile("s_waitcnt vmcnt(0)" ::: "memory"); __syncthreads();
        if (threadIdx.x == 0) { __builtin_amdgcn_fence(__ATOMIC_RELEASE, "agent"); __hip_atomic_fetch_add(early_flag2, 1u, __ATOMIC_RELAXED, __HIP_MEMORY_SCOPE_AGENT); } }
    if (!arrived) { asm volatile("s_waitcnt vmcnt(0)" ::: "memory"); __syncthreads();
        if (threadIdx.x == 0) { __builtin_amdgcn_fence(__ATOMIC_RELEASE, "agent"); __hip_atomic_fetch_add(early_flag, 1u, __ATOMIC_RELAXED, __HIP_MEMORY_SCOPE_AGENT); } }
}

DI void phase_moba_prep(const Params& P, LAS unsigned char* lds, int wg0, int nwg) {
    const int tid = opq_tid(), lane = tid & 63, wave = tid >> 6, l16 = lane & 15;
    bf16_t* proj = (bf16_t*)(P.ws + WS_R1); float* kmean = (float*)(P.ws + WS_KMEAN);
    LAS bf16_t* VS = (LAS bf16_t*)lds; LAS float* CS = (LAS float*)(lds + 69632);
    for (int task = wg0; task < 1024; task += nwg) {
        const int h = task & 7, blk = (task >> 3) & 63, b = task >> 9; const size_t rbase = (size_t)(b * TT + blk * 256);
        f32x4 qg0 = *(const f32x4*)(P.q_norm + l16 * 8), qg1 = *(const f32x4*)(P.q_norm + l16 * 8 + 4), kg0 = *(const f32x4*)(P.k_norm + l16 * 8), kg1 = *(const f32x4*)(P.k_norm + l16 * 8 + 4);
        float cs[8];
#pragma unroll
        for (int i = 0; i < 8; ++i) cs[i] = 0.f;
        u32x4 rq[8], rk[8], rv[8];
#pragma unroll
        for (int ps = 0; ps < 8; ++ps) { const int r = ps * 32 + wave * 4 + (lane >> 4); const bf16_t* rp = proj + (rbase + r) * NPJ + h * 128 + l16 * 8;
            rq[ps] = *(const u32x4*)(rp + OFF_MQ); rk[ps] = *(const u32x4*)(rp + OFF_MK); rv[ps] = *(const u32x4*)(rp + OFF_MV); }
#pragma unroll
        for (int ps = 0; ps < 8; ++ps) { const int r = ps * 32 + wave * 4 + (lane >> 4); bf16_t* rp = proj + (rbase + r) * NPJ + h * 128 + l16 * 8;
#pragma unroll
            for (int x = 0; x < 2; ++x) { bf16_t* ptr = rp + (x == 0 ? OFF_MQ : OFF_MK); const u32x4 raw = x == 0 ? rq[ps] : rk[ps]; float v[8];
                v[0] = bflo(raw.x); v[1] = bfhi(raw.x); v[2] = bflo(raw.y); v[3] = bfhi(raw.y); v[4] = bflo(raw.z); v[5] = bfhi(raw.z); v[6] = bflo(raw.w); v[7] = bfhi(raw.w);
                float ss = 0.f;
#pragma unroll
                for (int i = 0; i < 8; ++i) ss += v[i] * v[i];
                ss = row16_sum(ss);
                const float rs = rsqrtf(ss * (1.f / 128.f) + 1e-6f); const f32x4 g0 = x == 0 ? qg0 : kg0, g1 = x == 0 ? qg1 : kg1;
#pragma unroll
                for (int i = 0; i < 4; ++i) { v[i] *= rs * g0[i]; v[4 + i] *= rs * g1[i]; }
                if (x == 1) {
#pragma unroll
                    for (int i = 0; i < 8; ++i) cs[i] += v[i]; }
                u32x4 w; w.x = pk2(v[0], v[1]); w.y = pk2(v[2], v[3]); w.z = pk2(v[4], v[5]); w.w = pk2(v[6], v[7]); *(u32x4*)ptr = w; }
            *(LAS u32x4*)(VS + r * 136 + l16 * 8) = rv[ps]; }
#pragma unroll
        for (int i = 0; i < 8; ++i) { cs[i] += __shfl_xor(cs[i], 16); cs[i] += __shfl_xor(cs[i], 32); }
        if (lane < 16) {
#pragma unroll
            for (int i = 0; i < 8; ++i) CS[wave * 128 + lane * 8 + i] = cs[i]; }
        __syncthreads();
        if (tid < 128) { float s = 0.f;
#pragma unroll
            for (int w = 0; w < 8; ++w) s += CS[w * 128 + tid];
            kmean[((size_t)(b * 8 + h) * 64 + blk) * 128 + tid] = s * (1.f / 256.f); }
#pragma unroll 2
        for (int i8 = 0; i8 < 8; ++i8) { const int pid = tid + i8 * 512, e = (pid & 63) + 64 * (pid >> 11), ks = (pid >> 6) & 31; unsigned short f[8];
#pragma unroll
            for (int i = 0; i < 8; ++i) f[i] = VS[(ks * 8 + i) * 136 + e];
            u32x4 w; w.x = f[0] | ((unsigned)f[1] << 16); w.y = f[2] | ((unsigned)f[3] << 16); w.z = f[4] | ((unsigned)f[5] << 16); w.w = f[6] | ((unsigned)f[7] << 16);
            *(u32x4*)(proj + (rbase + 2 * e + (ks >> 4)) * NPJ + OFF_MV + h * 128 + (ks & 15) * 8) = w; }
        __syncthreads();
    }
}

DI void phase_moba_select(const Params& P, LAS unsigned char* lds, int wg0, int nwg) {
    const int tid = opq_tid(), qi = tid >> 1, half = tid & 1;
    const bf16_t* proj = (const bf16_t*)(P.ws + WS_R1); const float* kmean = (const float*)(P.ws + WS_KMEAN);
    int* cnt = (int*)(P.ws + WS_CNT); int* list = (int*)(P.ws + WS_LIST); f32x2* ML = (f32x2*)(P.ws + WS_ML);
    LAS float* KM = (LAS float*)lds; LAS int* hist = (LAS int*)(lds + 32768); LAS int* hbase = (LAS int*)(lds + 32768 + 256);
    for (int task = wg0; task < 1024; task += nwg) {
        const int tk = task >> 8, tw_ = task & 255, bhx = (tw_ >> 6) * 4 + tk, blk = (tk & 1) ? 63 - (tw_ & 63) : (tw_ & 63), h = bhx & 7, b = bhx >> 3; const int bh = b * 8 + h; const int t = blk * 256 + qi; const size_t rid = (size_t)bh * TT + t;
        for (int i = tid; i < blk * 128; i += NTHREADS) KM[i] = kmean[(size_t)bh * 64 * 128 + i];
        if (tid < 64) hist[tid] = 0;
        float q[64];
        { const bf16_t* qp = proj + (size_t)(b * TT + t) * NPJ + OFF_MQ + h * 128 + half * 64;
#pragma unroll
          for (int i = 0; i < 8; ++i) { const u32x4 raw = *(const u32x4*)(qp + 8 * i); q[8 * i] = bflo(raw.x); q[8 * i + 1] = bfhi(raw.x); q[8 * i + 2] = bflo(raw.y); q[8 * i + 3] = bfhi(raw.y);
              q[8 * i + 4] = bflo(raw.z); q[8 * i + 5] = bfhi(raw.z); q[8 * i + 6] = bflo(raw.w); q[8 * i + 7] = bfhi(raw.w); } }
        __syncthreads();
        float v0 = -INFINITY, v1 = -INFINITY, v2 = -INFINITY; int i0 = -1, i1 = -1, i2 = -1;
        for (int n = 0; n < blk; ++n) { const LAS float* km = KM + n * 128 + half * 64; float d0 = 0.f, d1 = 0.f, d2 = 0.f, d3 = 0.f;
#pragma unroll
            for (int i = 0; i < 16; ++i) { const f32x4 kv = *(const LAS f32x4*)(km + 4 * i); d0 += q[4 * i] * kv[0]; d1 += q[4 * i + 1] * kv[1]; d2 += q[4 * i + 2] * kv[2]; d3 += q[4 * i + 3] * kv[3]; }
            float g = (d0 + d1) + (d2 + d3); g += __shfl_xor(g, 1);
            if (g > v0) { v2 = v1; i2 = i1; v1 = v0; i1 = i0; v0 = g; i0 = n; } else if (g > v1) { v2 = v1; i2 = i1; v1 = g; i1 = n; } else if (g > v2) { v2 = g; i2 = n; } }
        int rk0 = 0, rk1 = 0, rk2 = 0;
        if (half == 0) { if (i0 >= 0) rk0 = __hip_atomic_fetch_add(&hist[i0], 1, __ATOMIC_RELAXED, __HIP_MEMORY_SCOPE_WORKGROUP); if (i1 >= 0) rk1 = __hip_atomic_fetch_add(&hist[i1], 1, __ATOMIC_RELAXED, __HIP_MEMORY_SCOPE_WORKGROUP); if (i2 >= 0) rk2 = __hip_atomic_fetch_add(&hist[i2], 1, __ATOMIC_RELAXED, __HIP_MEMORY_SCOPE_WORKGROUP); }
        __syncthreads();
        if (tid < 64) { const int c = hist[tid]; hbase[tid] = c > 0 ? atomicAdd(&cnt[bh * 64 + tid], c) : 0; }
        __syncthreads();
        if (half == 0) {
            const f32x2 dead = {-INFINITY, 0.f};
            if (i0 >= 0) list[(size_t)bh * LISTN + i0 * 16384 - 128 * i0 * (i0 + 1) + hbase[i0] + rk0] = t; else ML[0 * 262144 + rid] = dead;
            if (i1 >= 0) list[(size_t)bh * LISTN + i1 * 16384 - 128 * i1 * (i1 + 1) + hbase[i1] + rk1] = t | (1 << 14); else ML[1 * 262144 + rid] = dead;
            if (i2 >= 0) list[(size_t)bh * LISTN + i2 * 16384 - 128 * i2 * (i2 + 1) + hbase[i2] + rk2] = t | (2 << 14); else ML[2 * 262144 + rid] = dead;
        }
        __syncthreads();
    }
}

constexpr int G2_W = 0, G2_Q = 18432, G2_QK = 36864, G2_KD = 47104, G2_BUF = 67584, G2_RED = 135168;
DI void phase_gdn_scan(const Params& P, LAS unsigned char* lds, int bh, const unsigned* flag, unsigned need, int n_first) {
    const int tid = opq_tid(), lane = tid & 63, w = tid >> 6, fr = lane & 15, fq = lane >> 4, b = bh >> 3, h = bh & 7;
    const bf16_t* proj = (const bf16_t*)(P.ws + WS_R1); const bf16_t* W2 = (const bf16_t*)(P.ws + WS_W2); const bf16_t* QKB = (const bf16_t*)(P.ws + WS_QKB);
    const float* GL = (const float*)(P.ws + WS_GL); bf16_t* mix = (bf16_t*)(P.ws + WS_R2);
    float* SSQ = (float*)(P.ws + WS_SSQ);
    const int e = 16 * w + fr; const float gnw = P.gdn_norm[e];
    f32x4 S[8];
#pragma unroll
    for (int i = 0; i < 8; ++i) S[i] = (f32x4){0.f, 0.f, 0.f, 0.f};
    const int wrow0 = tid >> 4, wseg = tid & 15;
    const int qrow = tid >> 3, qseg = tid & 7;
    struct Stage { u32x4 sw[2], sq[2], sqk, skd[2]; };
    u32x2 un[4];
    Stage stA, stB;
#define G2_LOAD(X, nn) do { const int t0_ = b * TT + (nn) * 64; const int ci_ = ((b * 256 + (nn)) << 3) + h; \
        _Pragma("unroll") for (int i_ = 0; i_ < 2; ++i_) { X.sw[i_] = *(const u32x4*)(W2 + (size_t)(t0_ + wrow0 + 32 * i_) * 1024 + h * 128 + wseg * 8); \
            X.sq[i_] = *(const u32x4*)(proj + (size_t)(t0_ + wrow0 + 32 * i_) * NPJ + OFF_GQ + h * 128 + wseg * 8); \
            const int d_ = qrow + 64 * i_; X.skd[i_] = *(const u32x4*)(proj + (size_t)(t0_ + (d_ >> 1)) * NPJ + OFF_GK + h * 128 + (d_ & 1) * 64 + qseg * 8); } \
        X.sqk = *(const u32x4*)(QKB + (size_t)ci_ * 4096 + qrow * 64 + qseg * 8); } while (0)
#define UN_LOAD(nn) do { const int t0_ = b * TT + (nn) * 64; _Pragma("unroll") for (int mt_ = 0; mt_ < 4; ++mt_) un[mt_] = *(const u32x2*)(proj + (size_t)(t0_ + (e >> 1)) * NPJ + OFF_GV + h * 128 + (e & 1) * 64 + 16 * mt_ + 4 * fq); } while (0)
#define G2_ST2(base_, rowoff_, sg_, v_) do { const int g_ = ((sg_) >> 2) * 64, d_ = ((sg_) & 3) * 8; \
        *(LAS u32x2*)(B_ + (base_) + (rowoff_) + g_ + perm4(d_) * 2) = (u32x2){(v_).x, (v_).y}; *(LAS u32x2*)(B_ + (base_) + (rowoff_) + g_ + perm4(d_ + 4) * 2) = (u32x2){(v_).z, (v_).w}; } while (0)
#define G2_STORE(X, bufi) do { LAS unsigned char* B_ = lds + (bufi) * G2_BUF; \
        _Pragma("unroll") for (int i_ = 0; i_ < 2; ++i_) { G2_ST2(G2_W, (wrow0 + 32 * i_) * 288, wseg, X.sw[i_]); G2_ST2(G2_Q, (wrow0 + 32 * i_) * 288, wseg, X.sq[i_]); \
            G2_ST2(G2_KD, (qrow + 64 * i_) * 160, qseg, X.skd[i_]); } \
        G2_ST2(G2_QK, qrow * 160, qseg, X.sqk); } while (0)
    G2_LOAD(stA, 0); G2_STORE(stA, 0); UN_LOAD(0);
    float egl_n = GL[bh * 256];
    u32x2 uc[4];
#pragma unroll
    for (int i = 0; i < 4; ++i) uc[i] = un[i];
    G2_LOAD(stA, 1);
    __syncthreads();
    for (int n2 = 0; n2 < 256; n2 += 2) {
#pragma unroll
      for (int hf2 = 0; hf2 < 2; ++hf2) {
        const int n = n2 + hf2; Stage& LDs = hf2 ? stA : stB; Stage& STs = hf2 ? stB : stA;
        if (n == n_first - 2 || n == 62 || n == 126) {
            const unsigned* fl = (n == 126) ? flag + 1 : (n == 62 ? flag : flag + 2);
            if (tid == 0) { while (__hip_atomic_load(fl, __ATOMIC_RELAXED, __HIP_MEMORY_SCOPE_AGENT) < need) __builtin_amdgcn_s_sleep(8);
                __builtin_amdgcn_fence(__ATOMIC_ACQUIRE, "agent"); asm volatile("s_waitcnt vmcnt(0)" ::: "memory"); }
            __syncthreads(); }
        const int cur = hf2, t0 = b * TT + n * 64; LAS unsigned char* Bf = lds + cur * G2_BUF;
        { const int n2c = n + 2 < 256 ? n + 2 : 255, n1c = n + 1 < 256 ? n + 1 : 255; G2_LOAD(LDs, n2c); UN_LOAD(n1c); }
        const float egl = egl_n; egl_n = GL[bh * 256 + (n + 1 < 256 ? n + 1 : 255)];
        f32x4 Pm[4], Om[4];
#pragma unroll
        for (int mt = 0; mt < 4; ++mt) { Pm[mt] = (f32x4){0.f, 0.f, 0.f, 0.f}; Om[mt] = (f32x4){0.f, 0.f, 0.f, 0.f}; }
#define SBAR __builtin_amdgcn_sched_barrier(0)
#define LD_K4(dst, base_, ks_) do { const int o0_ = fr * 288 + (32 * (ks_) + 8 * fq) * 2; \
        dst[0] = *(const LAS bf16x8*)(Bf + base_ + o0_); dst[1] = *(const LAS bf16x8*)(Bf + base_ + o0_ + 4608); \
        dst[2] = *(const LAS bf16x8*)(Bf + base_ + o0_ + 9216); dst[3] = *(const LAS bf16x8*)(Bf + base_ + o0_ + 13824); } while (0)
#define MM_K4(src, sb_, A_) do { A_[0] = mfma16(src[0], sb_, A_[0]); A_[1] = mfma16(src[1], sb_, A_[1]); A_[2] = mfma16(src[2], sb_, A_[2]); A_[3] = mfma16(src[3], sb_, A_[3]); } while (0)
#define LD_R4(dst, base_, r0_, k2_) do { const int o0_ = (16 * (r0_) + fr) * 160 + (32 * (k2_) + 8 * fq) * 2; \
        dst[0] = *(const LAS bf16x8*)(Bf + base_ + o0_); dst[1] = *(const LAS bf16x8*)(Bf + base_ + o0_ + 2560); \
        dst[2] = *(const LAS bf16x8*)(Bf + base_ + o0_ + 5120); dst[3] = *(const LAS bf16x8*)(Bf + base_ + o0_ + 7680); } while (0)
#define MM_R4(src, vb_, A0_, A1_, A2_, A3_) do { A0_ = mfma16(src[0], vb_, A0_); A1_ = mfma16(src[1], vb_, A1_); A2_ = mfma16(src[2], vb_, A2_); A3_ = mfma16(src[3], vb_, A3_); } while (0)
        bf16x8 fa[4], fb[4];
        LD_K4(fa, G2_W, 0);
        const bf16x8 sb0 = pack8(S[0], S[1]), sb1 = pack8(S[2], S[3]), sb2 = pack8(S[4], S[5]), sb3 = pack8(S[6], S[7]);
        LD_K4(fb, G2_W, 1); SBAR; MM_K4(fa, sb0, Pm); SBAR;
        LD_K4(fa, G2_W, 2); SBAR; MM_K4(fb, sb1, Pm); SBAR;
        LD_K4(fb, G2_W, 3); SBAR; MM_K4(fa, sb2, Pm); SBAR;
        LD_K4(fa, G2_Q, 0); SBAR; MM_K4(fb, sb3, Pm); SBAR;
        f32x4 vn[4];
#pragma unroll
        for (int mt = 0; mt < 4; ++mt) { vn[mt][0] = bflo(uc[mt].x) - Pm[mt][0]; vn[mt][1] = bfhi(uc[mt].x) - Pm[mt][1]; vn[mt][2] = bflo(uc[mt].y) - Pm[mt][2]; vn[mt][3] = bfhi(uc[mt].y) - Pm[mt][3]; }
        bf16x8 Vb[2];
#pragma unroll
        for (int k2 = 0; k2 < 2; ++k2) Vb[k2] = pack8(vn[2 * k2], vn[2 * k2 + 1]);
        LD_K4(fb, G2_Q, 1); SBAR; MM_K4(fa, sb0, Om); SBAR;
        LD_K4(fa, G2_Q, 2); SBAR; MM_K4(fb, sb1, Om); SBAR;
        LD_K4(fb, G2_Q, 3); SBAR; MM_K4(fa, sb2, Om); SBAR;
        LD_R4(fa, G2_QK, 0, 0); SBAR; MM_K4(fb, sb3, Om); SBAR;
#pragma unroll
        for (int dt = 0; dt < 8; ++dt) S[dt] = S[dt] * egl;
        SBAR;
        LD_R4(fb, G2_QK, 0, 1); SBAR; MM_R4(fa, Vb[0], Om[0], Om[1], Om[2], Om[3]); SBAR;
        LD_R4(fa, G2_KD, 0, 0); SBAR; MM_R4(fb, Vb[1], Om[0], Om[1], Om[2], Om[3]); SBAR;
        LD_R4(fb, G2_KD, 0, 1); SBAR; MM_R4(fa, Vb[0], S[0], S[1], S[2], S[3]); SBAR;
        LD_R4(fa, G2_KD, 4, 0); SBAR; MM_R4(fb, Vb[1], S[0], S[1], S[2], S[3]); SBAR;
        LD_R4(fb, G2_KD, 4, 1); SBAR; MM_R4(fa, Vb[0], S[4], S[5], S[6], S[7]); SBAR;
        MM_R4(fb, Vb[1], S[4], S[5], S[6], S[7]); SBAR;
#undef LD_K4
#undef MM_K4
#undef LD_R4
#undef MM_R4
#undef SBAR
        { G2_STORE(STs, cur ^ 1);
#pragma unroll
            for (int i = 0; i < 4; ++i) uc[i] = un[i]; }
        { LAS bf16_t* OTW = (LAS bf16_t*)(lds + G2_RED + w * 2048);
#pragma unroll
          for (int mt = 0; mt < 4; ++mt)
#pragma unroll
            for (int j = 0; j < 4; ++j) OTW[(16 * mt + 4 * fq + j) * 16 + fr] = f2bf(Om[mt][j]);
#pragma unroll
          for (int i = 0; i < 2; ++i) { const int row = (lane >> 1) + 32 * i, hv = lane & 1;
              bf16_t* mp_ = mix + (size_t)(t0 + row) * DM + h * 128 + 16 * w + 8 * hv; const u32x4 ov_ = *(const LAS u32x4*)(OTW + row * 16 + hv * 8);
              asm volatile("global_store_dwordx4 %0, %1, off" :: "v"(mp_), "v"(ov_) : "memory"); } }
        __syncthreads();
      }
    }
#undef G2_LOAD
#undef UN_LOAD
#undef G2_STORE
#undef G2_ST2
    asm volatile("s_waitcnt vmcnt(0)" ::: "memory");
    __syncthreads();
}

constexpr int AT_KS = 0, AT_VT = 73728, AT_PF = 143360, AT_MISC = 147712;
DI void phase_moba_attn(const Params& P, LAS unsigned char* lds) {
    const int tid = opq_tid(), lane = tid & 63, w = tid >> 6, fr = lane & 15, fq = lane >> 4;
    const bf16_t* proj = (const bf16_t*)(P.ws + WS_R1); const int* cnt = (const int*)(P.ws + WS_CNT); const int* list = (const int*)(P.ws + WS_LIST);
    f32x2* ML = (f32x2*)(P.ws + WS_ML); bf16_t* opart = (bf16_t*)P.out; unsigned* workctr = (unsigned*)(P.ws + WS_CTL);
    LAS bf16_t* KS = (LAS bf16_t*)(lds + AT_KS); LAS bf16_t* VT = (LAS bf16_t*)(lds + AT_VT); LAS int* PF = (LAS int*)(lds + AT_PF); LAS int* MISC = (LAS int*)(lds + AT_MISC);
    { const int c0 = cnt[2 * tid], c1 = cnt[2 * tid + 1]; const int a = (c0 + 511) >> 9, bsum = a + ((c1 + 511) >> 9); int inc = bsum;
#pragma unroll
      for (int o = 1; o < 64; o <<= 1) { const int v = __shfl_up(inc, o); if (lane >= o) inc += v; }
      if (lane == 63) MISC[8 + w] = inc;
      __syncthreads();
      int wb = 0;
#pragma unroll
      for (int i = 0; i < 8; ++i) wb += (i < w) ? MISC[8 + i] : 0;
      const int ex = wb + inc - bsum; PF[2 * tid] = ex; PF[2 * tid + 1] = ex + a; if (tid == 511) PF[1024] = ex + bsum;
      __syncthreads(); }
    const int totalG = PF[1024];
    const float sc2 = 0.08838834764831845f * 1.4426950408889634f;
    const int tid_at = tid;
    for (;;) {
        int tid = tid_at; asm volatile("" : "+v"(tid)); const int lane = tid & 63, w = __builtin_amdgcn_readfirstlane(tid >> 6), fr = lane & 15, fq = lane >> 4;
        if (tid == 0) MISC[0] = (int)atomicAdd(workctr, 1u);
        __syncthreads();
        const int wid = MISC[0];
        __syncthreads();
        if (wid >= totalG + 1024) break;
        int bh, j, causal, qstart, qcount;
        if (wid < totalG) { int lo = 0, hi = 1024; while (hi - lo > 1) { const int mid = (lo + hi) >> 1; if (PF[mid] <= wid) lo = mid; else hi = mid; }
            bh = lo >> 6; j = lo & 63; causal = 0; qstart = (wid - PF[lo]) * 512; const int c = cnt[lo]; qcount = c - qstart; if (qcount > 512) qcount = 512; }
        else { const int o = wid - totalG; bh = o >> 6; j = o & 63; causal = 1; qstart = 0; qcount = 256; }
        const int b = bh >> 3, h = bh & 7; const size_t kbase = (size_t)(b * TT + j * 256);
        { u32x4 kr[8], vr[8];
#pragma unroll
          for (int i8 = 0; i8 < 8; ++i8) { const int pid = tid + i8 * 512; kr[i8] = *(const u32x4*)(proj + (kbase + (pid >> 4)) * NPJ + OFF_MK + h * 128 + (pid & 15) * 8);
              const int e = pid >> 5, ks = pid & 31; vr[i8] = *(const u32x4*)(proj + (kbase + 2 * e + (ks >> 4)) * NPJ + OFF_MV + h * 128 + (ks & 15) * 8); }
#pragma unroll
          for (int i8 = 0; i8 < 8; ++i8) { const int pid = tid + i8 * 512; *(LAS u32x4*)(KS + (pid >> 4) * 144 + (pid & 15) * 8) = kr[i8];
              const int e = pid >> 5, ks = pid & 31; const int g_ = (ks >> 2) * 32, d_ = (ks & 3) * 8;
              *(LAS u32x2*)(VT + e * 272 + g_ + perm4(d_)) = (u32x2){vr[i8].x, vr[i8].y}; *(LAS u32x2*)(VT + e * 272 + g_ + perm4(d_ + 4)) = (u32x2){vr[i8].z, vr[i8].w}; } }
        const int lbase = bh * LISTN + j * 16384 - 128 * j * (j + 1) + qstart;
        const int ntile = (qcount + 127) >> 7;
        int en0, en1, en2, en3;
        { const int q0 = 16 * w + fr, lim = qcount - 1;
          if (causal) { en0 = (j * 256 + q0) | (3 << 14); en1 = (j * 256 + q0 + 128) | (3 << 14); en2 = en1; en3 = en1; }
          else { en0 = list[lbase + (q0 < lim ? q0 : lim)]; en1 = list[lbase + (q0 + 128 < lim ? q0 + 128 : lim)]; en2 = list[lbase + (q0 + 256 < lim ? q0 + 256 : lim)]; en3 = list[lbase + (q0 + 384 < lim ? q0 + 384 : lim)]; } }
        bf16x8 Bq[4], Bn[4];
        { const bf16_t* qp = proj + (size_t)(b * TT + (en0 & 16383)) * NPJ + OFF_MQ + h * 128 + 8 * fq;
#pragma unroll
          for (int ks = 0; ks < 4; ++ks) Bq[ks] = *(const bf16x8*)(qp + 32 * ks); }
        __syncthreads();
        for (int tile = 0; tile < ntile; ++tile) {
            const int en = tile == 0 ? en0 : (tile == 1 ? en1 : (tile == 2 ? en2 : en3));
            { const int enx = tile == 0 ? en1 : (tile == 1 ? en2 : en3); const bf16_t* qp = proj + (size_t)(b * TT + (enx & 16383)) * NPJ + OFF_MQ + h * 128 + 8 * fq;
#pragma unroll
              for (int ks = 0; ks < 4; ++ks) Bn[ks] = *(const bf16x8*)(qp + 32 * ks); }
            const int qi = tile * 128 + 16 * w + fr; const bool valid = qi < qcount; const int t = en & 16383, slot = en >> 14;
            if (tile * 128 + 16 * w < qcount) {
            const int nkt = causal ? (8 * tile + w + 1) : 16;
            f32x4 st[16]; float mx = -INFINITY;
#pragma unroll
            for (int kp = 0; kp < 8; ++kp) { f32x4 a0 = {0.f, 0.f, 0.f, 0.f}, a1 = {0.f, 0.f, 0.f, 0.f};
                if (2 * kp < nkt) { bf16x8 kf[8];
#pragma unroll
                    for (int ks = 0; ks < 4; ++ks) { kf[ks] = *(const LAS bf16x8*)(KS + (32 * kp + fr) * 144 + 32 * ks + 8 * fq); kf[4 + ks] = *(const LAS bf16x8*)(KS + (32 * kp + 16 + fr) * 144 + 32 * ks + 8 * fq); }
#pragma unroll
                    for (int ks = 0; ks < 4; ++ks) { a0 = mfma16(kf[ks], Bq[ks], a0); a1 = mfma16(kf[4 + ks], Bq[ks], a1); }
#pragma unroll
                    for (int jj = 0; jj < 4; ++jj) { float s0 = a0[jj] * sc2, s1 = a1[jj] * sc2;
                        if (causal && (32 * kp + 4 * fq + jj) > qi) s0 = -INFINITY; if ((causal && (32 * kp + 16 + 4 * fq + jj) > qi) || 2 * kp + 1 >= nkt) s1 = -INFINITY;
                        a0[jj] = s0; a1[jj] = s1; mx = fmaxf(mx, fmaxf(s0, s1)); }
                } else { a0 = (f32x4){-INFINITY, -INFINITY, -INFINITY, -INFINITY}; a1 = a0; }
                st[2 * kp] = a0; st[2 * kp + 1] = a1; }
            mx = fmaxf(mx, __shfl_xor(mx, 16)); mx = fmaxf(mx, __shfl_xor(mx, 32));
            float ls = 0.f;
#pragma unroll
            for (int kt = 0; kt < 16; ++kt)
#pragma unroll
                for (int jj = 0; jj < 4; ++jj) { const float pv = exp2f(st[kt][jj] - mx); st[kt][jj] = pv; ls += pv; }
            ls += __shfl_xor(ls, 16); ls += __shfl_xor(ls, 32);
            f32x4 ot[8];
#pragma unroll
            for (int et = 0; et < 8; ++et) ot[et] = (f32x4){0.f, 0.f, 0.f, 0.f};
#pragma unroll
            for (int k2 = 0; k2 < 8; ++k2) { if (2 * k2 < nkt) { const bf16x8 pb = pack8(st[2 * k2], st[2 * k2 + 1]);
#pragma unroll
                    for (int eh = 0; eh < 2; ++eh) { bf16x8 vf[4];
#pragma unroll
                        for (int et = 0; et < 4; ++et) vf[et] = *(const LAS bf16x8*)(VT + (16 * (4 * eh + et) + fr) * 272 + 32 * k2 + 8 * fq);
#pragma unroll
                        for (int et = 0; et < 4; ++et) ot[4 * eh + et] = mfma16(vf[et], pb, ot[4 * eh + et]); } } }
            if (valid) { const float il = 1.f / ls; const size_t rid = (size_t)bh * TT + t; bf16_t* op = opart + ((size_t)slot * 262144 + rid) * 128 + 4 * fq;
#pragma unroll
                for (int et = 0; et < 8; ++et) { u32x2 wv; wv.x = pk2(ot[et][0] * il, ot[et][1] * il); wv.y = pk2(ot[et][2] * il, ot[et][3] * il); *(u32x2*)(op + 16 * et) = wv; }
                if (fq == 0) ML[(size_t)slot * 262144 + rid] = (f32x2){mx, ls}; }
            }
#pragma unroll
            for (int ks = 0; ks < 4; ++ks) Bq[ks] = Bn[ks];
        }
        __syncthreads();
    }
}

DI void phase_moba_combine(const Params& P, bool do_gate, bool do_moba, int wg0, int nwg) {
    const bf16_t* opart = (const bf16_t*)P.out; const f32x2* ML = (const f32x2*)(P.ws + WS_ML); bf16_t* mix = (bf16_t*)(P.ws + WS_R2);
    const int gtid = wg0 * NTHREADS + opq_tid(), gsz = nwg * NTHREADS;
    if (do_gate) { const bf16_t* proj = (const bf16_t*)(P.ws + WS_R1);
      for (int i0 = gtid; i0 < MT * 128; i0 += 4 * gsz) { u32x4 mv[4], zv[4];
#pragma unroll
          for (int k = 0; k < 4; ++k) { const int i = i0 + k * gsz < MT * 128 ? i0 + k * gsz : i0; const int row = i >> 7, sg = i & 127; mv[k] = *(const u32x4*)(mix + (size_t)row * DM + sg * 8); zv[k] = *(const u32x4*)(proj + (size_t)row * NPJ + OFF_GZ + sg * 8); }
          const int sg0 = i0 & 127; const f32x4 g0 = *(const f32x4*)(P.gdn_norm + (sg0 & 15) * 8), g1 = *(const f32x4*)(P.gdn_norm + (sg0 & 15) * 8 + 4);
#pragma unroll
          for (int k = 0; k < 4; ++k) { const int i = i0 + k * gsz; const int row = i >> 7, sg = i & 127;
              float o[8]; o[0] = bflo(mv[k].x); o[1] = bfhi(mv[k].x); o[2] = bflo(mv[k].y); o[3] = bfhi(mv[k].y); o[4] = bflo(mv[k].z); o[5] = bfhi(mv[k].z); o[6] = bflo(mv[k].w); o[7] = bfhi(mv[k].w);
              float ssl = 0.f;
#pragma unroll
              for (int q = 0; q < 8; ++q) ssl += o[q] * o[q];
              const float rs = rsqrtf(row16_sum(ssl) * (1.f / 128.f) + 1e-6f); const u32x4 z = zv[k];
              u32x4 wv; wv.x = pk2(o[0] * rs * g0[0] * silu_f(bflo(z.x)), o[1] * rs * g0[1] * silu_f(bfhi(z.x))); wv.y = pk2(o[2] * rs * g0[2] * silu_f(bflo(z.y)), o[3] * rs * g0[3] * silu_f(bfhi(z.y)));
              wv.z = pk2(o[4] * rs * g1[0] * silu_f(bflo(z.z)), o[5] * rs * g1[1] * silu_f(bfhi(z.z))); wv.w = pk2(o[6] * rs * g1[2] * silu_f(bflo(z.w)), o[7] * rs * g1[3] * silu_f(bfhi(z.w)));
              if (i < MT * 128) *(u32x4*)(mix + (size_t)row * DM + sg * 8) = wv; } } }
    if (do_moba) for (int i0 = gtid; i0 < 262144 * 16; i0 += 2 * gsz) {
        f32x2 ml[2][4]; u32x4 raw[2][4];
#pragma unroll
        for (int k = 0; k < 2; ++k) { const int i = i0 + k * gsz < 262144 * 16 ? i0 + k * gsz : i0; const int rid = i >> 4, sg = i & 15;
#pragma unroll
            for (int s = 0; s < 4; ++s) { ml[k][s] = ML[(size_t)s * 262144 + rid]; raw[k][s] = *(const u32x4*)(opart + ((size_t)s * 262144 + rid) * 128 + sg * 8); } }
#pragma unroll
        for (int k = 0; k < 2; ++k) { const int i = i0 + k * gsz; const int rid = i >> 4, sg = i & 15; const int bh = rid >> 14, t = rid & 16383, b = bh >> 3, h = bh & 7;
            float M = -INFINITY;
#pragma unroll
            for (int s = 0; s < 4; ++s) M = fmaxf(M, ml[k][s].x);
            float wgt[4], Lt = 0.f;
#pragma unroll
            for (int s = 0; s < 4; ++s) { wgt[s] = ml[k][s].y > 0.f ? ml[k][s].y * exp2f(ml[k][s].x - M) : 0.f; Lt += wgt[s]; }
            const float iL = 1.f / Lt; float o[8];
#pragma unroll
            for (int q = 0; q < 8; ++q) o[q] = 0.f;
#pragma unroll
            for (int s = 0; s < 4; ++s) { const float ww = wgt[s] * iL; const u32x4 r = raw[k][s];
                if (wgt[s] > 0.f) { o[0] += ww * bflo(r.x); o[1] += ww * bfhi(r.x); o[2] += ww * bflo(r.y); o[3] += ww * bfhi(r.y); o[4] += ww * bflo(r.z); o[5] += ww * bfhi(r.z); o[6] += ww * bflo(r.w); o[7] += ww * bfhi(r.w); } }
            u32x4 wv; wv.x = pk2(o[0], o[1]); wv.y = pk2(o[2], o[3]); wv.z = pk2(o[4], o[5]); wv.w = pk2(o[6], o[7]);
            if (i < 262144 * 16) *(u32x4*)(mix + (size_t)(b * TT + t) * DM + 1024 + h * 128 + sg * 8) = wv; } }
}

DI void sub_barrier(unsigned* ctr, unsigned nwg) {
    asm volatile("s_waitcnt vmcnt(0)" ::: "memory");
    __syncthreads();
    if (threadIdx.x == 0) {
        __builtin_amdgcn_fence(__ATOMIC_RELEASE, "agent");
        __hip_atomic_fetch_add(ctr, 1u, __ATOMIC_RELAXED, __HIP_MEMORY_SCOPE_AGENT);
        while (__hip_atomic_load(ctr, __ATOMIC_RELAXED, __HIP_MEMORY_SCOPE_AGENT) < nwg) __builtin_amdgcn_s_sleep(8);
        __builtin_amdgcn_fence(__ATOMIC_ACQUIRE, "agent");
        asm volatile("s_waitcnt vmcnt(0)" ::: "memory");
    }
    __syncthreads();
}

__global__ void __launch_bounds__(NTHREADS) hybrid_fwd(Params P) {
    extern __shared__ __attribute__((aligned(16))) unsigned char smem[];
    LAS unsigned char* lds = (LAS unsigned char*)smem;
    cg::grid_group grid = cg::this_grid();
    unsigned char* ws = P.ws; const int G = gridDim.x, bx = blockIdx.x;
    bf16_t* R0 = (bf16_t*)(ws + WS_R0); bf16_t* R1 = (bf16_t*)(ws + WS_R1); bf16_t* R2 = (bf16_t*)(ws + WS_R2);
    float* ss1 = (float*)(ws + WS_SS1); float* ss2 = (float*)(ws + WS_SS2);

    phase_prep(P, lds);
    grid.sync();
    { pg8::Gemm g{R0, (const bf16_t*)(ws + WS_WIN), MT, NPJ, DM}; pg8::StaticOrder S; S.init(MT, NPJ, G, bx); EpiProj E{R1, (bf16_t*)(ws + WS_HALO)}; pg8::gemm_phase<decltype(E), pg8::StaticOrder, true, true>(lds, g, S, E); }
    phase_ba(P);
    grid.sync();
    phase_gdn_prep(P, lds, 0, 32, bx, G);
    grid.sync();
    if (bx < 16) phase_gdn_scan(P, lds, bx, (const unsigned*)(ws + WS_CTL) + 11, (unsigned)(G - 16), 32);
    else { unsigned* ctl = (unsigned*)(ws + WS_CTL);
        phase_gdn_prep(P, lds, 32, 224, bx - 16, G - 16, ctl + 11, 768, ctl + 13, 256);
        asm volatile("s_waitcnt vmcnt(0)" ::: "memory"); __syncthreads();
        if (threadIdx.x == 0) { __builtin_amdgcn_fence(__ATOMIC_RELEASE, "agent"); __hip_atomic_fetch_add(ctl + 12, 1u, __ATOMIC_RELAXED, __HIP_MEMORY_SCOPE_AGENT); }
        phase_moba_prep(P, lds, bx - 16, G - 16); sub_barrier(ctl + 8, (unsigned)(G - 16));
        phase_moba_select(P, lds, bx - 16, G - 16); sub_barrier(ctl + 9, (unsigned)(G - 16));
        phase_moba_attn(P, lds);
        phase_wconv_late(P, lds, bx - 16, G - 16);
        sub_barrier(ctl + 10, (unsigned)(G - 16)); phase_moba_combine(P, false, true, bx - 16, G - 16); }
    grid.sync();
    phase_moba_combine(P, true, false, bx, G);
    grid.sync();
    { pg8::Gemm g{R2, (const bf16_t*)(ws + WS_WO), MT, DM, DM}; pg8::StaticOrder S; S.init(MT, DM, G, bx); EpiResid E{P.x, P.out, R0, ss1}; pg8::gemm_phase<decltype(E), pg8::StaticOrder, true, false>(lds, g, S, E); }
    grid.sync();
    { pg8::Gemm g{R0, (const bf16_t*)(ws + WS_WGU), MT, 2 * FF, DM}; pg8::StaticOrder S; S.init(MT, 2 * FF, G, bx); EpiAct E{R1, ss1}; pg8::gemm_phase<decltype(E), pg8::StaticOrder, true, true>(lds, g, S, E); }
    grid.sync();
    { pg8::Gemm g{(const bf16_t*)(ws + WS_PB), (const bf16_t*)(ws + WS_WPP), MT, DM, 256}; pg8::StaticOrder S; S.init(MT, DM, G, bx); EpiPlainBf16 E{R0, DM}; pg8::gemm_phase<decltype(E), pg8::StaticOrder, true, false>(lds, g, S, E); }
    { pg8::Gemm g{R1, (const bf16_t*)(ws + WS_WDN), MT, DM, FF}; pg8::StaticOrder S; S.init(MT, DM, G, bx); EpiResid E{P.out, P.out, R2, ss2}; pg8::gemm_phase<decltype(E), pg8::StaticOrder, true, false>(lds, g, S, E); }
    grid.sync();
    { pg8::Gemm g{R2, (const bf16_t*)(ws + WS_WPG), MT, DM, DM}; pg8::StaticOrder S; S.init(MT, DM, G, bx); EpiOut E{P.out, R0, ss2}; pg8::gemm_phase<decltype(E), pg8::StaticOrder, true, false>(lds, g, S, E); }
}

extern "C" void kernel_launch(void* const* d_in, const int* in_sizes, int n_in, void* d_out, int out_size, void* d_ws, size_t ws_size, hipStream_t stream) {
    static int grid_blocks = 0;
    if (!grid_blocks) {
        int dev = 0, cus = 0, per_cu = 0;
        hipGetDevice(&dev);
        hipDeviceGetAttribute(&cus, hipDeviceAttributeMultiprocessorCount, dev);
        hipFuncSetAttribute((const void*)hybrid_fwd, hipFuncAttributeMaxDynamicSharedMemorySize, LDS_BYTES);
        hipOccupancyMaxActiveBlocksPerMultiprocessor(&per_cu, (const void*)hybrid_fwd, NTHREADS, LDS_BYTES);
        if (per_cu < 1) per_cu = 1;
        grid_blocks = cus * per_cu;
        if (ws_size < WS_END) fprintf(stderr, "kernel_launch: workspace too small: %zu < %zu\n", ws_size, (size_t)WS_END);
    }
    Params p{};
    p.x = (const float*)d_in[0]; p.p = (const float*)d_in[1]; p.attn_norm = (const float*)d_in[2]; p.w_in = (const float*)d_in[3]; p.conv_w = (const float*)d_in[4];
    p.A_log = (const float*)d_in[5]; p.dt_bias = (const float*)d_in[6]; p.gdn_norm = (const float*)d_in[7]; p.q_norm = (const float*)d_in[8]; p.k_norm = (const float*)d_in[9];
    p.w_o = (const float*)d_in[10]; p.ffn_norm = (const float*)d_in[11]; p.w_gate = (const float*)d_in[12]; p.w_up = (const float*)d_in[13]; p.w_down = (const float*)d_in[14];
    p.ple_norm = (const float*)d_in[15]; p.w_pg = (const float*)d_in[16]; p.w_pp = (const float*)d_in[17];
    p.out = (float*)d_out; p.ws = (unsigned char*)d_ws;
    void* args[] = {&p};
    hipError_t e = hipLaunchCooperativeKernel((const void*)hybrid_fwd, dim3(grid_blocks), dim3(NTHREADS), args, LDS_BYTES, stream);
    if (e != hipSuccess) fprintf(stderr, "cooperative launch failed: %s (grid %d)\n", hipGetErrorString(e), grid_blocks);
}
```

```cpp
#include <hip/hip_runtime.h>
#include <hip/hip_cooperative_groups.h>
#include <cstdio>
namespace cg = cooperative_groups;

#define LAS __attribute__((address_space(3)))
#define DI __device__ __forceinline__
typedef unsigned short bf16_t;
typedef short bf16x8 __attribute__((ext_vector_type(8)));
typedef float f32x4 __attribute__((ext_vector_type(4)));
typedef float f32x2 __attribute__((ext_vector_type(2)));
typedef unsigned u32x4 __attribute__((ext_vector_type(4)));
typedef unsigned u32x2 __attribute__((ext_vector_type(2)));
typedef __bf16 bfv2 __attribute__((ext_vector_type(2)));

constexpr int DM = 2048, TT = 16384, MT = 32768, NPJ = 7168, FF = 5632, INW = 7184;
constexpr int OFF_GQ = 0, OFF_GK = 1024, OFF_GV = 2048, OFF_GZ = 3072, OFF_MQ = 4096, OFF_MK = 5120, OFF_MV = 6144;
constexpr int LISTN = 516096;
constexpr int NTHREADS = 512;
constexpr int LDS_BYTES = 163840;

constexpr size_t WS_CTL   = 0;
constexpr size_t WS_CNT   = 4096;
constexpr size_t WS_SS1   = 8192;
constexpr size_t WS_SS2   = WS_SS1 + 131072;
constexpr size_t WS_GL    = WS_SS2 + 131072;
constexpr size_t WS_KMEAN = WS_GL + 16384;
constexpr size_t WS_WBA   = WS_KMEAN + 524288;
constexpr size_t WS_BA    = WS_WBA + 65536;
constexpr size_t WS_WIN   = WS_BA + 2097152;
constexpr size_t WS_WO    = WS_WIN + (size_t)7168 * 2048 * 2;
constexpr size_t WS_WGU   = WS_WO + (size_t)2048 * 2048 * 2;
constexpr size_t WS_WDN   = WS_WGU + (size_t)11264 * 2048 * 2;
constexpr size_t WS_WPG   = WS_WDN + (size_t)2048 * 5632 * 2;
constexpr size_t WS_WPP   = WS_WPG + (size_t)2048 * 2048 * 2;
constexpr size_t WS_PB    = WS_WPP + (size_t)2048 * 256 * 2;
constexpr size_t WS_R0    = WS_PB + (size_t)32768 * 256 * 2;
constexpr size_t WS_R1    = WS_R0 + (size_t)32768 * 2048 * 2;
constexpr size_t WS_R2    = WS_R1 + (size_t)32768 * 7168 * 2;
constexpr size_t WS_W2    = WS_R2 + (size_t)32768 * 2048 * 2;
constexpr size_t WS_QKB   = WS_W2 + (size_t)32768 * 1024 * 2;
constexpr size_t WS_HALO  = WS_QKB + (size_t)4096 * 4096 * 2;
constexpr size_t WS_LIST  = WS_HALO + (size_t)513 * 3 * 3072 * 2 + 256 - ((size_t)513 * 3 * 3072 * 2) % 256;
constexpr size_t WS_ML    = WS_LIST + (size_t)16 * LISTN * 4;
constexpr size_t WS_SSQ   = WS_ML + (size_t)4 * 262144 * 8;
constexpr size_t WS_END   = WS_SSQ + (size_t)32768 * 64 * 4;

struct Params {
    const float* x; const float* p; const float* attn_norm; const float* w_in; const float* conv_w; const float* A_log; const float* dt_bias;
    const float* gdn_norm; const float* q_norm; const float* k_norm; const float* w_o; const float* ffn_norm; const float* w_gate; const float* w_up;
    const float* w_down; const float* ple_norm; const float* w_pg; const float* w_pp;
    float* out; unsigned char* ws;
};

DI unsigned pk2(float a, float b) { f32x2 v = {a, b}; bfv2 r = __builtin_convertvector(v, bfv2); return __builtin_bit_cast(unsigned, r); }
DI bf16_t f2bf(float a) { return (bf16_t)(pk2(a, 0.f) & 0xffffu); }
DI float bflo(unsigned w) { return __uint_as_float(w << 16); }
DI float bfhi(unsigned w) { return __uint_as_float(w & 0xffff0000u); }
DI float bf2f(bf16_t v) { return __uint_as_float(((unsigned)v) << 16); }
DI bf16x8 pack8(const f32x4& a, const f32x4& b) { u32x4 w; w.x = pk2(a[0], a[1]); w.y = pk2(a[2], a[3]); w.z = pk2(b[0], b[1]); w.w = pk2(b[2], b[3]); return __builtin_bit_cast(bf16x8, w); }
DI bf16x8 cat8(u32x2 lo, u32x2 hi) { u32x4 w; w.x = lo.x; w.y = lo.y; w.z = hi.x; w.w = hi.y; return __builtin_bit_cast(bf16x8, w); }
DI f32x4 mfma16(bf16x8 a, bf16x8 b, f32x4 c) { return __builtin_amdgcn_mfma_f32_16x16x32_bf16(a, b, c, 0, 0, 0); }
DI int perm4(int d4) { return d4 < 16 ? 2 * d4 : 2 * (d4 - 16) + 4; }
DI float dpp_f(float v, int ctrl_sel) { int x = __float_as_int(v); int r;
    if (ctrl_sel == 0) r = __builtin_amdgcn_mov_dpp(x, 0xB1, 0xf, 0xf, true); else if (ctrl_sel == 1) r = __builtin_amdgcn_mov_dpp(x, 0x4E, 0xf, 0xf, true);
    else if (ctrl_sel == 2) r = __builtin_amdgcn_mov_dpp(x, 0x141, 0xf, 0xf, true); else r = __builtin_amdgcn_mov_dpp(x, 0x140, 0xf, 0xf, true);
    return __int_as_float(r); }
DI float row16_sum(float v) { v += dpp_f(v, 0); v += dpp_f(v, 1); v += dpp_f(v, 2); v += dpp_f(v, 3); return v; }
DI float silu_f(float v) { return v * __builtin_amdgcn_rcpf(1.f + __expf(-v)); }
DI float sigm_f(float v) { return __builtin_amdgcn_rcpf(1.f + __expf(-v)); }

DI int opq_tid() { int t = threadIdx.x; asm volatile("" : "+v"(t)); return t; }

namespace pg8 {
constexpr int BM = 256, BK = 64, HALF = 128, HTB = HALF * BK * 2, STAGE_BYTES = 8 * HTB, NXCD = 8, WGM = 8;
DI int lds_byte(int r, int c) { const int st = (r >> 4) * 2 + (c >> 5), rr = r & 15, cc = c & 31, ob = rr * 64 + cc * 2; return st * 1024 + (ob ^ (((ob >> 9) & 1) << 5)); }
DI void stage_rc(int b, int& R, int& C) { const int st = b / 1024, sb = b % 1024, swz = sb ^ (((sb >> 9) & 1) << 5); R = (st >> 1) * 16 + swz / 64; C = (st & 1) * 32 + (swz % 64) / 2; }
DI int perm32(int rho) { const int n = rho >> 4, i = rho & 15; return 8 * (i >> 2) + 4 * n + (i & 3); }
struct Unit { int pm, pn; };
struct Gemm { const bf16_t* A; const bf16_t* Bt; int M, N, K; };
struct StaticOrder {
    int nM, nN, nwg, G, c;
    DI void init(int M, int N, int G_, int c_) { nM = M / BM; nN = N / BM; nwg = nM * nN; G = G_; c = c_; }
    DI bool next(int i, Unit& u) const {
        const long L = (long)i * G + c; if (L >= nwg) return false;
        int wgid = (int)L; { const int q = nwg / NXCD, r = nwg % NXCD, xcd = wgid % NXCD, off = wgid / NXCD; wgid = (xcd < r ? xcd * (q + 1) : r * (q + 1) + (xcd - r) * q) + off; }
        const int nig = WGM * nN, gid = wgid / nig, fm = gid * WGM, gsz = (nM - fm) < WGM ? (nM - fm) : WGM;
        u.pm = fm + ((wgid % nig) % gsz); u.pn = (wgid % nig) / gsz; return true;
    }
    DI void a_ready(const Unit&) const {}
    DI void done(const Unit&) const {}
};

template <class Epi, class Sched, bool ALIGN_EPI = false, bool SP2 = false>
DI void gemm_phase(LAS unsigned char* lds, const Gemm g, const Sched& S, const Epi& E) {
    const int tid = opq_tid(), wid = __builtin_amdgcn_readfirstlane(tid >> 6), lane = tid & 63, wr = wid >> 2, wc = wid & 3, fr = lane & 15, fq = lane >> 4;
    const int K = g.K, nt = K / BK;
    unsigned voffA[2], voffB[2];
#pragma unroll
    for (int i = 0; i < 2; ++i) { int R, C; stage_rc(tid * 16 + i * 8192, R, C); const int Rb = Epi::PERM ? ((R & ~31) + perm32(R & 31)) : R;
        voffA[i] = (unsigned)(R * K + C) * 2u; voffB[i] = (unsigned)(Rb * K + C) * 2u; }
    const size_t kstep = (size_t)(BK * 2);
    const size_t hstep = (size_t)HALF * K * 2;
    const size_t tstep = 2 * hstep;
    const unsigned ldsw = (unsigned)wid * 1024u;
    const int aoff = lds_byte(wr * 64 + fr, fq * 8), boff = lds_byte(wc * 32 + fr, fq * 8);
#define PG8_SA(b, h) (((b) * 2 + (h)) * HTB)
#define PG8_SB(b, h) ((4 + (b) * 2 + (h)) * HTB)
#define PG8_STAGE(bufoff, gbase, voff) do { _Pragma("unroll") for (int _i = 0; _i < 2; ++_i) \
        __builtin_amdgcn_global_load_lds((const unsigned*)((const char*)(gbase) + (voff)[_i]), (LAS unsigned*)(lds + (bufoff) + ldsw + _i * 8192), 16, 0, 0); } while (0)
#define PG8_LDA(dst, b, h) do { _Pragma("unroll") for (int m = 0; m < 4; ++m) _Pragma("unroll") for (int k = 0; k < 2; ++k) dst[m][k] = *(const LAS bf16x8*)(lds + PG8_SA(b, h) + aoff + m * 2048 + k * 1024); } while (0)
#define PG8_LDB(dst, b, h) do { _Pragma("unroll") for (int n = 0; n < 2; ++n) _Pragma("unroll") for (int k = 0; k < 2; ++k) dst[n][k] = *(const LAS bf16x8*)(lds + PG8_SB(b, h) + boff + n * 2048 + k * 1024); } while (0)
#define PG8_MMA(ai, bj, At, Bt) do { __builtin_amdgcn_s_setprio(1); _Pragma("unroll") for (int m = 0; m < 4; ++m) _Pragma("unroll") for (int n = 0; n < 2; ++n) _Pragma("unroll") for (int k = 0; k < 2; ++k) \
        acc[ai][bj][m][n] = __builtin_amdgcn_mfma_f32_16x16x32_bf16(Bt[n][k], At[m][k], acc[ai][bj][m][n], 0, 0, 0); __builtin_amdgcn_s_setprio(0); } while (0)
#define PG8_WAIT_V(n) asm volatile("s_waitcnt vmcnt(" #n ")" ::: "memory")
#define PG8_WAIT_L(n) asm volatile("s_waitcnt lgkmcnt(" #n ")" ::: "memory")
#define PG8_BAR __builtin_amdgcn_s_barrier()
#define PG8_SCHED __builtin_amdgcn_sched_barrier(0)
    Unit cur, nxt; int ui = 0;
    if (!S.next(0, cur)) return;
    f32x4 acc[2][2][4][2];
#pragma unroll
    for (int a = 0; a < 2; ++a)
#pragma unroll
        for (int b = 0; b < 2; ++b)
#pragma unroll
            for (int m = 0; m < 4; ++m)
#pragma unroll
                for (int n = 0; n < 2; ++n) acc[a][b][m][n] = (f32x4){0.f, 0.f, 0.f, 0.f};
    bf16x8 At[4][2], B0[2][2], B1[2][2];
    const char* cA = (const char*)g.A + (size_t)cur.pm * tstep; const char* cB = (const char*)g.Bt + (size_t)cur.pn * tstep;
    S.a_ready(cur);
    if constexpr (SP2) {
        PG8_STAGE(PG8_SB(0, 0), cB, voffB); PG8_STAGE(PG8_SB(0, 1), cB + hstep, voffB); PG8_STAGE(PG8_SA(0, 0), cA, voffA); PG8_STAGE(PG8_SA(0, 1), cA + hstep, voffA);
        if (wr == 1) PG8_BAR;
        PG8_WAIT_V(2); PG8_BAR;
        PG8_STAGE(PG8_SB(1, 0), cB + kstep, voffB); PG8_STAGE(PG8_SA(1, 0), cA + kstep, voffA); PG8_STAGE(PG8_SB(1, 1), cB + hstep + kstep, voffB);
        PG8_WAIT_V(6); PG8_BAR;
    } else {
        PG8_STAGE(PG8_SB(0, 0), cB, voffB); PG8_STAGE(PG8_SA(0, 0), cA, voffA); PG8_STAGE(PG8_SB(0, 1), cB + hstep, voffB); PG8_STAGE(PG8_SA(0, 1), cA + hstep, voffA);
        if (wr == 1) PG8_BAR;
        PG8_WAIT_V(4); PG8_BAR;
        PG8_STAGE(PG8_SB(1, 0), cB + kstep, voffB); PG8_STAGE(PG8_SA(1, 0), cA + kstep, voffA); PG8_STAGE(PG8_SB(1, 1), cB + hstep + kstep, voffB);
        PG8_WAIT_V(6); PG8_BAR;
    }
    for (;;) {
        const bool has_next = S.next(ui + 1, nxt);
        const char* nA = has_next ? (const char*)g.A + (size_t)nxt.pm * tstep : cA; const char* nB = has_next ? (const char*)g.Bt + (size_t)nxt.pn * tstep : cB;
        for (int t = 0; t < nt; t += 2) {
            const bool last = (t == nt - 2);
            const char* a1 = cA + (size_t)(t + 1) * kstep;
            const char* a2 = last ? nA : cA + (size_t)(t + 2) * kstep; const char* b2 = last ? nB : cB + (size_t)(t + 2) * kstep;
            const char* a3 = a2 + kstep; const char* b3 = b2 + kstep;
            if (last && has_next) S.a_ready(nxt);
            if constexpr (SP2) {
            PG8_LDB(B0, 0, 0); PG8_LDB(B1, 0, 1); PG8_SCHED; PG8_LDA(At, 0, 0); PG8_STAGE(PG8_SA(1, 1), a1 + hstep, voffA);
            PG8_WAIT_V(8); PG8_WAIT_L(0); PG8_BAR; PG8_MMA(0, 0, At, B0); PG8_MMA(0, 1, At, B1); PG8_BAR; PG8_SCHED;
            PG8_LDA(At, 0, 1); PG8_STAGE(PG8_SB(0, 0), b2, voffB); PG8_STAGE(PG8_SB(0, 1), b2 + hstep, voffB); PG8_STAGE(PG8_SA(0, 0), a2, voffA);
            PG8_WAIT_V(8); PG8_WAIT_L(0); PG8_BAR; PG8_MMA(1, 0, At, B0); PG8_MMA(1, 1, At, B1); PG8_BAR; PG8_SCHED;
            PG8_LDB(B0, 1, 0); PG8_LDB(B1, 1, 1); PG8_SCHED; PG8_LDA(At, 1, 0); PG8_STAGE(PG8_SA(0, 1), a2 + hstep, voffA);
            PG8_WAIT_V(8); PG8_WAIT_L(0); PG8_BAR; PG8_MMA(0, 0, At, B0); PG8_MMA(0, 1, At, B1); PG8_BAR; PG8_SCHED;
            PG8_LDA(At, 1, 1); PG8_STAGE(PG8_SB(1, 0), b3, voffB); PG8_STAGE(PG8_SB(1, 1), b3 + hstep, voffB); PG8_STAGE(PG8_SA(1, 0), a3, voffA);
            PG8_WAIT_V(8); PG8_WAIT_L(0); PG8_BAR; PG8_MMA(1, 0, At, B0); PG8_MMA(1, 1, At, B1); PG8_BAR; PG8_SCHED;
            } else {
            PG8_LDB(B0, 0, 0); PG8_SCHED; PG8_LDA(At, 0, 0); PG8_STAGE(PG8_SA(1, 1), a1 + hstep, voffA);
            PG8_WAIT_L(8); PG8_BAR; PG8_WAIT_L(0); PG8_MMA(0, 0, At, B0); PG8_BAR; PG8_SCHED;
            PG8_LDB(B1, 0, 1); PG8_STAGE(PG8_SB(0, 0), b2, voffB);
            PG8_BAR; PG8_WAIT_L(0); PG8_MMA(0, 1, At, B1); PG8_BAR;
            PG8_LDA(At, 0, 1); PG8_STAGE(PG8_SA(0, 0), a2, voffA);
            PG8_BAR; PG8_WAIT_L(0); PG8_MMA(1, 0, At, B0); PG8_BAR; PG8_SCHED;
            PG8_STAGE(PG8_SB(0, 1), b2 + hstep, voffB);
            PG8_WAIT_V(6); PG8_BAR; PG8_MMA(1, 1, At, B1); PG8_BAR;
            PG8_LDB(B0, 1, 0); PG8_SCHED; PG8_LDA(At, 1, 0); PG8_STAGE(PG8_SA(0, 1), a2 + hstep, voffA);
            PG8_WAIT_L(8); PG8_BAR; PG8_WAIT_L(0); PG8_MMA(0, 0, At, B0); PG8_BAR; PG8_SCHED;
            PG8_LDB(B1, 1, 1); PG8_STAGE(PG8_SB(1, 0), b3, voffB);
            PG8_BAR; PG8_WAIT_L(0); PG8_MMA(0, 1, At, B1); PG8_BAR;
            PG8_LDA(At, 1, 1); PG8_STAGE(PG8_SA(1, 0), a3, voffA);
            PG8_BAR; PG8_WAIT_L(0); PG8_MMA(1, 0, At, B0); PG8_BAR; PG8_SCHED;
            PG8_STAGE(PG8_SB(1, 1), b3 + hstep, voffB);
            PG8_WAIT_V(6); PG8_BAR; PG8_MMA(1, 1, At, B1); PG8_BAR;
            }
        }
        if constexpr (ALIGN_EPI) { if (wr == 0) PG8_BAR; }
        if constexpr (!Epi::AFTER_DRAIN) { E(acc, cur, wr, wc, fr, fq); S.done(cur); }
        if (!has_next) break;
#pragma unroll
        for (int a = 0; a < 2; ++a)
#pragma unroll
            for (int b = 0; b < 2; ++b)
#pragma unroll
                for (int m = 0; m < 4; ++m)
#pragma unroll
                    for (int n = 0; n < 2; ++n) acc[a][b][m][n] = (f32x4){0.f, 0.f, 0.f, 0.f};
        cur = nxt; cA = nA; cB = nB; ++ui;
        if constexpr (ALIGN_EPI) { if (wr == 1) PG8_BAR; }
    }
    PG8_WAIT_V(0);
    if constexpr (!ALIGN_EPI) { if (wr == 0) PG8_BAR; }
    PG8_BAR;
    if constexpr (Epi::AFTER_DRAIN) { E.fused(acc, cur, wr, wc, fr, fq, lds, wid, lane); S.done(cur); }
#undef PG8_SA
#undef PG8_SB
#undef PG8_STAGE
#undef PG8_LDA
#undef PG8_LDB
#undef PG8_MMA
#undef PG8_WAIT_V
#undef PG8_WAIT_L
#undef PG8_BAR
#undef PG8_SCHED
}
}
using pg8::Unit;

struct EpiProj {
    static constexpr bool PERM = true, AFTER_DRAIN = false;
    bf16_t* O; bf16_t* halo;
    DI void operator()(const f32x4 (&acc)[2][2][4][2], const Unit& u, int wr, int wc, int fr, int fq) const {
        const int row0 = u.pm * 256 + wr * 64 + fr, col0 = u.pn * 256 + wc * 32 + 8 * fq;
#pragma unroll
        for (int ai = 0; ai < 2; ++ai)
#pragma unroll
            for (int m = 0; m < 4; ++m) { const int row = row0 + ai * 128 + m * 16; bf16_t* rowp = O + (size_t)row * NPJ + col0;
#pragma unroll
                for (int bj = 0; bj < 2; ++bj) { const f32x4 v0 = acc[ai][bj][m][0], v1 = acc[ai][bj][m][1];
                    u32x4 w; w.x = pk2(v0[0], v0[1]); w.y = pk2(v0[2], v0[3]); w.z = pk2(v1[0], v1[1]); w.w = pk2(v1[2], v1[3]);
                    *(u32x4*)(rowp + bj * 128) = w;
                    if (m == 3 && fr >= 13 && u.pn < 12) *(u32x4*)(halo + ((size_t)((row >> 6) + 1) * 3 + (fr - 13)) * 3072 + col0 + bj * 128) = w; } }
    }
};
struct EpiPlainBf16 {
    static constexpr bool PERM = true, AFTER_DRAIN = false;
    bf16_t* O; int ldc;
    DI void operator()(const f32x4 (&acc)[2][2][4][2], const Unit& u, int wr, int wc, int fr, int fq) const {
        const int row0 = u.pm * 256 + wr * 64 + fr, col0 = u.pn * 256 + wc * 32 + 8 * fq;
#pragma unroll
        for (int ai = 0; ai < 2; ++ai)
#pragma unroll
            for (int m = 0; m < 4; ++m) { bf16_t* rowp = O + (size_t)(row0 + ai * 128 + m * 16) * ldc + col0;
#pragma unroll
                for (int bj = 0; bj < 2; ++bj) { const f32x4 v0 = acc[ai][bj][m][0], v1 = acc[ai][bj][m][1];
                    u32x4 w; w.x = pk2(v0[0], v0[1]); w.y = pk2(v0[2], v0[3]); w.z = pk2(v1[0], v1[1]); w.w = pk2(v1[2], v1[3]);
                    *(u32x4*)(rowp + bj * 128) = w; } }
    }
};
struct EpiResid {
    static constexpr bool PERM = false, AFTER_DRAIN = false;
    const float* base; float* out; bf16_t* hb; float* ss;
    DI void operator()(const f32x4 (&acc)[2][2][4][2], const Unit& u, int wr, int wc, int fr, int fq) const {
        const int row0 = u.pm * 256 + wr * 64 + fr, col0 = u.pn * 256 + wc * 32 + 4 * fq;
#pragma unroll
        for (int ai = 0; ai < 2; ++ai) { f32x4 bs[4][4];
#pragma unroll
            for (int m = 0; m < 4; ++m)
#pragma unroll
                for (int q = 0; q < 4; ++q) bs[m][q] = *(const f32x4*)(base + (size_t)(row0 + ai * 128 + m * 16) * DM + col0 + (q >> 1) * 128 + (q & 1) * 16);
#pragma unroll
            for (int m = 0; m < 4; ++m) { const int row = row0 + ai * 128 + m * 16; const size_t off = (size_t)row * DM + col0; float s = 0.f;
#pragma unroll
                for (int q = 0; q < 4; ++q) { const f32x4 hv = bs[m][q] + acc[ai][q >> 1][m][q & 1];
                        *(f32x4*)(out + off + (q >> 1) * 128 + (q & 1) * 16) = hv; u32x2 w; w.x = pk2(hv[0], hv[1]); w.y = pk2(hv[2], hv[3]);
                        *(u32x2*)(hb + off + (q >> 1) * 128 + (q & 1) * 16) = w; s += (hv[0] * hv[0] + hv[1] * hv[1]) + (hv[2] * hv[2] + hv[3] * hv[3]); }
                s += __shfl_xor(s, 16); s += __shfl_xor(s, 32);
                if (fq == 0) atomicAdd(ss + row, s); }
            asm volatile("" ::: "memory"); }
    }
};
struct EpiAct {
    static constexpr bool PERM = true, AFTER_DRAIN = false;
    bf16_t* O; const float* ss;
    DI void operator()(const f32x4 (&acc)[2][2][4][2], const Unit& u, int wr, int wc, int fr, int fq) const {
        const int row0 = u.pm * 256 + wr * 64 + fr, col0 = u.pn * 128 + wc * 32 + 8 * fq;
        float rs[8];
#pragma unroll
        for (int g = 0; g < 8; ++g) rs[g] = ss[row0 + (g >> 2) * 128 + (g & 3) * 16];
#pragma unroll
        for (int ai = 0; ai < 2; ++ai)
#pragma unroll
            for (int m = 0; m < 4; ++m) { const int row = row0 + ai * 128 + m * 16; const float r = rsqrtf(rs[ai * 4 + m] * (1.f / 2048.f) + 1e-6f);
                float a[8];
#pragma unroll
                for (int n = 0; n < 2; ++n)
#pragma unroll
                    for (int j = 0; j < 4; ++j) { const float gv = r * acc[ai][0][m][n][j], uv = r * acc[ai][1][m][n][j]; a[n * 4 + j] = silu_f(gv) * uv; }
                u32x4 w; w.x = pk2(a[0], a[1]); w.y = pk2(a[2], a[3]); w.z = pk2(a[4], a[5]); w.w = pk2(a[6], a[7]);
                *(u32x4*)(O + (size_t)row * FF + col0) = w; }
    }
};
struct EpiOut {
    static constexpr bool PERM = false, AFTER_DRAIN = false;
    float* out; const bf16_t* pp; const float* ss;
    DI void operator()(const f32x4 (&acc)[2][2][4][2], const Unit& u, int wr, int wc, int fr, int fq) const {
        const int row0 = u.pm * 256 + wr * 64 + fr, col0 = u.pn * 256 + wc * 32 + 4 * fq;
        float rs[8];
#pragma unroll
        for (int g = 0; g < 8; ++g) rs[g] = ss[row0 + (g >> 2) * 128 + (g & 3) * 16];
#pragma unroll
        for (int ai = 0; ai < 2; ++ai)
#pragma unroll
            for (int m = 0; m < 4; ++m) { const int row = row0 + ai * 128 + m * 16; const size_t off = (size_t)row * DM + col0; const float r = rsqrtf(rs[ai * 4 + m] * (1.f / 2048.f) + 1e-6f);
                f32x4 hv[4]; u32x2 pw[4];
#pragma unroll
                for (int q = 0; q < 4; ++q) { hv[q] = *(const f32x4*)(out + off + (q >> 1) * 128 + (q & 1) * 16); pw[q] = *(const u32x2*)(pp + off + (q >> 1) * 128 + (q & 1) * 16); }
#pragma unroll
                for (int q = 0; q < 4; ++q) { const f32x4 a = acc[ai][q >> 1][m][q & 1]; f32x4 o;
                        o[0] = hv[q][0] + sigm_f(r * a[0]) * bflo(pw[q].x); o[1] = hv[q][1] + sigm_f(r * a[1]) * bfhi(pw[q].x);
                        o[2] = hv[q][2] + sigm_f(r * a[2]) * bflo(pw[q].y); o[3] = hv[q][3] + sigm_f(r * a[3]) * bfhi(pw[q].y);
                        *(f32x4*)(out + off + (q >> 1) * 128 + (q & 1) * 16) = o; }
                asm volatile("" ::: "memory"); }
    }
};

DI void tconv_tile(const float* __restrict__ src, int ld, int c0, int k0, bf16_t* __restrict__ dst, int dK, int n0, const float* __restrict__ nw, LAS float* tl) {
    const int tid = opq_tid();
    f32x4 v[8];
#pragma unroll
    for (int i = 0; i < 8; ++i) v[i] = *(const f32x4*)(src + (size_t)(k0 + (tid >> 4) + 32 * i) * ld + c0 + (tid & 15) * 4);
#pragma unroll
    for (int i = 0; i < 8; ++i) { const int k = (tid >> 4) + 32 * i; const float sc = nw ? nw[k0 + k] : 1.f;
        LAS float* q = tl + k * 65 + (tid & 15) * 4; q[0] = v[i][0] * sc; q[1] = v[i][1] * sc; q[2] = v[i][2] * sc; q[3] = v[i][3] * sc; }
    __syncthreads();
    { const int n = tid >> 3, kq = (tid & 7) * 8;
#pragma unroll
      for (int j = 0; j < 4; ++j) { const int ks = kq + 64 * j; float f[8];
#pragma unroll
          for (int i = 0; i < 8; ++i) f[i] = tl[(ks + i) * 65 + n];
          u32x4 w; w.x = pk2(f[0], f[1]); w.y = pk2(f[2], f[3]); w.z = pk2(f[4], f[5]); w.w = pk2(f[6], f[7]);
          *(u32x4*)(dst + (size_t)(n0 + n) * dK + k0 + ks) = w; } }
    __syncthreads();
}

DI void phase_prep(const Params& P, LAS unsigned char* lds) {
    unsigned char* ws = P.ws; const int tid = opq_tid(), G = gridDim.x, bx = blockIdx.x;
    const int gtid = bx * NTHREADS + tid, gsz = G * NTHREADS;
    for (int i = gtid; i < (int)((WS_GL - WS_CTL) / 4); i += gsz) ((unsigned*)(ws + WS_CTL))[i] = 0u;
    { bf16_t* wba = (bf16_t*)(ws + WS_WBA); for (int i = gtid; i < 16 * 2048; i += gsz) { const int n = i >> 11, k = i & 2047; wba[i] = f2bf(P.w_in[(size_t)k * INW + 4096 + n]); } }
    { bf16_t* pb = (bf16_t*)(ws + WS_PB); for (int i = gtid; i < MT * 256 / 8; i += gsz) { const f32x4 a = *(const f32x4*)(P.p + (size_t)i * 8), b = *(const f32x4*)(P.p + (size_t)i * 8 + 4);
        u32x4 w; w.x = pk2(a[0], a[1]); w.y = pk2(a[2], a[3]); w.z = pk2(b[0], b[1]); w.w = pk2(b[2], b[3]); *(u32x4*)(pb + (size_t)i * 8) = w; } }
    { bf16_t* xn = (bf16_t*)(ws + WS_R0); const int lane = tid & 63, gw = bx * 8 + (tid >> 6);
      f32x4 wv[8];
#pragma unroll
      for (int i = 0; i < 8; ++i) wv[i] = *(const f32x4*)(P.attn_norm + lane * 4 + i * 256);
      for (int row = gw * 2; row < MT; row += G * 16) { const float* xr = P.x + (size_t)row * DM; f32x4 v[2][8]; float s0 = 0.f, s1 = 0.f;
#pragma unroll
          for (int r = 0; r < 2; ++r)
#pragma unroll
              for (int i = 0; i < 8; ++i) v[r][i] = *(const f32x4*)(xr + (size_t)r * DM + lane * 4 + i * 256);
#pragma unroll
          for (int i = 0; i < 8; ++i) { s0 += (v[0][i][0] * v[0][i][0] + v[0][i][1] * v[0][i][1]) + (v[0][i][2] * v[0][i][2] + v[0][i][3] * v[0][i][3]);
              s1 += (v[1][i][0] * v[1][i][0] + v[1][i][1] * v[1][i][1]) + (v[1][i][2] * v[1][i][2] + v[1][i][3] * v[1][i][3]); }
#pragma unroll
          for (int o = 1; o < 64; o <<= 1) { s0 += __shfl_xor(s0, o); s1 += __shfl_xor(s1, o); }
          const float r0 = rsqrtf(s0 * (1.f / 2048.f) + 1e-6f), r1 = rsqrtf(s1 * (1.f / 2048.f) + 1e-6f);
#pragma unroll
          for (int r = 0; r < 2; ++r)
#pragma unroll
              for (int i = 0; i < 8; ++i) { const float rr = r ? r1 : r0; u32x2 w; w.x = pk2(v[r][i][0] * rr * wv[i][0], v[r][i][1] * rr * wv[i][1]); w.y = pk2(v[r][i][2] * rr * wv[i][2], v[r][i][3] * rr * wv[i][3]);
                  *(u32x2*)(xn + (size_t)(row + r) * DM + lane * 4 + i * 256) = w; } } }
    LAS float* tl = (LAS float*)lds;
    for (int gi = bx; gi < 896; gi += G) { const int nt = gi >> 3, kg = gi & 7, n0 = nt * 64; tconv_tile(P.w_in, INW, n0 < 4096 ? n0 : n0 + 16, kg * 256, (bf16_t*)(ws + WS_WIN), 2048, n0, nullptr, tl); }
}
DI void phase_wconv_late(const Params& P, LAS unsigned char* lds, int wg0, int nwg) {
    unsigned char* ws = P.ws; LAS float* tl = (LAS float*)lds;
    for (int gi = 896 + wg0; gi < 3552; gi += nwg) {
        if (gi < 1152) { const int t2 = gi - 896, nt = t2 >> 3, kg = t2 & 7; tconv_tile(P.w_o, 2048, nt * 64, kg * 256, (bf16_t*)(ws + WS_WO), 2048, nt * 64, nullptr, tl); }
        else if (gi < 2560) { const int t2 = gi - 1152, nt = t2 >> 3, kg = t2 & 7, n0 = nt * 64, pn = n0 >> 8, r = n0 & 255;
            tconv_tile(r < 128 ? P.w_gate : P.w_up, FF, pn * 128 + (r & 127), kg * 256, (bf16_t*)(ws + WS_WGU), 2048, n0, P.ffn_norm, tl); }
        else if (gi < 3264) { const int t2 = gi - 2560, nt = t2 / 22, kg = t2 % 22; tconv_tile(P.w_down, 2048, nt * 64, kg * 256, (bf16_t*)(ws + WS_WDN), FF, nt * 64, nullptr, tl); }
        else if (gi < 3520) { const int t2 = gi - 3264, nt = t2 >> 3, kg = t2 & 7; tconv_tile(P.w_pg, 2048, nt * 64, kg * 256, (bf16_t*)(ws + WS_WPG), 2048, nt * 64, P.ple_norm, tl); }
        else { const int nt = gi - 3520; tconv_tile(P.w_pp, 2048, nt * 64, 0, (bf16_t*)(ws + WS_WPP), 256, nt * 64, nullptr, tl); }
    }
}

DI void phase_ba(const Params& P) {
    const int tid = opq_tid(), lane = tid & 63, fr = lane & 15, fq = lane >> 4, gw = blockIdx.x * 8 + (tid >> 6);
    const bf16_t* xn = (const bf16_t*)(P.ws + WS_R0); const bf16_t* wba = (const bf16_t*)(P.ws + WS_WBA); float* BA = (float*)(P.ws + WS_BA);
    for (int rt = gw; rt < MT / 16; rt += gridDim.x * 8) {
        f32x4 acc = {0.f, 0.f, 0.f, 0.f}; const bf16_t* ap = xn + (size_t)(rt * 16 + fr) * DM + 8 * fq; const bf16_t* bp = wba + fr * 2048 + 8 * fq;
#pragma unroll 16
        for (int ks = 0; ks < 64; ++ks) acc = mfma16(*(const bf16x8*)(ap + 32 * ks), *(const bf16x8*)(bp + 32 * ks), acc);
#pragma unroll
        for (int j = 0; j < 4; ++j) BA[(size_t)(rt * 16 + 4 * fq + j) * 16 + fr] = acc[j];
    }
}

constexpr int G1_QS = 0, G1_KS = 18432, G1_VT = 36864, G1_KT = 57344, G1_SM = 77824, G1_TEAM = 78848;
DI void phase_gdn_prep(const Params& P, LAS unsigned char* lds, int n_lo, int n_cnt, int wg0, int nwg, unsigned* early_flag = nullptr, int early_thr = 0, unsigned* early_flag2 = nullptr, int early_thr2 = 0) {
    const int tid0 = opq_tid(), team = tid0 >> 8;
    LAS unsigned char* L = lds + team * G1_TEAM;
    LAS bf16_t* QS = (LAS bf16_t*)(L + G1_QS); LAS bf16_t* KS = (LAS bf16_t*)(L + G1_KS); LAS bf16_t* VT = (LAS bf16_t*)(L + G1_VT); LAS bf16_t* KT = (LAS bf16_t*)(L + G1_KT);
    LAS float* AF = (LAS float*)(L + G1_QS); LAS bf16_t* TB = (LAS bf16_t*)(L + G1_KS); LAS float* SM = (LAS float*)(L + G1_SM);
    bf16_t* proj = (bf16_t*)(P.ws + WS_R1); const bf16_t* halo = (const bf16_t*)(P.ws + WS_HALO); const float* BA = (const float*)(P.ws + WS_BA);
    bf16_t* W2 = (bf16_t*)(P.ws + WS_W2); bf16_t* QKB = (bf16_t*)(P.ws + WS_QKB); float* GL = (float*)(P.ws + WS_GL);
    bool arrived = (early_flag == nullptr), arrived2 = (early_flag2 == nullptr);
    for (int pi = wg0; pi < n_cnt * 8; pi += nwg) {
        int tid = tid0; asm volatile("" : "+v"(tid));
        const int tt = tid & 255, tw = __builtin_amdgcn_readfirstlane((tid >> 6) & 3), lane = tid & 63, fr = lane & 15, fq = lane >> 4;
        const int cq = pi * 2 + team, h = cq & 7, b = (cq >> 3) & 1, n = n_lo + (cq >> 4), ci = ((b * 256 + n) << 3) + h, t0 = b * TT + n * 64;
        if (tw == 0) {
            const float bv = BA[(size_t)(t0 + lane) * 16 + h], av = BA[(size_t)(t0 + lane) * 16 + 8 + h];
            const float beta = sigm_f(bv); const float xx = av + P.dt_bias[h]; const float sp = xx > 20.f ? xx : log1pf(__expf(xx));
            const float gg = -__expf(P.A_log[h]) * sp; float gc = gg;
#pragma unroll
            for (int o = 1; o < 64; o <<= 1) { const float v = __shfl_up(gc, o); if (lane >= o) gc += v; }
            const float glast = __shfl(gc, 63);
            SM[lane] = gc; SM[64 + lane] = beta; SM[128 + lane] = __expf(gc); SM[192 + lane] = __expf(glast - gc);
            if (lane == 63) GL[(b * 8 + h) * 256 + n] = __expf(gc);
        }
        __syncthreads();
        { const int r = tt >> 2, cg0 = (tt & 3) * 32; const float beta_r = SM[64 + r], egc_r = SM[128 + r];
#pragma unroll 1
          for (int x = 0; x < 3; ++x) {
              float val[32]; const int colbase = x * 1024 + h * 128 + cg0;
              u32x4 rawa[4][4];
#pragma unroll
              for (int sg = 0; sg < 4; ++sg) { const int col = colbase + sg * 8;
#pragma unroll
                  for (int j = 0; j < 4; ++j) { const int rr = r - 3 + j; rawa[sg][j] = (u32x4){0u, 0u, 0u, 0u};
                      if (rr >= 0) rawa[sg][j] = *(const u32x4*)(proj + (size_t)(t0 + rr) * NPJ + col);
                      else if (n > 0) rawa[sg][j] = *(const u32x4*)(halo + ((size_t)(t0 >> 6) * 3 + (rr + 3)) * 3072 + col); } }
#pragma unroll
              for (int sg = 0; sg < 4; ++sg) { const int col = colbase + sg * 8;
#pragma unroll
                  for (int i = 0; i < 8; ++i) { const f32x4 w4 = *(const f32x4*)(P.conv_w + (size_t)(col + i) * 4); float a = 0.f;
#pragma unroll
                      for (int j = 0; j < 4; ++j) { const unsigned wd = rawa[sg][j][i >> 1]; const float xv = (i & 1) ? bfhi(wd) : bflo(wd); a += w4[j] * xv; }
                      val[sg * 8 + i] = silu_f(a); } }
              if (x < 2) { float ss = 0.f;
#pragma unroll
                  for (int i = 0; i < 32; ++i) ss += val[i] * val[i];
                  ss += __shfl_xor(ss, 1); ss += __shfl_xor(ss, 2);
                  const float sc = rsqrtf(ss + 1e-6f) * (x == 0 ? 0.08838834764831845f : 1.f);
#pragma unroll
                  for (int i = 0; i < 32; ++i) val[i] *= sc; }
              if (x < 2) { LAS bf16_t* dst = (x == 0 ? QS : KS) + r * 144 + cg0;
#pragma unroll
                  for (int i = 0; i < 4; ++i) { u32x4 w; w.x = pk2(val[8 * i], val[8 * i + 1]); w.y = pk2(val[8 * i + 2], val[8 * i + 3]); w.z = pk2(val[8 * i + 4], val[8 * i + 5]); w.w = pk2(val[8 * i + 6], val[8 * i + 7]);
                      *(LAS u32x4*)(dst + 8 * i) = w; } }
              if (x == 1) { const float f = beta_r * egc_r;
#pragma unroll
                  for (int i = 0; i < 32; ++i) KT[(cg0 + i) * 80 + r] = f2bf(val[i] * f); }
              if (x == 2) {
#pragma unroll
                  for (int i = 0; i < 32; ++i) VT[(cg0 + i) * 80 + r] = f2bf(val[i] * beta_r); }
          } }
        __syncthreads();
        f32x4 kk[4], qk[4];
#pragma unroll
        for (int nt = 0; nt < 4; ++nt) { kk[nt] = (f32x4){0.f, 0.f, 0.f, 0.f}; qk[nt] = (f32x4){0.f, 0.f, 0.f, 0.f}; }
#pragma unroll
        for (int ks = 0; ks < 4; ++ks) { const bf16x8 ak = *(const LAS bf16x8*)(KS + (16 * tw + fr) * 144 + 32 * ks + 8 * fq), aq = *(const LAS bf16x8*)(QS + (16 * tw + fr) * 144 + 32 * ks + 8 * fq);
#pragma unroll
            for (int nt = 0; nt < 4; ++nt) { const bf16x8 bk = *(const LAS bf16x8*)(KS + (16 * nt + fr) * 144 + 32 * ks + 8 * fq); kk[nt] = mfma16(ak, bk, kk[nt]); qk[nt] = mfma16(aq, bk, qk[nt]); } }
        { const int r = tt >> 2, cg0 = (tt & 3) * 32; const float e = SM[128 + r];
#pragma unroll
          for (int i = 0; i < 4; ++i) { const u32x4 s = *(const LAS u32x4*)(QS + r * 144 + cg0 + 8 * i); u32x4 w;
              w.x = pk2(bflo(s.x) * e, bfhi(s.x) * e); w.y = pk2(bflo(s.y) * e, bfhi(s.y) * e); w.z = pk2(bflo(s.z) * e, bfhi(s.z) * e); w.w = pk2(bflo(s.w) * e, bfhi(s.w) * e);
              *(u32x4*)(proj + (size_t)(t0 + r) * NPJ + OFF_GQ + h * 128 + cg0 + 8 * i) = w; } }
        { const int d = tt >> 1, cb = (tt & 1) * 32;
#pragma unroll
          for (int i4 = 0; i4 < 4; ++i4) { const int c0 = cb + 8 * i4; float f[8];
#pragma unroll
              for (int i = 0; i < 8; ++i) f[i] = bf2f(KS[(c0 + i) * 144 + d]) * SM[192 + c0 + i];
              u32x4 w; w.x = pk2(f[0], f[1]); w.y = pk2(f[2], f[3]); w.z = pk2(f[4], f[5]); w.w = pk2(f[6], f[7]);
              *(u32x4*)(proj + (size_t)(t0 + (d >> 1)) * NPJ + OFF_GK + h * 128 + (d & 1) * 64 + c0) = w; } }
        __syncthreads();
#pragma unroll
        for (int nt = 0; nt < 4; ++nt)
#pragma unroll
            for (int j = 0; j < 4; ++j) { const int c = 16 * tw + 4 * fq + j, s = 16 * nt + fr; const float dec = (s <= c) ? __expf(SM[c] - SM[s]) : 0.f;
                AF[c * 65 + s] = (s < c) ? SM[64 + c] * kk[nt][j] * dec : (s == c ? 1.f : 0.f);
                QKB[(size_t)ci * 4096 + c * 64 + s] = f2bf(qk[nt][j] * dec); }
        __syncthreads();
        { const int bb = tw * 16;
          if (lane < 16) {
              for (int i = 1; i < 16; ++i) { float a0 = 0.f, a1 = 0.f; int j = 0;
                  for (; j + 2 <= i; j += 2) { a0 += AF[(bb + i) * 65 + bb + j] * AF[(bb + j) * 65 + bb + lane]; a1 += AF[(bb + i) * 65 + bb + j + 1] * AF[(bb + j + 1) * 65 + bb + lane]; }
                  if (j < i) a0 += AF[(bb + i) * 65 + bb + j] * AF[(bb + j) * 65 + bb + lane];
                  AF[(bb + i) * 65 + bb + lane] = lane < i ? -(a0 + a1) : (lane == i ? 1.f : 0.f); } }
#pragma unroll
          for (int k = 0; k < 4; ++k) { const int row = bb + fq + 4 * k; TB[row * 80 + bb + fr] = f2bf(AF[row * 65 + bb + fr]);
              for (int jb = tw + 1; jb < 4; ++jb) TB[row * 80 + 16 * jb + fr] = (bf16_t)0; }
          __syncthreads();
          for (int i = 1; i < 4; ++i) {
              if (tw < i) { const int j = tw; f32x4 X = {0.f, 0.f, 0.f, 0.f};
                  for (int k = j; k < i; ++k) {
#pragma unroll
                      for (int kk = 0; kk < 4; ++kk) { const float av = AF[(16 * i + fr) * 65 + 16 * k + 4 * kk + fq];
                          const float bv = (k == j) ? AF[(16 * k + 4 * kk + fq) * 65 + 16 * j + fr] : bf2f(TB[(16 * k + 4 * kk + fq) * 80 + 16 * j + fr]);
                          X = __builtin_amdgcn_mfma_f32_16x16x4f32(av, bv, X, 0, 0, 0); } }
                  f32x4 O = {0.f, 0.f, 0.f, 0.f};
#pragma unroll
                  for (int kk = 0; kk < 4; ++kk) O = __builtin_amdgcn_mfma_f32_16x16x4f32(AF[(16 * i + fr) * 65 + 16 * i + 4 * fq + kk], X[kk], O, 0, 0, 0);
#pragma unroll
                  for (int jj = 0; jj < 4; ++jj) TB[(16 * i + 4 * fq + jj) * 80 + 16 * j + fr] = f2bf(-O[jj]); }
              __syncthreads(); }
        }
        { bf16x8 at[2];
#pragma unroll
          for (int ks = 0; ks < 2; ++ks) at[ks] = *(const LAS bf16x8*)(TB + (16 * tw + fr) * 80 + 32 * ks + 8 * fq);
#pragma unroll
          for (int nt = 0; nt < 8; ++nt) { f32x4 a = {0.f, 0.f, 0.f, 0.f};
#pragma unroll
              for (int ks = 0; ks < 2; ++ks) a = mfma16(at[ks], *(const LAS bf16x8*)(VT + (16 * nt + fr) * 80 + 32 * ks + 8 * fq), a);
              const int e = 16 * nt + fr; u32x2 w; w.x = pk2(a[0], a[1]); w.y = pk2(a[2], a[3]);
              *(u32x2*)(proj + (size_t)(t0 + (e >> 1)) * NPJ + OFF_GV + h * 128 + (e & 1) * 64 + 16 * tw + 4 * fq) = w; }
#pragma unroll
          for (int mt = 0; mt < 8; ++mt) { f32x4 a = {0.f, 0.f, 0.f, 0.f};
#pragma unroll
              for (int ks = 0; ks < 2; ++ks) a = mfma16(*(const LAS bf16x8*)(KT + (16 * mt + fr) * 80 + 32 * ks + 8 * fq), at[ks], a);
              u32x2 w; w.x = pk2(a[0], a[1]); w.y = pk2(a[2], a[3]);
              *(u32x2*)(W2 + (size_t)(t0 + 16 * tw + fr) * 1024 + h * 128 + 16 * mt + 4 * fq) = w; } }
        __syncthreads();
        if (!arrived && pi + nwg >= early_thr) {
            asm volatile("s_waitcnt vmcnt(0)" ::: "memory"); __syncthreads();
            if (threadIdx.x == 0) { __builtin_amdgcn_fence(__ATOMIC_RELEASE, "agent"); __hip_atomic_fetch_add(early_flag, 1u, __ATOMIC_RELAXED, __HIP_MEMORY_SCOPE_AGENT); }
            arrived = true; }
        if (!arrived2 && pi + nwg >= early_thr2) {
            asm volatile("s_waitcnt vmcnt(0)" ::: "memory"); __syncthreads();
            if (threadIdx.x == 0) { __builtin_amdgcn_fence(__ATOMIC_RELEASE, "agent"); __hip_atomic_fetch_add(early_flag2, 1u, __ATOMIC_RELAXED, __HIP_MEMORY_SCOPE_AGENT); }
            arrived2 = true; }
    }
    if (!arrived2) { asm volatile("s_waitcnt vmcnt(0)" ::: "memory"); __syncthreads();
        if (threadIdx.x == 0) { __builtin_amdgcn_fence(__ATOMIC_RELEASE, "agent"); __hip_atomic_fetch_add(early_flag2, 1u, __ATOMIC_RELAXED, __HIP_MEMORY_SCOPE_AGENT); } }
    if (!arrived) { asm volatile("s_waitcnt vmcnt(0)" ::: "memory"); __syncthreads();
        if (threadIdx.x == 0) { __builtin_amdgcn_fence(__ATOMIC_RELEASE, "agent"); __hip_atomic_fetch_add(early_flag, 1u, __ATOMIC_RELAXED, __HIP_MEMORY_SCOPE_AGENT); } }
}

DI void phase_moba_prep(const Params& P, LAS unsigned char* lds, int wg0, int nwg) {
    const int tid = opq_tid(), lane = tid & 63, wave = tid >> 6, l16 = lane & 15;
    bf16_t* proj = (bf16_t*)(P.ws + WS_R1); float* kmean = (float*)(P.ws + WS_KMEAN);
    LAS bf16_t* VS = (LAS bf16_t*)lds; LAS float* CS = (LAS float*)(lds + 69632);
    for (int task = wg0; task < 1024; task += nwg) {
        const int h = task & 7, blk = (task >> 3) & 63, b = task >> 9; const size_t rbase = (size_t)(b * TT + blk * 256);
        f32x4 qg0 = *(const f32x4*)(P.q_norm + l16 * 8), qg1 = *(const f32x4*)(P.q_norm + l16 * 8 + 4), kg0 = *(const f32x4*)(P.k_norm + l16 * 8), kg1 = *(const f32x4*)(P.k_norm + l16 * 8 + 4);
        float cs[8];
#pragma unroll
        for (int i = 0; i < 8; ++i) cs[i] = 0.f;
        u32x4 rq[8], rk[8], rv[8];
#pragma unroll
        for (int ps = 0; ps < 8; ++ps) { const int r = ps * 32 + wave * 4 + (lane >> 4); const bf16_t* rp = proj + (rbase + r) * NPJ + h * 128 + l16 * 8;
            rq[ps] = *(const u32x4*)(rp + OFF_MQ); rk[ps] = *(const u32x4*)(rp + OFF_MK); rv[ps] = *(const u32x4*)(rp + OFF_MV); }
#pragma unroll
        for (int ps = 0; ps < 8; ++ps) { const int r = ps * 32 + wave * 4 + (lane >> 4); bf16_t* rp = proj + (rbase + r) * NPJ + h * 128 + l16 * 8;
#pragma unroll
            for (int x = 0; x < 2; ++x) { bf16_t* ptr = rp + (x == 0 ? OFF_MQ : OFF_MK); const u32x4 raw = x == 0 ? rq[ps] : rk[ps]; float v[8];
                v[0] = bflo(raw.x); v[1] = bfhi(raw.x); v[2] = bflo(raw.y); v[3] = bfhi(raw.y); v[4] = bflo(raw.z); v[5] = bfhi(raw.z); v[6] = bflo(raw.w); v[7] = bfhi(raw.w);
                float ss = 0.f;
#pragma unroll
                for (int i = 0; i < 8; ++i) ss += v[i] * v[i];
                ss = row16_sum(ss);
                const float rs = rsqrtf(ss * (1.f / 128.f) + 1e-6f); const f32x4 g0 = x == 0 ? qg0 : kg0, g1 = x == 0 ? qg1 : kg1;
#pragma unroll
                for (int i = 0; i < 4; ++i) { v[i] *= rs * g0[i]; v[4 + i] *= rs * g1[i]; }
                if (x == 1) {
#pragma unroll
                    for (int i = 0; i < 8; ++i) cs[i] += v[i]; }
                u32x4 w; w.x = pk2(v[0], v[1]); w.y = pk2(v[2], v[3]); w.z = pk2(v[4], v[5]); w.w = pk2(v[6], v[7]); *(u32x4*)ptr = w; }
            *(LAS u32x4*)(VS + r * 136 + l16 * 8) = rv[ps]; }
#pragma unroll
        for (int i = 0; i < 8; ++i) { cs[i] += __shfl_xor(cs[i], 16); cs[i] += __shfl_xor(cs[i], 32); }
        if (lane < 16) {
#pragma unroll
            for (int i = 0; i < 8; ++i) CS[wave * 128 + lane * 8 + i] = cs[i]; }
        __syncthreads();
        if (tid < 128) { float s = 0.f;
#pragma unroll
            for (int w = 0; w < 8; ++w) s += CS[w * 128 + tid];
            kmean[((size_t)(b * 8 + h) * 64 + blk) * 128 + tid] = s * (1.f / 256.f); }
#pragma unroll 2
        for (int i8 = 0; i8 < 8; ++i8) { const int pid = tid + i8 * 512, e = (pid & 63) + 64 * (pid >> 11), ks = (pid >> 6) & 31; unsigned short f[8];
#pragma unroll
            for (int i = 0; i < 8; ++i) f[i] = VS[(ks * 8 + i) * 136 + e];
            u32x4 w; w.x = f[0] | ((unsigned)f[1] << 16); w.y = f[2] | ((unsigned)f[3] << 16); w.z = f[4] | ((unsigned)f[5] << 16); w.w = f[6] | ((unsigned)f[7] << 16);
            *(u32x4*)(proj + (rbase + 2 * e + (ks >> 4)) * NPJ + OFF_MV + h * 128 + (ks & 15) * 8) = w; }
        __syncthreads();
    }
}

DI void phase_moba_select(const Params& P, LAS unsigned char* lds, int wg0, int nwg) {
    const int tid = opq_tid(), qi = tid >> 1, half = tid & 1;
    const bf16_t* proj = (const bf16_t*)(P.ws + WS_R1); const float* kmean = (const float*)(P.ws + WS_KMEAN);
    int* cnt = (int*)(P.ws + WS_CNT); int* list = (int*)(P.ws + WS_LIST); f32x2* ML = (f32x2*)(P.ws + WS_ML);
    LAS float* KM = (LAS float*)lds; LAS int* hist = (LAS int*)(lds + 32768); LAS int* hbase = (LAS int*)(lds + 32768 + 256);
    for (int task = wg0; task < 1024; task += nwg) {
        const int tk = task >> 8, tw_ = task & 255, bhx = (tw_ >> 6) * 4 + tk, blk = (tk & 1) ? 63 - (tw_ & 63) : (tw_ & 63), h = bhx & 7, b = bhx >> 3; const int bh = b * 8 + h; const int t = blk * 256 + qi; const size_t rid = (size_t)bh * TT + t;
        for (int i = tid; i < blk * 128; i += NTHREADS) KM[i] = kmean[(size_t)bh * 64 * 128 + i];
        if (tid < 64) hist[tid] = 0;
        float q[64];
        { const bf16_t* qp = proj + (size_t)(b * TT + t) * NPJ + OFF_MQ + h * 128 + half * 64;
#pragma unroll
          for (int i = 0; i < 8; ++i) { const u32x4 raw = *(const u32x4*)(qp + 8 * i); q[8 * i] = bflo(raw.x); q[8 * i + 1] = bfhi(raw.x); q[8 * i + 2] = bflo(raw.y); q[8 * i + 3] = bfhi(raw.y);
              q[8 * i + 4] = bflo(raw.z); q[8 * i + 5] = bfhi(raw.z); q[8 * i + 6] = bflo(raw.w); q[8 * i + 7] = bfhi(raw.w); } }
        __syncthreads();
        float v0 = -INFINITY, v1 = -INFINITY, v2 = -INFINITY; int i0 = -1, i1 = -1, i2 = -1;
        for (int n = 0; n < blk; ++n) { const LAS float* km = KM + n * 128 + half * 64; float d0 = 0.f, d1 = 0.f, d2 = 0.f, d3 = 0.f;
#pragma unroll
            for (int i = 0; i < 16; ++i) { const f32x4 kv = *(const LAS f32x4*)(km + 4 * i); d0 += q[4 * i] * kv[0]; d1 += q[4 * i + 1] * kv[1]; d2 += q[4 * i + 2] * kv[2]; d3 += q[4 * i + 3] * kv[3]; }
            float g = (d0 + d1) + (d2 + d3); g += __shfl_xor(g, 1);
            if (g > v0) { v2 = v1; i2 = i1; v1 = v0; i1 = i0; v0 = g; i0 = n; } else if (g > v1) { v2 = v1; i2 = i1; v1 = g; i1 = n; } else if (g > v2) { v2 = g; i2 = n; } }
        int rk0 = 0, rk1 = 0, rk2 = 0;
        if (half == 0) { if (i0 >= 0) rk0 = __hip_atomic_fetch_add(&hist[i0], 1, __ATOMIC_RELAXED, __HIP_MEMORY_SCOPE_WORKGROUP); if (i1 >= 0) rk1 = __hip_atomic_fetch_add(&hist[i1], 1, __ATOMIC_RELAXED, __HIP_MEMORY_SCOPE_WORKGROUP); if (i2 >= 0) rk2 = __hip_atomic_fetch_add(&hist[i2], 1, __ATOMIC_RELAXED, __HIP_MEMORY_SCOPE_WORKGROUP); }
        __syncthreads();
        if (tid < 64) { const int c = hist[tid]; hbase[tid] = c > 0 ? atomicAdd(&cnt[bh * 64 + tid], c) : 0; }
        __syncthreads();
        if (half == 0) {
            const f32x2 dead = {-INFINITY, 0.f};
            if (i0 >= 0) list[(size_t)bh * LISTN + i0 * 16384 - 128 * i0 * (i0 + 1) + hbase[i0] + rk0] = t; else ML[0 * 262144 + rid] = dead;
            if (i1 >= 0) list[(size_t)bh * LISTN + i1 * 16384 - 128 * i1 * (i1 + 1) + hbase[i1] + rk1] = t | (1 << 14); else ML[1 * 262144 + rid] = dead;
            if (i2 >= 0) list[(size_t)bh * LISTN + i2 * 16384 - 128 * i2 * (i2 + 1) + hbase[i2] + rk2] = t | (2 << 14); else ML[2 * 262144 + rid] = dead;
        }
        __syncthreads();
    }
}

constexpr int G2_W = 0, G2_Q = 18432, G2_QK = 36864, G2_KD = 47104, G2_BUF = 67584, G2_RED = 135168;
DI void phase_gdn_scan(const Params& P, LAS unsigned char* lds, int bh, const unsigned* flag, unsigned need, int n_first) {
    const int tid = opq_tid(), lane = tid & 63, w = tid >> 6, fr = lane & 15, fq = lane >> 4, b = bh >> 3, h = bh & 7;
    const bf16_t* proj = (const bf16_t*)(P.ws + WS_R1); const bf16_t* W2 = (const bf16_t*)(P.ws + WS_W2); const bf16_t* QKB = (const bf16_t*)(P.ws + WS_QKB);
    const float* GL = (const float*)(P.ws + WS_GL); bf16_t* mix = (bf16_t*)(P.ws + WS_R2);
    float* SSQ = (float*)(P.ws + WS_SSQ);
    const int e = 16 * w + fr; const float gnw = P.gdn_norm[e];
    f32x4 S[8];
#pragma unroll
    for (int i = 0; i < 8; ++i) S[i] = (f32x4){0.f, 0.f, 0.f, 0.f};
    const int wrow0 = tid >> 4, wseg = tid & 15;
    const int qrow = tid >> 3, qseg = tid & 7;
    struct Stage { u32x4 sw[2], sq[2], sqk, skd[2]; };
    u32x2 un[4];
    Stage stA, stB;
#define G2_LOAD(X, nn) do { const int t0_ = b * TT + (nn) * 64; const int ci_ = ((b * 256 + (nn)) << 3) + h; \
        _Pragma("unroll") for (int i_ = 0; i_ < 2; ++i_) { X.sw[i_] = *(const u32x4*)(W2 + (size_t)(t0_ + wrow0 + 32 * i_) * 1024 + h * 128 + wseg * 8); \
            X.sq[i_] = *(const u32x4*)(proj + (size_t)(t0_ + wrow0 + 32 * i_) * NPJ + OFF_GQ + h * 128 + wseg * 8); \
            const int d_ = qrow + 64 * i_; X.skd[i_] = *(const u32x4*)(proj + (size_t)(t0_ + (d_ >> 1)) * NPJ + OFF_GK + h * 128 + (d_ & 1) * 64 + qseg * 8); } \
        X.sqk = *(const u32x4*)(QKB + (size_t)ci_ * 4096 + qrow * 64 + qseg * 8); } while (0)
#define UN_LOAD(nn) do { const int t0_ = b * TT + (nn) * 64; _Pragma("unroll") for (int mt_ = 0; mt_ < 4; ++mt_) un[mt_] = *(const u32x2*)(proj + (size_t)(t0_ + (e >> 1)) * NPJ + OFF_GV + h * 128 + (e & 1) * 64 + 16 * mt_ + 4 * fq); } while (0)
#define G2_ST2(base_, rowoff_, sg_, v_) do { const int g_ = ((sg_) >> 2) * 64, d_ = ((sg_) & 3) * 8; \
        *(LAS u32x2*)(B_ + (base_) + (rowoff_) + g_ + perm4(d_) * 2) = (u32x2){(v_).x, (v_).y}; *(LAS u32x2*)(B_ + (base_) + (rowoff_) + g_ + perm4(d_ + 4) * 2) = (u32x2){(v_).z, (v_).w}; } while (0)
#define G2_STORE(X, bufi) do { LAS unsigned char* B_ = lds + (bufi) * G2_BUF; \
        _Pragma("unroll") for (int i_ = 0; i_ < 2; ++i_) { G2_ST2(G2_W, (wrow0 + 32 * i_) * 288, wseg, X.sw[i_]); G2_ST2(G2_Q, (wrow0 + 32 * i_) * 288, wseg, X.sq[i_]); \
            G2_ST2(G2_KD, (qrow + 64 * i_) * 160, qseg, X.skd[i_]); } \
        G2_ST2(G2_QK, qrow * 160, qseg, X.sqk); } while (0)
    G2_LOAD(stA, 0); G2_STORE(stA, 0); UN_LOAD(0);
    float egl_n = GL[bh * 256];
    u32x2 uc[4];
#pragma unroll
    for (int i = 0; i < 4; ++i) uc[i] = un[i];
    G2_LOAD(stA, 1);
    __syncthreads();
    for (int n2 = 0; n2 < 256; n2 += 2) {
#pragma unroll
      for (int hf2 = 0; hf2 < 2; ++hf2) {
        const int n = n2 + hf2; Stage& LDs = hf2 ? stA : stB; Stage& STs = hf2 ? stB : stA;
        if (n == n_first - 2 || n == 62 || n == 126) {
            const unsigned* fl = (n == 126) ? flag + 1 : (n == 62 ? flag : flag + 2);
            if (tid == 0) { while (__hip_atomic_load(fl, __ATOMIC_RELAXED, __HIP_MEMORY_SCOPE_AGENT) < need) __builtin_amdgcn_s_sleep(8);
                __builtin_amdgcn_fence(__ATOMIC_ACQUIRE, "agent"); asm volatile("s_waitcnt vmcnt(0)" ::: "memory"); }
            __syncthreads(); }
        const int cur = hf2, t0 = b * TT + n * 64; LAS unsigned char* Bf = lds + cur * G2_BUF;
        { const int n2c = n + 2 < 256 ? n + 2 : 255, n1c = n + 1 < 256 ? n + 1 : 255; G2_LOAD(LDs, n2c); UN_LOAD(n1c); }
        const float egl = egl_n; egl_n = GL[bh * 256 + (n + 1 < 256 ? n + 1 : 255)];
        f32x4 Pm[4], Om[4];
#pragma unroll
        for (int mt = 0; mt < 4; ++mt) { Pm[mt] = (f32x4){0.f, 0.f, 0.f, 0.f}; Om[mt] = (f32x4){0.f, 0.f, 0.f, 0.f}; }
#define SBAR __builtin_amdgcn_sched_barrier(0)
#define LD_K4(dst, base_, ks_) do { const int o0_ = fr * 288 + (32 * (ks_) + 8 * fq) * 2; \
        dst[0] = *(const LAS bf16x8*)(Bf + base_ + o0_); dst[1] = *(const LAS bf16x8*)(Bf + base_ + o0_ + 4608); \
        dst[2] = *(const LAS bf16x8*)(Bf + base_ + o0_ + 9216); dst[3] = *(const LAS bf16x8*)(Bf + base_ + o0_ + 13824); } while (0)
#define MM_K4(src, sb_, A_) do { A_[0] = mfma16(src[0], sb_, A_[0]); A_[1] = mfma16(src[1], sb_, A_[1]); A_[2] = mfma16(src[2], sb_, A_[2]); A_[3] = mfma16(src[3], sb_, A_[3]); } while (0)
#define LD_R4(dst, base_, r0_, k2_) do { const int o0_ = (16 * (r0_) + fr) * 160 + (32 * (k2_) + 8 * fq) * 2; \
        dst[0] = *(const LAS bf16x8*)(Bf + base_ + o0_); dst[1] = *(const LAS bf16x8*)(Bf + base_ + o0_ + 2560); \
        dst[2] = *(const LAS bf16x8*)(Bf + base_ + o0_ + 5120); dst[3] = *(const LAS bf16x8*)(Bf + base_ + o0_ + 7680); } while (0)
#define MM_R4(src, vb_, A0_, A1_, A2_, A3_) do { A0_ = mfma16(src[0], vb_, A0_); A1_ = mfma16(src[1], vb_, A1_); A2_ = mfma16(src[2], vb_, A2_); A3_ = mfma16(src[3], vb_, A3_); } while (0)
        bf16x8 fa[4], fb[4];
        LD_K4(fa, G2_W, 0);
        const bf16x8 sb0 = pack8(S[0], S[1]), sb1 = pack8(S[2], S[3]), sb2 = pack8(S[4], S[5]), sb3 = pack8(S[6], S[7]);
        LD_K4(fb, G2_W, 1); SBAR; MM_K4(fa, sb0, Pm); SBAR;
        LD_K4(fa, G2_W, 2); SBAR; MM_K4(fb, sb1, Pm); SBAR;
        LD_K4(fb, G2_W, 3); SBAR; MM_K4(fa, sb2, Pm); SBAR;
        LD_K4(fa, G2_Q, 0); SBAR; MM_K4(fb, sb3, Pm); SBAR;
        f32x4 vn[4];
#pragma unroll
        for (int mt = 0; mt < 4; ++mt) { vn[mt][0] = bflo(uc[mt].x) - Pm[mt][0]; vn[mt][1] = bfhi(uc[mt].x) - Pm[mt][1]; vn[mt][2] = bflo(uc[mt].y) - Pm[mt][2]; vn[mt][3] = bfhi(uc[mt].y) - Pm[mt][3]; }
        bf16x8 Vb[2];
#pragma unroll
        for (int k2 = 0; k2 < 2; ++k2) Vb[k2] = pack8(vn[2 * k2], vn[2 * k2 + 1]);
        LD_K4(fb, G2_Q, 1); SBAR; MM_K4(fa, sb0, Om); SBAR;
        LD_K4(fa, G2_Q, 2); SBAR; MM_K4(fb, sb1, Om); SBAR;
        LD_K4(fb, G2_Q, 3); SBAR; MM_K4(fa, sb2, Om); SBAR;
        LD_R4(fa, G2_QK, 0, 0); SBAR; MM_K4(fb, sb3, Om); SBAR;
#pragma unroll
        for (int dt = 0; dt < 8; ++dt) S[dt] = S[dt] * egl;
        SBAR;
        LD_R4(fb, G2_QK, 0, 1); SBAR; MM_R4(fa, Vb[0], Om[0], Om[1], Om[2], Om[3]); SBAR;
        LD_R4(fa, G2_KD, 0, 0); SBAR; MM_R4(fb, Vb[1], Om[0], Om[1], Om[2], Om[3]); SBAR;
        LD_R4(fb, G2_KD, 0, 1); SBAR; MM_R4(fa, Vb[0], S[0], S[1], S[2], S[3]); SBAR;
        LD_R4(fa, G2_KD, 4, 0); SBAR; MM_R4(fb, Vb[1], S[0], S[1], S[2], S[3]); SBAR;
        LD_R4(fb, G2_KD, 4, 1); SBAR; MM_R4(fa, Vb[0], S[4], S[5], S[6], S[7]); SBAR;
        MM_R4(fb, Vb[1], S[4], S[5], S[6], S[7]); SBAR;
#undef LD_K4
#undef MM_K4
#undef LD_R4
#undef MM_R4
#undef SBAR
        { G2_STORE(STs, cur ^ 1);
#pragma unroll
            for (int i = 0; i < 4; ++i) uc[i] = un[i]; }
        { LAS bf16_t* OTW = (LAS bf16_t*)(lds + G2_RED + w * 2048);
#pragma unroll
          for (int mt = 0; mt < 4; ++mt)
#pragma unroll
            for (int j = 0; j < 4; ++j) OTW[(16 * mt + 4 * fq + j) * 16 + fr] = f2bf(Om[mt][j]);
#pragma unroll
          for (int i = 0; i < 2; ++i) { const int row = (lane >> 1) + 32 * i, hv = lane & 1;
              bf16_t* mp_ = mix + (size_t)(t0 + row) * DM + h * 128 + 16 * w + 8 * hv; const u32x4 ov_ = *(const LAS u32x4*)(OTW + row * 16 + hv * 8);
              asm volatile("global_store_dwordx4 %0, %1, off" :: "v"(mp_), "v"(ov_) : "memory"); } }
        __syncthreads();
      }
    }
#undef G2_LOAD
#undef UN_LOAD
#undef G2_STORE
#undef G2_ST2
    asm volatile("s_waitcnt vmcnt(0)" ::: "memory");
    __syncthreads();
}

constexpr int AT_KS = 0, AT_VT = 73728, AT_PF = 143360, AT_MISC = 147712;
DI void phase_moba_attn(const Params& P, LAS unsigned char* lds) {
    const int tid = opq_tid(), lane = tid & 63, w = tid >> 6, fr = lane & 15, fq = lane >> 4;
    const bf16_t* proj = (const bf16_t*)(P.ws + WS_R1); const int* cnt = (const int*)(P.ws + WS_CNT); const int* list = (const int*)(P.ws + WS_LIST);
    f32x2* ML = (f32x2*)(P.ws + WS_ML); bf16_t* opart = (bf16_t*)P.out; unsigned* workctr = (unsigned*)(P.ws + WS_CTL);
    LAS bf16_t* KS = (LAS bf16_t*)(lds + AT_KS); LAS bf16_t* VT = (LAS bf16_t*)(lds + AT_VT); LAS int* PF = (LAS int*)(lds + AT_PF); LAS int* MISC = (LAS int*)(lds + AT_MISC);
    { const int c0 = cnt[2 * tid], c1 = cnt[2 * tid + 1]; const int a = (c0 + 511) >> 9, bsum = a + ((c1 + 511) >> 9); int inc = bsum;
#pragma unroll
      for (int o = 1; o < 64; o <<= 1) { const int v = __shfl_up(inc, o); if (lane >= o) inc += v; }
      if (lane == 63) MISC[8 + w] = inc;
      __syncthreads();
      int wb = 0;
#pragma unroll
      for (int i = 0; i < 8; ++i) wb += (i < w) ? MISC[8 + i] : 0;
      const int ex = wb + inc - bsum; PF[2 * tid] = ex; PF[2 * tid + 1] = ex + a; if (tid == 511) PF[1024] = ex + bsum;
      __syncthreads(); }
    const int totalG = PF[1024];
    const float sc2 = 0.08838834764831845f * 1.4426950408889634f;
    const int tid_at = tid;
    for (;;) {
        int tid = tid_at; asm volatile("" : "+v"(tid)); const int lane = tid & 63, w = __builtin_amdgcn_readfirstlane(tid >> 6), fr = lane & 15, fq = lane >> 4;
        if (tid == 0) MISC[0] = (int)atomicAdd(workctr, 1u);
        __syncthreads();
        const int wid = MISC[0];
        __syncthreads();
        if (wid >= totalG + 1024) break;
        int bh, j, causal, qstart, qcount;
        if (wid < totalG) { int lo = 0, hi = 1024; while (hi - lo > 1) { const int mid = (lo + hi) >> 1; if (PF[mid] <= wid) lo = mid; else hi = mid; }
            bh = lo >> 6; j = lo & 63; causal = 0; qstart = (wid - PF[lo]) * 512; const int c = cnt[lo]; qcount = c - qstart; if (qcount > 512) qcount = 512; }
        else { const int o = wid - totalG; bh = o >> 6; j = o & 63; causal = 1; qstart = 0; qcount = 256; }
        const int b = bh >> 3, h = bh & 7; const size_t kbase = (size_t)(b * TT + j * 256);
        { u32x4 kr[8], vr[8];
#pragma unroll
          for (int i8 = 0; i8 < 8; ++i8) { const int pid = tid + i8 * 512; kr[i8] = *(const u32x4*)(proj + (kbase + (pid >> 4)) * NPJ + OFF_MK + h * 128 + (pid & 15) * 8);
              const int e = pid >> 5, ks = pid & 31; vr[i8] = *(const u32x4*)(proj + (kbase + 2 * e + (ks >> 4)) * NPJ + OFF_MV + h * 128 + (ks & 15) * 8); }
#pragma unroll
          for (int i8 = 0; i8 < 8; ++i8) { const int pid = tid + i8 * 512; *(LAS u32x4*)(KS + (pid >> 4) * 144 + (pid & 15) * 8) = kr[i8];
              const int e = pid >> 5, ks = pid & 31; const int g_ = (ks >> 2) * 32, d_ = (ks & 3) * 8;
              *(LAS u32x2*)(VT + e * 272 + g_ + perm4(d_)) = (u32x2){vr[i8].x, vr[i8].y}; *(LAS u32x2*)(VT + e * 272 + g_ + perm4(d_ + 4)) = (u32x2){vr[i8].z, vr[i8].w}; } }
        const int lbase = bh * LISTN + j * 16384 - 128 * j * (j + 1) + qstart;
        const int ntile = (qcount + 127) >> 7;
        int en0, en1, en2, en3;
        { const int q0 = 16 * w + fr, lim = qcount - 1;
          if (causal) { en0 = (j * 256 + q0) | (3 << 14); en1 = (j * 256 + q0 + 128) | (3 << 14); en2 = en1; en3 = en1; }
          else { en0 = list[lbase + (q0 < lim ? q0 : lim)]; en1 = list[lbase + (q0 + 128 < lim ? q0 + 128 : lim)]; en2 = list[lbase + (q0 + 256 < lim ? q0 + 256 : lim)]; en3 = list[lbase + (q0 + 384 < lim ? q0 + 384 : lim)]; } }
        bf16x8 Bq[4], Bn[4];
        { const bf16_t* qp = proj + (size_t)(b * TT + (en0 & 16383)) * NPJ + OFF_MQ + h * 128 + 8 * fq;
#pragma unroll
          for (int ks = 0; ks < 4; ++ks) Bq[ks] = *(const bf16x8*)(qp + 32 * ks); }
        __syncthreads();
        for (int tile = 0; tile < ntile; ++tile) {
            const int en = tile == 0 ? en0 : (tile == 1 ? en1 : (tile == 2 ? en2 : en3));
            { const int enx = tile == 0 ? en1 : (tile == 1 ? en2 : en3); const bf16_t* qp = proj + (size_t)(b * TT + (enx & 16383)) * NPJ + OFF_MQ + h * 128 + 8 * fq;
#pragma unroll
              for (int ks = 0; ks < 4; ++ks) Bn[ks] = *(const bf16x8*)(qp + 32 * ks); }
            const int qi = tile * 128 + 16 * w + fr; const bool valid = qi < qcount; const int t = en & 16383, slot = en >> 14;
            if (tile * 128 + 16 * w < qcount) {
            const int nkt = causal ? (8 * tile + w + 1) : 16;
            f32x4 st[16]; float mx = -INFINITY;
#pragma unroll
            for (int kp = 0; kp < 8; ++kp) { f32x4 a0 = {0.f, 0.f, 0.f, 0.f}, a1 = {0.f, 0.f, 0.f, 0.f};
                if (2 * kp < nkt) { bf16x8 kf[8];
#pragma unroll
                    for (int ks = 0; ks < 4; ++ks) { kf[ks] = *(const LAS bf16x8*)(KS + (32 * kp + fr) * 144 + 32 * ks + 8 * fq); kf[4 + ks] = *(const LAS bf16x8*)(KS + (32 * kp + 16 + fr) * 144 + 32 * ks + 8 * fq); }
#pragma unroll
                    for (int ks = 0; ks < 4; ++ks) { a0 = mfma16(kf[ks], Bq[ks], a0); a1 = mfma16(kf[4 + ks], Bq[ks], a1); }
#pragma unroll
                    for (int jj = 0; jj < 4; ++jj) { float s0 = a0[jj] * sc2, s1 = a1[jj] * sc2;
                        if (causal && (32 * kp + 4 * fq + jj) > qi) s0 = -INFINITY; if ((causal && (32 * kp + 16 + 4 * fq + jj) > qi) || 2 * kp + 1 >= nkt) s1 = -INFINITY;
                        a0[jj] = s0; a1[jj] = s1; mx = fmaxf(mx, fmaxf(s0, s1)); }
                } else { a0 = (f32x4){-INFINITY, -INFINITY, -INFINITY, -INFINITY}; a1 = a0; }
                st[2 * kp] = a0; st[2 * kp + 1] = a1; }
            mx = fmaxf(mx, __shfl_xor(mx, 16)); mx = fmaxf(mx, __shfl_xor(mx, 32));
            float ls = 0.f;
#pragma unroll
            for (int kt = 0; kt < 16; ++kt)
#pragma unroll
                for (int jj = 0; jj < 4; ++jj) { const float pv = exp2f(st[kt][jj] - mx); st[kt][jj] = pv; ls += pv; }
            ls += __shfl_xor(ls, 16); ls += __shfl_xor(ls, 32);
            f32x4 ot[8];
#pragma unroll
            for (int et = 0; et < 8; ++et) ot[et] = (f32x4){0.f, 0.f, 0.f, 0.f};
#pragma unroll
            for (int k2 = 0; k2 < 8; ++k2) { if (2 * k2 < nkt) { const bf16x8 pb = pack8(st[2 * k2], st[2 * k2 + 1]);
#pragma unroll
                    for (int eh = 0; eh < 2; ++eh) { bf16x8 vf[4];
#pragma unroll
                        for (int et = 0; et < 4; ++et) vf[et] = *(const LAS bf16x8*)(VT + (16 * (4 * eh + et) + fr) * 272 + 32 * k2 + 8 * fq);
#pragma unroll
                        for (int et = 0; et < 4; ++et) ot[4 * eh + et] = mfma16(vf[et], pb, ot[4 * eh + et]); } } }
            if (valid) { const float il = 1.f / ls; const size_t rid = (size_t)bh * TT + t; bf16_t* op = opart + ((size_t)slot * 262144 + rid) * 128 + 4 * fq;
#pragma unroll
                for (int et = 0; et < 8; ++et) { u32x2 wv; wv.x = pk2(ot[et][0] * il, ot[et][1] * il); wv.y = pk2(ot[et][2] * il, ot[et][3] * il); *(u32x2*)(op + 16 * et) = wv; }
                if (fq == 0) ML[(size_t)slot * 262144 + rid] = (f32x2){mx, ls}; }
            }
#pragma unroll
            for (int ks = 0; ks < 4; ++ks) Bq[ks] = Bn[ks];
        }
        __syncthreads();
    }
}

DI void phase_moba_combine(const Params& P, bool do_gate, bool do_moba, int wg0, int nwg) {
    const bf16_t* opart = (const bf16_t*)P.out; const f32x2* ML = (const f32x2*)(P.ws + WS_ML); bf16_t* mix = (bf16_t*)(P.ws + WS_R2);
    const int gtid = wg0 * NTHREADS + opq_tid(), gsz = nwg * NTHREADS;
    if (do_gate) { const bf16_t* proj = (const bf16_t*)(P.ws + WS_R1);
      for (int i0 = gtid; i0 < MT * 128; i0 += 4 * gsz) { u32x4 mv[4], zv[4];
#pragma unroll
          for (int k = 0; k < 4; ++k) { const int i = i0 + k * gsz < MT * 128 ? i0 + k * gsz : i0; const int row = i >> 7, sg = i & 127; mv[k] = *(const u32x4*)(mix + (size_t)row * DM + sg * 8); zv[k] = *(const u32x4*)(proj + (size_t)row * NPJ + OFF_GZ + sg * 8); }
          const int sg0 = i0 & 127; const f32x4 g0 = *(const f32x4*)(P.gdn_norm + (sg0 & 15) * 8), g1 = *(const f32x4*)(P.gdn_norm + (sg0 & 15) * 8 + 4);
#pragma unroll
          for (int k = 0; k < 4; ++k) { const int i = i0 + k * gsz; const int row = i >> 7, sg = i & 127;
              float o[8]; o[0] = bflo(mv[k].x); o[1] = bfhi(mv[k].x); o[2] = bflo(mv[k].y); o[3] = bfhi(mv[k].y); o[4] = bflo(mv[k].z); o[5] = bfhi(mv[k].z); o[6] = bflo(mv[k].w); o[7] = bfhi(mv[k].w);
              float ssl = 0.f;
#pragma unroll
              for (int q = 0; q < 8; ++q) ssl += o[q] * o[q];
              const float rs = rsqrtf(row16_sum(ssl) * (1.f / 128.f) + 1e-6f); const u32x4 z = zv[k];
              u32x4 wv; wv.x = pk2(o[0] * rs * g0[0] * silu_f(bflo(z.x)), o[1] * rs * g0[1] * silu_f(bfhi(z.x))); wv.y = pk2(o[2] * rs * g0[2] * silu_f(bflo(z.y)), o[3] * rs * g0[3] * silu_f(bfhi(z.y)));
              wv.z = pk2(o[4] * rs * g1[0] * silu_f(bflo(z.z)), o[5] * rs * g1[1] * silu_f(bfhi(z.z))); wv.w = pk2(o[6] * rs * g1[2] * silu_f(bflo(z.w)), o[7] * rs * g1[3] * silu_f(bfhi(z.w)));
              if (i < MT * 128) *(u32x4*)(mix + (size_t)row * DM + sg * 8) = wv; } } }
    if (do_moba) for (int i0 = gtid; i0 < 262144 * 16; i0 += 2 * gsz) {
        f32x2 ml[2][4]; u32x4 raw[2][4];
#pragma unroll
        for (int k = 0; k < 2; ++k) { const int i = i0 + k * gsz < 262144 * 16 ? i0 + k * gsz : i0; const int rid = i >> 4, sg = i & 15;
#pragma unroll
            for (int s = 0; s < 4; ++s) { ml[k][s] = ML[(size_t)s * 262144 + rid]; raw[k][s] = *(const u32x4*)(opart + ((size_t)s * 262144 + rid) * 128 + sg * 8); } }
#pragma unroll
        for (int k = 0; k < 2; ++k) { const int i = i0 + k * gsz; const int rid = i >> 4, sg = i & 15; const int bh = rid >> 14, t = rid & 16383, b = bh >> 3, h = bh & 7;
            float M = -INFINITY;
#pragma unroll
            for (int s = 0; s < 4; ++s) M = fmaxf(M, ml[k][s].x);
            float wgt[4], Lt = 0.f;
#pragma unroll
            for (int s = 0; s < 4; ++s) { wgt[s] = ml[k][s].y > 0.f ? ml[k][s].y * exp2f(ml[k][s].x - M) : 0.f; Lt += wgt[s]; }
            const float iL = 1.f / Lt; float o[8];
#pragma unroll
            for (int q = 0; q < 8; ++q) o[q] = 0.f;
#pragma unroll
            for (int s = 0; s < 4; ++s) { const float ww = wgt[s] * iL; const u32x4 r = raw[k][s];
                if (wgt[s] > 0.f) { o[0] += ww * bflo(r.x); o[1] += ww * bfhi(r.x); o[2] += ww * bflo(r.y); o[3] += ww * bfhi(r.y); o[4] += ww * bflo(r.z); o[5] += ww * bfhi(r.z); o[6] += ww * bflo(r.w); o[7] += ww * bfhi(r.w); } }
            u32x4 wv; wv.x = pk2(o[0], o[1]); wv.y = pk2(o[2], o[3]); wv.z = pk2(o[4], o[5]); wv.w = pk2(o[6], o[7]);
            if (i < 262144 * 16) *(u32x4*)(mix + (size_t)(b * TT + t) * DM + 1024 + h * 128 + sg * 8) = wv; } }
}

DI void sub_barrier(unsigned* ctr, unsigned nwg) {
    asm volatile("s_waitcnt vmcnt(0)" ::: "memory");
    __syncthreads();
    if (threadIdx.x == 0) {
        __builtin_amdgcn_fence(__ATOMIC_RELEASE, "agent");
        __hip_atomic_fetch_add(ctr, 1u, __ATOMIC_RELAXED, __HIP_MEMORY_SCOPE_AGENT);
        while (__hip_atomic_load(ctr, __ATOMIC_RELAXED, __HIP_MEMORY_SCOPE_AGENT) < nwg) __builtin_amdgcn_s_sleep(8);
        __builtin_amdgcn_fence(__ATOMIC_ACQUIRE, "agent");
        asm volatile("s_waitcnt vmcnt(0)" ::: "memory");
    }
    __syncthreads();
}

__global__ void __launch_bounds__(NTHREADS) hybrid_fwd(Params P) {
    extern __shared__ __attribute__((aligned(16))) unsigned char smem[];
    LAS unsigned char* lds = (LAS unsigned char*)smem;
    cg::grid_group grid = cg::this_grid();
    unsigned char* ws = P.ws; const int G = gridDim.x, bx = blockIdx.x;
    bf16_t* R0 = (bf16_t*)(ws + WS_R0); bf16_t* R1 = (bf16_t*)(ws + WS_R1); bf16_t* R2 = (bf16_t*)(ws + WS_R2);
    float* ss1 = (float*)(ws + WS_SS1); float* ss2 = (float*)(ws + WS_SS2);

    phase_prep(P, lds);
    grid.sync();
    { pg8::Gemm g{R0, (const bf16_t*)(ws + WS_WIN), MT, NPJ, DM}; pg8::StaticOrder S; S.init(MT, NPJ, G, bx); EpiProj E{R1, (bf16_t*)(ws + WS_HALO)}; pg8::gemm_phase<decltype(E), pg8::StaticOrder, true, true>(lds, g, S, E); }
    phase_ba(P);
    grid.sync();
    phase_gdn_prep(P, lds, 0, 32, bx, G, (unsigned*)(ws + WS_CTL) + 14, 0x7fffffff);
    if (bx < 16) {
        if (threadIdx.x == 0) { const unsigned* f14 = (const unsigned*)(ws + WS_CTL) + 14; while (__hip_atomic_load(f14, __ATOMIC_RELAXED, __HIP_MEMORY_SCOPE_AGENT) < (unsigned)G) __builtin_amdgcn_s_sleep(8);
            __builtin_amdgcn_fence(__ATOMIC_ACQUIRE, "agent"); asm volatile("s_waitcnt vmcnt(0)" ::: "memory"); }
        __syncthreads(); }
    if (bx < 16) phase_gdn_scan(P, lds, bx, (const unsigned*)(ws + WS_CTL) + 11, (unsigned)(G - 16), 32);
    else { unsigned* ctl = (unsigned*)(ws + WS_CTL);
        phase_gdn_prep(P, lds, 32, 224, bx - 16, G - 16, ctl + 11, 768, ctl + 13, 256);
        asm volatile("s_waitcnt vmcnt(0)" ::: "memory"); __syncthreads();
        if (threadIdx.x == 0) { __builtin_amdgcn_fence(__ATOMIC_RELEASE, "agent"); __hip_atomic_fetch_add(ctl + 12, 1u, __ATOMIC_RELAXED, __HIP_MEMORY_SCOPE_AGENT); }
        phase_moba_prep(P, lds, bx - 16, G - 16); sub_barrier(ctl + 8, (unsigned)(G - 16));
        phase_moba_select(P, lds, bx - 16, G - 16); sub_barrier(ctl + 9, (unsigned)(G - 16));
        phase_moba_attn(P, lds);
        phase_wconv_late(P, lds, bx - 16, G - 16);
        sub_barrier(ctl + 10, (unsigned)(G - 16)); phase_moba_combine(P, false, true, bx - 16, G - 16); }
    grid.sync();
    phase_moba_combine(P, true, false, bx, G);
    grid.sync();
    { pg8::Gemm g{R2, (const bf16_t*)(ws + WS_WO), MT, DM, DM}; pg8::StaticOrder S; S.init(MT, DM, G, bx); EpiResid E{P.x, P.out, R0, ss1}; pg8::gemm_phase<decltype(E), pg8::StaticOrder, true, false>(lds, g, S, E); }
    grid.sync();
    { pg8::Gemm g{R0, (const bf16_t*)(ws + WS_WGU), MT, 2 * FF, DM}; pg8::StaticOrder S; S.init(MT, 2 * FF, G, bx); EpiAct E{R1, ss1}; pg8::gemm_phase<decltype(E), pg8::StaticOrder, true, true>(lds, g, S, E); }
    grid.sync();
    { pg8::Gemm g{(const bf16_t*)(ws + WS_PB), (const bf16_t*)(ws + WS_WPP), MT, DM, 256}; pg8::StaticOrder S; S.init(MT, DM, G, bx); EpiPlainBf16 E{R0, DM}; pg8::gemm_phase<decltype(E), pg8::StaticOrder, true, false>(lds, g, S, E); }
    { pg8::Gemm g{R1, (const bf16_t*)(ws + WS_WDN), MT, DM, FF}; pg8::StaticOrder S; S.init(MT, DM, G, bx); EpiResid E{P.out, P.out, R2, ss2}; pg8::gemm_phase<decltype(E), pg8::StaticOrder, true, false>(lds, g, S, E); }
    grid.sync();
    { pg8::Gemm g{R2, (const bf16_t*)(ws + WS_WPG), MT, DM, DM}; pg8::StaticOrder S; S.init(MT, DM, G, bx); EpiOut E{P.out, R0, ss2}; pg8::gemm_phase<decltype(E), pg8::StaticOrder, true, false>(lds, g, S, E); }
}

extern "C" void kernel_launch(void* const* d_in, const int* in_sizes, int n_in, void* d_out, int out_size, void* d_ws, size_t ws_size, hipStream_t stream) {
    static int grid_blocks = 0;
    if (!grid_blocks) {
        int dev = 0, cus = 0, per_cu = 0;
        hipGetDevice(&dev);
        hipDeviceGetAttribute(&cus, hipDeviceAttributeMultiprocessorCount, dev);
        hipFuncSetAttribute((const void*)hybrid_fwd, hipFuncAttributeMaxDynamicSharedMemorySize, LDS_BYTES);
        hipOccupancyMaxActiveBlocksPerMultiprocessor(&per_cu, (const void*)hybrid_fwd, NTHREADS, LDS_BYTES);
        if (per_cu < 1) per_cu = 1;
        grid_blocks = cus * per_cu;
        if (ws_size < WS_END) fprintf(stderr, "kernel_launch: workspace too small: %zu < %zu\n", ws_size, (size_t)WS_END);
    }
    Params p{};
    p.x = (const float*)d_in[0]; p.p = (const float*)d_in[1]; p.attn_norm = (const float*)d_in[2]; p.w_in = (const float*)d_in[3]; p.conv_w = (const float*)d_in[4];
    p.A_log = (const float*)d_in[5]; p.dt_bias = (const float*)d_in[6]; p.gdn_norm = (const float*)d_in[7]; p.q_norm = (const float*)d_in[8]; p.k_norm = (const float*)d_in[9];
    p.w_o = (const float*)d_in[10]; p.ffn_norm = (const float*)d_in[11]; p.w_gate = (const float*)d_in[12]; p.w_up = (const float*)d_in[13]; p.w_down = (const float*)d_in[14];
    p.ple_norm = (const float*)d_in[15]; p.w_pg = (const float*)d_in[16]; p.w_pp = (const float*)d_in[17];
    p.out = (float*)d_out; p.ws = (unsigned char*)d_ws;
    void* args[] = {&p};
    hipError_t e = hipLaunchCooperativeKernel((const void*)hybrid_fwd, dim3(grid_blocks), dim3(NTHREADS), args, LDS_BYTES, stream);
    if (e != hipSuccess) fprintf(stderr, "cooperative launch failed: %s (grid %d)\n", hipGetErrorString(e), grid_blocks);
}
```

```cpp
#include <hip/hip_runtime.h>
#include <hip/hip_cooperative_groups.h>
#include <cstdio>
namespace cg = cooperative_groups;

#define LAS __attribute__((address_space(3)))
#define DI __device__ __forceinline__
typedef unsigned short bf16_t;
typedef short bf16x8 __attribute__((ext_vector_type(8)));
typedef float f32x4 __attribute__((ext_vector_type(4)));
typedef float f32x2 __attribute__((ext_vector_type(2)));
typedef unsigned u32x4 __attribute__((ext_vector_type(4)));
typedef unsigned u32x2 __attribute__((ext_vector_type(2)));
typedef __bf16 bfv2 __attribute__((ext_vector_type(2)));

constexpr int DM = 2048, TT = 16384, MT = 32768, NPJ = 7168, FF = 5632, INW = 7184;
constexpr int OFF_GQ = 0, OFF_GK = 1024, OFF_GV = 2048, OFF_GZ = 3072, OFF_MQ = 4096, OFF_MK = 5120, OFF_MV = 6144;
constexpr int LISTN = 516096;
constexpr int NTHREADS = 512;
constexpr int LDS_BYTES = 163840;

constexpr size_t WS_CTL   = 0;
constexpr size_t WS_CNT   = 4096;
constexpr size_t WS_SS1   = 8192;
constexpr size_t WS_SS2   = WS_SS1 + 131072;
constexpr size_t WS_GL    = WS_SS2 + 131072;
constexpr size_t WS_KMEAN = WS_GL + 16384;
constexpr size_t WS_WBA   = WS_KMEAN + 524288;
constexpr size_t WS_BA    = WS_WBA + 65536;
constexpr size_t WS_WIN   = WS_BA + 2097152;
constexpr size_t WS_WO    = WS_WIN + (size_t)7168 * 2048 * 2;
constexpr size_t WS_WGU   = WS_WO + (size_t)2048 * 2048 * 2;
constexpr size_t WS_WDN   = WS_WGU + (size_t)11264 * 2048 * 2;
constexpr size_t WS_WPG   = WS_WDN + (size_t)2048 * 5632 * 2;
constexpr size_t WS_WPP   = WS_WPG + (size_t)2048 * 2048 * 2;
constexpr size_t WS_PB    = WS_WPP + (size_t)2048 * 256 * 2;
constexpr size_t WS_R0    = WS_PB + (size_t)32768 * 256 * 2;
constexpr size_t WS_R1    = WS_R0 + (size_t)32768 * 2048 * 2;
constexpr size_t WS_R2    = WS_R1 + (size_t)32768 * 7168 * 2;
constexpr size_t WS_W2    = WS_R2 + (size_t)32768 * 2048 * 2;
constexpr size_t WS_QKB   = WS_W2 + (size_t)32768 * 1024 * 2;
constexpr size_t WS_HALO  = WS_QKB + (size_t)4096 * 4096 * 2;
constexpr size_t WS_LIST  = WS_HALO + (size_t)513 * 3 * 3072 * 2 + 256 - ((size_t)513 * 3 * 3072 * 2) % 256;
constexpr size_t WS_ML    = WS_LIST + (size_t)16 * LISTN * 4;
constexpr size_t WS_SSQ   = WS_ML + (size_t)4 * 262144 * 8;
constexpr size_t WS_END   = WS_SSQ + (size_t)32768 * 64 * 4;

struct Params {
    const float* x; const float* p; const float* attn_norm; const float* w_in; const float* conv_w; const float* A_log; const float* dt_bias;
    const float* gdn_norm; const float* q_norm; const float* k_norm; const float* w_o; const float* ffn_norm; const float* w_gate; const float* w_up;
    const float* w_down; const float* ple_norm; const float* w_pg; const float* w_pp;
    float* out; unsigned char* ws;
};

DI unsigned pk2(float a, float b) { f32x2 v = {a, b}; bfv2 r = __builtin_convertvector(v, bfv2); return __builtin_bit_cast(unsigned, r); }
DI bf16_t f2bf(float a) { return (bf16_t)(pk2(a, 0.f) & 0xffffu); }
DI float bflo(unsigned w) { return __uint_as_float(w << 16); }
DI float bfhi(unsigned w) { return __uint_as_float(w & 0xffff0000u); }
DI float bf2f(bf16_t v) { return __uint_as_float(((unsigned)v) << 16); }
DI bf16x8 pack8(const f32x4& a, const f32x4& b) { u32x4 w; w.x = pk2(a[0], a[1]); w.y = pk2(a[2], a[3]); w.z = pk2(b[0], b[1]); w.w = pk2(b[2], b[3]); return __builtin_bit_cast(bf16x8, w); }
DI bf16x8 cat8(u32x2 lo, u32x2 hi) { u32x4 w; w.x = lo.x; w.y = lo.y; w.z = hi.x; w.w = hi.y; return __builtin_bit_cast(bf16x8, w); }
DI f32x4 mfma16(bf16x8 a, bf16x8 b, f32x4 c) { return __builtin_amdgcn_mfma_f32_16x16x32_bf16(a, b, c, 0, 0, 0); }
DI int perm4(int d4) { return d4 < 16 ? 2 * d4 : 2 * (d4 - 16) + 4; }
DI float dpp_f(float v, int ctrl_sel) { int x = __float_as_int(v); int r;
    if (ctrl_sel == 0) r = __builtin_amdgcn_mov_dpp(x, 0xB1, 0xf, 0xf, true); else if (ctrl_sel == 1) r = __builtin_amdgcn_mov_dpp(x, 0x4E, 0xf, 0xf, true);
    else if (ctrl_sel == 2) r = __builtin_amdgcn_mov_dpp(x, 0x141, 0xf, 0xf, true); else r = __builtin_amdgcn_mov_dpp(x, 0x140, 0xf, 0xf, true);
    return __int_as_float(r); }
DI float row16_sum(float v) { v += dpp_f(v, 0); v += dpp_f(v, 1); v += dpp_f(v, 2); v += dpp_f(v, 3); return v; }
DI float silu_f(float v) { return v * __builtin_amdgcn_rcpf(1.f + __expf(-v)); }
DI float sigm_f(float v) { return __builtin_amdgcn_rcpf(1.f + __expf(-v)); }

DI int opq_tid() { int t = threadIdx.x; asm volatile("" : "+v"(t)); return t; }

namespace pg8 {
constexpr int BM = 256, BK = 64, HALF = 128, HTB = HALF * BK * 2, STAGE_BYTES = 8 * HTB, NXCD = 8, WGM = 8;
DI int lds_byte(int r, int c) { const int st = (r >> 4) * 2 + (c >> 5), rr = r & 15, cc = c & 31, ob = rr * 64 + cc * 2; return st * 1024 + (ob ^ (((ob >> 9) & 1) << 5)); }
DI void stage_rc(int b, int& R, int& C) { const int st = b / 1024, sb = b % 1024, swz = sb ^ (((sb >> 9) & 1) << 5); R = (st >> 1) * 16 + swz / 64; C = (st & 1) * 32 + (swz % 64) / 2; }
DI int perm32(int rho) { const int n = rho >> 4, i = rho & 15; return 8 * (i >> 2) + 4 * n + (i & 3); }
struct Unit { int pm, pn; };
struct Gemm { const bf16_t* A; const bf16_t* Bt; int M, N, K; };
struct StaticOrder {
    int nM, nN, nwg, G, c;
    DI void init(int M, int N, int G_, int c_) { nM = M / BM; nN = N / BM; nwg = nM * nN; G = G_; c = c_; }
    DI bool next(int i, Unit& u) const {
        const long L = (long)i * G + c; if (L >= nwg) return false;
        int wgid = (int)L; { const int q = nwg / NXCD, r = nwg % NXCD, xcd = wgid % NXCD, off = wgid / NXCD; wgid = (xcd < r ? xcd * (q + 1) : r * (q + 1) + (xcd - r) * q) + off; }
        const int nig = WGM * nN, gid = wgid / nig, fm = gid * WGM, gsz = (nM - fm) < WGM ? (nM - fm) : WGM;
        u.pm = fm + ((wgid % nig) % gsz); u.pn = (wgid % nig) / gsz; return true;
    }
    DI void a_ready(const Unit&) const {}
    DI void done(const Unit&) const {}
};

template <class Epi, class Sched, bool ALIGN_EPI = false, bool SP2 = false>
DI void gemm_phase(LAS unsigned char* lds, const Gemm g, const Sched& S, const Epi& E) {
    const int tid = opq_tid(), wid = __builtin_amdgcn_readfirstlane(tid >> 6), lane = tid & 63, wr = wid >> 2, wc = wid & 3, fr = lane & 15, fq = lane >> 4;
    const int K = g.K, nt = K / BK;
    unsigned voffA[2], voffB[2];
#pragma unroll
    for (int i = 0; i < 2; ++i) { int R, C; stage_rc(tid * 16 + i * 8192, R, C); const int Rb = Epi::PERM ? ((R & ~31) + perm32(R & 31)) : R;
        voffA[i] = (unsigned)(R * K + C) * 2u; voffB[i] = (unsigned)(Rb * K + C) * 2u; }
    const size_t kstep = (size_t)(BK * 2);
    const size_t hstep = (size_t)HALF * K * 2;
    const size_t tstep = 2 * hstep;
    const unsigned ldsw = (unsigned)wid * 1024u;
    const int aoff = lds_byte(wr * 64 + fr, fq * 8), boff = lds_byte(wc * 32 + fr, fq * 8);
#define PG8_SA(b, h) (((b) * 2 + (h)) * HTB)
#define PG8_SB(b, h) ((4 + (b) * 2 + (h)) * HTB)
#define PG8_STAGE(bufoff, gbase, voff) do { _Pragma("unroll") for (int _i = 0; _i < 2; ++_i) \
        __builtin_amdgcn_global_load_lds((const unsigned*)((const char*)(gbase) + (voff)[_i]), (LAS unsigned*)(lds + (bufoff) + ldsw + _i * 8192), 16, 0, 0); } while (0)
#define PG8_LDA(dst, b, h) do { _Pragma("unroll") for (int m = 0; m < 4; ++m) _Pragma("unroll") for (int k = 0; k < 2; ++k) dst[m][k] = *(const LAS bf16x8*)(lds + PG8_SA(b, h) + aoff + m * 2048 + k * 1024); } while (0)
#define PG8_LDB(dst, b, h) do { _Pragma("unroll") for (int n = 0; n < 2; ++n) _Pragma("unroll") for (int k = 0; k < 2; ++k) dst[n][k] = *(const LAS bf16x8*)(lds + PG8_SB(b, h) + boff + n * 2048 + k * 1024); } while (0)
#define PG8_MMA(ai, bj, At, Bt) do { __builtin_amdgcn_s_setprio(1); _Pragma("unroll") for (int m = 0; m < 4; ++m) _Pragma("unroll") for (int n = 0; n < 2; ++n) _Pragma("unroll") for (int k = 0; k < 2; ++k) \
        acc[ai][bj][m][n] = __builtin_amdgcn_mfma_f32_16x16x32_bf16(Bt[n][k], At[m][k], acc[ai][bj][m][n], 0, 0, 0); __builtin_amdgcn_s_setprio(0); } while (0)
#define PG8_WAIT_V(n) asm volatile("s_waitcnt vmcnt(" #n ")" ::: "memory")
#define PG8_WAIT_L(n) asm volatile("s_waitcnt lgkmcnt(" #n ")" ::: "memory")
#define PG8_BAR __builtin_amdgcn_s_barrier()
#define PG8_SCHED __builtin_amdgcn_sched_barrier(0)
    Unit cur, nxt; int ui = 0;
    if (!S.next(0, cur)) return;
    f32x4 acc[2][2][4][2];
#pragma unroll
    for (int a = 0; a < 2; ++a)
#pragma unroll
        for (int b = 0; b < 2; ++b)
#pragma unroll
            for (int m = 0; m < 4; ++m)
#pragma unroll
                for (int n = 0; n < 2; ++n) acc[a][b][m][n] = (f32x4){0.f, 0.f, 0.f, 0.f};
    bf16x8 At[4][2], B0[2][2], B1[2][2];
    const char* cA = (const char*)g.A + (size_t)cur.pm * tstep; const char* cB = (const char*)g.Bt + (size_t)cur.pn * tstep;
    S.a_ready(cur);
    if constexpr (SP2) {
        PG8_STAGE(PG8_SB(0, 0), cB, voffB); PG8_STAGE(PG8_SB(0, 1), cB + hstep, voffB); PG8_STAGE(PG8_SA(0, 0), cA, voffA); PG8_STAGE(PG8_SA(0, 1), cA + hstep, voffA);
        if (wr == 1) PG8_BAR;
        PG8_WAIT_V(2); PG8_BAR;
        PG8_STAGE(PG8_SB(1, 0), cB + kstep, voffB); PG8_STAGE(PG8_SA(1, 0), cA + kstep, voffA); PG8_STAGE(PG8_SB(1, 1), cB + hstep + kstep, voffB);
        PG8_WAIT_V(6); PG8_BAR;
    } else {
        PG8_STAGE(PG8_SB(0, 0), cB, voffB); PG8_STAGE(PG8_SA(0, 0), cA, voffA); PG8_STAGE(PG8_SB(0, 1), cB + hstep, voffB); PG8_STAGE(PG8_SA(0, 1), cA + hstep, voffA);
        if (wr == 1) PG8_BAR;
        PG8_WAIT_V(4); PG8_BAR;
        PG8_STAGE(PG8_SB(1, 0), cB + kstep, voffB); PG8_STAGE(PG8_SA(1, 0), cA + kstep, voffA); PG8_STAGE(PG8_SB(1, 1), cB + hstep + kstep, voffB);
        PG8_WAIT_V(6); PG8_BAR;
    }
    for (;;) {
        const bool has_next = S.next(ui + 1, nxt);
        const char* nA = has_next ? (const char*)g.A + (size_t)nxt.pm * tstep : cA; const char* nB = has_next ? (const char*)g.Bt + (size_t)nxt.pn * tstep : cB;
        for (int t = 0; t < nt; t += 2) {
            const bool last = (t == nt - 2);
            const char* a1 = cA + (size_t)(t + 1) * kstep;
            const char* a2 = last ? nA : cA + (size_t)(t + 2) * kstep; const char* b2 = last ? nB : cB + (size_t)(t + 2) * kstep;
            const char* a3 = a2 + kstep; const char* b3 = b2 + kstep;
            if (last && has_next) S.a_ready(nxt);
            if constexpr (SP2) {
            PG8_LDB(B0, 0, 0); PG8_LDB(B1, 0, 1); PG8_SCHED; PG8_LDA(At, 0, 0); PG8_STAGE(PG8_SA(1, 1), a1 + hstep, voffA);
            PG8_WAIT_V(8); PG8_WAIT_L(0); PG8_BAR; PG8_MMA(0, 0, At, B0); PG8_MMA(0, 1, At, B1); PG8_BAR; PG8_SCHED;
            PG8_LDA(At, 0, 1); PG8_STAGE(PG8_SB(0, 0), b2, voffB); PG8_STAGE(PG8_SB(0, 1), b2 + hstep, voffB); PG8_STAGE(PG8_SA(0, 0), a2, voffA);
            PG8_WAIT_V(8); PG8_WAIT_L(0); PG8_BAR; PG8_MMA(1, 0, At, B0); PG8_MMA(1, 1, At, B1); PG8_BAR; PG8_SCHED;
            PG8_LDB(B0, 1, 0); PG8_LDB(B1, 1, 1); PG8_SCHED; PG8_LDA(At, 1, 0); PG8_STAGE(PG8_SA(0, 1), a2 + hstep, voffA);
            PG8_WAIT_V(8); PG8_WAIT_L(0); PG8_BAR; PG8_MMA(0, 0, At, B0); PG8_MMA(0, 1, At, B1); PG8_BAR; PG8_SCHED;
            PG8_LDA(At, 1, 1); PG8_STAGE(PG8_SB(1, 0), b3, voffB); PG8_STAGE(PG8_SB(1, 1), b3 + hstep, voffB); PG8_STAGE(PG8_SA(1, 0), a3, voffA);
            PG8_WAIT_V(8); PG8_WAIT_L(0); PG8_BAR; PG8_MMA(1, 0, At, B0); PG8_MMA(1, 1, At, B1); PG8_BAR; PG8_SCHED;
            } else {
            PG8_LDB(B0, 0, 0); PG8_SCHED; PG8_LDA(At, 0, 0); PG8_STAGE(PG8_SA(1, 1), a1 + hstep, voffA);
            PG8_WAIT_L(8); PG8_BAR; PG8_WAIT_L(0); PG8_MMA(0, 0, At, B0); PG8_BAR; PG8_SCHED;
            PG8_LDB(B1, 0, 1); PG8_STAGE(PG8_SB(0, 0), b2, voffB);
            PG8_BAR; PG8_WAIT_L(0); PG8_MMA(0, 1, At, B1); PG8_BAR;
            PG8_LDA(At, 0, 1); PG8_STAGE(PG8_SA(0, 0), a2, voffA);
            PG8_BAR; PG8_WAIT_L(0); PG8_MMA(1, 0, At, B0); PG8_BAR; PG8_SCHED;
            PG8_STAGE(PG8_SB(0, 1), b2 + hstep, voffB);
            PG8_WAIT_V(6); PG8_BAR; PG8_MMA(1, 1, At, B1); PG8_BAR;
            PG8_LDB(B0, 1, 0); PG8_SCHED; PG8_LDA(At, 1, 0); PG8_STAGE(PG8_SA(0, 1), a2 + hstep, voffA);
            PG8_WAIT_L(8); PG8_BAR; PG8_WAIT_L(0); PG8_MMA(0, 0, At, B0); PG8_BAR; PG8_SCHED;
            PG8_LDB(B1, 1, 1); PG8_STAGE(PG8_SB(1, 0), b3, voffB);
            PG8_BAR; PG8_WAIT_L(0); PG8_MMA(0, 1, At, B1); PG8_BAR;
            PG8_LDA(At, 1, 1); PG8_STAGE(PG8_SA(1, 0), a3, voffA);
            PG8_BAR; PG8_WAIT_L(0); PG8_MMA(1, 0, At, B0); PG8_BAR; PG8_SCHED;
            PG8_STAGE(PG8_SB(1, 1), b3 + hstep, voffB);
            PG8_WAIT_V(6); PG8_BAR; PG8_MMA(1, 1, At, B1); PG8_BAR;
            }
        }
        if constexpr (ALIGN_EPI) { if (wr == 0) PG8_BAR; }
        if constexpr (!Epi::AFTER_DRAIN) { E(acc, cur, wr, wc, fr, fq); S.done(cur); }
        if (!has_next) break;
#pragma unroll
        for (int a = 0; a < 2; ++a)
#pragma unroll
            for (int b = 0; b < 2; ++b)
#pragma unroll
                for (int m = 0; m < 4; ++m)
#pragma unroll
                    for (int n = 0; n < 2; ++n) acc[a][b][m][n] = (f32x4){0.f, 0.f, 0.f, 0.f};
        cur = nxt; cA = nA; cB = nB; ++ui;
        if constexpr (ALIGN_EPI) { if (wr == 1) PG8_BAR; }
    }
    PG8_WAIT_V(0);
    if constexpr (!ALIGN_EPI) { if (wr == 0) PG8_BAR; }
    PG8_BAR;
    if constexpr (Epi::AFTER_DRAIN) { E.fused(acc, cur, wr, wc, fr, fq, lds, wid, lane); S.done(cur); }
#undef PG8_SA
#undef PG8_SB
#undef PG8_STAGE
#undef PG8_LDA
#undef PG8_LDB
#undef PG8_MMA
#undef PG8_WAIT_V
#undef PG8_WAIT_L
#undef PG8_BAR
#undef PG8_SCHED
}
}
using pg8::Unit;

struct EpiProj {
    static constexpr bool PERM = true, AFTER_DRAIN = false;
    bf16_t* O; bf16_t* halo;
    DI void operator()(const f32x4 (&acc)[2][2][4][2], const Unit& u, int wr, int wc, int fr, int fq) const {
        const int row0 = u.pm * 256 + wr * 64 + fr, col0 = u.pn * 256 + wc * 32 + 8 * fq;
#pragma unroll
        for (int ai = 0; ai < 2; ++ai)
#pragma unroll
            for (int m = 0; m < 4; ++m) { const int row = row0 + ai * 128 + m * 16; bf16_t* rowp = O + (size_t)row * NPJ + col0;
#pragma unroll
                for (int bj = 0; bj < 2; ++bj) { const f32x4 v0 = acc[ai][bj][m][0], v1 = acc[ai][bj][m][1];
                    u32x4 w; w.x = pk2(v0[0], v0[1]); w.y = pk2(v0[2], v0[3]); w.z = pk2(v1[0], v1[1]); w.w = pk2(v1[2], v1[3]);
                    *(u32x4*)(rowp + bj * 128) = w;
                    if (m == 3 && fr >= 13 && u.pn < 12) *(u32x4*)(halo + ((size_t)((row >> 6) + 1) * 3 + (fr - 13)) * 3072 + col0 + bj * 128) = w; } }
    }
};
struct EpiPlainBf16 {
    static constexpr bool PERM = true, AFTER_DRAIN = false;
    bf16_t* O; int ldc;
    DI void operator()(const f32x4 (&acc)[2][2][4][2], const Unit& u, int wr, int wc, int fr, int fq) const {
        const int row0 = u.pm * 256 + wr * 64 + fr, col0 = u.pn * 256 + wc * 32 + 8 * fq;
#pragma unroll
        for (int ai = 0; ai < 2; ++ai)
#pragma unroll
            for (int m = 0; m < 4; ++m) { bf16_t* rowp = O + (size_t)(row0 + ai * 128 + m * 16) * ldc + col0;
#pragma unroll
                for (int bj = 0; bj < 2; ++bj) { const f32x4 v0 = acc[ai][bj][m][0], v1 = acc[ai][bj][m][1];
                    u32x4 w; w.x = pk2(v0[0], v0[1]); w.y = pk2(v0[2], v0[3]); w.z = pk2(v1[0], v1[1]); w.w = pk2(v1[2], v1[3]);
                    *(u32x4*)(rowp + bj * 128) = w; } }
    }
};
struct EpiResid {
    static constexpr bool PERM = false, AFTER_DRAIN = false;
    const float* base; float* out; bf16_t* hb; float* ss;
    DI void operator()(const f32x4 (&acc)[2][2][4][2], const Unit& u, int wr, int wc, int fr, int fq) const {
        const int row0 = u.pm * 256 + wr * 64 + fr, col0 = u.pn * 256 + wc * 32 + 4 * fq;
#pragma unroll
        for (int ai = 0; ai < 2; ++ai) { f32x4 bs[4][4];
#pragma unroll
            for (int m = 0; m < 4; ++m)
#pragma unroll
                for (int q = 0; q < 4; ++q) bs[m][q] = *(const f32x4*)(base + (size_t)(row0 + ai * 128 + m * 16) * DM + col0 + (q >> 1) * 128 + (q & 1) * 16);
#pragma unroll
            for (int m = 0; m < 4; ++m) { const int row = row0 + ai * 128 + m * 16; const size_t off = (size_t)row * DM + col0; float s = 0.f;
#pragma unroll
                for (int q = 0; q < 4; ++q) { const f32x4 hv = bs[m][q] + acc[ai][q >> 1][m][q & 1];
                        *(f32x4*)(out + off + (q >> 1) * 128 + (q & 1) * 16) = hv; u32x2 w; w.x = pk2(hv[0], hv[1]); w.y = pk2(hv[2], hv[3]);
                        *(u32x2*)(hb + off + (q >> 1) * 128 + (q & 1) * 16) = w; s += (hv[0] * hv[0] + hv[1] * hv[1]) + (hv[2] * hv[2] + hv[3] * hv[3]); }
                s += __shfl_xor(s, 16); s += __shfl_xor(s, 32);
                if (fq == 0) atomicAdd(ss + row, s); }
            asm volatile("" ::: "memory"); }
    }
};
struct EpiAct {
    static constexpr bool PERM = true, AFTER_DRAIN = false;
    bf16_t* O; const float* ss;
    DI void operator()(const f32x4 (&acc)[2][2][4][2], const Unit& u, int wr, int wc, int fr, int fq) const {
        const int row0 = u.pm * 256 + wr * 64 + fr, col0 = u.pn * 128 + wc * 32 + 8 * fq;
        float rs[8];
#pragma unroll
        for (int g = 0; g < 8; ++g) rs[g] = ss[row0 + (g >> 2) * 128 + (g & 3) * 16];
#pragma unroll
        for (int ai = 0; ai < 2; ++ai)
#pragma unroll
            for (int m = 0; m < 4; ++m) { const int row = row0 + ai * 128 + m * 16; const float r = rsqrtf(rs[ai * 4 + m] * (1.f / 2048.f) + 1e-6f);
                float a[8];
#pragma unroll
                for (int n = 0; n < 2; ++n)
#pragma unroll
                    for (int j = 0; j < 4; ++j) { const float gv = r * acc[ai][0][m][n][j], uv = r * acc[ai][1][m][n][j]; a[n * 4 + j] = silu_f(gv) * uv; }
                u32x4 w; w.x = pk2(a[0], a[1]); w.y = pk2(a[2], a[3]); w.z = pk2(a[4], a[5]); w.w = pk2(a[6], a[7]);
                *(u32x4*)(O + (size_t)row * FF + col0) = w; }
    }
};
struct EpiOut {
    static constexpr bool PERM = false, AFTER_DRAIN = false;
    float* out; const bf16_t* pp; const float* ss;
    DI void operator()(const f32x4 (&acc)[2][2][4][2], const Unit& u, int wr, int wc, int fr, int fq) const {
        const int row0 = u.pm * 256 + wr * 64 + fr, col0 = u.pn * 256 + wc * 32 + 4 * fq;
        float rs[8];
#pragma unroll
        for (int g = 0; g < 8; ++g) rs[g] = ss[row0 + (g >> 2) * 128 + (g & 3) * 16];
#pragma unroll
        for (int ai = 0; ai < 2; ++ai)
#pragma unroll
            for (int m = 0; m < 4; ++m) { const int row = row0 + ai * 128 + m * 16; const size_t off = (size_t)row * DM + col0; const float r = rsqrtf(rs[ai * 4 + m] * (1.f / 2048.f) + 1e-6f);
                f32x4 hv[4]; u32x2 pw[4];
#pragma unroll
                for (int q = 0; q < 4; ++q) { hv[q] = *(const f32x4*)(out + off + (q >> 1) * 128 + (q & 1) * 16); pw[q] = *(const u32x2*)(pp + off + (q >> 1) * 128 + (q & 1) * 16); }
#pragma unroll
                for (int q = 0; q < 4; ++q) { const f32x4 a = acc[ai][q >> 1][m][q & 1]; f32x4 o;
                        o[0] = hv[q][0] + sigm_f(r * a[0]) * bflo(pw[q].x); o[1] = hv[q][1] + sigm_f(r * a[1]) * bfhi(pw[q].x);
                        o[2] = hv[q][2] + sigm_f(r * a[2]) * bflo(pw[q].y); o[3] = hv[q][3] + sigm_f(r * a[3]) * bfhi(pw[q].y);
                        *(f32x4*)(out + off + (q >> 1) * 128 + (q & 1) * 16) = o; }
                asm volatile("" ::: "memory"); }
    }
};

DI void tconv_tile(const float* __restrict__ src, int ld, int c0, int k0, bf16_t* __restrict__ dst, int dK, int n0, const float* __restrict__ nw, LAS float* tl) {
    const int tid = opq_tid();
    f32x4 v[8];
#pragma unroll
    for (int i = 0; i < 8; ++i) v[i] = *(const f32x4*)(src + (size_t)(k0 + (tid >> 4) + 32 * i) * ld + c0 + (tid & 15) * 4);
#pragma unroll
    for (int i = 0; i < 8; ++i) { const int k = (tid >> 4) + 32 * i; const float sc = nw ? nw[k0 + k] : 1.f;
        LAS float* q = tl + k * 65 + (tid & 15) * 4; q[0] = v[i][0] * sc; q[1] = v[i][1] * sc; q[2] = v[i][2] * sc; q[3] = v[i][3] * sc; }
    __syncthreads();
    { const int n = tid >> 3, kq = (tid & 7) * 8;
#pragma unroll
      for (int j = 0; j < 4; ++j) { const int ks = kq + 64 * j; float f[8];
#pragma unroll
          for (int i = 0; i < 8; ++i) f[i] = tl[(ks + i) * 65 + n];
          u32x4 w; w.x = pk2(f[0], f[1]); w.y = pk2(f[2], f[3]); w.z = pk2(f[4], f[5]); w.w = pk2(f[6], f[7]);
          *(u32x4*)(dst + (size_t)(n0 + n) * dK + k0 + ks) = w; } }
    __syncthreads();
}

DI void phase_prep(const Params& P, LAS unsigned char* lds) {
    unsigned char* ws = P.ws; const int tid = opq_tid(), G = gridDim.x, bx = blockIdx.x;
    const int gtid = bx * NTHREADS + tid, gsz = G * NTHREADS;
    for (int i = gtid; i < (int)((WS_GL - WS_CTL) / 4); i += gsz) ((unsigned*)(ws + WS_CTL))[i] = 0u;
    { bf16_t* wba = (bf16_t*)(ws + WS_WBA); for (int i = gtid; i < 16 * 2048; i += gsz) { const int n = i >> 11, k = i & 2047; wba[i] = f2bf(P.w_in[(size_t)k * INW + 4096 + n]); } }
    { bf16_t* pb = (bf16_t*)(ws + WS_PB); for (int i = gtid; i < MT * 256 / 8; i += gsz) { const f32x4 a = *(const f32x4*)(P.p + (size_t)i * 8), b = *(const f32x4*)(P.p + (size_t)i * 8 + 4);
        u32x4 w; w.x = pk2(a[0], a[1]); w.y = pk2(a[2], a[3]); w.z = pk2(b[0], b[1]); w.w = pk2(b[2], b[3]); *(u32x4*)(pb + (size_t)i * 8) = w; } }
    { bf16_t* xn = (bf16_t*)(ws + WS_R0); const int lane = tid & 63, gw = bx * 8 + (tid >> 6);
      f32x4 wv[8];
#pragma unroll
      for (int i = 0; i < 8; ++i) wv[i] = *(const f32x4*)(P.attn_norm + lane * 4 + i * 256);
      for (int row = gw * 2; row < MT; row += G * 16) { const float* xr = P.x + (size_t)row * DM; f32x4 v[2][8]; float s0 = 0.f, s1 = 0.f;
#pragma unroll
          for (int r = 0; r < 2; ++r)
#pragma unroll
              for (int i = 0; i < 8; ++i) v[r][i] = *(const f32x4*)(xr + (size_t)r * DM + lane * 4 + i * 256);
#pragma unroll
          for (int i = 0; i < 8; ++i) { s0 += (v[0][i][0] * v[0][i][0] + v[0][i][1] * v[0][i][1]) + (v[0][i][2] * v[0][i][2] + v[0][i][3] * v[0][i][3]);
              s1 += (v[1][i][0] * v[1][i][0] + v[1][i][1] * v[1][i][1]) + (v[1][i][2] * v[1][i][2] + v[1][i][3] * v[1][i][3]); }
#pragma unroll
          for (int o = 1; o < 64; o <<= 1) { s0 += __shfl_xor(s0, o); s1 += __shfl_xor(s1, o); }
          const float r0 = rsqrtf(s0 * (1.f / 2048.f) + 1e-6f), r1 = rsqrtf(s1 * (1.f / 2048.f) + 1e-6f);
#pragma unroll
          for (int r = 0; r < 2; ++r)
#pragma unroll
              for (int i = 0; i < 8; ++i) { const float rr = r ? r1 : r0; u32x2 w; w.x = pk2(v[r][i][0] * rr * wv[i][0], v[r][i][1] * rr * wv[i][1]); w.y = pk2(v[r][i][2] * rr * wv[i][2], v[r][i][3] * rr * wv[i][3]);
                  *(u32x2*)(xn + (size_t)(row + r) * DM + lane * 4 + i * 256) = w; } } }
    LAS float* tl = (LAS float*)lds;
    for (int gi = bx; gi < 896; gi += G) { const int nt = gi >> 3, kg = gi & 7, n0 = nt * 64; tconv_tile(P.w_in, INW, n0 < 4096 ? n0 : n0 + 16, kg * 256, (bf16_t*)(ws + WS_WIN), 2048, n0, nullptr, tl); }
}
DI void phase_wconv_late(const Params& P, LAS unsigned char* lds, int wg0, int nwg) {
    unsigned char* ws = P.ws; LAS float* tl = (LAS float*)lds;
    for (int gi = 896 + wg0; gi < 3552; gi += nwg) {
        if (gi < 1152) { const int t2 = gi - 896, nt = t2 >> 3, kg = t2 & 7; tconv_tile(P.w_o, 2048, nt * 64, kg * 256, (bf16_t*)(ws + WS_WO), 2048, nt * 64, nullptr, tl); }
        else if (gi < 2560) { const int t2 = gi - 1152, nt = t2 >> 3, kg = t2 & 7, n0 = nt * 64, pn = n0 >> 8, r = n0 & 255;
            tconv_tile(r < 128 ? P.w_gate : P.w_up, FF, pn * 128 + (r & 127), kg * 256, (bf16_t*)(ws + WS_WGU), 2048, n0, P.ffn_norm, tl); }
        else if (gi < 3264) { const int t2 = gi - 2560, nt = t2 / 22, kg = t2 % 22; tconv_tile(P.w_down, 2048, nt * 64, kg * 256, (bf16_t*)(ws + WS_WDN), FF, nt * 64, nullptr, tl); }
        else if (gi < 3520) { const int t2 = gi - 3264, nt = t2 >> 3, kg = t2 & 7; tconv_tile(P.w_pg, 2048, nt * 64, kg * 256, (bf16_t*)(ws + WS_WPG), 2048, nt * 64, P.ple_norm, tl); }
        else { const int nt = gi - 3520; tconv_tile(P.w_pp, 2048, nt * 64, 0, (bf16_t*)(ws + WS_WPP), 256, nt * 64, nullptr, tl); }
    }
}

DI void phase_ba(const Params& P) {
    const int tid = opq_tid(), lane = tid & 63, fr = lane & 15, fq = lane >> 4, gw = blockIdx.x * 8 + (tid >> 6);
    const bf16_t* xn = (const bf16_t*)(P.ws + WS_R0); const bf16_t* wba = (const bf16_t*)(P.ws + WS_WBA); float* BA = (float*)(P.ws + WS_BA);
    for (int rt = gw; rt < MT / 16; rt += gridDim.x * 8) {
        f32x4 acc = {0.f, 0.f, 0.f, 0.f}; const bf16_t* ap = xn + (size_t)(rt * 16 + fr) * DM + 8 * fq; const bf16_t* bp = wba + fr * 2048 + 8 * fq;
#pragma unroll 16
        for (int ks = 0; ks < 64; ++ks) acc = mfma16(*(const bf16x8*)(ap + 32 * ks), *(const bf16x8*)(bp + 32 * ks), acc);
#pragma unroll
        for (int j = 0; j < 4; ++j) BA[(size_t)(rt * 16 + 4 * fq + j) * 16 + fr] = acc[j];
    }
}

constexpr int G1_QS = 0, G1_KS = 18432, G1_VT = 36864, G1_KT = 57344, G1_SM = 77824, G1_TEAM = 78848;
DI void phase_gdn_prep(const Params& P, LAS unsigned char* lds, int n_lo, int n_cnt, int wg0, int nwg, unsigned* early_flag = nullptr, int early_thr = 0, unsigned* early_flag2 = nullptr, int early_thr2 = 0) {
    const int tid0 = opq_tid(), team = tid0 >> 8;
    LAS unsigned char* L = lds + team * G1_TEAM;
    LAS bf16_t* QS = (LAS bf16_t*)(L + G1_QS); LAS bf16_t* KS = (LAS bf16_t*)(L + G1_KS); LAS bf16_t* VT = (LAS bf16_t*)(L + G1_VT); LAS bf16_t* KT = (LAS bf16_t*)(L + G1_KT);
    LAS float* AF = (LAS float*)(L + G1_QS); LAS bf16_t* TB = (LAS bf16_t*)(L + G1_KS); LAS float* SM = (LAS float*)(L + G1_SM);
    bf16_t* proj = (bf16_t*)(P.ws + WS_R1); const bf16_t* halo = (const bf16_t*)(P.ws + WS_HALO); const float* BA = (const float*)(P.ws + WS_BA);
    bf16_t* W2 = (bf16_t*)(P.ws + WS_W2); bf16_t* QKB = (bf16_t*)(P.ws + WS_QKB); float* GL = (float*)(P.ws + WS_GL);
    bool arrived = (early_flag == nullptr), arrived2 = (early_flag2 == nullptr);
    for (int pi = wg0; pi < n_cnt * 8; pi += nwg) {
        int tid = tid0; asm volatile("" : "+v"(tid));
        const int tt = tid & 255, tw = __builtin_amdgcn_readfirstlane((tid >> 6) & 3), lane = tid & 63, fr = lane & 15, fq = lane >> 4;
        const int cq = pi * 2 + team, h = cq & 7, b = (cq >> 3) & 1, n = n_lo + (cq >> 4), ci = ((b * 256 + n) << 3) + h, t0 = b * TT + n * 64;
        if (tw == 0) {
            const float bv = BA[(size_t)(t0 + lane) * 16 + h], av = BA[(size_t)(t0 + lane) * 16 + 8 + h];
            const float beta = sigm_f(bv); const float xx = av + P.dt_bias[h]; const float sp = xx > 20.f ? xx : log1pf(__expf(xx));
            const float gg = -__expf(P.A_log[h]) * sp; float gc = gg;
#pragma unroll
            for (int o = 1; o < 64; o <<= 1) { const float v = __shfl_up(gc, o); if (lane >= o) gc += v; }
            const float glast = __shfl(gc, 63);
            SM[lane] = gc; SM[64 + lane] = beta; SM[128 + lane] = __expf(gc); SM[192 + lane] = __expf(glast - gc);
            if (lane == 63) GL[(b * 8 + h) * 256 + n] = __expf(gc);
        }
        __syncthreads();
        { const int r = tt >> 2, cg0 = (tt & 3) * 32; const float beta_r = SM[64 + r], egc_r = SM[128 + r];
#pragma unroll 1
          for (int x = 0; x < 3; ++x) {
              float val[32]; const int colbase = x * 1024 + h * 128 + cg0;
              u32x4 rawa[4][4];
#pragma unroll
              for (int sg = 0; sg < 4; ++sg) { const int col = colbase + sg * 8;
#pragma unroll
                  for (int j = 0; j < 4; ++j) { const int rr = r - 3 + j; rawa[sg][j] = (u32x4){0u, 0u, 0u, 0u};
                      if (rr >= 0) rawa[sg][j] = *(const u32x4*)(proj + (size_t)(t0 + rr) * NPJ + col);
                      else if (n > 0) rawa[sg][j] = *(const u32x4*)(halo + ((size_t)(t0 >> 6) * 3 + (rr + 3)) * 3072 + col); } }
#pragma unroll
              for (int sg = 0; sg < 4; ++sg) { const int col = colbase + sg * 8;
#pragma unroll
                  for (int i = 0; i < 8; ++i) { const f32x4 w4 = *(const f32x4*)(P.conv_w + (size_t)(col + i) * 4); float a = 0.f;
#pragma unroll
                      for (int j = 0; j < 4; ++j) { const unsigned wd = rawa[sg][j][i >> 1]; const float xv = (i & 1) ? bfhi(wd) : bflo(wd); a += w4[j] * xv; }
                      val[sg * 8 + i] = silu_f(a); } }
              if (x < 2) { float ss = 0.f;
#pragma unroll
                  for (int i = 0; i < 32; ++i) ss += val[i] * val[i];
                  ss += __shfl_xor(ss, 1); ss += __shfl_xor(ss, 2);
                  const float sc = rsqrtf(ss + 1e-6f) * (x == 0 ? 0.08838834764831845f : 1.f);
#pragma unroll
                  for (int i = 0; i < 32; ++i) val[i] *= sc; }
              if (x < 2) { LAS bf16_t* dst = (x == 0 ? QS : KS) + r * 144 + cg0;
#pragma unroll
                  for (int i = 0; i < 4; ++i) { u32x4 w; w.x = pk2(val[8 * i], val[8 * i + 1]); w.y = pk2(val[8 * i + 2], val[8 * i + 3]); w.z = pk2(val[8 * i + 4], val[8 * i + 5]); w.w = pk2(val[8 * i + 6], val[8 * i + 7]);
                      *(LAS u32x4*)(dst + 8 * i) = w; } }
              if (x == 1) { const float f = beta_r * egc_r;
#pragma unroll
                  for (int i = 0; i < 32; ++i) KT[(cg0 + i) * 80 + r] = f2bf(val[i] * f); }
              if (x == 2) {
#pragma unroll
                  for (int i = 0; i < 32; ++i) VT[(cg0 + i) * 80 + r] = f2bf(val[i] * beta_r); }
          } }
        __syncthreads();
        f32x4 kk[4], qk[4];
#pragma unroll
        for (int nt = 0; nt < 4; ++nt) { kk[nt] = (f32x4){0.f, 0.f, 0.f, 0.f}; qk[nt] = (f32x4){0.f, 0.f, 0.f, 0.f}; }
#pragma unroll
        for (int ks = 0; ks < 4; ++ks) { const bf16x8 ak = *(const LAS bf16x8*)(KS + (16 * tw + fr) * 144 + 32 * ks + 8 * fq), aq = *(const LAS bf16x8*)(QS + (16 * tw + fr) * 144 + 32 * ks + 8 * fq);
#pragma unroll
            for (int nt = 0; nt < 4; ++nt) { const bf16x8 bk = *(const LAS bf16x8*)(KS + (16 * nt + fr) * 144 + 32 * ks + 8 * fq); kk[nt] = mfma16(ak, bk, kk[nt]); qk[nt] = mfma16(aq, bk, qk[nt]); } }
        { const int r = tt >> 2, cg0 = (tt & 3) * 32; const float e = SM[128 + r];
#pragma unroll
          for (int i = 0; i < 4; ++i) { const u32x4 s = *(const LAS u32x4*)(QS + r * 144 + cg0 + 8 * i); u32x4 w;
              w.x = pk2(bflo(s.x) * e, bfhi(s.x) * e); w.y = pk2(bflo(s.y) * e, bfhi(s.y) * e); w.z = pk2(bflo(s.z) * e, bfhi(s.z) * e); w.w = pk2(bflo(s.w) * e, bfhi(s.w) * e);
              *(u32x4*)(proj + (size_t)(t0 + r) * NPJ + OFF_GQ + h * 128 + cg0 + 8 * i) = w; } }
        { const int d = tt >> 1, cb = (tt & 1) * 32;
#pragma unroll
          for (int i4 = 0; i4 < 4; ++i4) { const int c0 = cb + 8 * i4; float f[8];
#pragma unroll
              for (int i = 0; i < 8; ++i) f[i] = bf2f(KS[(c0 + i) * 144 + d]) * SM[192 + c0 + i];
              u32x4 w; w.x = pk2(f[0], f[1]); w.y = pk2(f[2], f[3]); w.z = pk2(f[4], f[5]); w.w = pk2(f[6], f[7]);
              *(u32x4*)(proj + (size_t)(t0 + (d >> 1)) * NPJ + OFF_GK + h * 128 + (d & 1) * 64 + c0) = w; } }
        __syncthreads();
#pragma unroll
        for (int nt = 0; nt < 4; ++nt)
#pragma unroll
            for (int j = 0; j < 4; ++j) { const int c = 16 * tw + 4 * fq + j, s = 16 * nt + fr; const float dec = (s <= c) ? __expf(SM[c] - SM[s]) : 0.f;
                AF[c * 65 + s] = (s < c) ? SM[64 + c] * kk[nt][j] * dec : (s == c ? 1.f : 0.f);
                QKB[(size_t)ci * 4096 + c * 64 + s] = f2bf(qk[nt][j] * dec); }
        __syncthreads();
        { const int bb = tw * 16;
          if (lane < 16) {
              for (int i = 1; i < 16; ++i) { float a0 = 0.f, a1 = 0.f; int j = 0;
                  for (; j + 2 <= i; j += 2) { a0 += AF[(bb + i) * 65 + bb + j] * AF[(bb + j) * 65 + bb + lane]; a1 += AF[(bb + i) * 65 + bb + j + 1] * AF[(bb + j + 1) * 65 + bb + lane]; }
                  if (j < i) a0 += AF[(bb + i) * 65 + bb + j] * AF[(bb + j) * 65 + bb + lane];
                  AF[(bb + i) * 65 + bb + lane] = lane < i ? -(a0 + a1) : (lane == i ? 1.f : 0.f); } }
#pragma unroll
          for (int k = 0; k < 4; ++k) { const int row = bb + fq + 4 * k; TB[row * 80 + bb + fr] = f2bf(AF[row * 65 + bb + fr]);
              for (int jb = tw + 1; jb < 4; ++jb) TB[row * 80 + 16 * jb + fr] = (bf16_t)0; }
          __syncthreads();
          for (int i = 1; i < 4; ++i) {
              if (tw < i) { const int j = tw; f32x4 X = {0.f, 0.f, 0.f, 0.f};
                  for (int k = j; k < i; ++k) {
#pragma unroll
                      for (int kk = 0; kk < 4; ++kk) { const float av = AF[(16 * i + fr) * 65 + 16 * k + 4 * kk + fq];
                          const float bv = (k == j) ? AF[(16 * k + 4 * kk + fq) * 65 + 16 * j + fr] : bf2f(TB[(16 * k + 4 * kk + fq) * 80 + 16 * j + fr]);
                          X = __builtin_amdgcn_mfma_f32_16x16x4f32(av, bv, X, 0, 0, 0); } }
                  f32x4 O = {0.f, 0.f, 0.f, 0.f};
#pragma unroll
                  for (int kk = 0; kk < 4; ++kk) O = __builtin_amdgcn_mfma_f32_16x16x4f32(AF[(16 * i + fr) * 65 + 16 * i + 4 * fq + kk], X[kk], O, 0, 0, 0);
#pragma unroll
                  for (int jj = 0; jj < 4; ++jj) TB[(16 * i + 4 * fq + jj) * 80 + 16 * j + fr] = f2bf(-O[jj]); }
              __syncthreads(); }
        }
        { bf16x8 at[2];
#pragma unroll
          for (int ks = 0; ks < 2; ++ks) at[ks] = *(const LAS bf16x8*)(TB + (16 * tw + fr) * 80 + 32 * ks + 8 * fq);
#pragma unroll
          for (int nt = 0; nt < 8; ++nt) { f32x4 a = {0.f, 0.f, 0.f, 0.f};
#pragma unroll
              for (int ks = 0; ks < 2; ++ks) a = mfma16(at[ks], *(const LAS bf16x8*)(VT + (16 * nt + fr) * 80 + 32 * ks + 8 * fq), a);
              const int e = 16 * nt + fr; u32x2 w; w.x = pk2(a[0], a[1]); w.y = pk2(a[2], a[3]);
              *(u32x2*)(proj + (size_t)(t0 + (e >> 1)) * NPJ + OFF_GV + h * 128 + (e & 1) * 64 + 16 * tw + 4 * fq) = w; }
#pragma unroll
          for (int mt = 0; mt < 8; ++mt) { f32x4 a = {0.f, 0.f, 0.f, 0.f};
#pragma unroll
              for (int ks = 0; ks < 2; ++ks) a = mfma16(*(const LAS bf16x8*)(KT + (16 * mt + fr) * 80 + 32 * ks + 8 * fq), at[ks], a);
              u32x2 w; w.x = pk2(a[0], a[1]); w.y = pk2(a[2], a[3]);
              *(u32x2*)(W2 + (size_t)(t0 + 16 * tw + fr) * 1024 + h * 128 + 16 * mt + 4 * fq) = w; } }
        __syncthreads();
        if (!arrived && pi + nwg >= early_thr) {
            asm volatile("s_waitcnt vmcnt(0)" ::: "memory"); __syncthreads();
            if (threadIdx.x == 0) { __builtin_amdgcn_fence(__ATOMIC_RELEASE, "agent"); __hip_atomic_fetch_add(early_flag, 1u, __ATOMIC_RELAXED, __HIP_MEMORY_SCOPE_AGENT); }
            arrived = true; }
        if (!arrived2 && pi + nwg >= early_thr2) {
            asm volatile("s_waitcnt vmcnt(0)" ::: "memory"); __syncthreads();
            if (threadIdx.x == 0) { __builtin_amdgcn_fence(__ATOMIC_RELEASE, "agent"); __hip_atomic_fetch_add(early_flag2, 1u, __ATOMIC_RELAXED, __HIP_MEMORY_SCOPE_AGENT); }
            arrived2 = true; }
    }
    if (!arrived2) { asm volatile("s_waitcnt vmcnt(0)" ::: "memory"); __syncthreads();
        if (threadIdx.x == 0) { __builtin_amdgcn_fence(__ATOMIC_RELEASE, "agent"); __hip_atomic_fetch_add(early_flag2, 1u, __ATOMIC_RELAXED, __HIP_MEMORY_SCOPE_AGENT); } }
    if (!arrived) { asm volatile("s_waitcnt vmcnt(0)" ::: "memory"); __syncthreads();
        if (threadIdx.x == 0) { __builtin_amdgcn_fence(__ATOMIC_RELEASE, "agent"); __hip_atomic_fetch_add(early_flag, 1u, __ATOMIC_RELAXED, __HIP_MEMORY_SCOPE_AGENT); } }
}

DI void phase_moba_prep(const Params& P, LAS unsigned char* lds, int wg0, int nwg) {
    const int tid = opq_tid(), lane = tid & 63, wave = tid >> 6, l16 = lane & 15;
    bf16_t* proj = (bf16_t*)(P.ws + WS_R1); float* kmean = (float*)(P.ws + WS_KMEAN);
    LAS bf16_t* VS = (LAS bf16_t*)lds; LAS float* CS = (LAS float*)(lds + 69632);
    for (int task = wg0; task < 1024; task += nwg) {
        const int h = task & 7, blk = (task >> 3) & 63, b = task >> 9; const size_t rbase = (size_t)(b * TT + blk * 256);
        f32x4 qg0 = *(const f32x4*)(P.q_norm + l16 * 8), qg1 = *(const f32x4*)(P.q_norm + l16 * 8 + 4), kg0 = *(const f32x4*)(P.k_norm + l16 * 8), kg1 = *(const f32x4*)(P.k_norm + l16 * 8 + 4);
        float cs[8];
#pragma unroll
        for (int i = 0; i < 8; ++i) cs[i] = 0.f;
        u32x4 rq[8], rk[8], rv[8];
#pragma unroll
        for (int ps = 0; ps < 8; ++ps) { const int r = ps * 32 + wave * 4 + (lane >> 4); const bf16_t* rp = proj + (rbase + r) * NPJ + h * 128 + l16 * 8;
            rq[ps] = *(const u32x4*)(rp + OFF_MQ); rk[ps] = *(const u32x4*)(rp + OFF_MK); rv[ps] = *(const u32x4*)(rp + OFF_MV); }
#pragma unroll
        for (int ps = 0; ps < 8; ++ps) { const int r = ps * 32 + wave * 4 + (lane >> 4); bf16_t* rp = proj + (rbase + r) * NPJ + h * 128 + l16 * 8;
#pragma unroll
            for (int x = 0; x < 2; ++x) { bf16_t* ptr = rp + (x == 0 ? OFF_MQ : OFF_MK); const u32x4 raw = x == 0 ? rq[ps] : rk[ps]; float v[8];
                v[0] = bflo(raw.x); v[1] = bfhi(raw.x); v[2] = bflo(raw.y); v[3] = bfhi(raw.y); v[4] = bflo(raw.z); v[5] = bfhi(raw.z); v[6] = bflo(raw.w); v[7] = bfhi(raw.w);
                float ss = 0.f;
#pragma unroll
                for (int i = 0; i < 8; ++i) ss += v[i] * v[i];
                ss = row16_sum(ss);
                const float rs = rsqrtf(ss * (1.f / 128.f) + 1e-6f); const f32x4 g0 = x == 0 ? qg0 : kg0, g1 = x == 0 ? qg1 : kg1;
#pragma unroll
                for (int i = 0; i < 4; ++i) { v[i] *= rs * g0[i]; v[4 + i] *= rs * g1[i]; }
                if (x == 1) {
#pragma unroll
                    for (int i = 0; i < 8; ++i) cs[i] += v[i]; }
                u32x4 w; w.x = pk2(v[0], v[1]); w.y = pk2(v[2], v[3]); w.z = pk2(v[4], v[5]); w.w = pk2(v[6], v[7]); *(u32x4*)ptr = w; }
            *(LAS u32x4*)(VS + r * 136 + l16 * 8) = rv[ps]; }
#pragma unroll
        for (int i = 0; i < 8; ++i) { cs[i] += __shfl_xor(cs[i], 16); cs[i] += __shfl_xor(cs[i], 32); }
        if (lane < 16) {
#pragma unroll
            for (int i = 0; i < 8; ++i) CS[wave * 128 + lane * 8 + i] = cs[i]; }
        __syncthreads();
        if (tid < 128) { float s = 0.f;
#pragma unroll
            for (int w = 0; w < 8; ++w) s += CS[w * 128 + tid];
            kmean[((size_t)(b * 8 + h) * 64 + blk) * 128 + tid] = s * (1.f / 256.f); }
#pragma unroll 2
        for (int i8 = 0; i8 < 8; ++i8) { const int pid = tid + i8 * 512, e = (pid & 63) + 64 * (pid >> 11), ks = (pid >> 6) & 31; unsigned short f[8];
#pragma unroll
            for (int i = 0; i < 8; ++i) f[i] = VS[(ks * 8 + i) * 136 + e];
            u32x4 w; w.x = f[0] | ((unsigned)f[1] << 16); w.y = f[2] | ((unsigned)f[3] << 16); w.z = f[4] | ((unsigned)f[5] << 16); w.w = f[6] | ((unsigned)f[7] << 16);
            *(u32x4*)(proj + (rbase + 2 * e + (ks >> 4)) * NPJ + OFF_MV + h * 128 + (ks & 15) * 8) = w; }
        __syncthreads();
    }
}

DI void phase_moba_select(const Params& P, LAS unsigned char* lds, int wg0, int nwg) {
    const int tid = opq_tid(), qi = tid >> 1, half = tid & 1;
    const bf16_t* proj = (const bf16_t*)(P.ws + WS_R1); const float* kmean = (const float*)(P.ws + WS_KMEAN);
    int* cnt = (int*)(P.ws + WS_CNT); int* list = (int*)(P.ws + WS_LIST); f32x2* ML = (f32x2*)(P.ws + WS_ML);
    LAS float* KM = (LAS float*)lds; LAS int* hist = (LAS int*)(lds + 32768); LAS int* hbase = (LAS int*)(lds + 32768 + 256);
    for (int task = wg0; task < 1024; task += nwg) {
        const int tk = task >> 8, tw_ = task & 255, bhx = (tw_ >> 6) * 4 + tk, blk = (tk & 1) ? 63 - (tw_ & 63) : (tw_ & 63), h = bhx & 7, b = bhx >> 3; const int bh = b * 8 + h; const int t = blk * 256 + qi; const size_t rid = (size_t)bh * TT + t;
        for (int i = tid; i < blk * 128; i += NTHREADS) KM[i] = kmean[(size_t)bh * 64 * 128 + i];
        if (tid < 64) hist[tid] = 0;
        float q[64];
        { const bf16_t* qp = proj + (size_t)(b * TT + t) * NPJ + OFF_MQ + h * 128 + half * 64;
#pragma unroll
          for (int i = 0; i < 8; ++i) { const u32x4 raw = *(const u32x4*)(qp + 8 * i); q[8 * i] = bflo(raw.x); q[8 * i + 1] = bfhi(raw.x); q[8 * i + 2] = bflo(raw.y); q[8 * i + 3] = bfhi(raw.y);
              q[8 * i + 4] = bflo(raw.z); q[8 * i + 5] = bfhi(raw.z); q[8 * i + 6] = bflo(raw.w); q[8 * i + 7] = bfhi(raw.w); } }
        __syncthreads();
        float v0 = -INFINITY, v1 = -INFINITY, v2 = -INFINITY; int i0 = -1, i1 = -1, i2 = -1;
        for (int n = 0; n < blk; ++n) { const LAS float* km = KM + n * 128 + half * 64; float d0 = 0.f, d1 = 0.f, d2 = 0.f, d3 = 0.f;
#pragma unroll
            for (int i = 0; i < 16; ++i) { const f32x4 kv = *(const LAS f32x4*)(km + 4 * i); d0 += q[4 * i] * kv[0]; d1 += q[4 * i + 1] * kv[1]; d2 += q[4 * i + 2] * kv[2]; d3 += q[4 * i + 3] * kv[3]; }
            float g = (d0 + d1) + (d2 + d3); g += __shfl_xor(g, 1);
            if (g > v0) { v2 = v1; i2 = i1; v1 = v0; i1 = i0; v0 = g; i0 = n; } else if (g > v1) { v2 = v1; i2 = i1; v1 = g; i1 = n; } else if (g > v2) { v2 = g; i2 = n; } }
        int rk0 = 0, rk1 = 0, rk2 = 0;
        if (half == 0) { if (i0 >= 0) rk0 = __hip_atomic_fetch_add(&hist[i0], 1, __ATOMIC_RELAXED, __HIP_MEMORY_SCOPE_WORKGROUP); if (i1 >= 0) rk1 = __hip_atomic_fetch_add(&hist[i1], 1, __ATOMIC_RELAXED, __HIP_MEMORY_SCOPE_WORKGROUP); if (i2 >= 0) rk2 = __hip_atomic_fetch_add(&hist[i2], 1, __ATOMIC_RELAXED, __HIP_MEMORY_SCOPE_WORKGROUP); }
        __syncthreads();
        if (tid < 64) { const int c = hist[tid]; hbase[tid] = c > 0 ? atomicAdd(&cnt[bh * 64 + tid], c) : 0; }
        __syncthreads();
        if (half == 0) {
            const f32x2 dead = {-INFINITY, 0.f};
            if (i0 >= 0) list[(size_t)bh * LISTN + i0 * 16384 - 128 * i0 * (i0 + 1) + hbase[i0] + rk0] = t; else ML[0 * 262144 + rid] = dead;
            if (i1 >= 0) list[(size_t)bh * LISTN + i1 * 16384 - 128 * i1 * (i1 + 1) + hbase[i1] + rk1] = t | (1 << 14); else ML[1 * 262144 + rid] = dead;
            if (i2 >= 0) list[(size_t)bh * LISTN + i2 * 16384 - 128 * i2 * (i2 + 1) + hbase[i2] + rk2] = t | (2 << 14); else ML[2 * 262144 + rid] = dead;
        }
        __syncthreads();
    }
}

constexpr int G2_W = 0, G2_Q = 18432, G2_QK = 36864, G2_KD = 47104, G2_BUF = 67584, G2_RED = 135168;
DI void phase_gdn_scan(const Params& P, LAS unsigned char* lds, int bh, const unsigned* flag, unsigned need, int n_first) {
    const int tid = opq_tid(), lane = tid & 63, w = tid >> 6, fr = lane & 15, fq = lane >> 4, b = bh >> 3, h = bh & 7;
    const bf16_t* proj = (const bf16_t*)(P.ws + WS_R1); const bf16_t* W2 = (const bf16_t*)(P.ws + WS_W2); const bf16_t* QKB = (const bf16_t*)(P.ws + WS_QKB);
    const float* GL = (const float*)(P.ws + WS_GL); bf16_t* mix = (bf16_t*)(P.ws + WS_R2);
    float* SSQ = (float*)(P.ws + WS_SSQ);
    const int e = 16 * w + fr; const float gnw = P.gdn_norm[e];
    f32x4 S[8];
#pragma unroll
    for (int i = 0; i < 8; ++i) S[i] = (f32x4){0.f, 0.f, 0.f, 0.f};
    const int wrow0 = tid >> 4, wseg = tid & 15;
    const int qrow = tid >> 3, qseg = tid & 7;
    struct Stage { u32x4 sw[2], sq[2], sqk, skd[2]; };
    u32x2 un[4];
    Stage stA, stB;
#define G2_LOAD(X, nn) do { const int t0_ = b * TT + (nn) * 64; const int ci_ = ((b * 256 + (nn)) << 3) + h; \
        _Pragma("unroll") for (int i_ = 0; i_ < 2; ++i_) { X.sw[i_] = *(const u32x4*)(W2 + (size_t)(t0_ + wrow0 + 32 * i_) * 1024 + h * 128 + wseg * 8); \
            X.sq[i_] = *(const u32x4*)(proj + (size_t)(t0_ + wrow0 + 32 * i_) * NPJ + OFF_GQ + h * 128 + wseg * 8); \
            const int d_ = qrow + 64 * i_; X.skd[i_] = *(const u32x4*)(proj + (size_t)(t0_ + (d_ >> 1)) * NPJ + OFF_GK + h * 128 + (d_ & 1) * 64 + qseg * 8); } \
        X.sqk = *(const u32x4*)(QKB + (size_t)ci_ * 4096 + qrow * 64 + qseg * 8); } while (0)
#define UN_LOAD(nn) do { const int t0_ = b * TT + (nn) * 64; _Pragma("unroll") for (int mt_ = 0; mt_ < 4; ++mt_) un[mt_] = *(const u32x2*)(proj + (size_t)(t0_ + (e >> 1)) * NPJ + OFF_GV + h * 128 + (e & 1) * 64 + 16 * mt_ + 4 * fq); } while (0)
#define G2_ST2(base_, rowoff_, sg_, v_) do { const int g_ = ((sg_) >> 2) * 64, d_ = ((sg_) & 3) * 8; \
        *(LAS u32x2*)(B_ + (base_) + (rowoff_) + g_ + perm4(d_) * 2) = (u32x2){(v_).x, (v_).y}; *(LAS u32x2*)(B_ + (base_) + (rowoff_) + g_ + perm4(d_ + 4) * 2) = (u32x2){(v_).z, (v_).w}; } while (0)
#define G2_STORE(X, bufi) do { LAS unsigned char* B_ = lds + (bufi) * G2_BUF; \
        _Pragma("unroll") for (int i_ = 0; i_ < 2; ++i_) { G2_ST2(G2_W, (wrow0 + 32 * i_) * 288, wseg, X.sw[i_]); G2_ST2(G2_Q, (wrow0 + 32 * i_) * 288, wseg, X.sq[i_]); \
            G2_ST2(G2_KD, (qrow + 64 * i_) * 160, qseg, X.skd[i_]); } \
        G2_ST2(G2_QK, qrow * 160, qseg, X.sqk); } while (0)
    G2_LOAD(stA, 0); G2_STORE(stA, 0); UN_LOAD(0);
    float egl_n = GL[bh * 256];
    u32x2 uc[4];
#pragma unroll
    for (int i = 0; i < 4; ++i) uc[i] = un[i];
    G2_LOAD(stA, 1);
    __syncthreads();
    for (int n2 = 0; n2 < 256; n2 += 2) {
#pragma unroll
      for (int hf2 = 0; hf2 < 2; ++hf2) {
        const int n = n2 + hf2; Stage& LDs = hf2 ? stA : stB; Stage& STs = hf2 ? stB : stA;
        if (n == n_first - 2 || n == 62 || n == 126) {
            const unsigned* fl = (n == 126) ? flag + 1 : (n == 62 ? flag : flag + 2);
            if (tid == 0) { while (__hip_atomic_load(fl, __ATOMIC_RELAXED, __HIP_MEMORY_SCOPE_AGENT) < need) __builtin_amdgcn_s_sleep(8);
                __builtin_amdgcn_fence(__ATOMIC_ACQUIRE, "agent"); asm volatile("s_waitcnt vmcnt(0)" ::: "memory"); }
            __syncthreads(); }
        const int cur = hf2, t0 = b * TT + n * 64; LAS unsigned char* Bf = lds + cur * G2_BUF;
        { const int n2c = n + 2 < 256 ? n + 2 : 255, n1c = n + 1 < 256 ? n + 1 : 255; G2_LOAD(LDs, n2c); UN_LOAD(n1c); }
        const float egl = egl_n; egl_n = GL[bh * 256 + (n + 1 < 256 ? n + 1 : 255)];
        f32x4 Pm[4], Om[4];
#pragma unroll
        for (int mt = 0; mt < 4; ++mt) { Pm[mt] = (f32x4){0.f, 0.f, 0.f, 0.f}; Om[mt] = (f32x4){0.f, 0.f, 0.f, 0.f}; }
#define SBAR __builtin_amdgcn_sched_barrier(0)
#define LD_K4(dst, base_, ks_) do { const int o0_ = fr * 288 + (32 * (ks_) + 8 * fq) * 2; \
        dst[0] = *(const LAS bf16x8*)(Bf + base_ + o0_); dst[1] = *(const LAS bf16x8*)(Bf + base_ + o0_ + 4608); \
        dst[2] = *(const LAS bf16x8*)(Bf + base_ + o0_ + 9216); dst[3] = *(const LAS bf16x8*)(Bf + base_ + o0_ + 13824); } while (0)
#define MM_K4(src, sb_, A_) do { A_[0] = mfma16(src[0], sb_, A_[0]); A_[1] = mfma16(src[1], sb_, A_[1]); A_[2] = mfma16(src[2], sb_, A_[2]); A_[3] = mfma16(src[3], sb_, A_[3]); } while (0)
#define LD_R4(dst, base_, r0_, k2_) do { const int o0_ = (16 * (r0_) + fr) * 160 + (32 * (k2_) + 8 * fq) * 2; \
        dst[0] = *(const LAS bf16x8*)(Bf + base_ + o0_); dst[1] = *(const LAS bf16x8*)(Bf + base_ + o0_ + 2560); \
        dst[2] = *(const LAS bf16x8*)(Bf + base_ + o0_ + 5120); dst[3] = *(const LAS bf16x8*)(Bf + base_ + o0_ + 7680); } while (0)
#define MM_R4(src, vb_, A0_, A1_, A2_, A3_) do { A0_ = mfma16(src[0], vb_, A0_); A1_ = mfma16(src[1], vb_, A1_); A2_ = mfma16(src[2], vb_, A2_); A3_ = mfma16(src[3], vb_, A3_); } while (0)
        bf16x8 fa[4], fb[4];
        LD_K4(fa, G2_W, 0);
        const bf16x8 sb0 = pack8(S[0], S[1]), sb1 = pack8(S[2], S[3]), sb2 = pack8(S[4], S[5]), sb3 = pack8(S[6], S[7]);
        LD_K4(fb, G2_W, 1); SBAR; MM_K4(fa, sb0, Pm); SBAR;
        LD_K4(fa, G2_W, 2); SBAR; MM_K4(fb, sb1, Pm); SBAR;
        LD_K4(fb, G2_W, 3); SBAR; MM_K4(fa, sb2, Pm); SBAR;
        LD_K4(fa, G2_Q, 0); SBAR; MM_K4(fb, sb3, Pm); SBAR;
        f32x4 vn[4];
#pragma unroll
        for (int mt = 0; mt < 4; ++mt) { vn[mt][0] = bflo(uc[mt].x) - Pm[mt][0]; vn[mt][1] = bfhi(uc[mt].x) - Pm[mt][1]; vn[mt][2] = bflo(uc[mt].y) - Pm[mt][2]; vn[mt][3] = bfhi(uc[mt].y) - Pm[mt][3]; }
        bf16x8 Vb[2];
#pragma unroll
        for (int k2 = 0; k2 < 2; ++k2) Vb[k2] = pack8(vn[2 * k2], vn[2 * k2 + 1]);
        LD_K4(fb, G2_Q, 1); SBAR; MM_K4(fa, sb0, Om); SBAR;
        LD_K4(fa, G2_Q, 2); SBAR; MM_K4(fb, sb1, Om); SBAR;
        LD_K4(fb, G2_Q, 3); SBAR; MM_K4(fa, sb2, Om); SBAR;
        LD_R4(fa, G2_QK, 0, 0); SBAR; MM_K4(fb, sb3, Om); SBAR;
#pragma unroll
        for (int dt = 0; dt < 8; ++dt) S[dt] = S[dt] * egl;
        SBAR;
        LD_R4(fb, G2_QK, 0, 1); SBAR; MM_R4(fa, Vb[0], Om[0], Om[1], Om[2], Om[3]); SBAR;
        LD_R4(fa, G2_KD, 0, 0); SBAR; MM_R4(fb, Vb[1], Om[0], Om[1], Om[2], Om[3]); SBAR;
        LD_R4(fb, G2_KD, 0, 1); SBAR; MM_R4(fa, Vb[0], S[0], S[1], S[2], S[3]); SBAR;
        LD_R4(fa, G2_KD, 4, 0); SBAR; MM_R4(fb, Vb[1], S[0], S[1], S[2], S[3]); SBAR;
        LD_R4(fb, G2_KD, 4, 1); SBAR; MM_R4(fa, Vb[0], S[4], S[5], S[6], S[7]); SBAR;
        MM_R4(fb, Vb[1], S[4], S[5], S[6], S[7]); SBAR;
#undef LD_K4
#undef MM_K4
#undef LD_R4
#undef MM_R4
#undef SBAR
        { G2_STORE(STs, cur ^ 1);
#pragma unroll
            for (int i = 0; i < 4; ++i) uc[i] = un[i]; }
        { LAS bf16_t* OTW = (LAS bf16_t*)(lds + G2_RED + w * 2048);
#pragma unroll
          for (int mt = 0; mt < 4; ++mt)
#pragma unroll
            for (int j = 0; j < 4; ++j) OTW[(16 * mt + 4 * fq + j) * 16 + fr] = f2bf(Om[mt][j]);
#pragma unroll
          for (int i = 0; i < 2; ++i) { const int row = (lane >> 1) + 32 * i, hv = lane & 1;
              bf16_t* mp_ = mix + (size_t)(t0 + row) * DM + h * 128 + 16 * w + 8 * hv; const u32x4 ov_ = *(const LAS u32x4*)(OTW + row * 16 + hv * 8);
              asm volatile("global_store_dwordx4 %0, %1, off" :: "v"(mp_), "v"(ov_) : "memory"); } }
        __syncthreads();
      }
    }
#undef G2_LOAD
#undef UN_LOAD
#undef G2_STORE
#undef G2_ST2
    asm volatile("s_waitcnt vmcnt(0)" ::: "memory");
    __syncthreads();
}

constexpr int AT_KS = 0, AT_VT = 73728, AT_PF = 143360, AT_MISC = 147712;
DI void phase_moba_attn(const Params& P, LAS unsigned char* lds) {
    const int tid = opq_tid(), lane = tid & 63, w = tid >> 6, fr = lane & 15, fq = lane >> 4;
    const bf16_t* proj = (const bf16_t*)(P.ws + WS_R1); const int* cnt = (const int*)(P.ws + WS_CNT); const int* list = (const int*)(P.ws + WS_LIST);
    f32x2* ML = (f32x2*)(P.ws + WS_ML); bf16_t* opart = (bf16_t*)P.out; unsigned* workctr = (unsigned*)(P.ws + WS_CTL);
    LAS bf16_t* KS = (LAS bf16_t*)(lds + AT_KS); LAS bf16_t* VT = (LAS bf16_t*)(lds + AT_VT); LAS int* PF = (LAS int*)(lds + AT_PF); LAS int* MISC = (LAS int*)(lds + AT_MISC);
    { const int c0 = cnt[2 * tid], c1 = cnt[2 * tid + 1]; const int a = (c0 + 511) >> 9, bsum = a + ((c1 + 511) >> 9); int inc = bsum;
#pragma unroll
      for (int o = 1; o < 64; o <<= 1) { const int v = __shfl_up(inc, o); if (lane >= o) inc += v; }
      if (lane == 63) MISC[8 + w] = inc;
      __syncthreads();
      int wb = 0;
#pragma unroll
      for (int i = 0; i < 8; ++i) wb += (i < w) ? MISC[8 + i] : 0;
      const int ex = wb + inc - bsum; PF[2 * tid] = ex; PF[2 * tid + 1] = ex + a; if (tid == 511) PF[1024] = ex + bsum;
      __syncthreads(); }
    const int totalG = PF[1024];
    const float sc2 = 0.08838834764831845f * 1.4426950408889634f;
    const int tid_at = tid;
    for (;;) {
        int tid = tid_at; asm volatile("" : "+v"(tid)); const int lane = tid & 63, w = __builtin_amdgcn_readfirstlane(tid >> 6), fr = lane & 15, fq = lane >> 4;
        if (tid == 0) MISC[0] = (int)atomicAdd(workctr, 1u);
        __syncthreads();
        const int wid = MISC[0];
        __syncthreads();
        if (wid >= totalG + 1024) break;
        int bh, j, causal, qstart, qcount;
        if (wid < totalG) { int lo = 0, hi = 1024; while (hi - lo > 1) { const int mid = (lo + hi) >> 1; if (PF[mid] <= wid) lo = mid; else hi = mid; }
            bh = lo >> 6; j = lo & 63; causal = 0; qstart = (wid - PF[lo]) * 512; const int c = cnt[lo]; qcount = c - qstart; if (qcount > 512) qcount = 512; }
        else { const int o = wid - totalG; bh = o >> 6; j = o & 63; causal = 1; qstart = 0; qcount = 256; }
        const int b = bh >> 3, h = bh & 7; const size_t kbase = (size_t)(b * TT + j * 256);
        { u32x4 kr[8], vr[8];
#pragma unroll
          for (int i8 = 0; i8 < 8; ++i8) { const int pid = tid + i8 * 512; kr[i8] = *(const u32x4*)(proj + (kbase + (pid >> 4)) * NPJ + OFF_MK + h * 128 + (pid & 15) * 8);
              const int e = pid >> 5, ks = pid & 31; vr[i8] = *(const u32x4*)(proj + (kbase + 2 * e + (ks >> 4)) * NPJ + OFF_MV + h * 128 + (ks & 15) * 8); }
#pragma unroll
          for (int i8 = 0; i8 < 8; ++i8) { const int pid = tid + i8 * 512; *(LAS u32x4*)(KS + (pid >> 4) * 144 + (pid & 15) * 8) = kr[i8];
              const int e = pid >> 5, ks = pid & 31; const int g_ = (ks >> 2) * 32, d_ = (ks & 3) * 8;
              *(LAS u32x2*)(VT + e * 272 + g_ + perm4(d_)) = (u32x2){vr[i8].x, vr[i8].y}; *(LAS u32x2*)(VT + e * 272 + g_ + perm4(d_ + 4)) = (u32x2){vr[i8].z, vr[i8].w}; } }
        const int lbase = bh * LISTN + j * 16384 - 128 * j * (j + 1) + qstart;
        const int ntile = (qcount + 127) >> 7;
        int en0, en1, en2, en3;
        { const int q0 = 16 * w + fr, lim = qcount - 1;
          if (causal) { en0 = (j * 256 + q0) | (3 << 14); en1 = (j * 256 + q0 + 128) | (3 << 14); en2 = en1; en3 = en1; }
          else { en0 = list[lbase + (q0 < lim ? q0 : lim)]; en1 = list[lbase + (q0 + 128 < lim ? q0 + 128 : lim)]; en2 = list[lbase + (q0 + 256 < lim ? q0 + 256 : lim)]; en3 = list[lbase + (q0 + 384 < lim ? q0 + 384 : lim)]; } }
        bf16x8 Bq[4], Bn[4];
        { const bf16_t* qp = proj + (size_t)(b * TT + (en0 & 16383)) * NPJ + OFF_MQ + h * 128 + 8 * fq;
#pragma unroll
          for (int ks = 0; ks < 4; ++ks) Bq[ks] = *(const bf16x8*)(qp + 32 * ks); }
        __syncthreads();
        for (int tile = 0; tile < ntile; ++tile) {
            const int en = tile == 0 ? en0 : (tile == 1 ? en1 : (tile == 2 ? en2 : en3));
            { const int enx = tile == 0 ? en1 : (tile == 1 ? en2 : en3); const bf16_t* qp = proj + (size_t)(b * TT + (enx & 16383)) * NPJ + OFF_MQ + h * 128 + 8 * fq;
#pragma unroll
              for (int ks = 0; ks < 4; ++ks) Bn[ks] = *(const bf16x8*)(qp + 32 * ks); }
            const int qi = tile * 128 + 16 * w + fr; const bool valid = qi < qcount; const int t = en & 16383, slot = en >> 14;
            if (tile * 128 + 16 * w < qcount) {
            const int nkt = causal ? (8 * tile + w + 1) : 16;
            f32x4 st[16]; float mx = -INFINITY;
#pragma unroll
            for (int kp = 0; kp < 8; ++kp) { f32x4 a0 = {0.f, 0.f, 0.f, 0.f}, a1 = {0.f, 0.f, 0.f, 0.f};
                if (2 * kp < nkt) { bf16x8 kf[8];
#pragma unroll
                    for (int ks = 0; ks < 4; ++ks) { kf[ks] = *(const LAS bf16x8*)(KS + (32 * kp + fr) * 144 + 32 * ks + 8 * fq); kf[4 + ks] = *(const LAS bf16x8*)(KS + (32 * kp + 16 + fr) * 144 + 32 * ks + 8 * fq); }
#pragma unroll
                    for (int ks = 0; ks < 4; ++ks) { a0 = mfma16(kf[ks], Bq[ks], a0); a1 = mfma16(kf[4 + ks], Bq[ks], a1); }
#pragma unroll
                    for (int jj = 0; jj < 4; ++jj) { float s0 = a0[jj] * sc2, s1 = a1[jj] * sc2;
                        if (causal && (32 * kp + 4 * fq + jj) > qi) s0 = -INFINITY; if ((causal && (32 * kp + 16 + 4 * fq + jj) > qi) || 2 * kp + 1 >= nkt) s1 = -INFINITY;
                        a0[jj] = s0; a1[jj] = s1; mx = fmaxf(mx, fmaxf(s0, s1)); }
                } else { a0 = (f32x4){-INFINITY, -INFINITY, -INFINITY, -INFINITY}; a1 = a0; }
                st[2 * kp] = a0; st[2 * kp + 1] = a1; }
            mx = fmaxf(mx, __shfl_xor(mx, 16)); mx = fmaxf(mx, __shfl_xor(mx, 32));
            float ls = 0.f;
#pragma unroll
            for (int kt = 0; kt < 16; ++kt)
#pragma unroll
                for (int jj = 0; jj < 4; ++jj) { const float pv = exp2f(st[kt][jj] - mx); st[kt][jj] = pv; ls += pv; }
            ls += __shfl_xor(ls, 16); ls += __shfl_xor(ls, 32);
            f32x4 ot[8];
#pragma unroll
            for (int et = 0; et < 8; ++et) ot[et] = (f32x4){0.f, 0.f, 0.f, 0.f};
#pragma unroll
            for (int k2 = 0; k2 < 8; ++k2) { if (2 * k2 < nkt) { const bf16x8 pb = pack8(st[2 * k2], st[2 * k2 + 1]);
#pragma unroll
                    for (int eh = 0; eh < 2; ++eh) { bf16x8 vf[4];
#pragma unroll
                        for (int et = 0; et < 4; ++et) vf[et] = *(const LAS bf16x8*)(VT + (16 * (4 * eh + et) + fr) * 272 + 32 * k2 + 8 * fq);
#pragma unroll
                        for (int et = 0; et < 4; ++et) ot[4 * eh + et] = mfma16(vf[et], pb, ot[4 * eh + et]); } } }
            if (valid) { const float il = 1.f / ls; const size_t rid = (size_t)bh * TT + t; bf16_t* op = opart + ((size_t)slot * 262144 + rid) * 128 + 4 * fq;
#pragma unroll
                for (int et = 0; et < 8; ++et) { u32x2 wv; wv.x = pk2(ot[et][0] * il, ot[et][1] * il); wv.y = pk2(ot[et][2] * il, ot[et][3] * il); *(u32x2*)(op + 16 * et) = wv; }
                if (fq == 0) ML[(size_t)slot * 262144 + rid] = (f32x2){mx, ls}; }
            }
#pragma unroll
            for (int ks = 0; ks < 4; ++ks) Bq[ks] = Bn[ks];
        }
        __syncthreads();
    }
}

DI void phase_moba_combine(const Params& P, bool do_gate, bool do_moba, int wg0, int nwg) {
    const bf16_t* opart = (const bf16_t*)P.out; const f32x2* ML = (const f32x2*)(P.ws + WS_ML); bf16_t* mix = (bf16_t*)(P.ws + WS_R2);
    const int gtid = wg0 * NTHREADS + opq_tid(), gsz = nwg * NTHREADS;
    if (do_gate) { const bf16_t* proj = (const bf16_t*)(P.ws + WS_R1);
      for (int i0 = gtid; i0 < MT * 128; i0 += 4 * gsz) { u32x4 mv[4], zv[4];
#pragma unroll
          for (int k = 0; k < 4; ++k) { const int i = i0 + k * gsz < MT * 128 ? i0 + k * gsz : i0; const int row = i >> 7, sg = i & 127; mv[k] = *(const u32x4*)(mix + (size_t)row * DM + sg * 8); zv[k] = *(const u32x4*)(proj + (size_t)row * NPJ + OFF_GZ + sg * 8); }
          const int sg0 = i0 & 127; const f32x4 g0 = *(const f32x4*)(P.gdn_norm + (sg0 & 15) * 8), g1 = *(const f32x4*)(P.gdn_norm + (sg0 & 15) * 8 + 4);
#pragma unroll
          for (int k = 0; k < 4; ++k) { const int i = i0 + k * gsz; const int row = i >> 7, sg = i & 127;
              float o[8]; o[0] = bflo(mv[k].x); o[1] = bfhi(mv[k].x); o[2] = bflo(mv[k].y); o[3] = bfhi(mv[k].y); o[4] = bflo(mv[k].z); o[5] = bfhi(mv[k].z); o[6] = bflo(mv[k].w); o[7] = bfhi(mv[k].w);
              float ssl = 0.f;
#pragma unroll
              for (int q = 0; q < 8; ++q) ssl += o[q] * o[q];
              const float rs = rsqrtf(row16_sum(ssl) * (1.f / 128.f) + 1e-6f); const u32x4 z = zv[k];
              u32x4 wv; wv.x = pk2(o[0] * rs * g0[0] * silu_f(bflo(z.x)), o[1] * rs * g0[1] * silu_f(bfhi(z.x))); wv.y = pk2(o[2] * rs * g0[2] * silu_f(bflo(z.y)), o[3] * rs * g0[3] * silu_f(bfhi(z.y)));
              wv.z = pk2(o[4] * rs * g1[0] * silu_f(bflo(z.z)), o[5] * rs * g1[1] * silu_f(bfhi(z.z))); wv.w = pk2(o[6] * rs * g1[2] * silu_f(bflo(z.w)), o[7] * rs * g1[3] * silu_f(bfhi(z.w)));
              if (i < MT * 128) *(u32x4*)(mix + (size_t)row * DM + sg * 8) = wv; } } }
    if (do_moba) for (int i0 = gtid; i0 < 262144 * 16; i0 += 2 * gsz) {
        f32x2 ml[2][4]; u32x4 raw[2][4];
#pragma unroll
        for (int k = 0; k < 2; ++k) { const int i = i0 + k * gsz < 262144 * 16 ? i0 + k * gsz : i0; const int rid = i >> 4, sg = i & 15;
#pragma unroll
            for (int s = 0; s < 4; ++s) { ml[k][s] = ML[(size_t)s * 262144 + rid]; raw[k][s] = *(const u32x4*)(opart + ((size_t)s * 262144 + rid) * 128 + sg * 8); } }
#pragma unroll
        for (int k = 0; k < 2; ++k) { const int i = i0 + k * gsz; const int rid = i >> 4, sg = i & 15; const int bh = rid >> 14, t = rid & 16383, b = bh >> 3, h = bh & 7;
            float M = -INFINITY;
#pragma unroll
            for (int s = 0; s < 4; ++s) M = fmaxf(M, ml[k][s].x);
            float wgt[4], Lt = 0.f;
#pragma unroll
            for (int s = 0; s < 4; ++s) { wgt[s] = ml[k][s].y > 0.f ? ml[k][s].y * exp2f(ml[k][s].x - M) : 0.f; Lt += wgt[s]; }
            const float iL = 1.f / Lt; float o[8];
#pragma unroll
            for (int q = 0; q < 8; ++q) o[q] = 0.f;
#pragma unroll
            for (int s = 0; s < 4; ++s) { const float ww = wgt[s] * iL; const u32x4 r = raw[k][s];
                if (wgt[s] > 0.f) { o[0] += ww * bflo(r.x); o[1] += ww * bfhi(r.x); o[2] += ww * bflo(r.y); o[3] += ww * bfhi(r.y); o[4] += ww * bflo(r.z); o[5] += ww * bfhi(r.z); o[6] += ww * bflo(r.w); o[7] += ww * bfhi(r.w); } }
            u32x4 wv; wv.x = pk2(o[0], o[1]); wv.y = pk2(o[2], o[3]); wv.z = pk2(o[4], o[5]); wv.w = pk2(o[6], o[7]);
            if (i < 262144 * 16) *(u32x4*)(mix + (size_t)(b * TT + t) * DM + 1024 + h * 128 + sg * 8) = wv; } }
}

DI void sub_barrier(unsigned* ctr, unsigned nwg) {
    asm volatile("s_waitcnt vmcnt(0)" ::: "memory");
    __syncthreads();
    if (threadIdx.x == 0) {
        __builtin_amdgcn_fence(__ATOMIC_RELEASE, "agent");
        __hip_atomic_fetch_add(ctr, 1u, __ATOMIC_RELAXED, __HIP_MEMORY_SCOPE_AGENT);
        while (__hip_atomic_load(ctr, __ATOMIC_RELAXED, __HIP_MEMORY_SCOPE_AGENT) < nwg) __builtin_amdgcn_s_sleep(8);
        __builtin_amdgcn_fence(__ATOMIC_ACQUIRE, "agent");
        asm volatile("s_waitcnt vmcnt(0)" ::: "memory");
    }
    __syncthreads();
}

__global__ void __launch_bounds__(NTHREADS) hybrid_fwd(Params P) {
    extern __shared__ __attribute__((aligned(16))) unsigned char smem[];
    LAS unsigned char* lds = (LAS unsigned char*)smem;
    cg::grid_group grid = cg::this_grid();
    unsigned char* ws = P.ws; const int G = gridDim.x, bx = blockIdx.x;
    bf16_t* R0 = (bf16_t*)(ws + WS_R0); bf16_t* R1 = (bf16_t*)(ws + WS_R1); bf16_t* R2 = (bf16_t*)(ws + WS_R2);
    float* ss1 = (float*)(ws + WS_SS1); float* ss2 = (float*)(ws + WS_SS2);

    phase_prep(P, lds);
    grid.sync();
    { pg8::Gemm g{R0, (const bf16_t*)(ws + WS_WIN), MT, NPJ, DM}; pg8::StaticOrder S; S.init(MT, NPJ, G, bx); EpiProj E{R1, (bf16_t*)(ws + WS_HALO)}; pg8::gemm_phase<decltype(E), pg8::StaticOrder, true, true>(lds, g, S, E); }
    phase_ba(P);
    grid.sync();
    phase_gdn_prep(P, lds, 0, 32, bx, G, (unsigned*)(ws + WS_CTL) + 14, 0x7fffffff);
    if (bx < 16) {
        if (threadIdx.x == 0) { const unsigned* f14 = (const unsigned*)(ws + WS_CTL) + 14; while (__hip_atomic_load(f14, __ATOMIC_RELAXED, __HIP_MEMORY_SCOPE_AGENT) < (unsigned)G) __builtin_amdgcn_s_sleep(8);
            __builtin_amdgcn_fence(__ATOMIC_ACQUIRE, "agent"); asm volatile("s_waitcnt vmcnt(0)" ::: "memory"); }
        __syncthreads(); }
    if (bx < 16) phase_gdn_scan(P, lds, bx, (const unsigned*)(ws + WS_CTL) + 11, (unsigned)(G - 16), 32);
    else { unsigned* ctl = (unsigned*)(ws + WS_CTL);
        phase_gdn_prep(P, lds, 32, 224, bx - 16, G - 16, ctl + 11, 768, ctl + 13, 256);
        asm volatile("s_waitcnt vmcnt(0)" ::: "memory"); __syncthreads();
        if (threadIdx.x == 0) { __builtin_amdgcn_fence(__ATOMIC_RELEASE, "agent"); __hip_atomic_fetch_add(ctl + 12, 1u, __ATOMIC_RELAXED, __HIP_MEMORY_SCOPE_AGENT); }
        phase_moba_prep(P, lds, bx - 16, G - 16); sub_barrier(ctl + 8, (unsigned)(G - 16));
        phase_moba_select(P, lds, bx - 16, G - 16); sub_barrier(ctl + 9, (unsigned)(G - 16));
        phase_moba_attn(P, lds);
        phase_wconv_late(P, lds, bx - 16, G - 16);
        sub_barrier(ctl + 10, (unsigned)(G - 16)); phase_moba_combine(P, false, true, bx - 16, G - 16); }
    if (bx < 16) { asm volatile("s_waitcnt vmcnt(0)" ::: "memory"); __syncthreads();
        if (threadIdx.x == 0) { __builtin_amdgcn_fence(__ATOMIC_RELEASE, "agent"); __hip_atomic_fetch_add((unsigned*)(ws + WS_CTL) + 15, 1u, __ATOMIC_RELAXED, __HIP_MEMORY_SCOPE_AGENT); } }
    { if (threadIdx.x == 0) { const unsigned* f15 = (const unsigned*)(ws + WS_CTL) + 15;
          while (__hip_atomic_load(f15, __ATOMIC_RELAXED, __HIP_MEMORY_SCOPE_AGENT) < 16u) __builtin_amdgcn_s_sleep(8);
          __builtin_amdgcn_fence(__ATOMIC_ACQUIRE, "agent"); asm volatile("s_waitcnt vmcnt(0)" ::: "memory"); }
      __syncthreads(); }
    phase_moba_combine(P, true, false, bx, G);
    grid.sync();
    { pg8::Gemm g{R2, (const bf16_t*)(ws + WS_WO), MT, DM, DM}; pg8::StaticOrder S; S.init(MT, DM, G, bx); EpiResid E{P.x, P.out, R0, ss1}; pg8::gemm_phase<decltype(E), pg8::StaticOrder, true, false>(lds, g, S, E); }
    grid.sync();
    { pg8::Gemm g{R0, (const bf16_t*)(ws + WS_WGU), MT, 2 * FF, DM}; pg8::StaticOrder S; S.init(MT, 2 * FF, G, bx); EpiAct E{R1, ss1}; pg8::gemm_phase<decltype(E), pg8::StaticOrder, true, true>(lds, g, S, E); }
    grid.sync();
    { pg8::Gemm g{(const bf16_t*)(ws + WS_PB), (const bf16_t*)(ws + WS_WPP), MT, DM, 256}; pg8::StaticOrder S; S.init(MT, DM, G, bx); EpiPlainBf16 E{R0, DM}; pg8::gemm_phase<decltype(E), pg8::StaticOrder, true, false>(lds, g, S, E); }
    { pg8::Gemm g{R1, (const bf16_t*)(ws + WS_WDN), MT, DM, FF}; pg8::StaticOrder S; S.init(MT, DM, G, bx); EpiResid E{P.out, P.out, R2, ss2}; pg8::gemm_phase<decltype(E), pg8::StaticOrder, true, false>(lds, g, S, E); }
    grid.sync();
    { pg8::Gemm g{R2, (const bf16_t*)(ws + WS_WPG), MT, DM, DM}; pg8::StaticOrder S; S.init(MT, DM, G, bx); EpiOut E{P.out, R0, ss2}; pg8::gemm_phase<decltype(E), pg8::StaticOrder, true, false>(lds, g, S, E); }
}

extern "C" void kernel_launch(void* const* d_in, const int* in_sizes, int n_in, void* d_out, int out_size, void* d_ws, size_t ws_size, hipStream_t stream) {
    static int grid_blocks = 0;
    if (!grid_blocks) {
        int dev = 0, cus = 0, per_cu = 0;
        hipGetDevice(&dev);
        hipDeviceGetAttribute(&cus, hipDeviceAttributeMultiprocessorCount, dev);
        hipFuncSetAttribute((const void*)hybrid_fwd, hipFuncAttributeMaxDynamicSharedMemorySize, LDS_BYTES);
        hipOccupancyMaxActiveBlocksPerMultiprocessor(&per_cu, (const void*)hybrid_fwd, NTHREADS, LDS_BYTES);
        if (per_cu < 1) per_cu = 1;
        grid_blocks = cus * per_cu;
        if (ws_size < WS_END) fprintf(stderr, "kernel_launch: workspace too small: %zu < %zu\n", ws_size, (size_t)WS_END);
    }
    Params p{};
    p.x = (const float*)d_in[0]; p.p = (const float*)d_in[1]; p.attn_norm = (const float*)d_in[2]; p.w_in = (const float*)d_in[3]; p.conv_w = (const float*)d_in[4];
    p.A_log = (const float*)d_in[5]; p.dt_bias = (const float*)d_in[6]; p.gdn_norm = (const float*)d_in[7]; p.q_norm = (const float*)d_in[8]; p.k_norm = (const float*)d_in[9];
    p.w_o = (const float*)d_in[10]; p.ffn_norm = (const float*)d_in[11]; p.w_gate = (const float*)d_in[12]; p.w_up = (const float*)d_in[13]; p.w_down = (const float*)d_in[14];
    p.ple_norm = (const float*)d_in[15]; p.w_pg = (const float*)d_in[16]; p.w_pp = (const float*)d_in[17];
    p.out = (float*)d_out; p.ws = (unsigned char*)d_ws;
    void* args[] = {&p};
    hipError_t e = hipLaunchCooperativeKernel((const void*)hybrid_fwd, dim3(grid_blocks), dim3(NTHREADS), args, LDS_BYTES, stream);
    if (e != hipSuccess) fprintf(stderr, "cooperative launch failed: %s (grid %d)\n", hipGetErrorString(e), grid_blocks);
}
```

```cpp
#include <hip/hip_runtime.h>
#include <hip/hip_cooperative_groups.h>
#include <cstdio>
namespace cg = cooperative_groups;

#define LAS __attribute__((address_space(3)))
#define DI __device__ __forceinline__
typedef unsigned short bf16_t;
typedef short bf16x8 __attribute__((ext_vector_type(8)));
typedef float f32x4 __attribute__((ext_vector_type(4)));
typedef float f32x2 __attribute__((ext_vector_type(2)));
typedef unsigned u32x4 __attribute__((ext_vector_type(4)));
typedef unsigned u32x2 __attribute__((ext_vector_type(2)));
typedef __bf16 bfv2 __attribute__((ext_vector_type(2)));

constexpr int DM = 2048, TT = 16384, MT = 32768, NPJ = 7168, FF = 5632, INW = 7184;
constexpr int OFF_GQ = 0, OFF_GK = 1024, OFF_GV = 2048, OFF_GZ = 3072, OFF_MQ = 4096, OFF_MK = 5120, OFF_MV = 6144;
constexpr int LISTN = 516096;
constexpr int NTHREADS = 512;
constexpr int LDS_BYTES = 163840;

constexpr size_t WS_CTL   = 0;
constexpr size_t WS_CNT   = 4096;
constexpr size_t WS_SS1   = 8192;
constexpr size_t WS_SS2   = WS_SS1 + 131072;
constexpr size_t WS_GL    = WS_SS2 + 131072;
constexpr size_t WS_KMEAN = WS_GL + 16384;
constexpr size_t WS_WBA   = WS_KMEAN + 524288;
constexpr size_t WS_BA    = WS_WBA + 65536;
constexpr size_t WS_WIN   = WS_BA + 2097152;
constexpr size_t WS_WO    = WS_WIN + (size_t)7168 * 2048 * 2;
constexpr size_t WS_WGU   = WS_WO + (size_t)2048 * 2048 * 2;
constexpr size_t WS_WDN   = WS_WGU + (size_t)11264 * 2048 * 2;
constexpr size_t WS_WPG   = WS_WDN + (size_t)2048 * 5632 * 2;
constexpr size_t WS_WPP   = WS_WPG + (size_t)2048 * 2048 * 2;
constexpr size_t WS_PB    = WS_WPP + (size_t)2048 * 256 * 2;
constexpr size_t WS_R0    = WS_PB + (size_t)32768 * 256 * 2;
constexpr size_t WS_R1    = WS_R0 + (size_t)32768 * 2048 * 2;
constexpr size_t WS_R2    = WS_R1 + (size_t)32768 * 7168 * 2;
constexpr size_t WS_W2    = WS_R2 + (size_t)32768 * 2048 * 2;
constexpr size_t WS_QKB   = WS_W2 + (size_t)32768 * 1024 * 2;
constexpr size_t WS_HALO  = WS_QKB + (size_t)4096 * 4096 * 2;
constexpr size_t WS_LIST  = WS_HALO + (size_t)513 * 3 * 3072 * 2 + 256 - ((size_t)513 * 3 * 3072 * 2) % 256;
constexpr size_t WS_ML    = WS_LIST + (size_t)16 * LISTN * 4;
constexpr size_t WS_SSQ   = WS_ML + (size_t)4 * 262144 * 8;
constexpr size_t WS_END   = WS_SSQ + (size_t)32768 * 64 * 4;

struct Params {
    const float* x; const float* p; const float* attn_norm; const float* w_in; const float* conv_w; const float* A_log; const float* dt_bias;
    const float* gdn_norm; const float* q_norm; const float* k_norm; const float* w_o; const float* ffn_norm; const float* w_gate; const float* w_up;
    const float* w_down; const float* ple_norm; const float* w_pg; const float* w_pp;
    float* out; unsigned char* ws;
};

DI unsigned pk2(float a, float b) { f32x2 v = {a, b}; bfv2 r = __builtin_convertvector(v, bfv2); return __builtin_bit_cast(unsigned, r); }
DI bf16_t f2bf(float a) { return (bf16_t)(pk2(a, 0.f) & 0xffffu); }
DI float bflo(unsigned w) { return __uint_as_float(w << 16); }
DI float bfhi(unsigned w) { return __uint_as_float(w & 0xffff0000u); }
DI float bf2f(bf16_t v) { return __uint_as_float(((unsigned)v) << 16); }
DI bf16x8 pack8(const f32x4& a, const f32x4& b) { u32x4 w; w.x = pk2(a[0], a[1]); w.y = pk2(a[2], a[3]); w.z = pk2(b[0], b[1]); w.w = pk2(b[2], b[3]); return __builtin_bit_cast(bf16x8, w); }
DI bf16x8 cat8(u32x2 lo, u32x2 hi) { u32x4 w; w.x = lo.x; w.y = lo.y; w.z = hi.x; w.w = hi.y; return __builtin_bit_cast(bf16x8, w); }
DI f32x4 mfma16(bf16x8 a, bf16x8 b, f32x4 c) { return __builtin_amdgcn_mfma_f32_16x16x32_bf16(a, b, c, 0, 0, 0); }
DI int perm4(int d4) { return d4 < 16 ? 2 * d4 : 2 * (d4 - 16) + 4; }
DI float dpp_f(float v, int ctrl_sel) { int x = __float_as_int(v); int r;
    if (ctrl_sel == 0) r = __builtin_amdgcn_mov_dpp(x, 0xB1, 0xf, 0xf, true); else if (ctrl_sel == 1) r = __builtin_amdgcn_mov_dpp(x, 0x4E, 0xf, 0xf, true);
    else if (ctrl_sel == 2) r = __builtin_amdgcn_mov_dpp(x, 0x141, 0xf, 0xf, true); else r = __builtin_amdgcn_mov_dpp(x, 0x140, 0xf, 0xf, true);
    return __int_as_float(r); }
DI float row16_sum(float v) { v += dpp_f(v, 0); v += dpp_f(v, 1); v += dpp_f(v, 2); v += dpp_f(v, 3); return v; }
DI float silu_f(float v) { return v * __builtin_amdgcn_rcpf(1.f + __expf(-v)); }
DI float sigm_f(float v) { return __builtin_amdgcn_rcpf(1.f + __expf(-v)); }

DI int opq_tid() { int t = threadIdx.x; asm volatile("" : "+v"(t)); return t; }

namespace pg8 {
constexpr int BM = 256, BK = 64, HALF = 128, HTB = HALF * BK * 2, STAGE_BYTES = 8 * HTB, NXCD = 8, WGM = 8;
DI int lds_byte(int r, int c) { const int st = (r >> 4) * 2 + (c >> 5), rr = r & 15, cc = c & 31, ob = rr * 64 + cc * 2; return st * 1024 + (ob ^ (((ob >> 9) & 1) << 5)); }
DI void stage_rc(int b, int& R, int& C) { const int st = b / 1024, sb = b % 1024, swz = sb ^ (((sb >> 9) & 1) << 5); R = (st >> 1) * 16 + swz / 64; C = (st & 1) * 32 + (swz % 64) / 2; }
DI int perm32(int rho) { const int n = rho >> 4, i = rho & 15; return 8 * (i >> 2) + 4 * n + (i & 3); }
struct Unit { int pm, pn; };
struct Gemm { const bf16_t* A; const bf16_t* Bt; int M, N, K; };
struct StaticOrder {
    int nM, nN, nwg, G, c;
    DI void init(int M, int N, int G_, int c_) { nM = M / BM; nN = N / BM; nwg = nM * nN; G = G_; c = c_; }
    DI bool next(int i, Unit& u) const {
        const long L = (long)i * G + c; if (L >= nwg) return false;
        int wgid = (int)L; { const int q = nwg / NXCD, r = nwg % NXCD, xcd = wgid % NXCD, off = wgid / NXCD; wgid = (xcd < r ? xcd * (q + 1) : r * (q + 1) + (xcd - r) * q) + off; }
        const int nig = WGM * nN, gid = wgid / nig, fm = gid * WGM, gsz = (nM - fm) < WGM ? (nM - fm) : WGM;
        u.pm = fm + ((wgid % nig) % gsz); u.pn = (wgid % nig) / gsz; return true;
    }
    DI void a_ready(const Unit&) const {}
    DI void done(const Unit&) const {}
};

template <class Epi, class Sched, bool ALIGN_EPI = false, bool SP2 = false>
DI void gemm_phase(LAS unsigned char* lds, const Gemm g, const Sched& S, const Epi& E) {
    const int tid = opq_tid(), wid = __builtin_amdgcn_readfirstlane(tid >> 6), lane = tid & 63, wr = wid >> 2, wc = wid & 3, fr = lane & 15, fq = lane >> 4;
    const int K = g.K, nt = K / BK;
    unsigned voffA[2], voffB[2];
#pragma unroll
    for (int i = 0; i < 2; ++i) { int R, C; stage_rc(tid * 16 + i * 8192, R, C); const int Rb = Epi::PERM ? ((R & ~31) + perm32(R & 31)) : R;
        voffA[i] = (unsigned)(R * K + C) * 2u; voffB[i] = (unsigned)(Rb * K + C) * 2u; }
    const size_t kstep = (size_t)(BK * 2);
    const size_t hstep = (size_t)HALF * K * 2;
    const size_t tstep = 2 * hstep;
    const unsigned ldsw = (unsigned)wid * 1024u;
    const int aoff = lds_byte(wr * 64 + fr, fq * 8), boff = lds_byte(wc * 32 + fr, fq * 8);
#define PG8_SA(b, h) (((b) * 2 + (h)) * HTB)
#define PG8_SB(b, h) ((4 + (b) * 2 + (h)) * HTB)
#define PG8_STAGE(bufoff, gbase, voff) do { _Pragma("unroll") for (int _i = 0; _i < 2; ++_i) \
        __builtin_amdgcn_global_load_lds((const unsigned*)((const char*)(gbase) + (voff)[_i]), (LAS unsigned*)(lds + (bufoff) + ldsw + _i * 8192), 16, 0, 0); } while (0)
#define PG8_LDA(dst, b, h) do { _Pragma("unroll") for (int m = 0; m < 4; ++m) _Pragma("unroll") for (int k = 0; k < 2; ++k) dst[m][k] = *(const LAS bf16x8*)(lds + PG8_SA(b, h) + aoff + m * 2048 + k * 1024); } while (0)
#define PG8_LDB(dst, b, h) do { _Pragma("unroll") for (int n = 0; n < 2; ++n) _Pragma("unroll") for (int k = 0; k < 2; ++k) dst[n][k] = *(const LAS bf16x8*)(lds + PG8_SB(b, h) + boff + n * 2048 + k * 1024); } while (0)
#define PG8_MMA(ai, bj, At, Bt) do { __builtin_amdgcn_s_setprio(1); _Pragma("unroll") for (int m = 0; m < 4; ++m) _Pragma("unroll") for (int n = 0; n < 2; ++n) _Pragma("unroll") for (int k = 0; k < 2; ++k) \
        acc[ai][bj][m][n] = __builtin_amdgcn_mfma_f32_16x16x32_bf16(Bt[n][k], At[m][k], acc[ai][bj][m][n], 0, 0, 0); __builtin_amdgcn_s_setprio(0); } while (0)
#define PG8_WAIT_V(n) asm volatile("s_waitcnt vmcnt(" #n ")" ::: "memory")
#define PG8_WAIT_L(n) asm volatile("s_waitcnt lgkmcnt(" #n ")" ::: "memory")
#define PG8_BAR __builtin_amdgcn_s_barrier()
#define PG8_SCHED __builtin_amdgcn_sched_barrier(0)
    Unit cur, nxt; int ui = 0;
    if (!S.next(0, cur)) return;
    f32x4 acc[2][2][4][2];
#pragma unroll
    for (int a = 0; a < 2; ++a)
#pragma unroll
        for (int b = 0; b < 2; ++b)
#pragma unroll
            for (int m = 0; m < 4; ++m)
#pragma unroll
                for (int n = 0; n < 2; ++n) acc[a][b][m][n] = (f32x4){0.f, 0.f, 0.f, 0.f};
    bf16x8 At[4][2], B0[2][2], B1[2][2];
    const char* cA = (const char*)g.A + (size_t)cur.pm * tstep; const char* cB = (const char*)g.Bt + (size_t)cur.pn * tstep;
    S.a_ready(cur);
    if constexpr (SP2) {
        PG8_STAGE(PG8_SB(0, 0), cB, voffB); PG8_STAGE(PG8_SB(0, 1), cB + hstep, voffB); PG8_STAGE(PG8_SA(0, 0), cA, voffA); PG8_STAGE(PG8_SA(0, 1), cA + hstep, voffA);
        if (wr == 1) PG8_BAR;
        PG8_WAIT_V(2); PG8_BAR;
        PG8_STAGE(PG8_SB(1, 0), cB + kstep, voffB); PG8_STAGE(PG8_SA(1, 0), cA + kstep, voffA); PG8_STAGE(PG8_SB(1, 1), cB + hstep + kstep, voffB);
        PG8_WAIT_V(6); PG8_BAR;
    } else {
        PG8_STAGE(PG8_SB(0, 0), cB, voffB); PG8_STAGE(PG8_SA(0, 0), cA, voffA); PG8_STAGE(PG8_SB(0, 1), cB + hstep, voffB); PG8_STAGE(PG8_SA(0, 1), cA + hstep, voffA);
        if (wr == 1) PG8_BAR;
        PG8_WAIT_V(4); PG8_BAR;
        PG8_STAGE(PG8_SB(1, 0), cB + kstep, voffB); PG8_STAGE(PG8_SA(1, 0), cA + kstep, voffA); PG8_STAGE(PG8_SB(1, 1), cB + hstep + kstep, voffB);
        PG8_WAIT_V(6); PG8_BAR;
    }
    for (;;) {
        const bool has_next = S.next(ui + 1, nxt);
        const char* nA = has_next ? (const char*)g.A + (size_t)nxt.pm * tstep : cA; const char* nB = has_next ? (const char*)g.Bt + (size_t)nxt.pn * tstep : cB;
        for (int t = 0; t < nt; t += 2) {
            const bool last = (t == nt - 2);
            const char* a1 = cA + (size_t)(t + 1) * kstep;
            const char* a2 = last ? nA : cA + (size_t)(t + 2) * kstep; const char* b2 = last ? nB : cB + (size_t)(t + 2) * kstep;
            const char* a3 = a2 + kstep; const char* b3 = b2 + kstep;
            if (last && has_next) S.a_ready(nxt);
            if constexpr (SP2) {
            PG8_LDB(B0, 0, 0); PG8_LDB(B1, 0, 1); PG8_SCHED; PG8_LDA(At, 0, 0); PG8_STAGE(PG8_SA(1, 1), a1 + hstep, voffA);
            PG8_WAIT_V(8); PG8_WAIT_L(0); PG8_BAR; PG8_MMA(0, 0, At, B0); PG8_MMA(0, 1, At, B1); PG8_BAR; PG8_SCHED;
            PG8_LDA(At, 0, 1); PG8_STAGE(PG8_SB(0, 0), b2, voffB); PG8_STAGE(PG8_SB(0, 1), b2 + hstep, voffB); PG8_STAGE(PG8_SA(0, 0), a2, voffA);
            PG8_WAIT_V(8); PG8_WAIT_L(0); PG8_BAR; PG8_MMA(1, 0, At, B0); PG8_MMA(1, 1, At, B1); PG8_BAR; PG8_SCHED;
            PG8_LDB(B0, 1, 0); PG8_LDB(B1, 1, 1); PG8_SCHED; PG8_LDA(At, 1, 0); PG8_STAGE(PG8_SA(0, 1), a2 + hstep, voffA);
            PG8_WAIT_V(8); PG8_WAIT_L(0); PG8_BAR; PG8_MMA(0, 0, At, B0); PG8_MMA(0, 1, At, B1); PG8_BAR; PG8_SCHED;
            PG8_LDA(At, 1, 1); PG8_STAGE(PG8_SB(1, 0), b3, voffB); PG8_STAGE(PG8_SB(1, 1), b3 + hstep, voffB); PG8_STAGE(PG8_SA(1, 0), a3, voffA);
            PG8_WAIT_V(8); PG8_WAIT_L(0); PG8_BAR; PG8_MMA(1, 0, At, B0); PG8_MMA(1, 1, At, B1); PG8_BAR; PG8_SCHED;
            } else {
            PG8_LDB(B0, 0, 0); PG8_SCHED; PG8_LDA(At, 0, 0); PG8_STAGE(PG8_SA(1, 1), a1 + hstep, voffA);
            PG8_WAIT_L(8); PG8_BAR; PG8_WAIT_L(0); PG8_MMA(0, 0, At, B0); PG8_BAR; PG8_SCHED;
            PG8_LDB(B1, 0, 1); PG8_STAGE(PG8_SB(0, 0), b2, voffB);
            PG8_BAR; PG8_WAIT_L(0); PG8_MMA(0, 1, At, B1); PG8_BAR;
            PG8_LDA(At, 0, 1); PG8_STAGE(PG8_SA(0, 0), a2, voffA);
            PG8_BAR; PG8_WAIT_L(0); PG8_MMA(1, 0, At, B0); PG8_BAR; PG8_SCHED;
            PG8_STAGE(PG8_SB(0, 1), b2 + hstep, voffB);
            PG8_WAIT_V(6); PG8_BAR; PG8_MMA(1, 1, At, B1); PG8_BAR;
            PG8_LDB(B0, 1, 0); PG8_SCHED; PG8_LDA(At, 1, 0); PG8_STAGE(PG8_SA(0, 1), a2 + hstep, voffA);
            PG8_WAIT_L(8); PG8_BAR; PG8_WAIT_L(0); PG8_MMA(0, 0, At, B0); PG8_BAR; PG8_SCHED;
            PG8_LDB(B1, 1, 1); PG8_STAGE(PG8_SB(1, 0), b3, voffB);
            PG8_BAR; PG8_WAIT_L(0); PG8_MMA(0, 1, At, B1); PG8_BAR;
            PG8_LDA(At, 1, 1); PG8_STAGE(PG8_SA(1, 0), a3, voffA);
            PG8_BAR; PG8_WAIT_L(0); PG8_MMA(1, 0, At, B0); PG8_BAR; PG8_SCHED;
            PG8_STAGE(PG8_SB(1, 1), b3 + hstep, voffB);
            PG8_WAIT_V(6); PG8_BAR; PG8_MMA(1, 1, At, B1); PG8_BAR;
            }
        }
        if constexpr (ALIGN_EPI) { if (wr == 0) PG8_BAR; }
        if constexpr (!Epi::AFTER_DRAIN) { E(acc, cur, wr, wc, fr, fq); S.done(cur); }
        if (!has_next) break;
#pragma unroll
        for (int a = 0; a < 2; ++a)
#pragma unroll
            for (int b = 0; b < 2; ++b)
#pragma unroll
                for (int m = 0; m < 4; ++m)
#pragma unroll
                    for (int n = 0; n < 2; ++n) acc[a][b][m][n] = (f32x4){0.f, 0.f, 0.f, 0.f};
        cur = nxt; cA = nA; cB = nB; ++ui;
        if constexpr (ALIGN_EPI) { if (wr == 1) PG8_BAR; }
    }
    PG8_WAIT_V(0);
    if constexpr (!ALIGN_EPI) { if (wr == 0) PG8_BAR; }
    PG8_BAR;
    if constexpr (Epi::AFTER_DRAIN) { E.fused(acc, cur, wr, wc, fr, fq, lds, wid, lane); S.done(cur); }
#undef PG8_SA
#undef PG8_SB
#undef PG8_STAGE
#undef PG8_LDA
#undef PG8_LDB
#undef PG8_MMA
#undef PG8_WAIT_V
#undef PG8_WAIT_L
#undef PG8_BAR
#undef PG8_SCHED
}
}
using pg8::Unit;

struct EpiProj {
    static constexpr bool PERM = true, AFTER_DRAIN = false;
    bf16_t* O; bf16_t* halo;
    DI void operator()(const f32x4 (&acc)[2][2][4][2], const Unit& u, int wr, int wc, int fr, int fq) const {
        const int row0 = u.pm * 256 + wr * 64 + fr, col0 = u.pn * 256 + wc * 32 + 8 * fq;
#pragma unroll
        for (int ai = 0; ai < 2; ++ai)
#pragma unroll
            for (int m = 0; m < 4; ++m) { const int row = row0 + ai * 128 + m * 16; bf16_t* rowp = O + (size_t)row * NPJ + col0;
#pragma unroll
                for (int bj = 0; bj < 2; ++bj) { const f32x4 v0 = acc[ai][bj][m][0], v1 = acc[ai][bj][m][1];
                    u32x4 w; w.x = pk2(v0[0], v0[1]); w.y = pk2(v0[2], v0[3]); w.z = pk2(v1[0], v1[1]); w.w = pk2(v1[2], v1[3]);
                    *(u32x4*)(rowp + bj * 128) = w;
                    if (m == 3 && fr >= 13 && u.pn < 12) *(u32x4*)(halo + ((size_t)((row >> 6) + 1) * 3 + (fr - 13)) * 3072 + col0 + bj * 128) = w; } }
    }
};
struct EpiPlainBf16 {
    static constexpr bool PERM = true, AFTER_DRAIN = false;
    bf16_t* O; int ldc;
    DI void operator()(const f32x4 (&acc)[2][2][4][2], const Unit& u, int wr, int wc, int fr, int fq) const {
        const int row0 = u.pm * 256 + wr * 64 + fr, col0 = u.pn * 256 + wc * 32 + 8 * fq;
#pragma unroll
        for (int ai = 0; ai < 2; ++ai)
#pragma unroll
            for (int m = 0; m < 4; ++m) { bf16_t* rowp = O + (size_t)(row0 + ai * 128 + m * 16) * ldc + col0;
#pragma unroll
                for (int bj = 0; bj < 2; ++bj) { const f32x4 v0 = acc[ai][bj][m][0], v1 = acc[ai][bj][m][1];
                    u32x4 w; w.x = pk2(v0[0], v0[1]); w.y = pk2(v0[2], v0[3]); w.z = pk2(v1[0], v1[1]); w.w = pk2(v1[2], v1[3]);
                    *(u32x4*)(rowp + bj * 128) = w; } }
    }
};
struct EpiResid {
    static constexpr bool PERM = false, AFTER_DRAIN = false;
    const float* base; float* out; bf16_t* hb; float* ss;
    DI void operator()(const f32x4 (&acc)[2][2][4][2], const Unit& u, int wr, int wc, int fr, int fq) const {
        const int row0 = u.pm * 256 + wr * 64 + fr, col0 = u.pn * 256 + wc * 32 + 4 * fq;
#pragma unroll
        for (int ai = 0; ai < 2; ++ai) { f32x4 bs[4][4];
#pragma unroll
            for (int m = 0; m < 4; ++m)
#pragma unroll
                for (int q = 0; q < 4; ++q) bs[m][q] = *(const f32x4*)(base + (size_t)(row0 + ai * 128 + m * 16) * DM + col0 + (q >> 1) * 128 + (q & 1) * 16);
#pragma unroll
            for (int m = 0; m < 4; ++m) { const int row = row0 + ai * 128 + m * 16; const size_t off = (size_t)row * DM + col0; float s = 0.f;
#pragma unroll
                for (int q = 0; q < 4; ++q) { const f32x4 hv = bs[m][q] + acc[ai][q >> 1][m][q & 1];
                        *(f32x4*)(out + off + (q >> 1) * 128 + (q & 1) * 16) = hv; u32x2 w; w.x = pk2(hv[0], hv[1]); w.y = pk2(hv[2], hv[3]);
                        *(u32x2*)(hb + off + (q >> 1) * 128 + (q & 1) * 16) = w; s += (hv[0] * hv[0] + hv[1] * hv[1]) + (hv[2] * hv[2] + hv[3] * hv[3]); }
                s += __shfl_xor(s, 16); s += __shfl_xor(s, 32);
                if (fq == 0) atomicAdd(ss + row, s); }
            asm volatile("" ::: "memory"); }
    }
};
struct EpiAct {
    static constexpr bool PERM = true, AFTER_DRAIN = false;
    bf16_t* O; const float* ss;
    DI void operator()(const f32x4 (&acc)[2][2][4][2], const Unit& u, int wr, int wc, int fr, int fq) const {
        const int row0 = u.pm * 256 + wr * 64 + fr, col0 = u.pn * 128 + wc * 32 + 8 * fq;
        float rs[8];
#pragma unroll
        for (int g = 0; g < 8; ++g) rs[g] = ss[row0 + (g >> 2) * 128 + (g & 3) * 16];
#pragma unroll
        for (int ai = 0; ai < 2; ++ai)
#pragma unroll
            for (int m = 0; m < 4; ++m) { const int row = row0 + ai * 128 + m * 16; const float r = rsqrtf(rs[ai * 4 + m] * (1.f / 2048.f) + 1e-6f);
                float a[8];
#pragma unroll
                for (int n = 0; n < 2; ++n)
#pragma unroll
                    for (int j = 0; j < 4; ++j) { const float gv = r * acc[ai][0][m][n][j], uv = r * acc[ai][1][m][n][j]; a[n * 4 + j] = silu_f(gv) * uv; }
                u32x4 w; w.x = pk2(a[0], a[1]); w.y = pk2(a[2], a[3]); w.z = pk2(a[4], a[5]); w.w = pk2(a[6], a[7]);
                *(u32x4*)(O + (size_t)row * FF + col0) = w; }
    }
};
struct EpiOut {
    static constexpr bool PERM = false, AFTER_DRAIN = false;
    float* out; const bf16_t* pp; const float* ss;
    DI void operator()(const f32x4 (&acc)[2][2][4][2], const Unit& u, int wr, int wc, int fr, int fq) const {
        const int row0 = u.pm * 256 + wr * 64 + fr, col0 = u.pn * 256 + wc * 32 + 4 * fq;
        float rs[8];
#pragma unroll
        for (int g = 0; g < 8; ++g) rs[g] = ss[row0 + (g >> 2) * 128 + (g & 3) * 16];
#pragma unroll
        for (int ai = 0; ai < 2; ++ai)
#pragma unroll
            for (int m = 0; m < 4; ++m) { const int row = row0 + ai * 128 + m * 16; const size_t off = (size_t)row * DM + col0; const float r = rsqrtf(rs[ai * 4 + m] * (1.f / 2048.f) + 1e-6f);
                f32x4 hv[4]; u32x2 pw[4];
#pragma unroll
                for (int q = 0; q < 4; ++q) { hv[q] = *(const f32x4*)(out + off + (q >> 1) * 128 + (q & 1) * 16); pw[q] = *(const u32x2*)(pp + off + (q >> 1) * 128 + (q & 1) * 16); }
#pragma unroll
                for (int q = 0; q < 4; ++q) { const f32x4 a = acc[ai][q >> 1][m][q & 1]; f32x4 o;
                        o[0] = hv[q][0] + sigm_f(r * a[0]) * bflo(pw[q].x); o[1] = hv[q][1] + sigm_f(r * a[1]) * bfhi(pw[q].x);
                        o[2] = hv[q][2] + sigm_f(r * a[2]) * bflo(pw[q].y); o[3] = hv[q][3] + sigm_f(r * a[3]) * bfhi(pw[q].y);
                        *(f32x4*)(out + off + (q >> 1) * 128 + (q & 1) * 16) = o; }
                asm volatile("" ::: "memory"); }
    }
};

DI void tconv_tile(const float* __restrict__ src, int ld, int c0, int k0, bf16_t* __restrict__ dst, int dK, int n0, const float* __restrict__ nw, LAS float* tl) {
    const int tid = opq_tid();
    f32x4 v[8];
#pragma unroll
    for (int i = 0; i < 8; ++i) v[i] = *(const f32x4*)(src + (size_t)(k0 + (tid >> 4) + 32 * i) * ld + c0 + (tid & 15) * 4);
#pragma unroll
    for (int i = 0; i < 8; ++i) { const int k = (tid >> 4) + 32 * i; const float sc = nw ? nw[k0 + k] : 1.f;
        LAS float* q = tl + k * 65 + (tid & 15) * 4; q[0] = v[i][0] * sc; q[1] = v[i][1] * sc; q[2] = v[i][2] * sc; q[3] = v[i][3] * sc; }
    __syncthreads();
    { const int n = tid >> 3, kq = (tid & 7) * 8;
#pragma unroll
      for (int j = 0; j < 4; ++j) { const int ks = kq + 64 * j; float f[8];
#pragma unroll
          for (int i = 0; i < 8; ++i) f[i] = tl[(ks + i) * 65 + n];
          u32x4 w; w.x = pk2(f[0], f[1]); w.y = pk2(f[2], f[3]); w.z = pk2(f[4], f[5]); w.w = pk2(f[6], f[7]);
          *(u32x4*)(dst + (size_t)(n0 + n) * dK + k0 + ks) = w; } }
    __syncthreads();
}

DI void phase_prep(const Params& P, LAS unsigned char* lds) {
    unsigned char* ws = P.ws; const int tid = opq_tid(), G = gridDim.x, bx = blockIdx.x;
    const int gtid = bx * NTHREADS + tid, gsz = G * NTHREADS;
    for (int i = gtid; i < (int)((WS_GL - WS_CTL) / 4); i += gsz) ((unsigned*)(ws + WS_CTL))[i] = 0u;
    { bf16_t* wba = (bf16_t*)(ws + WS_WBA); for (int i = gtid; i < 16 * 2048; i += gsz) { const int n = i >> 11, k = i & 2047; wba[i] = f2bf(P.w_in[(size_t)k * INW + 4096 + n]); } }
    { bf16_t* pb = (bf16_t*)(ws + WS_PB); for (int i = gtid; i < MT * 256 / 8; i += gsz) { const f32x4 a = *(const f32x4*)(P.p + (size_t)i * 8), b = *(const f32x4*)(P.p + (size_t)i * 8 + 4);
        u32x4 w; w.x = pk2(a[0], a[1]); w.y = pk2(a[2], a[3]); w.z = pk2(b[0], b[1]); w.w = pk2(b[2], b[3]); *(u32x4*)(pb + (size_t)i * 8) = w; } }
    { bf16_t* xn = (bf16_t*)(ws + WS_R0); const int lane = tid & 63, gw = bx * 8 + (tid >> 6);
      f32x4 wv[8];
#pragma unroll
      for (int i = 0; i < 8; ++i) wv[i] = *(const f32x4*)(P.attn_norm + lane * 4 + i * 256);
      for (int row = gw * 2; row < MT; row += G * 16) { const float* xr = P.x + (size_t)row * DM; f32x4 v[2][8]; float s0 = 0.f, s1 = 0.f;
#pragma unroll
          for (int r = 0; r < 2; ++r)
#pragma unroll
              for (int i = 0; i < 8; ++i) v[r][i] = *(const f32x4*)(xr + (size_t)r * DM + lane * 4 + i * 256);
#pragma unroll
          for (int i = 0; i < 8; ++i) { s0 += (v[0][i][0] * v[0][i][0] + v[0][i][1] * v[0][i][1]) + (v[0][i][2] * v[0][i][2] + v[0][i][3] * v[0][i][3]);
              s1 += (v[1][i][0] * v[1][i][0] + v[1][i][1] * v[1][i][1]) + (v[1][i][2] * v[1][i][2] + v[1][i][3] * v[1][i][3]); }
#pragma unroll
          for (int o = 1; o < 64; o <<= 1) { s0 += __shfl_xor(s0, o); s1 += __shfl_xor(s1, o); }
          const float r0 = rsqrtf(s0 * (1.f / 2048.f) + 1e-6f), r1 = rsqrtf(s1 * (1.f / 2048.f) + 1e-6f);
#pragma unroll
          for (int r = 0; r < 2; ++r)
#pragma unroll
              for (int i = 0; i < 8; ++i) { const float rr = r ? r1 : r0; u32x2 w; w.x = pk2(v[r][i][0] * rr * wv[i][0], v[r][i][1] * rr * wv[i][1]); w.y = pk2(v[r][i][2] * rr * wv[i][2], v[r][i][3] * rr * wv[i][3]);
                  *(u32x2*)(xn + (size_t)(row + r) * DM + lane * 4 + i * 256) = w; } } }
    LAS float* tl = (LAS float*)lds;
    for (int gi = bx; gi < 896; gi += G) { const int nt = gi >> 3, kg = gi & 7, n0 = nt * 64; tconv_tile(P.w_in, INW, n0 < 4096 ? n0 : n0 + 16, kg * 256, (bf16_t*)(ws + WS_WIN), 2048, n0, nullptr, tl); }
}
DI void phase_wconv_late(const Params& P, LAS unsigned char* lds, int wg0, int nwg) {
    unsigned char* ws = P.ws; LAS float* tl = (LAS float*)lds;
    for (int gi = 896 + wg0; gi < 3552; gi += nwg) {
        if (gi < 1152) { const int t2 = gi - 896, nt = t2 >> 3, kg = t2 & 7; tconv_tile(P.w_o, 2048, nt * 64, kg * 256, (bf16_t*)(ws + WS_WO), 2048, nt * 64, nullptr, tl); }
        else if (gi < 2560) { const int t2 = gi - 1152, nt = t2 >> 3, kg = t2 & 7, n0 = nt * 64, pn = n0 >> 8, r = n0 & 255;
            tconv_tile(r < 128 ? P.w_gate : P.w_up, FF, pn * 128 + (r & 127), kg * 256, (bf16_t*)(ws + WS_WGU), 2048, n0, P.ffn_norm, tl); }
        else if (gi < 3264) { const int t2 = gi - 2560, nt = t2 / 22, kg = t2 % 22; tconv_tile(P.w_down, 2048, nt * 64, kg * 256, (bf16_t*)(ws + WS_WDN), FF, nt * 64, nullptr, tl); }
        else if (gi < 3520) { const int t2 = gi - 3264, nt = t2 >> 3, kg = t2 & 7; tconv_tile(P.w_pg, 2048, nt * 64, kg * 256, (bf16_t*)(ws + WS_WPG), 2048, nt * 64, P.ple_norm, tl); }
        else { const int nt = gi - 3520; tconv_tile(P.w_pp, 2048, nt * 64, 0, (bf16_t*)(ws + WS_WPP), 256, nt * 64, nullptr, tl); }
    }
}

DI void phase_ba(const Params& P) {
    const int tid = opq_tid(), lane = tid & 63, fr = lane & 15, fq = lane >> 4, gw = blockIdx.x * 8 + (tid >> 6);
    const bf16_t* xn = (const bf16_t*)(P.ws + WS_R0); const bf16_t* wba = (const bf16_t*)(P.ws + WS_WBA); float* BA = (float*)(P.ws + WS_BA);
    for (int rt = gw; rt < MT / 16; rt += gridDim.x * 8) {
        f32x4 acc = {0.f, 0.f, 0.f, 0.f}; const bf16_t* ap = xn + (size_t)(rt * 16 + fr) * DM + 8 * fq; const bf16_t* bp = wba + fr * 2048 + 8 * fq;
#pragma unroll 16
        for (int ks = 0; ks < 64; ++ks) acc = mfma16(*(const bf16x8*)(ap + 32 * ks), *(const bf16x8*)(bp + 32 * ks), acc);
#pragma unroll
        for (int j = 0; j < 4; ++j) BA[(size_t)(rt * 16 + 4 * fq + j) * 16 + fr] = acc[j];
    }
}

constexpr int G1_QS = 0, G1_KS = 18432, G1_VT = 36864, G1_KT = 57344, G1_SM = 77824, G1_TEAM = 78848;
DI void phase_gdn_prep(const Params& P, LAS unsigned char* lds, int n_lo, int n_cnt, int wg0, int nwg, unsigned* early_flag = nullptr, int early_thr = 0, unsigned* early_flag2 = nullptr, int early_thr2 = 0) {
    const int tid0 = opq_tid(), team = tid0 >> 8;
    LAS unsigned char* L = lds + team * G1_TEAM;
    LAS bf16_t* QS = (LAS bf16_t*)(L + G1_QS); LAS bf16_t* KS = (LAS bf16_t*)(L + G1_KS); LAS bf16_t* VT = (LAS bf16_t*)(L + G1_VT); LAS bf16_t* KT = (LAS bf16_t*)(L + G1_KT);
    LAS float* AF = (LAS float*)(L + G1_QS); LAS bf16_t* TB = (LAS bf16_t*)(L + G1_KS); LAS float* SM = (LAS float*)(L + G1_SM);
    bf16_t* proj = (bf16_t*)(P.ws + WS_R1); const bf16_t* halo = (const bf16_t*)(P.ws + WS_HALO); const float* BA = (const float*)(P.ws + WS_BA);
    bf16_t* W2 = (bf16_t*)(P.ws + WS_W2); bf16_t* QKB = (bf16_t*)(P.ws + WS_QKB); float* GL = (float*)(P.ws + WS_GL);
    bool arrived = (early_flag == nullptr), arrived2 = (early_flag2 == nullptr);
    for (int pi = wg0; pi < n_cnt * 8; pi += nwg) {
        int tid = tid0; asm volatile("" : "+v"(tid));
        const int tt = tid & 255, tw = __builtin_amdgcn_readfirstlane((tid >> 6) & 3), lane = tid & 63, fr = lane & 15, fq = lane >> 4;
        const int cq = pi * 2 + team, h = cq & 7, b = (cq >> 3) & 1, n = n_lo + (cq >> 4), ci = ((b * 256 + n) << 3) + h, t0 = b * TT + n * 64;
        if (tw == 0) {
            const float bv = BA[(size_t)(t0 + lane) * 16 + h], av = BA[(size_t)(t0 + lane) * 16 + 8 + h];
            const float beta = sigm_f(bv); const float xx = av + P.dt_bias[h]; const float sp = xx > 20.f ? xx : log1pf(__expf(xx));
            const float gg = -__expf(P.A_log[h]) * sp; float gc = gg;
#pragma unroll
            for (int o = 1; o < 64; o <<= 1) { const float v = __shfl_up(gc, o); if (lane >= o) gc += v; }
            const float glast = __shfl(gc, 63);
            SM[lane] = gc; SM[64 + lane] = beta; SM[128 + lane] = __expf(gc); SM[192 + lane] = __expf(glast - gc);
            if (lane == 63) GL[(b * 8 + h) * 256 + n] = __expf(gc);
        }
        __syncthreads();
        { const int r = tt >> 2, cg0 = (tt & 3) * 32; const float beta_r = SM[64 + r], egc_r = SM[128 + r];
#pragma unroll 1
          for (int x = 0; x < 3; ++x) {
              float val[32]; const int colbase = x * 1024 + h * 128 + cg0;
              u32x4 rawa[4][4];
#pragma unroll
              for (int sg = 0; sg < 4; ++sg) { const int col = colbase + sg * 8;
#pragma unroll
                  for (int j = 0; j < 4; ++j) { const int rr = r - 3 + j; rawa[sg][j] = (u32x4){0u, 0u, 0u, 0u};
                      if (rr >= 0) rawa[sg][j] = *(const u32x4*)(proj + (size_t)(t0 + rr) * NPJ + col);
                      else if (n > 0) rawa[sg][j] = *(const u32x4*)(halo + ((size_t)(t0 >> 6) * 3 + (rr + 3)) * 3072 + col); } }
#pragma unroll
              for (int sg = 0; sg < 4; ++sg) { const int col = colbase + sg * 8;
#pragma unroll
                  for (int i = 0; i < 8; ++i) { const f32x4 w4 = *(const f32x4*)(P.conv_w + (size_t)(col + i) * 4); float a = 0.f;
#pragma unroll
                      for (int j = 0; j < 4; ++j) { const unsigned wd = rawa[sg][j][i >> 1]; const float xv = (i & 1) ? bfhi(wd) : bflo(wd); a += w4[j] * xv; }
                      val[sg * 8 + i] = silu_f(a); } }
              if (x < 2) { float ss = 0.f;
#pragma unroll
                  for (int i = 0; i < 32; ++i) ss += val[i] * val[i];
                  ss += __shfl_xor(ss, 1); ss += __shfl_xor(ss, 2);
                  const float sc = rsqrtf(ss + 1e-6f) * (x == 0 ? 0.08838834764831845f : 1.f);
#pragma unroll
                  for (int i = 0; i < 32; ++i) val[i] *= sc; }
              if (x < 2) { LAS bf16_t* dst = (x == 0 ? QS : KS) + r * 144 + cg0;
#pragma unroll
                  for (int i = 0; i < 4; ++i) { u32x4 w; w.x = pk2(val[8 * i], val[8 * i + 1]); w.y = pk2(val[8 * i + 2], val[8 * i + 3]); w.z = pk2(val[8 * i + 4], val[8 * i + 5]); w.w = pk2(val[8 * i + 6], val[8 * i + 7]);
                      *(LAS u32x4*)(dst + 8 * i) = w; } }
              if (x == 1) { const float f = beta_r * egc_r;
#pragma unroll
                  for (int i = 0; i < 32; ++i) KT[(cg0 + i) * 80 + r] = f2bf(val[i] * f); }
              if (x == 2) {
#pragma unroll
                  for (int i = 0; i < 32; ++i) VT[(cg0 + i) * 80 + r] = f2bf(val[i] * beta_r); }
          } }
        __syncthreads();
        f32x4 kk[4], qk[4];
#pragma unroll
        for (int nt = 0; nt < 4; ++nt) { kk[nt] = (f32x4){0.f, 0.f, 0.f, 0.f}; qk[nt] = (f32x4){0.f, 0.f, 0.f, 0.f}; }
#pragma unroll
        for (int ks = 0; ks < 4; ++ks) { const bf16x8 ak = *(const LAS bf16x8*)(KS + (16 * tw + fr) * 144 + 32 * ks + 8 * fq), aq = *(const LAS bf16x8*)(QS + (16 * tw + fr) * 144 + 32 * ks + 8 * fq);
#pragma unroll
            for (int nt = 0; nt < 4; ++nt) { const bf16x8 bk = *(const LAS bf16x8*)(KS + (16 * nt + fr) * 144 + 32 * ks + 8 * fq); kk[nt] = mfma16(ak, bk, kk[nt]); qk[nt] = mfma16(aq, bk, qk[nt]); } }
        { const int r = tt >> 2, cg0 = (tt & 3) * 32; const float e = SM[128 + r];
#pragma unroll
          for (int i = 0; i < 4; ++i) { const u32x4 s = *(const LAS u32x4*)(QS + r * 144 + cg0 + 8 * i); u32x4 w;
              w.x = pk2(bflo(s.x) * e, bfhi(s.x) * e); w.y = pk2(bflo(s.y) * e, bfhi(s.y) * e); w.z = pk2(bflo(s.z) * e, bfhi(s.z) * e); w.w = pk2(bflo(s.w) * e, bfhi(s.w) * e);
              *(u32x4*)(proj + (size_t)(t0 + r) * NPJ + OFF_GQ + h * 128 + cg0 + 8 * i) = w; } }
        { const int d = tt >> 1, cb = (tt & 1) * 32;
#pragma unroll
          for (int i4 = 0; i4 < 4; ++i4) { const int c0 = cb + 8 * i4; float f[8];
#pragma unroll
              for (int i = 0; i < 8; ++i) f[i] = bf2f(KS[(c0 + i) * 144 + d]) * SM[192 + c0 + i];
              u32x4 w; w.x = pk2(f[0], f[1]); w.y = pk2(f[2], f[3]); w.z = pk2(f[4], f[5]); w.w = pk2(f[6], f[7]);
              *(u32x4*)(proj + (size_t)(t0 + (d >> 1)) * NPJ + OFF_GK + h * 128 + (d & 1) * 64 + c0) = w; } }
        __syncthreads();
#pragma unroll
        for (int nt = 0; nt < 4; ++nt)
#pragma unroll
            for (int j = 0; j < 4; ++j) { const int c = 16 * tw + 4 * fq + j, s = 16 * nt + fr; const float dec = (s <= c) ? __expf(SM[c] - SM[s]) : 0.f;
                AF[c * 65 + s] = (s < c) ? SM[64 + c] * kk[nt][j] * dec : (s == c ? 1.f : 0.f);
                QKB[(size_t)ci * 4096 + c * 64 + s] = f2bf(qk[nt][j] * dec); }
        __syncthreads();
        { const int bb = tw * 16;
          if (lane < 16) {
              for (int i = 1; i < 16; ++i) { float a0 = 0.f, a1 = 0.f; int j = 0;
                  for (; j + 2 <= i; j += 2) { a0 += AF[(bb + i) * 65 + bb + j] * AF[(bb + j) * 65 + bb + lane]; a1 += AF[(bb + i) * 65 + bb + j + 1] * AF[(bb + j + 1) * 65 + bb + lane]; }
                  if (j < i) a0 += AF[(bb + i) * 65 + bb + j] * AF[(bb + j) * 65 + bb + lane];
                  AF[(bb + i) * 65 + bb + lane] = lane < i ? -(a0 + a1) : (lane == i ? 1.f : 0.f); } }
#pragma unroll
          for (int k = 0; k < 4; ++k) { const int row = bb + fq + 4 * k; TB[row * 80 + bb + fr] = f2bf(AF[row * 65 + bb + fr]);
              for (int jb = tw + 1; jb < 4; ++jb) TB[row * 80 + 16 * jb + fr] = (bf16_t)0; }
          __syncthreads();
          for (int i = 1; i < 4; ++i) {
              if (tw < i) { const int j = tw; f32x4 X = {0.f, 0.f, 0.f, 0.f};
                  for (int k = j; k < i; ++k) {
#pragma unroll
                      for (int kk = 0; kk < 4; ++kk) { const float av = AF[(16 * i + fr) * 65 + 16 * k + 4 * kk + fq];
                          const float bv = (k == j) ? AF[(16 * k + 4 * kk + fq) * 65 + 16 * j + fr] : bf2f(TB[(16 * k + 4 * kk + fq) * 80 + 16 * j + fr]);
                          X = __builtin_amdgcn_mfma_f32_16x16x4f32(av, bv, X, 0, 0, 0); } }
                  f32x4 O = {0.f, 0.f, 0.f, 0.f};
#pragma unroll
                  for (int kk = 0; kk < 4; ++kk) O = __builtin_amdgcn_mfma_f32_16x16x4f32(AF[(16 * i + fr) * 65 + 16 * i + 4 * fq + kk], X[kk], O, 0, 0, 0);
#pragma unroll
                  for (int jj = 0; jj < 4; ++jj) TB[(16 * i + 4 * fq + jj) * 80 + 16 * j + fr] = f2bf(-O[jj]); }
              __syncthreads(); }
        }
        { bf16x8 at[2];
#pragma unroll
          for (int ks = 0; ks < 2; ++ks) at[ks] = *(const LAS bf16x8*)(TB + (16 * tw + fr) * 80 + 32 * ks + 8 * fq);
#pragma unroll
          for (int nt = 0; nt < 8; ++nt) { f32x4 a = {0.f, 0.f, 0.f, 0.f};
#pragma unroll
              for (int ks = 0; ks < 2; ++ks) a = mfma16(at[ks], *(const LAS bf16x8*)(VT + (16 * nt + fr) * 80 + 32 * ks + 8 * fq), a);
              const int e = 16 * nt + fr; u32x2 w; w.x = pk2(a[0], a[1]); w.y = pk2(a[2], a[3]);
              *(u32x2*)(proj + (size_t)(t0 + (e >> 1)) * NPJ + OFF_GV + h * 128 + (e & 1) * 64 + 16 * tw + 4 * fq) = w; }
#pragma unroll
          for (int mt = 0; mt < 8; ++mt) { f32x4 a = {0.f, 0.f, 0.f, 0.f};
#pragma unroll
              for (int ks = 0; ks < 2; ++ks) a = mfma16(*(const LAS bf16x8*)(KT + (16 * mt + fr) * 80 + 32 * ks + 8 * fq), at[ks], a);
              u32x2 w; w.x = pk2(a[0], a[1]); w.y = pk2(a[2], a[3]);
              *(u32x2*)(W2 + (size_t)(t0 + 16 * tw + fr) * 1024 + h * 128 + 16 * mt + 4 * fq) = w; } }
        __syncthreads();
        if (!arrived && pi + nwg >= early_thr) {
            asm volatile("s_waitcnt vmcnt(0)" ::: "memory"); __syncthreads();
            if (threadIdx.x == 0) { __builtin_amdgcn_fence(__ATOMIC_RELEASE, "agent"); __hip_atomic_fetch_add(early_flag, 1u, __ATOMIC_RELAXED, __HIP_MEMORY_SCOPE_AGENT); }
            arrived = true; }
        if (!arrived2 && pi + nwg >= early_thr2) {
            asm volatile("s_waitcnt vmcnt(0)" ::: "memory"); __syncthreads();
            if (threadIdx.x == 0) { __builtin_amdgcn_fence(__ATOMIC_RELEASE, "agent"); __hip_atomic_fetch_add(early_flag2, 1u, __ATOMIC_RELAXED, __HIP_MEMORY_SCOPE_AGENT); }
            arrived2 = true; }
    }
    if (!arrived2) { asm volatile("s_waitcnt vmcnt(0)" ::: "memory"); __syncthreads();
        if (threadIdx.x == 0) { __builtin_amdgcn_fence(__ATOMIC_RELEASE, "agent"); __hip_atomic_fetch_add(early_flag2, 1u, __ATOMIC_RELAXED, __HIP_MEMORY_SCOPE_AGENT); } }
    if (!arrived) { asm volatile("s_waitcnt vmcnt(0)" ::: "memory"); __syncthreads();
        if (threadIdx.x == 0) { __builtin_amdgcn_fence(__ATOMIC_RELEASE, "agent"); __hip_atomic_fetch_add(early_flag, 1u, __ATOMIC_RELAXED, __HIP_MEMORY_SCOPE_AGENT); } }
}

DI void phase_moba_prep(const Params& P, LAS unsigned char* lds, int wg0, int nwg) {
    const int tid = opq_tid(), lane = tid & 63, wave = tid >> 6, l16 = lane & 15;
    bf16_t* proj = (bf16_t*)(P.ws + WS_R1); float* kmean = (float*)(P.ws + WS_KMEAN);
    LAS bf16_t* VS = (LAS bf16_t*)lds; LAS float* CS = (LAS float*)(lds + 69632);
    for (int task = wg0; task < 1024; task += nwg) {
        const int h = task & 7, blk = (task >> 3) & 63, b = task >> 9; const size_t rbase = (size_t)(b * TT + blk * 256);
        f32x4 qg0 = *(const f32x4*)(P.q_norm + l16 * 8), qg1 = *(const f32x4*)(P.q_norm + l16 * 8 + 4), kg0 = *(const f32x4*)(P.k_norm + l16 * 8), kg1 = *(const f32x4*)(P.k_norm + l16 * 8 + 4);
        float cs[8];
#pragma unroll
        for (int i = 0; i < 8; ++i) cs[i] = 0.f;
        u32x4 rq[8], rk[8], rv[8];
#pragma unroll
        for (int ps = 0; ps < 8; ++ps) { const int r = ps * 32 + wave * 4 + (lane >> 4); const bf16_t* rp = proj + (rbase + r) * NPJ + h * 128 + l16 * 8;
            rq[ps] = *(const u32x4*)(rp + OFF_MQ); rk[ps] = *(const u32x4*)(rp + OFF_MK); rv[ps] = *(const u32x4*)(rp + OFF_MV); }
#pragma unroll
        for (int ps = 0; ps < 8; ++ps) { const int r = ps * 32 + wave * 4 + (lane >> 4); bf16_t* rp = proj + (rbase + r) * NPJ + h * 128 + l16 * 8;
#pragma unroll
            for (int x = 0; x < 2; ++x) { bf16_t* ptr = rp + (x == 0 ? OFF_MQ : OFF_MK); const u32x4 raw = x == 0 ? rq[ps] : rk[ps]; float v[8];
                v[0] = bflo(raw.x); v[1] = bfhi(raw.x); v[2] = bflo(raw.y); v[3] = bfhi(raw.y); v[4] = bflo(raw.z); v[5] = bfhi(raw.z); v[6] = bflo(raw.w); v[7] = bfhi(raw.w);
                float ss = 0.f;
#pragma unroll
                for (int i = 0; i < 8; ++i) ss += v[i] * v[i];
                ss = row16_sum(ss);
                const float rs = rsqrtf(ss * (1.f / 128.f) + 1e-6f); const f32x4 g0 = x == 0 ? qg0 : kg0, g1 = x == 0 ? qg1 : kg1;
#pragma unroll
                for (int i = 0; i < 4; ++i) { v[i] *= rs * g0[i]; v[4 + i] *= rs * g1[i]; }
                if (x == 1) {
#pragma unroll
                    for (int i = 0; i < 8; ++i) cs[i] += v[i]; }
                u32x4 w; w.x = pk2(v[0], v[1]); w.y = pk2(v[2], v[3]); w.z = pk2(v[4], v[5]); w.w = pk2(v[6], v[7]); *(u32x4*)ptr = w; }
            *(LAS u32x4*)(VS + r * 136 + l16 * 8) = rv[ps]; }
#pragma unroll
        for (int i = 0; i < 8; ++i) { cs[i] += __shfl_xor(cs[i], 16); cs[i] += __shfl_xor(cs[i], 32); }
        if (lane < 16) {
#pragma unroll
            for (int i = 0; i < 8; ++i) CS[wave * 128 + lane * 8 + i] = cs[i]; }
        __syncthreads();
        if (tid < 128) { float s = 0.f;
#pragma unroll
            for (int w = 0; w < 8; ++w) s += CS[w * 128 + tid];
            kmean[((size_t)(b * 8 + h) * 64 + blk) * 128 + tid] = s * (1.f / 256.f); }
#pragma unroll 2
        for (int i8 = 0; i8 < 8; ++i8) { const int pid = tid + i8 * 512, e = (pid & 63) + 64 * (pid >> 11), ks = (pid >> 6) & 31; unsigned short f[8];
#pragma unroll
            for (int i = 0; i < 8; ++i) f[i] = VS[(ks * 8 + i) * 136 + e];
            u32x4 w; w.x = f[0] | ((unsigned)f[1] << 16); w.y = f[2] | ((unsigned)f[3] << 16); w.z = f[4] | ((unsigned)f[5] << 16); w.w = f[6] | ((unsigned)f[7] << 16);
            *(u32x4*)(proj + (rbase + 2 * e + (ks >> 4)) * NPJ + OFF_MV + h * 128 + (ks & 15) * 8) = w; }
        __syncthreads();
    }
}

DI void phase_moba_select(const Params& P, LAS unsigned char* lds, int wg0, int nwg) {
    const int tid = opq_tid(), qi = tid >> 1, half = tid & 1;
    const bf16_t* proj = (const bf16_t*)(P.ws + WS_R1); const float* kmean = (const float*)(P.ws + WS_KMEAN);
    int* cnt = (int*)(P.ws + WS_CNT); int* list = (int*)(P.ws + WS_LIST); f32x2* ML = (f32x2*)(P.ws + WS_ML);
    LAS float* KM = (LAS float*)lds; LAS int* hist = (LAS int*)(lds + 32768); LAS int* hbase = (LAS int*)(lds + 32768 + 256);
    for (int task = wg0; task < 1024; task += nwg) {
        const int tk = task >> 8, tw_ = task & 255, bhx = (tw_ >> 6) * 4 + tk, blk = (tk & 1) ? 63 - (tw_ & 63) : (tw_ & 63), h = bhx & 7, b = bhx >> 3; const int bh = b * 8 + h; const int t = blk * 256 + qi; const size_t rid = (size_t)bh * TT + t;
        for (int i = tid; i < blk * 128; i += NTHREADS) KM[i] = kmean[(size_t)bh * 64 * 128 + i];
        if (tid < 64) hist[tid] = 0;
        float q[64];
        { const bf16_t* qp = proj + (size_t)(b * TT + t) * NPJ + OFF_MQ + h * 128 + half * 64;
#pragma unroll
          for (int i = 0; i < 8; ++i) { const u32x4 raw = *(const u32x4*)(qp + 8 * i); q[8 * i] = bflo(raw.x); q[8 * i + 1] = bfhi(raw.x); q[8 * i + 2] = bflo(raw.y); q[8 * i + 3] = bfhi(raw.y);
              q[8 * i + 4] = bflo(raw.z); q[8 * i + 5] = bfhi(raw.z); q[8 * i + 6] = bflo(raw.w); q[8 * i + 7] = bfhi(raw.w); } }
        __syncthreads();
        float v0 = -INFINITY, v1 = -INFINITY, v2 = -INFINITY; int i0 = -1, i1 = -1, i2 = -1;
        for (int n = 0; n < blk; ++n) { const LAS float* km = KM + n * 128 + half * 64; float d0 = 0.f, d1 = 0.f, d2 = 0.f, d3 = 0.f;
#pragma unroll
            for (int i = 0; i < 16; ++i) { const f32x4 kv = *(const LAS f32x4*)(km + 4 * i); d0 += q[4 * i] * kv[0]; d1 += q[4 * i + 1] * kv[1]; d2 += q[4 * i + 2] * kv[2]; d3 += q[4 * i + 3] * kv[3]; }
            float g = (d0 + d1) + (d2 + d3); g += __shfl_xor(g, 1);
            if (g > v0) { v2 = v1; i2 = i1; v1 = v0; i1 = i0; v0 = g; i0 = n; } else if (g > v1) { v2 = v1; i2 = i1; v1 = g; i1 = n; } else if (g > v2) { v2 = g; i2 = n; } }
        int rk0 = 0, rk1 = 0, rk2 = 0;
        if (half == 0) { if (i0 >= 0) rk0 = __hip_atomic_fetch_add(&hist[i0], 1, __ATOMIC_RELAXED, __HIP_MEMORY_SCOPE_WORKGROUP); if (i1 >= 0) rk1 = __hip_atomic_fetch_add(&hist[i1], 1, __ATOMIC_RELAXED, __HIP_MEMORY_SCOPE_WORKGROUP); if (i2 >= 0) rk2 = __hip_atomic_fetch_add(&hist[i2], 1, __ATOMIC_RELAXED, __HIP_MEMORY_SCOPE_WORKGROUP); }
        __syncthreads();
        if (tid < 64) { const int c = hist[tid]; hbase[tid] = c > 0 ? atomicAdd(&cnt[bh * 64 + tid], c) : 0; }
        __syncthreads();
        if (half == 0) {
            const f32x2 dead = {-INFINITY, 0.f};
            if (i0 >= 0) list[(size_t)bh * LISTN + i0 * 16384 - 128 * i0 * (i0 + 1) + hbase[i0] + rk0] = t; else ML[0 * 262144 + rid] = dead;
            if (i1 >= 0) list[(size_t)bh * LISTN + i1 * 16384 - 128 * i1 * (i1 + 1) + hbase[i1] + rk1] = t | (1 << 14); else ML[1 * 262144 + rid] = dead;
            if (i2 >= 0) list[(size_t)bh * LISTN + i2 * 16384 - 128 * i2 * (i2 + 1) + hbase[i2] + rk2] = t | (2 << 14); else ML[2 * 262144 + rid] = dead;
        }
        __syncthreads();
    }
}

constexpr int G2_W = 0, G2_Q = 18432, G2_QK = 36864, G2_KD = 47104, G2_BUF = 67584, G2_RED = 135168;
DI void phase_gdn_scan(const Params& P, LAS unsigned char* lds, int bh, const unsigned* flag, unsigned need, int n_first) {
    const int tid = opq_tid(), lane = tid & 63, w = tid >> 6, fr = lane & 15, fq = lane >> 4, b = bh >> 3, h = bh & 7;
    const bf16_t* proj = (const bf16_t*)(P.ws + WS_R1); const bf16_t* W2 = (const bf16_t*)(P.ws + WS_W2); const bf16_t* QKB = (const bf16_t*)(P.ws + WS_QKB);
    const float* GL = (const float*)(P.ws + WS_GL); bf16_t* mix = (bf16_t*)(P.ws + WS_R2);
    float* SSQ = (float*)(P.ws + WS_SSQ);
    const int e = 16 * w + fr; const float gnw = P.gdn_norm[e];
    f32x4 S[8];
#pragma unroll
    for (int i = 0; i < 8; ++i) S[i] = (f32x4){0.f, 0.f, 0.f, 0.f};
    const int wrow0 = tid >> 4, wseg = tid & 15;
    const int qrow = tid >> 3, qseg = tid & 7;
    struct Stage { u32x4 sw[2], sq[2], sqk, skd[2]; };
    u32x2 un[4];
    Stage stA, stB;
#define G2_LOAD(X, nn) do { const int t0_ = b * TT + (nn) * 64; const int ci_ = ((b * 256 + (nn)) << 3) + h; \
        _Pragma("unroll") for (int i_ = 0; i_ < 2; ++i_) { X.sw[i_] = *(const u32x4*)(W2 + (size_t)(t0_ + wrow0 + 32 * i_) * 1024 + h * 128 + wseg * 8); \
            X.sq[i_] = *(const u32x4*)(proj + (size_t)(t0_ + wrow0 + 32 * i_) * NPJ + OFF_GQ + h * 128 + wseg * 8); \
            const int d_ = qrow + 64 * i_; X.skd[i_] = *(const u32x4*)(proj + (size_t)(t0_ + (d_ >> 1)) * NPJ + OFF_GK + h * 128 + (d_ & 1) * 64 + qseg * 8); } \
        X.sqk = *(const u32x4*)(QKB + (size_t)ci_ * 4096 + qrow * 64 + qseg * 8); } while (0)
#define UN_LOAD(nn) do { const int t0_ = b * TT + (nn) * 64; _Pragma("unroll") for (int mt_ = 0; mt_ < 4; ++mt_) un[mt_] = *(const u32x2*)(proj + (size_t)(t0_ + (e >> 1)) * NPJ + OFF_GV + h * 128 + (e & 1) * 64 + 16 * mt_ + 4 * fq); } while (0)
#define G2_ST2(base_, rowoff_, sg_, v_) do { const int g_ = ((sg_) >> 2) * 64, d_ = ((sg_) & 3) * 8; \
        *(LAS u32x2*)(B_ + (base_) + (rowoff_) + g_ + perm4(d_) * 2) = (u32x2){(v_).x, (v_).y}; *(LAS u32x2*)(B_ + (base_) + (rowoff_) + g_ + perm4(d_ + 4) * 2) = (u32x2){(v_).z, (v_).w}; } while (0)
#define G2_STORE(X, bufi) do { LAS unsigned char* B_ = lds + (bufi) * G2_BUF; \
        _Pragma("unroll") for (int i_ = 0; i_ < 2; ++i_) { G2_ST2(G2_W, (wrow0 + 32 * i_) * 288, wseg, X.sw[i_]); G2_ST2(G2_Q, (wrow0 + 32 * i_) * 288, wseg, X.sq[i_]); \
            G2_ST2(G2_KD, (qrow + 64 * i_) * 160, qseg, X.skd[i_]); } \
        G2_ST2(G2_QK, qrow * 160, qseg, X.sqk); } while (0)
    G2_LOAD(stA, 0); G2_STORE(stA, 0); UN_LOAD(0);
    float egl_n = GL[bh * 256];
    u32x2 uc[4];
#pragma unroll
    for (int i = 0; i < 4; ++i) uc[i] = un[i];
    G2_LOAD(stA, 1);
    __syncthreads();
    for (int n2 = 0; n2 < 256; n2 += 2) {
#pragma unroll
      for (int hf2 = 0; hf2 < 2; ++hf2) {
        const int n = n2 + hf2; Stage& LDs = hf2 ? stA : stB; Stage& STs = hf2 ? stB : stA;
        if (n == n_first - 2 || n == 62 || n == 126) {
            const unsigned* fl = (n == 126) ? flag + 1 : (n == 62 ? flag : flag + 2);
            if (tid == 0) { while (__hip_atomic_load(fl, __ATOMIC_RELAXED, __HIP_MEMORY_SCOPE_AGENT) < need) __builtin_amdgcn_s_sleep(8);
                __builtin_amdgcn_fence(__ATOMIC_ACQUIRE, "agent"); asm volatile("s_waitcnt vmcnt(0)" ::: "memory"); }
            __syncthreads(); }
        const int cur = hf2, t0 = b * TT + n * 64; LAS unsigned char* Bf = lds + cur * G2_BUF;
        { const int n2c = n + 2 < 256 ? n + 2 : 255, n1c = n + 1 < 256 ? n + 1 : 255; G2_LOAD(LDs, n2c); UN_LOAD(n1c); }
        const float egl = egl_n; egl_n = GL[bh * 256 + (n + 1 < 256 ? n + 1 : 255)];
        f32x4 Pm[4], Om[4];
#pragma unroll
        for (int mt = 0; mt < 4; ++mt) { Pm[mt] = (f32x4){0.f, 0.f, 0.f, 0.f}; Om[mt] = (f32x4){0.f, 0.f, 0.f, 0.f}; }
#define SBAR __builtin_amdgcn_sched_barrier(0)
#define LD_K4(dst, base_, ks_) do { const int o0_ = fr * 288 + (32 * (ks_) + 8 * fq) * 2; \
        dst[0] = *(const LAS bf16x8*)(Bf + base_ + o0_); dst[1] = *(const LAS bf16x8*)(Bf + base_ + o0_ + 4608); \
        dst[2] = *(const LAS bf16x8*)(Bf + base_ + o0_ + 9216); dst[3] = *(const LAS bf16x8*)(Bf + base_ + o0_ + 13824); } while (0)
#define MM_K4(src, sb_, A_) do { A_[0] = mfma16(src[0], sb_, A_[0]); A_[1] = mfma16(src[1], sb_, A_[1]); A_[2] = mfma16(src[2], sb_, A_[2]); A_[3] = mfma16(src[3], sb_, A_[3]); } while (0)
#define LD_R4(dst, base_, r0_, k2_) do { const int o0_ = (16 * (r0_) + fr) * 160 + (32 * (k2_) + 8 * fq) * 2; \
        dst[0] = *(const LAS bf16x8*)(Bf + base_ + o0_); dst[1] = *(const LAS bf16x8*)(Bf + base_ + o0_ + 2560); \
        dst[2] = *(const LAS bf16x8*)(Bf + base_ + o0_ + 5120); dst[3] = *(const LAS bf16x8*)(Bf + base_ + o0_ + 7680); } while (0)
#define MM_R4(src, vb_, A0_, A1_, A2_, A3_) do { A0_ = mfma16(src[0], vb_, A0_); A1_ = mfma16(src[1], vb_, A1_); A2_ = mfma16(src[2], vb_, A2_); A3_ = mfma16(src[3], vb_, A3_); } while (0)
        bf16x8 fa[4], fb[4];
        LD_K4(fa, G2_W, 0);
        const bf16x8 sb0 = pack8(S[0], S[1]), sb1 = pack8(S[2], S[3]), sb2 = pack8(S[4], S[5]), sb3 = pack8(S[6], S[7]);
        LD_K4(fb, G2_W, 1); SBAR; MM_K4(fa, sb0, Pm); SBAR;
        LD_K4(fa, G2_W, 2); SBAR; MM_K4(fb, sb1, Pm); SBAR;
        LD_K4(fb, G2_W, 3); SBAR; MM_K4(fa, sb2, Pm); SBAR;
        LD_K4(fa, G2_Q, 0); SBAR; MM_K4(fb, sb3, Pm); SBAR;
        f32x4 vn[4];
#pragma unroll
        for (int mt = 0; mt < 4; ++mt) { vn[mt][0] = bflo(uc[mt].x) - Pm[mt][0]; vn[mt][1] = bfhi(uc[mt].x) - Pm[mt][1]; vn[mt][2] = bflo(uc[mt].y) - Pm[mt][2]; vn[mt][3] = bfhi(uc[mt].y) - Pm[mt][3]; }
        bf16x8 Vb[2];
#pragma unroll
        for (int k2 = 0; k2 < 2; ++k2) Vb[k2] = pack8(vn[2 * k2], vn[2 * k2 + 1]);
        LD_K4(fb, G2_Q, 1); SBAR; MM_K4(fa, sb0, Om); SBAR;
        LD_K4(fa, G2_Q, 2); SBAR; MM_K4(fb, sb1, Om); SBAR;
        LD_K4(fb, G2_Q, 3); SBAR; MM_K4(fa, sb2, Om); SBAR;
        LD_R4(fa, G2_QK, 0, 0); SBAR; MM_K4(fb, sb3, Om); SBAR;
#pragma unroll
        for (int dt = 0; dt < 8; ++dt) S[dt] = S[dt] * egl;
        SBAR;
        LD_R4(fb, G2_QK, 0, 1); SBAR; MM_R4(fa, Vb[0], Om[0], Om[1], Om[2], Om[3]); SBAR;
        LD_R4(fa, G2_KD, 0, 0); SBAR; MM_R4(fb, Vb[1], Om[0], Om[1], Om[2], Om[3]); SBAR;
        LD_R4(fb, G2_KD, 0, 1); SBAR; MM_R4(fa, Vb[0], S[0], S[1], S[2], S[3]); SBAR;
        LD_R4(fa, G2_KD, 4, 0); SBAR; MM_R4(fb, Vb[1], S[0], S[1], S[2], S[3]); SBAR;
        LD_R4(fb, G2_KD, 4, 1); SBAR; MM_R4(fa, Vb[0], S[4], S[5], S[6], S[7]); SBAR;
        MM_R4(fb, Vb[1], S[4], S[5], S[6], S[7]); SBAR;
#undef LD_K4
#undef MM_K4
#undef LD_R4
#undef MM_R4
#undef SBAR
        { G2_STORE(STs, cur ^ 1);
#pragma unroll
            for (int i = 0; i < 4; ++i) uc[i] = un[i]; }
        { LAS bf16_t* OTW = (LAS bf16_t*)(lds + G2_RED + w * 2048);
#pragma unroll
          for (int mt = 0; mt < 4; ++mt)
#pragma unroll
            for (int j = 0; j < 4; ++j) OTW[(16 * mt + 4 * fq + j) * 16 + fr] = f2bf(Om[mt][j]);
#pragma unroll
          for (int i = 0; i < 2; ++i) { const int row = (lane >> 1) + 32 * i, hv = lane & 1;
              bf16_t* mp_ = mix + (size_t)(t0 + row) * DM + h * 128 + 16 * w + 8 * hv; const u32x4 ov_ = *(const LAS u32x4*)(OTW + row * 16 + hv * 8);
              asm volatile("global_store_dwordx4 %0, %1, off" :: "v"(mp_), "v"(ov_) : "memory"); } }
        __syncthreads();
      }
    }
#undef G2_LOAD
#undef UN_LOAD
#undef G2_STORE
#undef G2_ST2
    asm volatile("s_waitcnt vmcnt(0)" ::: "memory");
    __syncthreads();
}

constexpr int AT_KS = 0, AT_VT = 73728, AT_PF = 143360, AT_MISC = 147712;
DI void phase_moba_attn(const Params& P, LAS unsigned char* lds) {
    const int tid = opq_tid(), lane = tid & 63, w = tid >> 6, fr = lane & 15, fq = lane >> 4;
    const bf16_t* proj = (const bf16_t*)(P.ws + WS_R1); const int* cnt = (const int*)(P.ws + WS_CNT); const int* list = (const int*)(P.ws + WS_LIST);
    f32x2* ML = (f32x2*)(P.ws + WS_ML); bf16_t* opart = (bf16_t*)P.out; unsigned* workctr = (unsigned*)(P.ws + WS_CTL);
    LAS bf16_t* KS = (LAS bf16_t*)(lds + AT_KS); LAS bf16_t* VT = (LAS bf16_t*)(lds + AT_VT); LAS int* PF = (LAS int*)(lds + AT_PF); LAS int* MISC = (LAS int*)(lds + AT_MISC);
    { const int c0 = cnt[2 * tid], c1 = cnt[2 * tid + 1]; const int a = (c0 + 511) >> 9, bsum = a + ((c1 + 511) >> 9); int inc = bsum;
#pragma unroll
      for (int o = 1; o < 64; o <<= 1) { const int v = __shfl_up(inc, o); if (lane >= o) inc += v; }
      if (lane == 63) MISC[8 + w] = inc;
      __syncthreads();
      int wb = 0;
#pragma unroll
      for (int i = 0; i < 8; ++i) wb += (i < w) ? MISC[8 + i] : 0;
      const int ex = wb + inc - bsum; PF[2 * tid] = ex; PF[2 * tid + 1] = ex + a; if (tid == 511) PF[1024] = ex + bsum;
      __syncthreads(); }
    const int totalG = PF[1024];
    const float sc2 = 0.08838834764831845f * 1.4426950408889634f;
    const int tid_at = tid;
    for (;;) {
        int tid = tid_at; asm volatile("" : "+v"(tid)); const int lane = tid & 63, w = __builtin_amdgcn_readfirstlane(tid >> 6), fr = lane & 15, fq = lane >> 4;
        if (tid == 0) MISC[0] = (int)atomicAdd(workctr, 1u);
        __syncthreads();
        const int wid = MISC[0];
        __syncthreads();
        if (wid >= totalG + 1024) break;
        int bh, j, causal, qstart, qcount;
        if (wid < totalG) { int lo = 0, hi = 1024; while (hi - lo > 1) { const int mid = (lo + hi) >> 1; if (PF[mid] <= wid) lo = mid; else hi = mid; }
            bh = lo >> 6; j = lo & 63; causal = 0; qstart = (wid - PF[lo]) * 512; const int c = cnt[lo]; qcount = c - qstart; if (qcount > 512) qcount = 512; }
        else { const int o = wid - totalG; bh = o >> 6; j = o & 63; causal = 1; qstart = 0; qcount = 256; }
        const int b = bh >> 3, h = bh & 7; const size_t kbase = (size_t)(b * TT + j * 256);
        { u32x4 kr[8], vr[8];
#pragma unroll
          for (int i8 = 0; i8 < 8; ++i8) { const int pid = tid + i8 * 512; kr[i8] = *(const u32x4*)(proj + (kbase + (pid >> 4)) * NPJ + OFF_MK + h * 128 + (pid & 15) * 8);
              const int e = pid >> 5, ks = pid & 31; vr[i8] = *(const u32x4*)(proj + (kbase + 2 * e + (ks >> 4)) * NPJ + OFF_MV + h * 128 + (ks & 15) * 8); }
#pragma unroll
          for (int i8 = 0; i8 < 8; ++i8) { const int pid = tid + i8 * 512; *(LAS u32x4*)(KS + (pid >> 4) * 144 + (pid & 15) * 8) = kr[i8];
              const int e = pid >> 5, ks = pid & 31; const int g_ = (ks >> 2) * 32, d_ = (ks & 3) * 8;
              *(LAS u32x2*)(VT + e * 272 + g_ + perm4(d_)) = (u32x2){vr[i8].x, vr[i8].y}; *(LAS u32x2*)(VT + e * 272 + g_ + perm4(d_ + 4)) = (u32x2){vr[i8].z, vr[i8].w}; } }
        const int lbase = bh * LISTN + j * 16384 - 128 * j * (j + 1) + qstart;
        const int ntile = (qcount + 127) >> 7;
        int en0, en1, en2, en3;
        { const int q0 = 16 * w + fr, lim = qcount - 1;
          if (causal) { en0 = (j * 256 + q0) | (3 << 14); en1 = (j * 256 + q0 + 128) | (3 << 14); en2 = en1; en3 = en1; }
          else { en0 = list[lbase + (q0 < lim ? q0 : lim)]; en1 = list[lbase + (q0 + 128 < lim ? q0 + 128 : lim)]; en2 = list[lbase + (q0 + 256 < lim ? q0 + 256 : lim)]; en3 = list[lbase + (q0 + 384 < lim ? q0 + 384 : lim)]; } }
        bf16x8 Bq[4], Bn[4];
        { const bf16_t* qp = proj + (size_t)(b * TT + (en0 & 16383)) * NPJ + OFF_MQ + h * 128 + 8 * fq;
#pragma unroll
          for (int ks = 0; ks < 4; ++ks) Bq[ks] = *(const bf16x8*)(qp + 32 * ks); }
        __syncthreads();
        for (int tile = 0; tile < ntile; ++tile) {
            const int en = tile == 0 ? en0 : (tile == 1 ? en1 : (tile == 2 ? en2 : en3));
            { const int enx = tile == 0 ? en1 : (tile == 1 ? en2 : en3); const bf16_t* qp = proj + (size_t)(b * TT + (enx & 16383)) * NPJ + OFF_MQ + h * 128 + 8 * fq;
#pragma unroll
              for (int ks = 0; ks < 4; ++ks) Bn[ks] = *(const bf16x8*)(qp + 32 * ks); }
            const int qi = tile * 128 + 16 * w + fr; const bool valid = qi < qcount; const int t = en & 16383, slot = en >> 14;
            if (tile * 128 + 16 * w < qcount) {
            const int nkt = causal ? (8 * tile + w + 1) : 16;
            f32x4 st[16]; float mx = -INFINITY;
#pragma unroll
            for (int kp = 0; kp < 8; ++kp) { f32x4 a0 = {0.f, 0.f, 0.f, 0.f}, a1 = {0.f, 0.f, 0.f, 0.f};
                if (2 * kp < nkt) { bf16x8 kf[8];
#pragma unroll
                    for (int ks = 0; ks < 4; ++ks) { kf[ks] = *(const LAS bf16x8*)(KS + (32 * kp + fr) * 144 + 32 * ks + 8 * fq); kf[4 + ks] = *(const LAS bf16x8*)(KS + (32 * kp + 16 + fr) * 144 + 32 * ks + 8 * fq); }
#pragma unroll
                    for (int ks = 0; ks < 4; ++ks) { a0 = mfma16(kf[ks], Bq[ks], a0); a1 = mfma16(kf[4 + ks], Bq[ks], a1); }
#pragma unroll
                    for (int jj = 0; jj < 4; ++jj) { float s0 = a0[jj] * sc2, s1 = a1[jj] * sc2;
                        if (causal && (32 * kp + 4 * fq + jj) > qi) s0 = -INFINITY; if ((causal && (32 * kp + 16 + 4 * fq + jj) > qi) || 2 * kp + 1 >= nkt) s1 = -INFINITY;
                        a0[jj] = s0; a1[jj] = s1; mx = fmaxf(mx, fmaxf(s0, s1)); }
                } else { a0 = (f32x4){-INFINITY, -INFINITY, -INFINITY, -INFINITY}; a1 = a0; }
                st[2 * kp] = a0; st[2 * kp + 1] = a1; }
            mx = fmaxf(mx, __shfl_xor(mx, 16)); mx = fmaxf(mx, __shfl_xor(mx, 32));
            float ls = 0.f;
#pragma unroll
            for (int kt = 0; kt < 16; ++kt)
#pragma unroll
                for (int jj = 0; jj < 4; ++jj) { const float pv = exp2f(st[kt][jj] - mx); st[kt][jj] = pv; ls += pv; }
            ls += __shfl_xor(ls, 16); ls += __shfl_xor(ls, 32);
            f32x4 ot[8];
#pragma unroll
            for (int et = 0; et < 8; ++et) ot[et] = (f32x4){0.f, 0.f, 0.f, 0.f};
#pragma unroll
            for (int k2 = 0; k2 < 8; ++k2) { if (2 * k2 < nkt) { const bf16x8 pb = pack8(st[2 * k2], st[2 * k2 + 1]);
#pragma unroll
                    for (int eh = 0; eh < 2; ++eh) { bf16x8 vf[4];
#pragma unroll
                        for (int et = 0; et < 4; ++et) vf[et] = *(const LAS bf16x8*)(VT + (16 * (4 * eh + et) + fr) * 272 + 32 * k2 + 8 * fq);
#pragma unroll
                        for (int et = 0; et < 4; ++et) ot[4 * eh + et] = mfma16(vf[et], pb, ot[4 * eh + et]); } } }
            if (valid) { const float il = 1.f / ls; const size_t rid = (size_t)bh * TT + t; bf16_t* op = opart + ((size_t)slot * 262144 + rid) * 128 + 4 * fq;
#pragma unroll
                for (int et = 0; et < 8; ++et) { u32x2 wv; wv.x = pk2(ot[et][0] * il, ot[et][1] * il); wv.y = pk2(ot[et][2] * il, ot[et][3] * il); *(u32x2*)(op + 16 * et) = wv; }
                if (fq == 0) ML[(size_t)slot * 262144 + rid] = (f32x2){mx, ls}; }
            }
#pragma unroll
            for (int ks = 0; ks < 4; ++ks) Bq[ks] = Bn[ks];
        }
        __syncthreads();
    }
}

DI void phase_moba_combine(const Params& P, bool do_gate, bool do_moba, int wg0, int nwg) {
    const bf16_t* opart = (const bf16_t*)P.out; const f32x2* ML = (const f32x2*)(P.ws + WS_ML); bf16_t* mix = (bf16_t*)(P.ws + WS_R2);
    const int gtid = wg0 * NTHREADS + opq_tid(), gsz = nwg * NTHREADS;
    if (do_gate) { const bf16_t* proj = (const bf16_t*)(P.ws + WS_R1);
      for (int i0 = gtid; i0 < MT * 128; i0 += 8 * gsz) { u32x4 mv[8], zv[8];
#pragma unroll
          for (int k = 0; k < 8; ++k) { const int i = i0 + k * gsz < MT * 128 ? i0 + k * gsz : i0; const int row = i >> 7, sg = i & 127; mv[k] = *(const u32x4*)(mix + (size_t)row * DM + sg * 8); zv[k] = *(const u32x4*)(proj + (size_t)row * NPJ + OFF_GZ + sg * 8); }
          const int sg0 = i0 & 127; const f32x4 g0 = *(const f32x4*)(P.gdn_norm + (sg0 & 15) * 8), g1 = *(const f32x4*)(P.gdn_norm + (sg0 & 15) * 8 + 4);
#pragma unroll
          for (int k = 0; k < 8; ++k) { const int i = i0 + k * gsz; const int row = i >> 7, sg = i & 127;
              float o[8]; o[0] = bflo(mv[k].x); o[1] = bfhi(mv[k].x); o[2] = bflo(mv[k].y); o[3] = bfhi(mv[k].y); o[4] = bflo(mv[k].z); o[5] = bfhi(mv[k].z); o[6] = bflo(mv[k].w); o[7] = bfhi(mv[k].w);
              float ssl = 0.f;
#pragma unroll
              for (int q = 0; q < 8; ++q) ssl += o[q] * o[q];
              const float rs = rsqrtf(row16_sum(ssl) * (1.f / 128.f) + 1e-6f); const u32x4 z = zv[k];
              u32x4 wv; wv.x = pk2(o[0] * rs * g0[0] * silu_f(bflo(z.x)), o[1] * rs * g0[1] * silu_f(bfhi(z.x))); wv.y = pk2(o[2] * rs * g0[2] * silu_f(bflo(z.y)), o[3] * rs * g0[3] * silu_f(bfhi(z.y)));
              wv.z = pk2(o[4] * rs * g1[0] * silu_f(bflo(z.z)), o[5] * rs * g1[1] * silu_f(bfhi(z.z))); wv.w = pk2(o[6] * rs * g1[2] * silu_f(bflo(z.w)), o[7] * rs * g1[3] * silu_f(bfhi(z.w)));
              if (i < MT * 128) *(u32x4*)(mix + (size_t)row * DM + sg * 8) = wv; } } }
    if (do_moba) for (int i0 = gtid; i0 < 262144 * 16; i0 += 2 * gsz) {
        f32x2 ml[2][4]; u32x4 raw[2][4];
#pragma unroll
        for (int k = 0; k < 2; ++k) { const int i = i0 + k * gsz < 262144 * 16 ? i0 + k * gsz : i0; const int rid = i >> 4, sg = i & 15;
#pragma unroll
            for (int s = 0; s < 4; ++s) { ml[k][s] = ML[(size_t)s * 262144 + rid]; raw[k][s] = *(const u32x4*)(opart + ((size_t)s * 262144 + rid) * 128 + sg * 8); } }
#pragma unroll
        for (int k = 0; k < 2; ++k) { const int i = i0 + k * gsz; const int rid = i >> 4, sg = i & 15; const int bh = rid >> 14, t = rid & 16383, b = bh >> 3, h = bh & 7;
            float M = -INFINITY;
#pragma unroll
            for (int s = 0; s < 4; ++s) M = fmaxf(M, ml[k][s].x);
            float wgt[4], Lt = 0.f;
#pragma unroll
            for (int s = 0; s < 4; ++s) { wgt[s] = ml[k][s].y > 0.f ? ml[k][s].y * exp2f(ml[k][s].x - M) : 0.f; Lt += wgt[s]; }
            const float iL = 1.f / Lt; float o[8];
#pragma unroll
            for (int q = 0; q < 8; ++q) o[q] = 0.f;
#pragma unroll
            for (int s = 0; s < 4; ++s) { const float ww = wgt[s] * iL; const u32x4 r = raw[k][s];
                if (wgt[s] > 0.f) { o[0] += ww * bflo(r.x); o[1] += ww * bfhi(r.x); o[2] += ww * bflo(r.y); o[3] += ww * bfhi(r.y); o[4] += ww * bflo(r.z); o[5] += ww * bfhi(r.z); o[6] += ww * bflo(r.w); o[7] += ww * bfhi(r.w); } }
            u32x4 wv; wv.x = pk2(o[0], o[1]); wv.y = pk2(o[2], o[3]); wv.z = pk2(o[4], o[5]); wv.w = pk2(o[6], o[7]);
            if (i < 262144 * 16) *(u32x4*)(mix + (size_t)(b * TT + t) * DM + 1024 + h * 128 + sg * 8) = wv; } }
}

DI void sub_barrier(unsigned* ctr, unsigned nwg) {
    asm volatile("s_waitcnt vmcnt(0)" ::: "memory");
    __syncthreads();
    if (threadIdx.x == 0) {
        __builtin_amdgcn_fence(__ATOMIC_RELEASE, "agent");
        __hip_atomic_fetch_add(ctr, 1u, __ATOMIC_RELAXED, __HIP_MEMORY_SCOPE_AGENT);
        while (__hip_atomic_load(ctr, __ATOMIC_RELAXED, __HIP_MEMORY_SCOPE_AGENT) < nwg) __builtin_amdgcn_s_sleep(8);
        __builtin_amdgcn_fence(__ATOMIC_ACQUIRE, "agent");
        asm volatile("s_waitcnt vmcnt(0)" ::: "memory");
    }
    __syncthreads();
}

__global__ void __launch_bounds__(NTHREADS) hybrid_fwd(Params P) {
    extern __shared__ __attribute__((aligned(16))) unsigned char smem[];
    LAS unsigned char* lds = (LAS unsigned char*)smem;
    cg::grid_group grid = cg::this_grid();
    unsigned char* ws = P.ws; const int G = gridDim.x, bx = blockIdx.x;
    bf16_t* R0 = (bf16_t*)(ws + WS_R0); bf16_t* R1 = (bf16_t*)(ws + WS_R1); bf16_t* R2 = (bf16_t*)(ws + WS_R2);
    float* ss1 = (float*)(ws + WS_SS1); float* ss2 = (float*)(ws + WS_SS2);

    phase_prep(P, lds);
    grid.sync();
    { pg8::Gemm g{R0, (const bf16_t*)(ws + WS_WIN), MT, NPJ, DM}; pg8::StaticOrder S; S.init(MT, NPJ, G, bx); EpiProj E{R1, (bf16_t*)(ws + WS_HALO)}; pg8::gemm_phase<decltype(E), pg8::StaticOrder, true, true>(lds, g, S, E); }
    phase_ba(P);
    grid.sync();
    phase_gdn_prep(P, lds, 0, 32, bx, G, (unsigned*)(ws + WS_CTL) + 14, 0x7fffffff);
    if (bx < 16) {
        if (threadIdx.x == 0) { const unsigned* f14 = (const unsigned*)(ws + WS_CTL) + 14; while (__hip_atomic_load(f14, __ATOMIC_RELAXED, __HIP_MEMORY_SCOPE_AGENT) < (unsigned)G) __builtin_amdgcn_s_sleep(8);
            __builtin_amdgcn_fence(__ATOMIC_ACQUIRE, "agent"); asm volatile("s_waitcnt vmcnt(0)" ::: "memory"); }
        __syncthreads(); }
    if (bx < 16) phase_gdn_scan(P, lds, bx, (const unsigned*)(ws + WS_CTL) + 11, (unsigned)(G - 16), 32);
    else { unsigned* ctl = (unsigned*)(ws + WS_CTL);
        phase_gdn_prep(P, lds, 32, 224, bx - 16, G - 16, ctl + 11, 768, ctl + 13, 256);
        asm volatile("s_waitcnt vmcnt(0)" ::: "memory"); __syncthreads();
        if (threadIdx.x == 0) { __builtin_amdgcn_fence(__ATOMIC_RELEASE, "agent"); __hip_atomic_fetch_add(ctl + 12, 1u, __ATOMIC_RELAXED, __HIP_MEMORY_SCOPE_AGENT); }
        phase_moba_prep(P, lds, bx - 16, G - 16); sub_barrier(ctl + 8, (unsigned)(G - 16));
        phase_moba_select(P, lds, bx - 16, G - 16); sub_barrier(ctl + 9, (unsigned)(G - 16));
        phase_moba_attn(P, lds);
        phase_wconv_late(P, lds, bx - 16, G - 16);
        sub_barrier(ctl + 10, (unsigned)(G - 16)); phase_moba_combine(P, false, true, bx - 16, G - 16); }
    if (bx < 16) { asm volatile("s_waitcnt vmcnt(0)" ::: "memory"); __syncthreads();
        if (threadIdx.x == 0) { __builtin_amdgcn_fence(__ATOMIC_RELEASE, "agent"); __hip_atomic_fetch_add((unsigned*)(ws + WS_CTL) + 15, 1u, __ATOMIC_RELAXED, __HIP_MEMORY_SCOPE_AGENT); } }
    { if (threadIdx.x == 0) { const unsigned* f15 = (const unsigned*)(ws + WS_CTL) + 15;
          while (__hip_atomic_load(f15, __ATOMIC_RELAXED, __HIP_MEMORY_SCOPE_AGENT) < 16u) __builtin_amdgcn_s_sleep(8);
          __builtin_amdgcn_fence(__ATOMIC_ACQUIRE, "agent"); asm volatile("s_waitcnt vmcnt(0)" ::: "memory"); }
      __syncthreads(); }
    phase_moba_combine(P, true, false, bx, G);
    grid.sync();
    { pg8::Gemm g{R2, (const bf16_t*)(ws + WS_WO), MT, DM, DM}; pg8::StaticOrder S; S.init(MT, DM, G, bx); EpiResid E{P.x, P.out, R0, ss1}; pg8::gemm_phase<decltype(E), pg8::StaticOrder, true, false>(lds, g, S, E); }
    grid.sync();
    { pg8::Gemm g{R0, (const bf16_t*)(ws + WS_WGU), MT, 2 * FF, DM}; pg8::StaticOrder S; S.init(MT, 2 * FF, G, bx); EpiAct E{R1, ss1}; pg8::gemm_phase<decltype(E), pg8::StaticOrder, true, true>(lds, g, S, E); }
    grid.sync();
    { pg8::Gemm g{(const bf16_t*)(ws + WS_PB), (const bf16_t*)(ws + WS_WPP), MT, DM, 256}; pg8::StaticOrder S; S.init(MT, DM, G, bx); EpiPlainBf16 E{R0, DM}; pg8::gemm_phase<decltype(E), pg8::StaticOrder, true, false>(lds, g, S, E); }
    { pg8::Gemm g{R1, (const bf16_t*)(ws + WS_WDN), MT, DM, FF}; pg8::StaticOrder S; S.init(MT, DM, G, bx); EpiResid E{P.out, P.out, R2, ss2}; pg8::gemm_phase<decltype(E), pg8::StaticOrder, true, false>(lds, g, S, E); }
    grid.sync();
    { pg8::Gemm g{R2, (const bf16_t*)(ws + WS_WPG), MT, DM, DM}; pg8::StaticOrder S; S.init(MT, DM, G, bx); EpiOut E{P.out, R0, ss2}; pg8::gemm_phase<decltype(E), pg8::StaticOrder, true, false>(lds, g, S, E); }
}

extern "C" void kernel_launch(void* const* d_in, const int* in_sizes, int n_in, void* d_out, int out_size, void* d_ws, size_t ws_size, hipStream_t stream) {
    static int grid_blocks = 0;
    if (!grid_blocks) {
        int dev = 0, cus = 0, per_cu = 0;
        hipGetDevice(&dev);
        hipDeviceGetAttribute(&cus, hipDeviceAttributeMultiprocessorCount, dev);
        hipFuncSetAttribute((const void*)hybrid_fwd, hipFuncAttributeMaxDynamicSharedMemorySize, LDS_BYTES);
        hipOccupancyMaxActiveBlocksPerMultiprocessor(&per_cu, (const void*)hybrid_fwd, NTHREADS, LDS_BYTES);
        if (per_cu < 1) per_cu = 1;
        grid_blocks = cus * per_cu;
        if (ws_size < WS_END) fprintf(stderr, "kernel_launch: workspace too small: %zu < %zu\n", ws_size, (size_t)WS_END);
    }
    Params p{};
    p.x = (const float*)d_in[0]; p.p = (const float*)d_in[1]; p.attn_norm = (const float*)d_in[2]; p.w_in = (const float*)d_in[3]; p.conv_w = (const float*)d_in[4];
    p.A_log = (const float*)d_in[5]; p.dt_bias = (const float*)d_in[6]; p.gdn_norm = (const float*)d_in[7]; p.q_norm = (const float*)d_in[8]; p.k_norm = (const float*)d_in[9];
    p.w_o = (const float*)d_in[10]; p.ffn_norm = (const float*)d_in[11]; p.w_gate = (const float*)d_in[12]; p.w_up = (const float*)d_in[13]; p.w_down = (const float*)d_in[14];
    p.ple_norm = (const float*)d_in[15]; p.w_pg = (const float*)d_in[16]; p.w_pp = (const float*)d_in[17];
    p.out = (float*)d_out; p.ws = (unsigned char*)d_ws;
    void* args[] = {&p};
    hipError_t e = hipLaunchCooperativeKernel((const void*)hybrid_fwd, dim3(grid_blocks), dim3(NTHREADS), args, LDS_BYTES, stream);
    if (e != hipSuccess) fprintf(stderr, "cooperative launch failed: %s (grid %d)\n", hipGetErrorString(e), grid_blocks);
}
```

```cpp
#include <hip/hip_runtime.h>
#include <hip/hip_cooperative_groups.h>
#include <cstdio>
namespace cg = cooperative_groups;

#define LAS __attribute__((address_space(3)))
#define DI __device__ __forceinline__
typedef unsigned short bf16_t;
typedef short bf16x8 __attribute__((ext_vector_type(8)));
typedef float f32x4 __attribute__((ext_vector_type(4)));
typedef float f32x2 __attribute__((ext_vector_type(2)));
typedef unsigned u32x4 __attribute__((ext_vector_type(4)));
typedef unsigned u32x2 __attribute__((ext_vector_type(2)));
typedef __bf16 bfv2 __attribute__((ext_vector_type(2)));

constexpr int DM = 2048, TT = 16384, MT = 32768, NPJ = 7168, FF = 5632, INW = 7184;
constexpr int OFF_GQ = 0, OFF_GK = 1024, OFF_GV = 2048, OFF_GZ = 3072, OFF_MQ = 4096, OFF_MK = 5120, OFF_MV = 6144;
constexpr int LISTN = 516096;
constexpr int NTHREADS = 512;
constexpr int LDS_BYTES = 163840;

constexpr size_t WS_CTL   = 0;
constexpr size_t WS_CNT   = 4096;
constexpr size_t WS_SS1   = 8192;
constexpr size_t WS_SS2   = WS_SS1 + 131072;
constexpr size_t WS_GL    = WS_SS2 + 131072;
constexpr size_t WS_KMEAN = WS_GL + 16384;
constexpr size_t WS_WBA   = WS_KMEAN + 524288;
constexpr size_t WS_BA    = WS_WBA + 65536;
constexpr size_t WS_WIN   = WS_BA + 2097152;
constexpr size_t WS_WO    = WS_WIN + (size_t)7168 * 2048 * 2;
constexpr size_t WS_WGU   = WS_WO + (size_t)2048 * 2048 * 2;
constexpr size_t WS_WDN   = WS_WGU + (size_t)11264 * 2048 * 2;
constexpr size_t WS_WPG   = WS_WDN + (size_t)2048 * 5632 * 2;
constexpr size_t WS_WPP   = WS_WPG + (size_t)2048 * 2048 * 2;
constexpr size_t WS_PB    = WS_WPP + (size_t)2048 * 256 * 2;
constexpr size_t WS_R0    = WS_PB + (size_t)32768 * 256 * 2;
constexpr size_t WS_R1    = WS_R0 + (size_t)32768 * 2048 * 2;
constexpr size_t WS_R2    = WS_R1 + (size_t)32768 * 7168 * 2;
constexpr size_t WS_W2    = WS_R2 + (size_t)32768 * 2048 * 2;
constexpr size_t WS_QKB   = WS_W2 + (size_t)32768 * 1024 * 2;
constexpr size_t WS_HALO  = WS_QKB + (size_t)4096 * 4096 * 2;
constexpr size_t WS_LIST  = WS_HALO + (size_t)513 * 3 * 3072 * 2 + 256 - ((size_t)513 * 3 * 3072 * 2) % 256;
constexpr size_t WS_ML    = WS_LIST + (size_t)16 * LISTN * 4;
constexpr size_t WS_SSQ   = WS_ML + (size_t)4 * 262144 * 8;
constexpr size_t WS_END   = WS_SSQ + (size_t)32768 * 64 * 4;

struct Params {
    const float* x; const float* p; const float* attn_norm; const float* w_in; const float* conv_w; const float* A_log; const float* dt_bias;
    const float* gdn_norm; const float* q_norm; const float* k_norm; const float* w_o; const float* ffn_norm; const float* w_gate; const float* w_up;
    const float* w_down; const float* ple_norm; const float* w_pg; const float* w_pp;
    float* out; unsigned char* ws;
};

DI unsigned pk2(float a, float b) { f32x2 v = {a, b}; bfv2 r = __builtin_convertvector(v, bfv2); return __builtin_bit_cast(unsigned, r); }
DI bf16_t f2bf(float a) { return (bf16_t)(pk2(a, 0.f) & 0xffffu); }
DI float bflo(unsigned w) { return __uint_as_float(w << 16); }
DI float bfhi(unsigned w) { return __uint_as_float(w & 0xffff0000u); }
DI float bf2f(bf16_t v) { return __uint_as_float(((unsigned)v) << 16); }
DI bf16x8 pack8(const f32x4& a, const f32x4& b) { u32x4 w; w.x = pk2(a[0], a[1]); w.y = pk2(a[2], a[3]); w.z = pk2(b[0], b[1]); w.w = pk2(b[2], b[3]); return __builtin_bit_cast(bf16x8, w); }
DI bf16x8 cat8(u32x2 lo, u32x2 hi) { u32x4 w; w.x = lo.x; w.y = lo.y; w.z = hi.x; w.w = hi.y; return __builtin_bit_cast(bf16x8, w); }
DI f32x4 mfma16(bf16x8 a, bf16x8 b, f32x4 c) { return __builtin_amdgcn_mfma_f32_16x16x32_bf16(a, b, c, 0, 0, 0); }
DI int perm4(int d4) { return d4 < 16 ? 2 * d4 : 2 * (d4 - 16) + 4; }
DI float dpp_f(float v, int ctrl_sel) { int x = __float_as_int(v); int r;
    if (ctrl_sel == 0) r = __builtin_amdgcn_mov_dpp(x, 0xB1, 0xf, 0xf, true); else if (ctrl_sel == 1) r = __builtin_amdgcn_mov_dpp(x, 0x4E, 0xf, 0xf, true);
    else if (ctrl_sel == 2) r = __builtin_amdgcn_mov_dpp(x, 0x141, 0xf, 0xf, true); else r = __builtin_amdgcn_mov_dpp(x, 0x140, 0xf, 0xf, true);
    return __int_as_float(r); }
DI float row16_sum(float v) { v += dpp_f(v, 0); v += dpp_f(v, 1); v += dpp_f(v, 2); v += dpp_f(v, 3); return v; }
DI float silu_f(float v) { return v * __builtin_amdgcn_rcpf(1.f + __expf(-v)); }
DI float sigm_f(float v) { return __builtin_amdgcn_rcpf(1.f + __expf(-v)); }

DI int opq_tid() { int t = threadIdx.x; asm volatile("" : "+v"(t)); return t; }

namespace pg8 {
constexpr int BM = 256, BK = 64, HALF = 128, HTB = HALF * BK * 2, STAGE_BYTES = 8 * HTB, NXCD = 8, WGM = 8;
DI int lds_byte(int r, int c) { const int st = (r >> 4) * 2 + (c >> 5), rr = r & 15, cc = c & 31, ob = rr * 64 + cc * 2; return st * 1024 + (ob ^ (((ob >> 9) & 1) << 5)); }
DI void stage_rc(int b, int& R, int& C) { const int st = b / 1024, sb = b % 1024, swz = sb ^ (((sb >> 9) & 1) << 5); R = (st >> 1) * 16 + swz / 64; C = (st & 1) * 32 + (swz % 64) / 2; }
DI int perm32(int rho) { const int n = rho >> 4, i = rho & 15; return 8 * (i >> 2) + 4 * n + (i & 3); }
struct Unit { int pm, pn; };
struct Gemm { const bf16_t* A; const bf16_t* Bt; int M, N, K; };
struct StaticOrder {
    int nM, nN, nwg, G, c;
    DI void init(int M, int N, int G_, int c_) { nM = M / BM; nN = N / BM; nwg = nM * nN; G = G_; c = c_; }
    DI bool next(int i, Unit& u) const {
        const long L = (long)i * G + c; if (L >= nwg) return false;
        int wgid = (int)L; { const int q = nwg / NXCD, r = nwg % NXCD, xcd = wgid % NXCD, off = wgid / NXCD; wgid = (xcd < r ? xcd * (q + 1) : r * (q + 1) + (xcd - r) * q) + off; }
        const int nig = WGM * nN, gid = wgid / nig, fm = gid * WGM, gsz = (nM - fm) < WGM ? (nM - fm) : WGM;
        u.pm = fm + ((wgid % nig) % gsz); u.pn = (wgid % nig) / gsz; return true;
    }
    DI void a_ready(const Unit&) const {}
    DI void done(const Unit&) const {}
};

template <class Epi, class Sched, bool ALIGN_EPI = false, bool SP2 = false>
DI void gemm_phase(LAS unsigned char* lds, const Gemm g, const Sched& S, const Epi& E) {
    const int tid = opq_tid(), wid = __builtin_amdgcn_readfirstlane(tid >> 6), lane = tid & 63, wr = wid >> 2, wc = wid & 3, fr = lane & 15, fq = lane >> 4;
    const int K = g.K, nt = K / BK;
    unsigned voffA[2], voffB[2];
#pragma unroll
    for (int i = 0; i < 2; ++i) { int R, C; stage_rc(tid * 16 + i * 8192, R, C); const int Rb = Epi::PERM ? ((R & ~31) + perm32(R & 31)) : R;
        voffA[i] = (unsigned)(R * K + C) * 2u; voffB[i] = (unsigned)(Rb * K + C) * 2u; }
    const size_t kstep = (size_t)(BK * 2);
    const size_t hstep = (size_t)HALF * K * 2;
    const size_t tstep = 2 * hstep;
    const unsigned ldsw = (unsigned)wid * 1024u;
    const int aoff = lds_byte(wr * 64 + fr, fq * 8), boff = lds_byte(wc * 32 + fr, fq * 8);
#define PG8_SA(b, h) (((b) * 2 + (h)) * HTB)
#define PG8_SB(b, h) ((4 + (b) * 2 + (h)) * HTB)
#define PG8_STAGE(bufoff, gbase, voff) do { _Pragma("unroll") for (int _i = 0; _i < 2; ++_i) \
        __builtin_amdgcn_global_load_lds((const unsigned*)((const char*)(gbase) + (voff)[_i]), (LAS unsigned*)(lds + (bufoff) + ldsw + _i * 8192), 16, 0, 0); } while (0)
#define PG8_LDA(dst, b, h) do { _Pragma("unroll") for (int m = 0; m < 4; ++m) _Pragma("unroll") for (int k = 0; k < 2; ++k) dst[m][k] = *(const LAS bf16x8*)(lds + PG8_SA(b, h) + aoff + m * 2048 + k * 1024); } while (0)
#define PG8_LDB(dst, b, h) do { _Pragma("unroll") for (int n = 0; n < 2; ++n) _Pragma("unroll") for (int k = 0; k < 2; ++k) dst[n][k] = *(const LAS bf16x8*)(lds + PG8_SB(b, h) + boff + n * 2048 + k * 1024); } while (0)
#define PG8_MMA(ai, bj, At, Bt) do { __builtin_amdgcn_s_setprio(1); _Pragma("unroll") for (int m = 0; m < 4; ++m) _Pragma("unroll") for (int n = 0; n < 2; ++n) _Pragma("unroll") for (int k = 0; k < 2; ++k) \
        acc[ai][bj][m][n] = __builtin_amdgcn_mfma_f32_16x16x32_bf16(Bt[n][k], At[m][k], acc[ai][bj][m][n], 0, 0, 0); __builtin_amdgcn_s_setprio(0); } while (0)
#define PG8_WAIT_V(n) asm volatile("s_waitcnt vmcnt(" #n ")" ::: "memory")
#define PG8_WAIT_L(n) asm volatile("s_waitcnt lgkmcnt(" #n ")" ::: "memory")
#define PG8_BAR __builtin_amdgcn_s_barrier()
#define PG8_SCHED __builtin_amdgcn_sched_barrier(0)
    Unit cur, nxt; int ui = 0;
    if (!S.next(0, cur)) return;
    f32x4 acc[2][2][4][2];
#pragma unroll
    for (int a = 0; a < 2; ++a)
#pragma unroll
        for (int b = 0; b < 2; ++b)
#pragma unroll
            for (int m = 0; m < 4; ++m)
#pragma unroll
                for (int n = 0; n < 2; ++n) acc[a][b][m][n] = (f32x4){0.f, 0.f, 0.f, 0.f};
    bf16x8 At[4][2], B0[2][2], B1[2][2];
    const char* cA = (const char*)g.A + (size_t)cur.pm * tstep; const char* cB = (const char*)g.Bt + (size_t)cur.pn * tstep;
    S.a_ready(cur);
    if constexpr (SP2) {
        PG8_STAGE(PG8_SB(0, 0), cB, voffB); PG8_STAGE(PG8_SB(0, 1), cB + hstep, voffB); PG8_STAGE(PG8_SA(0, 0), cA, voffA); PG8_STAGE(PG8_SA(0, 1), cA + hstep, voffA);
        if (wr == 1) PG8_BAR;
        PG8_WAIT_V(2); PG8_BAR;
        PG8_STAGE(PG8_SB(1, 0), cB + kstep, voffB); PG8_STAGE(PG8_SA(1, 0), cA + kstep, voffA); PG8_STAGE(PG8_SB(1, 1), cB + hstep + kstep, voffB);
        PG8_WAIT_V(6); PG8_BAR;
    } else {
        PG8_STAGE(PG8_SB(0, 0), cB, voffB); PG8_STAGE(PG8_SA(0, 0), cA, voffA); PG8_STAGE(PG8_SB(0, 1), cB + hstep, voffB); PG8_STAGE(PG8_SA(0, 1), cA + hstep, voffA);
        if (wr == 1) PG8_BAR;
        PG8_WAIT_V(4); PG8_BAR;
        PG8_STAGE(PG8_SB(1, 0), cB + kstep, voffB); PG8_STAGE(PG8_SA(1, 0), cA + kstep, voffA); PG8_STAGE(PG8_SB(1, 1), cB + hstep + kstep, voffB);
        PG8_WAIT_V(6); PG8_BAR;
    }
    for (;;) {
        const bool has_next = S.next(ui + 1, nxt);
        const char* nA = has_next ? (const char*)g.A + (size_t)nxt.pm * tstep : cA; const char* nB = has_next ? (const char*)g.Bt + (size_t)nxt.pn * tstep : cB;
        for (int t = 0; t < nt; t += 2) {
            const bool last = (t == nt - 2);
            const char* a1 = cA + (size_t)(t + 1) * kstep;
            const char* a2 = last ? nA : cA + (size_t)(t + 2) * kstep; const char* b2 = last ? nB : cB + (size_t)(t + 2) * kstep;
            const char* a3 = a2 + kstep; const char* b3 = b2 + kstep;
            if (last && has_next) S.a_ready(nxt);
            if constexpr (SP2) {
            PG8_LDB(B0, 0, 0); PG8_LDB(B1, 0, 1); PG8_SCHED; PG8_LDA(At, 0, 0); PG8_STAGE(PG8_SA(1, 1), a1 + hstep, voffA);
            PG8_WAIT_V(8); PG8_WAIT_L(0); PG8_BAR; PG8_MMA(0, 0, At, B0); PG8_MMA(0, 1, At, B1); PG8_BAR; PG8_SCHED;
            PG8_LDA(At, 0, 1); PG8_STAGE(PG8_SB(0, 0), b2, voffB); PG8_STAGE(PG8_SB(0, 1), b2 + hstep, voffB); PG8_STAGE(PG8_SA(0, 0), a2, voffA);
            PG8_WAIT_V(8); PG8_WAIT_L(0); PG8_BAR; PG8_MMA(1, 0, At, B0); PG8_MMA(1, 1, At, B1); PG8_BAR; PG8_SCHED;
            PG8_LDB(B0, 1, 0); PG8_LDB(B1, 1, 1); PG8_SCHED; PG8_LDA(At, 1, 0); PG8_STAGE(PG8_SA(0, 1), a2 + hstep, voffA);
            PG8_WAIT_V(8); PG8_WAIT_L(0); PG8_BAR; PG8_MMA(0, 0, At, B0); PG8_MMA(0, 1, At, B1); PG8_BAR; PG8_SCHED;
            PG8_LDA(At, 1, 1); PG8_STAGE(PG8_SB(1, 0), b3, voffB); PG8_STAGE(PG8_SB(1, 1), b3 + hstep, voffB); PG8_STAGE(PG8_SA(1, 0), a3, voffA);
            PG8_WAIT_V(8); PG8_WAIT_L(0); PG8_BAR; PG8_MMA(1, 0, At, B0); PG8_MMA(1, 1, At, B1); PG8_BAR; PG8_SCHED;
            } else {
            PG8_LDB(B0, 0, 0); PG8_SCHED; PG8_LDA(At, 0, 0); PG8_STAGE(PG8_SA(1, 1), a1 + hstep, voffA);
            PG8_WAIT_L(8); PG8_BAR; PG8_WAIT_L(0); PG8_MMA(0, 0, At, B0); PG8_BAR; PG8_SCHED;
            PG8_LDB(B1, 0, 1); PG8_STAGE(PG8_SB(0, 0), b2, voffB);
            PG8_BAR; PG8_WAIT_L(0); PG8_MMA(0, 1, At, B1); PG8_BAR;
            PG8_LDA(At, 0, 1); PG8_STAGE(PG8_SA(0, 0), a2, voffA);
            PG8_BAR; PG8_WAIT_L(0); PG8_MMA(1, 0, At, B0); PG8_BAR; PG8_SCHED;
            PG8_STAGE(PG8_SB(0, 1), b2 + hstep, voffB);
            PG8_WAIT_V(6); PG8_BAR; PG8_MMA(1, 1, At, B1); PG8_BAR;
            PG8_LDB(B0, 1, 0); PG8_SCHED; PG8_LDA(At, 1, 0); PG8_STAGE(PG8_SA(0, 1), a2 + hstep, voffA);
            PG8_WAIT_L(8); PG8_BAR; PG8_WAIT_L(0); PG8_MMA(0, 0, At, B0); PG8_BAR; PG8_SCHED;
            PG8_LDB(B1, 1, 1); PG8_STAGE(PG8_SB(1, 0), b3, voffB);
            PG8_BAR; PG8_WAIT_L(0); PG8_MMA(0, 1, At, B1); PG8_BAR;
            PG8_LDA(At, 1, 1); PG8_STAGE(PG8_SA(1, 0), a3, voffA);
            PG8_BAR; PG8_WAIT_L(0); PG8_MMA(1, 0, At, B0); PG8_BAR; PG8_SCHED;
            PG8_STAGE(PG8_SB(1, 1), b3 + hstep, voffB);
            PG8_WAIT_V(6); PG8_BAR; PG8_MMA(1, 1, At, B1); PG8_BAR;
            }
        }
        if constexpr (ALIGN_EPI) { if (wr == 0) PG8_BAR; }
        if constexpr (!Epi::AFTER_DRAIN) { E(acc, cur, wr, wc, fr, fq); S.done(cur); }
        if (!has_next) break;
#pragma unroll
        for (int a = 0; a < 2; ++a)
#pragma unroll
            for (int b = 0; b < 2; ++b)
#pragma unroll
                for (int m = 0; m < 4; ++m)
#pragma unroll
                    for (int n = 0; n < 2; ++n) acc[a][b][m][n] = (f32x4){0.f, 0.f, 0.f, 0.f};
        cur = nxt; cA = nA; cB = nB; ++ui;
        if constexpr (ALIGN_EPI) { if (wr == 1) PG8_BAR; }
    }
    PG8_WAIT_V(0);
    if constexpr (!ALIGN_EPI) { if (wr == 0) PG8_BAR; }
    PG8_BAR;
    if constexpr (Epi::AFTER_DRAIN) { E.fused(acc, cur, wr, wc, fr, fq, lds, wid, lane); S.done(cur); }
#undef PG8_SA
#undef PG8_SB
#undef PG8_STAGE
#undef PG8_LDA
#undef PG8_LDB
#undef PG8_MMA
#undef PG8_WAIT_V
#undef PG8_WAIT_L
#undef PG8_BAR
#undef PG8_SCHED
}
}
using pg8::Unit;

struct EpiProj {
    static constexpr bool PERM = true, AFTER_DRAIN = false;
    bf16_t* O; bf16_t* halo;
    DI void operator()(const f32x4 (&acc)[2][2][4][2], const Unit& u, int wr, int wc, int fr, int fq) const {
        const int row0 = u.pm * 256 + wr * 64 + fr, col0 = u.pn * 256 + wc * 32 + 8 * fq;
#pragma unroll
        for (int ai = 0; ai < 2; ++ai)
#pragma unroll
            for (int m = 0; m < 4; ++m) { const int row = row0 + ai * 128 + m * 16; bf16_t* rowp = O + (size_t)row * NPJ + col0;
#pragma unroll
                for (int bj = 0; bj < 2; ++bj) { const f32x4 v0 = acc[ai][bj][m][0], v1 = acc[ai][bj][m][1];
                    u32x4 w; w.x = pk2(v0[0], v0[1]); w.y = pk2(v0[2], v0[3]); w.z = pk2(v1[0], v1[1]); w.w = pk2(v1[2], v1[3]);
                    *(u32x4*)(rowp + bj * 128) = w;
                    if (m == 3 && fr >= 13 && u.pn < 12) *(u32x4*)(halo + ((size_t)((row >> 6) + 1) * 3 + (fr - 13)) * 3072 + col0 + bj * 128) = w; } }
    }
};
struct EpiPlainBf16 {
    static constexpr bool PERM = true, AFTER_DRAIN = false;
    bf16_t* O; int ldc;
    DI void operator()(const f32x4 (&acc)[2][2][4][2], const Unit& u, int wr, int wc, int fr, int fq) const {
        const int row0 = u.pm * 256 + wr * 64 + fr, col0 = u.pn * 256 + wc * 32 + 8 * fq;
#pragma unroll
        for (int ai = 0; ai < 2; ++ai)
#pragma unroll
            for (int m = 0; m < 4; ++m) { bf16_t* rowp = O + (size_t)(row0 + ai * 128 + m * 16) * ldc + col0;
#pragma unroll
                for (int bj = 0; bj < 2; ++bj) { const f32x4 v0 = acc[ai][bj][m][0], v1 = acc[ai][bj][m][1];
                    u32x4 w; w.x = pk2(v0[0], v0[1]); w.y = pk2(v0[2], v0[3]); w.z = pk2(v1[0], v1[1]); w.w = pk2(v1[2], v1[3]);
                    *(u32x4*)(rowp + bj * 128) = w; } }
    }
};
struct EpiResid {
    static constexpr bool PERM = false, AFTER_DRAIN = false;
    const float* base; float* out; bf16_t* hb; float* ss;
    DI void operator()(const f32x4 (&acc)[2][2][4][2], const Unit& u, int wr, int wc, int fr, int fq) const {
        const int row0 = u.pm * 256 + wr * 64 + fr, col0 = u.pn * 256 + wc * 32 + 4 * fq;
#pragma unroll
        for (int ai = 0; ai < 2; ++ai) { f32x4 bs[4][4];
#pragma unroll
            for (int m = 0; m < 4; ++m)
#pragma unroll
                for (int q = 0; q < 4; ++q) bs[m][q] = *(const f32x4*)(base + (size_t)(row0 + ai * 128 + m * 16) * DM + col0 + (q >> 1) * 128 + (q & 1) * 16);
#pragma unroll
            for (int m = 0; m < 4; ++m) { const int row = row0 + ai * 128 + m * 16; const size_t off = (size_t)row * DM + col0; float s = 0.f;
#pragma unroll
                for (int q = 0; q < 4; ++q) { const f32x4 hv = bs[m][q] + acc[ai][q >> 1][m][q & 1];
                        *(f32x4*)(out + off + (q >> 1) * 128 + (q & 1) * 16) = hv; u32x2 w; w.x = pk2(hv[0], hv[1]); w.y = pk2(hv[2], hv[3]);
                        *(u32x2*)(hb + off + (q >> 1) * 128 + (q & 1) * 16) = w; s += (hv[0] * hv[0] + hv[1] * hv[1]) + (hv[2] * hv[2] + hv[3] * hv[3]); }
                s += __shfl_xor(s, 16); s += __shfl_xor(s, 32);
                if (fq == 0) atomicAdd(ss + row, s); }
            asm volatile("" ::: "memory"); }
    }
};
struct EpiAct {
    static constexpr bool PERM = true, AFTER_DRAIN = false;
    bf16_t* O; const float* ss;
    DI void operator()(const f32x4 (&acc)[2][2][4][2], const Unit& u, int wr, int wc, int fr, int fq) const {
        const int row0 = u.pm * 256 + wr * 64 + fr, col0 = u.pn * 128 + wc * 32 + 8 * fq;
        float rs[8];
#pragma unroll
        for (int g = 0; g < 8; ++g) rs[g] = ss[row0 + (g >> 2) * 128 + (g & 3) * 16];
#pragma unroll
        for (int ai = 0; ai < 2; ++ai)
#pragma unroll
            for (int m = 0; m < 4; ++m) { const int row = row0 + ai * 128 + m * 16; const float r = rsqrtf(rs[ai * 4 + m] * (1.f / 2048.f) + 1e-6f);
                float a[8];
#pragma unroll
                for (int n = 0; n < 2; ++n)
#pragma unroll
                    for (int j = 0; j < 4; ++j) { const float gv = r * acc[ai][0][m][n][j], uv = r * acc[ai][1][m][n][j]; a[n * 4 + j] = silu_f(gv) * uv; }
                u32x4 w; w.x = pk2(a[0], a[1]); w.y = pk2(a[2], a[3]); w.z = pk2(a[4], a[5]); w.w = pk2(a[6], a[7]);
                *(u32x4*)(O + (size_t)row * FF + col0) = w; }
    }
};
struct EpiOut {
    static constexpr bool PERM = false, AFTER_DRAIN = false;
    float* out; const bf16_t* pp; const float* ss;
    DI void operator()(const f32x4 (&acc)[2][2][4][2], const Unit& u, int wr, int wc, int fr, int fq) const {
        const int row0 = u.pm * 256 + wr * 64 + fr, col0 = u.pn * 256 + wc * 32 + 4 * fq;
        float rs[8];
#pragma unroll
        for (int g = 0; g < 8; ++g) rs[g] = ss[row0 + (g >> 2) * 128 + (g & 3) * 16];
#pragma unroll
        for (int ai = 0; ai < 2; ++ai)
#pragma unroll
            for (int m = 0; m < 4; ++m) { const int row = row0 + ai * 128 + m * 16; const size_t off = (size_t)row * DM + col0; const float r = rsqrtf(rs[ai * 4 + m] * (1.f / 2048.f) + 1e-6f);
                f32x4 hv[4]; u32x2 pw[4];
#pragma unroll
                for (int q = 0; q < 4; ++q) { hv[q] = *(const f32x4*)(out + off + (q >> 1) * 128 + (q & 1) * 16); pw[q] = *(const u32x2*)(pp + off + (q >> 1) * 128 + (q & 1) * 16); }
#pragma unroll
                for (int q = 0; q < 4; ++q) { const f32x4 a = acc[ai][q >> 1][m][q & 1]; f32x4 o;
                        o[0] = hv[q][0] + sigm_f(r * a[0]) * bflo(pw[q].x); o[1] = hv[q][1] + sigm_f(r * a[1]) * bfhi(pw[q].x);
                        o[2] = hv[q][2] + sigm_f(r * a[2]) * bflo(pw[q].y); o[3] = hv[q][3] + sigm_f(r * a[3]) * bfhi(pw[q].y);
                        *(f32x4*)(out + off + (q >> 1) * 128 + (q & 1) * 16) = o; }
                asm volatile("" ::: "memory"); }
    }
};

DI void tconv_tile(const float* __restrict__ src, int ld, int c0, int k0, bf16_t* __restrict__ dst, int dK, int n0, const float* __restrict__ nw, LAS float* tl) {
    const int tid = opq_tid();
    f32x4 v[8];
#pragma unroll
    for (int i = 0; i < 8; ++i) v[i] = *(const f32x4*)(src + (size_t)(k0 + (tid >> 4) + 32 * i) * ld + c0 + (tid & 15) * 4);
#pragma unroll
    for (int i = 0; i < 8; ++i) { const int k = (tid >> 4) + 32 * i; const float sc = nw ? nw[k0 + k] : 1.f;
        LAS float* q = tl + k * 65 + (tid & 15) * 4; q[0] = v[i][0] * sc; q[1] = v[i][1] * sc; q[2] = v[i][2] * sc; q[3] = v[i][3] * sc; }
    __syncthreads();
    { const int n = tid >> 3, kq = (tid & 7) * 8;
#pragma unroll
      for (int j = 0; j < 4; ++j) { const int ks = kq + 64 * j; float f[8];
#pragma unroll
          for (int i = 0; i < 8; ++i) f[i] = tl[(ks + i) * 65 + n];
          u32x4 w; w.x = pk2(f[0], f[1]); w.y = pk2(f[2], f[3]); w.z = pk2(f[4], f[5]); w.w = pk2(f[6], f[7]);
          *(u32x4*)(dst + (size_t)(n0 + n) * dK + k0 + ks) = w; } }
    __syncthreads();
}

DI void phase_prep(const Params& P, LAS unsigned char* lds) {
    unsigned char* ws = P.ws; const int tid = opq_tid(), G = gridDim.x, bx = blockIdx.x;
    const int gtid = bx * NTHREADS + tid, gsz = G * NTHREADS;
    for (int i = gtid; i < (int)((WS_GL - WS_CTL) / 4); i += gsz) ((unsigned*)(ws + WS_CTL))[i] = 0u;
    { bf16_t* wba = (bf16_t*)(ws + WS_WBA); for (int i = gtid; i < 16 * 2048; i += gsz) { const int n = i >> 11, k = i & 2047; wba[i] = f2bf(P.w_in[(size_t)k * INW + 4096 + n]); } }
    { bf16_t* pb = (bf16_t*)(ws + WS_PB); const int NI = MT * 256 / 8;
      for (int i0 = gtid; i0 < NI; i0 += 4 * gsz) { f32x4 a[4], b4[4];
#pragma unroll
          for (int k = 0; k < 4; ++k) { const int i = i0 + k * gsz < NI ? i0 + k * gsz : i0; a[k] = *(const f32x4*)(P.p + (size_t)i * 8); b4[k] = *(const f32x4*)(P.p + (size_t)i * 8 + 4); }
#pragma unroll
          for (int k = 0; k < 4; ++k) { const int i = i0 + k * gsz; u32x4 w; w.x = pk2(a[k][0], a[k][1]); w.y = pk2(a[k][2], a[k][3]); w.z = pk2(b4[k][0], b4[k][1]); w.w = pk2(b4[k][2], b4[k][3]);
              if (i < NI) *(u32x4*)(pb + (size_t)i * 8) = w; } } }
    { bf16_t* xn = (bf16_t*)(ws + WS_R0); const int lane = tid & 63, gw = bx * 8 + (tid >> 6);
      f32x4 wv[8];
#pragma unroll
      for (int i = 0; i < 8; ++i) wv[i] = *(const f32x4*)(P.attn_norm + lane * 4 + i * 256);
      for (int row = gw * 2; row < MT; row += G * 16) { const float* xr = P.x + (size_t)row * DM; f32x4 v[2][8]; float s0 = 0.f, s1 = 0.f;
#pragma unroll
          for (int r = 0; r < 2; ++r)
#pragma unroll
              for (int i = 0; i < 8; ++i) v[r][i] = *(const f32x4*)(xr + (size_t)r * DM + lane * 4 + i * 256);
#pragma unroll
          for (int i = 0; i < 8; ++i) { s0 += (v[0][i][0] * v[0][i][0] + v[0][i][1] * v[0][i][1]) + (v[0][i][2] * v[0][i][2] + v[0][i][3] * v[0][i][3]);
              s1 += (v[1][i][0] * v[1][i][0] + v[1][i][1] * v[1][i][1]) + (v[1][i][2] * v[1][i][2] + v[1][i][3] * v[1][i][3]); }
#pragma unroll
          for (int o = 1; o < 64; o <<= 1) { s0 += __shfl_xor(s0, o); s1 += __shfl_xor(s1, o); }
          const float r0 = rsqrtf(s0 * (1.f / 2048.f) + 1e-6f), r1 = rsqrtf(s1 * (1.f / 2048.f) + 1e-6f);
#pragma unroll
          for (int r = 0; r < 2; ++r)
#pragma unroll
              for (int i = 0; i < 8; ++i) { const float rr = r ? r1 : r0; u32x2 w; w.x = pk2(v[r][i][0] * rr * wv[i][0], v[r][i][1] * rr * wv[i][1]); w.y = pk2(v[r][i][2] * rr * wv[i][2], v[r][i][3] * rr * wv[i][3]);
                  *(u32x2*)(xn + (size_t)(row + r) * DM + lane * 4 + i * 256) = w; } } }
    LAS float* tl = (LAS float*)lds;
    for (int gi = bx; gi < 896; gi += G) { const int nt = gi >> 3, kg = gi & 7, n0 = nt * 64; tconv_tile(P.w_in, INW, n0 < 4096 ? n0 : n0 + 16, kg * 256, (bf16_t*)(ws + WS_WIN), 2048, n0, nullptr, tl); }
}
DI void phase_wconv_late(const Params& P, LAS unsigned char* lds, int wg0, int nwg) {
    unsigned char* ws = P.ws; LAS float* tl = (LAS float*)lds;
    for (int gi = 896 + wg0; gi < 3552; gi += nwg) {
        if (gi < 1152) { const int t2 = gi - 896, nt = t2 >> 3, kg = t2 & 7; tconv_tile(P.w_o, 2048, nt * 64, kg * 256, (bf16_t*)(ws + WS_WO), 2048, nt * 64, nullptr, tl); }
        else if (gi < 2560) { const int t2 = gi - 1152, nt = t2 >> 3, kg = t2 & 7, n0 = nt * 64, pn = n0 >> 8, r = n0 & 255;
            tconv_tile(r < 128 ? P.w_gate : P.w_up, FF, pn * 128 + (r & 127), kg * 256, (bf16_t*)(ws + WS_WGU), 2048, n0, P.ffn_norm, tl); }
        else if (gi < 3264) { const int t2 = gi - 2560, nt = t2 / 22, kg = t2 % 22; tconv_tile(P.w_down, 2048, nt * 64, kg * 256, (bf16_t*)(ws + WS_WDN), FF, nt * 64, nullptr, tl); }
        else if (gi < 3520) { const int t2 = gi - 3264, nt = t2 >> 3, kg = t2 & 7; tconv_tile(P.w_pg, 2048, nt * 64, kg * 256, (bf16_t*)(ws + WS_WPG), 2048, nt * 64, P.ple_norm, tl); }
        else { const int nt = gi - 3520; tconv_tile(P.w_pp, 2048, nt * 64, 0, (bf16_t*)(ws + WS_WPP), 256, nt * 64, nullptr, tl); }
    }
}

DI void phase_ba(const Params& P) {
    const int tid = opq_tid(), lane = tid & 63, fr = lane & 15, fq = lane >> 4, gw = blockIdx.x * 8 + (tid >> 6);
    const bf16_t* xn = (const bf16_t*)(P.ws + WS_R0); const bf16_t* wba = (const bf16_t*)(P.ws + WS_WBA); float* BA = (float*)(P.ws + WS_BA);
    for (int rt = gw; rt < MT / 16; rt += gridDim.x * 8) {
        f32x4 acc = {0.f, 0.f, 0.f, 0.f}; const bf16_t* ap = xn + (size_t)(rt * 16 + fr) * DM + 8 * fq; const bf16_t* bp = wba + fr * 2048 + 8 * fq;
#pragma unroll 16
        for (int ks = 0; ks < 64; ++ks) acc = mfma16(*(const bf16x8*)(ap + 32 * ks), *(const bf16x8*)(bp + 32 * ks), acc);
#pragma unroll
        for (int j = 0; j < 4; ++j) BA[(size_t)(rt * 16 + 4 * fq + j) * 16 + fr] = acc[j];
    }
}

constexpr int G1_QS = 0, G1_KS = 18432, G1_VT = 36864, G1_KT = 57344, G1_SM = 77824, G1_TEAM = 78848;
DI void phase_gdn_prep(const Params& P, LAS unsigned char* lds, int n_lo, int n_cnt, int wg0, int nwg, unsigned* early_flag = nullptr, int early_thr = 0, unsigned* early_flag2 = nullptr, int early_thr2 = 0) {
    const int tid0 = opq_tid(), team = tid0 >> 8;
    LAS unsigned char* L = lds + team * G1_TEAM;
    LAS bf16_t* QS = (LAS bf16_t*)(L + G1_QS); LAS bf16_t* KS = (LAS bf16_t*)(L + G1_KS); LAS bf16_t* VT = (LAS bf16_t*)(L + G1_VT); LAS bf16_t* KT = (LAS bf16_t*)(L + G1_KT);
    LAS float* AF = (LAS float*)(L + G1_QS); LAS bf16_t* TB = (LAS bf16_t*)(L + G1_KS); LAS float* SM = (LAS float*)(L + G1_SM);
    bf16_t* proj = (bf16_t*)(P.ws + WS_R1); const bf16_t* halo = (const bf16_t*)(P.ws + WS_HALO); const float* BA = (const float*)(P.ws + WS_BA);
    bf16_t* W2 = (bf16_t*)(P.ws + WS_W2); bf16_t* QKB = (bf16_t*)(P.ws + WS_QKB); float* GL = (float*)(P.ws + WS_GL);
    bool arrived = (early_flag == nullptr), arrived2 = (early_flag2 == nullptr);
    for (int pi = wg0; pi < n_cnt * 8; pi += nwg) {
        int tid = tid0; asm volatile("" : "+v"(tid));
        const int tt = tid & 255, tw = __builtin_amdgcn_readfirstlane((tid >> 6) & 3), lane = tid & 63, fr = lane & 15, fq = lane >> 4;
        const int cq = pi * 2 + team, h = cq & 7, b = (cq >> 3) & 1, n = n_lo + (cq >> 4), ci = ((b * 256 + n) << 3) + h, t0 = b * TT + n * 64;
        if (tw == 0) {
            const float bv = BA[(size_t)(t0 + lane) * 16 + h], av = BA[(size_t)(t0 + lane) * 16 + 8 + h];
            const float beta = sigm_f(bv); const float xx = av + P.dt_bias[h]; const float sp = xx > 20.f ? xx : log1pf(__expf(xx));
            const float gg = -__expf(P.A_log[h]) * sp; float gc = gg;
#pragma unroll
            for (int o = 1; o < 64; o <<= 1) { const float v = __shfl_up(gc, o); if (lane >= o) gc += v; }
            const float glast = __shfl(gc, 63);
            SM[lane] = gc; SM[64 + lane] = beta; SM[128 + lane] = __expf(gc); SM[192 + lane] = __expf(glast - gc);
            if (lane == 63) GL[(b * 8 + h) * 256 + n] = __expf(gc);
        }
        __syncthreads();
        { const int r = tt >> 2, cg0 = (tt & 3) * 32; const float beta_r = SM[64 + r], egc_r = SM[128 + r];
#pragma unroll 1
          for (int x = 0; x < 3; ++x) {
              float val[32]; const int colbase = x * 1024 + h * 128 + cg0;
              u32x4 rawa[4][4];
#pragma unroll
              for (int sg = 0; sg < 4; ++sg) { const int col = colbase + sg * 8;
#pragma unroll
                  for (int j = 0; j < 4; ++j) { const int rr = r - 3 + j; rawa[sg][j] = (u32x4){0u, 0u, 0u, 0u};
                      if (rr >= 0) rawa[sg][j] = *(const u32x4*)(proj + (size_t)(t0 + rr) * NPJ + col);
                      else if (n > 0) rawa[sg][j] = *(const u32x4*)(halo + ((size_t)(t0 >> 6) * 3 + (rr + 3)) * 3072 + col); } }
#pragma unroll
              for (int sg = 0; sg < 4; ++sg) { const int col = colbase + sg * 8;
#pragma unroll
                  for (int i = 0; i < 8; ++i) { const f32x4 w4 = *(const f32x4*)(P.conv_w + (size_t)(col + i) * 4); float a = 0.f;
#pragma unroll
                      for (int j = 0; j < 4; ++j) { const unsigned wd = rawa[sg][j][i >> 1]; const float xv = (i & 1) ? bfhi(wd) : bflo(wd); a += w4[j] * xv; }
                      val[sg * 8 + i] = silu_f(a); } }
              if (x < 2) { float ss = 0.f;
#pragma unroll
                  for (int i = 0; i < 32; ++i) ss += val[i] * val[i];
                  ss += __shfl_xor(ss, 1); ss += __shfl_xor(ss, 2);
                  const float sc = rsqrtf(ss + 1e-6f) * (x == 0 ? 0.08838834764831845f : 1.f);
#pragma unroll
                  for (int i = 0; i < 32; ++i) val[i] *= sc; }
              if (x < 2) { LAS bf16_t* dst = (x == 0 ? QS : KS) + r * 144 + cg0;
#pragma unroll
                  for (int i = 0; i < 4; ++i) { u32x4 w; w.x = pk2(val[8 * i], val[8 * i + 1]); w.y = pk2(val[8 * i + 2], val[8 * i + 3]); w.z = pk2(val[8 * i + 4], val[8 * i + 5]); w.w = pk2(val[8 * i + 6], val[8 * i + 7]);
                      *(LAS u32x4*)(dst + 8 * i) = w; } }
              if (x == 1) { const float f = beta_r * egc_r;
#pragma unroll
                  for (int i = 0; i < 32; ++i) KT[(cg0 + i) * 80 + r] = f2bf(val[i] * f); }
              if (x == 2) {
#pragma unroll
                  for (int i = 0; i < 32; ++i) VT[(cg0 + i) * 80 + r] = f2bf(val[i] * beta_r); }
          } }
        __syncthreads();
        f32x4 kk[4], qk[4];
#pragma unroll
        for (int nt = 0; nt < 4; ++nt) { kk[nt] = (f32x4){0.f, 0.f, 0.f, 0.f}; qk[nt] = (f32x4){0.f, 0.f, 0.f, 0.f}; }
#pragma unroll
        for (int ks = 0; ks < 4; ++ks) { const bf16x8 ak = *(const LAS bf16x8*)(KS + (16 * tw + fr) * 144 + 32 * ks + 8 * fq), aq = *(const LAS bf16x8*)(QS + (16 * tw + fr) * 144 + 32 * ks + 8 * fq);
#pragma unroll
            for (int nt = 0; nt < 4; ++nt) { const bf16x8 bk = *(const LAS bf16x8*)(KS + (16 * nt + fr) * 144 + 32 * ks + 8 * fq); kk[nt] = mfma16(ak, bk, kk[nt]); qk[nt] = mfma16(aq, bk, qk[nt]); } }
        { const int r = tt >> 2, cg0 = (tt & 3) * 32; const float e = SM[128 + r];
#pragma unroll
          for (int i = 0; i < 4; ++i) { const u32x4 s = *(const LAS u32x4*)(QS + r * 144 + cg0 + 8 * i); u32x4 w;
              w.x = pk2(bflo(s.x) * e, bfhi(s.x) * e); w.y = pk2(bflo(s.y) * e, bfhi(s.y) * e); w.z = pk2(bflo(s.z) * e, bfhi(s.z) * e); w.w = pk2(bflo(s.w) * e, bfhi(s.w) * e);
              *(u32x4*)(proj + (size_t)(t0 + r) * NPJ + OFF_GQ + h * 128 + cg0 + 8 * i) = w; } }
        { const int d = tt >> 1, cb = (tt & 1) * 32;
#pragma unroll
          for (int i4 = 0; i4 < 4; ++i4) { const int c0 = cb + 8 * i4; float f[8];
#pragma unroll
              for (int i = 0; i < 8; ++i) f[i] = bf2f(KS[(c0 + i) * 144 + d]) * SM[192 + c0 + i];
              u32x4 w; w.x = pk2(f[0], f[1]); w.y = pk2(f[2], f[3]); w.z = pk2(f[4], f[5]); w.w = pk2(f[6], f[7]);
              *(u32x4*)(proj + (size_t)(t0 + (d >> 1)) * NPJ + OFF_GK + h * 128 + (d & 1) * 64 + c0) = w; } }
        __syncthreads();
#pragma unroll
        for (int nt = 0; nt < 4; ++nt)
#pragma unroll
            for (int j = 0; j < 4; ++j) { const int c = 16 * tw + 4 * fq + j, s = 16 * nt + fr; const float dec = (s <= c) ? __expf(SM[c] - SM[s]) : 0.f;
                AF[c * 65 + s] = (s < c) ? SM[64 + c] * kk[nt][j] * dec : (s == c ? 1.f : 0.f);
                QKB[(size_t)ci * 4096 + c * 64 + s] = f2bf(qk[nt][j] * dec); }
        __syncthreads();
        { const int bb = tw * 16;
          if (lane < 16) {
              for (int i = 1; i < 16; ++i) { float a0 = 0.f, a1 = 0.f; int j = 0;
                  for (; j + 2 <= i; j += 2) { a0 += AF[(bb + i) * 65 + bb + j] * AF[(bb + j) * 65 + bb + lane]; a1 += AF[(bb + i) * 65 + bb + j + 1] * AF[(bb + j + 1) * 65 + bb + lane]; }
                  if (j < i) a0 += AF[(bb + i) * 65 + bb + j] * AF[(bb + j) * 65 + bb + lane];
                  AF[(bb + i) * 65 + bb + lane] = lane < i ? -(a0 + a1) : (lane == i ? 1.f : 0.f); } }
#pragma unroll
          for (int k = 0; k < 4; ++k) { const int row = bb + fq + 4 * k; TB[row * 80 + bb + fr] = f2bf(AF[row * 65 + bb + fr]);
              for (int jb = tw + 1; jb < 4; ++jb) TB[row * 80 + 16 * jb + fr] = (bf16_t)0; }
          __syncthreads();
          for (int i = 1; i < 4; ++i) {
              if (tw < i) { const int j = tw; f32x4 X = {0.f, 0.f, 0.f, 0.f};
                  for (int k = j; k < i; ++k) {
#pragma unroll
                      for (int kk = 0; kk < 4; ++kk) { const float av = AF[(16 * i + fr) * 65 + 16 * k + 4 * kk + fq];
                          const float bv = (k == j) ? AF[(16 * k + 4 * kk + fq) * 65 + 16 * j + fr] : bf2f(TB[(16 * k + 4 * kk + fq) * 80 + 16 * j + fr]);
                          X = __builtin_amdgcn_mfma_f32_16x16x4f32(av, bv, X, 0, 0, 0); } }
                  f32x4 O = {0.f, 0.f, 0.f, 0.f};
#pragma unroll
                  for (int kk = 0; kk < 4; ++kk) O = __builtin_amdgcn_mfma_f32_16x16x4f32(AF[(16 * i + fr) * 65 + 16 * i + 4 * fq + kk], X[kk], O, 0, 0, 0);
#pragma unroll
                  for (int jj = 0; jj < 4; ++jj) TB[(16 * i + 4 * fq + jj) * 80 + 16 * j + fr] = f2bf(-O[jj]); }
              __syncthreads(); }
        }
        { bf16x8 at[2];
#pragma unroll
          for (int ks = 0; ks < 2; ++ks) at[ks] = *(const LAS bf16x8*)(TB + (16 * tw + fr) * 80 + 32 * ks + 8 * fq);
#pragma unroll
          for (int nt = 0; nt < 8; ++nt) { f32x4 a = {0.f, 0.f, 0.f, 0.f};
#pragma unroll
              for (int ks = 0; ks < 2; ++ks) a = mfma16(at[ks], *(const LAS bf16x8*)(VT + (16 * nt + fr) * 80 + 32 * ks + 8 * fq), a);
              const int e = 16 * nt + fr; u32x2 w; w.x = pk2(a[0], a[1]); w.y = pk2(a[2], a[3]);
              *(u32x2*)(proj + (size_t)(t0 + (e >> 1)) * NPJ + OFF_GV + h * 128 + (e & 1) * 64 + 16 * tw + 4 * fq) = w; }
#pragma unroll
          for (int mt = 0; mt < 8; ++mt) { f32x4 a = {0.f, 0.f, 0.f, 0.f};
#pragma unroll
              for (int ks = 0; ks < 2; ++ks) a = mfma16(*(const LAS bf16x8*)(KT + (16 * mt + fr) * 80 + 32 * ks + 8 * fq), at[ks], a);
              u32x2 w; w.x = pk2(a[0], a[1]); w.y = pk2(a[2], a[3]);
              *(u32x2*)(W2 + (size_t)(t0 + 16 * tw + fr) * 1024 + h * 128 + 16 * mt + 4 * fq) = w; } }
        __syncthreads();
        if (!arrived && pi + nwg >= early_thr) {
            asm volatile("s_waitcnt vmcnt(0)" ::: "memory"); __syncthreads();
            if (threadIdx.x == 0) { __builtin_amdgcn_fence(__ATOMIC_RELEASE, "agent"); __hip_atomic_fetch_add(early_flag, 1u, __ATOMIC_RELAXED, __HIP_MEMORY_SCOPE_AGENT); }
            arrived = true; }
        if (!arrived2 && pi + nwg >= early_thr2) {
            asm volatile("s_waitcnt vmcnt(0)" ::: "memory"); __syncthreads();
            if (threadIdx.x == 0) { __builtin_amdgcn_fence(__ATOMIC_RELEASE, "agent"); __hip_atomic_fetch_add(early_flag2, 1u, __ATOMIC_RELAXED, __HIP_MEMORY_SCOPE_AGENT); }
            arrived2 = true; }
    }
    if (!arrived2) { asm volatile("s_waitcnt vmcnt(0)" ::: "memory"); __syncthreads();
        if (threadIdx.x == 0) { __builtin_amdgcn_fence(__ATOMIC_RELEASE, "agent"); __hip_atomic_fetch_add(early_flag2, 1u, __ATOMIC_RELAXED, __HIP_MEMORY_SCOPE_AGENT); } }
    if (!arrived) { asm volatile("s_waitcnt vmcnt(0)" ::: "memory"); __syncthreads();
        if (threadIdx.x == 0) { __builtin_amdgcn_fence(__ATOMIC_RELEASE, "agent"); __hip_atomic_fetch_add(early_flag, 1u, __ATOMIC_RELAXED, __HIP_MEMORY_SCOPE_AGENT); } }
}

DI void phase_moba_prep(const Params& P, LAS unsigned char* lds, int wg0, int nwg) {
    const int tid = opq_tid(), lane = tid & 63, wave = tid >> 6, l16 = lane & 15;
    bf16_t* proj = (bf16_t*)(P.ws + WS_R1); float* kmean = (float*)(P.ws + WS_KMEAN);
    LAS bf16_t* VS = (LAS bf16_t*)lds; LAS float* CS = (LAS float*)(lds + 69632);
    for (int task = wg0; task < 1024; task += nwg) {
        const int h = task & 7, blk = (task >> 3) & 63, b = task >> 9; const size_t rbase = (size_t)(b * TT + blk * 256);
        f32x4 qg0 = *(const f32x4*)(P.q_norm + l16 * 8), qg1 = *(const f32x4*)(P.q_norm + l16 * 8 + 4), kg0 = *(const f32x4*)(P.k_norm + l16 * 8), kg1 = *(const f32x4*)(P.k_norm + l16 * 8 + 4);
        float cs[8];
#pragma unroll
        for (int i = 0; i < 8; ++i) cs[i] = 0.f;
        u32x4 rq[8], rk[8], rv[8];
#pragma unroll
        for (int ps = 0; ps < 8; ++ps) { const int r = ps * 32 + wave * 4 + (lane >> 4); const bf16_t* rp = proj + (rbase + r) * NPJ + h * 128 + l16 * 8;
            rq[ps] = *(const u32x4*)(rp + OFF_MQ); rk[ps] = *(const u32x4*)(rp + OFF_MK); rv[ps] = *(const u32x4*)(rp + OFF_MV); }
#pragma unroll
        for (int ps = 0; ps < 8; ++ps) { const int r = ps * 32 + wave * 4 + (lane >> 4); bf16_t* rp = proj + (rbase + r) * NPJ + h * 128 + l16 * 8;
#pragma unroll
            for (int x = 0; x < 2; ++x) { bf16_t* ptr = rp + (x == 0 ? OFF_MQ : OFF_MK); const u32x4 raw = x == 0 ? rq[ps] : rk[ps]; float v[8];
                v[0] = bflo(raw.x); v[1] = bfhi(raw.x); v[2] = bflo(raw.y); v[3] = bfhi(raw.y); v[4] = bflo(raw.z); v[5] = bfhi(raw.z); v[6] = bflo(raw.w); v[7] = bfhi(raw.w);
                float ss = 0.f;
#pragma unroll
                for (int i = 0; i < 8; ++i) ss += v[i] * v[i];
                ss = row16_sum(ss);
                const float rs = rsqrtf(ss * (1.f / 128.f) + 1e-6f); const f32x4 g0 = x == 0 ? qg0 : kg0, g1 = x == 0 ? qg1 : kg1;
#pragma unroll
                for (int i = 0; i < 4; ++i) { v[i] *= rs * g0[i]; v[4 + i] *= rs * g1[i]; }
                if (x == 1) {
#pragma unroll
                    for (int i = 0; i < 8; ++i) cs[i] += v[i]; }
                u32x4 w; w.x = pk2(v[0], v[1]); w.y = pk2(v[2], v[3]); w.z = pk2(v[4], v[5]); w.w = pk2(v[6], v[7]); *(u32x4*)ptr = w; }
            *(LAS u32x4*)(VS + r * 136 + l16 * 8) = rv[ps]; }
#pragma unroll
        for (int i = 0; i < 8; ++i) { cs[i] += __shfl_xor(cs[i], 16); cs[i] += __shfl_xor(cs[i], 32); }
        if (lane < 16) {
#pragma unroll
            for (int i = 0; i < 8; ++i) CS[wave * 128 + lane * 8 + i] = cs[i]; }
        __syncthreads();
        if (tid < 128) { float s = 0.f;
#pragma unroll
            for (int w = 0; w < 8; ++w) s += CS[w * 128 + tid];
            kmean[((size_t)(b * 8 + h) * 64 + blk) * 128 + tid] = s * (1.f / 256.f); }
#pragma unroll 2
        for (int i8 = 0; i8 < 8; ++i8) { const int pid = tid + i8 * 512, e = (pid & 63) + 64 * (pid >> 11), ks = (pid >> 6) & 31; unsigned short f[8];
#pragma unroll
            for (int i = 0; i < 8; ++i) f[i] = VS[(ks * 8 + i) * 136 + e];
            u32x4 w; w.x = f[0] | ((unsigned)f[1] << 16); w.y = f[2] | ((unsigned)f[3] << 16); w.z = f[4] | ((unsigned)f[5] << 16); w.w = f[6] | ((unsigned)f[7] << 16);
            *(u32x4*)(proj + (rbase + 2 * e + (ks >> 4)) * NPJ + OFF_MV + h * 128 + (ks & 15) * 8) = w; }
        __syncthreads();
    }
}

DI void phase_moba_select(const Params& P, LAS unsigned char* lds, int wg0, int nwg) {
    const int tid = opq_tid(), qi = tid >> 1, half = tid & 1;
    const bf16_t* proj = (const bf16_t*)(P.ws + WS_R1); const float* kmean = (const float*)(P.ws + WS_KMEAN);
    int* cnt = (int*)(P.ws + WS_CNT); int* list = (int*)(P.ws + WS_LIST); f32x2* ML = (f32x2*)(P.ws + WS_ML);
    LAS float* KM = (LAS float*)lds; LAS int* hist = (LAS int*)(lds + 32768); LAS int* hbase = (LAS int*)(lds + 32768 + 256);
    for (int task = wg0; task < 1024; task += nwg) {
        const int tk = task >> 8, tw_ = task & 255, bhx = (tw_ >> 6) * 4 + tk, blk = (tk & 1) ? 63 - (tw_ & 63) : (tw_ & 63), h = bhx & 7, b = bhx >> 3; const int bh = b * 8 + h; const int t = blk * 256 + qi; const size_t rid = (size_t)bh * TT + t;
        for (int i = tid; i < blk * 128; i += NTHREADS) KM[i] = kmean[(size_t)bh * 64 * 128 + i];
        if (tid < 64) hist[tid] = 0;
        float q[64];
        { const bf16_t* qp = proj + (size_t)(b * TT + t) * NPJ + OFF_MQ + h * 128 + half * 64;
#pragma unroll
          for (int i = 0; i < 8; ++i) { const u32x4 raw = *(const u32x4*)(qp + 8 * i); q[8 * i] = bflo(raw.x); q[8 * i + 1] = bfhi(raw.x); q[8 * i + 2] = bflo(raw.y); q[8 * i + 3] = bfhi(raw.y);
              q[8 * i + 4] = bflo(raw.z); q[8 * i + 5] = bfhi(raw.z); q[8 * i + 6] = bflo(raw.w); q[8 * i + 7] = bfhi(raw.w); } }
        __syncthreads();
        float v0 = -INFINITY, v1 = -INFINITY, v2 = -INFINITY; int i0 = -1, i1 = -1, i2 = -1;
        for (int n = 0; n < blk; ++n) { const LAS float* km = KM + n * 128 + half * 64; float d0 = 0.f, d1 = 0.f, d2 = 0.f, d3 = 0.f;
#pragma unroll
            for (int i = 0; i < 16; ++i) { const f32x4 kv = *(const LAS f32x4*)(km + 4 * i); d0 += q[4 * i] * kv[0]; d1 += q[4 * i + 1] * kv[1]; d2 += q[4 * i + 2] * kv[2]; d3 += q[4 * i + 3] * kv[3]; }
            float g = (d0 + d1) + (d2 + d3); g += __shfl_xor(g, 1);
            if (g > v0) { v2 = v1; i2 = i1; v1 = v0; i1 = i0; v0 = g; i0 = n; } else if (g > v1) { v2 = v1; i2 = i1; v1 = g; i1 = n; } else if (g > v2) { v2 = g; i2 = n; } }
        int rk0 = 0, rk1 = 0, rk2 = 0;
        if (half == 0) { if (i0 >= 0) rk0 = __hip_atomic_fetch_add(&hist[i0], 1, __ATOMIC_RELAXED, __HIP_MEMORY_SCOPE_WORKGROUP); if (i1 >= 0) rk1 = __hip_atomic_fetch_add(&hist[i1], 1, __ATOMIC_RELAXED, __HIP_MEMORY_SCOPE_WORKGROUP); if (i2 >= 0) rk2 = __hip_atomic_fetch_add(&hist[i2], 1, __ATOMIC_RELAXED, __HIP_MEMORY_SCOPE_WORKGROUP); }
        __syncthreads();
        if (tid < 64) { const int c = hist[tid]; hbase[tid] = c > 0 ? atomicAdd(&cnt[bh * 64 + tid], c) : 0; }
        __syncthreads();
        if (half == 0) {
            const f32x2 dead = {-INFINITY, 0.f};
            if (i0 >= 0) list[(size_t)bh * LISTN + i0 * 16384 - 128 * i0 * (i0 + 1) + hbase[i0] + rk0] = t; else ML[0 * 262144 + rid] = dead;
            if (i1 >= 0) list[(size_t)bh * LISTN + i1 * 16384 - 128 * i1 * (i1 + 1) + hbase[i1] + rk1] = t | (1 << 14); else ML[1 * 262144 + rid] = dead;
            if (i2 >= 0) list[(size_t)bh * LISTN + i2 * 16384 - 128 * i2 * (i2 + 1) + hbase[i2] + rk2] = t | (2 << 14); else ML[2 * 262144 + rid] = dead;
        }
        __syncthreads();
    }
}

constexpr int G2_W = 0, G2_Q = 18432, G2_QK = 36864, G2_KD = 47104, G2_BUF = 67584, G2_RED = 135168;
DI void phase_gdn_scan(const Params& P, LAS unsigned char* lds, int bh, const unsigned* flag, unsigned need, int n_first) {
    const int tid = opq_tid(), lane = tid & 63, w = tid >> 6, fr = lane & 15, fq = lane >> 4, b = bh >> 3, h = bh & 7;
    const bf16_t* proj = (const bf16_t*)(P.ws + WS_R1); const bf16_t* W2 = (const bf16_t*)(P.ws + WS_W2); const bf16_t* QKB = (const bf16_t*)(P.ws + WS_QKB);
    const float* GL = (const float*)(P.ws + WS_GL); bf16_t* mix = (bf16_t*)(P.ws + WS_R2);
    float* SSQ = (float*)(P.ws + WS_SSQ);
    const int e = 16 * w + fr; const float gnw = P.gdn_norm[e];
    f32x4 S[8];
#pragma unroll
    for (int i = 0; i < 8; ++i) S[i] = (f32x4){0.f, 0.f, 0.f, 0.f};
    const int wrow0 = tid >> 4, wseg = tid & 15;
    const int qrow = tid >> 3, qseg = tid & 7;
    struct Stage { u32x4 sw[2], sq[2], sqk, skd[2]; };
    u32x2 un[4];
    Stage stA, stB;
#define G2_LOAD(X, nn) do { const int t0_ = b * TT + (nn) * 64; const int ci_ = ((b * 256 + (nn)) << 3) + h; \
        _Pragma("unroll") for (int i_ = 0; i_ < 2; ++i_) { X.sw[i_] = *(const u32x4*)(W2 + (size_t)(t0_ + wrow0 + 32 * i_) * 1024 + h * 128 + wseg * 8); \
            X.sq[i_] = *(const u32x4*)(proj + (size_t)(t0_ + wrow0 + 32 * i_) * NPJ + OFF_GQ + h * 128 + wseg * 8); \
            const int d_ = qrow + 64 * i_; X.skd[i_] = *(const u32x4*)(proj + (size_t)(t0_ + (d_ >> 1)) * NPJ + OFF_GK + h * 128 + (d_ & 1) * 64 + qseg * 8); } \
        X.sqk = *(const u32x4*)(QKB + (size_t)ci_ * 4096 + qrow * 64 + qseg * 8); } while (0)
#define UN_LOAD(nn) do { const int t0_ = b * TT + (nn) * 64; _Pragma("unroll") for (int mt_ = 0; mt_ < 4; ++mt_) un[mt_] = *(const u32x2*)(proj + (size_t)(t0_ + (e >> 1)) * NPJ + OFF_GV + h * 128 + (e & 1) * 64 + 16 * mt_ + 4 * fq); } while (0)
#define G2_ST2(base_, rowoff_, sg_, v_) do { const int g_ = ((sg_) >> 2) * 64, d_ = ((sg_) & 3) * 8; \
        *(LAS u32x2*)(B_ + (base_) + (rowoff_) + g_ + perm4(d_) * 2) = (u32x2){(v_).x, (v_).y}; *(LAS u32x2*)(B_ + (base_) + (rowoff_) + g_ + perm4(d_ + 4) * 2) = (u32x2){(v_).z, (v_).w}; } while (0)
#define G2_STORE(X, bufi) do { LAS unsigned char* B_ = lds + (bufi) * G2_BUF; \
        _Pragma("unroll") for (int i_ = 0; i_ < 2; ++i_) { G2_ST2(G2_W, (wrow0 + 32 * i_) * 288, wseg, X.sw[i_]); G2_ST2(G2_Q, (wrow0 + 32 * i_) * 288, wseg, X.sq[i_]); \
            G2_ST2(G2_KD, (qrow + 64 * i_) * 160, qseg, X.skd[i_]); } \
        G2_ST2(G2_QK, qrow * 160, qseg, X.sqk); } while (0)
    G2_LOAD(stA, 0); G2_STORE(stA, 0); UN_LOAD(0);
    float egl_n = GL[bh * 256];
    u32x2 uc[4];
#pragma unroll
    for (int i = 0; i < 4; ++i) uc[i] = un[i];
    G2_LOAD(stA, 1);
    __syncthreads();
    for (int n2 = 0; n2 < 256; n2 += 2) {
#pragma unroll
      for (int hf2 = 0; hf2 < 2; ++hf2) {
        const int n = n2 + hf2; Stage& LDs = hf2 ? stA : stB; Stage& STs = hf2 ? stB : stA;
        if (n == n_first - 2 || n == 62 || n == 126) {
            const unsigned* fl = (n == 126) ? flag + 1 : (n == 62 ? flag : flag + 2);
            if (tid == 0) { while (__hip_atomic_load(fl, __ATOMIC_RELAXED, __HIP_MEMORY_SCOPE_AGENT) < need) __builtin_amdgcn_s_sleep(8);
                __builtin_amdgcn_fence(__ATOMIC_ACQUIRE, "agent"); asm volatile("s_waitcnt vmcnt(0)" ::: "memory"); }
            __syncthreads(); }
        const int cur = hf2, t0 = b * TT + n * 64; LAS unsigned char* Bf = lds + cur * G2_BUF;
        { const int n2c = n + 2 < 256 ? n + 2 : 255, n1c = n + 1 < 256 ? n + 1 : 255; G2_LOAD(LDs, n2c); UN_LOAD(n1c); }
        const float egl = egl_n; egl_n = GL[bh * 256 + (n + 1 < 256 ? n + 1 : 255)];
        f32x4 Pm[4], Om[4];
#pragma unroll
        for (int mt = 0; mt < 4; ++mt) { Pm[mt] = (f32x4){0.f, 0.f, 0.f, 0.f}; Om[mt] = (f32x4){0.f, 0.f, 0.f, 0.f}; }
#define SBAR __builtin_amdgcn_sched_barrier(0)
#define LD_K4(dst, base_, ks_) do { const int o0_ = fr * 288 + (32 * (ks_) + 8 * fq) * 2; \
        dst[0] = *(const LAS bf16x8*)(Bf + base_ + o0_); dst[1] = *(const LAS bf16x8*)(Bf + base_ + o0_ + 4608); \
        dst[2] = *(const LAS bf16x8*)(Bf + base_ + o0_ + 9216); dst[3] = *(const LAS bf16x8*)(Bf + base_ + o0_ + 13824); } while (0)
#define MM_K4(src, sb_, A_) do { A_[0] = mfma16(src[0], sb_, A_[0]); A_[1] = mfma16(src[1], sb_, A_[1]); A_[2] = mfma16(src[2], sb_, A_[2]); A_[3] = mfma16(src[3], sb_, A_[3]); } while (0)
#define LD_R4(dst, base_, r0_, k2_) do { const int o0_ = (16 * (r0_) + fr) * 160 + (32 * (k2_) + 8 * fq) * 2; \
        dst[0] = *(const LAS bf16x8*)(Bf + base_ + o0_); dst[1] = *(const LAS bf16x8*)(Bf + base_ + o0_ + 2560); \
        dst[2] = *(const LAS bf16x8*)(Bf + base_ + o0_ + 5120); dst[3] = *(const LAS bf16x8*)(Bf + base_ + o0_ + 7680); } while (0)
#define MM_R4(src, vb_, A0_, A1_, A2_, A3_) do { A0_ = mfma16(src[0], vb_, A0_); A1_ = mfma16(src[1], vb_, A1_); A2_ = mfma16(src[2], vb_, A2_); A3_ = mfma16(src[3], vb_, A3_); } while (0)
        bf16x8 fa[4], fb[4];
        LD_K4(fa, G2_W, 0);
        const bf16x8 sb0 = pack8(S[0], S[1]), sb1 = pack8(S[2], S[3]), sb2 = pack8(S[4], S[5]), sb3 = pack8(S[6], S[7]);
        LD_K4(fb, G2_W, 1); SBAR; MM_K4(fa, sb0, Pm); SBAR;
        LD_K4(fa, G2_W, 2); SBAR; MM_K4(fb, sb1, Pm); SBAR;
        LD_K4(fb, G2_W, 3); SBAR; MM_K4(fa, sb2, Pm); SBAR;
        LD_K4(fa, G2_Q, 0); SBAR; MM_K4(fb, sb3, Pm); SBAR;
        f32x4 vn[4];
#pragma unroll
        for (int mt = 0; mt < 4; ++mt) { vn[mt][0] = bflo(uc[mt].x) - Pm[mt][0]; vn[mt][1] = bfhi(uc[mt].x) - Pm[mt][1]; vn[mt][2] = bflo(uc[mt].y) - Pm[mt][2]; vn[mt][3] = bfhi(uc[mt].y) - Pm[mt][3]; }
        bf16x8 Vb[2];
#pragma unroll
        for (int k2 = 0; k2 < 2; ++k2) Vb[k2] = pack8(vn[2 * k2], vn[2 * k2 + 1]);
        LD_K4(fb, G2_Q, 1); SBAR; MM_K4(fa, sb0, Om); SBAR;
        LD_K4(fa, G2_Q, 2); SBAR; MM_K4(fb, sb1, Om); SBAR;
        LD_K4(fb, G2_Q, 3); SBAR; MM_K4(fa, sb2, Om); SBAR;
        LD_R4(fa, G2_QK, 0, 0); SBAR; MM_K4(fb, sb3, Om); SBAR;
#pragma unroll
        for (int dt = 0; dt < 8; ++dt) S[dt] = S[dt] * egl;
        SBAR;
        LD_R4(fb, G2_QK, 0, 1); SBAR; MM_R4(fa, Vb[0], Om[0], Om[1], Om[2], Om[3]); SBAR;
        LD_R4(fa, G2_KD, 0, 0); SBAR; MM_R4(fb, Vb[1], Om[0], Om[1], Om[2], Om[3]); SBAR;
        LD_R4(fb, G2_KD, 0, 1); SBAR; MM_R4(fa, Vb[0], S[0], S[1], S[2], S[3]); SBAR;
        LD_R4(fa, G2_KD, 4, 0); SBAR; MM_R4(fb, Vb[1], S[0], S[1], S[2], S[3]); SBAR;
        LD_R4(fb, G2_KD, 4, 1); SBAR; MM_R4(fa, Vb[0], S[4], S[5], S[6], S[7]); SBAR;
        MM_R4(fb, Vb[1], S[4], S[5], S[6], S[7]); SBAR;
#undef LD_K4
#undef MM_K4
#undef LD_R4
#undef MM_R4
#undef SBAR
        { G2_STORE(STs, cur ^ 1);
#pragma unroll
            for (int i = 0; i < 4; ++i) uc[i] = un[i]; }
        { LAS bf16_t* OTW = (LAS bf16_t*)(lds + G2_RED + w * 2048);
#pragma unroll
          for (int mt = 0; mt < 4; ++mt)
#pragma unroll
            for (int j = 0; j < 4; ++j) OTW[(16 * mt + 4 * fq + j) * 16 + fr] = f2bf(Om[mt][j]);
#pragma unroll
          for (int i = 0; i < 2; ++i) { const int row = (lane >> 1) + 32 * i, hv = lane & 1;
              bf16_t* mp_ = mix + (size_t)(t0 + row) * DM + h * 128 + 16 * w + 8 * hv; const u32x4 ov_ = *(const LAS u32x4*)(OTW + row * 16 + hv * 8);
              asm volatile("global_store_dwordx4 %0, %1, off" :: "v"(mp_), "v"(ov_) : "memory"); } }
        __syncthreads();
      }
    }
#undef G2_LOAD
#undef UN_LOAD
#undef G2_STORE
#undef G2_ST2
    asm volatile("s_waitcnt vmcnt(0)" ::: "memory");
    __syncthreads();
}

constexpr int AT_KS = 0, AT_VT = 73728, AT_PF = 143360, AT_MISC = 147712;
DI void phase_moba_attn(const Params& P, LAS unsigned char* lds) {
    const int tid = opq_tid(), lane = tid & 63, w = tid >> 6, fr = lane & 15, fq = lane >> 4;
    const bf16_t* proj = (const bf16_t*)(P.ws + WS_R1); const int* cnt = (const int*)(P.ws + WS_CNT); const int* list = (const int*)(P.ws + WS_LIST);
    f32x2* ML = (f32x2*)(P.ws + WS_ML); bf16_t* opart = (bf16_t*)P.out; unsigned* workctr = (unsigned*)(P.ws + WS_CTL);
    LAS bf16_t* KS = (LAS bf16_t*)(lds + AT_KS); LAS bf16_t* VT = (LAS bf16_t*)(lds + AT_VT); LAS int* PF = (LAS int*)(lds + AT_PF); LAS int* MISC = (LAS int*)(lds + AT_MISC);
    { const int c0 = cnt[2 * tid], c1 = cnt[2 * tid + 1]; const int a = (c0 + 511) >> 9, bsum = a + ((c1 + 511) >> 9); int inc = bsum;
#pragma unroll
      for (int o = 1; o < 64; o <<= 1) { const int v = __shfl_up(inc, o); if (lane >= o) inc += v; }
      if (lane == 63) MISC[8 + w] = inc;
      __syncthreads();
      int wb = 0;
#pragma unroll
      for (int i = 0; i < 8; ++i) wb += (i < w) ? MISC[8 + i] : 0;
      const int ex = wb + inc - bsum; PF[2 * tid] = ex; PF[2 * tid + 1] = ex + a; if (tid == 511) PF[1024] = ex + bsum;
      __syncthreads(); }
    const int totalG = PF[1024];
    const float sc2 = 0.08838834764831845f * 1.4426950408889634f;
    const int tid_at = tid;
    for (;;) {
        int tid = tid_at; asm volatile("" : "+v"(tid)); const int lane = tid & 63, w = __builtin_amdgcn_readfirstlane(tid >> 6), fr = lane & 15, fq = lane >> 4;
        if (tid == 0) MISC[0] = (int)atomicAdd(workctr, 1u);
        __syncthreads();
        const int wid = MISC[0];
        __syncthreads();
        if (wid >= totalG + 1024) break;
        int bh, j, causal, qstart, qcount;
        if (wid < totalG) { int lo = 0, hi = 1024; while (hi - lo > 1) { const int mid = (lo + hi) >> 1; if (PF[mid] <= wid) lo = mid; else hi = mid; }
            bh = lo >> 6; j = lo & 63; causal = 0; qstart = (wid - PF[lo]) * 512; const int c = cnt[lo]; qcount = c - qstart; if (qcount > 512) qcount = 512; }
        else { const int o = wid - totalG; bh = o >> 6; j = o & 63; causal = 1; qstart = 0; qcount = 256; }
        const int b = bh >> 3, h = bh & 7; const size_t kbase = (size_t)(b * TT + j * 256);
        { u32x4 kr[8], vr[8];
#pragma unroll
          for (int i8 = 0; i8 < 8; ++i8) { const int pid = tid + i8 * 512; kr[i8] = *(const u32x4*)(proj + (kbase + (pid >> 4)) * NPJ + OFF_MK + h * 128 + (pid & 15) * 8);
              const int e = pid >> 5, ks = pid & 31; vr[i8] = *(const u32x4*)(proj + (kbase + 2 * e + (ks >> 4)) * NPJ + OFF_MV + h * 128 + (ks & 15) * 8); }
#pragma unroll
          for (int i8 = 0; i8 < 8; ++i8) { const int pid = tid + i8 * 512; *(LAS u32x4*)(KS + (pid >> 4) * 144 + (pid & 15) * 8) = kr[i8];
              const int e = pid >> 5, ks = pid & 31; const int g_ = (ks >> 2) * 32, d_ = (ks & 3) * 8;
              *(LAS u32x2*)(VT + e * 272 + g_ + perm4(d_)) = (u32x2){vr[i8].x, vr[i8].y}; *(LAS u32x2*)(VT + e * 272 + g_ + perm4(d_ + 4)) = (u32x2){vr[i8].z, vr[i8].w}; } }
        const int lbase = bh * LISTN + j * 16384 - 128 * j * (j + 1) + qstart;
        const int ntile = (qcount + 127) >> 7;
        int en0, en1, en2, en3;
        { const int q0 = 16 * w + fr, lim = qcount - 1;
          if (causal) { en0 = (j * 256 + q0) | (3 << 14); en1 = (j * 256 + q0 + 128) | (3 << 14); en2 = en1; en3 = en1; }
          else { en0 = list[lbase + (q0 < lim ? q0 : lim)]; en1 = list[lbase + (q0 + 128 < lim ? q0 + 128 : lim)]; en2 = list[lbase + (q0 + 256 < lim ? q0 + 256 : lim)]; en3 = list[lbase + (q0 + 384 < lim ? q0 + 384 : lim)]; } }
        bf16x8 Bq[4], Bn[4];
        { const bf16_t* qp = proj + (size_t)(b * TT + (en0 & 16383)) * NPJ + OFF_MQ + h * 128 + 8 * fq;
#pragma unroll
          for (int ks = 0; ks < 4; ++ks) Bq[ks] = *(const bf16x8*)(qp + 32 * ks); }
        __syncthreads();
        for (int tile = 0; tile < ntile; ++tile) {
            const int en = tile == 0 ? en0 : (tile == 1 ? en1 : (tile == 2 ? en2 : en3));
            { const int enx = tile == 0 ? en1 : (tile == 1 ? en2 : en3); const bf16_t* qp = proj + (size_t)(b * TT + (enx & 16383)) * NPJ + OFF_MQ + h * 128 + 8 * fq;
#pragma unroll
              for (int ks = 0; ks < 4; ++ks) Bn[ks] = *(const bf16x8*)(qp + 32 * ks); }
            const int qi = tile * 128 + 16 * w + fr; const bool valid = qi < qcount; const int t = en & 16383, slot = en >> 14;
            if (tile * 128 + 16 * w < qcount) {
            const int nkt = causal ? (8 * tile + w + 1) : 16;
            f32x4 st[16]; float mx = -INFINITY;
#pragma unroll
            for (int kp = 0; kp < 8; ++kp) { f32x4 a0 = {0.f, 0.f, 0.f, 0.f}, a1 = {0.f, 0.f, 0.f, 0.f};
                if (2 * kp < nkt) { bf16x8 kf[8];
#pragma unroll
                    for (int ks = 0; ks < 4; ++ks) { kf[ks] = *(const LAS bf16x8*)(KS + (32 * kp + fr) * 144 + 32 * ks + 8 * fq); kf[4 + ks] = *(const LAS bf16x8*)(KS + (32 * kp + 16 + fr) * 144 + 32 * ks + 8 * fq); }
#pragma unroll
                    for (int ks = 0; ks < 4; ++ks) { a0 = mfma16(kf[ks], Bq[ks], a0); a1 = mfma16(kf[4 + ks], Bq[ks], a1); }
#pragma unroll
                    for (int jj = 0; jj < 4; ++jj) { float s0 = a0[jj] * sc2, s1 = a1[jj] * sc2;
                        if (causal && (32 * kp + 4 * fq + jj) > qi) s0 = -INFINITY; if ((causal && (32 * kp + 16 + 4 * fq + jj) > qi) || 2 * kp + 1 >= nkt) s1 = -INFINITY;
                        a0[jj] = s0; a1[jj] = s1; mx = fmaxf(mx, fmaxf(s0, s1)); }
                } else { a0 = (f32x4){-INFINITY, -INFINITY, -INFINITY, -INFINITY}; a1 = a0; }
                st[2 * kp] = a0; st[2 * kp + 1] = a1; }
            mx = fmaxf(mx, __shfl_xor(mx, 16)); mx = fmaxf(mx, __shfl_xor(mx, 32));
            float ls = 0.f;
#pragma unroll
            for (int kt = 0; kt < 16; ++kt)
#pragma unroll
                for (int jj = 0; jj < 4; ++jj) { const float pv = exp2f(st[kt][jj] - mx); st[kt][jj] = pv; ls += pv; }
            ls += __shfl_xor(ls, 16); ls += __shfl_xor(ls, 32);
            f32x4 ot[8];
#pragma unroll
            for (int et = 0; et < 8; ++et) ot[et] = (f32x4){0.f, 0.f, 0.f, 0.f};
#pragma unroll
            for (int k2 = 0; k2 < 8; ++k2) { if (2 * k2 < nkt) { const bf16x8 pb = pack8(st[2 * k2], st[2 * k2 + 1]);
#pragma unroll
                    for (int eh = 0; eh < 2; ++eh) { bf16x8 vf[4];
#pragma unroll
                        for (int et = 0; et < 4; ++et) vf[et] = *(const LAS bf16x8*)(VT + (16 * (4 * eh + et) + fr) * 272 + 32 * k2 + 8 * fq);
#pragma unroll
                        for (int et = 0; et < 4; ++et) ot[4 * eh + et] = mfma16(vf[et], pb, ot[4 * eh + et]); } } }
            if (valid) { const float il = 1.f / ls; const size_t rid = (size_t)bh * TT + t; bf16_t* op = opart + ((size_t)slot * 262144 + rid) * 128 + 4 * fq;
#pragma unroll
                for (int et = 0; et < 8; ++et) { u32x2 wv; wv.x = pk2(ot[et][0] * il, ot[et][1] * il); wv.y = pk2(ot[et][2] * il, ot[et][3] * il); *(u32x2*)(op + 16 * et) = wv; }
                if (fq == 0) ML[(size_t)slot * 262144 + rid] = (f32x2){mx, ls}; }
            }
#pragma unroll
            for (int ks = 0; ks < 4; ++ks) Bq[ks] = Bn[ks];
        }
        __syncthreads();
    }
}

DI void phase_moba_combine(const Params& P, bool do_gate, bool do_moba, int wg0, int nwg) {
    const bf16_t* opart = (const bf16_t*)P.out; const f32x2* ML = (const f32x2*)(P.ws + WS_ML); bf16_t* mix = (bf16_t*)(P.ws + WS_R2);
    const int gtid = wg0 * NTHREADS + opq_tid(), gsz = nwg * NTHREADS;
    if (do_gate) { const bf16_t* proj = (const bf16_t*)(P.ws + WS_R1);
      for (int i0 = gtid; i0 < MT * 128; i0 += 8 * gsz) { u32x4 mv[8], zv[8];
#pragma unroll
          for (int k = 0; k < 8; ++k) { const int i = i0 + k * gsz < MT * 128 ? i0 + k * gsz : i0; const int row = i >> 7, sg = i & 127; mv[k] = *(const u32x4*)(mix + (size_t)row * DM + sg * 8); zv[k] = *(const u32x4*)(proj + (size_t)row * NPJ + OFF_GZ + sg * 8); }
          const int sg0 = i0 & 127; const f32x4 g0 = *(const f32x4*)(P.gdn_norm + (sg0 & 15) * 8), g1 = *(const f32x4*)(P.gdn_norm + (sg0 & 15) * 8 + 4);
#pragma unroll
          for (int k = 0; k < 8; ++k) { const int i = i0 + k * gsz; const int row = i >> 7, sg = i & 127;
              float o[8]; o[0] = bflo(mv[k].x); o[1] = bfhi(mv[k].x); o[2] = bflo(mv[k].y); o[3] = bfhi(mv[k].y); o[4] = bflo(mv[k].z); o[5] = bfhi(mv[k].z); o[6] = bflo(mv[k].w); o[7] = bfhi(mv[k].w);
              float ssl = 0.f;
#pragma unroll
              for (int q = 0; q < 8; ++q) ssl += o[q] * o[q];
              const float rs = rsqrtf(row16_sum(ssl) * (1.f / 128.f) + 1e-6f); const u32x4 z = zv[k];
              u32x4 wv; wv.x = pk2(o[0] * rs * g0[0] * silu_f(bflo(z.x)), o[1] * rs * g0[1] * silu_f(bfhi(z.x))); wv.y = pk2(o[2] * rs * g0[2] * silu_f(bflo(z.y)), o[3] * rs * g0[3] * silu_f(bfhi(z.y)));
              wv.z = pk2(o[4] * rs * g1[0] * silu_f(bflo(z.z)), o[5] * rs * g1[1] * silu_f(bfhi(z.z))); wv.w = pk2(o[6] * rs * g1[2] * silu_f(bflo(z.w)), o[7] * rs * g1[3] * silu_f(bfhi(z.w)));
              if (i < MT * 128) *(u32x4*)(mix + (size_t)row * DM + sg * 8) = wv; } } }
    if (do_moba) for (int i0 = gtid; i0 < 262144 * 16; i0 += 2 * gsz) {
        f32x2 ml[2][4]; u32x4 raw[2][4];
#pragma unroll
        for (int k = 0; k < 2; ++k) { const int i = i0 + k * gsz < 262144 * 16 ? i0 + k * gsz : i0; const int rid = i >> 4, sg = i & 15;
#pragma unroll
            for (int s = 0; s < 4; ++s) { ml[k][s] = ML[(size_t)s * 262144 + rid]; raw[k][s] = *(const u32x4*)(opart + ((size_t)s * 262144 + rid) * 128 + sg * 8); } }
#pragma unroll
        for (int k = 0; k < 2; ++k) { const int i = i0 + k * gsz; const int rid = i >> 4, sg = i & 15; const int bh = rid >> 14, t = rid & 16383, b = bh >> 3, h = bh & 7;
            float M = -INFINITY;
#pragma unroll
            for (int s = 0; s < 4; ++s) M = fmaxf(M, ml[k][s].x);
            float wgt[4], Lt = 0.f;
#pragma unroll
            for (int s = 0; s < 4; ++s) { wgt[s] = ml[k][s].y > 0.f ? ml[k][s].y * exp2f(ml[k][s].x - M) : 0.f; Lt += wgt[s]; }
            const float iL = 1.f / Lt; float o[8];
#pragma unroll
            for (int q = 0; q < 8; ++q) o[q] = 0.f;
#pragma unroll
            for (int s = 0; s < 4; ++s) { const float ww = wgt[s] * iL; const u32x4 r = raw[k][s];
                if (wgt[s] > 0.f) { o[0] += ww * bflo(r.x); o[1] += ww * bfhi(r.x); o[2] += ww * bflo(r.y); o[3] += ww * bfhi(r.y); o[4] += ww * bflo(r.z); o[5] += ww * bfhi(r.z); o[6] += ww * bflo(r.w); o[7] += ww * bfhi(r.w); } }
            u32x4 wv; wv.x = pk2(o[0], o[1]); wv.y = pk2(o[2], o[3]); wv.z = pk2(o[4], o[5]); wv.w = pk2(o[6], o[7]);
            if (i < 262144 * 16) *(u32x4*)(mix + (size_t)(b * TT + t) * DM + 1024 + h * 128 + sg * 8) = wv; } }
}

DI void sub_barrier(unsigned* ctr, unsigned nwg) {
    asm volatile("s_waitcnt vmcnt(0)" ::: "memory");
    __syncthreads();
    if (threadIdx.x == 0) {
        __builtin_amdgcn_fence(__ATOMIC_RELEASE, "agent");
        __hip_atomic_fetch_add(ctr, 1u, __ATOMIC_RELAXED, __HIP_MEMORY_SCOPE_AGENT);
        while (__hip_atomic_load(ctr, __ATOMIC_RELAXED, __HIP_MEMORY_SCOPE_AGENT) < nwg) __builtin_amdgcn_s_sleep(8);
        __builtin_amdgcn_fence(__ATOMIC_ACQUIRE, "agent");
        asm volatile("s_waitcnt vmcnt(0)" ::: "memory");
    }
    __syncthreads();
}

__global__ void __launch_bounds__(NTHREADS) hybrid_fwd(Params P) {
    extern __shared__ __attribute__((aligned(16))) unsigned char smem[];
    LAS unsigned char* lds = (LAS unsigned char*)smem;
    cg::grid_group grid = cg::this_grid();
    unsigned char* ws = P.ws; const int G = gridDim.x, bx = blockIdx.x;
    bf16_t* R0 = (bf16_t*)(ws + WS_R0); bf16_t* R1 = (bf16_t*)(ws + WS_R1); bf16_t* R2 = (bf16_t*)(ws + WS_R2);
    float* ss1 = (float*)(ws + WS_SS1); float* ss2 = (float*)(ws + WS_SS2);

    phase_prep(P, lds);
    grid.sync();
    { pg8::Gemm g{R0, (const bf16_t*)(ws + WS_WIN), MT, NPJ, DM}; pg8::StaticOrder S; S.init(MT, NPJ, G, bx); EpiProj E{R1, (bf16_t*)(ws + WS_HALO)}; pg8::gemm_phase<decltype(E), pg8::StaticOrder, true, true>(lds, g, S, E); }
    phase_ba(P);
    grid.sync();
    phase_gdn_prep(P, lds, 0, 32, bx, G, (unsigned*)(ws + WS_CTL) + 14, 0x7fffffff);
    if (bx < 16) {
        if (threadIdx.x == 0) { const unsigned* f14 = (const unsigned*)(ws + WS_CTL) + 14; while (__hip_atomic_load(f14, __ATOMIC_RELAXED, __HIP_MEMORY_SCOPE_AGENT) < (unsigned)G) __builtin_amdgcn_s_sleep(8);
            __builtin_amdgcn_fence(__ATOMIC_ACQUIRE, "agent"); asm volatile("s_waitcnt vmcnt(0)" ::: "memory"); }
        __syncthreads(); }
    if (bx < 16) phase_gdn_scan(P, lds, bx, (const unsigned*)(ws + WS_CTL) + 11, (unsigned)(G - 16), 32);
    else { unsigned* ctl = (unsigned*)(ws + WS_CTL);
        phase_gdn_prep(P, lds, 32, 224, bx - 16, G - 16, ctl + 11, 768, ctl + 13, 256);
        asm volatile("s_waitcnt vmcnt(0)" ::: "memory"); __syncthreads();
        if (threadIdx.x == 0) { __builtin_amdgcn_fence(__ATOMIC_RELEASE, "agent"); __hip_atomic_fetch_add(ctl + 12, 1u, __ATOMIC_RELAXED, __HIP_MEMORY_SCOPE_AGENT); }
        phase_moba_prep(P, lds, bx - 16, G - 16); sub_barrier(ctl + 8, (unsigned)(G - 16));
        phase_moba_select(P, lds, bx - 16, G - 16); sub_barrier(ctl + 9, (unsigned)(G - 16));
        phase_moba_attn(P, lds);
        phase_wconv_late(P, lds, bx - 16, G - 16);
        sub_barrier(ctl + 10, (unsigned)(G - 16)); phase_moba_combine(P, false, true, bx - 16, G - 16); }
    if (bx < 16) { asm volatile("s_waitcnt vmcnt(0)" ::: "memory"); __syncthreads();
        if (threadIdx.x == 0) { __builtin_amdgcn_fence(__ATOMIC_RELEASE, "agent"); __hip_atomic_fetch_add((unsigned*)(ws + WS_CTL) + 15, 1u, __ATOMIC_RELAXED, __HIP_MEMORY_SCOPE_AGENT); } }
    { if (threadIdx.x == 0) { const unsigned* f15 = (const unsigned*)(ws + WS_CTL) + 15;
          while (__hip_atomic_load(f15, __ATOMIC_RELAXED, __HIP_MEMORY_SCOPE_AGENT) < 16u) __builtin_amdgcn_s_sleep(8);
          __builtin_amdgcn_fence(__ATOMIC_ACQUIRE, "agent"); asm volatile("s_waitcnt vmcnt(0)" ::: "memory"); }
      __syncthreads(); }
    phase_moba_combine(P, true, false, bx, G);
    grid.sync();
    { pg8::Gemm g{R2, (const bf16_t*)(ws + WS_WO), MT, DM, DM}; pg8::StaticOrder S; S.init(MT, DM, G, bx); EpiResid E{P.x, P.out, R0, ss1}; pg8::gemm_phase<decltype(E), pg8::StaticOrder, true, false>(lds, g, S, E); }
    grid.sync();
    { pg8::Gemm g{R0, (const bf16_t*)(ws + WS_WGU), MT, 2 * FF, DM}; pg8::StaticOrder S; S.init(MT, 2 * FF, G, bx); EpiAct E{R1, ss1}; pg8::gemm_phase<decltype(E), pg8::StaticOrder, true, true>(lds, g, S, E); }
    grid.sync();
    { pg8::Gemm g{(const bf16_t*)(ws + WS_PB), (const bf16_t*)(ws + WS_WPP), MT, DM, 256}; pg8::StaticOrder S; S.init(MT, DM, G, bx); EpiPlainBf16 E{R0, DM}; pg8::gemm_phase<decltype(E), pg8::StaticOrder, true, false>(lds, g, S, E); }
    { pg8::Gemm g{R1, (const bf16_t*)(ws + WS_WDN), MT, DM, FF}; pg8::StaticOrder S; S.init(MT, DM, G, bx); EpiResid E{P.out, P.out, R2, ss2}; pg8::gemm_phase<decltype(E), pg8::StaticOrder, true, false>(lds, g, S, E); }
    grid.sync();
    { pg8::Gemm g{R2, (const bf16_t*)(ws + WS_WPG), MT, DM, DM}; pg8::StaticOrder S; S.init(MT, DM, G, bx); EpiOut E{P.out, R0, ss2}; pg8::gemm_phase<decltype(E), pg8::StaticOrder, true, false>(lds, g, S, E); }
}

extern "C" void kernel_launch(void* const* d_in, const int* in_sizes, int n_in, void* d_out, int out_size, void* d_ws, size_t ws_size, hipStream_t stream) {
    static int grid_blocks = 0;
    if (!grid_blocks) {
        int dev = 0, cus = 0, per_cu = 0;
        hipGetDevice(&dev);
        hipDeviceGetAttribute(&cus, hipDeviceAttributeMultiprocessorCount, dev);
        hipFuncSetAttribute((const void*)hybrid_fwd, hipFuncAttributeMaxDynamicSharedMemorySize, LDS_BYTES);
        hipOccupancyMaxActiveBlocksPerMultiprocessor(&per_cu, (const void*)hybrid_fwd, NTHREADS, LDS_BYTES);
        if (per_cu < 1) per_cu = 1;
        grid_blocks = cus * per_cu;
        if (ws_size < WS_END) fprintf(stderr, "kernel_launch: workspace too small: %zu < %zu\n", ws_size, (size_t)WS_END);
    }
    Params p{};
    p.x = (const float*)d_in[0]; p.p = (const float*)d_in[1]; p.attn_norm = (const float*)d_in[2]; p.w_in = (const float*)d_in[3]; p.conv_w = (const float*)d_in[4];
    p.A_log = (const float*)d_in[5]; p.dt_bias = (const float*)d_in[6]; p.gdn_norm = (const float*)d_in[7]; p.q_norm = (const float*)d_in[8]; p.k_norm = (const float*)d_in[9];
    p.w_o = (const float*)d_in[10]; p.ffn_norm = (const float*)d_in[11]; p.w_gate = (const float*)d_in[12]; p.w_up = (const float*)d_in[13]; p.w_down = (const float*)d_in[14];
    p.ple_norm = (const float*)d_in[15]; p.w_pg = (const float*)d_in[16]; p.w_pp = (const float*)d_in[17];
    p.out = (float*)d_out; p.ws = (unsigned char*)d_ws;
    void* args[] = {&p};
    hipError_t e = hipLaunchCooperativeKernel((const void*)hybrid_fwd, dim3(grid_blocks), dim3(NTHREADS), args, LDS_BYTES, stream);
    if (e != hipSuccess) fprintf(stderr, "cooperative launch failed: %s (grid %d)\n", hipGetErrorString(e), grid_blocks);
}
```
